# Optimizing an MI355X kernel written in HIP

```python
import math
import jax, jax.numpy as jnp
from jax import lax
import numpy as np

D_MODEL = 2048
BATCH = 2
SEQ = 16384
DEPTH = 2

F32 = jnp.float32
CTX_LEN = 256
GRID_W = 64
CHUNK = 64
EPS = 1e-6
TINY = 1e-30
N_BRANCH = 4
BRANCH_W = 512
GLA_HEADS = 4
GLA_DK = 64
GLA_DV = 128
GLA_RANK = 16
GLA_GATE_NORM = 16.0
HG_HEADS = 4
HG_DK = 128
HG_DV = 128
DN_HEADS = 4
DN_DK = 128
DN_DV = 128
CONV_W = 4
RG_WIDTH = 512
RG_BLOCKS = 4
RG_C = 8.0
D_FF = 5632
N_EXPERTS = 8
TOP_K = 2
MOE_BLOCK = 256

IN_SPLITS = (
    GLA_HEADS * GLA_DK, GLA_HEADS * GLA_DK, GLA_HEADS * GLA_DV, GLA_HEADS * GLA_DV, 2 * GLA_RANK,
    HG_HEADS * HG_DK, HG_HEADS * HG_DK, HG_HEADS * HG_DK, HG_HEADS * HG_DV, HG_HEADS * HG_DV,
    DN_HEADS * DN_DK, DN_HEADS * DN_DK, DN_HEADS * DN_DV, 2 * DN_HEADS, 2 * DN_HEADS, DN_HEADS * DN_DV,
    RG_WIDTH, RG_WIDTH,
)
N_MIX_COLS = sum(IN_SPLITS)
D_IN = N_MIX_COLS + N_BRANCH * D_MODEL

kernel_name = 'hybrid_gla_hgrn2_gdn_rglru_moe_dit'


def _rms(x, w):
    xf = x.astype(F32)
    y = xf * lax.rsqrt(jnp.mean(jnp.square(xf), axis=-1, keepdims=True) + EPS)
    return (y * w.astype(F32)).astype(x.dtype)


def _modulate(x, w, shift, scale):
    return _rms(x, w) * (1.0 + scale) + shift


def _l2norm(x):
    return x * lax.rsqrt(jnp.sum(jnp.square(x), axis=-1, keepdims=True) + EPS)


def _raster_to_column(h, rows):
    b, t, d = h.shape
    return h.reshape(b, rows, GRID_W, d).transpose(0, 2, 1, 3).reshape(b, t, d)


def _column_to_raster(h, rows):
    b, t, d = h.shape
    return h.reshape(b, GRID_W, rows, d).transpose(0, 2, 1, 3).reshape(b, t, d)


def _centred_conv(x, w):
    t = x.shape[1]
    left = CONV_W // 2
    xp = jnp.pad(x, ((0, 0), (left, CONV_W - 1 - left), (0, 0)))
    y = xp[:, 0:t] * w[0]
    for j in range(1, CONV_W):
        y = y + xp[:, j:j + t] * w[j]
    return y


def _to_chunks(a):
    b, t, h, d = a.shape
    return a.reshape(b, t // CHUNK, CHUNK, h, d).transpose(1, 0, 3, 2, 4)


def _from_chunks(a):
    n, b, h, c, d = a.shape
    return a.transpose(1, 0, 3, 2, 4).reshape(b, n * c, h, d)


def _gated_linear_chunk(q, k, v, log_f, s0):
    qc, kc, vc = _to_chunks(q), _to_chunks(k), _to_chunks(v)
    bc = jnp.cumsum(_to_chunks(log_f), axis=-2)
    incl = jnp.tril(jnp.ones((CHUNK, CHUNK), dtype=bool))

    def step(s, inp):
        qn, kn, vn, bn = inp
        diff = bn[:, :, :, None, :] - bn[:, :, None, :, :]
        rel = jnp.where(incl[:, :, None], jnp.exp(jnp.minimum(diff, 0.0)), 0.0)
        attn = jnp.einsum('bhik,bhjk,bhijk->bhij', qn, kn, rel)
        b_last = bn[:, :, -1:, :]
        o = jnp.einsum('bhij,bhjv->bhiv', attn, vn) + jnp.einsum('bhik,bhkv->bhiv', qn * jnp.exp(bn), s)
        s = s * jnp.exp(b_last[:, :, 0, :, None]) + jnp.einsum('bhjk,bhjv->bhkv', kn * jnp.exp(b_last - bn), vn)
        return s, o

    s, o = lax.scan(step, s0, (qc, kc, vc, bc))
    return _from_chunks(o), s


def _gated_delta_chunk(q, k, v, g, beta, s0):
    qc, kc, vc = _to_chunks(q), _to_chunks(k), _to_chunks(v)
    gc = jnp.cumsum(_to_chunks(g[..., None])[..., 0], axis=-1)
    bc = _to_chunks(beta[..., None])[..., 0]
    incl = jnp.tril(jnp.ones((CHUNK, CHUNK), dtype=bool))
    strict = jnp.tril(jnp.ones((CHUNK, CHUNK), dtype=bool), -1)
    rel = jnp.where(incl, jnp.exp(jnp.minimum(gc[..., :, None] - gc[..., None, :], 0.0)), 0.0)
    kb = kc * bc[..., None]
    a_kk = jnp.where(strict, jnp.einsum('nbhik,nbhjk->nbhij', kb, kc) * rel, 0.0)
    eye = jnp.eye(CHUNK, dtype=q.dtype)
    t_inv = lax.linalg.triangular_solve(a_kk + eye, jnp.broadcast_to(eye, a_kk.shape),
                                        left_side=True, lower=True, unit_diagonal=True)
    u = t_inv @ (vc * bc[..., None])
    w = t_inv @ (kb * jnp.exp(gc)[..., None])
    a_qk = jnp.where(incl, jnp.einsum('nbhik,nbhjk->nbhij', qc, kc) * rel, 0.0)
    q_dec = qc * jnp.exp(gc)[..., None]
    k_dec = kc * jnp.exp(gc[..., -1:] - gc)[..., None]
    g_last = jnp.exp(gc[..., -1])

    def step(s, inp):
        u_n, w_n, qd_n, kd_n, aqk_n, gl_n = inp
        v_new = u_n - w_n @ s
        o = qd_n @ s + aqk_n @ v_new
        s = s * gl_n[..., None, None] + jnp.einsum('bhck,bhcv->bhkv', kd_n, v_new)
        return s, o

    s, o = lax.scan(step, s0, (u, w, q_dec, k_dec, a_qk, g_last))
    return _from_chunks(o), s


def _linear_scan(log_a, u, h0):
    def combine(l, r):
        return l[0] * r[0], r[0] * l[1] + r[1]
    a_cum, h = lax.associative_scan(combine, (jnp.exp(log_a), u), axis=1)
    h = h + a_cum * h0[:, None, :]
    return h, h[:, -1]


def _bidirectional(run, ctx_fwd, lat_fwd, ctx_bwd, lat_bwd, s0):
    flip = lambda a: jnp.flip(a, axis=1)
    oc_f, sc_f = run(*ctx_fwd, s0)
    ol_f, _ = run(*lat_fwd, sc_f)
    oc_b, sc_b = run(*[flip(a) for a in ctx_bwd], s0)
    ol_b, _ = run(*[flip(a) for a in lat_bwd], sc_b)
    return oc_f + flip(oc_b), ol_f + flip(ol_b)


def _gated_head_norm(o, g, norm_w):
    b, t, h, v = o.shape
    y = _rms(o, norm_w) * jax.nn.silu(g.astype(F32)).reshape(b, t, h, v)
    return y.reshape(b, t, h * v).astype(g.dtype)


def _gla_branch(pc, pl, w_a2, b_a2, norm_w):
    def inputs(p, d):
        q, k, v, _, a = p
        bsz, t = q.shape[:2]
        z = a[..., d * GLA_RANK:(d + 1) * GLA_RANK].astype(F32) @ w_a2[d].astype(F32) + b_a2[d].astype(F32)
        log_f = jax.nn.log_sigmoid(z) / GLA_GATE_NORM
        heads = lambda u, n: u.astype(F32).reshape(bsz, t, GLA_HEADS, n)
        return (heads(q, GLA_DK) * GLA_DK ** -0.5, heads(k, GLA_DK), heads(v, GLA_DV), heads(log_f, GLA_DK))
    s0 = jnp.zeros((pl[0].shape[0], GLA_HEADS, GLA_DK, GLA_DV), F32)
    oc, ol = _bidirectional(_gated_linear_chunk, inputs(pc, 0), inputs(pl, 0), inputs(pc, 1), inputs(pl, 1), s0)
    return _gated_head_norm(oc, pc[3], norm_w), _gated_head_norm(ol, pl[3], norm_w)


def _hgrn2_branch(pc, pl, lb, norm_w):
    lb = lb.astype(F32)
    def inputs(p, d):
        q, f_fwd, f_bwd, i, _ = p
        bsz, t = q.shape[:2]
        z = (f_fwd, f_bwd)[d].astype(F32)
        f = lb + (1.0 - lb) * jax.nn.sigmoid(z)
        log_f = jnp.log(jnp.maximum(f, TINY))
        key = (1.0 - lb) * jax.nn.sigmoid(-z)
        heads = lambda u, n: u.reshape(bsz, t, HG_HEADS, n)
        qh = jax.nn.silu(q.astype(F32)) * HG_DK ** -0.5
        return (heads(qh, HG_DK), heads(key, HG_DK), heads(i.astype(F32), HG_DV), heads(log_f, HG_DK))
    s0 = jnp.zeros((pl[0].shape[0], HG_HEADS, HG_DK, HG_DV), F32)
    oc, ol = _bidirectional(_gated_linear_chunk, inputs(pc, 0), inputs(pl, 0), inputs(pc, 1), inputs(pl, 1), s0)
    return _gated_head_norm(oc, pc[4], norm_w), _gated_head_norm(ol, pl[4], norm_w)


def _deltanet_branch(pc, pl, conv_w, a_log, dt_bias, norm_w):
    a_log = a_log.astype(F32)
    dt_bias = dt_bias.astype(F32)
    def prep(p):
        q, k, v, a, b, _ = p
        bsz, t = q.shape[:2]
        qkv = jax.nn.silu(_centred_conv(jnp.concatenate([q, k, v], axis=-1), conv_w).astype(F32))
        q, k, v = jnp.split(qkv, [DN_HEADS * DN_DK, 2 * DN_HEADS * DN_DK], axis=-1)
        q = _l2norm(q.reshape(bsz, t, DN_HEADS, DN_DK)) * DN_DK ** -0.5
        k = _l2norm(k.reshape(bsz, t, DN_HEADS, DN_DK))
        v = v.reshape(bsz, t, DN_HEADS, DN_DV)
        return q, k, v, a.astype(F32).reshape(bsz, t, 2, DN_HEADS), b.astype(F32).reshape(bsz, t, 2, DN_HEADS)
    def inputs(pp, d):
        q, k, v, a, b = pp
        g = -jnp.exp(a_log[d]) * jax.nn.softplus(a[:, :, d] + dt_bias[d])
        beta = jax.nn.sigmoid(b[:, :, d])
        return q, k, v, g, beta
    ppc, ppl = prep(pc), prep(pl)
    s0 = jnp.zeros((pl[0].shape[0], DN_HEADS, DN_DK, DN_DV), F32)
    oc, ol = _bidirectional(_gated_delta_chunk, inputs(ppc, 0), inputs(ppl, 0), inputs(ppc, 1), inputs(ppl, 1), s0)
    return _gated_head_norm(oc, pc[5], norm_w), _gated_head_norm(ol, pl[5], norm_w)


def _rglru_branch(pc, pl, conv_w, conv_b, w_r, b_r, w_i, b_i, lam):
    def prep(p):
        return (_centred_conv(p[0], conv_w) + conv_b).astype(F32)
    def inputs(xb, d):
        bsz, t = xb.shape[:2]
        xr = xb.reshape(bsz, t, RG_BLOCKS, RG_WIDTH // RG_BLOCKS)
        blockdiag = lambda w, b: jnp.einsum('btnc,ncd->btnd', xr, w.astype(F32)).reshape(bsz, t, RG_WIDTH) + b.astype(F32)
        r = jax.nn.sigmoid(blockdiag(w_r[d], b_r[d]))
        i = jax.nn.sigmoid(blockdiag(w_i[d], b_i[d]))
        log_a = -RG_C * r * jax.nn.softplus(-lam[d].astype(F32))
        u = jnp.sqrt(jnp.maximum(-jnp.expm1(2.0 * log_a), 0.0)) * (i * xb)
        return log_a, u
    xc, xl = prep(pc), prep(pl)
    s0 = jnp.zeros((pl[0].shape[0], RG_WIDTH), F32)
    hc, hl = _bidirectional(_linear_scan, inputs(xc, 0), inputs(xl, 0), inputs(xc, 1), inputs(xl, 1), s0)
    out = lambda h, y: (jax.nn.gelu(y.astype(F32)) * h).astype(y.dtype)
    return out(hc, pc[1]), out(hl, pl[1])


def _token_mixer(hl, hc, w_in, w_up, w_out, gla_p, hg_p, dn_p, rg_p, ctx_out):
    cuts = [int(v) for v in np.cumsum(IN_SPLITS)[:-1]]
    w_mix = w_in[:, :N_MIX_COLS]
    pl = jnp.split(hl @ w_mix, cuts, axis=-1)
    pc = jnp.split(hc @ w_mix, cuts, axis=-1)
    outs = [
        _gla_branch(pc[0:5], pl[0:5], *gla_p),
        _hgrn2_branch(pc[5:10], pl[5:10], *hg_p),
        _deltanet_branch(pc[10:16], pl[10:16], *dn_p),
        _rglru_branch(pc[16:18], pl[16:18], *rg_p),
    ]

    def merge(h, branch_outs):
        acc = None
        for b, o in enumerate(branch_outs):
            gate = jax.nn.sigmoid(h @ w_in[:, N_MIX_COLS + b * D_MODEL:N_MIX_COLS + (b + 1) * D_MODEL])
            term = gate * (o @ w_up[b])
            acc = term if acc is None else acc + term
        return acc @ w_out

    yl = merge(hl, [o[1] for o in outs])
    yc = merge(hc, [o[0] for o in outs]) if ctx_out else None
    return yl, yc


def _swiglu(h, w1, w3, w2):
    return (jax.nn.silu(h @ w1) * (h @ w3)) @ w2


def _moe(h, router, w1, w3, w2):
    shape = h.shape
    t = h.reshape(-1, shape[-1])
    logits = (t @ router).astype(F32)
    top_logits, top_idx = lax.top_k(logits, TOP_K)
    top_w = jax.nn.softmax(top_logits, axis=-1)
    flat_e = top_idx.reshape(-1)
    m = flat_e.shape[0]
    order = jnp.argsort(flat_e)
    sorted_e = flat_e[order]
    tok = order // TOP_K
    counts = jnp.bincount(flat_e, length=N_EXPERTS)
    padded = (counts + MOE_BLOCK - 1) // MOE_BLOCK * MOE_BLOCK
    pad_end = jnp.cumsum(padded)
    start = jnp.cumsum(counts) - counts
    dest = pad_end[sorted_e] - padded[sorted_e] + jnp.arange(m) - start[sorted_e]
    n_blocks = -(-m // MOE_BLOCK) + N_EXPERTS
    buf = jnp.zeros((n_blocks * MOE_BLOCK, shape[-1]), t.dtype).at[dest].set(t[tok])
    block_e = jnp.minimum(jnp.searchsorted(pad_end, jnp.arange(n_blocks) * MOE_BLOCK, side='right'), N_EXPERTS - 1)

    def expert_block(args):
        xb, e = args
        return (jax.nn.silu(xb @ w1[e]) * (xb @ w3[e])) @ w2[e]

    y = lax.map(expert_block, (buf.reshape(n_blocks, MOE_BLOCK, shape[-1]), block_e))
    y = y.reshape(n_blocks * MOE_BLOCK, shape[-1])[dest] * top_w.reshape(-1)[order][:, None].astype(t.dtype)
    return jnp.zeros_like(t).at[tok].add(y).reshape(shape)


def setup_inputs(seed: int = 0) -> dict:
    key = jax.random.key(seed)
    ks = iter(jax.random.split(key, 48))
    nrm = lambda shape, s: jax.random.normal(next(ks), shape, F32) * s
    uni = lambda shape, lo, hi: jax.random.uniform(next(ks), shape, F32, lo, hi)
    n_dense = (DEPTH + 1) // 2
    n_moe = DEPTH // 2
    hd = D_MODEL ** -0.5
    dt = jnp.exp(uni((DEPTH, 2, DN_HEADS), math.log(1e-3), math.log(1e-1)))
    a_rg = uni((DEPTH, 2, RG_WIDTH), 0.9, 0.999) ** (1.0 / RG_C)
    return {
        'x': nrm((BATCH, SEQ, D_MODEL), 1.0),
        'c': nrm((BATCH, D_MODEL), 1.0),
        'ctx': nrm((BATCH, CTX_LEN, D_MODEL), 1.0),
        'c_ctx': nrm((D_MODEL,), 1.0),
        'w_mod': nrm((DEPTH, D_MODEL, 6 * D_MODEL), 0.5 * hd),
        'b_mod': nrm((DEPTH, 6 * D_MODEL), 0.02),
        'norm_w': 1.0 + nrm((DEPTH, 2, D_MODEL), 0.02),
        'final_norm_w': 1.0 + nrm((D_MODEL,), 0.02),
        'w_in': nrm((DEPTH, D_MODEL, D_IN), hd),
        'w_up': nrm((DEPTH, N_BRANCH, BRANCH_W, D_MODEL), BRANCH_W ** -0.5),
        'w_out': nrm((DEPTH, D_MODEL, D_MODEL), hd),
        'gla_w_a2': nrm((DEPTH, 2, GLA_RANK, GLA_HEADS * GLA_DK), GLA_RANK ** -0.5),
        'gla_b_a2': nrm((DEPTH, 2, GLA_HEADS * GLA_DK), 0.1),
        'gla_norm_w': 1.0 + nrm((DEPTH, GLA_DV), 0.02),
        'hg_lb_logits': nrm((DEPTH, HG_HEADS * HG_DK), 0.1),
        'hg_norm_w': 1.0 + nrm((DEPTH, HG_DV), 0.02),
        'dn_conv_w': nrm((DEPTH, CONV_W, DN_HEADS * (2 * DN_DK + DN_DV)), CONV_W ** -0.5),
        'dn_a_log': jnp.log(uni((DEPTH, 2, DN_HEADS), 1.0, 16.0)),
        'dn_dt_bias': dt + jnp.log(-jnp.expm1(-dt)),
        'dn_norm_w': 1.0 + nrm((DEPTH, DN_DV), 0.02),
        'rg_conv_w': nrm((DEPTH, CONV_W, RG_WIDTH), CONV_W ** -0.5),
        'rg_conv_b': nrm((DEPTH, RG_WIDTH), 0.02),
        'rg_w_r': nrm((DEPTH, 2, RG_BLOCKS, RG_WIDTH // RG_BLOCKS, RG_WIDTH // RG_BLOCKS), (RG_WIDTH // RG_BLOCKS) ** -0.5),
        'rg_b_r': nrm((DEPTH, 2, RG_WIDTH), 0.02),
        'rg_w_i': nrm((DEPTH, 2, RG_BLOCKS, RG_WIDTH // RG_BLOCKS, RG_WIDTH // RG_BLOCKS), (RG_WIDTH // RG_BLOCKS) ** -0.5),
        'rg_b_i': nrm((DEPTH, 2, RG_WIDTH), 0.02),
        'rg_lambda': jnp.log(a_rg) - jnp.log1p(-a_rg),
        'ffn_w1': nrm((n_dense, D_MODEL, D_FF), hd),
        'ffn_w3': nrm((n_dense, D_MODEL, D_FF), hd),
        'ffn_w2': nrm((n_dense, D_FF, D_MODEL), D_FF ** -0.5),
        'moe_router': nrm((n_moe, D_MODEL, N_EXPERTS), hd),
        'moe_w1': nrm((n_moe, N_EXPERTS, D_MODEL, D_FF), hd),
        'moe_w3': nrm((n_moe, N_EXPERTS, D_MODEL, D_FF), hd),
        'moe_w2': nrm((n_moe, N_EXPERTS, D_FF, D_MODEL), D_FF ** -0.5),
    }


def reference(x, c, ctx, c_ctx, w_mod, b_mod, norm_w, final_norm_w, w_in, w_up, w_out,
              gla_w_a2, gla_b_a2, gla_norm_w, hg_lb_logits, hg_norm_w,
              dn_conv_w, dn_a_log, dn_dt_bias, dn_norm_w,
              rg_conv_w, rg_conv_b, rg_w_r, rg_b_r, rg_w_i, rg_b_i, rg_lambda,
              ffn_w1, ffn_w3, ffn_w2, moe_router, moe_w1, moe_w3, moe_w2):
    rows = x.shape[1] // GRID_W
    lb_sm = jax.nn.softmax(hg_lb_logits.astype(F32), axis=0)
    lower_bounds = jnp.cumsum(lb_sm, axis=0) - lb_sm[0]
    silu_c = jax.nn.silu(c)
    silu_cc = jax.nn.silu(c_ctx)
    xl, xc = x, ctx
    for l in range(DEPTH):
        last = l == DEPTH - 1
        mod_l = jnp.split((silu_c @ w_mod[l] + b_mod[l])[:, None, :], 6, axis=-1)
        mod_c = jnp.split(silu_cc @ w_mod[l] + b_mod[l], 6, axis=-1)
        hl = _modulate(xl, norm_w[l, 0], mod_l[0], mod_l[1])
        hc = _modulate(xc, norm_w[l, 0], mod_c[0], mod_c[1])
        if l % 2 == 1:
            hl = _raster_to_column(hl, rows)
        yl, yc = _token_mixer(
            hl, hc, w_in[l], w_up[l], w_out[l],
            (gla_w_a2[l], gla_b_a2[l], gla_norm_w[l]),
            (lower_bounds[l], hg_norm_w[l]),
            (dn_conv_w[l], dn_a_log[l], dn_dt_bias[l], dn_norm_w[l]),
            (rg_conv_w[l], rg_conv_b[l], rg_w_r[l], rg_b_r[l], rg_w_i[l], rg_b_i[l], rg_lambda[l]),
            not last)
        if l % 2 == 1:
            yl = _column_to_raster(yl, rows)
        xl = xl + mod_l[2] * yl
        if l % 2 == 0:
            j = l // 2
            ffn = lambda h, j=j: _swiglu(h, ffn_w1[j], ffn_w3[j], ffn_w2[j])
        else:
            j = l // 2
            ffn = lambda h, j=j: _moe(h, moe_router[j], moe_w1[j], moe_w3[j], moe_w2[j])
        hl = _modulate(xl, norm_w[l, 1], mod_l[3], mod_l[4])
        xl = xl + mod_l[5] * ffn(hl)
        if not last:
            xc = xc + mod_c[2] * yc
            hc = _modulate(xc, norm_w[l, 1], mod_c[3], mod_c[4])
            xc = xc + mod_c[5] * ffn(hc)
    return _rms(xl, final_norm_w)
```

```cpp
#include <hip/hip_runtime.h>
#include <cstdio>
#include <cstdint>
#define N_LAUNCHES 23
namespace pg8 {
#define PG8_LAS __attribute__((address_space(3)))
typedef unsigned short bf16_t;
typedef short bf16x8 __attribute__((ext_vector_type(8)));
typedef float f32x4 __attribute__((ext_vector_type(4)));
typedef unsigned u32x4 __attribute__((ext_vector_type(4)));
constexpr int BM = 256, BK = 64, HALF = 128, HTB = HALF * BK * 2  , STAGE_BYTES = 8 * HTB, NXCD = 8, WGM = 8;

__host__ __device__ __forceinline__ int lds_byte(int r, int c) { const int st = (r >> 4) * 2 + (c >> 5), rr = r & 15, cc = c & 31, ob = rr * 64 + cc * 2; return st * 1024 + (ob ^ (((ob >> 9) & 1) << 5)); }
__host__ __device__ __forceinline__ void stage_rc(int b, int& R, int& C) { const int st = b / 1024, sb = b % 1024, swz = sb ^ (((sb >> 9) & 1) << 5); R = (st >> 1) * 16 + swz / 64; C = (st & 1) * 32 + (swz % 64) / 2; }
__host__ __device__ __forceinline__ int perm32(int rho) { const int n = rho >> 4, i = rho & 15; return 8 * (i >> 2) + 4 * n + (i & 3); }

struct Unit { int pm, pn; };
struct Gemm { const bf16_t* A; const bf16_t* Bt; int M, N, K; };

struct StaticOrder {
    int nM, nN, nwg, G, c;
    __host__ __device__ void init(int M, int N, int G_, int c_) { nM = M / BM; nN = N / BM; nwg = nM * nN; G = G_; c = c_; }
    __host__ __device__ bool next(int i, Unit& u) const {
        const long L = (long)i * G + c; if (L >= nwg) return false;
        int wgid = (int)L; { const int q = nwg / NXCD, r = nwg % NXCD, xcd = wgid % NXCD, off = wgid / NXCD; wgid = (xcd < r ? xcd * (q + 1) : r * (q + 1) + (xcd - r) * q) + off; }
        const int nig = WGM * nN, gid = wgid / nig, fm = gid * WGM, gsz = (nM - fm) < WGM ? (nM - fm) : WGM;
        u.pm = fm + ((wgid % nig) % gsz); u.pn = (wgid % nig) / gsz; return true;
    }
    __device__ __forceinline__ void a_ready(const Unit&) const {}
    __device__ __forceinline__ void done(const Unit&) const {}
};
__device__ __forceinline__ unsigned cvt_pk_bf16(float lo, float hi) { unsigned r; asm volatile("v_cvt_pk_bf16_f32 %0, %1, %2" : "=v"(r) : "v"(lo), "v"(hi)); return r; }
template <class Epi, class Sched, bool ALIGN_EPI = false, bool SP2 = false>
__device__ __forceinline__ void gemm_phase(PG8_LAS unsigned char* lds, const Gemm g, const Sched& S, const Epi& E) {
    const int tid = threadIdx.x, wid = __builtin_amdgcn_readfirstlane(tid >> 6), lane = tid & 63, wr = wid >> 2, wc = wid & 3, fr = lane & 15, fq = lane >> 4;
    const int K = g.K, nt = K / BK;
    unsigned voffA[2], voffB[2];
#pragma unroll
    for (int i = 0; i < 2; ++i) { int R, C; stage_rc(tid * 16 + i * 8192, R, C); const int Rb = Epi::PERM ? ((R & ~31) + perm32(R & 31)) : R;
        voffA[i] = (unsigned)(R * K + C) * 2u; voffB[i] = (unsigned)(Rb * K + C) * 2u; }
    const size_t kstep = (size_t)(BK * 2);
    const size_t hstep = (size_t)HALF * K * 2;
    const size_t tstep = 2 * hstep;
    const unsigned ldsw = (unsigned)wid * 1024u;
    const int aoff = lds_byte(wr * 64 + fr, fq * 8), boff = lds_byte(wc * 32 + fr, fq * 8);
#define PG8_SA(b, h) (((b) * 2 + (h)) * HTB)
#define PG8_SB(b, h) ((4 + (b) * 2 + (h)) * HTB)
#define PG8_STAGE(bufoff, gbase, voff) do { _Pragma("unroll") for (int _i = 0; _i < 2; ++_i) \
        __builtin_amdgcn_global_load_lds((const unsigned*)((const char*)(gbase) + (voff)[_i]), (PG8_LAS unsigned*)(lds + (bufoff) + ldsw + _i * 8192), 16, 0, 0); } while (0)
#define PG8_LDA(dst, b, h) do { _Pragma("unroll") for (int m = 0; m < 4; ++m) _Pragma("unroll") for (int k = 0; k < 2; ++k) dst[m][k] = *(const PG8_LAS bf16x8*)(lds + PG8_SA(b, h) + aoff + m * 2048 + k * 1024); } while (0)
#define PG8_LDB(dst, b, h) do { _Pragma("unroll") for (int n = 0; n < 2; ++n) _Pragma("unroll") for (int k = 0; k < 2; ++k) dst[n][k] = *(const PG8_LAS bf16x8*)(lds + PG8_SB(b, h) + boff + n * 2048 + k * 1024); } while (0)
#define PG8_MMA(ai, bj, At, Bt) do { __builtin_amdgcn_s_setprio(1); _Pragma("unroll") for (int m = 0; m < 4; ++m) _Pragma("unroll") for (int n = 0; n < 2; ++n) _Pragma("unroll") for (int k = 0; k < 2; ++k) \
        acc[ai][bj][m][n] = __builtin_amdgcn_mfma_f32_16x16x32_bf16(Bt[n][k], At[m][k], acc[ai][bj][m][n], 0, 0, 0); __builtin_amdgcn_s_setprio(0); } while (0)
#define PG8_WAIT_V(n) asm volatile("s_waitcnt vmcnt(" #n ")" ::: "memory")
#define PG8_WAIT_L(n) asm volatile("s_waitcnt lgkmcnt(" #n ")" ::: "memory")
#define PG8_BAR __builtin_amdgcn_s_barrier()
#define PG8_SCHED __builtin_amdgcn_sched_barrier(0)
    Unit cur, nxt; int ui = 0;
    if (!S.next(0, cur)) return;
    f32x4 acc[2][2][4][2];
#pragma unroll
    for (int a = 0; a < 2; ++a)
#pragma unroll
        for (int b = 0; b < 2; ++b)
#pragma unroll
            for (int m = 0; m < 4; ++m)
#pragma unroll
                for (int n = 0; n < 2; ++n) acc[a][b][m][n] = (f32x4){0.f, 0.f, 0.f, 0.f};
    bf16x8 At[4][2], B0[2][2], B1[2][2];
    const char* cA = (const char*)g.A + (size_t)cur.pm * tstep; const char* cB = (const char*)g.Bt + (size_t)cur.pn * tstep;
    S.a_ready(cur);
    if constexpr (SP2) {
        PG8_STAGE(PG8_SB(0, 0), cB, voffB); PG8_STAGE(PG8_SB(0, 1), cB + hstep, voffB); PG8_STAGE(PG8_SA(0, 0), cA, voffA); PG8_STAGE(PG8_SA(0, 1), cA + hstep, voffA);
        if (wr == 1) PG8_BAR;
        PG8_WAIT_V(2); PG8_BAR;
        PG8_STAGE(PG8_SB(1, 0), cB + kstep, voffB); PG8_STAGE(PG8_SA(1, 0), cA + kstep, voffA); PG8_STAGE(PG8_SB(1, 1), cB + hstep + kstep, voffB);
        PG8_WAIT_V(6); PG8_BAR;
    } else {
        PG8_STAGE(PG8_SB(0, 0), cB, voffB); PG8_STAGE(PG8_SA(0, 0), cA, voffA); PG8_STAGE(PG8_SB(0, 1), cB + hstep, voffB); PG8_STAGE(PG8_SA(0, 1), cA + hstep, voffA);
        if (wr == 1) PG8_BAR;
        PG8_WAIT_V(4); PG8_BAR;
        PG8_STAGE(PG8_SB(1, 0), cB + kstep, voffB); PG8_STAGE(PG8_SA(1, 0), cA + kstep, voffA); PG8_STAGE(PG8_SB(1, 1), cB + hstep + kstep, voffB);
        PG8_WAIT_V(6); PG8_BAR;
    }
    for (;;) {
        const bool has_next = S.next(ui + 1, nxt);
        const char* nA = has_next ? (const char*)g.A + (size_t)nxt.pm * tstep : cA; const char* nB = has_next ? (const char*)g.Bt + (size_t)nxt.pn * tstep : cB;
        for (int t = 0; t < nt; t += 2) {
            const bool last = (t == nt - 2);
            const char* a1 = cA + (size_t)(t + 1) * kstep;
            const char* a2 = last ? nA : cA + (size_t)(t + 2) * kstep; const char* b2 = last ? nB : cB + (size_t)(t + 2) * kstep;
            const char* a3 = a2 + kstep; const char* b3 = b2 + kstep;
            if (last && has_next) S.a_ready(nxt);
            if constexpr (SP2) {
            PG8_LDB(B0, 0, 0); PG8_LDB(B1, 0, 1); PG8_SCHED; PG8_LDA(At, 0, 0); PG8_STAGE(PG8_SA(1, 1), a1 + hstep, voffA);
            PG8_WAIT_V(8); PG8_WAIT_L(0); PG8_BAR; PG8_MMA(0, 0, At, B0); PG8_MMA(0, 1, At, B1); PG8_BAR; PG8_SCHED;
            PG8_LDA(At, 0, 1); PG8_STAGE(PG8_SB(0, 0), b2, voffB); PG8_STAGE(PG8_SB(0, 1), b2 + hstep, voffB); PG8_STAGE(PG8_SA(0, 0), a2, voffA);
            PG8_WAIT_V(8); PG8_WAIT_L(0); PG8_BAR; PG8_MMA(1, 0, At, B0); PG8_MMA(1, 1, At, B1); PG8_BAR; PG8_SCHED;
            PG8_LDB(B0, 1, 0); PG8_LDB(B1, 1, 1); PG8_SCHED; PG8_LDA(At, 1, 0); PG8_STAGE(PG8_SA(0, 1), a2 + hstep, voffA);
            PG8_WAIT_V(8); PG8_WAIT_L(0); PG8_BAR; PG8_MMA(0, 0, At, B0); PG8_MMA(0, 1, At, B1); PG8_BAR; PG8_SCHED;
            PG8_LDA(At, 1, 1); PG8_STAGE(PG8_SB(1, 0), b3, voffB); PG8_STAGE(PG8_SB(1, 1), b3 + hstep, voffB); PG8_STAGE(PG8_SA(1, 0), a3, voffA);
            PG8_WAIT_V(8); PG8_WAIT_L(0); PG8_BAR; PG8_MMA(1, 0, At, B0); PG8_MMA(1, 1, At, B1); PG8_BAR; PG8_SCHED;
            } else {
            PG8_LDB(B0, 0, 0); PG8_SCHED; PG8_LDA(At, 0, 0); PG8_STAGE(PG8_SA(1, 1), a1 + hstep, voffA);
            PG8_WAIT_L(8); PG8_BAR; PG8_WAIT_L(0); PG8_MMA(0, 0, At, B0); PG8_BAR; PG8_SCHED;
            PG8_LDB(B1, 0, 1); PG8_STAGE(PG8_SB(0, 0), b2, voffB);
            PG8_BAR; PG8_WAIT_L(0); PG8_MMA(0, 1, At, B1); PG8_BAR;
            PG8_LDA(At, 0, 1); PG8_STAGE(PG8_SA(0, 0), a2, voffA);
            PG8_BAR; PG8_WAIT_L(0); PG8_MMA(1, 0, At, B0); PG8_BAR; PG8_SCHED;
            PG8_STAGE(PG8_SB(0, 1), b2 + hstep, voffB);
            PG8_WAIT_V(6); PG8_BAR; PG8_MMA(1, 1, At, B1); PG8_BAR;
            PG8_LDB(B0, 1, 0); PG8_SCHED; PG8_LDA(At, 1, 0); PG8_STAGE(PG8_SA(0, 1), a2 + hstep, voffA);
            PG8_WAIT_L(8); PG8_BAR; PG8_WAIT_L(0); PG8_MMA(0, 0, At, B0); PG8_BAR; PG8_SCHED;
            PG8_LDB(B1, 1, 1); PG8_STAGE(PG8_SB(1, 0), b3, voffB);
            PG8_BAR; PG8_WAIT_L(0); PG8_MMA(0, 1, At, B1); PG8_BAR;
            PG8_LDA(At, 1, 1); PG8_STAGE(PG8_SA(1, 0), a3, voffA);
            PG8_BAR; PG8_WAIT_L(0); PG8_MMA(1, 0, At, B0); PG8_BAR; PG8_SCHED;
            PG8_STAGE(PG8_SB(1, 1), b3 + hstep, voffB);
            PG8_WAIT_V(6); PG8_BAR; PG8_MMA(1, 1, At, B1); PG8_BAR;
            }
        }
        if constexpr (ALIGN_EPI) { if (wr == 0) PG8_BAR; }
        if constexpr (!Epi::AFTER_DRAIN) { E(acc, cur, wr, wc, fr, fq); S.done(cur); }
        if (!has_next) break;
#pragma unroll
        for (int a = 0; a < 2; ++a)
#pragma unroll
            for (int b = 0; b < 2; ++b)
#pragma unroll
                for (int m = 0; m < 4; ++m)
#pragma unroll
                    for (int n = 0; n < 2; ++n) acc[a][b][m][n] = (f32x4){0.f, 0.f, 0.f, 0.f};
        cur = nxt; cA = nA; cB = nB; ++ui;
        if constexpr (ALIGN_EPI) { if (wr == 1) PG8_BAR; }
    }
    PG8_WAIT_V(0);
    if constexpr (!ALIGN_EPI) { if (wr == 0) PG8_BAR; }
    PG8_BAR;
    if constexpr (Epi::AFTER_DRAIN) { E.fused(acc, cur, wr, wc, fr, fq, lds, wid, lane); S.done(cur); }
#undef PG8_SA
#undef PG8_SB
#undef PG8_STAGE
#undef PG8_LDA
#undef PG8_LDB
#undef PG8_MMA
#undef PG8_WAIT_V
#undef PG8_WAIT_L
#undef PG8_BAR
#undef PG8_SCHED
}
}
#define XB_TMO      128
#define XB_XCNT(j)  (256  + 64 * (j))
#define XB_XSUB(j)  (1280 + 64 * (j))
#define XB_XGEN(j)  (2304 + 64 * (j))
#define XB_TOP      3328
#define XB_TOPGEN   3392
#define XCD_BAR_WORDS 3456
#define XB_SPIN_CAP (1u << 18)
#define LAS __attribute__((address_space(3)))

__device__ __forceinline__ unsigned xb_ld(unsigned* p)              { return __hip_atomic_load(p, __ATOMIC_RELAXED, __HIP_MEMORY_SCOPE_AGENT); }
__device__ __forceinline__ unsigned xb_add(unsigned* p, unsigned v) { return __hip_atomic_fetch_add(p, v, __ATOMIC_RELAXED, __HIP_MEMORY_SCOPE_AGENT); }
__device__ __forceinline__ unsigned xb_xcc_id() { return (unsigned)__builtin_amdgcn_s_getreg((3 << 11) | 20) & 0xFu; }
#define XB_SPIN(cond, bar) do { unsigned _sp = 0; while (cond) { __builtin_amdgcn_s_sleep(1); \
    if ((++_sp & 255u) == 0u) { if (xb_ld(&(bar)[XB_TMO])) break; if (_sp > XB_SPIN_CAP) { atomicAdd(&(bar)[XB_TMO], 1u); break; } } } } while (0)

struct XcdBarrier {
    unsigned* bar; unsigned x;
    volatile LAS unsigned* st;
};

__device__ __forceinline__ XcdBarrier xcd_barrier_post(unsigned* bar, volatile LAS unsigned* st) {
    XcdBarrier b; b.bar = bar; b.x = xb_xcc_id(); b.st = st;
    if (threadIdx.x == 0) (void)xb_add(&bar[XB_XCNT(b.x)], 1u);
    return b;
}
__device__ __forceinline__ void xcd_barrier_complete(unsigned* bar, unsigned x, unsigned& nloc, unsigned& nx) {
    const unsigned G = gridDim.x * gridDim.y * gridDim.z;
    unsigned sum, cnt, mine, sp = 0u;
    for (;;) {
        sum = 0u; cnt = 0u; mine = 0u;
#pragma unroll
        for (unsigned j = 0; j < 16; ++j) { const unsigned c = xb_ld(&bar[XB_XCNT(j)]); sum += c; cnt += (c > 0u) ? 1u : 0u; mine = (j == x) ? c : mine; }
        if (sum == G) break;
        __builtin_amdgcn_s_sleep(1);
        if ((++sp & 255u) == 0u) { if (xb_ld(&bar[XB_TMO])) break; if (sp > XB_SPIN_CAP) { atomicAdd(&bar[XB_TMO], 1u); break; } }
    }
    nloc = mine > 0u ? mine : 1u; nx = cnt > 0u ? cnt : 1u;
}

__device__ __forceinline__ void xcd_barrier(const XcdBarrier& b) {
    asm volatile("s_waitcnt vmcnt(0)" ::: "memory");
    __syncthreads();
    if (threadIdx.x == 0) {
        unsigned* bar = b.bar;
        __builtin_amdgcn_s_waitcnt(0);
        unsigned nloc = b.st[0], nx = b.st[1];
        if (nloc == 0u) { xcd_barrier_complete(bar, b.x, nloc, nx); b.st[0] = nloc; b.st[1] = nx; }
        const unsigned old = xb_add(&bar[XB_XSUB(b.x)], 1u);
        const unsigned gen = old / nloc;
        if (old + 1u == (gen + 1u) * nloc) {
            __builtin_amdgcn_fence(__ATOMIC_RELEASE, "agent");
            asm volatile("s_waitcnt vmcnt(0)" ::: "memory");
            const unsigned og = xb_add(&bar[XB_TOP], 1u);
            const unsigned tg = og / nx;
            if (og + 1u == (tg + 1u) * nx) xb_add(&bar[XB_TOPGEN], 1u);
            else XB_SPIN(xb_ld(&bar[XB_TOPGEN]) == tg, bar);
            __builtin_amdgcn_fence(__ATOMIC_ACQUIRE, "agent");
            xb_add(&bar[XB_XGEN(b.x)], 1u);
            asm volatile("s_waitcnt vmcnt(0)" ::: "memory");
        } else {
            XB_SPIN(xb_ld(&bar[XB_XGEN(b.x)]) == gen, bar);
            __builtin_amdgcn_fence(__ATOMIC_ACQUIRE, "agent");
            asm volatile("s_waitcnt vmcnt(0)" ::: "memory");
        }
    }
    __syncthreads();
}


typedef pg8::bf16_t bf16_t;
typedef pg8::f32x4 f32x4;
typedef pg8::u32x4 u32x4;
typedef unsigned u32x2 __attribute__((ext_vector_type(2)));

constexpr int D = 2048, NB = 2, T = 16384, CL = 256;
constexpr int ML = NB * T;
constexpr int MC = NB * CL;
constexpr int MT = ML + MC;
constexpr int NMIX = 7216, NMIXP = 7424, NGATE = 8192, NPROJ = NMIXP + NGATE;
constexpr int DIN = 15408;
constexpr int FF = 5632, NE = 8;
constexpr int MOE_ROWS = 67584;
constexpr int C_GLA_Q = 0, C_GLA_K = 256, C_GLA_V = 512, C_GLA_G = 1024, C_GLA_A = 1536;
constexpr int C_HG_Q = 1568, C_HG_F = 2080, C_HG_I = 3104, C_HG_G = 3616;
constexpr int C_DN_Q = 4128, C_DN_K = 4640, C_DN_V = 5152, C_DN_A = 5664, C_DN_B = 5672, C_DN_G = 5680;
constexpr int C_RG_X = 6192, C_RG_Y = 6704;
constexpr float EPS = 1e-6f;

enum { I_X = 0, I_C, I_CTX, I_CCTX, I_WMOD, I_BMOD, I_NORMW, I_FNORMW, I_WIN, I_WUP, I_WOUT, I_GLA_WA2, I_GLA_BA2, I_GLA_NW, I_HG_LB, I_HG_NW,
       I_DN_CW, I_DN_ALOG, I_DN_DTB, I_DN_NW, I_RG_CW, I_RG_CB, I_RG_WR, I_RG_BR, I_RG_WI, I_RG_BI, I_RG_LAM, I_F1, I_F3, I_F2, I_ROUTER, I_M1, I_M3, I_M2, N_IN };

constexpr size_t WS_CTL = 0, CTL_BYTES = 65536;
constexpr size_t CTL_BAR = 0, CTL_WGH = 16384, CTL_META = 24576;
constexpr size_t WS_MOD = WS_CTL + CTL_BYTES;
constexpr size_t WS_XC = WS_MOD + 294912;
constexpr size_t WS_TOPI = WS_XC + 4194304;
constexpr size_t WS_TOPW = WS_TOPI + 131072;
constexpr size_t WS_DEST = WS_TOPW + 262144;
constexpr size_t WIN_BYTES = (size_t)NPROJ * D * 2;
constexpr size_t WS_WIN = WS_DEST + 262144;
constexpr size_t WS_WUP = WS_WIN + 2 * WIN_BYTES;
constexpr size_t WS_WOUT = WS_WUP + 2 * 8388608;
constexpr size_t WS_F13 = WS_WOUT + 2 * 8388608;
constexpr size_t WS_F2 = WS_F13 + 46137344;
constexpr size_t WS_H = WS_F2 + 23068672;
constexpr size_t WS_BIG = WS_H + 136314880;
constexpr size_t WS_PGATE = WS_BIG;
constexpr size_t WS_PMIX = WS_PGATE + 545259520;
constexpr size_t WS_ORAW = WS_PMIX + 494141440;
constexpr size_t WS_RGLA = WS_ORAW + 272629760;
constexpr size_t WS_RGU = WS_RGLA + 68157440;
constexpr size_t WS_MACC = WS_PMIX;
constexpr size_t WS_MERGED = WS_PMIX + 272629760;
constexpr size_t WS_HID = WS_BIG;
constexpr size_t WS_M13 = WS_BIG;
constexpr size_t WS_M2 = WS_M13 + 369098752;
constexpr size_t WS_GATH = WS_M2 + 184549376;
constexpr size_t WS_HIDM = WS_GATH + 276824064;
constexpr size_t WS_END = WS_HIDM + 761266176;
static_assert(WS_MERGED + 136314880 <= WS_PMIX + 494141440, "merged fits in pmix region");
static_assert(WS_RGU + 68157440 <= WS_END, "mixer stage fits");

constexpr int LDS_SCR = 0;
constexpr int LDS_AUX = 131072;
constexpr int LDS_MISC = 131072 + 8192;
constexpr int LDS_BYTES = 147456;

struct Args { const float* in[N_IN]; float* out; unsigned char* ws; int ph_lo, ph_hi; };

__device__ __forceinline__ float bflo(unsigned w) { return __uint_as_float(w << 16); }
__device__ __forceinline__ float bfhi(unsigned w) { return __uint_as_float(w & 0xffff0000u); }
__device__ __forceinline__ void unpack8(const u32x4 w, float (&f)[8]) { f[0] = bflo(w.x); f[1] = bfhi(w.x); f[2] = bflo(w.y); f[3] = bfhi(w.y); f[4] = bflo(w.z); f[5] = bfhi(w.z); f[6] = bflo(w.w); f[7] = bfhi(w.w); }
__device__ __forceinline__ u32x4 pack8(const float (&f)[8]) { u32x4 w; w.x = pg8::cvt_pk_bf16(f[0], f[1]); w.y = pg8::cvt_pk_bf16(f[2], f[3]); w.z = pg8::cvt_pk_bf16(f[4], f[5]); w.w = pg8::cvt_pk_bf16(f[6], f[7]); return w; }
__device__ __forceinline__ float bf1(const bf16_t* p) { return __uint_as_float(((unsigned)*p) << 16); }
__device__ __forceinline__ float sigm(float x) { return 1.0f / (1.0f + __expf(-x)); }
__device__ __forceinline__ float siluf(float x) { return x / (1.0f + __expf(-x)); }
__device__ __forceinline__ float softplusf(float x) { return fmaxf(x, 0.f) + log1pf(__expf(-fabsf(x))); }
__device__ __forceinline__ float wave_sum(float v) { v += __shfl_xor(v, 32); v += __shfl_xor(v, 16); v += __shfl_xor(v, 8); v += __shfl_xor(v, 4); v += __shfl_xor(v, 2); v += __shfl_xor(v, 1); return v; }
__device__ __forceinline__ float gelu_tanh(float y) { const float u = 0.7978845608028654f * (y + 0.044715f * y * y * y); const float e = __expf(2.f * u); const float th = 1.f - 2.f / (e + 1.f); return 0.5f * y * (1.f + th); }

namespace pg8 {
struct EpiProj {
    static constexpr bool PERM = true, AFTER_DRAIN = false;
    bf16_t* mix; bf16_t* gate;
    __device__ __forceinline__ void operator()(const f32x4 (&acc)[2][2][4][2], const Unit& u, int wr, int wc, int fr, int fq) const {
        const int row0 = u.pm * BM + wr * 64 + fr; int colt = u.pn * BM; const bool isg = colt >= NMIXP;
        bf16_t* base = isg ? gate : mix; const int ldc = isg ? NGATE : NMIXP; if (isg) colt -= NMIXP;
        const int col0 = colt + wc * 32 + 8 * fq;
#pragma unroll
        for (int ai = 0; ai < 2; ++ai)
#pragma unroll
            for (int m = 0; m < 4; ++m) { bf16_t* rowp = base + (size_t)(row0 + ai * HALF + m * 16) * ldc + col0;
#pragma unroll
                for (int bj = 0; bj < 2; ++bj) { f32x4 v0 = acc[ai][bj][m][0], v1 = acc[ai][bj][m][1];
                    if (isg) {
#pragma unroll
                        for (int j = 0; j < 4; ++j) { v0[j] = sigm(v0[j]); v1[j] = sigm(v1[j]); } }
                    u32x4 w; w.x = cvt_pk_bf16(v0[0], v0[1]); w.y = cvt_pk_bf16(v0[2], v0[3]); w.z = cvt_pk_bf16(v1[0], v1[1]); w.w = cvt_pk_bf16(v1[2], v1[3]);
                    *(u32x4*)(rowp + bj * HALF) = w; } }
    }
};
struct EpiUpGate {
    static constexpr bool PERM = true, AFTER_DRAIN = false;
    const bf16_t* gate; float* macc; bf16_t* merged; int nMtot;
    __device__ __forceinline__ void operator()(const f32x4 (&acc)[2][2][4][2], const Unit& u, int wr, int wc, int fr, int fq) const {
        const int b = u.pn >> 3, pn = u.pn & 7, pm = u.pm - b * nMtot;
        const int row0 = pm * BM + wr * 64 + fr, col0 = pn * BM + wc * 32 + 8 * fq;
#pragma unroll
        for (int ai = 0; ai < 2; ++ai)
#pragma unroll
            for (int m = 0; m < 4; ++m) { const size_t r = (size_t)(row0 + ai * HALF + m * 16);
#pragma unroll
                for (int bj = 0; bj < 2; ++bj) { const int c = col0 + bj * HALF;
                    const u32x4 gw = *(const u32x4*)(gate + r * NGATE + b * 2048 + c); float g[8]; unpack8(gw, g);
                    f32x4 v0 = acc[ai][bj][m][0], v1 = acc[ai][bj][m][1];
#pragma unroll
                    for (int j = 0; j < 4; ++j) { v0[j] *= g[j]; v1[j] *= g[4 + j]; }
                    float* mp = macc + r * 2048 + c;
                    if (b > 0) { v0 += *(const f32x4*)mp; v1 += *(const f32x4*)(mp + 4); }
                    if (b < 3) { *(f32x4*)mp = v0; *(f32x4*)(mp + 4) = v1; }
                    else { u32x4 w; w.x = cvt_pk_bf16(v0[0], v0[1]); w.y = cvt_pk_bf16(v0[2], v0[3]); w.z = cvt_pk_bf16(v1[0], v1[1]); w.w = cvt_pk_bf16(v1[2], v1[3]);
                           *(u32x4*)(merged + r * 2048 + c) = w; } } }
    }
};
struct EpiResid {
    static constexpr bool PERM = false, AFTER_DRAIN = false;
    const float* srcl; float* dstl; const float* srcc; float* dstc; const float* modv;
    int permute;
    __device__ __forceinline__ void operator()(const f32x4 (&acc)[2][2][4][2], const Unit& u, int wr, int wc, int fr, int fq) const {
        const int row0 = u.pm * BM + wr * 64 + fr, col0 = u.pn * BM + wc * 32 + 4 * fq;
#pragma unroll
        for (int ai = 0; ai < 2; ++ai)
#pragma unroll
            for (int m = 0; m < 4; ++m) { const int r = row0 + ai * HALF + m * 16;
                const float* sp; float* dp; const float* mp;
                if (r < ML) { const int b = r >> 14, s = r & 16383; const int t = permute ? (((s & 255) << 6) | (s >> 8)) : s; const size_t o = ((size_t)(b << 14) + t) * D;
                    sp = srcl + o; dp = dstl + o; mp = modv + b * 12288; }
                else { const size_t o = (size_t)(r - ML) * D; sp = srcc + o; dp = dstc + o; mp = modv + 2 * 12288; }
#pragma unroll
                for (int bj = 0; bj < 2; ++bj)
#pragma unroll
                    for (int n = 0; n < 2; ++n) { const int c = col0 + bj * HALF + n * 16;
                        const f32x4 sv = *(const f32x4*)(sp + c), mv = *(const f32x4*)(mp + c);
                        *(f32x4*)(dp + c) = sv + mv * acc[ai][bj][m][n]; } }
    }
};
struct EpiSwiglu {
    static constexpr bool PERM = true, AFTER_DRAIN = false;
    bf16_t* hid; int nper;
    __device__ __forceinline__ void operator()(const f32x4 (&acc)[2][2][4][2], const Unit& u, int wr, int wc, int fr, int fq) const {
        const int pn = u.pn % nper; const int row0 = u.pm * BM + wr * 64 + fr, col0 = pn * HALF + wc * 32 + 8 * fq;
#pragma unroll
        for (int ai = 0; ai < 2; ++ai)
#pragma unroll
            for (int m = 0; m < 4; ++m) { bf16_t* rowp = hid + (size_t)(row0 + ai * HALF + m * 16) * FF + col0;
                float o[8];
#pragma unroll
                for (int n = 0; n < 2; ++n)
#pragma unroll
                    for (int j = 0; j < 4; ++j) { const float g = acc[ai][0][m][n][j], v = acc[ai][1][m][n][j]; o[n * 4 + j] = siluf(g) * v; }
                u32x4 w; w.x = cvt_pk_bf16(o[0], o[1]); w.y = cvt_pk_bf16(o[2], o[3]); w.z = cvt_pk_bf16(o[4], o[5]); w.w = cvt_pk_bf16(o[6], o[7]);
                *(u32x4*)rowp = w; }
    }
};
struct EpiPlainBf16 {
    static constexpr bool PERM = true, AFTER_DRAIN = false;
    bf16_t* O; int ldc; int nper;
    __device__ __forceinline__ void operator()(const f32x4 (&acc)[2][2][4][2], const Unit& u, int wr, int wc, int fr, int fq) const {
        const int pn = u.pn % nper; const int row0 = u.pm * BM + wr * 64 + fr, col0 = pn * BM + wc * 32 + 8 * fq;
#pragma unroll
        for (int ai = 0; ai < 2; ++ai)
#pragma unroll
            for (int m = 0; m < 4; ++m) { bf16_t* rowp = O + (size_t)(row0 + ai * HALF + m * 16) * ldc + col0;
#pragma unroll
                for (int bj = 0; bj < 2; ++bj) { const f32x4 v0 = acc[ai][bj][m][0], v1 = acc[ai][bj][m][1];
                    u32x4 w; w.x = cvt_pk_bf16(v0[0], v0[1]); w.y = cvt_pk_bf16(v0[2], v0[3]); w.z = cvt_pk_bf16(v1[0], v1[1]); w.w = cvt_pk_bf16(v1[2], v1[3]);
                    *(u32x4*)(rowp + bj * HALF) = w; } }
    }
};
struct UpGateOrder {
    StaticOrder so; int nMtot;
    __device__ void init(int M, int G, int c, int nMtot_) { so.init(M, 2048, G, c); nMtot = nMtot_; }
    __device__ bool next(int i, Unit& u) const { Unit t; if (!so.next(i >> 2, t)) return false; const int b = i & 3; u.pm = b * nMtot + t.pm; u.pn = b * 8 + t.pn; return true; }
    __device__ __forceinline__ void a_ready(const Unit&) const {}
    __device__ __forceinline__ void done(const Unit&) const {}
};
struct MoeOrder {
    StaticOrder so; int be[8]; int nper;
    __device__ void init(int nused, int nper_, int G, int c, const int* be_) { so.init(nused * BM, nper_ * BM, G, c); nper = nper_;
#pragma unroll
        for (int e = 0; e < 8; ++e) be[e] = be_[e]; }
    __device__ bool next(int i, Unit& u) const { Unit t; if (!so.next(i, t)) return false; int e = 0;
#pragma unroll
        for (int j = 0; j < 7; ++j) e += (t.pm >= be[j]) ? 1 : 0;
        u.pm = t.pm; u.pn = e * nper + t.pn; return true; }
    __device__ __forceinline__ void a_ready(const Unit&) const {}
    __device__ __forceinline__ void done(const Unit&) const {}
};
}

__device__ __forceinline__ int lds_add(volatile LAS int* p) { return __hip_atomic_fetch_add((LAS int*)p, 1, __ATOMIC_RELAXED, __HIP_MEMORY_SCOPE_WORKGROUP); }
struct Ctx { const Args* a; LAS unsigned char* lds; int tid, lane, wave, wg, G; };

__device__ __forceinline__ void conv_tile(const float* src, size_t ldsrc, int nvalid, bf16_t* dst, size_t ldd, LAS float* tile, int tid) {
    const int nn = tid & 63, kk = tid >> 6;
    float v[16];
#pragma unroll
    for (int j = 0; j < 16; ++j) v[j] = (nn < nvalid) ? src[(size_t)(kk + 8 * j) * ldsrc + nn] : 0.f;
#pragma unroll
    for (int j = 0; j < 16; ++j) tile[nn * 129 + kk + 8 * j] = v[j];
    __syncthreads();
    const int lane = tid & 63, w = tid >> 6;
#pragma unroll
    for (int p = 0; p < 8; ++p) { const int n = w + 8 * p; const float a = tile[n * 129 + 2 * lane], b = tile[n * 129 + 2 * lane + 1];
        *(unsigned*)(dst + (size_t)n * ldd + 2 * lane) = pg8::cvt_pk_bf16(a, b); }
    __syncthreads();
}
template <int KIND>
__device__ __forceinline__ void conv_job(const Ctx& c, const float* src, const float* src2, size_t ldsrc, int K, int Nd, bf16_t* dst, int& rot) {
    LAS float* tile = (LAS float*)(c.lds + LDS_SCR);
    const int nkt = K / 128, nnt = Nd / 64, ntile = nkt * nnt;
    int t0 = (c.wg - rot) % c.G; if (t0 < 0) t0 += c.G;
    for (int t = t0; t < ntile; t += c.G) {
        const int nt = t % nnt, kt = t / nnt, n0 = nt * 64, k0 = kt * 128;
        const float* s = src; int c0 = n0, nvalid = 64;
        if (KIND == 1) { if (n0 >= NMIXP) c0 = n0 - (NMIXP - NMIX); else { nvalid = NMIX - n0; nvalid = nvalid < 0 ? 0 : (nvalid > 64 ? 64 : nvalid); } }
        if (KIND == 2) { const int which = (n0 & 255) >> 7; c0 = (n0 >> 8) * 128 + (n0 & 127); s = which ? src2 : src; }
        conv_tile(s + (size_t)k0 * ldsrc + c0, ldsrc, nvalid, dst + (size_t)n0 * K + k0, (size_t)K, tile, c.tid);
    }
    rot = (rot + ntile) % c.G;
}

__device__ __forceinline__ void mod_phase(const Ctx& c) {
    const Args& a = *c.a; const int tid = c.tid;
    LAS float* s = (LAS float*)(c.lds + LDS_SCR);
    LAS float* red = s + 3 * 2048;
    for (int i = tid; i < 3 * 2048; i += 512) { const int r = i >> 11, k = i & 2047; const float cv = (r < 2) ? a.in[I_C][r * 2048 + k] : a.in[I_CCTX][k]; s[i] = siluf(cv); }
    __syncthreads();
    float* modv = (float*)(a.ws + WS_MOD);
    for (int task = c.wg; task < 192; task += c.G) {
        const int l = task / 96, cb = task % 96, cq = tid & 31, kg = tid >> 5;
        const float* w = a.in[I_WMOD] + (size_t)l * 2048 * 12288 + cb * 128 + cq * 4;
        f32x4 a0 = {0.f, 0.f, 0.f, 0.f}, a1 = a0, a2 = a0;
#pragma unroll 8
        for (int k = kg; k < 2048; k += 16) { const f32x4 wv = *(const f32x4*)(w + (size_t)k * 12288); a0 += s[k] * wv; a1 += s[2048 + k] * wv; a2 += s[4096 + k] * wv; }
#pragma unroll
        for (int j = 0; j < 4; ++j) { red[(kg * 3 + 0) * 128 + cq * 4 + j] = a0[j]; red[(kg * 3 + 1) * 128 + cq * 4 + j] = a1[j]; red[(kg * 3 + 2) * 128 + cq * 4 + j] = a2[j]; }
        __syncthreads();
        if (tid < 384) { const int r = tid >> 7, cc = tid & 127; float sum = 0.f;
#pragma unroll
            for (int g = 0; g < 16; ++g) sum += red[(g * 3 + r) * 128 + cc];
            modv[(size_t)(l * 3 + r) * 12288 + cb * 128 + cc] = sum + a.in[I_BMOD][l * 12288 + cb * 128 + cc]; }
        __syncthreads();
    }
}

__device__ __forceinline__ void modnorm_row(f32x4 (&v)[8], const float* nw, const float* shift, const float* scale, int lane) {
    float ss = 0.f;
#pragma unroll
    for (int j = 0; j < 8; ++j) ss += v[j][0] * v[j][0] + v[j][1] * v[j][1] + v[j][2] * v[j][2] + v[j][3] * v[j][3];
    ss = wave_sum(ss);
    const float rstd = rsqrtf(ss * (1.0f / 2048.0f) + EPS);
#pragma unroll
    for (int j = 0; j < 8; ++j) { const int cc = (j * 64 + lane) * 4; const f32x4 w = *(const f32x4*)(nw + cc), sh = *(const f32x4*)(shift + cc), sc = *(const f32x4*)(scale + cc);
        v[j] = (v[j] * rstd * w) * (1.0f + sc) + sh; }
}
__device__ __forceinline__ void store_row_bf16(const f32x4 (&v)[8], bf16_t* hrow, int lane) {
#pragma unroll
    for (int j = 0; j < 8; ++j) { u32x2 w; w.x = pg8::cvt_pk_bf16(v[j][0], v[j][1]); w.y = pg8::cvt_pk_bf16(v[j][2], v[j][3]); *(u32x2*)(hrow + (j * 64 + lane) * 4) = w; }
}
template <int L, int WHICH>
__device__ __forceinline__ void norm_phase(const Ctx& c) {
    const Args& a = *c.a; const int gw = c.wg * 8 + c.wave, nw = c.G * 8, lane = c.lane;
    const float* modv = (const float*)(a.ws + WS_MOD) + (size_t)L * 3 * 12288 + (WHICH ? 3 : 0) * 2048;
    const float* normw = a.in[I_NORMW] + (L * 2 + WHICH) * 2048;
    const float* xc = (const float*)(a.ws + WS_XC);
    bf16_t* H = (bf16_t*)(a.ws + WS_H);
    for (int r = gw; r < MT; r += nw) {
        const float* src; int mr; size_t hrow;
        if (r < ML) { const int b = r >> 14, t = r & 16383; src = ((L == 0 && WHICH == 0) ? a.in[I_X] : (const float*)a.out) + (size_t)r * D; mr = b;
            hrow = (L == 1 && WHICH == 0) ? (size_t)(b << 14) + ((t & 63) << 8) + (t >> 6) : (size_t)r; }
        else { const int rc = r - ML; src = ((L == 0 && WHICH == 0) ? a.in[I_CTX] : xc) + (size_t)rc * D; mr = 2; hrow = r; }
        f32x4 v[8];
#pragma unroll
        for (int j = 0; j < 8; ++j) v[j] = *(const f32x4*)(src + (j * 64 + lane) * 4);
        const float* shift = modv + (size_t)mr * 12288;
        modnorm_row(v, normw, shift, shift + 2048, lane);
        store_row_bf16(v, H + hrow * D, lane);
    }
}

template <int L>
__device__ __forceinline__ void rgprep_phase(const Ctx& c) {
    const Args& a = *c.a; const int tid = c.tid;
    LAS float* xbT = (LAS float*)(c.lds + LDS_SCR);
    const bf16_t* PM = (const bf16_t*)(a.ws + WS_PMIX);
    bf16_t* RGLA = (bf16_t*)(a.ws + WS_RGLA); bf16_t* RGU = (bf16_t*)(a.ws + WS_RGU);
    const float* cw = a.in[I_RG_CW] + L * 4 * 512; const float* cb = a.in[I_RG_CB] + L * 512;
    for (int item = c.wg; item < 520 * 4; item += c.G) {
        const int tt = item >> 2, n = item & 3;
        size_t rowbase; int t0, Ls;
        if (tt < 512) { const int b = tt >> 8; rowbase = (size_t)b * T; t0 = (tt & 255) * 64; Ls = T; }
        else { const int tc = tt - 512, b = tc >> 2; rowbase = (size_t)ML + b * CL; t0 = (tc & 3) * 64; Ls = CL; }
        __syncthreads();
        {
            const int tl = tid >> 3, cg = tid & 7, ch0 = n * 128 + cg * 16;
            float acc[16];
#pragma unroll
            for (int j = 0; j < 16; ++j) acc[j] = cb[ch0 + j];
#pragma unroll
            for (int tap = 0; tap < 4; ++tap) { const int ts = t0 + tl + tap - 2;
                if (ts >= 0 && ts < Ls) { const bf16_t* rp = PM + (rowbase + ts) * NMIXP + C_RG_X + ch0; const u32x4 w0 = *(const u32x4*)rp, w1 = *(const u32x4*)(rp + 8);
                    float f[8], g[8]; unpack8(w0, f); unpack8(w1, g);
#pragma unroll
                    for (int j = 0; j < 8; ++j) { acc[j] += cw[tap * 512 + ch0 + j] * f[j]; acc[8 + j] += cw[tap * 512 + ch0 + 8 + j] * g[j]; } } }
#pragma unroll
            for (int j = 0; j < 16; ++j) xbT[(cg * 16 + j) * 68 + tl] = acc[j];
        }
        __syncthreads();
        const int oc = tid & 127, tg = tid >> 7, ch = n * 128 + oc;
#pragma unroll 1
        for (int d = 0; d < 2; ++d) {
            const float* wr = a.in[I_RG_WR] + ((size_t)((L * 2 + d) * 4 + n) * 128) * 128 + oc;
            const float* wi = a.in[I_RG_WI] + ((size_t)((L * 2 + d) * 4 + n) * 128) * 128 + oc;
            float ar[16], ai[16];
#pragma unroll
            for (int j = 0; j < 16; ++j) { ar[j] = 0.f; ai[j] = 0.f; }
#pragma unroll 4
            for (int k = 0; k < 128; ++k) { const float w1 = wr[k * 128], w2 = wi[k * 128];
                const LAS f32x4* xp = (const LAS f32x4*)(xbT + k * 68 + tg * 16);
#pragma unroll
                for (int q = 0; q < 4; ++q) { const f32x4 xv = xp[q];
#pragma unroll
                    for (int j = 0; j < 4; ++j) { ar[q * 4 + j] += xv[j] * w1; ai[q * 4 + j] += xv[j] * w2; } } }
            const float br = a.in[I_RG_BR][(L * 2 + d) * 512 + ch], bi = a.in[I_RG_BI][(L * 2 + d) * 512 + ch];
            const float sp = softplusf(-a.in[I_RG_LAM][(L * 2 + d) * 512 + ch]);
#pragma unroll
            for (int j = 0; j < 16; ++j) { const int tl = tg * 16 + j; const float r = sigm(ar[j] + br), ig = sigm(ai[j] + bi);
                const float la = -8.0f * r * sp; const float xb = xbT[oc * 68 + tl];
                const float u = sqrtf(fmaxf(-expm1f(2.0f * la), 0.f)) * (ig * xb);
                const size_t o = ((size_t)d * MT + rowbase + t0 + tl) * 512 + ch;
                RGLA[o] = (bf16_t)(pg8::cvt_pk_bf16(la, 0.f) & 0xffffu); RGU[o] = (bf16_t)(pg8::cvt_pk_bf16(u, 0.f) & 0xffffu); }
        }
    }
}

template <int L>
__device__ __forceinline__ void chain_gla(const Ctx& c, int b, int h, int d, int vh) {
    const Args& a = *c.a; const int tid = c.tid;
    LAS float* qs = (LAS float*)(c.lds + LDS_SCR); LAS float* ks = qs + 4096; LAS float* fs = ks + 4096; LAS float* vs = fs + 4096; LAS float* os = vs + 4096;
    LAS float* wa = (LAS float*)(c.lds + LDS_AUX);
    const bf16_t* PM = (const bf16_t*)(a.ws + WS_PMIX);
    bf16_t* ORAW = (bf16_t*)(a.ws + WS_ORAW) + (size_t)d * MT * 2048;
    for (int i = tid; i < 1024; i += 512) wa[i] = a.in[I_GLA_WA2][((L * 2 + d) * 16 + (i >> 6)) * 256 + h * 64 + (i & 63)];
    if (tid < 64) wa[1024 + tid] = a.in[I_GLA_BA2][(L * 2 + d) * 256 + h * 64 + tid];
    float s[8];
#pragma unroll
    for (int j = 0; j < 8; ++j) s[j] = 0.f;
    const int vc = tid >> 3, kq = tid & 7;
#pragma unroll 1
    for (int seg = 0; seg < 2; ++seg) {
        const int Ls = seg ? T : CL; const size_t rowbase = seg ? (size_t)b * T : (size_t)ML + b * CL;
#pragma unroll 1
        for (int jb = 0; jb < Ls / 64; ++jb) {
            const int r0 = d ? Ls - 64 * (jb + 1) : 64 * jb;
            __syncthreads();
            {   const int i = tid >> 3, cg = tid & 7, lr = d ? 63 - i : i; const bf16_t* rp = PM + (rowbase + r0 + lr) * NMIXP;
                float fq[8], fk[8], fv[8], fa[16];
                { const u32x4 w = *(const u32x4*)(rp + C_GLA_Q + h * 64 + cg * 8); unpack8(w, fq); }
                { const u32x4 w = *(const u32x4*)(rp + C_GLA_K + h * 64 + cg * 8); unpack8(w, fk); }
                { const u32x4 w = *(const u32x4*)(rp + C_GLA_V + h * 128 + vh * 64 + cg * 8); unpack8(w, fv); }
                { const u32x4 w0 = *(const u32x4*)(rp + C_GLA_A + d * 16), w1 = *(const u32x4*)(rp + C_GLA_A + d * 16 + 8); float t0[8], t1[8]; unpack8(w0, t0); unpack8(w1, t1);
#pragma unroll
                  for (int j = 0; j < 8; ++j) { fa[j] = t0[j]; fa[8 + j] = t1[j]; } }
#pragma unroll
                for (int j = 0; j < 8; ++j) { const int o = i * 64 + cg * 8 + j; qs[o] = fq[j] * 0.125f; ks[o] = fk[j]; vs[o] = fv[j];
                    float z = wa[1024 + cg * 8 + j];
#pragma unroll
                    for (int r = 0; r < 16; ++r) z += fa[r] * wa[r * 64 + cg * 8 + j];
                    fs[o] = __expf(-softplusf(-z) * (1.0f / 16.0f)); }
            }
            __syncthreads();
#pragma unroll 2
            for (int i = 0; i < 64; ++i) {
                const f32x4 f0 = *(const LAS f32x4*)(fs + i * 64 + kq * 8), f1 = *(const LAS f32x4*)(fs + i * 64 + kq * 8 + 4);
                const f32x4 k0 = *(const LAS f32x4*)(ks + i * 64 + kq * 8), k1 = *(const LAS f32x4*)(ks + i * 64 + kq * 8 + 4);
                const f32x4 q0 = *(const LAS f32x4*)(qs + i * 64 + kq * 8), q1 = *(const LAS f32x4*)(qs + i * 64 + kq * 8 + 4);
                const float vv = vs[i * 64 + vc]; float po = 0.f;
#pragma unroll
                for (int j = 0; j < 4; ++j) { s[j] = f0[j] * s[j] + k0[j] * vv; s[4 + j] = f1[j] * s[4 + j] + k1[j] * vv; po += s[j] * q0[j] + s[4 + j] * q1[j]; }
                po += __shfl_xor(po, 1); po += __shfl_xor(po, 2); po += __shfl_xor(po, 4);
                if (kq == 0) os[i * 64 + vc] = po;
            }
            __syncthreads();
            {   const int i = tid >> 3, cg = tid & 7, lr = d ? 63 - i : i; float o[8];
#pragma unroll
                for (int j = 0; j < 8; ++j) o[j] = os[i * 64 + cg * 8 + j];
                *(u32x4*)(ORAW + (rowbase + r0 + lr) * 2048 + 0 * 512 + h * 128 + vh * 64 + cg * 8) = pack8(o); }
        }
    }
}
template <int L>
__device__ __forceinline__ void chain_hg(const Ctx& c, int b, int h, int d, int vh) {
    const Args& a = *c.a; const int tid = c.tid;
    LAS float* qs = (LAS float*)(c.lds + LDS_SCR); LAS float* ks = qs + 8192; LAS float* fs = ks + 8192; LAS float* vs = fs + 8192; LAS float* os = vs + 4096;
    LAS float* lbs = (LAS float*)(c.lds + LDS_AUX);
    const bf16_t* PM = (const bf16_t*)(a.ws + WS_PMIX);
    bf16_t* ORAW = (bf16_t*)(a.ws + WS_ORAW) + (size_t)d * MT * 2048;
    if (tid < 128) { float lb = 0.f; if (L == 1) { const float l0 = a.in[I_HG_LB][h * 128 + tid], l1 = a.in[I_HG_LB][512 + h * 128 + tid]; lb = 1.0f / (1.0f + expf(l0 - l1)); } lbs[tid] = lb; }
    float s[16];
#pragma unroll
    for (int j = 0; j < 16; ++j) s[j] = 0.f;
    const int vc = tid >> 3, kq = tid & 7;
#pragma unroll 1
    for (int seg = 0; seg < 2; ++seg) {
        const int Ls = seg ? T : CL; const size_t rowbase = seg ? (size_t)b * T : (size_t)ML + b * CL;
#pragma unroll 1
        for (int jb = 0; jb < Ls / 64; ++jb) {
            const int r0 = d ? Ls - 64 * (jb + 1) : 64 * jb;
            __syncthreads();
            {   const int i = tid >> 3, cg = tid & 7, lr = d ? 63 - i : i; const bf16_t* rp = PM + (rowbase + r0 + lr) * NMIXP;
#pragma unroll
                for (int hf = 0; hf < 2; ++hf) { const int ch = cg * 16 + hf * 8; float fq[8], fz[8];
                    { const u32x4 w = *(const u32x4*)(rp + C_HG_Q + h * 128 + ch); unpack8(w, fq); }
                    { const u32x4 w = *(const u32x4*)(rp + C_HG_F + d * 512 + h * 128 + ch); unpack8(w, fz); }
#pragma unroll
                    for (int j = 0; j < 8; ++j) { const int o = i * 128 + ch + j; const float lb = lbs[ch + j], sg = sigm(fz[j]);
                        qs[o] = siluf(fq[j]) * 0.08838834764831845f; fs[o] = fmaxf(lb + (1.0f - lb) * sg, 1e-30f); ks[o] = (1.0f - lb) * (1.0f - sg); } }
                float fv[8]; { const u32x4 w = *(const u32x4*)(rp + C_HG_I + h * 128 + vh * 64 + cg * 8); unpack8(w, fv); }
#pragma unroll
                for (int j = 0; j < 8; ++j) vs[i * 64 + cg * 8 + j] = fv[j];
            }
            __syncthreads();
#pragma unroll 2
            for (int i = 0; i < 64; ++i) {
                const float vv = vs[i * 64 + vc]; float po = 0.f;
#pragma unroll
                for (int q4 = 0; q4 < 4; ++q4) {
                    const f32x4 f0 = *(const LAS f32x4*)(fs + i * 128 + kq * 16 + q4 * 4), k0 = *(const LAS f32x4*)(ks + i * 128 + kq * 16 + q4 * 4), q0 = *(const LAS f32x4*)(qs + i * 128 + kq * 16 + q4 * 4);
#pragma unroll
                    for (int j = 0; j < 4; ++j) { s[q4 * 4 + j] = f0[j] * s[q4 * 4 + j] + k0[j] * vv; po += s[q4 * 4 + j] * q0[j]; } }
                po += __shfl_xor(po, 1); po += __shfl_xor(po, 2); po += __shfl_xor(po, 4);
                if (kq == 0) os[i * 64 + vc] = po;
            }
            __syncthreads();
            {   const int i = tid >> 3, cg = tid & 7, lr = d ? 63 - i : i; float o[8];
#pragma unroll
                for (int j = 0; j < 8; ++j) o[j] = os[i * 64 + cg * 8 + j];
                *(u32x4*)(ORAW + (rowbase + r0 + lr) * 2048 + 1 * 512 + h * 128 + vh * 64 + cg * 8) = pack8(o); }
        }
    }
}
template <int L>
__device__ __forceinline__ void chain_dn(const Ctx& c, int b, int h, int d, int vh) {
    const Args& a = *c.a; const int tid = c.tid;
    LAS float* qs = (LAS float*)(c.lds + LDS_SCR); LAS float* ks = qs + 8192; LAS float* vs = ks + 8192; LAS float* os = vs + 4096; LAS float* as = os + 4096; LAS float* bs = as + 64;
    LAS float* cwl = (LAS float*)(c.lds + LDS_AUX);
    const bf16_t* PM = (const bf16_t*)(a.ws + WS_PMIX);
    bf16_t* ORAW = (bf16_t*)(a.ws + WS_ORAW) + (size_t)d * MT * 2048;
    for (int i = tid; i < 4 * 320; i += 512) { const int tap = i / 320, cc = i % 320; const int ch = cc < 128 ? h * 128 + cc : (cc < 256 ? 512 + h * 128 + (cc - 128) : 1024 + h * 128 + vh * 64 + (cc - 256));
        cwl[i] = a.in[I_DN_CW][(L * 4 + tap) * 1536 + ch]; }
    const float neg_ea = -expf(a.in[I_DN_ALOG][(L * 2 + d) * 4 + h]), dtb = a.in[I_DN_DTB][(L * 2 + d) * 4 + h];
    float s[16];
#pragma unroll
    for (int j = 0; j < 16; ++j) s[j] = 0.f;
    const int vc = tid >> 3, kq = tid & 7;
#pragma unroll 1
    for (int seg = 0; seg < 2; ++seg) {
        const int Ls = seg ? T : CL; const size_t rowbase = seg ? (size_t)b * T : (size_t)ML + b * CL;
#pragma unroll 1
        for (int jb = 0; jb < Ls / 64; ++jb) {
            const int r0 = d ? Ls - 64 * (jb + 1) : 64 * jb;
            __syncthreads();
            {   const int i = tid >> 3, cg = tid & 7, lr = d ? 63 - i : i, t = r0 + lr;
                float aq[16], ak[16], av[8];
#pragma unroll
                for (int j = 0; j < 16; ++j) { aq[j] = 0.f; ak[j] = 0.f; }
#pragma unroll
                for (int j = 0; j < 8; ++j) av[j] = 0.f;
#pragma unroll
                for (int tap = 0; tap < 4; ++tap) { const int ts = t + tap - 2;
                    if (ts >= 0 && ts < Ls) { const bf16_t* rp = PM + (rowbase + ts) * NMIXP; const LAS float* w = cwl + tap * 320;
                        float f0[8], f1[8];
                        { const u32x4 w0 = *(const u32x4*)(rp + C_DN_Q + h * 128 + cg * 16), w1 = *(const u32x4*)(rp + C_DN_Q + h * 128 + cg * 16 + 8); unpack8(w0, f0); unpack8(w1, f1); }
#pragma unroll
                        for (int j = 0; j < 8; ++j) { aq[j] += w[cg * 16 + j] * f0[j]; aq[8 + j] += w[cg * 16 + 8 + j] * f1[j]; }
                        { const u32x4 w0 = *(const u32x4*)(rp + C_DN_K + h * 128 + cg * 16), w1 = *(const u32x4*)(rp + C_DN_K + h * 128 + cg * 16 + 8); unpack8(w0, f0); unpack8(w1, f1); }
#pragma unroll
                        for (int j = 0; j < 8; ++j) { ak[j] += w[128 + cg * 16 + j] * f0[j]; ak[8 + j] += w[128 + cg * 16 + 8 + j] * f1[j]; }
                        { const u32x4 w0 = *(const u32x4*)(rp + C_DN_V + h * 128 + vh * 64 + cg * 8); unpack8(w0, f0); }
#pragma unroll
                        for (int j = 0; j < 8; ++j) av[j] += w[256 + cg * 8 + j] * f0[j]; } }
#pragma unroll
                for (int j = 0; j < 16; ++j) { qs[i * 128 + cg * 16 + j] = siluf(aq[j]); ks[i * 128 + cg * 16 + j] = siluf(ak[j]); }
#pragma unroll
                for (int j = 0; j < 8; ++j) vs[i * 64 + cg * 8 + j] = siluf(av[j]);
                if (tid < 64) { const int lr2 = d ? 63 - tid : tid; const bf16_t* rp = PM + (rowbase + r0 + lr2) * NMIXP;
                    const float g = neg_ea * softplusf(bf1(rp + C_DN_A + d * 4 + h) + dtb); as[tid] = __expf(g); bs[tid] = sigm(bf1(rp + C_DN_B + d * 4 + h)); }
            }
            __syncthreads();
            {
                const int rowid = tid >> 2, part = tid & 3; LAS float* p = (rowid < 64 ? qs + rowid * 128 : ks + (rowid - 64) * 128) + part * 32; float ss = 0.f;
#pragma unroll
                for (int j = 0; j < 32; ++j) ss += p[j] * p[j];
                ss += __shfl_xor(ss, 1); ss += __shfl_xor(ss, 2);
                const float rs = rsqrtf(ss + EPS) * (rowid < 64 ? 0.08838834764831845f : 1.0f);
#pragma unroll
                for (int j = 0; j < 32; ++j) p[j] *= rs;
            }
            __syncthreads();
#pragma unroll 2
            for (int i = 0; i < 64; ++i) {
                f32x4 kk[4]; float kts = 0.f;
#pragma unroll
                for (int q4 = 0; q4 < 4; ++q4) { kk[q4] = *(const LAS f32x4*)(ks + i * 128 + kq * 16 + q4 * 4);
#pragma unroll
                    for (int j = 0; j < 4; ++j) kts += s[q4 * 4 + j] * kk[q4][j]; }
                kts += __shfl_xor(kts, 1); kts += __shfl_xor(kts, 2); kts += __shfl_xor(kts, 4);
                const float al = as[i], be = bs[i]; const float vn = be * (vs[i * 64 + vc] - al * kts); float po = 0.f;
#pragma unroll
                for (int q4 = 0; q4 < 4; ++q4) { const f32x4 q0 = *(const LAS f32x4*)(qs + i * 128 + kq * 16 + q4 * 4);
#pragma unroll
                    for (int j = 0; j < 4; ++j) { s[q4 * 4 + j] = al * s[q4 * 4 + j] + kk[q4][j] * vn; po += s[q4 * 4 + j] * q0[j]; } }
                po += __shfl_xor(po, 1); po += __shfl_xor(po, 2); po += __shfl_xor(po, 4);
                if (kq == 0) os[i * 64 + vc] = po;
            }
            __syncthreads();
            {   const int i = tid >> 3, cg = tid & 7, lr = d ? 63 - i : i; float o[8];
#pragma unroll
                for (int j = 0; j < 8; ++j) o[j] = os[i * 64 + cg * 8 + j];
                *(u32x4*)(ORAW + (rowbase + r0 + lr) * 2048 + 2 * 512 + h * 128 + vh * 64 + cg * 8) = pack8(o); }
        }
    }
}
__device__ __forceinline__ void chain_rg(const Ctx& c, int gw  ) {
    const Args& a = *c.a; const int b = gw >> 3, d = (gw >> 2) & 1, ch = (gw & 3) * 128 + c.lane * 2;
    const bf16_t* RGLA = (const bf16_t*)(a.ws + WS_RGLA) + (size_t)d * MT * 512 + ch; const bf16_t* RGU = (const bf16_t*)(a.ws + WS_RGU) + (size_t)d * MT * 512 + ch;
    bf16_t* ORAW = (bf16_t*)(a.ws + WS_ORAW) + (size_t)d * MT * 2048 + 1536 + ch;
    float h0 = 0.f, h1 = 0.f;
#pragma unroll 1
    for (int seg = 0; seg < 2; ++seg) {
        const int Ls = seg ? T : CL; const size_t rowbase = seg ? (size_t)b * T : (size_t)ML + b * CL;
#pragma unroll 1
        for (int s0 = 0; s0 < Ls; s0 += 16) {
            unsigned la[16], uu[16];
#pragma unroll
            for (int j = 0; j < 16; ++j) { const size_t row = rowbase + (d ? Ls - 1 - (s0 + j) : s0 + j); la[j] = *(const unsigned*)(RGLA + row * 512); uu[j] = *(const unsigned*)(RGU + row * 512); }
#pragma unroll
            for (int j = 0; j < 16; ++j) { const size_t row = rowbase + (d ? Ls - 1 - (s0 + j) : s0 + j);
                h0 = __expf(bflo(la[j])) * h0 + bflo(uu[j]); h1 = __expf(bfhi(la[j])) * h1 + bfhi(uu[j]);
                *(unsigned*)(ORAW + row * 2048) = pg8::cvt_pk_bf16(h0, h1); }
        }
    }
}
template <int L>
__device__ __forceinline__ void chains_phase(const Ctx& c) {
    const int w = c.wg;
    if (w < 96) { const int ty = w >> 5, r = w & 31, b = r >> 4, h = (r >> 2) & 3, d = (r >> 1) & 1, vh = r & 1;
        if (ty == 0) chain_gla<L>(c, b, h, d, vh); else if (ty == 1) chain_hg<L>(c, b, h, d, vh); else chain_dn<L>(c, b, h, d, vh); }
    else if (w < 98) chain_rg(c, (w - 96) * 8 + c.wave);
}

template <int L>
__device__ __forceinline__ void combine_phase(const Ctx& c) {
    const Args& a = *c.a; const int gw = c.wg * 8 + c.wave, nw = c.G * 8, lane = c.lane;
    const bf16_t* PM = (const bf16_t*)(a.ws + WS_PMIX); const bf16_t* O0 = (const bf16_t*)(a.ws + WS_ORAW); const bf16_t* O1 = O0 + (size_t)MT * 2048;
    bf16_t* O = (bf16_t*)(a.ws + WS_H);
    const int cb = lane * 8, hv = cb & 127;
    float nwv[3][8];
#pragma unroll
    for (int j = 0; j < 8; ++j) { nwv[0][j] = a.in[I_GLA_NW][L * 128 + hv + j]; nwv[1][j] = a.in[I_HG_NW][L * 128 + hv + j]; nwv[2][j] = a.in[I_DN_NW][L * 128 + hv + j]; }
    const int nrows = (L == 0) ? MT : ML;
    for (int r = gw; r < nrows; r += nw) {
        const bf16_t* pm = PM + (size_t)r * NMIXP;
#pragma unroll
        for (int br = 0; br < 3; ++br) {
            const int gcol = br == 0 ? C_GLA_G : (br == 1 ? C_HG_G : C_DN_G);
            float x0[8], x1[8], g[8], o[8];
            { const u32x4 w = *(const u32x4*)(O0 + (size_t)r * 2048 + br * 512 + cb); unpack8(w, x0); }
            { const u32x4 w = *(const u32x4*)(O1 + (size_t)r * 2048 + br * 512 + cb); unpack8(w, x1); }
            { const u32x4 w = *(const u32x4*)(pm + gcol + cb); unpack8(w, g); }
            float ss = 0.f;
#pragma unroll
            for (int j = 0; j < 8; ++j) { o[j] = x0[j] + x1[j]; ss += o[j] * o[j]; }
            ss += __shfl_xor(ss, 1); ss += __shfl_xor(ss, 2); ss += __shfl_xor(ss, 4); ss += __shfl_xor(ss, 8);
            const float rs = rsqrtf(ss * (1.0f / 128.0f) + EPS);
#pragma unroll
            for (int j = 0; j < 8; ++j) o[j] = o[j] * rs * nwv[br][j] * siluf(g[j]);
            *(u32x4*)(O + ((size_t)br * MT + r) * 512 + cb) = pack8(o);
        }
        {   float x0[8], x1[8], y[8], o[8];
            { const u32x4 w = *(const u32x4*)(O0 + (size_t)r * 2048 + 1536 + cb); unpack8(w, x0); }
            { const u32x4 w = *(const u32x4*)(O1 + (size_t)r * 2048 + 1536 + cb); unpack8(w, x1); }
            { const u32x4 w = *(const u32x4*)(pm + C_RG_Y + cb); unpack8(w, y); }
#pragma unroll
            for (int j = 0; j < 8; ++j) o[j] = gelu_tanh(y[j]) * (x0[j] + x1[j]);
            *(u32x4*)(O + ((size_t)3 * MT + r) * 512 + cb) = pack8(o);
        }
    }
}

__device__ __forceinline__ void route1_phase(const Ctx& c) {
    const Args& a = *c.a; const int lane = c.lane;
    const float* modv = (const float*)(a.ws + WS_MOD) + (size_t)1 * 3 * 12288 + 3 * 2048;
    const float* normw = a.in[I_NORMW] + (1 * 2 + 1) * 2048;
    const float* router = a.in[I_ROUTER];
    bf16_t* H = (bf16_t*)(a.ws + WS_H);
    unsigned* topi = (unsigned*)(a.ws + WS_TOPI); float* topw = (float*)(a.ws + WS_TOPW);
    volatile LAS int* hist = (volatile LAS int*)(c.lds + LDS_AUX);
    if (c.tid < 8) hist[c.tid] = 0;
    __syncthreads();
    const int rpw = ML / c.G;
    for (int rr = c.wave; rr < rpw; rr += 8) {
        const int r = c.wg * rpw + rr, b = r >> 14;
        const float* src = (const float*)a.out + (size_t)r * D;
        f32x4 v[8];
#pragma unroll
        for (int j = 0; j < 8; ++j) v[j] = *(const f32x4*)(src + (j * 64 + lane) * 4);
        const float* shift = modv + (size_t)b * 12288;
        modnorm_row(v, normw, shift, shift + 2048, lane);
        store_row_bf16(v, H + (size_t)r * D, lane);
        float lg[8];
#pragma unroll
        for (int e = 0; e < 8; ++e) lg[e] = 0.f;
#pragma unroll
        for (int j = 0; j < 8; ++j)
#pragma unroll
            for (int q = 0; q < 4; ++q) { const int cc = (j * 64 + lane) * 4 + q; const f32x4 r0 = *(const f32x4*)(router + cc * 8), r1 = *(const f32x4*)(router + cc * 8 + 4); const float x = v[j][q];
                lg[0] += x * r0[0]; lg[1] += x * r0[1]; lg[2] += x * r0[2]; lg[3] += x * r0[3]; lg[4] += x * r1[0]; lg[5] += x * r1[1]; lg[6] += x * r1[2]; lg[7] += x * r1[3]; }
#pragma unroll
        for (int e = 0; e < 8; ++e) lg[e] = wave_sum(lg[e]);
        int e0 = 0; float m0 = lg[0];
#pragma unroll
        for (int e = 1; e < 8; ++e) if (lg[e] > m0) { m0 = lg[e]; e0 = e; }
        int e1 = -1; float m1 = -3.0e38f;
#pragma unroll
        for (int e = 0; e < 8; ++e) if (e != e0 && lg[e] > m1) { m1 = lg[e]; e1 = e; }
        if (lane == 0) { const float ex = __expf(m1 - m0); const float w0 = 1.0f / (1.0f + ex); topi[r] = (unsigned)e0 | ((unsigned)e1 << 8); topw[2 * r] = w0; topw[2 * r + 1] = ex * w0;
            lds_add(&hist[e0]); lds_add(&hist[e1]); }
    }
    __syncthreads();
    if (c.tid < 8) ((int*)(a.ws + WS_CTL + CTL_WGH))[c.wg * 8 + c.tid] = hist[c.tid];
}
__device__ __forceinline__ void route2_phase(const Ctx& c) {
    const Args& a = *c.a; const int lane = c.lane, tid = c.tid;
    const int* wgh = (const int*)(a.ws + WS_CTL + CTL_WGH);
    volatile LAS int* tab = (volatile LAS int*)(c.lds + LDS_AUX);
    if (tid < 8) { int tot = 0, base = 0; for (int w = 0; w < c.G; ++w) { const int v = wgh[w * 8 + tid]; tot += v; if (w < c.wg) base += v; } tab[tid] = tot; tab[8 + tid] = base; tab[24 + tid] = 0; tab[32 + tid] = (tot + 255) / 256 * 256; }
    __syncthreads();
    if (tid == 0) { int acc = 0; for (int e = 0; e < 8; ++e) { tab[16 + e] = acc; acc += tab[32 + e]; }
        if (c.wg == 0) { int* meta = (int*)(a.ws + WS_CTL + CTL_META); int cum = 0; for (int e = 0; e < 8; ++e) { cum += tab[32 + e] / 256; meta[e] = cum; } meta[8] = cum; } }
    __syncthreads();
    const bf16_t* H = (const bf16_t*)(a.ws + WS_H); bf16_t* GATH = (bf16_t*)(a.ws + WS_GATH);
    const unsigned* topi = (const unsigned*)(a.ws + WS_TOPI); int* dest = (int*)(a.ws + WS_DEST);
    const int rpw = ML / c.G;
    for (int rr = c.wave; rr < rpw; rr += 8) {
        const int r = c.wg * rpw + rr; const unsigned ti = topi[r]; const int e0 = ti & 255, e1 = (ti >> 8) & 255;
        int d0 = 0, d1 = 0;
        if (lane == 0) { d0 = tab[16 + e0] + tab[8 + e0] + lds_add(&tab[24 + e0]); d1 = tab[16 + e1] + tab[8 + e1] + lds_add(&tab[24 + e1]); dest[2 * r] = d0; dest[2 * r + 1] = d1; }
        d0 = __shfl(d0, 0); d1 = __shfl(d1, 0);
        const u32x4* sp = (const u32x4*)(H + (size_t)r * D); u32x4* p0 = (u32x4*)(GATH + (size_t)d0 * D); u32x4* p1 = (u32x4*)(GATH + (size_t)d1 * D);
#pragma unroll
        for (int j = 0; j < 4; ++j) { const u32x4 w = sp[j * 64 + lane]; p0[j * 64 + lane] = w; p1[j * 64 + lane] = w; }
    }
    if (c.wg < 8) { const int e = c.wg; const int lo = tab[16 + e] + tab[e], hi = tab[16 + e] + tab[32 + e]; const u32x4 z = {0u, 0u, 0u, 0u};
        for (int r = lo + c.wave; r < hi; r += 8) { u32x4* p = (u32x4*)(GATH + (size_t)r * D);
#pragma unroll
            for (int j = 0; j < 4; ++j) p[j * 64 + lane] = z; } }
}
__device__ __forceinline__ void final_phase(const Ctx& c) {
    const Args& a = *c.a; const int gw = c.wg * 8 + c.wave, nw = c.G * 8, lane = c.lane;
    const float* modv = (const float*)(a.ws + WS_MOD) + (size_t)1 * 3 * 12288 + 5 * 2048;
    const bf16_t* Y = (const bf16_t*)(a.ws + WS_GATH); const int* dest = (const int*)(a.ws + WS_DEST); const float* topw = (const float*)(a.ws + WS_TOPW);
    const float* fw = a.in[I_FNORMW];
    for (int r = gw; r < ML; r += nw) {
        const int b = r >> 14; float* xr = a.out + (size_t)r * D; const float* mg = modv + (size_t)b * 12288;
        const int d0 = dest[2 * r], d1 = dest[2 * r + 1]; const float w0 = topw[2 * r], w1 = topw[2 * r + 1];
        const bf16_t* y0 = Y + (size_t)d0 * D; const bf16_t* y1 = Y + (size_t)d1 * D;
        f32x4 v[8]; float ss = 0.f;
#pragma unroll
        for (int j = 0; j < 8; ++j) { const int cc = (j * 64 + lane) * 4; const f32x4 x = *(const f32x4*)(xr + cc), g = *(const f32x4*)(mg + cc);
            const u32x2 a0 = *(const u32x2*)(y0 + cc), a1 = *(const u32x2*)(y1 + cc);
            f32x4 m; m[0] = w0 * bflo(a0.x) + w1 * bflo(a1.x); m[1] = w0 * bfhi(a0.x) + w1 * bfhi(a1.x); m[2] = w0 * bflo(a0.y) + w1 * bflo(a1.y); m[3] = w0 * bfhi(a0.y) + w1 * bfhi(a1.y);
            v[j] = x + g * m; ss += v[j][0] * v[j][0] + v[j][1] * v[j][1] + v[j][2] * v[j][2] + v[j][3] * v[j][3]; }
        ss = wave_sum(ss); const float rstd = rsqrtf(ss * (1.0f / 2048.0f) + EPS);
#pragma unroll
        for (int j = 0; j < 8; ++j) { const int cc = (j * 64 + lane) * 4; const f32x4 w = *(const f32x4*)(fw + cc); *(f32x4*)(xr + cc) = v[j] * rstd * w; }
    }
}

#ifndef N_LAUNCHES
#define N_LAUNCHES 1
#endif
constexpr int N_PHASES = 23;

template <int L>
__device__ __forceinline__ void gemm_proj(const Ctx& c) {
    const Args& a = *c.a;
    pg8::Gemm g{(const bf16_t*)(a.ws + WS_H), (const bf16_t*)(a.ws + WS_WIN + (size_t)L * WIN_BYTES), MT, NPROJ, D};
    pg8::StaticOrder S; S.init(MT, NPROJ, c.G, c.wg);
    pg8::EpiProj E{(bf16_t*)(a.ws + WS_PMIX), (bf16_t*)(a.ws + WS_PGATE)};
    pg8::gemm_phase<pg8::EpiProj, pg8::StaticOrder, true, true>(c.lds + LDS_SCR, g, S, E);
}
template <int L>
__device__ __forceinline__ void gemm_upgate(const Ctx& c) {
    const Args& a = *c.a; constexpr int M = (L == 0) ? MT : ML;
    pg8::Gemm g{(const bf16_t*)(a.ws + WS_H), (const bf16_t*)(a.ws + WS_WUP + (size_t)L * 8388608), M, 2048, 512};
    pg8::UpGateOrder S; S.init(M, c.G, c.wg, MT / 256);
    pg8::EpiUpGate E{(const bf16_t*)(a.ws + WS_PGATE), (float*)(a.ws + WS_MACC), (bf16_t*)(a.ws + WS_MERGED), MT / 256};
    pg8::gemm_phase<pg8::EpiUpGate, pg8::UpGateOrder, true, true>(c.lds + LDS_SCR, g, S, E);
}
template <int L>
__device__ __forceinline__ void gemm_wout(const Ctx& c) {
    const Args& a = *c.a; constexpr int M = (L == 0) ? MT : ML;
    pg8::Gemm g{(const bf16_t*)(a.ws + WS_MERGED), (const bf16_t*)(a.ws + WS_WOUT + (size_t)L * 8388608), M, D, D};
    pg8::StaticOrder S; S.init(M, D, c.G, c.wg);
    const float* modv = (const float*)(a.ws + WS_MOD) + (size_t)L * 3 * 12288 + 2 * 2048;
    pg8::EpiResid E{L == 0 ? a.in[I_X] : (const float*)a.out, a.out, L == 0 ? a.in[I_CTX] : (const float*)(a.ws + WS_XC), (float*)(a.ws + WS_XC), modv, L == 1 ? 1 : 0};
    pg8::gemm_phase<pg8::EpiResid, pg8::StaticOrder, true, true>(c.lds + LDS_SCR, g, S, E);
}
__device__ __forceinline__ void gemm_ffn13(const Ctx& c) {
    const Args& a = *c.a;
    pg8::Gemm g{(const bf16_t*)(a.ws + WS_H), (const bf16_t*)(a.ws + WS_F13), MT, 2 * FF, D};
    pg8::StaticOrder S; S.init(MT, 2 * FF, c.G, c.wg);
    pg8::EpiSwiglu E{(bf16_t*)(a.ws + WS_HID), 2 * FF / 256};
    pg8::gemm_phase<pg8::EpiSwiglu, pg8::StaticOrder, true, true>(c.lds + LDS_SCR, g, S, E);
}
__device__ __forceinline__ void gemm_ffn2(const Ctx& c) {
    const Args& a = *c.a;
    pg8::Gemm g{(const bf16_t*)(a.ws + WS_HID), (const bf16_t*)(a.ws + WS_F2), MT, D, FF};
    pg8::StaticOrder S; S.init(MT, D, c.G, c.wg);
    const float* modv = (const float*)(a.ws + WS_MOD) + (size_t)0 * 3 * 12288 + 5 * 2048;
    pg8::EpiResid E{(const float*)a.out, a.out, (const float*)(a.ws + WS_XC), (float*)(a.ws + WS_XC), modv, 0};
    pg8::gemm_phase<pg8::EpiResid, pg8::StaticOrder, true, true>(c.lds + LDS_SCR, g, S, E);
}
__device__ __forceinline__ void gemm_moe13(const Ctx& c) {
    const Args& a = *c.a; const int* meta = (const int*)(a.ws + WS_CTL + CTL_META);
    int be[8];
#pragma unroll
    for (int e = 0; e < 8; ++e) be[e] = __builtin_amdgcn_readfirstlane(meta[e]);
    pg8::Gemm g{(const bf16_t*)(a.ws + WS_GATH), (const bf16_t*)(a.ws + WS_M13), MOE_ROWS, 2 * FF, D};
    pg8::MoeOrder S; S.init(be[7], 2 * FF / 256, c.G, c.wg, be);
    pg8::EpiSwiglu E{(bf16_t*)(a.ws + WS_HIDM), 2 * FF / 256};
    pg8::gemm_phase<pg8::EpiSwiglu, pg8::MoeOrder, true, true>(c.lds + LDS_SCR, g, S, E);
}
__device__ __forceinline__ void gemm_moe2(const Ctx& c) {
    const Args& a = *c.a; const int* meta = (const int*)(a.ws + WS_CTL + CTL_META);
    int be[8];
#pragma unroll
    for (int e = 0; e < 8; ++e) be[e] = __builtin_amdgcn_readfirstlane(meta[e]);
    pg8::Gemm g{(const bf16_t*)(a.ws + WS_HIDM), (const bf16_t*)(a.ws + WS_M2), MOE_ROWS, D, FF};
    pg8::MoeOrder S; S.init(be[7], D / 256, c.G, c.wg, be);
    pg8::EpiPlainBf16 E{(bf16_t*)(a.ws + WS_GATH), D, D / 256};
    pg8::gemm_phase<pg8::EpiPlainBf16, pg8::MoeOrder, true, true>(c.lds + LDS_SCR, g, S, E);
}

__device__ __forceinline__ void prologue_phase(const Ctx& c) {
    const Args& a = *c.a; int rot = 0;
    mod_phase(c);
    for (int l = 0; l < 2; ++l) {
        conv_job<1>(c, a.in[I_WIN] + (size_t)l * D * DIN, nullptr, DIN, D, NPROJ, (bf16_t*)(a.ws + WS_WIN + (size_t)l * WIN_BYTES), rot);
        for (int b = 0; b < 4; ++b) conv_job<0>(c, a.in[I_WUP] + (size_t)(l * 4 + b) * 512 * D, nullptr, D, 512, D, (bf16_t*)(a.ws + WS_WUP + (size_t)l * 8388608 + (size_t)b * 2048 * 512 * 2), rot);
        conv_job<0>(c, a.in[I_WOUT] + (size_t)l * D * D, nullptr, D, D, D, (bf16_t*)(a.ws + WS_WOUT + (size_t)l * 8388608), rot);
    }
    conv_job<2>(c, a.in[I_F1], a.in[I_F3], FF, D, 2 * FF, (bf16_t*)(a.ws + WS_F13), rot);
    conv_job<0>(c, a.in[I_F2], nullptr, D, FF, D, (bf16_t*)(a.ws + WS_F2), rot);
}
__device__ __forceinline__ void moeconv_phase(const Ctx& c) {
    const Args& a = *c.a; int rot = 0;
    for (int e = 0; e < 8; ++e) {
        conv_job<2>(c, a.in[I_M1] + (size_t)e * D * FF, a.in[I_M3] + (size_t)e * D * FF, FF, D, 2 * FF, (bf16_t*)(a.ws + WS_M13 + (size_t)e * 46137344), rot);
        conv_job<0>(c, a.in[I_M2] + (size_t)e * FF * D, nullptr, D, FF, D, (bf16_t*)(a.ws + WS_M2 + (size_t)e * 23068672), rot);
    }
}

__global__ void __launch_bounds__(512, 2) fwd_kernel(Args args) {
    extern __shared__ __attribute__((aligned(16))) unsigned char lds_raw[];
    Ctx c; c.a = &args; c.lds = (LAS unsigned char*)lds_raw; c.tid = threadIdx.x; c.lane = c.tid & 63; c.wave = __builtin_amdgcn_readfirstlane(c.tid >> 6); c.wg = blockIdx.x; c.G = gridDim.x;
    volatile LAS unsigned* misc = (volatile LAS unsigned*)(c.lds + LDS_MISC);
    if (c.tid < 16) misc[c.tid] = 0u;
    __syncthreads();
    const int lo = args.ph_lo, hi = args.ph_hi;
    XcdBarrier bar; bar.bar = (unsigned*)(args.ws + WS_CTL + CTL_BAR); bar.x = 0; bar.st = misc;
    if (hi - lo > 1) bar = xcd_barrier_post((unsigned*)(args.ws + WS_CTL + CTL_BAR), misc);
#define IN(k) (lo <= (k) && (k) < hi)
#define SEAM(k) do { if (IN(k) && IN((k) + 1)) xcd_barrier(bar); } while (0)
    if (IN(0)) { prologue_phase(c); } SEAM(0);
    if (IN(1)) { norm_phase<0, 0>(c); } SEAM(1);
    if (IN(2)) { gemm_proj<0>(c); } SEAM(2);
    if (IN(3)) { rgprep_phase<0>(c); } SEAM(3);
    if (IN(4)) { chains_phase<0>(c); } SEAM(4);
    if (IN(5)) { combine_phase<0>(c); } SEAM(5);
    if (IN(6)) { gemm_upgate<0>(c); } SEAM(6);
    if (IN(7)) { gemm_wout<0>(c); } SEAM(7);
    if (IN(8)) { norm_phase<0, 1>(c); } SEAM(8);
    if (IN(9)) { gemm_ffn13(c); } SEAM(9);
    if (IN(10)) { gemm_ffn2(c); } SEAM(10);
    if (IN(11)) { norm_phase<1, 0>(c); } SEAM(11);
    if (IN(12)) { gemm_proj<1>(c); } SEAM(12);
    if (IN(13)) { rgprep_phase<1>(c); } SEAM(13);
    if (IN(14)) { chains_phase<1>(c); } SEAM(14);
    if (IN(15)) { combine_phase<1>(c); } SEAM(15);
    if (IN(16)) { gemm_upgate<1>(c); } SEAM(16);
    if (IN(17)) { gemm_wout<1>(c); } SEAM(17);
    if (IN(18)) { route1_phase(c); __syncthreads(); moeconv_phase(c); } SEAM(18);
    if (IN(19)) { route2_phase(c); } SEAM(19);
    if (IN(20)) { gemm_moe13(c); } SEAM(20);
    if (IN(21)) { gemm_moe2(c); } SEAM(21);
    if (IN(22)) { final_phase(c); }
#undef IN
#undef SEAM
}

extern "C" void kernel_launch(void* const* d_in, const int* in_sizes, int n_in, void* d_out, int out_size, void* d_ws, size_t ws_size, hipStream_t stream) {
    static int grid = 0;
    if (grid == 0) {
        if (n_in != N_IN || out_size != ML * D || ws_size < WS_END) { fprintf(stderr, "kernel_launch: unexpected shapes: n_in %d out %d ws %zu (need %zu)\n", n_in, out_size, ws_size, (size_t)WS_END); grid = -1; return; }
        int dev = 0, cus = 0;
        if (hipGetDevice(&dev) != hipSuccess || hipDeviceGetAttribute(&cus, hipDeviceAttributeMultiprocessorCount, dev) != hipSuccess) { grid = -1; return; }
        if (hipFuncSetAttribute((const void*)fwd_kernel, hipFuncAttributeMaxDynamicSharedMemorySize, LDS_BYTES) != hipSuccess) { fprintf(stderr, "kernel_launch: hipFuncSetAttribute failed\n"); grid = -1; return; }
        int per_cu = 0;
        if (hipOccupancyMaxActiveBlocksPerMultiprocessor(&per_cu, (const void*)fwd_kernel, 512, LDS_BYTES) != hipSuccess || per_cu < 1) { fprintf(stderr, "kernel_launch: occupancy query says %d\n", per_cu); }
        (void)hipGetLastError();
        grid = cus > 256 ? 256 : cus;
    }
    if (grid < 0) return;
    (void)hipMemsetAsync((char*)d_ws + WS_CTL, 0, CTL_BYTES, stream);
    Args a{};
    for (int i = 0; i < N_IN; ++i) a.in[i] = (const float*)d_in[i];
    a.out = (float*)d_out; a.ws = (unsigned char*)d_ws;
#if N_LAUNCHES == 1
    a.ph_lo = 0; a.ph_hi = N_PHASES;
    hipLaunchKernelGGL(fwd_kernel, dim3(grid), dim3(512), LDS_BYTES, stream, a);
#else
    for (int p = 0; p < N_PHASES; ++p) { a.ph_lo = p; a.ph_hi = p + 1; hipLaunchKernelGGL(fwd_kernel, dim3(grid), dim3(512), LDS_BYTES, stream, a); }
#endif
}
```

```cpp
#include <hip/hip_runtime.h>
#include <cstdio>
#include <cstdint>
#define N_LAUNCHES 1
namespace pg8 {
#define PG8_LAS __attribute__((address_space(3)))
typedef unsigned short bf16_t;
typedef short bf16x8 __attribute__((ext_vector_type(8)));
typedef float f32x4 __attribute__((ext_vector_type(4)));
typedef unsigned u32x4 __attribute__((ext_vector_type(4)));
constexpr int BM = 256, BK = 64, HALF = 128, HTB = HALF * BK * 2  , STAGE_BYTES = 8 * HTB, NXCD = 8, WGM = 8;

__host__ __device__ __forceinline__ int lds_byte(int r, int c) { const int st = (r >> 4) * 2 + (c >> 5), rr = r & 15, cc = c & 31, ob = rr * 64 + cc * 2; return st * 1024 + (ob ^ (((ob >> 9) & 1) << 5)); }
__host__ __device__ __forceinline__ void stage_rc(int b, int& R, int& C) { const int st = b / 1024, sb = b % 1024, swz = sb ^ (((sb >> 9) & 1) << 5); R = (st >> 1) * 16 + swz / 64; C = (st & 1) * 32 + (swz % 64) / 2; }
__host__ __device__ __forceinline__ int perm32(int rho) { const int n = rho >> 4, i = rho & 15; return 8 * (i >> 2) + 4 * n + (i & 3); }

struct Unit { int pm, pn; };
struct Gemm { const bf16_t* A; const bf16_t* Bt; int M, N, K; };

struct StaticOrder {
    int nM, nN, nwg, G, c;
    __host__ __device__ void init(int M, int N, int G_, int c_) { nM = M / BM; nN = N / BM; nwg = nM * nN; G = G_; c = c_; }
    __host__ __device__ bool next(int i, Unit& u) const {
        const long L = (long)i * G + c; if (L >= nwg) return false;
        int wgid = (int)L; { const int q = nwg / NXCD, r = nwg % NXCD, xcd = wgid % NXCD, off = wgid / NXCD; wgid = (xcd < r ? xcd * (q + 1) : r * (q + 1) + (xcd - r) * q) + off; }
        const int nig = WGM * nN, gid = wgid / nig, fm = gid * WGM, gsz = (nM - fm) < WGM ? (nM - fm) : WGM;
        u.pm = fm + ((wgid % nig) % gsz); u.pn = (wgid % nig) / gsz; return true;
    }
    __device__ __forceinline__ void a_ready(const Unit&) const {}
    __device__ __forceinline__ void done(const Unit&) const {}
};
__device__ __forceinline__ unsigned cvt_pk_bf16(float lo, float hi) { unsigned r; asm volatile("v_cvt_pk_bf16_f32 %0, %1, %2" : "=v"(r) : "v"(lo), "v"(hi)); return r; }
template <class Epi, class Sched, bool ALIGN_EPI = false, bool SP2 = false>
__device__ __forceinline__ void gemm_phase(PG8_LAS unsigned char* lds, const Gemm g, const Sched& S, const Epi& E) {
    const int tid = threadIdx.x, wid = __builtin_amdgcn_readfirstlane(tid >> 6), lane = tid & 63, wr = wid >> 2, wc = wid & 3, fr = lane & 15, fq = lane >> 4;
    const int K = g.K, nt = K / BK;
    unsigned voffA[2], voffB[2];
#pragma unroll
    for (int i = 0; i < 2; ++i) { int R, C; stage_rc(tid * 16 + i * 8192, R, C); const int Rb = Epi::PERM ? ((R & ~31) + perm32(R & 31)) : R;
        voffA[i] = (unsigned)(R * K + C) * 2u; voffB[i] = (unsigned)(Rb * K + C) * 2u; }
    const size_t kstep = (size_t)(BK * 2);
    const size_t hstep = (size_t)HALF * K * 2;
    const size_t tstep = 2 * hstep;
    const unsigned ldsw = (unsigned)wid * 1024u;
    const int aoff = lds_byte(wr * 64 + fr, fq * 8), boff = lds_byte(wc * 32 + fr, fq * 8);
#define PG8_SA(b, h) (((b) * 2 + (h)) * HTB)
#define PG8_SB(b, h) ((4 + (b) * 2 + (h)) * HTB)
#define PG8_STAGE(bufoff, gbase, voff) do { _Pragma("unroll") for (int _i = 0; _i < 2; ++_i) \
        __builtin_amdgcn_global_load_lds((const unsigned*)((const char*)(gbase) + (voff)[_i]), (PG8_LAS unsigned*)(lds + (bufoff) + ldsw + _i * 8192), 16, 0, 0); } while (0)
#define PG8_LDA(dst, b, h) do { _Pragma("unroll") for (int m = 0; m < 4; ++m) _Pragma("unroll") for (int k = 0; k < 2; ++k) dst[m][k] = *(const PG8_LAS bf16x8*)(lds + PG8_SA(b, h) + aoff + m * 2048 + k * 1024); } while (0)
#define PG8_LDB(dst, b, h) do { _Pragma("unroll") for (int n = 0; n < 2; ++n) _Pragma("unroll") for (int k = 0; k < 2; ++k) dst[n][k] = *(const PG8_LAS bf16x8*)(lds + PG8_SB(b, h) + boff + n * 2048 + k * 1024); } while (0)
#define PG8_MMA(ai, bj, At, Bt) do { __builtin_amdgcn_s_setprio(1); _Pragma("unroll") for (int m = 0; m < 4; ++m) _Pragma("unroll") for (int n = 0; n < 2; ++n) _Pragma("unroll") for (int k = 0; k < 2; ++k) \
        acc[ai][bj][m][n] = __builtin_amdgcn_mfma_f32_16x16x32_bf16(Bt[n][k], At[m][k], acc[ai][bj][m][n], 0, 0, 0); __builtin_amdgcn_s_setprio(0); } while (0)
#define PG8_WAIT_V(n) asm volatile("s_waitcnt vmcnt(" #n ")" ::: "memory")
#define PG8_WAIT_L(n) asm volatile("s_waitcnt lgkmcnt(" #n ")" ::: "memory")
#define PG8_BAR __builtin_amdgcn_s_barrier()
#define PG8_SCHED __builtin_amdgcn_sched_barrier(0)
    Unit cur, nxt; int ui = 0;
    if (!S.next(0, cur)) return;
    f32x4 acc[2][2][4][2];
#pragma unroll
    for (int a = 0; a < 2; ++a)
#pragma unroll
        for (int b = 0; b < 2; ++b)
#pragma unroll
            for (int m = 0; m < 4; ++m)
#pragma unroll
                for (int n = 0; n < 2; ++n) acc[a][b][m][n] = (f32x4){0.f, 0.f, 0.f, 0.f};
    bf16x8 At[4][2], B0[2][2], B1[2][2];
    const char* cA = (const char*)g.A + (size_t)cur.pm * tstep; const char* cB = (const char*)g.Bt + (size_t)cur.pn * tstep;
    S.a_ready(cur);
    if constexpr (SP2) {
        PG8_STAGE(PG8_SB(0, 0), cB, voffB); PG8_STAGE(PG8_SB(0, 1), cB + hstep, voffB); PG8_STAGE(PG8_SA(0, 0), cA, voffA); PG8_STAGE(PG8_SA(0, 1), cA + hstep, voffA);
        if (wr == 1) PG8_BAR;
        PG8_WAIT_V(2); PG8_BAR;
        PG8_STAGE(PG8_SB(1, 0), cB + kstep, voffB); PG8_STAGE(PG8_SA(1, 0), cA + kstep, voffA); PG8_STAGE(PG8_SB(1, 1), cB + hstep + kstep, voffB);
        PG8_WAIT_V(6); PG8_BAR;
    } else {
        PG8_STAGE(PG8_SB(0, 0), cB, voffB); PG8_STAGE(PG8_SA(0, 0), cA, voffA); PG8_STAGE(PG8_SB(0, 1), cB + hstep, voffB); PG8_STAGE(PG8_SA(0, 1), cA + hstep, voffA);
        if (wr == 1) PG8_BAR;
        PG8_WAIT_V(4); PG8_BAR;
        PG8_STAGE(PG8_SB(1, 0), cB + kstep, voffB); PG8_STAGE(PG8_SA(1, 0), cA + kstep, voffA); PG8_STAGE(PG8_SB(1, 1), cB + hstep + kstep, voffB);
        PG8_WAIT_V(6); PG8_BAR;
    }
    for (;;) {
        const bool has_next = S.next(ui + 1, nxt);
        const char* nA = has_next ? (const char*)g.A + (size_t)nxt.pm * tstep : cA; const char* nB = has_next ? (const char*)g.Bt + (size_t)nxt.pn * tstep : cB;
        for (int t = 0; t < nt; t += 2) {
            const bool last = (t == nt - 2);
            const char* a1 = cA + (size_t)(t + 1) * kstep;
            const char* a2 = last ? nA : cA + (size_t)(t + 2) * kstep; const char* b2 = last ? nB : cB + (size_t)(t + 2) * kstep;
            const char* a3 = a2 + kstep; const char* b3 = b2 + kstep;
            if (last && has_next) S.a_ready(nxt);
            if constexpr (SP2) {
            PG8_LDB(B0, 0, 0); PG8_LDB(B1, 0, 1); PG8_SCHED; PG8_LDA(At, 0, 0); PG8_STAGE(PG8_SA(1, 1), a1 + hstep, voffA);
            PG8_WAIT_V(8); PG8_WAIT_L(0); PG8_BAR; PG8_MMA(0, 0, At, B0); PG8_MMA(0, 1, At, B1); PG8_BAR; PG8_SCHED;
            PG8_LDA(At, 0, 1); PG8_STAGE(PG8_SB(0, 0), b2, voffB); PG8_STAGE(PG8_SB(0, 1), b2 + hstep, voffB); PG8_STAGE(PG8_SA(0, 0), a2, voffA);
            PG8_WAIT_V(8); PG8_WAIT_L(0); PG8_BAR; PG8_MMA(1, 0, At, B0); PG8_MMA(1, 1, At, B1); PG8_BAR; PG8_SCHED;
            PG8_LDB(B0, 1, 0); PG8_LDB(B1, 1, 1); PG8_SCHED; PG8_LDA(At, 1, 0); PG8_STAGE(PG8_SA(0, 1), a2 + hstep, voffA);
            PG8_WAIT_V(8); PG8_WAIT_L(0); PG8_BAR; PG8_MMA(0, 0, At, B0); PG8_MMA(0, 1, At, B1); PG8_BAR; PG8_SCHED;
            PG8_LDA(At, 1, 1); PG8_STAGE(PG8_SB(1, 0), b3, voffB); PG8_STAGE(PG8_SB(1, 1), b3 + hstep, voffB); PG8_STAGE(PG8_SA(1, 0), a3, voffA);
            PG8_WAIT_V(8); PG8_WAIT_L(0); PG8_BAR; PG8_MMA(1, 0, At, B0); PG8_MMA(1, 1, At, B1); PG8_BAR; PG8_SCHED;
            } else {
            PG8_LDB(B0, 0, 0); PG8_SCHED; PG8_LDA(At, 0, 0); PG8_STAGE(PG8_SA(1, 1), a1 + hstep, voffA);
            PG8_WAIT_L(8); PG8_BAR; PG8_WAIT_L(0); PG8_MMA(0, 0, At, B0); PG8_BAR; PG8_SCHED;
            PG8_LDB(B1, 0, 1); PG8_STAGE(PG8_SB(0, 0), b2, voffB);
            PG8_BAR; PG8_WAIT_L(0); PG8_MMA(0, 1, At, B1); PG8_BAR;
            PG8_LDA(At, 0, 1); PG8_STAGE(PG8_SA(0, 0), a2, voffA);
            PG8_BAR; PG8_WAIT_L(0); PG8_MMA(1, 0, At, B0); PG8_BAR; PG8_SCHED;
            PG8_STAGE(PG8_SB(0, 1), b2 + hstep, voffB);
            PG8_WAIT_V(6); PG8_BAR; PG8_MMA(1, 1, At, B1); PG8_BAR;
            PG8_LDB(B0, 1, 0); PG8_SCHED; PG8_LDA(At, 1, 0); PG8_STAGE(PG8_SA(0, 1), a2 + hstep, voffA);
            PG8_WAIT_L(8); PG8_BAR; PG8_WAIT_L(0); PG8_MMA(0, 0, At, B0); PG8_BAR; PG8_SCHED;
            PG8_LDB(B1, 1, 1); PG8_STAGE(PG8_SB(1, 0), b3, voffB);
            PG8_BAR; PG8_WAIT_L(0); PG8_MMA(0, 1, At, B1); PG8_BAR;
            PG8_LDA(At, 1, 1); PG8_STAGE(PG8_SA(1, 0), a3, voffA);
            PG8_BAR; PG8_WAIT_L(0); PG8_MMA(1, 0, At, B0); PG8_BAR; PG8_SCHED;
            PG8_STAGE(PG8_SB(1, 1), b3 + hstep, voffB);
            PG8_WAIT_V(6); PG8_BAR; PG8_MMA(1, 1, At, B1); PG8_BAR;
            }
        }
        if constexpr (ALIGN_EPI) { if (wr == 0) PG8_BAR; }
        if constexpr (!Epi::AFTER_DRAIN) { E(acc, cur, wr, wc, fr, fq); S.done(cur); }
        if (!has_next) break;
#pragma unroll
        for (int a = 0; a < 2; ++a)
#pragma unroll
            for (int b = 0; b < 2; ++b)
#pragma unroll
                for (int m = 0; m < 4; ++m)
#pragma unroll
                    for (int n = 0; n < 2; ++n) acc[a][b][m][n] = (f32x4){0.f, 0.f, 0.f, 0.f};
        cur = nxt; cA = nA; cB = nB; ++ui;
        if constexpr (ALIGN_EPI) { if (wr == 1) PG8_BAR; }
    }
    PG8_WAIT_V(0);
    if constexpr (!ALIGN_EPI) { if (wr == 0) PG8_BAR; }
    PG8_BAR;
    if constexpr (Epi::AFTER_DRAIN) { E.fused(acc, cur, wr, wc, fr, fq, lds, wid, lane); S.done(cur); }
#undef PG8_SA
#undef PG8_SB
#undef PG8_STAGE
#undef PG8_LDA
#undef PG8_LDB
#undef PG8_MMA
#undef PG8_WAIT_V
#undef PG8_WAIT_L
#undef PG8_BAR
#undef PG8_SCHED
}
}
#define XB_TMO      128
#define XB_XCNT(j)  (256  + 64 * (j))
#define XB_XSUB(j)  (1280 + 64 * (j))
#define XB_XGEN(j)  (2304 + 64 * (j))
#define XB_TOP      3328
#define XB_TOPGEN   3392
#define XCD_BAR_WORDS 3456
#define XB_SPIN_CAP (1u << 18)
#define LAS __attribute__((address_space(3)))

__device__ __forceinline__ unsigned xb_ld(unsigned* p)              { return __hip_atomic_load(p, __ATOMIC_RELAXED, __HIP_MEMORY_SCOPE_AGENT); }
__device__ __forceinline__ unsigned xb_add(unsigned* p, unsigned v) { return __hip_atomic_fetch_add(p, v, __ATOMIC_RELAXED, __HIP_MEMORY_SCOPE_AGENT); }
__device__ __forceinline__ unsigned xb_xcc_id() { return (unsigned)__builtin_amdgcn_s_getreg((3 << 11) | 20) & 0xFu; }
#define XB_SPIN(cond, bar) do { unsigned _sp = 0; while (cond) { __builtin_amdgcn_s_sleep(1); \
    if ((++_sp & 255u) == 0u) { if (xb_ld(&(bar)[XB_TMO])) break; if (_sp > XB_SPIN_CAP) { atomicAdd(&(bar)[XB_TMO], 1u); break; } } } } while (0)

struct XcdBarrier {
    unsigned* bar; unsigned x;
    volatile LAS unsigned* st;
};

__device__ __forceinline__ XcdBarrier xcd_barrier_post(unsigned* bar, volatile LAS unsigned* st) {
    XcdBarrier b; b.bar = bar; b.x = xb_xcc_id(); b.st = st;
    if (threadIdx.x == 0) (void)xb_add(&bar[XB_XCNT(b.x)], 1u);
    return b;
}
__device__ __forceinline__ void xcd_barrier_complete(unsigned* bar, unsigned x, unsigned& nloc, unsigned& nx) {
    const unsigned G = gridDim.x * gridDim.y * gridDim.z;
    unsigned sum, cnt, mine, sp = 0u;
    for (;;) {
        sum = 0u; cnt = 0u; mine = 0u;
#pragma unroll
        for (unsigned j = 0; j < 16; ++j) { const unsigned c = xb_ld(&bar[XB_XCNT(j)]); sum += c; cnt += (c > 0u) ? 1u : 0u; mine = (j == x) ? c : mine; }
        if (sum == G) break;
        __builtin_amdgcn_s_sleep(1);
        if ((++sp & 255u) == 0u) { if (xb_ld(&bar[XB_TMO])) break; if (sp > XB_SPIN_CAP) { atomicAdd(&bar[XB_TMO], 1u); break; } }
    }
    nloc = mine > 0u ? mine : 1u; nx = cnt > 0u ? cnt : 1u;
}

__device__ __forceinline__ void xcd_barrier(const XcdBarrier& b) {
    asm volatile("s_waitcnt vmcnt(0)" ::: "memory");
    __syncthreads();
    if (threadIdx.x == 0) {
        unsigned* bar = b.bar;
        __builtin_amdgcn_s_waitcnt(0);
        unsigned nloc = b.st[0], nx = b.st[1];
        if (nloc == 0u) { xcd_barrier_complete(bar, b.x, nloc, nx); b.st[0] = nloc; b.st[1] = nx; }
        const unsigned old = xb_add(&bar[XB_XSUB(b.x)], 1u);
        const unsigned gen = old / nloc;
        if (old + 1u == (gen + 1u) * nloc) {
            __builtin_amdgcn_fence(__ATOMIC_RELEASE, "agent");
            asm volatile("s_waitcnt vmcnt(0)" ::: "memory");
            const unsigned og = xb_add(&bar[XB_TOP], 1u);
            const unsigned tg = og / nx;
            if (og + 1u == (tg + 1u) * nx) xb_add(&bar[XB_TOPGEN], 1u);
            else XB_SPIN(xb_ld(&bar[XB_TOPGEN]) == tg, bar);
            __builtin_amdgcn_fence(__ATOMIC_ACQUIRE, "agent");
            xb_add(&bar[XB_XGEN(b.x)], 1u);
            asm volatile("s_waitcnt vmcnt(0)" ::: "memory");
        } else {
            XB_SPIN(xb_ld(&bar[XB_XGEN(b.x)]) == gen, bar);
            __builtin_amdgcn_fence(__ATOMIC_ACQUIRE, "agent");
            asm volatile("s_waitcnt vmcnt(0)" ::: "memory");
        }
    }
    __syncthreads();
}


typedef pg8::bf16_t bf16_t;
typedef pg8::f32x4 f32x4;
typedef pg8::u32x4 u32x4;
typedef unsigned u32x2 __attribute__((ext_vector_type(2)));

constexpr int D = 2048, NB = 2, T = 16384, CL = 256;
constexpr int ML = NB * T;
constexpr int MC = NB * CL;
constexpr int MT = ML + MC;
constexpr int NMIX = 7216, NMIXP = 7424, NGATE = 8192, NPROJ = NMIXP + NGATE;
constexpr int DIN = 15408;
constexpr int FF = 5632, NE = 8;
constexpr int MOE_ROWS = 67584;
constexpr int C_GLA_Q = 0, C_GLA_K = 256, C_GLA_V = 512, C_GLA_G = 1024, C_GLA_A = 1536;
constexpr int C_HG_Q = 1568, C_HG_F = 2080, C_HG_I = 3104, C_HG_G = 3616;
constexpr int C_DN_Q = 4128, C_DN_K = 4640, C_DN_V = 5152, C_DN_A = 5664, C_DN_B = 5672, C_DN_G = 5680;
constexpr int C_RG_X = 6192, C_RG_Y = 6704;
constexpr float EPS = 1e-6f;

enum { I_X = 0, I_C, I_CTX, I_CCTX, I_WMOD, I_BMOD, I_NORMW, I_FNORMW, I_WIN, I_WUP, I_WOUT, I_GLA_WA2, I_GLA_BA2, I_GLA_NW, I_HG_LB, I_HG_NW,
       I_DN_CW, I_DN_ALOG, I_DN_DTB, I_DN_NW, I_RG_CW, I_RG_CB, I_RG_WR, I_RG_BR, I_RG_WI, I_RG_BI, I_RG_LAM, I_F1, I_F3, I_F2, I_ROUTER, I_M1, I_M3, I_M2, N_IN };

constexpr size_t WS_CTL = 0, CTL_BYTES = 65536;
constexpr size_t CTL_BAR = 0, CTL_WGH = 16384, CTL_META = 24576;
constexpr size_t WS_MOD = WS_CTL + CTL_BYTES;
constexpr size_t WS_XC = WS_MOD + 294912;
constexpr size_t WS_TOPI = WS_XC + 4194304;
constexpr size_t WS_TOPW = WS_TOPI + 131072;
constexpr size_t WS_DEST = WS_TOPW + 262144;
constexpr size_t WIN_BYTES = (size_t)NPROJ * D * 2;
constexpr size_t WS_WIN = WS_DEST + 262144;
constexpr size_t WS_WUP = WS_WIN + 2 * WIN_BYTES;
constexpr size_t WS_WOUT = WS_WUP + 2 * 8388608;
constexpr size_t WS_F13 = WS_WOUT + 2 * 8388608;
constexpr size_t WS_F2 = WS_F13 + 46137344;
constexpr size_t WS_H = WS_F2 + 23068672;
constexpr size_t WS_BIG = WS_H + 136314880;
constexpr size_t WS_PGATE = WS_BIG;
constexpr size_t WS_PMIX = WS_PGATE + 545259520;
constexpr size_t WS_ORAW = WS_PMIX + 494141440;
constexpr size_t WS_RGLA = WS_ORAW + 272629760;
constexpr size_t WS_RGU = WS_RGLA + 68157440;
constexpr size_t WS_MACC = WS_PMIX;
constexpr size_t WS_MERGED = WS_PMIX + 272629760;
constexpr size_t WS_HID = WS_BIG;
constexpr size_t WS_M13 = WS_BIG;
constexpr size_t WS_M2 = WS_M13 + 369098752;
constexpr size_t WS_GATH = WS_M2 + 184549376;
constexpr size_t WS_HIDM = WS_GATH + 276824064;
constexpr size_t WS_END = WS_HIDM + 761266176;
static_assert(WS_MERGED + 136314880 <= WS_PMIX + 494141440, "merged fits in pmix region");
static_assert(WS_RGU + 68157440 <= WS_END, "mixer stage fits");

constexpr int LDS_SCR = 0;
constexpr int LDS_AUX = 131072;
constexpr int LDS_MISC = 131072 + 8192;
constexpr int LDS_BYTES = 147456;

struct Args { const float* in[N_IN]; float* out; unsigned char* ws; int ph_lo, ph_hi; };

__device__ __forceinline__ float bflo(unsigned w) { return __uint_as_float(w << 16); }
__device__ __forceinline__ float bfhi(unsigned w) { return __uint_as_float(w & 0xffff0000u); }
__device__ __forceinline__ void unpack8(const u32x4 w, float (&f)[8]) { f[0] = bflo(w.x); f[1] = bfhi(w.x); f[2] = bflo(w.y); f[3] = bfhi(w.y); f[4] = bflo(w.z); f[5] = bfhi(w.z); f[6] = bflo(w.w); f[7] = bfhi(w.w); }
__device__ __forceinline__ u32x4 pack8(const float (&f)[8]) { u32x4 w; w.x = pg8::cvt_pk_bf16(f[0], f[1]); w.y = pg8::cvt_pk_bf16(f[2], f[3]); w.z = pg8::cvt_pk_bf16(f[4], f[5]); w.w = pg8::cvt_pk_bf16(f[6], f[7]); return w; }
__device__ __forceinline__ float bf1(const bf16_t* p) { return __uint_as_float(((unsigned)*p) << 16); }
__device__ __forceinline__ float sigm(float x) { return 1.0f / (1.0f + __expf(-x)); }
__device__ __forceinline__ float siluf(float x) { return x / (1.0f + __expf(-x)); }
__device__ __forceinline__ float softplusf(float x) { return fmaxf(x, 0.f) + log1pf(__expf(-fabsf(x))); }
__device__ __forceinline__ float wave_sum(float v) { v += __shfl_xor(v, 32); v += __shfl_xor(v, 16); v += __shfl_xor(v, 8); v += __shfl_xor(v, 4); v += __shfl_xor(v, 2); v += __shfl_xor(v, 1); return v; }
__device__ __forceinline__ float gelu_tanh(float y) { const float u = 0.7978845608028654f * (y + 0.044715f * y * y * y); const float e = __expf(2.f * u); const float th = 1.f - 2.f / (e + 1.f); return 0.5f * y * (1.f + th); }

namespace pg8 {
struct EpiProj {
    static constexpr bool PERM = true, AFTER_DRAIN = false;
    bf16_t* mix; bf16_t* gate;
    __device__ __forceinline__ void operator()(const f32x4 (&acc)[2][2][4][2], const Unit& u, int wr, int wc, int fr, int fq) const {
        const int row0 = u.pm * BM + wr * 64 + fr; int colt = u.pn * BM; const bool isg = colt >= NMIXP;
        bf16_t* base = isg ? gate : mix; const int ldc = isg ? NGATE : NMIXP; if (isg) colt -= NMIXP;
        const int col0 = colt + wc * 32 + 8 * fq;
#pragma unroll
        for (int ai = 0; ai < 2; ++ai)
#pragma unroll
            for (int m = 0; m < 4; ++m) { bf16_t* rowp = base + (size_t)(row0 + ai * HALF + m * 16) * ldc + col0;
#pragma unroll
                for (int bj = 0; bj < 2; ++bj) { f32x4 v0 = acc[ai][bj][m][0], v1 = acc[ai][bj][m][1];
                    if (isg) {
#pragma unroll
                        for (int j = 0; j < 4; ++j) { v0[j] = sigm(v0[j]); v1[j] = sigm(v1[j]); } }
                    u32x4 w; w.x = cvt_pk_bf16(v0[0], v0[1]); w.y = cvt_pk_bf16(v0[2], v0[3]); w.z = cvt_pk_bf16(v1[0], v1[1]); w.w = cvt_pk_bf16(v1[2], v1[3]);
                    *(u32x4*)(rowp + bj * HALF) = w; } }
    }
};
struct EpiUpGate {
    static constexpr bool PERM = true, AFTER_DRAIN = false;
    const bf16_t* gate; float* macc; bf16_t* merged; int nMtot;
    __device__ __forceinline__ void operator()(const f32x4 (&acc)[2][2][4][2], const Unit& u, int wr, int wc, int fr, int fq) const {
        const int b = u.pn >> 3, pn = u.pn & 7, pm = u.pm - b * nMtot;
        const int row0 = pm * BM + wr * 64 + fr, col0 = pn * BM + wc * 32 + 8 * fq;
#pragma unroll
        for (int ai = 0; ai < 2; ++ai)
#pragma unroll
            for (int m = 0; m < 4; ++m) { const size_t r = (size_t)(row0 + ai * HALF + m * 16);
#pragma unroll
                for (int bj = 0; bj < 2; ++bj) { const int c = col0 + bj * HALF;
                    const u32x4 gw = *(const u32x4*)(gate + r * NGATE + b * 2048 + c); float g[8]; unpack8(gw, g);
                    f32x4 v0 = acc[ai][bj][m][0], v1 = acc[ai][bj][m][1];
#pragma unroll
                    for (int j = 0; j < 4; ++j) { v0[j] *= g[j]; v1[j] *= g[4 + j]; }
                    float* mp = macc + r * 2048 + c;
                    if (b > 0) { v0 += *(const f32x4*)mp; v1 += *(const f32x4*)(mp + 4); }
                    if (b < 3) { *(f32x4*)mp = v0; *(f32x4*)(mp + 4) = v1; }
                    else { u32x4 w; w.x = cvt_pk_bf16(v0[0], v0[1]); w.y = cvt_pk_bf16(v0[2], v0[3]); w.z = cvt_pk_bf16(v1[0], v1[1]); w.w = cvt_pk_bf16(v1[2], v1[3]);
                           *(u32x4*)(merged + r * 2048 + c) = w; } } }
    }
};
struct EpiResid {
    static constexpr bool PERM = false, AFTER_DRAIN = false;
    const float* srcl; float* dstl; const float* srcc; float* dstc; const float* modv;
    int permute;
    __device__ __forceinline__ void operator()(const f32x4 (&acc)[2][2][4][2], const Unit& u, int wr, int wc, int fr, int fq) const {
        const int row0 = u.pm * BM + wr * 64 + fr, col0 = u.pn * BM + wc * 32 + 4 * fq;
#pragma unroll
        for (int ai = 0; ai < 2; ++ai)
#pragma unroll
            for (int m = 0; m < 4; ++m) { const int r = row0 + ai * HALF + m * 16;
                const float* sp; float* dp; const float* mp;
                if (r < ML) { const int b = r >> 14, s = r & 16383; const int t = permute ? (((s & 255) << 6) | (s >> 8)) : s; const size_t o = ((size_t)(b << 14) + t) * D;
                    sp = srcl + o; dp = dstl + o; mp = modv + b * 12288; }
                else { const size_t o = (size_t)(r - ML) * D; sp = srcc + o; dp = dstc + o; mp = modv + 2 * 12288; }
#pragma unroll
                for (int bj = 0; bj < 2; ++bj)
#pragma unroll
                    for (int n = 0; n < 2; ++n) { const int c = col0 + bj * HALF + n * 16;
                        const f32x4 sv = *(const f32x4*)(sp + c), mv = *(const f32x4*)(mp + c);
                        *(f32x4*)(dp + c) = sv + mv * acc[ai][bj][m][n]; } }
    }
};
struct EpiSwiglu {
    static constexpr bool PERM = true, AFTER_DRAIN = false;
    bf16_t* hid; int nper;
    __device__ __forceinline__ void operator()(const f32x4 (&acc)[2][2][4][2], const Unit& u, int wr, int wc, int fr, int fq) const {
        const int pn = u.pn % nper; const int row0 = u.pm * BM + wr * 64 + fr, col0 = pn * HALF + wc * 32 + 8 * fq;
#pragma unroll
        for (int ai = 0; ai < 2; ++ai)
#pragma unroll
            for (int m = 0; m < 4; ++m) { bf16_t* rowp = hid + (size_t)(row0 + ai * HALF + m * 16) * FF + col0;
                float o[8];
#pragma unroll
                for (int n = 0; n < 2; ++n)
#pragma unroll
                    for (int j = 0; j < 4; ++j) { const float g = acc[ai][0][m][n][j], v = acc[ai][1][m][n][j]; o[n * 4 + j] = siluf(g) * v; }
                u32x4 w; w.x = cvt_pk_bf16(o[0], o[1]); w.y = cvt_pk_bf16(o[2], o[3]); w.z = cvt_pk_bf16(o[4], o[5]); w.w = cvt_pk_bf16(o[6], o[7]);
                *(u32x4*)rowp = w; }
    }
};
struct EpiPlainBf16 {
    static constexpr bool PERM = true, AFTER_DRAIN = false;
    bf16_t* O; int ldc; int nper;
    __device__ __forceinline__ void operator()(const f32x4 (&acc)[2][2][4][2], const Unit& u, int wr, int wc, int fr, int fq) const {
        const int pn = u.pn % nper; const int row0 = u.pm * BM + wr * 64 + fr, col0 = pn * BM + wc * 32 + 8 * fq;
#pragma unroll
        for (int ai = 0; ai < 2; ++ai)
#pragma unroll
            for (int m = 0; m < 4; ++m) { bf16_t* rowp = O + (size_t)(row0 + ai * HALF + m * 16) * ldc + col0;
#pragma unroll
                for (int bj = 0; bj < 2; ++bj) { const f32x4 v0 = acc[ai][bj][m][0], v1 = acc[ai][bj][m][1];
                    u32x4 w; w.x = cvt_pk_bf16(v0[0], v0[1]); w.y = cvt_pk_bf16(v0[2], v0[3]); w.z = cvt_pk_bf16(v1[0], v1[1]); w.w = cvt_pk_bf16(v1[2], v1[3]);
                    *(u32x4*)(rowp + bj * HALF) = w; } }
    }
};
struct UpGateOrder {
    StaticOrder so; int nMtot;
    __device__ void init(int M, int G, int c, int nMtot_) { so.init(M, 2048, G, c); nMtot = nMtot_; }
    __device__ bool next(int i, Unit& u) const { Unit t; if (!so.next(i >> 2, t)) return false; const int b = i & 3; u.pm = b * nMtot + t.pm; u.pn = b * 8 + t.pn; return true; }
    __device__ __forceinline__ void a_ready(const Unit&) const {}
    __device__ __forceinline__ void done(const Unit&) const {}
};
struct MoeOrder {
    StaticOrder so; int be[8]; int nper;
    __device__ void init(int nused, int nper_, int G, int c, const int* be_) { so.init(nused * BM, nper_ * BM, G, c); nper = nper_;
#pragma unroll
        for (int e = 0; e < 8; ++e) be[e] = be_[e]; }
    __device__ bool next(int i, Unit& u) const { Unit t; if (!so.next(i, t)) return false; int e = 0;
#pragma unroll
        for (int j = 0; j < 7; ++j) e += (t.pm >= be[j]) ? 1 : 0;
        u.pm = t.pm; u.pn = e * nper + t.pn; return true; }
    __device__ __forceinline__ void a_ready(const Unit&) const {}
    __device__ __forceinline__ void done(const Unit&) const {}
};
}

__device__ __forceinline__ int lds_add(volatile LAS int* p) { return __hip_atomic_fetch_add((LAS int*)p, 1, __ATOMIC_RELAXED, __HIP_MEMORY_SCOPE_WORKGROUP); }
struct Ctx { const Args* a; LAS unsigned char* lds; int tid, lane, wave, wg, G; };

__device__ __forceinline__ void conv_tile(const float* src, size_t ldsrc, int nvalid, bf16_t* dst, size_t ldd, LAS float* tile, int tid) {
    const int nn = tid & 63, kk = tid >> 6;
    float v[16];
#pragma unroll
    for (int j = 0; j < 16; ++j) v[j] = (nn < nvalid) ? src[(size_t)(kk + 8 * j) * ldsrc + nn] : 0.f;
#pragma unroll
    for (int j = 0; j < 16; ++j) tile[nn * 129 + kk + 8 * j] = v[j];
    __syncthreads();
    const int lane = tid & 63, w = tid >> 6;
#pragma unroll
    for (int p = 0; p < 8; ++p) { const int n = w + 8 * p; const float a = tile[n * 129 + 2 * lane], b = tile[n * 129 + 2 * lane + 1];
        *(unsigned*)(dst + (size_t)n * ldd + 2 * lane) = pg8::cvt_pk_bf16(a, b); }
    __syncthreads();
}
template <int KIND>
__device__ __forceinline__ void conv_job(const Ctx& c, const float* src, const float* src2, size_t ldsrc, int K, int Nd, bf16_t* dst, int& rot) {
    LAS float* tile = (LAS float*)(c.lds + LDS_SCR);
    const int nkt = K / 128, nnt = Nd / 64, ntile = nkt * nnt;
    int t0 = (c.wg - rot) % c.G; if (t0 < 0) t0 += c.G;
    for (int t = t0; t < ntile; t += c.G) {
        const int nt = t % nnt, kt = t / nnt, n0 = nt * 64, k0 = kt * 128;
        const float* s = src; int c0 = n0, nvalid = 64;
        if (KIND == 1) { if (n0 >= NMIXP) c0 = n0 - (NMIXP - NMIX); else { nvalid = NMIX - n0; nvalid = nvalid < 0 ? 0 : (nvalid > 64 ? 64 : nvalid); } }
        if (KIND == 2) { const int which = (n0 & 255) >> 7; c0 = (n0 >> 8) * 128 + (n0 & 127); s = which ? src2 : src; }
        conv_tile(s + (size_t)k0 * ldsrc + c0, ldsrc, nvalid, dst + (size_t)n0 * K + k0, (size_t)K, tile, c.tid);
    }
    rot = (rot + ntile) % c.G;
}

__device__ __forceinline__ void mod_phase(const Ctx& c) {
    const Args& a = *c.a; const int tid = c.tid;
    LAS float* s = (LAS float*)(c.lds + LDS_SCR);
    LAS float* red = s + 3 * 2048;
    for (int i = tid; i < 3 * 2048; i += 512) { const int r = i >> 11, k = i & 2047; const float cv = (r < 2) ? a.in[I_C][r * 2048 + k] : a.in[I_CCTX][k]; s[i] = siluf(cv); }
    __syncthreads();
    float* modv = (float*)(a.ws + WS_MOD);
    for (int task = c.wg; task < 192; task += c.G) {
        const int l = task / 96, cb = task % 96, cq = tid & 31, kg = tid >> 5;
        const float* w = a.in[I_WMOD] + (size_t)l * 2048 * 12288 + cb * 128 + cq * 4;
        f32x4 a0 = {0.f, 0.f, 0.f, 0.f}, a1 = a0, a2 = a0;
#pragma unroll 8
        for (int k = kg; k < 2048; k += 16) { const f32x4 wv = *(const f32x4*)(w + (size_t)k * 12288); a0 += s[k] * wv; a1 += s[2048 + k] * wv; a2 += s[4096 + k] * wv; }
#pragma unroll
        for (int j = 0; j < 4; ++j) { red[(kg * 3 + 0) * 128 + cq * 4 + j] = a0[j]; red[(kg * 3 + 1) * 128 + cq * 4 + j] = a1[j]; red[(kg * 3 + 2) * 128 + cq * 4 + j] = a2[j]; }
        __syncthreads();
        if (tid < 384) { const int r = tid >> 7, cc = tid & 127; float sum = 0.f;
#pragma unroll
            for (int g = 0; g < 16; ++g) sum += red[(g * 3 + r) * 128 + cc];
            modv[(size_t)(l * 3 + r) * 12288 + cb * 128 + cc] = sum + a.in[I_BMOD][l * 12288 + cb * 128 + cc]; }
        __syncthreads();
    }
}

__device__ __forceinline__ void modnorm_row(f32x4 (&v)[8], const float* nw, const float* shift, const float* scale, int lane) {
    float ss = 0.f;
#pragma unroll
    for (int j = 0; j < 8; ++j) ss += v[j][0] * v[j][0] + v[j][1] * v[j][1] + v[j][2] * v[j][2] + v[j][3] * v[j][3];
    ss = wave_sum(ss);
    const float rstd = rsqrtf(ss * (1.0f / 2048.0f) + EPS);
#pragma unroll
    for (int j = 0; j < 8; ++j) { const int cc = (j * 64 + lane) * 4; const f32x4 w = *(const f32x4*)(nw + cc), sh = *(const f32x4*)(shift + cc), sc = *(const f32x4*)(scale + cc);
        v[j] = (v[j] * rstd * w) * (1.0f + sc) + sh; }
}
__device__ __forceinline__ void store_row_bf16(const f32x4 (&v)[8], bf16_t* hrow, int lane) {
#pragma unroll
    for (int j = 0; j < 8; ++j) { u32x2 w; w.x = pg8::cvt_pk_bf16(v[j][0], v[j][1]); w.y = pg8::cvt_pk_bf16(v[j][2], v[j][3]); *(u32x2*)(hrow + (j * 64 + lane) * 4) = w; }
}
template <int L, int WHICH>
__device__ __forceinline__ void norm_phase(const Ctx& c) {
    const Args& a = *c.a; const int gw = c.wg * 8 + c.wave, nw = c.G * 8, lane = c.lane;
    const float* modv = (const float*)(a.ws + WS_MOD) + (size_t)L * 3 * 12288 + (WHICH ? 3 : 0) * 2048;
    const float* normw = a.in[I_NORMW] + (L * 2 + WHICH) * 2048;
    const float* xc = (const float*)(a.ws + WS_XC);
    bf16_t* H = (bf16_t*)(a.ws + WS_H);
    for (int r = gw; r < MT; r += nw) {
        const float* src; int mr; size_t hrow;
        if (r < ML) { const int b = r >> 14, t = r & 16383; src = ((L == 0 && WHICH == 0) ? a.in[I_X] : (const float*)a.out) + (size_t)r * D; mr = b;
            hrow = (L == 1 && WHICH == 0) ? (size_t)(b << 14) + ((t & 63) << 8) + (t >> 6) : (size_t)r; }
        else { const int rc = r - ML; src = ((L == 0 && WHICH == 0) ? a.in[I_CTX] : xc) + (size_t)rc * D; mr = 2; hrow = r; }
        f32x4 v[8];
#pragma unroll
        for (int j = 0; j < 8; ++j) v[j] = *(const f32x4*)(src + (j * 64 + lane) * 4);
        const float* shift = modv + (size_t)mr * 12288;
        modnorm_row(v, normw, shift, shift + 2048, lane);
        store_row_bf16(v, H + hrow * D, lane);
    }
}

template <int L>
__device__ __forceinline__ void rgprep_phase(const Ctx& c) {
    const Args& a = *c.a; const int tid = c.tid;
    LAS float* xbT = (LAS float*)(c.lds + LDS_SCR);
    const bf16_t* PM = (const bf16_t*)(a.ws + WS_PMIX);
    bf16_t* RGLA = (bf16_t*)(a.ws + WS_RGLA); bf16_t* RGU = (bf16_t*)(a.ws + WS_RGU);
    const float* cw = a.in[I_RG_CW] + L * 4 * 512; const float* cb = a.in[I_RG_CB] + L * 512;
    for (int item = c.wg; item < 520 * 4; item += c.G) {
        const int tt = item >> 2, n = item & 3;
        size_t rowbase; int t0, Ls;
        if (tt < 512) { const int b = tt >> 8; rowbase = (size_t)b * T; t0 = (tt & 255) * 64; Ls = T; }
        else { const int tc = tt - 512, b = tc >> 2; rowbase = (size_t)ML + b * CL; t0 = (tc & 3) * 64; Ls = CL; }
        __syncthreads();
        {
            const int tl = tid >> 3, cg = tid & 7, ch0 = n * 128 + cg * 16;
            float acc[16];
#pragma unroll
            for (int j = 0; j < 16; ++j) acc[j] = cb[ch0 + j];
#pragma unroll
            for (int tap = 0; tap < 4; ++tap) { const int ts = t0 + tl + tap - 2;
                if (ts >= 0 && ts < Ls) { const bf16_t* rp = PM + (rowbase + ts) * NMIXP + C_RG_X + ch0; const u32x4 w0 = *(const u32x4*)rp, w1 = *(const u32x4*)(rp + 8);
                    float f[8], g[8]; unpack8(w0, f); unpack8(w1, g);
#pragma unroll
                    for (int j = 0; j < 8; ++j) { acc[j] += cw[tap * 512 + ch0 + j] * f[j]; acc[8 + j] += cw[tap * 512 + ch0 + 8 + j] * g[j]; } } }
#pragma unroll
            for (int j = 0; j < 16; ++j) xbT[(cg * 16 + j) * 68 + tl] = acc[j];
        }
        __syncthreads();
        const int oc = tid & 127, tg = tid >> 7, ch = n * 128 + oc;
#pragma unroll 1
        for (int d = 0; d < 2; ++d) {
            const float* wr = a.in[I_RG_WR] + ((size_t)((L * 2 + d) * 4 + n) * 128) * 128 + oc;
            const float* wi = a.in[I_RG_WI] + ((size_t)((L * 2 + d) * 4 + n) * 128) * 128 + oc;
            float ar[16], ai[16];
#pragma unroll
            for (int j = 0; j < 16; ++j) { ar[j] = 0.f; ai[j] = 0.f; }
#pragma unroll 4
            for (int k = 0; k < 128; ++k) { const float w1 = wr[k * 128], w2 = wi[k * 128];
                const LAS f32x4* xp = (const LAS f32x4*)(xbT + k * 68 + tg * 16);
#pragma unroll
                for (int q = 0; q < 4; ++q) { const f32x4 xv = xp[q];
#pragma unroll
                    for (int j = 0; j < 4; ++j) { ar[q * 4 + j] += xv[j] * w1; ai[q * 4 + j] += xv[j] * w2; } } }
            const float br = a.in[I_RG_BR][(L * 2 + d) * 512 + ch], bi = a.in[I_RG_BI][(L * 2 + d) * 512 + ch];
            const float sp = softplusf(-a.in[I_RG_LAM][(L * 2 + d) * 512 + ch]);
#pragma unroll
            for (int j = 0; j < 16; ++j) { const int tl = tg * 16 + j; const float r = sigm(ar[j] + br), ig = sigm(ai[j] + bi);
                const float la = -8.0f * r * sp; const float xb = xbT[oc * 68 + tl];
                const float u = sqrtf(fmaxf(-expm1f(2.0f * la), 0.f)) * (ig * xb);
                const size_t o = ((size_t)d * MT + rowbase + t0 + tl) * 512 + ch;
                RGLA[o] = (bf16_t)(pg8::cvt_pk_bf16(la, 0.f) & 0xffffu); RGU[o] = (bf16_t)(pg8::cvt_pk_bf16(u, 0.f) & 0xffffu); }
        }
    }
}

template <int L>
__device__ __forceinline__ void chain_gla(const Ctx& c, int b, int h, int d, int vh) {
    const Args& a = *c.a; const int tid = c.tid;
    LAS float* qs = (LAS float*)(c.lds + LDS_SCR); LAS float* ks = qs + 4096; LAS float* fs = ks + 4096; LAS float* vs = fs + 4096; LAS float* os = vs + 4096;
    LAS float* wa = (LAS float*)(c.lds + LDS_AUX);
    const bf16_t* PM = (const bf16_t*)(a.ws + WS_PMIX);
    bf16_t* ORAW = (bf16_t*)(a.ws + WS_ORAW) + (size_t)d * MT * 2048;
    for (int i = tid; i < 1024; i += 512) wa[i] = a.in[I_GLA_WA2][((L * 2 + d) * 16 + (i >> 6)) * 256 + h * 64 + (i & 63)];
    if (tid < 64) wa[1024 + tid] = a.in[I_GLA_BA2][(L * 2 + d) * 256 + h * 64 + tid];
    float s[8];
#pragma unroll
    for (int j = 0; j < 8; ++j) s[j] = 0.f;
    const int vc = tid >> 3, kq = tid & 7;
#pragma unroll 1
    for (int seg = 0; seg < 2; ++seg) {
        const int Ls = seg ? T : CL; const size_t rowbase = seg ? (size_t)b * T : (size_t)ML + b * CL;
#pragma unroll 1
        for (int jb = 0; jb < Ls / 64; ++jb) {
            const int r0 = d ? Ls - 64 * (jb + 1) : 64 * jb;
            __syncthreads();
            {   const int i = tid >> 3, cg = tid & 7, lr = d ? 63 - i : i; const bf16_t* rp = PM + (rowbase + r0 + lr) * NMIXP;
                float fq[8], fk[8], fv[8], fa[16];
                { const u32x4 w = *(const u32x4*)(rp + C_GLA_Q + h * 64 + cg * 8); unpack8(w, fq); }
                { const u32x4 w = *(const u32x4*)(rp + C_GLA_K + h * 64 + cg * 8); unpack8(w, fk); }
                { const u32x4 w = *(const u32x4*)(rp + C_GLA_V + h * 128 + vh * 64 + cg * 8); unpack8(w, fv); }
                { const u32x4 w0 = *(const u32x4*)(rp + C_GLA_A + d * 16), w1 = *(const u32x4*)(rp + C_GLA_A + d * 16 + 8); float t0[8], t1[8]; unpack8(w0, t0); unpack8(w1, t1);
#pragma unroll
                  for (int j = 0; j < 8; ++j) { fa[j] = t0[j]; fa[8 + j] = t1[j]; } }
#pragma unroll
                for (int j = 0; j < 8; ++j) { const int o = i * 64 + cg * 8 + j; qs[o] = fq[j] * 0.125f; ks[o] = fk[j]; vs[o] = fv[j];
                    float z = wa[1024 + cg * 8 + j];
#pragma unroll
                    for (int r = 0; r < 16; ++r) z += fa[r] * wa[r * 64 + cg * 8 + j];
                    fs[o] = __expf(-softplusf(-z) * (1.0f / 16.0f)); }
            }
            __syncthreads();
#pragma unroll 2
            for (int i = 0; i < 64; ++i) {
                const f32x4 f0 = *(const LAS f32x4*)(fs + i * 64 + kq * 8), f1 = *(const LAS f32x4*)(fs + i * 64 + kq * 8 + 4);
                const f32x4 k0 = *(const LAS f32x4*)(ks + i * 64 + kq * 8), k1 = *(const LAS f32x4*)(ks + i * 64 + kq * 8 + 4);
                const f32x4 q0 = *(const LAS f32x4*)(qs + i * 64 + kq * 8), q1 = *(const LAS f32x4*)(qs + i * 64 + kq * 8 + 4);
                const float vv = vs[i * 64 + vc]; float po = 0.f;
#pragma unroll
                for (int j = 0; j < 4; ++j) { s[j] = f0[j] * s[j] + k0[j] * vv; s[4 + j] = f1[j] * s[4 + j] + k1[j] * vv; po += s[j] * q0[j] + s[4 + j] * q1[j]; }
                po += __shfl_xor(po, 1); po += __shfl_xor(po, 2); po += __shfl_xor(po, 4);
                if (kq == 0) os[i * 64 + vc] = po;
            }
            __syncthreads();
            {   const int i = tid >> 3, cg = tid & 7, lr = d ? 63 - i : i; float o[8];
#pragma unroll
                for (int j = 0; j < 8; ++j) o[j] = os[i * 64 + cg * 8 + j];
                *(u32x4*)(ORAW + (rowbase + r0 + lr) * 2048 + 0 * 512 + h * 128 + vh * 64 + cg * 8) = pack8(o); }
        }
    }
}
template <int L>
__device__ __forceinline__ void chain_hg(const Ctx& c, int b, int h, int d, int vh) {
    const Args& a = *c.a; const int tid = c.tid;
    LAS float* qs = (LAS float*)(c.lds + LDS_SCR); LAS float* ks = qs + 8192; LAS float* fs = ks + 8192; LAS float* vs = fs + 8192; LAS float* os = vs + 4096;
    LAS float* lbs = (LAS float*)(c.lds + LDS_AUX);
    const bf16_t* PM = (const bf16_t*)(a.ws + WS_PMIX);
    bf16_t* ORAW = (bf16_t*)(a.ws + WS_ORAW) + (size_t)d * MT * 2048;
    if (tid < 128) { float lb = 0.f; if (L == 1) { const float l0 = a.in[I_HG_LB][h * 128 + tid], l1 = a.in[I_HG_LB][512 + h * 128 + tid]; lb = 1.0f / (1.0f + expf(l0 - l1)); } lbs[tid] = lb; }
    float s[16];
#pragma unroll
    for (int j = 0; j < 16; ++j) s[j] = 0.f;
    const int vc = tid >> 3, kq = tid & 7;
#pragma unroll 1
    for (int seg = 0; seg < 2; ++seg) {
        const int Ls = seg ? T : CL; const size_t rowbase = seg ? (size_t)b * T : (size_t)ML + b * CL;
#pragma unroll 1
        for (int jb = 0; jb < Ls / 64; ++jb) {
            const int r0 = d ? Ls - 64 * (jb + 1) : 64 * jb;
            __syncthreads();
            {   const int i = tid >> 3, cg = tid & 7, lr = d ? 63 - i : i; const bf16_t* rp = PM + (rowbase + r0 + lr) * NMIXP;
#pragma unroll
                for (int hf = 0; hf < 2; ++hf) { const int ch = cg * 16 + hf * 8; float fq[8], fz[8];
                    { const u32x4 w = *(const u32x4*)(rp + C_HG_Q + h * 128 + ch); unpack8(w, fq); }
                    { const u32x4 w = *(const u32x4*)(rp + C_HG_F + d * 512 + h * 128 + ch); unpack8(w, fz); }
#pragma unroll
                    for (int j = 0; j < 8; ++j) { const int o = i * 128 + ch + j; const float lb = lbs[ch + j], sg = sigm(fz[j]);
                        qs[o] = siluf(fq[j]) * 0.08838834764831845f; fs[o] = fmaxf(lb + (1.0f - lb) * sg, 1e-30f); ks[o] = (1.0f - lb) * (1.0f - sg); } }
                float fv[8]; { const u32x4 w = *(const u32x4*)(rp + C_HG_I + h * 128 + vh * 64 + cg * 8); unpack8(w, fv); }
#pragma unroll
                for (int j = 0; j < 8; ++j) vs[i * 64 + cg * 8 + j] = fv[j];
            }
            __syncthreads();
#pragma unroll 2
            for (int i = 0; i < 64; ++i) {
                const float vv = vs[i * 64 + vc]; float po = 0.f;
#pragma unroll
                for (int q4 = 0; q4 < 4; ++q4) {
                    const f32x4 f0 = *(const LAS f32x4*)(fs + i * 128 + kq * 16 + q4 * 4), k0 = *(const LAS f32x4*)(ks + i * 128 + kq * 16 + q4 * 4), q0 = *(const LAS f32x4*)(qs + i * 128 + kq * 16 + q4 * 4);
#pragma unroll
                    for (int j = 0; j < 4; ++j) { s[q4 * 4 + j] = f0[j] * s[q4 * 4 + j] + k0[j] * vv; po += s[q4 * 4 + j] * q0[j]; } }
                po += __shfl_xor(po, 1); po += __shfl_xor(po, 2); po += __shfl_xor(po, 4);
                if (kq == 0) os[i * 64 + vc] = po;
            }
            __syncthreads();
            {   const int i = tid >> 3, cg = tid & 7, lr = d ? 63 - i : i; float o[8];
#pragma unroll
                for (int j = 0; j < 8; ++j) o[j] = os[i * 64 + cg * 8 + j];
                *(u32x4*)(ORAW + (rowbase + r0 + lr) * 2048 + 1 * 512 + h * 128 + vh * 64 + cg * 8) = pack8(o); }
        }
    }
}
template <int L>
__device__ __forceinline__ void chain_dn(const Ctx& c, int b, int h, int d, int vh) {
    const Args& a = *c.a; const int tid = c.tid;
    LAS float* qs = (LAS float*)(c.lds + LDS_SCR); LAS float* ks = qs + 8192; LAS float* vs = ks + 8192; LAS float* os = vs + 4096; LAS float* as = os + 4096; LAS float* bs = as + 64;
    LAS float* cwl = (LAS float*)(c.lds + LDS_AUX);
    const bf16_t* PM = (const bf16_t*)(a.ws + WS_PMIX);
    bf16_t* ORAW = (bf16_t*)(a.ws + WS_ORAW) + (size_t)d * MT * 2048;
    for (int i = tid; i < 4 * 320; i += 512) { const int tap = i / 320, cc = i % 320; const int ch = cc < 128 ? h * 128 + cc : (cc < 256 ? 512 + h * 128 + (cc - 128) : 1024 + h * 128 + vh * 64 + (cc - 256));
        cwl[i] = a.in[I_DN_CW][(L * 4 + tap) * 1536 + ch]; }
    const float neg_ea = -expf(a.in[I_DN_ALOG][(L * 2 + d) * 4 + h]), dtb = a.in[I_DN_DTB][(L * 2 + d) * 4 + h];
    float s[16];
#pragma unroll
    for (int j = 0; j < 16; ++j) s[j] = 0.f;
    const int vc = tid >> 3, kq = tid & 7;
#pragma unroll 1
    for (int seg = 0; seg < 2; ++seg) {
        const int Ls = seg ? T : CL; const size_t rowbase = seg ? (size_t)b * T : (size_t)ML + b * CL;
#pragma unroll 1
        for (int jb = 0; jb < Ls / 64; ++jb) {
            const int r0 = d ? Ls - 64 * (jb + 1) : 64 * jb;
            __syncthreads();
            {   const int i = tid >> 3, cg = tid & 7, lr = d ? 63 - i : i, t = r0 + lr;
                float aq[16], ak[16], av[8];
#pragma unroll
                for (int j = 0; j < 16; ++j) { aq[j] = 0.f; ak[j] = 0.f; }
#pragma unroll
                for (int j = 0; j < 8; ++j) av[j] = 0.f;
#pragma unroll
                for (int tap = 0; tap < 4; ++tap) { const int ts = t + tap - 2;
                    if (ts >= 0 && ts < Ls) { const bf16_t* rp = PM + (rowbase + ts) * NMIXP; const LAS float* w = cwl + tap * 320;
                        float f0[8], f1[8];
                        { const u32x4 w0 = *(const u32x4*)(rp + C_DN_Q + h * 128 + cg * 16), w1 = *(const u32x4*)(rp + C_DN_Q + h * 128 + cg * 16 + 8); unpack8(w0, f0); unpack8(w1, f1); }
#pragma unroll
                        for (int j = 0; j < 8; ++j) { aq[j] += w[cg * 16 + j] * f0[j]; aq[8 + j] += w[cg * 16 + 8 + j] * f1[j]; }
                        { const u32x4 w0 = *(const u32x4*)(rp + C_DN_K + h * 128 + cg * 16), w1 = *(const u32x4*)(rp + C_DN_K + h * 128 + cg * 16 + 8); unpack8(w0, f0); unpack8(w1, f1); }
#pragma unroll
                        for (int j = 0; j < 8; ++j) { ak[j] += w[128 + cg * 16 + j] * f0[j]; ak[8 + j] += w[128 + cg * 16 + 8 + j] * f1[j]; }
                        { const u32x4 w0 = *(const u32x4*)(rp + C_DN_V + h * 128 + vh * 64 + cg * 8); unpack8(w0, f0); }
#pragma unroll
                        for (int j = 0; j < 8; ++j) av[j] += w[256 + cg * 8 + j] * f0[j]; } }
#pragma unroll
                for (int j = 0; j < 16; ++j) { qs[i * 128 + cg * 16 + j] = siluf(aq[j]); ks[i * 128 + cg * 16 + j] = siluf(ak[j]); }
#pragma unroll
                for (int j = 0; j < 8; ++j) vs[i * 64 + cg * 8 + j] = siluf(av[j]);
                if (tid < 64) { const int lr2 = d ? 63 - tid : tid; const bf16_t* rp = PM + (rowbase + r0 + lr2) * NMIXP;
                    const float g = neg_ea * softplusf(bf1(rp + C_DN_A + d * 4 + h) + dtb); as[tid] = __expf(g); bs[tid] = sigm(bf1(rp + C_DN_B + d * 4 + h)); }
            }
            __syncthreads();
            {
                const int rowid = tid >> 2, part = tid & 3; LAS float* p = (rowid < 64 ? qs + rowid * 128 : ks + (rowid - 64) * 128) + part * 32; float ss = 0.f;
#pragma unroll
                for (int j = 0; j < 32; ++j) ss += p[j] * p[j];
                ss += __shfl_xor(ss, 1); ss += __shfl_xor(ss, 2);
                const float rs = rsqrtf(ss + EPS) * (rowid < 64 ? 0.08838834764831845f : 1.0f);
#pragma unroll
                for (int j = 0; j < 32; ++j) p[j] *= rs;
            }
            __syncthreads();
#pragma unroll 2
            for (int i = 0; i < 64; ++i) {
                f32x4 kk[4]; float kts = 0.f;
#pragma unroll
                for (int q4 = 0; q4 < 4; ++q4) { kk[q4] = *(const LAS f32x4*)(ks + i * 128 + kq * 16 + q4 * 4);
#pragma unroll
                    for (int j = 0; j < 4; ++j) kts += s[q4 * 4 + j] * kk[q4][j]; }
                kts += __shfl_xor(kts, 1); kts += __shfl_xor(kts, 2); kts += __shfl_xor(kts, 4);
                const float al = as[i], be = bs[i]; const float vn = be * (vs[i * 64 + vc] - al * kts); float po = 0.f;
#pragma unroll
                for (int q4 = 0; q4 < 4; ++q4) { const f32x4 q0 = *(const LAS f32x4*)(qs + i * 128 + kq * 16 + q4 * 4);
#pragma unroll
                    for (int j = 0; j < 4; ++j) { s[q4 * 4 + j] = al * s[q4 * 4 + j] + kk[q4][j] * vn; po += s[q4 * 4 + j] * q0[j]; } }
                po += __shfl_xor(po, 1); po += __shfl_xor(po, 2); po += __shfl_xor(po, 4);
                if (kq == 0) os[i * 64 + vc] = po;
            }
            __syncthreads();
            {   const int i = tid >> 3, cg = tid & 7, lr = d ? 63 - i : i; float o[8];
#pragma unroll
                for (int j = 0; j < 8; ++j) o[j] = os[i * 64 + cg * 8 + j];
                *(u32x4*)(ORAW + (rowbase + r0 + lr) * 2048 + 2 * 512 + h * 128 + vh * 64 + cg * 8) = pack8(o); }
        }
    }
}
__device__ __forceinline__ void chain_rg(const Ctx& c, int gw  ) {
    const Args& a = *c.a; const int b = gw >> 3, d = (gw >> 2) & 1, ch = (gw & 3) * 128 + c.lane * 2;
    const bf16_t* RGLA = (const bf16_t*)(a.ws + WS_RGLA) + (size_t)d * MT * 512 + ch; const bf16_t* RGU = (const bf16_t*)(a.ws + WS_RGU) + (size_t)d * MT * 512 + ch;
    bf16_t* ORAW = (bf16_t*)(a.ws + WS_ORAW) + (size_t)d * MT * 2048 + 1536 + ch;
    float h0 = 0.f, h1 = 0.f;
#pragma unroll 1
    for (int seg = 0; seg < 2; ++seg) {
        const int Ls = seg ? T : CL; const size_t rowbase = seg ? (size_t)b * T : (size_t)ML + b * CL;
#pragma unroll 1
        for (int s0 = 0; s0 < Ls; s0 += 16) {
            unsigned la[16], uu[16];
#pragma unroll
            for (int j = 0; j < 16; ++j) { const size_t row = rowbase + (d ? Ls - 1 - (s0 + j) : s0 + j); la[j] = *(const unsigned*)(RGLA + row * 512); uu[j] = *(const unsigned*)(RGU + row * 512); }
#pragma unroll
            for (int j = 0; j < 16; ++j) { const size_t row = rowbase + (d ? Ls - 1 - (s0 + j) : s0 + j);
                h0 = __expf(bflo(la[j])) * h0 + bflo(uu[j]); h1 = __expf(bfhi(la[j])) * h1 + bfhi(uu[j]);
                *(unsigned*)(ORAW + row * 2048) = pg8::cvt_pk_bf16(h0, h1); }
        }
    }
}
template <int L>
__device__ __forceinline__ void chains_phase(const Ctx& c) {
    const int w = c.wg;
    if (w < 96) { const int ty = w >> 5, r = w & 31, b = r >> 4, h = (r >> 2) & 3, d = (r >> 1) & 1, vh = r & 1;
        if (ty == 0) chain_gla<L>(c, b, h, d, vh); else if (ty == 1) chain_hg<L>(c, b, h, d, vh); else chain_dn<L>(c, b, h, d, vh); }
    else if (w < 98) chain_rg(c, (w - 96) * 8 + c.wave);
}

template <int L>
__device__ __forceinline__ void combine_phase(const Ctx& c) {
    const Args& a = *c.a; const int gw = c.wg * 8 + c.wave, nw = c.G * 8, lane = c.lane;
    const bf16_t* PM = (const bf16_t*)(a.ws + WS_PMIX); const bf16_t* O0 = (const bf16_t*)(a.ws + WS_ORAW); const bf16_t* O1 = O0 + (size_t)MT * 2048;
    bf16_t* O = (bf16_t*)(a.ws + WS_H);
    const int cb = lane * 8, hv = cb & 127;
    float nwv[3][8];
#pragma unroll
    for (int j = 0; j < 8; ++j) { nwv[0][j] = a.in[I_GLA_NW][L * 128 + hv + j]; nwv[1][j] = a.in[I_HG_NW][L * 128 + hv + j]; nwv[2][j] = a.in[I_DN_NW][L * 128 + hv + j]; }
    const int nrows = (L == 0) ? MT : ML;
    for (int r = gw; r < nrows; r += nw) {
        const bf16_t* pm = PM + (size_t)r * NMIXP;
#pragma unroll
        for (int br = 0; br < 3; ++br) {
            const int gcol = br == 0 ? C_GLA_G : (br == 1 ? C_HG_G : C_DN_G);
            float x0[8], x1[8], g[8], o[8];
            { const u32x4 w = *(const u32x4*)(O0 + (size_t)r * 2048 + br * 512 + cb); unpack8(w, x0); }
            { const u32x4 w = *(const u32x4*)(O1 + (size_t)r * 2048 + br * 512 + cb); unpack8(w, x1); }
            { const u32x4 w = *(const u32x4*)(pm + gcol + cb); unpack8(w, g); }
            float ss = 0.f;
#pragma unroll
            for (int j = 0; j < 8; ++j) { o[j] = x0[j] + x1[j]; ss += o[j] * o[j]; }
            ss += __shfl_xor(ss, 1); ss += __shfl_xor(ss, 2); ss += __shfl_xor(ss, 4); ss += __shfl_xor(ss, 8);
            const float rs = rsqrtf(ss * (1.0f / 128.0f) + EPS);
#pragma unroll
            for (int j = 0; j < 8; ++j) o[j] = o[j] * rs * nwv[br][j] * siluf(g[j]);
            *(u32x4*)(O + ((size_t)br * MT + r) * 512 + cb) = pack8(o);
        }
        {   float x0[8], x1[8], y[8], o[8];
            { const u32x4 w = *(const u32x4*)(O0 + (size_t)r * 2048 + 1536 + cb); unpack8(w, x0); }
            { const u32x4 w = *(const u32x4*)(O1 + (size_t)r * 2048 + 1536 + cb); unpack8(w, x1); }
            { const u32x4 w = *(const u32x4*)(pm + C_RG_Y + cb); unpack8(w, y); }
#pragma unroll
            for (int j = 0; j < 8; ++j) o[j] = gelu_tanh(y[j]) * (x0[j] + x1[j]);
            *(u32x4*)(O + ((size_t)3 * MT + r) * 512 + cb) = pack8(o);
        }
    }
}

__device__ __forceinline__ void route1_phase(const Ctx& c) {
    const Args& a = *c.a; const int lane = c.lane;
    const float* modv = (const float*)(a.ws + WS_MOD) + (size_t)1 * 3 * 12288 + 3 * 2048;
    const float* normw = a.in[I_NORMW] + (1 * 2 + 1) * 2048;
    const float* router = a.in[I_ROUTER];
    bf16_t* H = (bf16_t*)(a.ws + WS_H);
    unsigned* topi = (unsigned*)(a.ws + WS_TOPI); float* topw = (float*)(a.ws + WS_TOPW);
    volatile LAS int* hist = (volatile LAS int*)(c.lds + LDS_AUX);
    if (c.tid < 8) hist[c.tid] = 0;
    __syncthreads();
    const int rpw = ML / c.G;
    for (int rr = c.wave; rr < rpw; rr += 8) {
        const int r = c.wg * rpw + rr, b = r >> 14;
        const float* src = (const float*)a.out + (size_t)r * D;
        f32x4 v[8];
#pragma unroll
        for (int j = 0; j < 8; ++j) v[j] = *(const f32x4*)(src + (j * 64 + lane) * 4);
        const float* shift = modv + (size_t)b * 12288;
        modnorm_row(v, normw, shift, shift + 2048, lane);
        store_row_bf16(v, H + (size_t)r * D, lane);
        float lg[8];
#pragma unroll
        for (int e = 0; e < 8; ++e) lg[e] = 0.f;
#pragma unroll
        for (int j = 0; j < 8; ++j)
#pragma unroll
            for (int q = 0; q < 4; ++q) { const int cc = (j * 64 + lane) * 4 + q; const f32x4 r0 = *(const f32x4*)(router + cc * 8), r1 = *(const f32x4*)(router + cc * 8 + 4); const float x = v[j][q];
                lg[0] += x * r0[0]; lg[1] += x * r0[1]; lg[2] += x * r0[2]; lg[3] += x * r0[3]; lg[4] += x * r1[0]; lg[5] += x * r1[1]; lg[6] += x * r1[2]; lg[7] += x * r1[3]; }
#pragma unroll
        for (int e = 0; e < 8; ++e) lg[e] = wave_sum(lg[e]);
        int e0 = 0; float m0 = lg[0];
#pragma unroll
        for (int e = 1; e < 8; ++e) if (lg[e] > m0) { m0 = lg[e]; e0 = e; }
        int e1 = -1; float m1 = -3.0e38f;
#pragma unroll
        for (int e = 0; e < 8; ++e) if (e != e0 && lg[e] > m1) { m1 = lg[e]; e1 = e; }
        if (lane == 0) { const float ex = __expf(m1 - m0); const float w0 = 1.0f / (1.0f + ex); topi[r] = (unsigned)e0 | ((unsigned)e1 << 8); topw[2 * r] = w0; topw[2 * r + 1] = ex * w0;
            lds_add(&hist[e0]); lds_add(&hist[e1]); }
    }
    __syncthreads();
    if (c.tid < 8) ((int*)(a.ws + WS_CTL + CTL_WGH))[c.wg * 8 + c.tid] = hist[c.tid];
}
__device__ __forceinline__ void route2_phase(const Ctx& c) {
    const Args& a = *c.a; const int lane = c.lane, tid = c.tid;
    const int* wgh = (const int*)(a.ws + WS_CTL + CTL_WGH);
    volatile LAS int* tab = (volatile LAS int*)(c.lds + LDS_AUX);
    if (tid < 8) { int tot = 0, base = 0; for (int w = 0; w < c.G; ++w) { const int v = wgh[w * 8 + tid]; tot += v; if (w < c.wg) base += v; } tab[tid] = tot; tab[8 + tid] = base; tab[24 + tid] = 0; tab[32 + tid] = (tot + 255) / 256 * 256; }
    __syncthreads();
    if (tid == 0) { int acc = 0; for (int e = 0; e < 8; ++e) { tab[16 + e] = acc; acc += tab[32 + e]; }
        if (c.wg == 0) { int* meta = (int*)(a.ws + WS_CTL + CTL_META); int cum = 0; for (int e = 0; e < 8; ++e) { cum += tab[32 + e] / 256; meta[e] = cum; } meta[8] = cum; } }
    __syncthreads();
    const bf16_t* H = (const bf16_t*)(a.ws + WS_H); bf16_t* GATH = (bf16_t*)(a.ws + WS_GATH);
    const unsigned* topi = (const unsigned*)(a.ws + WS_TOPI); int* dest = (int*)(a.ws + WS_DEST);
    const int rpw = ML / c.G;
    for (int rr = c.wave; rr < rpw; rr += 8) {
        const int r = c.wg * rpw + rr; const unsigned ti = topi[r]; const int e0 = ti & 255, e1 = (ti >> 8) & 255;
        int d0 = 0, d1 = 0;
        if (lane == 0) { d0 = tab[16 + e0] + tab[8 + e0] + lds_add(&tab[24 + e0]); d1 = tab[16 + e1] + tab[8 + e1] + lds_add(&tab[24 + e1]); dest[2 * r] = d0; dest[2 * r + 1] = d1; }
        d0 = __shfl(d0, 0); d1 = __shfl(d1, 0);
        const u32x4* sp = (const u32x4*)(H + (size_t)r * D); u32x4* p0 = (u32x4*)(GATH + (size_t)d0 * D); u32x4* p1 = (u32x4*)(GATH + (size_t)d1 * D);
#pragma unroll
        for (int j = 0; j < 4; ++j) { const u32x4 w = sp[j * 64 + lane]; p0[j * 64 + lane] = w; p1[j * 64 + lane] = w; }
    }
    if (c.wg < 8) { const int e = c.wg; const int lo = tab[16 + e] + tab[e], hi = tab[16 + e] + tab[32 + e]; const u32x4 z = {0u, 0u, 0u, 0u};
        for (int r = lo + c.wave; r < hi; r += 8) { u32x4* p = (u32x4*)(GATH + (size_t)r * D);
#pragma unroll
            for (int j = 0; j < 4; ++j) p[j * 64 + lane] = z; } }
}
__device__ __forceinline__ void final_phase(const Ctx& c) {
    const Args& a = *c.a; const int gw = c.wg * 8 + c.wave, nw = c.G * 8, lane = c.lane;
    const float* modv = (const float*)(a.ws + WS_MOD) + (size_t)1 * 3 * 12288 + 5 * 2048;
    const bf16_t* Y = (const bf16_t*)(a.ws + WS_GATH); const int* dest = (const int*)(a.ws + WS_DEST); const float* topw = (const float*)(a.ws + WS_TOPW);
    const float* fw = a.in[I_FNORMW];
    for (int r = gw; r < ML; r += nw) {
        const int b = r >> 14; float* xr = a.out + (size_t)r * D; const float* mg = modv + (size_t)b * 12288;
        const int d0 = dest[2 * r], d1 = dest[2 * r + 1]; const float w0 = topw[2 * r], w1 = topw[2 * r + 1];
        const bf16_t* y0 = Y + (size_t)d0 * D; const bf16_t* y1 = Y + (size_t)d1 * D;
        f32x4 v[8]; float ss = 0.f;
#pragma unroll
        for (int j = 0; j < 8; ++j) { const int cc = (j * 64 + lane) * 4; const f32x4 x = *(const f32x4*)(xr + cc), g = *(const f32x4*)(mg + cc);
            const u32x2 a0 = *(const u32x2*)(y0 + cc), a1 = *(const u32x2*)(y1 + cc);
            f32x4 m; m[0] = w0 * bflo(a0.x) + w1 * bflo(a1.x); m[1] = w0 * bfhi(a0.x) + w1 * bfhi(a1.x); m[2] = w0 * bflo(a0.y) + w1 * bflo(a1.y); m[3] = w0 * bfhi(a0.y) + w1 * bfhi(a1.y);
            v[j] = x + g * m; ss += v[j][0] * v[j][0] + v[j][1] * v[j][1] + v[j][2] * v[j][2] + v[j][3] * v[j][3]; }
        ss = wave_sum(ss); const float rstd = rsqrtf(ss * (1.0f / 2048.0f) + EPS);
#pragma unroll
        for (int j = 0; j < 8; ++j) { const int cc = (j * 64 + lane) * 4; const f32x4 w = *(const f32x4*)(fw + cc); *(f32x4*)(xr + cc) = v[j] * rstd * w; }
    }
}

#ifndef N_LAUNCHES
#define N_LAUNCHES 1
#endif
constexpr int N_PHASES = 23;

template <int L>
__device__ __forceinline__ void gemm_proj(const Ctx& c) {
    const Args& a = *c.a;
    pg8::Gemm g{(const bf16_t*)(a.ws + WS_H), (const bf16_t*)(a.ws + WS_WIN + (size_t)L * WIN_BYTES), MT, NPROJ, D};
    pg8::StaticOrder S; S.init(MT, NPROJ, c.G, c.wg);
    pg8::EpiProj E{(bf16_t*)(a.ws + WS_PMIX), (bf16_t*)(a.ws + WS_PGATE)};
    pg8::gemm_phase<pg8::EpiProj, pg8::StaticOrder, true, true>(c.lds + LDS_SCR, g, S, E);
}
template <int L>
__device__ __forceinline__ void gemm_upgate(const Ctx& c) {
    const Args& a = *c.a; constexpr int M = (L == 0) ? MT : ML;
    pg8::Gemm g{(const bf16_t*)(a.ws + WS_H), (const bf16_t*)(a.ws + WS_WUP + (size_t)L * 8388608), M, 2048, 512};
    pg8::UpGateOrder S; S.init(M, c.G, c.wg, MT / 256);
    pg8::EpiUpGate E{(const bf16_t*)(a.ws + WS_PGATE), (float*)(a.ws + WS_MACC), (bf16_t*)(a.ws + WS_MERGED), MT / 256};
    pg8::gemm_phase<pg8::EpiUpGate, pg8::UpGateOrder, true, true>(c.lds + LDS_SCR, g, S, E);
}
template <int L>
__device__ __forceinline__ void gemm_wout(const Ctx& c) {
    const Args& a = *c.a; constexpr int M = (L == 0) ? MT : ML;
    pg8::Gemm g{(const bf16_t*)(a.ws + WS_MERGED), (const bf16_t*)(a.ws + WS_WOUT + (size_t)L * 8388608), M, D, D};
    pg8::StaticOrder S; S.init(M, D, c.G, c.wg);
    const float* modv = (const float*)(a.ws + WS_MOD) + (size_t)L * 3 * 12288 + 2 * 2048;
    pg8::EpiResid E{L == 0 ? a.in[I_X] : (const float*)a.out, a.out, L == 0 ? a.in[I_CTX] : (const float*)(a.ws + WS_XC), (float*)(a.ws + WS_XC), modv, L == 1 ? 1 : 0};
    pg8::gemm_phase<pg8::EpiResid, pg8::StaticOrder, true, true>(c.lds + LDS_SCR, g, S, E);
}
__device__ __forceinline__ void gemm_ffn13(const Ctx& c) {
    const Args& a = *c.a;
    pg8::Gemm g{(const bf16_t*)(a.ws + WS_H), (const bf16_t*)(a.ws + WS_F13), MT, 2 * FF, D};
    pg8::StaticOrder S; S.init(MT, 2 * FF, c.G, c.wg);
    pg8::EpiSwiglu E{(bf16_t*)(a.ws + WS_HID), 2 * FF / 256};
    pg8::gemm_phase<pg8::EpiSwiglu, pg8::StaticOrder, true, true>(c.lds + LDS_SCR, g, S, E);
}
__device__ __forceinline__ void gemm_ffn2(const Ctx& c) {
    const Args& a = *c.a;
    pg8::Gemm g{(const bf16_t*)(a.ws + WS_HID), (const bf16_t*)(a.ws + WS_F2), MT, D, FF};
    pg8::StaticOrder S; S.init(MT, D, c.G, c.wg);
    const float* modv = (const float*)(a.ws + WS_MOD) + (size_t)0 * 3 * 12288 + 5 * 2048;
    pg8::EpiResid E{(const float*)a.out, a.out, (const float*)(a.ws + WS_XC), (float*)(a.ws + WS_XC), modv, 0};
    pg8::gemm_phase<pg8::EpiResid, pg8::StaticOrder, true, true>(c.lds + LDS_SCR, g, S, E);
}
__device__ __forceinline__ void gemm_moe13(const Ctx& c) {
    const Args& a = *c.a; const int* meta = (const int*)(a.ws + WS_CTL + CTL_META);
    int be[8];
#pragma unroll
    for (int e = 0; e < 8; ++e) be[e] = __builtin_amdgcn_readfirstlane(meta[e]);
    pg8::Gemm g{(const bf16_t*)(a.ws + WS_GATH), (const bf16_t*)(a.ws + WS_M13), MOE_ROWS, 2 * FF, D};
    pg8::MoeOrder S; S.init(be[7], 2 * FF / 256, c.G, c.wg, be);
    pg8::EpiSwiglu E{(bf16_t*)(a.ws + WS_HIDM), 2 * FF / 256};
    pg8::gemm_phase<pg8::EpiSwiglu, pg8::MoeOrder, true, true>(c.lds + LDS_SCR, g, S, E);
}
__device__ __forceinline__ void gemm_moe2(const Ctx& c) {
    const Args& a = *c.a; const int* meta = (const int*)(a.ws + WS_CTL + CTL_META);
    int be[8];
#pragma unroll
    for (int e = 0; e < 8; ++e) be[e] = __builtin_amdgcn_readfirstlane(meta[e]);
    pg8::Gemm g{(const bf16_t*)(a.ws + WS_HIDM), (const bf16_t*)(a.ws + WS_M2), MOE_ROWS, D, FF};
    pg8::MoeOrder S; S.init(be[7], D / 256, c.G, c.wg, be);
    pg8::EpiPlainBf16 E{(bf16_t*)(a.ws + WS_GATH), D, D / 256};
    pg8::gemm_phase<pg8::EpiPlainBf16, pg8::MoeOrder, true, true>(c.lds + LDS_SCR, g, S, E);
}

__device__ __forceinline__ void prologue_phase(const Ctx& c) {
    const Args& a = *c.a; int rot = 0;
    mod_phase(c);
    for (int l = 0; l < 2; ++l) {
        conv_job<1>(c, a.in[I_WIN] + (size_t)l * D * DIN, nullptr, DIN, D, NPROJ, (bf16_t*)(a.ws + WS_WIN + (size_t)l * WIN_BYTES), rot);
        for (int b = 0; b < 4; ++b) conv_job<0>(c, a.in[I_WUP] + (size_t)(l * 4 + b) * 512 * D, nullptr, D, 512, D, (bf16_t*)(a.ws + WS_WUP + (size_t)l * 8388608 + (size_t)b * 2048 * 512 * 2), rot);
        conv_job<0>(c, a.in[I_WOUT] + (size_t)l * D * D, nullptr, D, D, D, (bf16_t*)(a.ws + WS_WOUT + (size_t)l * 8388608), rot);
    }
    conv_job<2>(c, a.in[I_F1], a.in[I_F3], FF, D, 2 * FF, (bf16_t*)(a.ws + WS_F13), rot);
    conv_job<0>(c, a.in[I_F2], nullptr, D, FF, D, (bf16_t*)(a.ws + WS_F2), rot);
}
__device__ __forceinline__ void moeconv_phase(const Ctx& c) {
    const Args& a = *c.a; int rot = 0;
    for (int e = 0; e < 8; ++e) {
        conv_job<2>(c, a.in[I_M1] + (size_t)e * D * FF, a.in[I_M3] + (size_t)e * D * FF, FF, D, 2 * FF, (bf16_t*)(a.ws + WS_M13 + (size_t)e * 46137344), rot);
        conv_job<0>(c, a.in[I_M2] + (size_t)e * FF * D, nullptr, D, FF, D, (bf16_t*)(a.ws + WS_M2 + (size_t)e * 23068672), rot);
    }
}

__global__ void __launch_bounds__(512, 2) fwd_kernel(Args args) {
    extern __shared__ __attribute__((aligned(16))) unsigned char lds_raw[];
    Ctx c; c.a = &args; c.lds = (LAS unsigned char*)lds_raw; c.tid = threadIdx.x; c.lane = c.tid & 63; c.wave = __builtin_amdgcn_readfirstlane(c.tid >> 6); c.wg = blockIdx.x; c.G = gridDim.x;
    volatile LAS unsigned* misc = (volatile LAS unsigned*)(c.lds + LDS_MISC);
    if (c.tid < 16) misc[c.tid] = 0u;
    __syncthreads();
    const int lo = args.ph_lo, hi = args.ph_hi;
    XcdBarrier bar; bar.bar = (unsigned*)(args.ws + WS_CTL + CTL_BAR); bar.x = 0; bar.st = misc;
    if (hi - lo > 1) bar = xcd_barrier_post((unsigned*)(args.ws + WS_CTL + CTL_BAR), misc);
#define IN(k) (lo <= (k) && (k) < hi)
#define SEAM(k) do { if (IN(k) && IN((k) + 1)) xcd_barrier(bar); } while (0)
    if (IN(0)) { prologue_phase(c); } SEAM(0);
    if (IN(1)) { norm_phase<0, 0>(c); } SEAM(1);
    if (IN(2)) { gemm_proj<0>(c); } SEAM(2);
    if (IN(3)) { rgprep_phase<0>(c); } SEAM(3);
    if (IN(4)) { chains_phase<0>(c); } SEAM(4);
    if (IN(5)) { combine_phase<0>(c); } SEAM(5);
    if (IN(6)) { gemm_upgate<0>(c); } SEAM(6);
    if (IN(7)) { gemm_wout<0>(c); } SEAM(7);
    if (IN(8)) { norm_phase<0, 1>(c); } SEAM(8);
    if (IN(9)) { gemm_ffn13(c); } SEAM(9);
    if (IN(10)) { gemm_ffn2(c); } SEAM(10);
    if (IN(11)) { norm_phase<1, 0>(c); } SEAM(11);
    if (IN(12)) { gemm_proj<1>(c); } SEAM(12);
    if (IN(13)) { rgprep_phase<1>(c); } SEAM(13);
    if (IN(14)) { chains_phase<1>(c); } SEAM(14);
    if (IN(15)) { combine_phase<1>(c); } SEAM(15);
    if (IN(16)) { gemm_upgate<1>(c); } SEAM(16);
    if (IN(17)) { gemm_wout<1>(c); } SEAM(17);
    if (IN(18)) { route1_phase(c); __syncthreads(); moeconv_phase(c); } SEAM(18);
    if (IN(19)) { route2_phase(c); } SEAM(19);
    if (IN(20)) { gemm_moe13(c); } SEAM(20);
    if (IN(21)) { gemm_moe2(c); } SEAM(21);
    if (IN(22)) { final_phase(c); }
#undef IN
#undef SEAM
}

extern "C" void kernel_launch(void* const* d_in, const int* in_sizes, int n_in, void* d_out, int out_size, void* d_ws, size_t ws_size, hipStream_t stream) {
    static int grid = 0;
    if (grid == 0) {
        if (n_in != N_IN || out_size != ML * D || ws_size < WS_END) { fprintf(stderr, "kernel_launch: unexpected shapes: n_in %d out %d ws %zu (need %zu)\n", n_in, out_size, ws_size, (size_t)WS_END); grid = -1; return; }
        int dev = 0, cus = 0;
        if (hipGetDevice(&dev) != hipSuccess || hipDeviceGetAttribute(&cus, hipDeviceAttributeMultiprocessorCount, dev) != hipSuccess) { grid = -1; return; }
        if (hipFuncSetAttribute((const void*)fwd_kernel, hipFuncAttributeMaxDynamicSharedMemorySize, LDS_BYTES) != hipSuccess) { fprintf(stderr, "kernel_launch: hipFuncSetAttribute failed\n"); grid = -1; return; }
        int per_cu = 0;
        if (hipOccupancyMaxActiveBlocksPerMultiprocessor(&per_cu, (const void*)fwd_kernel, 512, LDS_BYTES) != hipSuccess || per_cu < 1) { fprintf(stderr, "kernel_launch: occupancy query says %d\n", per_cu); }
        (void)hipGetLastError();
        grid = cus > 256 ? 256 : cus;
    }
    if (grid < 0) return;
    (void)hipMemsetAsync((char*)d_ws + WS_CTL, 0, CTL_BYTES, stream);
    Args a{};
    for (int i = 0; i < N_IN; ++i) a.in[i] = (const float*)d_in[i];
    a.out = (float*)d_out; a.ws = (unsigned char*)d_ws;
#if N_LAUNCHES == 1
    a.ph_lo = 0; a.ph_hi = N_PHASES;
    hipLaunchKernelGGL(fwd_kernel, dim3(grid), dim3(512), LDS_BYTES, stream, a);
#else
    for (int p = 0; p < N_PHASES; ++p) { a.ph_lo = p; a.ph_hi = p + 1; hipLaunchKernelGGL(fwd_kernel, dim3(grid), dim3(512), LDS_BYTES, stream, a); }
#endif
}
```

```cpp
#include <hip/hip_runtime.h>
#include <cstdio>
#include <cstdint>
#define N_LAUNCHES 1
namespace pg8 {
#define PG8_LAS __attribute__((address_space(3)))
typedef unsigned short bf16_t;
typedef short bf16x8 __attribute__((ext_vector_type(8)));
typedef float f32x4 __attribute__((ext_vector_type(4)));
typedef unsigned u32x4 __attribute__((ext_vector_type(4)));
constexpr int BM = 256, BK = 64, HALF = 128, HTB = HALF * BK * 2  , STAGE_BYTES = 8 * HTB, NXCD = 8, WGM = 8;

__host__ __device__ __forceinline__ int lds_byte(int r, int c) { const int st = (r >> 4) * 2 + (c >> 5), rr = r & 15, cc = c & 31, ob = rr * 64 + cc * 2; return st * 1024 + (ob ^ (((ob >> 9) & 1) << 5)); }
__host__ __device__ __forceinline__ void stage_rc(int b, int& R, int& C) { const int st = b / 1024, sb = b % 1024, swz = sb ^ (((sb >> 9) & 1) << 5); R = (st >> 1) * 16 + swz / 64; C = (st & 1) * 32 + (swz % 64) / 2; }
__host__ __device__ __forceinline__ int perm32(int rho) { const int n = rho >> 4, i = rho & 15; return 8 * (i >> 2) + 4 * n + (i & 3); }

struct Unit { int pm, pn; };
struct Gemm { const bf16_t* A; const bf16_t* Bt; int M, N, K; };

struct StaticOrder {
    int nM, nN, nwg, G, c;
    __host__ __device__ void init(int M, int N, int G_, int c_) { nM = M / BM; nN = N / BM; nwg = nM * nN; G = G_; c = c_; }
    __host__ __device__ bool next(int i, Unit& u) const {
        const long L = (long)i * G + c; if (L >= nwg) return false;
        int wgid = (int)L; { const int q = nwg / NXCD, r = nwg % NXCD, xcd = wgid % NXCD, off = wgid / NXCD; wgid = (xcd < r ? xcd * (q + 1) : r * (q + 1) + (xcd - r) * q) + off; }
        const int nig = WGM * nN, gid = wgid / nig, fm = gid * WGM, gsz = (nM - fm) < WGM ? (nM - fm) : WGM;
        u.pm = fm + ((wgid % nig) % gsz); u.pn = (wgid % nig) / gsz; return true;
    }
    __device__ __forceinline__ void a_ready(const Unit&) const {}
    __device__ __forceinline__ void done(const Unit&) const {}
};
__device__ __forceinline__ unsigned cvt_pk_bf16(float lo, float hi) { unsigned r; asm volatile("v_cvt_pk_bf16_f32 %0, %1, %2" : "=v"(r) : "v"(lo), "v"(hi)); return r; }
typedef __bf16 bf16x2_t __attribute__((ext_vector_type(2)));
typedef float f32x2c_t __attribute__((ext_vector_type(2)));
__device__ __forceinline__ unsigned cvt_pk_bf16_safe(float lo, float hi) { const f32x2c_t v = {lo, hi}; return __builtin_bit_cast(unsigned, __builtin_convertvector(v, bf16x2_t)); }
template <class Epi, class Sched, bool ALIGN_EPI = false, bool SP2 = false>
__device__ __forceinline__ void gemm_phase(PG8_LAS unsigned char* lds, const Gemm g, const Sched& S, const Epi& E) {
    int tid_ = threadIdx.x; asm volatile("" : "+v"(tid_));
    const int tid = tid_, wid = __builtin_amdgcn_readfirstlane(tid >> 6), lane = tid & 63, wr = wid >> 2, wc = wid & 3, fr = lane & 15, fq = lane >> 4;
    const int K = g.K, nt = K / BK;
    unsigned voffA[2], voffB[2];
#pragma unroll
    for (int i = 0; i < 2; ++i) { int R, C; stage_rc(tid * 16 + i * 8192, R, C); const int Rb = Epi::PERM ? ((R & ~31) + perm32(R & 31)) : R;
        voffA[i] = (unsigned)(R * K + C) * 2u; voffB[i] = (unsigned)(Rb * K + C) * 2u; }
    const size_t kstep = (size_t)(BK * 2);
    const size_t hstep = (size_t)HALF * K * 2;
    const size_t tstep = 2 * hstep;
    const unsigned ldsw = (unsigned)wid * 1024u;
    const int aoff = lds_byte(wr * 64 + fr, fq * 8), boff = lds_byte(wc * 32 + fr, fq * 8);
#define PG8_SA(b, h) (((b) * 2 + (h)) * HTB)
#define PG8_SB(b, h) ((4 + (b) * 2 + (h)) * HTB)
#define PG8_STAGE(bufoff, gbase, voff) do { _Pragma("unroll") for (int _i = 0; _i < 2; ++_i) \
        __builtin_amdgcn_global_load_lds((const unsigned*)((const char*)(gbase) + (voff)[_i]), (PG8_LAS unsigned*)(lds + (bufoff) + ldsw + _i * 8192), 16, 0, 0); } while (0)
#define PG8_LDA(dst, b, h) do { _Pragma("unroll") for (int m = 0; m < 4; ++m) _Pragma("unroll") for (int k = 0; k < 2; ++k) dst[m][k] = *(const PG8_LAS bf16x8*)(lds + PG8_SA(b, h) + aoff + m * 2048 + k * 1024); } while (0)
#define PG8_LDB(dst, b, h) do { _Pragma("unroll") for (int n = 0; n < 2; ++n) _Pragma("unroll") for (int k = 0; k < 2; ++k) dst[n][k] = *(const PG8_LAS bf16x8*)(lds + PG8_SB(b, h) + boff + n * 2048 + k * 1024); } while (0)
#define PG8_MMA(ai, bj, At, Bt) do { __builtin_amdgcn_s_setprio(1); _Pragma("unroll") for (int m = 0; m < 4; ++m) _Pragma("unroll") for (int n = 0; n < 2; ++n) _Pragma("unroll") for (int k = 0; k < 2; ++k) \
        acc[ai][bj][m][n] = __builtin_amdgcn_mfma_f32_16x16x32_bf16(Bt[n][k], At[m][k], acc[ai][bj][m][n], 0, 0, 0); __builtin_amdgcn_s_setprio(0); } while (0)
#define PG8_WAIT_V(n) asm volatile("s_waitcnt vmcnt(" #n ")" ::: "memory")
#define PG8_WAIT_L(n) asm volatile("s_waitcnt lgkmcnt(" #n ")" ::: "memory")
#define PG8_BAR __builtin_amdgcn_s_barrier()
#define PG8_SCHED __builtin_amdgcn_sched_barrier(0)
    Unit cur, nxt; int ui = 0;
    if (!S.next(0, cur)) return;
    f32x4 acc[2][2][4][2];
#pragma unroll
    for (int a = 0; a < 2; ++a)
#pragma unroll
        for (int b = 0; b < 2; ++b)
#pragma unroll
            for (int m = 0; m < 4; ++m)
#pragma unroll
                for (int n = 0; n < 2; ++n) acc[a][b][m][n] = (f32x4){0.f, 0.f, 0.f, 0.f};
    bf16x8 At[4][2], B0[2][2], B1[2][2];
    const char* cA = (const char*)g.A + (size_t)cur.pm * tstep; const char* cB = (const char*)g.Bt + (size_t)cur.pn * tstep;
    S.a_ready(cur);
    if constexpr (SP2) {
        PG8_STAGE(PG8_SB(0, 0), cB, voffB); PG8_STAGE(PG8_SB(0, 1), cB + hstep, voffB); PG8_STAGE(PG8_SA(0, 0), cA, voffA); PG8_STAGE(PG8_SA(0, 1), cA + hstep, voffA);
        if (wr == 1) PG8_BAR;
        PG8_WAIT_V(2); PG8_BAR;
        PG8_STAGE(PG8_SB(1, 0), cB + kstep, voffB); PG8_STAGE(PG8_SA(1, 0), cA + kstep, voffA); PG8_STAGE(PG8_SB(1, 1), cB + hstep + kstep, voffB);
        PG8_WAIT_V(6); PG8_BAR;
    } else {
        PG8_STAGE(PG8_SB(0, 0), cB, voffB); PG8_STAGE(PG8_SA(0, 0), cA, voffA); PG8_STAGE(PG8_SB(0, 1), cB + hstep, voffB); PG8_STAGE(PG8_SA(0, 1), cA + hstep, voffA);
        if (wr == 1) PG8_BAR;
        PG8_WAIT_V(4); PG8_BAR;
        PG8_STAGE(PG8_SB(1, 0), cB + kstep, voffB); PG8_STAGE(PG8_SA(1, 0), cA + kstep, voffA); PG8_STAGE(PG8_SB(1, 1), cB + hstep + kstep, voffB);
        PG8_WAIT_V(6); PG8_BAR;
    }
    for (;;) {
        const bool has_next = S.next(ui + 1, nxt);
        const char* nA = has_next ? (const char*)g.A + (size_t)nxt.pm * tstep : cA; const char* nB = has_next ? (const char*)g.Bt + (size_t)nxt.pn * tstep : cB;
        for (int t = 0; t < nt; t += 2) {
            const bool last = (t == nt - 2);
            const char* a1 = cA + (size_t)(t + 1) * kstep;
            const char* a2 = last ? nA : cA + (size_t)(t + 2) * kstep; const char* b2 = last ? nB : cB + (size_t)(t + 2) * kstep;
            const char* a3 = a2 + kstep; const char* b3 = b2 + kstep;
            if (last && has_next) S.a_ready(nxt);
            if constexpr (SP2) {
            PG8_LDB(B0, 0, 0); PG8_LDB(B1, 0, 1); PG8_SCHED; PG8_LDA(At, 0, 0); PG8_STAGE(PG8_SA(1, 1), a1 + hstep, voffA);
            PG8_WAIT_V(8); PG8_WAIT_L(0); PG8_BAR; PG8_MMA(0, 0, At, B0); PG8_MMA(0, 1, At, B1); PG8_BAR; PG8_SCHED;
            PG8_LDA(At, 0, 1); PG8_STAGE(PG8_SB(0, 0), b2, voffB); PG8_STAGE(PG8_SB(0, 1), b2 + hstep, voffB); PG8_STAGE(PG8_SA(0, 0), a2, voffA);
            PG8_WAIT_V(8); PG8_WAIT_L(0); PG8_BAR; PG8_MMA(1, 0, At, B0); PG8_MMA(1, 1, At, B1); PG8_BAR; PG8_SCHED;
            PG8_LDB(B0, 1, 0); PG8_LDB(B1, 1, 1); PG8_SCHED; PG8_LDA(At, 1, 0); PG8_STAGE(PG8_SA(0, 1), a2 + hstep, voffA);
            PG8_WAIT_V(8); PG8_WAIT_L(0); PG8_BAR; PG8_MMA(0, 0, At, B0); PG8_MMA(0, 1, At, B1); PG8_BAR; PG8_SCHED;
            PG8_LDA(At, 1, 1); PG8_STAGE(PG8_SB(1, 0), b3, voffB); PG8_STAGE(PG8_SB(1, 1), b3 + hstep, voffB); PG8_STAGE(PG8_SA(1, 0), a3, voffA);
            PG8_WAIT_V(8); PG8_WAIT_L(0); PG8_BAR; PG8_MMA(1, 0, At, B0); PG8_MMA(1, 1, At, B1); PG8_BAR; PG8_SCHED;
            } else {
            PG8_LDB(B0, 0, 0); PG8_SCHED; PG8_LDA(At, 0, 0); PG8_STAGE(PG8_SA(1, 1), a1 + hstep, voffA);
            PG8_WAIT_L(8); PG8_BAR; PG8_WAIT_L(0); PG8_MMA(0, 0, At, B0); PG8_BAR; PG8_SCHED;
            PG8_LDB(B1, 0, 1); PG8_STAGE(PG8_SB(0, 0), b2, voffB);
            PG8_BAR; PG8_WAIT_L(0); PG8_MMA(0, 1, At, B1); PG8_BAR;
            PG8_LDA(At, 0, 1); PG8_STAGE(PG8_SA(0, 0), a2, voffA);
            PG8_BAR; PG8_WAIT_L(0); PG8_MMA(1, 0, At, B0); PG8_BAR; PG8_SCHED;
            PG8_STAGE(PG8_SB(0, 1), b2 + hstep, voffB);
            PG8_WAIT_V(6); PG8_BAR; PG8_MMA(1, 1, At, B1); PG8_BAR;
            PG8_LDB(B0, 1, 0); PG8_SCHED; PG8_LDA(At, 1, 0); PG8_STAGE(PG8_SA(0, 1), a2 + hstep, voffA);
            PG8_WAIT_L(8); PG8_BAR; PG8_WAIT_L(0); PG8_MMA(0, 0, At, B0); PG8_BAR; PG8_SCHED;
            PG8_LDB(B1, 1, 1); PG8_STAGE(PG8_SB(1, 0), b3, voffB);
            PG8_BAR; PG8_WAIT_L(0); PG8_MMA(0, 1, At, B1); PG8_BAR;
            PG8_LDA(At, 1, 1); PG8_STAGE(PG8_SA(1, 0), a3, voffA);
            PG8_BAR; PG8_WAIT_L(0); PG8_MMA(1, 0, At, B0); PG8_BAR; PG8_SCHED;
            PG8_STAGE(PG8_SB(1, 1), b3 + hstep, voffB);
            PG8_WAIT_V(6); PG8_BAR; PG8_MMA(1, 1, At, B1); PG8_BAR;
            }
        }
        if constexpr (ALIGN_EPI) { if (wr == 0) PG8_BAR; }
        if constexpr (!Epi::AFTER_DRAIN) { E(acc, cur, wr, wc, fr, fq); S.done(cur); }
        if (!has_next) break;
#pragma unroll
        for (int a = 0; a < 2; ++a)
#pragma unroll
            for (int b = 0; b < 2; ++b)
#pragma unroll
                for (int m = 0; m < 4; ++m)
#pragma unroll
                    for (int n = 0; n < 2; ++n) acc[a][b][m][n] = (f32x4){0.f, 0.f, 0.f, 0.f};
        cur = nxt; cA = nA; cB = nB; ++ui;
        if constexpr (ALIGN_EPI) { if (wr == 1) PG8_BAR; }
    }
    PG8_WAIT_V(0);
    if constexpr (!ALIGN_EPI) { if (wr == 0) PG8_BAR; }
    PG8_BAR;
    if constexpr (Epi::AFTER_DRAIN) { E.fused(acc, cur, wr, wc, fr, fq, lds, wid, lane); S.done(cur); }
#undef PG8_SA
#undef PG8_SB
#undef PG8_STAGE
#undef PG8_LDA
#undef PG8_LDB
#undef PG8_MMA
#undef PG8_WAIT_V
#undef PG8_WAIT_L
#undef PG8_BAR
#undef PG8_SCHED
}
}
#define XB_TMO      128
#define XB_XCNT(j)  (256  + 64 * (j))
#define XB_XSUB(j)  (1280 + 64 * (j))
#define XB_XGEN(j)  (2304 + 64 * (j))
#define XB_TOP      3328
#define XB_TOPGEN   3392
#define XCD_BAR_WORDS 3456
#define XB_SPIN_CAP (1u << 18)
#define LAS __attribute__((address_space(3)))

__device__ __forceinline__ unsigned xb_ld(unsigned* p)              { return __hip_atomic_load(p, __ATOMIC_RELAXED, __HIP_MEMORY_SCOPE_AGENT); }
__device__ __forceinline__ unsigned xb_add(unsigned* p, unsigned v) { return __hip_atomic_fetch_add(p, v, __ATOMIC_RELAXED, __HIP_MEMORY_SCOPE_AGENT); }
__device__ __forceinline__ unsigned xb_xcc_id() { return (unsigned)__builtin_amdgcn_s_getreg((3 << 11) | 20) & 0xFu; }
#define XB_SPIN(cond, bar) do { unsigned _sp = 0; while (cond) { __builtin_amdgcn_s_sleep(1); \
    if ((++_sp & 255u) == 0u) { if (xb_ld(&(bar)[XB_TMO])) break; if (_sp > XB_SPIN_CAP) { atomicAdd(&(bar)[XB_TMO], 1u); break; } } } } while (0)

struct XcdBarrier {
    unsigned* bar; unsigned x;
    volatile LAS unsigned* st;
};

__device__ __forceinline__ XcdBarrier xcd_barrier_post(unsigned* bar, volatile LAS unsigned* st) {
    XcdBarrier b; b.bar = bar; b.x = xb_xcc_id(); b.st = st;
    if (threadIdx.x == 0) (void)xb_add(&bar[XB_XCNT(b.x)], 1u);
    return b;
}
__device__ __forceinline__ void xcd_barrier_complete(unsigned* bar, unsigned x, unsigned& nloc, unsigned& nx) {
    const unsigned G = gridDim.x * gridDim.y * gridDim.z;
    unsigned sum, cnt, mine, sp = 0u;
    for (;;) {
        sum = 0u; cnt = 0u; mine = 0u;
#pragma unroll
        for (unsigned j = 0; j < 16; ++j) { const unsigned c = xb_ld(&bar[XB_XCNT(j)]); sum += c; cnt += (c > 0u) ? 1u : 0u; mine = (j == x) ? c : mine; }
        if (sum == G) break;
        __builtin_amdgcn_s_sleep(1);
        if ((++sp & 255u) == 0u) { if (xb_ld(&bar[XB_TMO])) break; if (sp > XB_SPIN_CAP) { atomicAdd(&bar[XB_TMO], 1u); break; } }
    }
    nloc = mine > 0u ? mine : 1u; nx = cnt > 0u ? cnt : 1u;
}

__device__ __forceinline__ void xcd_barrier(const XcdBarrier& b) {
    asm volatile("s_waitcnt vmcnt(0)" ::: "memory");
    __syncthreads();
    if (threadIdx.x == 0) {
        unsigned* bar = b.bar;
        __builtin_amdgcn_s_waitcnt(0);
        unsigned nloc = b.st[0], nx = b.st[1];
        if (nloc == 0u) { xcd_barrier_complete(bar, b.x, nloc, nx); b.st[0] = nloc; b.st[1] = nx; }
        const unsigned old = xb_add(&bar[XB_XSUB(b.x)], 1u);
        const unsigned gen = old / nloc;
        if (old + 1u == (gen + 1u) * nloc) {
            __builtin_amdgcn_fence(__ATOMIC_RELEASE, "agent");
            asm volatile("s_waitcnt vmcnt(0)" ::: "memory");
            const unsigned og = xb_add(&bar[XB_TOP], 1u);
            const unsigned tg = og / nx;
            if (og + 1u == (tg + 1u) * nx) xb_add(&bar[XB_TOPGEN], 1u);
            else XB_SPIN(xb_ld(&bar[XB_TOPGEN]) == tg, bar);
            __builtin_amdgcn_fence(__ATOMIC_ACQUIRE, "agent");
            xb_add(&bar[XB_XGEN(b.x)], 1u);
            asm volatile("s_waitcnt vmcnt(0)" ::: "memory");
        } else {
            XB_SPIN(xb_ld(&bar[XB_XGEN(b.x)]) == gen, bar);
            __builtin_amdgcn_fence(__ATOMIC_ACQUIRE, "agent");
            asm volatile("s_waitcnt vmcnt(0)" ::: "memory");
        }
    }
    __syncthreads();
}


typedef pg8::bf16_t bf16_t;
typedef pg8::f32x4 f32x4;
typedef pg8::u32x4 u32x4;
typedef unsigned u32x2 __attribute__((ext_vector_type(2)));

constexpr int D = 2048, NB = 2, T = 16384, CL = 256;
constexpr int ML = NB * T;
constexpr int MC = NB * CL;
constexpr int MT = ML + MC;
constexpr int NMIX = 7216, NMIXP = 7424, NGATE = 8192, NPROJ = NMIXP + NGATE;
constexpr int DIN = 15408;
constexpr int FF = 5632, NE = 8;
constexpr int MOE_ROWS = 67584;
constexpr int C_GLA_Q = 0, C_GLA_K = 256, C_GLA_V = 512, C_GLA_G = 1024, C_GLA_A = 1536;
constexpr int C_HG_Q = 1568, C_HG_F = 2080, C_HG_I = 3104, C_HG_G = 3616;
constexpr int C_DN_Q = 4128, C_DN_K = 4640, C_DN_V = 5152, C_DN_A = 5664, C_DN_B = 5672, C_DN_G = 5680;
constexpr int C_RG_X = 6192, C_RG_Y = 6704;
constexpr float EPS = 1e-6f;

enum { I_X = 0, I_C, I_CTX, I_CCTX, I_WMOD, I_BMOD, I_NORMW, I_FNORMW, I_WIN, I_WUP, I_WOUT, I_GLA_WA2, I_GLA_BA2, I_GLA_NW, I_HG_LB, I_HG_NW,
       I_DN_CW, I_DN_ALOG, I_DN_DTB, I_DN_NW, I_RG_CW, I_RG_CB, I_RG_WR, I_RG_BR, I_RG_WI, I_RG_BI, I_RG_LAM, I_F1, I_F3, I_F2, I_ROUTER, I_M1, I_M3, I_M2, N_IN };

constexpr size_t WS_CTL = 0, CTL_BYTES = 65536;
constexpr size_t CTL_BAR = 0, CTL_WGH = 16384, CTL_META = 24576;
constexpr size_t WS_MOD = WS_CTL + CTL_BYTES;
constexpr size_t WS_XC = WS_MOD + 294912;
constexpr size_t WS_TOPI = WS_XC + 4194304;
constexpr size_t WS_TOPW = WS_TOPI + 131072;
constexpr size_t WS_DEST = WS_TOPW + 262144;
constexpr size_t WIN_BYTES = (size_t)NPROJ * D * 2;
constexpr size_t WS_WIN = WS_DEST + 262144;
constexpr size_t WS_WUP = WS_WIN + 2 * WIN_BYTES;
constexpr size_t WS_WOUT = WS_WUP + 2 * 8388608;
constexpr size_t WS_F13 = WS_WOUT + 2 * 8388608;
constexpr size_t WS_F2 = WS_F13 + 46137344;
constexpr size_t WS_H = WS_F2 + 23068672;
constexpr size_t WS_BIG = WS_H + 136314880;
constexpr size_t WS_PMIX = WS_BIG;
constexpr size_t WS_ORAW = WS_PMIX + 494141440;
constexpr size_t WS_RGLA = WS_ORAW + 272629760;
constexpr size_t WS_RGU = WS_RGLA + 68157440;
constexpr size_t WS_O = WS_RGU + 68157440;
constexpr size_t WS_SCR = WS_O + 136314880;
constexpr size_t SC_GLA_VT = 0, SC_GLA_QP = SC_GLA_VT + 34078720, SC_GLA_KT = SC_GLA_QP + 34078720, SC_GLA_A = SC_GLA_KT + 34078720, SC_GLA_LAM = SC_GLA_A + 34078720;
constexpr size_t SC_HG_VT = SC_GLA_LAM + 1064960, SC_HG_QP = SC_HG_VT + 34078720, SC_HG_KT = SC_HG_QP + 68157440, SC_HG_A = SC_HG_KT + 68157440, SC_HG_LAM = SC_HG_A + 34078720;
constexpr size_t SC_DN_QS = SC_HG_LAM + 2129920, SC_DN_KT = SC_DN_QS + 34078720, SC_DN_UT = SC_DN_KT + 34078720, SC_DN_WN = SC_DN_UT + 68157440, SC_DN_AQK = SC_DN_WN + 68157440, SC_DN_SC = SC_DN_AQK + 34078720;
constexpr size_t SC_END = SC_DN_SC + 4259840;
constexpr size_t WS_PGATE = WS_SCR;
constexpr size_t WS_MACC = WS_PMIX;
constexpr size_t WS_MERGED = WS_PMIX + 272629760;
constexpr size_t WS_HID = WS_BIG;
constexpr size_t WS_M13 = WS_BIG;
constexpr size_t WS_M2 = WS_M13 + 369098752;
constexpr size_t WS_GATH = WS_M2 + 184549376;
constexpr size_t WS_HIDM = WS_GATH + 276824064;
constexpr size_t WS_END_A = WS_HIDM + 761266176, WS_END_B = WS_SCR + (SC_END > 545259520 ? SC_END : 545259520);
constexpr size_t WS_END = WS_END_A > WS_END_B ? WS_END_A : WS_END_B;
static_assert(WS_MERGED + 136314880 <= WS_PMIX + 494141440, "merged fits in pmix region");
static_assert(WS_END <= 2041000000ull, "workspace budget");

constexpr int LDS_SCR = 0;
constexpr int LDS_AUX = 131072;
constexpr int LDS_MISC = 131072 + 8192;
constexpr int LDS_BYTES = 147456;

struct Args { const float* in[N_IN]; float* out; unsigned char* ws; int ph_lo, ph_hi; };

__device__ __forceinline__ float bflo(unsigned w) { return __uint_as_float(w << 16); }
__device__ __forceinline__ float bfhi(unsigned w) { return __uint_as_float(w & 0xffff0000u); }
__device__ __forceinline__ void unpack8(const u32x4 w, float (&f)[8]) { f[0] = bflo(w.x); f[1] = bfhi(w.x); f[2] = bflo(w.y); f[3] = bfhi(w.y); f[4] = bflo(w.z); f[5] = bfhi(w.z); f[6] = bflo(w.w); f[7] = bfhi(w.w); }
typedef __bf16 bfx8_t __attribute__((ext_vector_type(8)));
typedef float f32x8 __attribute__((ext_vector_type(8)));
__device__ __forceinline__ u32x4 pack8(const float (&f)[8]) { f32x8 v;
#pragma unroll
    for (int j = 0; j < 8; ++j) v[j] = f[j];
    return __builtin_bit_cast(u32x4, __builtin_convertvector(v, bfx8_t)); }
__device__ __forceinline__ float bf1(const bf16_t* p) { return __uint_as_float(((unsigned)*p) << 16); }
__device__ __forceinline__ float sigm(float x) { return 1.0f / (1.0f + __expf(-x)); }
__device__ __forceinline__ float siluf(float x) { return x / (1.0f + __expf(-x)); }
__device__ __forceinline__ float softplusf(float x) { return fmaxf(x, 0.f) + log1pf(__expf(-fabsf(x))); }
__device__ __forceinline__ float wave_sum(float v) { v += __shfl_xor(v, 32); v += __shfl_xor(v, 16); v += __shfl_xor(v, 8); v += __shfl_xor(v, 4); v += __shfl_xor(v, 2); v += __shfl_xor(v, 1); return v; }
__device__ __forceinline__ float gelu_tanh(float y) { const float u = 0.7978845608028654f * (y + 0.044715f * y * y * y); const float e = __expf(2.f * u); const float th = 1.f - 2.f / (e + 1.f); return 0.5f * y * (1.f + th); }

namespace pg8 {
template <bool SIG> struct EpiBf16S {
    static constexpr bool PERM = true, AFTER_DRAIN = false;
    bf16_t* O; int ldc;
    __device__ __forceinline__ void operator()(const f32x4 (&acc)[2][2][4][2], const Unit& u, int wr, int wc, int fr, int fq) const {
        const int row0 = u.pm * BM + wr * 64 + fr, col0 = u.pn * BM + wc * 32 + 8 * fq;
#pragma unroll
        for (int ai = 0; ai < 2; ++ai)
#pragma unroll
            for (int m = 0; m < 4; ++m) { bf16_t* rowp = O + (size_t)(row0 + ai * HALF + m * 16) * ldc + col0;
#pragma unroll
                for (int bj = 0; bj < 2; ++bj) { f32x4 v0 = acc[ai][bj][m][0], v1 = acc[ai][bj][m][1];
                    if (SIG) {
#pragma unroll
                        for (int j = 0; j < 4; ++j) { v0[j] = sigm(v0[j]); v1[j] = sigm(v1[j]); } }
                    u32x4 w; w.x = cvt_pk_bf16_safe(v0[0], v0[1]); w.y = cvt_pk_bf16_safe(v0[2], v0[3]); w.z = cvt_pk_bf16_safe(v1[0], v1[1]); w.w = cvt_pk_bf16_safe(v1[2], v1[3]);
                    *(u32x4*)(rowp + bj * HALF) = w; } }
    }
};
struct EpiUpGate {
    static constexpr bool PERM = true, AFTER_DRAIN = false;
    const bf16_t* gate; float* macc; bf16_t* merged; int nMtot;
    __device__ __forceinline__ void operator()(const f32x4 (&acc)[2][2][4][2], const Unit& u, int wr, int wc, int fr, int fq) const {
        const int b = u.pn >> 3, pn = u.pn & 7, pm = u.pm - b * nMtot;
        const int row0 = pm * BM + wr * 64 + fr, col0 = pn * BM + wc * 32 + 8 * fq;
#pragma unroll
        for (int ai = 0; ai < 2; ++ai)
#pragma unroll
            for (int m = 0; m < 4; ++m) { const size_t r = (size_t)(row0 + ai * HALF + m * 16);
#pragma unroll
                for (int bj = 0; bj < 2; ++bj) { const int c = col0 + bj * HALF;
                    const u32x4 gw = *(const u32x4*)(gate + r * NGATE + b * 2048 + c); float g[8]; unpack8(gw, g);
                    f32x4 v0 = acc[ai][bj][m][0], v1 = acc[ai][bj][m][1];
#pragma unroll
                    for (int j = 0; j < 4; ++j) { v0[j] *= g[j]; v1[j] *= g[4 + j]; }
                    float* mp = macc + r * 2048 + c;
                    if (b > 0) { v0 += *(const f32x4*)mp; v1 += *(const f32x4*)(mp + 4); }
                    if (b < 3) { *(f32x4*)mp = v0; *(f32x4*)(mp + 4) = v1; }
                    else { u32x4 w; w.x = cvt_pk_bf16_safe(v0[0], v0[1]); w.y = cvt_pk_bf16_safe(v0[2], v0[3]); w.z = cvt_pk_bf16_safe(v1[0], v1[1]); w.w = cvt_pk_bf16_safe(v1[2], v1[3]);
                           *(u32x4*)(merged + r * 2048 + c) = w; } } }
    }
};
struct EpiResid {
    static constexpr bool PERM = false, AFTER_DRAIN = false;
    const float* srcl; float* dstl; const float* srcc; float* dstc; const float* modv;
    int permute;
    __device__ __forceinline__ void operator()(const f32x4 (&acc)[2][2][4][2], const Unit& u, int wr, int wc, int fr, int fq) const {
        const int row0 = u.pm * BM + wr * 64 + fr, col0 = u.pn * BM + wc * 32 + 4 * fq;
#pragma unroll
        for (int ai = 0; ai < 2; ++ai)
#pragma unroll
            for (int m = 0; m < 4; ++m) { const int r = row0 + ai * HALF + m * 16;
                const float* sp; float* dp; const float* mp;
                if (r < ML) { const int b = r >> 14, s = r & 16383; const int t = permute ? (((s & 255) << 6) | (s >> 8)) : s; const size_t o = ((size_t)(b << 14) + t) * D;
                    sp = srcl + o; dp = dstl + o; mp = modv + b * 12288; }
                else { const size_t o = (size_t)(r - ML) * D; sp = srcc + o; dp = dstc + o; mp = modv + 2 * 12288; }
#pragma unroll
                for (int bj = 0; bj < 2; ++bj)
#pragma unroll
                    for (int n = 0; n < 2; ++n) { const int c = col0 + bj * HALF + n * 16;
                        const f32x4 sv = *(const f32x4*)(sp + c), mv = *(const f32x4*)(mp + c);
                        *(f32x4*)(dp + c) = sv + mv * acc[ai][bj][m][n]; } }
    }
};
struct EpiSwiglu {
    static constexpr bool PERM = true, AFTER_DRAIN = false;
    bf16_t* hid; int nper;
    __device__ __forceinline__ void operator()(const f32x4 (&acc)[2][2][4][2], const Unit& u, int wr, int wc, int fr, int fq) const {
        const int pn = u.pn % nper; const int row0 = u.pm * BM + wr * 64 + fr, col0 = pn * HALF + wc * 32 + 8 * fq;
#pragma unroll
        for (int ai = 0; ai < 2; ++ai)
#pragma unroll
            for (int m = 0; m < 4; ++m) { bf16_t* rowp = hid + (size_t)(row0 + ai * HALF + m * 16) * FF + col0;
                float o[8];
#pragma unroll
                for (int n = 0; n < 2; ++n)
#pragma unroll
                    for (int j = 0; j < 4; ++j) { const float g = acc[ai][0][m][n][j], v = acc[ai][1][m][n][j]; o[n * 4 + j] = siluf(g) * v; }
                u32x4 w; w.x = cvt_pk_bf16_safe(o[0], o[1]); w.y = cvt_pk_bf16_safe(o[2], o[3]); w.z = cvt_pk_bf16_safe(o[4], o[5]); w.w = cvt_pk_bf16_safe(o[6], o[7]);
                *(u32x4*)rowp = w; }
    }
};
struct EpiPlainBf16 {
    static constexpr bool PERM = true, AFTER_DRAIN = false;
    bf16_t* O; int ldc; int nper;
    __device__ __forceinline__ void operator()(const f32x4 (&acc)[2][2][4][2], const Unit& u, int wr, int wc, int fr, int fq) const {
        const int pn = u.pn % nper; const int row0 = u.pm * BM + wr * 64 + fr, col0 = pn * BM + wc * 32 + 8 * fq;
#pragma unroll
        for (int ai = 0; ai < 2; ++ai)
#pragma unroll
            for (int m = 0; m < 4; ++m) { bf16_t* rowp = O + (size_t)(row0 + ai * HALF + m * 16) * ldc + col0;
#pragma unroll
                for (int bj = 0; bj < 2; ++bj) { const f32x4 v0 = acc[ai][bj][m][0], v1 = acc[ai][bj][m][1];
                    u32x4 w; w.x = cvt_pk_bf16_safe(v0[0], v0[1]); w.y = cvt_pk_bf16_safe(v0[2], v0[3]); w.z = cvt_pk_bf16_safe(v1[0], v1[1]); w.w = cvt_pk_bf16_safe(v1[2], v1[3]);
                    *(u32x4*)(rowp + bj * HALF) = w; } }
    }
};
struct UpGateOrder {
    StaticOrder so; int nMtot;
    __device__ void init(int M, int G, int c, int nMtot_) { so.init(M, 2048, G, c); nMtot = nMtot_; }
    __device__ bool next(int i, Unit& u) const { Unit t; if (!so.next(i >> 2, t)) return false; const int b = i & 3; u.pm = b * nMtot + t.pm; u.pn = b * 8 + t.pn; return true; }
    __device__ __forceinline__ void a_ready(const Unit&) const {}
    __device__ __forceinline__ void done(const Unit&) const {}
};
struct MoeOrder {
    StaticOrder so; int be[8]; int nper;
    __device__ void init(int nused, int nper_, int G, int c, const int* be_) { so.init(nused * BM, nper_ * BM, G, c); nper = nper_;
#pragma unroll
        for (int e = 0; e < 8; ++e) be[e] = be_[e]; }
    __device__ bool next(int i, Unit& u) const { Unit t; if (!so.next(i, t)) return false; int e = 0;
#pragma unroll
        for (int j = 0; j < 7; ++j) e += (t.pm >= be[j]) ? 1 : 0;
        u.pm = t.pm; u.pn = e * nper + t.pn; return true; }
    __device__ __forceinline__ void a_ready(const Unit&) const {}
    __device__ __forceinline__ void done(const Unit&) const {}
};
}

__device__ __forceinline__ int lds_add(volatile LAS int* p) { return __hip_atomic_fetch_add((LAS int*)p, 1, __ATOMIC_RELAXED, __HIP_MEMORY_SCOPE_WORKGROUP); }
typedef const __attribute__((address_space(4))) Args* ArgsP;
#define ARGS_REF const __attribute__((address_space(4))) Args&
struct Ctx { ArgsP a; LAS unsigned char* lds; int tid, lane, wave, wg, G; };

__device__ __forceinline__ void conv_tile(const float* src, size_t ldsrc, int nvalid, bf16_t* dst, size_t ldd, LAS float* tile, int tid) {
    const int nn = tid & 63, kk = tid >> 6;
    float v[16];
#pragma unroll
    for (int j = 0; j < 16; ++j) v[j] = (nn < nvalid) ? src[(size_t)(kk + 8 * j) * ldsrc + nn] : 0.f;
#pragma unroll
    for (int j = 0; j < 16; ++j) tile[nn * 129 + kk + 8 * j] = v[j];
    __syncthreads();
    const int lane = tid & 63, w = tid >> 6;
#pragma unroll
    for (int p = 0; p < 8; ++p) { const int n = w + 8 * p; const float a = tile[n * 129 + 2 * lane], b = tile[n * 129 + 2 * lane + 1];
        *(unsigned*)(dst + (size_t)n * ldd + 2 * lane) = pg8::cvt_pk_bf16_safe(a, b); }
    __syncthreads();
}
template <int KIND>
__device__ __forceinline__ void conv_job(const Ctx& c, const float* src, const float* src2, size_t ldsrc, int K, int Nd, bf16_t* dst, int& rot) {
    LAS float* tile = (LAS float*)(c.lds + LDS_SCR);
    const int nkt = K / 128, nnt = Nd / 64, ntile = nkt * nnt;
    int t0 = (c.wg - rot) % c.G; if (t0 < 0) t0 += c.G;
    for (int t = t0; t < ntile; t += c.G) {
        const int nt = t % nnt, kt = t / nnt, n0 = nt * 64, k0 = kt * 128;
        const float* s = src; int c0 = n0, nvalid = 64;
        if (KIND == 1) { if (n0 >= NMIXP) c0 = n0 - (NMIXP - NMIX); else { nvalid = NMIX - n0; nvalid = nvalid < 0 ? 0 : (nvalid > 64 ? 64 : nvalid); } }
        if (KIND == 2) { const int which = (n0 & 255) >> 7; c0 = (n0 >> 8) * 128 + (n0 & 127); s = which ? src2 : src; }
        conv_tile(s + (size_t)k0 * ldsrc + c0, ldsrc, nvalid, dst + (size_t)n0 * K + k0, (size_t)K, tile, c.tid);
    }
    rot = (rot + ntile) % c.G;
}

__device__ __forceinline__ void mod_phase(const Ctx& c) {
    ARGS_REF a = *c.a; const int tid = c.tid;
    LAS float* s = (LAS float*)(c.lds + LDS_SCR);
    LAS float* red = s + 3 * 2048;
    for (int i = tid; i < 3 * 2048; i += 512) { const int r = i >> 11, k = i & 2047; const float cv = (r < 2) ? a.in[I_C][r * 2048 + k] : a.in[I_CCTX][k]; s[i] = siluf(cv); }
    __syncthreads();
    float* modv = (float*)(a.ws + WS_MOD);
    for (int task = c.wg; task < 192; task += c.G) {
        const int l = task / 96, cb = task % 96, cq = tid & 31, kg = tid >> 5;
        const float* w = a.in[I_WMOD] + (size_t)l * 2048 * 12288 + cb * 128 + cq * 4;
        f32x4 a0 = {0.f, 0.f, 0.f, 0.f}, a1 = a0, a2 = a0;
#pragma unroll 8
        for (int k = kg; k < 2048; k += 16) { const f32x4 wv = *(const f32x4*)(w + (size_t)k * 12288); a0 += s[k] * wv; a1 += s[2048 + k] * wv; a2 += s[4096 + k] * wv; }
#pragma unroll
        for (int j = 0; j < 4; ++j) { red[(kg * 3 + 0) * 128 + cq * 4 + j] = a0[j]; red[(kg * 3 + 1) * 128 + cq * 4 + j] = a1[j]; red[(kg * 3 + 2) * 128 + cq * 4 + j] = a2[j]; }
        __syncthreads();
        if (tid < 384) { const int r = tid >> 7, cc = tid & 127; float sum = 0.f;
#pragma unroll
            for (int g = 0; g < 16; ++g) sum += red[(g * 3 + r) * 128 + cc];
            modv[(size_t)(l * 3 + r) * 12288 + cb * 128 + cc] = sum + a.in[I_BMOD][l * 12288 + cb * 128 + cc]; }
        __syncthreads();
    }
}

__device__ __forceinline__ void modnorm_row(f32x4 (&v)[8], const float* nw, const float* shift, const float* scale, int lane) {
    float ss = 0.f;
#pragma unroll
    for (int j = 0; j < 8; ++j) ss += v[j][0] * v[j][0] + v[j][1] * v[j][1] + v[j][2] * v[j][2] + v[j][3] * v[j][3];
    ss = wave_sum(ss);
    const float rstd = rsqrtf(ss * (1.0f / 2048.0f) + EPS);
#pragma unroll
    for (int j = 0; j < 8; ++j) { const int cc = (j * 64 + lane) * 4; const f32x4 w = *(const f32x4*)(nw + cc), sh = *(const f32x4*)(shift + cc), sc = *(const f32x4*)(scale + cc);
        v[j] = (v[j] * rstd * w) * (1.0f + sc) + sh; }
}
__device__ __forceinline__ void store_row_bf16(const f32x4 (&v)[8], bf16_t* hrow, int lane) {
#pragma unroll
    for (int j = 0; j < 8; ++j) { u32x2 w; w.x = pg8::cvt_pk_bf16_safe(v[j][0], v[j][1]); w.y = pg8::cvt_pk_bf16_safe(v[j][2], v[j][3]); *(u32x2*)(hrow + (j * 64 + lane) * 4) = w; }
}
template <int L, int WHICH>
__device__ __forceinline__ void norm_phase(const Ctx& c) {
    ARGS_REF a = *c.a; const int gw = c.wg * 8 + c.wave, nw = c.G * 8, lane = c.lane;
    const float* modv = (const float*)(a.ws + WS_MOD) + (size_t)L * 3 * 12288 + (WHICH ? 3 : 0) * 2048;
    const float* normw = a.in[I_NORMW] + (L * 2 + WHICH) * 2048;
    const float* xc = (const float*)(a.ws + WS_XC);
    bf16_t* H = (bf16_t*)(a.ws + WS_H);
    for (int r = gw; r < MT; r += nw) {
        const float* src; int mr; size_t hrow;
        if (r < ML) { const int b = r >> 14, t = r & 16383; src = ((L == 0 && WHICH == 0) ? a.in[I_X] : (const float*)a.out) + (size_t)r * D; mr = b;
            hrow = (L == 1 && WHICH == 0) ? (size_t)(b << 14) + ((t & 63) << 8) + (t >> 6) : (size_t)r; }
        else { const int rc = r - ML; src = ((L == 0 && WHICH == 0) ? a.in[I_CTX] : xc) + (size_t)rc * D; mr = 2; hrow = r; }
        f32x4 v[8];
#pragma unroll
        for (int j = 0; j < 8; ++j) v[j] = *(const f32x4*)(src + (j * 64 + lane) * 4);
        const float* shift = modv + (size_t)mr * 12288;
        modnorm_row(v, normw, shift, shift + 2048, lane);
        store_row_bf16(v, H + hrow * D, lane);
    }
}

template <int L>
__device__ __forceinline__ void rgprep_item(const Ctx& c, int item) {
    ARGS_REF a = *c.a; const int tid = c.tid;
    LAS float* xbT = (LAS float*)(c.lds + LDS_SCR);
    const bf16_t* PM = (const bf16_t*)(a.ws + WS_PMIX);
    bf16_t* RGLA = (bf16_t*)(a.ws + WS_RGLA); bf16_t* RGU = (bf16_t*)(a.ws + WS_RGU);
    const float* cw = a.in[I_RG_CW] + L * 4 * 512; const float* cb = a.in[I_RG_CB] + L * 512;
    {
        const int tt = item >> 2, n = item & 3;
        size_t rowbase; int t0, Ls;
        if (tt < 512) { const int b = tt >> 8; rowbase = (size_t)b * T; t0 = (tt & 255) * 64; Ls = T; }
        else { const int tc = tt - 512, b = tc >> 2; rowbase = (size_t)ML + b * CL; t0 = (tc & 3) * 64; Ls = CL; }
        __syncthreads();
        {
            const int tl = tid >> 3, cg = tid & 7, ch0 = n * 128 + cg * 16;
            float acc[16];
#pragma unroll
            for (int j = 0; j < 16; ++j) acc[j] = cb[ch0 + j];
#pragma unroll
            for (int tap = 0; tap < 4; ++tap) { const int ts = t0 + tl + tap - 2;
                if (ts >= 0 && ts < Ls) { const bf16_t* rp = PM + (rowbase + ts) * NMIXP + C_RG_X + ch0; const u32x4 w0 = *(const u32x4*)rp, w1 = *(const u32x4*)(rp + 8);
                    float f[8], g[8]; unpack8(w0, f); unpack8(w1, g);
#pragma unroll
                    for (int j = 0; j < 8; ++j) { acc[j] += cw[tap * 512 + ch0 + j] * f[j]; acc[8 + j] += cw[tap * 512 + ch0 + 8 + j] * g[j]; } } }
#pragma unroll
            for (int j = 0; j < 16; ++j) xbT[(cg * 16 + j) * 68 + tl] = acc[j];
        }
        __syncthreads();
        const int oc = tid & 127, tg = tid >> 7, ch = n * 128 + oc;
#pragma unroll 1
        for (int d = 0; d < 2; ++d) {
            const float* wr = a.in[I_RG_WR] + ((size_t)((L * 2 + d) * 4 + n) * 128) * 128 + oc;
            const float* wi = a.in[I_RG_WI] + ((size_t)((L * 2 + d) * 4 + n) * 128) * 128 + oc;
            float ar[16], ai[16];
#pragma unroll
            for (int j = 0; j < 16; ++j) { ar[j] = 0.f; ai[j] = 0.f; }
#pragma unroll 4
            for (int k = 0; k < 128; ++k) { const float w1 = wr[k * 128], w2 = wi[k * 128];
                const LAS f32x4* xp = (const LAS f32x4*)(xbT + k * 68 + tg * 16);
#pragma unroll
                for (int q = 0; q < 4; ++q) { const f32x4 xv = xp[q];
#pragma unroll
                    for (int j = 0; j < 4; ++j) { ar[q * 4 + j] += xv[j] * w1; ai[q * 4 + j] += xv[j] * w2; } } }
            const float br = a.in[I_RG_BR][(L * 2 + d) * 512 + ch], bi = a.in[I_RG_BI][(L * 2 + d) * 512 + ch];
            const float sp = softplusf(-a.in[I_RG_LAM][(L * 2 + d) * 512 + ch]);
#pragma unroll
            for (int j = 0; j < 16; ++j) { const int tl = tg * 16 + j; const float r = sigm(ar[j] + br), ig = sigm(ai[j] + bi);
                const float la = -8.0f * r * sp; const float xb = xbT[oc * 68 + tl];
                const float u = sqrtf(fmaxf(-expm1f(2.0f * la), 0.f)) * (ig * xb);
                const size_t o = ((size_t)d * MT + rowbase + t0 + tl) * 512 + ch;
                RGLA[o] = (bf16_t)(pg8::cvt_pk_bf16_safe(la, 0.f) & 0xffffu); RGU[o] = (bf16_t)(pg8::cvt_pk_bf16_safe(u, 0.f) & 0xffffu); }
        }
    }
}

template <int L>
__device__ __forceinline__ void chain_gla(const Ctx& c, int b, int h, int d, int vh) {
    ARGS_REF a = *c.a; const int tid = c.tid;
    LAS float* qs = (LAS float*)(c.lds + LDS_SCR); LAS float* ks = qs + 4096; LAS float* fs = ks + 4096; LAS float* vs = fs + 4096; LAS float* os = vs + 4096;
    LAS float* wa = (LAS float*)(c.lds + LDS_AUX);
    const bf16_t* PM = (const bf16_t*)(a.ws + WS_PMIX);
    bf16_t* ORAW = (bf16_t*)(a.ws + WS_ORAW) + (size_t)d * MT * 2048;
    for (int i = tid; i < 1024; i += 512) wa[i] = a.in[I_GLA_WA2][((L * 2 + d) * 16 + (i >> 6)) * 256 + h * 64 + (i & 63)];
    if (tid < 64) wa[1024 + tid] = a.in[I_GLA_BA2][(L * 2 + d) * 256 + h * 64 + tid];
    float s[8];
#pragma unroll
    for (int j = 0; j < 8; ++j) s[j] = 0.f;
    const int vc = tid >> 3, kq = tid & 7;
#pragma unroll 1
    for (int seg = 0; seg < 2; ++seg) {
        const int Ls = seg ? T : CL; const size_t rowbase = seg ? (size_t)b * T : (size_t)ML + b * CL;
#pragma unroll 1
        for (int jb = 0; jb < Ls / 64; ++jb) {
            const int r0 = d ? Ls - 64 * (jb + 1) : 64 * jb;
            __syncthreads();
            {   const int i = tid >> 3, cg = tid & 7, lr = d ? 63 - i : i; const bf16_t* rp = PM + (rowbase + r0 + lr) * NMIXP;
                float fq[8], fk[8], fv[8], fa[16];
                { const u32x4 w = *(const u32x4*)(rp + C_GLA_Q + h * 64 + cg * 8); unpack8(w, fq); }
                { const u32x4 w = *(const u32x4*)(rp + C_GLA_K + h * 64 + cg * 8); unpack8(w, fk); }
                { const u32x4 w = *(const u32x4*)(rp + C_GLA_V + h * 128 + vh * 64 + cg * 8); unpack8(w, fv); }
                { const u32x4 w0 = *(const u32x4*)(rp + C_GLA_A + d * 16), w1 = *(const u32x4*)(rp + C_GLA_A + d * 16 + 8); float t0[8], t1[8]; unpack8(w0, t0); unpack8(w1, t1);
#pragma unroll
                  for (int j = 0; j < 8; ++j) { fa[j] = t0[j]; fa[8 + j] = t1[j]; } }
#pragma unroll
                for (int j = 0; j < 8; ++j) { const int o = i * 64 + cg * 8 + j; qs[o] = fq[j] * 0.125f; ks[o] = fk[j]; vs[o] = fv[j];
                    float z = wa[1024 + cg * 8 + j];
#pragma unroll
                    for (int r = 0; r < 16; ++r) z += fa[r] * wa[r * 64 + cg * 8 + j];
                    fs[o] = __expf(-softplusf(-z) * (1.0f / 16.0f)); }
            }
            __syncthreads();
#pragma unroll 2
            for (int i = 0; i < 64; ++i) {
                const f32x4 f0 = *(const LAS f32x4*)(fs + i * 64 + kq * 8), f1 = *(const LAS f32x4*)(fs + i * 64 + kq * 8 + 4);
                const f32x4 k0 = *(const LAS f32x4*)(ks + i * 64 + kq * 8), k1 = *(const LAS f32x4*)(ks + i * 64 + kq * 8 + 4);
                const f32x4 q0 = *(const LAS f32x4*)(qs + i * 64 + kq * 8), q1 = *(const LAS f32x4*)(qs + i * 64 + kq * 8 + 4);
                const float vv = vs[i * 64 + vc]; float po = 0.f;
#pragma unroll
                for (int j = 0; j < 4; ++j) { s[j] = f0[j] * s[j] + k0[j] * vv; s[4 + j] = f1[j] * s[4 + j] + k1[j] * vv; po += s[j] * q0[j] + s[4 + j] * q1[j]; }
                po += __shfl_xor(po, 1); po += __shfl_xor(po, 2); po += __shfl_xor(po, 4);
                if (kq == 0) os[i * 64 + vc] = po;
            }
            __syncthreads();
            {   const int i = tid >> 3, cg = tid & 7, lr = d ? 63 - i : i; float o[8];
#pragma unroll
                for (int j = 0; j < 8; ++j) o[j] = os[i * 64 + cg * 8 + j];
                *(u32x4*)(ORAW + (rowbase + r0 + lr) * 2048 + 0 * 512 + h * 128 + vh * 64 + cg * 8) = pack8(o); }
        }
    }
}
template <int L>
__device__ __forceinline__ void chain_hg(const Ctx& c, int b, int h, int d, int vh) {
    ARGS_REF a = *c.a; const int tid = c.tid;
    LAS float* qs = (LAS float*)(c.lds + LDS_SCR); LAS float* ks = qs + 8192; LAS float* fs = ks + 8192; LAS float* vs = fs + 8192; LAS float* os = vs + 4096;
    LAS float* lbs = (LAS float*)(c.lds + LDS_AUX);
    const bf16_t* PM = (const bf16_t*)(a.ws + WS_PMIX);
    bf16_t* ORAW = (bf16_t*)(a.ws + WS_ORAW) + (size_t)d * MT * 2048;
    if (tid < 128) { float lb = 0.f; if (L == 1) { const float l0 = a.in[I_HG_LB][h * 128 + tid], l1 = a.in[I_HG_LB][512 + h * 128 + tid]; lb = 1.0f / (1.0f + expf(l0 - l1)); } lbs[tid] = lb; }
    float s[16];
#pragma unroll
    for (int j = 0; j < 16; ++j) s[j] = 0.f;
    const int vc = tid >> 3, kq = tid & 7;
#pragma unroll 1
    for (int seg = 0; seg < 2; ++seg) {
        const int Ls = seg ? T : CL; const size_t rowbase = seg ? (size_t)b * T : (size_t)ML + b * CL;
#pragma unroll 1
        for (int jb = 0; jb < Ls / 64; ++jb) {
            const int r0 = d ? Ls - 64 * (jb + 1) : 64 * jb;
            __syncthreads();
            {   const int i = tid >> 3, cg = tid & 7, lr = d ? 63 - i : i; const bf16_t* rp = PM + (rowbase + r0 + lr) * NMIXP;
#pragma unroll
                for (int hf = 0; hf < 2; ++hf) { const int ch = cg * 16 + hf * 8; float fq[8], fz[8];
                    { const u32x4 w = *(const u32x4*)(rp + C_HG_Q + h * 128 + ch); unpack8(w, fq); }
                    { const u32x4 w = *(const u32x4*)(rp + C_HG_F + d * 512 + h * 128 + ch); unpack8(w, fz); }
#pragma unroll
                    for (int j = 0; j < 8; ++j) { const int o = i * 128 + ch + j; const float lb = lbs[ch + j], sg = sigm(fz[j]);
                        qs[o] = siluf(fq[j]) * 0.08838834764831845f; fs[o] = fmaxf(lb + (1.0f - lb) * sg, 1e-30f); ks[o] = (1.0f - lb) * (1.0f - sg); } }
                float fv[8]; { const u32x4 w = *(const u32x4*)(rp + C_HG_I + h * 128 + vh * 64 + cg * 8); unpack8(w, fv); }
#pragma unroll
                for (int j = 0; j < 8; ++j) vs[i * 64 + cg * 8 + j] = fv[j];
            }
            __syncthreads();
#pragma unroll 2
            for (int i = 0; i < 64; ++i) {
                const float vv = vs[i * 64 + vc]; float po = 0.f;
#pragma unroll
                for (int q4 = 0; q4 < 4; ++q4) {
                    const f32x4 f0 = *(const LAS f32x4*)(fs + i * 128 + kq * 16 + q4 * 4), k0 = *(const LAS f32x4*)(ks + i * 128 + kq * 16 + q4 * 4), q0 = *(const LAS f32x4*)(qs + i * 128 + kq * 16 + q4 * 4);
#pragma unroll
                    for (int j = 0; j < 4; ++j) { s[q4 * 4 + j] = f0[j] * s[q4 * 4 + j] + k0[j] * vv; po += s[q4 * 4 + j] * q0[j]; } }
                po += __shfl_xor(po, 1); po += __shfl_xor(po, 2); po += __shfl_xor(po, 4);
                if (kq == 0) os[i * 64 + vc] = po;
            }
            __syncthreads();
            {   const int i = tid >> 3, cg = tid & 7, lr = d ? 63 - i : i; float o[8];
#pragma unroll
                for (int j = 0; j < 8; ++j) o[j] = os[i * 64 + cg * 8 + j];
                *(u32x4*)(ORAW + (rowbase + r0 + lr) * 2048 + 1 * 512 + h * 128 + vh * 64 + cg * 8) = pack8(o); }
        }
    }
}
template <int L>
__device__ __forceinline__ void chain_dn(const Ctx& c, int b, int h, int d, int vh) {
    ARGS_REF a = *c.a; const int tid = c.tid;
    LAS float* qs = (LAS float*)(c.lds + LDS_SCR); LAS float* ks = qs + 8192; LAS float* vs = ks + 8192; LAS float* os = vs + 4096; LAS float* as = os + 4096; LAS float* bs = as + 64;
    LAS float* cwl = (LAS float*)(c.lds + LDS_AUX);
    const bf16_t* PM = (const bf16_t*)(a.ws + WS_PMIX);
    bf16_t* ORAW = (bf16_t*)(a.ws + WS_ORAW) + (size_t)d * MT * 2048;
    for (int i = tid; i < 4 * 320; i += 512) { const int tap = i / 320, cc = i % 320; const int ch = cc < 128 ? h * 128 + cc : (cc < 256 ? 512 + h * 128 + (cc - 128) : 1024 + h * 128 + vh * 64 + (cc - 256));
        cwl[i] = a.in[I_DN_CW][(L * 4 + tap) * 1536 + ch]; }
    const float neg_ea = -expf(a.in[I_DN_ALOG][(L * 2 + d) * 4 + h]), dtb = a.in[I_DN_DTB][(L * 2 + d) * 4 + h];
    float s[16];
#pragma unroll
    for (int j = 0; j < 16; ++j) s[j] = 0.f;
    const int vc = tid >> 3, kq = tid & 7;
#pragma unroll 1
    for (int seg = 0; seg < 2; ++seg) {
        const int Ls = seg ? T : CL; const size_t rowbase = seg ? (size_t)b * T : (size_t)ML + b * CL;
#pragma unroll 1
        for (int jb = 0; jb < Ls / 64; ++jb) {
            const int r0 = d ? Ls - 64 * (jb + 1) : 64 * jb;
            __syncthreads();
            {   const int i = tid >> 3, cg = tid & 7, lr = d ? 63 - i : i, t = r0 + lr;
                float aq[16], ak[16], av[8];
#pragma unroll
                for (int j = 0; j < 16; ++j) { aq[j] = 0.f; ak[j] = 0.f; }
#pragma unroll
                for (int j = 0; j < 8; ++j) av[j] = 0.f;
#pragma unroll
                for (int tap = 0; tap < 4; ++tap) { const int ts = t + tap - 2;
                    if (ts >= 0 && ts < Ls) { const bf16_t* rp = PM + (rowbase + ts) * NMIXP; const LAS float* w = cwl + tap * 320;
                        float f0[8], f1[8];
                        { const u32x4 w0 = *(const u32x4*)(rp + C_DN_Q + h * 128 + cg * 16), w1 = *(const u32x4*)(rp + C_DN_Q + h * 128 + cg * 16 + 8); unpack8(w0, f0); unpack8(w1, f1); }
#pragma unroll
                        for (int j = 0; j < 8; ++j) { aq[j] += w[cg * 16 + j] * f0[j]; aq[8 + j] += w[cg * 16 + 8 + j] * f1[j]; }
                        { const u32x4 w0 = *(const u32x4*)(rp + C_DN_K + h * 128 + cg * 16), w1 = *(const u32x4*)(rp + C_DN_K + h * 128 + cg * 16 + 8); unpack8(w0, f0); unpack8(w1, f1); }
#pragma unroll
                        for (int j = 0; j < 8; ++j) { ak[j] += w[128 + cg * 16 + j] * f0[j]; ak[8 + j] += w[128 + cg * 16 + 8 + j] * f1[j]; }
                        { const u32x4 w0 = *(const u32x4*)(rp + C_DN_V + h * 128 + vh * 64 + cg * 8); unpack8(w0, f0); }
#pragma unroll
                        for (int j = 0; j < 8; ++j) av[j] += w[256 + cg * 8 + j] * f0[j]; } }
#pragma unroll
                for (int j = 0; j < 16; ++j) { qs[i * 128 + cg * 16 + j] = siluf(aq[j]); ks[i * 128 + cg * 16 + j] = siluf(ak[j]); }
#pragma unroll
                for (int j = 0; j < 8; ++j) vs[i * 64 + cg * 8 + j] = siluf(av[j]);
                if (tid < 64) { const int lr2 = d ? 63 - tid : tid; const bf16_t* rp = PM + (rowbase + r0 + lr2) * NMIXP;
                    const float g = neg_ea * softplusf(bf1(rp + C_DN_A + d * 4 + h) + dtb); as[tid] = __expf(g); bs[tid] = sigm(bf1(rp + C_DN_B + d * 4 + h)); }
            }
            __syncthreads();
            {
                const int rowid = tid >> 2, part = tid & 3; LAS float* p = (rowid < 64 ? qs + rowid * 128 : ks + (rowid - 64) * 128) + part * 32; float ss = 0.f;
#pragma unroll
                for (int j = 0; j < 32; ++j) ss += p[j] * p[j];
                ss += __shfl_xor(ss, 1); ss += __shfl_xor(ss, 2);
                const float rs = rsqrtf(ss + EPS) * (rowid < 64 ? 0.08838834764831845f : 1.0f);
#pragma unroll
                for (int j = 0; j < 32; ++j) p[j] *= rs;
            }
            __syncthreads();
#pragma unroll 2
            for (int i = 0; i < 64; ++i) {
                f32x4 kk[4]; float kts = 0.f;
#pragma unroll
                for (int q4 = 0; q4 < 4; ++q4) { kk[q4] = *(const LAS f32x4*)(ks + i * 128 + kq * 16 + q4 * 4);
#pragma unroll
                    for (int j = 0; j < 4; ++j) kts += s[q4 * 4 + j] * kk[q4][j]; }
                kts += __shfl_xor(kts, 1); kts += __shfl_xor(kts, 2); kts += __shfl_xor(kts, 4);
                const float al = as[i], be = bs[i]; const float vn = be * (vs[i * 64 + vc] - al * kts); float po = 0.f;
#pragma unroll
                for (int q4 = 0; q4 < 4; ++q4) { const f32x4 q0 = *(const LAS f32x4*)(qs + i * 128 + kq * 16 + q4 * 4);
#pragma unroll
                    for (int j = 0; j < 4; ++j) { s[q4 * 4 + j] = al * s[q4 * 4 + j] + kk[q4][j] * vn; po += s[q4 * 4 + j] * q0[j]; } }
                po += __shfl_xor(po, 1); po += __shfl_xor(po, 2); po += __shfl_xor(po, 4);
                if (kq == 0) os[i * 64 + vc] = po;
            }
            __syncthreads();
            {   const int i = tid >> 3, cg = tid & 7, lr = d ? 63 - i : i; float o[8];
#pragma unroll
                for (int j = 0; j < 8; ++j) o[j] = os[i * 64 + cg * 8 + j];
                *(u32x4*)(ORAW + (rowbase + r0 + lr) * 2048 + 2 * 512 + h * 128 + vh * 64 + cg * 8) = pack8(o); }
        }
    }
}
__device__ __forceinline__ void chain_rg(const Ctx& c, int gw  ) {
    ARGS_REF a = *c.a; const int b = gw >> 3, d = (gw >> 2) & 1, ch = (gw & 3) * 128 + c.lane * 2;
    const bf16_t* RGLA = (const bf16_t*)(a.ws + WS_RGLA) + (size_t)d * MT * 512 + ch; const bf16_t* RGU = (const bf16_t*)(a.ws + WS_RGU) + (size_t)d * MT * 512 + ch;
    bf16_t* ORAW = (bf16_t*)(a.ws + WS_ORAW) + (size_t)d * MT * 2048 + 1536 + ch;
    float h0 = 0.f, h1 = 0.f;
#pragma unroll 1
    for (int seg = 0; seg < 2; ++seg) {
        const int Ls = seg ? T : CL; const size_t rowbase = seg ? (size_t)b * T : (size_t)ML + b * CL;
#pragma unroll 1
        for (int s0 = 0; s0 < Ls; s0 += 16) {
            unsigned la[16], uu[16];
#pragma unroll
            for (int j = 0; j < 16; ++j) { const size_t row = rowbase + (d ? Ls - 1 - (s0 + j) : s0 + j); la[j] = *(const unsigned*)(RGLA + row * 512); uu[j] = *(const unsigned*)(RGU + row * 512); }
#pragma unroll
            for (int j = 0; j < 16; ++j) { const size_t row = rowbase + (d ? Ls - 1 - (s0 + j) : s0 + j);
                h0 = __expf(bflo(la[j])) * h0 + bflo(uu[j]); h1 = __expf(bfhi(la[j])) * h1 + bfhi(uu[j]);
                *(unsigned*)(ORAW + row * 2048) = pg8::cvt_pk_bf16_safe(h0, h1); }
        }
    }
}

typedef float f32x16 __attribute__((ext_vector_type(16)));
typedef pg8::bf16x8 bf16x8;
#define MFMA32(a, b, c) __builtin_amdgcn_mfma_f32_32x32x16_bf16((a), (b), (c), 0, 0, 0)
template <int S_> __device__ __forceinline__ bf16x8 pack_step(const f32x16& x) {
    f32x8 v;
#pragma unroll
    for (int j = 0; j < 8; ++j) v[j] = x[8 * S_ + j];
    return __builtin_bit_cast(bf16x8, __builtin_convertvector(v, bfx8_t));
}
__device__ __forceinline__ bf16_t f2bf(float f) { const __bf16 b = (__bf16)f; return __builtin_bit_cast(bf16_t, b); }
__device__ __forceinline__ int permpos(int k) { const int w = k & 15; return (k & ~15) + (((w >> 2) & 1) << 3) + ((w >> 3) << 2) + (w & 3); }
__device__ __forceinline__ int crow16(int idx, int hh) { return (idx & 3) + 8 * (idx >> 2) + 4 * hh; }
__device__ __forceinline__ size_t chunk_rowbase(int b, int n) { return n < 4 ? (size_t)ML + b * CL + n * 64 : (size_t)b * T + (size_t)(n - 4) * 64; }

template <int L, int TY>
__device__ __forceinline__ void intra_g_item(const Ctx& c, int b, int h, int n) {
    constexpr int K = TY ? 128 : 64, NSEG = 512 / K, TS = 64 / NSEG, QPITCH = 2 * K + 16;
    ARGS_REF a = *c.a; const int tid = c.tid;
    const bf16_t* PM = (const bf16_t*)(a.ws + WS_PMIX);
    unsigned char* scr = a.ws + WS_SCR;
    const size_t rowbase = chunk_rowbase(b, n);
    const int rec = (b * 4 + h) * 260 + n;
    LAS unsigned char* Qh = c.lds + LDS_SCR; LAS unsigned char* Kh = Qh + 64 * QPITCH; LAS float* segtot = (LAS float*)(Kh + 64 * QPITCH);
    __syncthreads();
    {
        const int v = tid & 127, t0 = (tid >> 7) * 16; float vals[16];
        const char* vb = (const char*)(PM + rowbase * NMIXP + (TY ? C_HG_I : C_GLA_V) + h * 128); asm volatile("" : "+s"(vb));
        const unsigned vo = (unsigned)(t0 * NMIXP + v) * 2u;
#pragma unroll
        for (int j = 0; j < 16; ++j) vals[j] = bf1((const bf16_t*)(vb + (vo + (unsigned)(j * NMIXP * 2))));
        float v0[8], v1[8];
#pragma unroll
        for (int j = 0; j < 8; ++j) { v0[j] = vals[j]; v1[j] = vals[8 + j]; }
        u32x4* dst = (u32x4*)(scr + (TY ? SC_HG_VT : SC_GLA_VT) + (size_t)rec * 16384 + v * 128 + t0 * 2);
        dst[0] = pack8(v0); dst[1] = pack8(v1);
    }
    const int k = tid & (K - 1), tq = tid / K;
    float lb = 0.f;
    if (TY == 1 && L == 1) { const float l0 = a.in[I_HG_LB][h * 128 + k], l1 = a.in[I_HG_LB][512 + h * 128 + k]; lb = 1.0f / (1.0f + expf(l0 - l1)); }
#pragma unroll 1
    for (int d = 0; d < 2; ++d) {
        float qv[TS], kv[TS], bv[TS];
        const char* pb = (const char*)(PM + rowbase * NMIXP); asm volatile("" : "+s"(pb));
        const unsigned ro = (unsigned)(TS * tq * NMIXP) * 2u;
        if (TY == 0) {
            float w[16]; const float bias = a.in[I_GLA_BA2][(L * 2 + d) * 256 + h * 64 + k];
#pragma unroll
            for (int r = 0; r < 16; ++r) w[r] = a.in[I_GLA_WA2][((L * 2 + d) * 16 + r) * 256 + h * 64 + k];
#pragma unroll
            for (int j = 0; j < TS; ++j) { const bf16_t* rp = (const bf16_t*)(pb + (ro + (unsigned)(j * NMIXP * 2)));
                qv[j] = bf1(rp + C_GLA_Q + h * 64 + k) * 0.125f; kv[j] = bf1(rp + C_GLA_K + h * 64 + k);
                const u32x4 w0 = *(const u32x4*)(rp + C_GLA_A + d * 16), w1 = *(const u32x4*)(rp + C_GLA_A + d * 16 + 8); float f0[8], f1[8]; unpack8(w0, f0); unpack8(w1, f1);
                float z = bias;
#pragma unroll
                for (int r = 0; r < 8; ++r) { z += f0[r] * w[r]; z += f1[r] * w[8 + r]; }
                bv[j] = -softplusf(-z) * (1.0f / 16.0f); }
        } else {
#pragma unroll
            for (int j = 0; j < TS; ++j) { const bf16_t* rp = (const bf16_t*)(pb + (ro + (unsigned)(j * NMIXP * 2)));
                qv[j] = siluf(bf1(rp + C_HG_Q + h * 128 + k)) * 0.08838834764831845f;
                const float sg = sigm(bf1(rp + C_HG_F + d * 512 + h * 128 + k));
                bv[j] = __logf(fmaxf(lb + (1.0f - lb) * sg, 1e-30f)); kv[j] = (1.0f - lb) * (1.0f - sg); }
        }
        float run = 0.f;
        if (d == 0) {
#pragma unroll
            for (int j = 0; j < TS; ++j) { run += bv[j]; bv[j] = run; } }
        else {
#pragma unroll
            for (int j = TS - 1; j >= 0; --j) { run += bv[j]; bv[j] = run; } }
        segtot[tq * K + k] = run;
        __syncthreads();
        float off = 0.f, tot = 0.f, R = 0.f;
#pragma unroll
        for (int sg = 0; sg < NSEG; ++sg) { const float s = segtot[sg * K + k]; tot += s;
            if (d ? (sg > tq) : (sg < tq)) off += s;
            if (d ? (sg >= NSEG / 2) : (sg < NSEG / 2)) R += s; }
        const size_t drec = (size_t)((d * 8 + b * 4 + h) * 260 + n);
        bf16_t* qp = (bf16_t*)(scr + (TY ? SC_HG_QP : SC_GLA_QP) + drec * (64 * K * 2));
        bf16_t* ktp = (bf16_t*)(scr + (TY ? SC_HG_KT : SC_GLA_KT) + drec * (64 * K * 2));
        const int pk = permpos(k);
        float kt[TS];
#pragma unroll
        for (int j = 0; j < TS; ++j) { const int t = TS * tq + j; const float B = off + bv[j];
            qp[t * K + pk] = f2bf(qv[j] * __expf(B));
            kt[j] = kv[j] * __expf(tot - B);
            *(LAS bf16_t*)(Qh + t * QPITCH + k * 2) = f2bf(qv[j] * __expf(fminf(B - R, 60.f)));
            *(LAS bf16_t*)(Kh + t * QPITCH + k * 2) = f2bf(kv[j] * __expf(fminf(R - B, 60.f))); }
        {   u32x4* dst = (u32x4*)(ktp + k * 64 + TS * tq);
#pragma unroll
            for (int g = 0; g < TS / 8; ++g) { float t8[8];
#pragma unroll
                for (int j = 0; j < 8; ++j) t8[j] = kt[g * 8 + j];
                dst[g] = pack8(t8); } }
        if (tq == 0) ((float*)(scr + (TY ? SC_HG_LAM : SC_GLA_LAM) + drec * (K * 4)))[k] = __expf(tot);
        __syncthreads();
        if (c.wave < 4) {
            const int it = c.wave >> 1, jt = c.wave & 1, r = c.lane & 31, hh = c.lane >> 5;
            bf16_t* ap = (bf16_t*)(scr + (TY ? SC_HG_A : SC_GLA_A) + drec * 8192);
            f32x16 acc;
#pragma unroll
            for (int i = 0; i < 16; ++i) acc[i] = 0.f;
            const bool dead = d ? (it == 1 && jt == 0) : (it == 0 && jt == 1);
            if (!dead) {
#pragma unroll
                for (int ks = 0; ks < K / 16; ++ks) { const bf16x8 af = *(const LAS bf16x8*)(Qh + (32 * it + r) * QPITCH + ks * 32 + hh * 16), bfr = *(const LAS bf16x8*)(Kh + (32 * jt + r) * QPITCH + ks * 32 + hh * 16);
                    acc = MFMA32(af, bfr, acc); } }
            const int jj = 32 * jt + r;
#pragma unroll
            for (int i = 0; i < 16; ++i) { const int ii = 32 * it + crow16(i, hh); const bool ok = d ? (jj >= ii) : (jj <= ii); ap[ii * 64 + jj] = f2bf(ok ? acc[i] : 0.f); }
        }
        __syncthreads();
    }
}

template <int TY> struct GChunk {
    static constexpr int K = TY ? 128 : 64, QPITCH = 2 * K + 16, RQ = 64 * K * 2 / 16 / 256  , NRL = 2 * RQ + 2 + 4;
    static constexpr int OFF_QP = 0, OFF_KT = 64 * QPITCH, OFF_A = OFF_KT + K * 144, OFF_VT = OFF_A + 64 * 144, OFF_LAM = OFF_VT + 128 * 144, BYTES = OFF_LAM + K * 4;
};
#define LBAR() do { asm volatile("s_waitcnt lgkmcnt(0)" ::: "memory"); __builtin_amdgcn_s_barrier(); asm volatile("" ::: "memory"); } while (0)
template <int TY>
__device__ __forceinline__ void gchunk_issue(const unsigned char* scr, int b, int h, int d, int n, int lt, u32x4 (&pf)[GChunk<TY>::NRL], float& lamv) {
    typedef GChunk<TY> G; constexpr int K = G::K, RQ = G::RQ;
    const size_t drec = (size_t)((d * 8 + b * 4 + h) * 260 + n), rec = (size_t)((b * 4 + h) * 260 + n);
    const u32x4* qp = (const u32x4*)(scr + (TY ? SC_HG_QP : SC_GLA_QP) + drec * (64 * K * 2));
    const u32x4* kt = (const u32x4*)(scr + (TY ? SC_HG_KT : SC_GLA_KT) + drec * (64 * K * 2));
    const u32x4* ap = (const u32x4*)(scr + (TY ? SC_HG_A : SC_GLA_A) + drec * 8192);
    const u32x4* vt = (const u32x4*)(scr + (TY ? SC_HG_VT : SC_GLA_VT) + rec * 16384);
#pragma unroll
    for (int i = 0; i < RQ; ++i) { pf[i] = qp[i * 256 + lt]; pf[RQ + i] = kt[i * 256 + lt]; }
    pf[2 * RQ] = ap[lt]; pf[2 * RQ + 1] = ap[256 + lt];
#pragma unroll
    for (int i = 0; i < 4; ++i) pf[2 * RQ + 2 + i] = vt[i * 256 + lt];
    if (lt < K) lamv = ((const float*)(scr + (TY ? SC_HG_LAM : SC_GLA_LAM) + drec * (K * 4)))[lt];
}
template <int TY>
__device__ __forceinline__ void gchunk_commit(LAS unsigned char* buf, int lt, const u32x4 (&pf)[GChunk<TY>::NRL], float lamv) {
    typedef GChunk<TY> G; constexpr int K = G::K, PPR = K * 2 / 16, RQ = G::RQ;
#pragma unroll
    for (int i = 0; i < RQ; ++i) { const int p = i * 256 + lt;
        *(LAS u32x4*)(buf + G::OFF_QP + (p / PPR) * G::QPITCH + (p % PPR) * 16) = pf[i];
        *(LAS u32x4*)(buf + G::OFF_KT + (p >> 3) * 144 + (p & 7) * 16) = pf[RQ + i]; }
#pragma unroll
    for (int i = 0; i < 2; ++i) { const int p = i * 256 + lt; *(LAS u32x4*)(buf + G::OFF_A + (p >> 3) * 144 + (p & 7) * 16) = pf[2 * RQ + i]; }
#pragma unroll
    for (int i = 0; i < 4; ++i) { const int p = i * 256 + lt; *(LAS u32x4*)(buf + G::OFF_VT + (p >> 3) * 144 + (p & 7) * 16) = pf[2 * RQ + 2 + i]; }
    if (lt < K) *(LAS float*)(buf + G::OFF_LAM + lt * 4) = lamv;
}
template <int TY>
__device__ __forceinline__ void gchunk_compute(LAS unsigned char* buf, f32x16 (&S)[GChunk<TY>::K / 32], bf16_t* orow, int vs, int lane) {
    typedef GChunk<TY> G; constexpr int K = G::K, KT_ = K / 32;
    const int r = lane & 31, hh = lane >> 5;
    bf16x8 vf[4];
#pragma unroll
    for (int ts = 0; ts < 4; ++ts) vf[ts] = *(const LAS bf16x8*)(buf + G::OFF_VT + (32 * vs + r) * 144 + ts * 32 + hh * 16);
    f32x16 o[2];
#pragma unroll
    for (int it = 0; it < 2; ++it) {
#pragma unroll
        for (int i = 0; i < 16; ++i) o[it][i] = 0.f; }
#pragma unroll
    for (int kt = 0; kt < KT_; ++kt) { const bf16x8 b0 = pack_step<0>(S[kt]), b1 = pack_step<1>(S[kt]);
#pragma unroll
        for (int it = 0; it < 2; ++it) { const bf16x8 q0 = *(const LAS bf16x8*)(buf + G::OFF_QP + (32 * it + r) * G::QPITCH + (2 * kt) * 32 + hh * 16), q1 = *(const LAS bf16x8*)(buf + G::OFF_QP + (32 * it + r) * G::QPITCH + (2 * kt + 1) * 32 + hh * 16);
            o[it] = MFMA32(q0, b0, o[it]); o[it] = MFMA32(q1, b1, o[it]); }
        __builtin_amdgcn_sched_barrier(0); }
#pragma unroll
    for (int ts = 0; ts < 4; ++ts)
#pragma unroll
        for (int it = 0; it < 2; ++it) { const bf16x8 af = *(const LAS bf16x8*)(buf + G::OFF_A + (32 * it + r) * 144 + ts * 32 + hh * 16);
            o[it] = MFMA32(af, vf[ts], o[it]); }
    __builtin_amdgcn_sched_barrier(0);
#pragma unroll
    for (int kt = 0; kt < KT_; ++kt) {
        __builtin_amdgcn_sched_barrier(0);
#pragma unroll
        for (int g = 0; g < 4; ++g) { const f32x4 lm = *(const LAS f32x4*)(buf + G::OFF_LAM + (32 * kt + 8 * g + 4 * hh) * 4);
#pragma unroll
            for (int j = 0; j < 4; ++j) S[kt][4 * g + j] *= lm[j]; }
#pragma unroll
        for (int ts = 0; ts < 4; ++ts) { const bf16x8 kf = *(const LAS bf16x8*)(buf + G::OFF_KT + (32 * kt + r) * 144 + ts * 32 + hh * 16);
            S[kt] = MFMA32(kf, vf[ts], S[kt]); } }
    __builtin_amdgcn_sched_barrier(0);
#pragma unroll
    for (int it = 0; it < 2; ++it)
#pragma unroll
        for (int i = 0; i < 16; ++i) orow[(size_t)(32 * it + crow16(i, hh)) * 2048 + 32 * vs + r] = f2bf(o[it][i]);
}
template <int L, int TY>
__device__ __forceinline__ void chain_g(const Ctx& c, int b, int h, int d) {
    typedef GChunk<TY> G; constexpr int KT_ = G::K / 32;
    ARGS_REF a = *c.a;
    const unsigned char* scr = a.ws + WS_SCR;
    LAS unsigned char* buf = c.lds + LDS_SCR;
    static_assert(G::BYTES <= 65536, "two chunk buffers must fit the scratch region");
#define CHUNK_OF(m) (d ? ((m) < 4 ? 3 - (m) : 263 - (m)) : (m))
    __syncthreads();
    if (c.wave < 4) {
        bf16_t* ORAW = (bf16_t*)(a.ws + WS_ORAW) + (size_t)d * MT * 2048 + TY * 512 + h * 128;
        f32x16 S[KT_];
#pragma unroll
        for (int kt = 0; kt < KT_; ++kt)
#pragma unroll
            for (int i = 0; i < 16; ++i) S[kt][i] = 0.f;
        LBAR();
#pragma unroll 1
        for (int m = 0; m < 260; ++m) {
            gchunk_compute<TY>(buf + (m & 1) * 65536, S, ORAW + chunk_rowbase(b, CHUNK_OF(m)) * 2048, c.wave, c.lane);
            LBAR();
        }
    } else {
        const int lt = c.tid - 256;
        u32x4 pfA[G::NRL], pfB[G::NRL]; float lamA = 0.f, lamB = 0.f;
        gchunk_issue<TY>(scr, b, h, d, CHUNK_OF(0), lt, pfA, lamA);
        gchunk_issue<TY>(scr, b, h, d, CHUNK_OF(1), lt, pfB, lamB);
        gchunk_commit<TY>(buf, lt, pfA, lamA);
        gchunk_issue<TY>(scr, b, h, d, CHUNK_OF(2), lt, pfA, lamA);
        LBAR();
#pragma unroll 1
        for (int m = 0; m < 260; m += 2) {
            gchunk_commit<TY>(buf + 65536, lt, pfB, lamB);
            if (m + 3 < 260) gchunk_issue<TY>(scr, b, h, d, CHUNK_OF(m + 3), lt, pfB, lamB);
            LBAR();
            if (m + 2 < 260) gchunk_commit<TY>(buf, lt, pfA, lamA);
            if (m + 4 < 260) gchunk_issue<TY>(scr, b, h, d, CHUNK_OF(m + 4), lt, pfA, lamA);
            LBAR();
        }
    }
#undef CHUNK_OF
}

__device__ __forceinline__ int posU(int i) { const int w = i & 31; return (i & 32) + (((w >> 2) & 1) << 4) + (w & 3) + ((w >> 3) << 2); }
__device__ __forceinline__ constexpr int pp16(int w) { return (((w >> 2) & 1) << 3) + ((w >> 3) << 2) + (w & 3); }

__device__ __forceinline__ void trisolve64(const LAS float* A, int cidx, float (&Tc)[64]) {
#pragma unroll
    for (int pi = 0; pi < 64; ++pi) {
        float acc = (pi == cidx) ? 1.f : 0.f;
#pragma unroll
        for (int q = 0; q < (pi + 3) / 4; ++q) { const f32x4 av = *(const LAS f32x4*)(A + pi * 64 + 4 * q);
#pragma unroll
            for (int jj = 0; jj < 4; ++jj) if (4 * q + jj < pi) acc -= av[jj] * Tc[4 * q + jj]; }
        Tc[pi] = acc;
        if ((pi & 3) == 3) __builtin_amdgcn_sched_barrier(0);
    }
}

template <int L>
__device__ __forceinline__ void intra_dn_item(const Ctx& c, int b, int h, int n) {
    ARGS_REF a = *c.a; const int tid = c.tid, lane = c.lane, wave = c.wave;
    const bf16_t* PM = (const bf16_t*)(a.ws + WS_PMIX);
    unsigned char* scr = a.ws + WS_SCR;
    const int rec = (b * 4 + h) * 260 + n;
    LAS unsigned char* Qh = c.lds + LDS_SCR;
    LAS unsigned char* Kh = Qh + 17408;
    LAS unsigned char* Tp = Qh;
    LAS unsigned char* KTp = c.lds + LDS_SCR + 36864;
    LAS unsigned char* VTp = KTp + 18432;
    LAS float* Ap = (LAS float*)(VTp + 18432);
    LAS float* sm = (LAS float*)(c.lds + LDS_AUX);
    __syncthreads();
    {
        const int i = tid >> 3, cg = tid & 7;
        const int Ls = n < 4 ? CL : T; const int tseg = (n < 4 ? n : n - 4) * 64 + i; const size_t segbase = n < 4 ? (size_t)ML + b * CL : (size_t)b * T;
        float aq[16], ak[16], av[16];
#pragma unroll
        for (int j = 0; j < 16; ++j) { aq[j] = 0.f; ak[j] = 0.f; av[j] = 0.f; }
        const float* cw = a.in[I_DN_CW] + (size_t)L * 4 * 1536 + h * 128 + cg * 16;
#pragma unroll
        for (int tap = 0; tap < 4; ++tap) { const int ts = tseg + tap - 2;
            if (ts >= 0 && ts < Ls) { const bf16_t* rp = PM + (segbase + ts) * NMIXP + h * 128 + cg * 16; const float* w = cw + tap * 1536;
                float f0[8], f1[8];
                { const u32x4 w0 = *(const u32x4*)(rp + C_DN_Q), w1 = *(const u32x4*)(rp + C_DN_Q + 8); unpack8(w0, f0); unpack8(w1, f1); }
#pragma unroll
                for (int j = 0; j < 8; ++j) { aq[j] += w[j] * f0[j]; aq[8 + j] += w[8 + j] * f1[j]; }
                { const u32x4 w0 = *(const u32x4*)(rp + C_DN_K), w1 = *(const u32x4*)(rp + C_DN_K + 8); unpack8(w0, f0); unpack8(w1, f1); }
#pragma unroll
                for (int j = 0; j < 8; ++j) { ak[j] += w[512 + j] * f0[j]; ak[8 + j] += w[512 + 8 + j] * f1[j]; }
                { const u32x4 w0 = *(const u32x4*)(rp + C_DN_V), w1 = *(const u32x4*)(rp + C_DN_V + 8); unpack8(w0, f0); unpack8(w1, f1); }
#pragma unroll
                for (int j = 0; j < 8; ++j) { av[j] += w[1024 + j] * f0[j]; av[8 + j] += w[1024 + 8 + j] * f1[j]; } } }
        float sq = 0.f, sk = 0.f;
#pragma unroll
        for (int j = 0; j < 16; ++j) { aq[j] = siluf(aq[j]); ak[j] = siluf(ak[j]); av[j] = siluf(av[j]); sq += aq[j] * aq[j]; sk += ak[j] * ak[j]; }
        sq += __shfl_xor(sq, 1); sq += __shfl_xor(sq, 2); sq += __shfl_xor(sq, 4);
        sk += __shfl_xor(sk, 1); sk += __shfl_xor(sk, 2); sk += __shfl_xor(sk, 4);
        const float rq = rsqrtf(sq + EPS) * 0.08838834764831845f, rk = rsqrtf(sk + EPS);
        float qp[16];
#pragma unroll
        for (int j = 0; j < 16; ++j) { aq[j] *= rq; ak[j] *= rk; }
#pragma unroll
        for (int j = 0; j < 16; ++j) qp[pp16(j)] = aq[j];
        {   float x0[8], x1[8];
#pragma unroll
            for (int j = 0; j < 8; ++j) { x0[j] = qp[j]; x1[j] = qp[8 + j]; }
            u32x4* dst = (u32x4*)(scr + SC_DN_QS + (size_t)rec * 16384 + i * 256 + cg * 32); dst[0] = pack8(x0); dst[1] = pack8(x1);
#pragma unroll
            for (int j = 0; j < 8; ++j) { x0[j] = aq[j]; x1[j] = aq[8 + j]; }
            *(LAS u32x4*)(Qh + i * 272 + cg * 32) = pack8(x0); *(LAS u32x4*)(Qh + i * 272 + cg * 32 + 16) = pack8(x1);
#pragma unroll
            for (int j = 0; j < 8; ++j) { x0[j] = ak[j]; x1[j] = ak[8 + j]; }
            *(LAS u32x4*)(Kh + i * 272 + cg * 32) = pack8(x0); *(LAS u32x4*)(Kh + i * 272 + cg * 32 + 16) = pack8(x1); }
        const int pj = permpos(i);
#pragma unroll
        for (int j = 0; j < 16; ++j) { *(LAS bf16_t*)(KTp + (cg * 16 + j) * 144 + pj * 2) = f2bf(ak[j]); *(LAS bf16_t*)(VTp + (cg * 16 + j) * 144 + pj * 2) = f2bf(av[j]); }
        if (tid < 128) { const int d = tid >> 6, t = tid & 63; const bf16_t* rp = PM + (chunk_rowbase(b, n) + t) * NMIXP;
            const float g = -expf(a.in[I_DN_ALOG][(L * 2 + d) * 4 + h]) * softplusf(bf1(rp + C_DN_A + d * 4 + h) + a.in[I_DN_DTB][(L * 2 + d) * 4 + h]);
            sm[d * 256 + t] = g; sm[d * 256 + 128 + t] = sigm(bf1(rp + C_DN_B + d * 4 + h)); }
    }
    __syncthreads();
    const int r = lane & 31, hh = lane >> 5;
    f32x16 gram;
#pragma unroll
    for (int i = 0; i < 16; ++i) gram[i] = 0.f;
    const int t1 = (wave & 3) >> 1, t2 = wave & 1;
#pragma unroll
    for (int ks = 0; ks < 8; ++ks) {
        const bf16x8 af = *(const LAS bf16x8*)(Kh + (32 * (wave < 4 ? t2 : t1) + r) * 272 + ks * 32 + hh * 16);
        const bf16x8 bfr = *(const LAS bf16x8*)((wave < 4 ? Qh : Kh) + (32 * (wave < 4 ? t1 : t2) + r) * 272 + ks * 32 + hh * 16);
        gram = MFMA32(af, bfr, gram); }
    {
        u32x4* dst = (u32x4*)(scr + SC_DN_KT + (size_t)rec * 16384);
#pragma unroll
        for (int q = 0; q < 2; ++q) { const int p = q * 512 + tid; dst[p] = *(const LAS u32x4*)(KTp + (p >> 3) * 144 + (p & 7) * 16); } }
    if (tid < 128) { const int d = tid >> 6, t = tid & 63; float acc = 0.f;
        for (int tt = 0; tt < 64; ++tt) { const float g = sm[d * 256 + tt]; if (d ? (tt >= t) : (tt <= t)) acc += g; }
        sm[d * 256 + 64 + t] = acc; }
    __syncthreads();
#pragma unroll 1
    for (int d = 0; d < 2; ++d) {
        const LAS float* gc = sm + d * 256 + 64; const LAS float* be = sm + d * 256 + 128;
        const size_t drec = (size_t)((d * 8 + b * 4 + h) * 260 + n);
        if (wave < 4) {
            const int i = 32 * t1 + r; const float gi = gc[i]; float o[16];
#pragma unroll
            for (int idx = 0; idx < 16; ++idx) { const int j = 32 * t2 + crow16(idx, hh); const bool ok = d ? (j >= i) : (j <= i); o[idx] = ok ? gram[idx] * __expf(fminf(gi - gc[j], 0.f)) : 0.f; }
            float x0[8], x1[8];
#pragma unroll
            for (int j = 0; j < 8; ++j) { x0[j] = o[j]; x1[j] = o[8 + j]; }
            bf16_t* ap = (bf16_t*)(scr + SC_DN_AQK + drec * 8192) + i * 64 + 32 * t2 + 8 * hh;
            *(u32x4*)ap = pack8(x0); *(u32x4*)(ap + 16) = pack8(x1);
        } else {
            const int j = 32 * t2 + r; const float gj = gc[j]; const int pj = d ? 63 - j : j;
#pragma unroll
            for (int idx = 0; idx < 16; ++idx) { const int i = 32 * t1 + crow16(idx, hh); const int pi = d ? 63 - i : i;
                Ap[d * 4096 + pi * 64 + pj] = (pj < pi) ? be[i] * gram[idx] * __expf(fminf(gc[i] - gj, 0.f)) : 0.f; }
        }
        if (tid < 64) { const float gtot = d ? gc[0] : gc[63]; float* sc = (float*)(scr + SC_DN_SC + drec * 1024);
            const float eg = __expf(gc[tid]); sc[tid] = eg; sc[64 + tid] = __expf(gtot - gc[tid]); if (tid == 0) sc[128] = __expf(gtot); sm[d * 256 + 192 + tid] = eg; }
    }
    __syncthreads();
    if (wave < 2) {
        const int d = wave; float Tc[64];
        trisolve64(Ap + d * 4096, lane, Tc);
        const int j = d ? 63 - lane : lane; const float bj = sm[d * 256 + 128 + j], ej = sm[d * 256 + 192 + j]; const int pj2 = permpos(j) * 2;
        LAS unsigned char* T1 = Tp + d * 18432; LAS unsigned char* T2 = T1 + 9216;
#pragma unroll
        for (int pi = 0; pi < 64; ++pi) { const int i = d ? 63 - pi : pi; const float v1 = Tc[pi] * bj;
            *(LAS bf16_t*)(T1 + i * 144 + pj2) = f2bf(v1); *(LAS bf16_t*)(T2 + i * 144 + pj2) = f2bf(v1 * ej); }
    }
    __syncthreads();
#pragma unroll 1
    for (int q = 0; q < 4; ++q) {
        const int tile = wave * 4 + q, d = tile >> 4, isw = (tile >> 3) & 1, it = (tile >> 2) & 1, xt = tile & 3;
        const size_t drec = (size_t)((d * 8 + b * 4 + h) * 260 + n);
        LAS unsigned char* T1 = Tp + d * 18432; LAS unsigned char* T2 = T1 + 9216;
        f32x16 acc;
#pragma unroll
        for (int i = 0; i < 16; ++i) acc[i] = 0.f;
        if (!isw) {
#pragma unroll
            for (int js = 0; js < 4; ++js) { const bf16x8 af = *(const LAS bf16x8*)(T1 + (32 * it + r) * 144 + js * 32 + hh * 16), bfr = *(const LAS bf16x8*)(VTp + (32 * xt + r) * 144 + js * 32 + hh * 16);
                acc = MFMA32(af, bfr, acc); }
            float x0[8], x1[8];
#pragma unroll
            for (int j = 0; j < 8; ++j) { x0[j] = acc[j]; x1[j] = acc[8 + j]; }
            bf16_t* up = (bf16_t*)(scr + SC_DN_UT + drec * 16384) + (32 * xt + r) * 64 + it * 32 + hh * 16;
            *(u32x4*)up = pack8(x0); *(u32x4*)(up + 8) = pack8(x1);
        } else {
#pragma unroll
            for (int js = 0; js < 4; ++js) { const bf16x8 af = *(const LAS bf16x8*)(KTp + (32 * xt + r) * 144 + js * 32 + hh * 16), bfr = *(const LAS bf16x8*)(T2 + (32 * it + r) * 144 + js * 32 + hh * 16);
                acc = MFMA32(af, bfr, acc); }
            float x0[8], x1[8];
#pragma unroll
            for (int j = 0; j < 8; ++j) { x0[j] = -acc[j]; x1[j] = -acc[8 + j]; }
            bf16_t* wp = (bf16_t*)(scr + SC_DN_WN + drec * 16384) + (32 * it + r) * 128 + 32 * xt + 8 * hh;
            *(u32x4*)wp = pack8(x0); *(u32x4*)(wp + 16) = pack8(x1);
        }
    }
}

struct DChunk { static constexpr int OFF_QS = 0, OFF_KT = 17408, OFF_UT = OFF_KT + 18432, OFF_WN = OFF_UT + 18432, OFF_AQK = OFF_WN + 17408, OFF_SC = OFF_AQK + 9216, BYTES = OFF_SC + 1024, NRL = 18; };
__device__ __forceinline__ void dchunk_issue(const unsigned char* scr, int b, int h, int d, int n, int lt, u32x4 (&pf)[DChunk::NRL], f32x4& scv) {
    const size_t drec = (size_t)((d * 8 + b * 4 + h) * 260 + n), rec = (size_t)((b * 4 + h) * 260 + n);
    const u32x4* qs = (const u32x4*)(scr + SC_DN_QS + rec * 16384); const u32x4* kt = (const u32x4*)(scr + SC_DN_KT + rec * 16384);
    const u32x4* ut = (const u32x4*)(scr + SC_DN_UT + drec * 16384); const u32x4* wn = (const u32x4*)(scr + SC_DN_WN + drec * 16384);
    const u32x4* aq = (const u32x4*)(scr + SC_DN_AQK + drec * 8192);
#pragma unroll
    for (int i = 0; i < 4; ++i) { pf[i] = qs[i * 256 + lt]; pf[4 + i] = kt[i * 256 + lt]; pf[8 + i] = ut[i * 256 + lt]; pf[12 + i] = wn[i * 256 + lt]; }
    pf[16] = aq[lt]; pf[17] = aq[256 + lt];
    if (lt < 64) scv = ((const f32x4*)(scr + SC_DN_SC + drec * 1024))[lt];
}
__device__ __forceinline__ void dchunk_commit(LAS unsigned char* buf, int lt, const u32x4 (&pf)[DChunk::NRL], const f32x4 scv) {
    typedef DChunk G;
#pragma unroll
    for (int i = 0; i < 4; ++i) { const int p = i * 256 + lt;
        *(LAS u32x4*)(buf + G::OFF_QS + (p >> 4) * 272 + (p & 15) * 16) = pf[i];
        *(LAS u32x4*)(buf + G::OFF_KT + (p >> 3) * 144 + (p & 7) * 16) = pf[4 + i];
        *(LAS u32x4*)(buf + G::OFF_UT + (p >> 3) * 144 + (p & 7) * 16) = pf[8 + i];
        *(LAS u32x4*)(buf + G::OFF_WN + (p >> 4) * 272 + (p & 15) * 16) = pf[12 + i]; }
#pragma unroll
    for (int i = 0; i < 2; ++i) { const int p = i * 256 + lt; *(LAS u32x4*)(buf + G::OFF_AQK + (p >> 3) * 144 + (p & 7) * 16) = pf[16 + i]; }
    if (lt < 64) *(LAS f32x4*)(buf + G::OFF_SC + lt * 16) = scv;
}
__device__ __forceinline__ void dchunk_compute(LAS unsigned char* buf, f32x16 (&S)[4], bf16_t* orow, int vs, int lane) {
    typedef DChunk G; const int r = lane & 31, hh = lane >> 5;
    f32x16 vn[2], o[2];
#pragma unroll
    for (int it = 0; it < 2; ++it) { const u32x4 u0 = *(const LAS u32x4*)(buf + G::OFF_UT + (32 * vs + r) * 144 + it * 64 + hh * 32), u1 = *(const LAS u32x4*)(buf + G::OFF_UT + (32 * vs + r) * 144 + it * 64 + hh * 32 + 16);
        float f0[8], f1[8]; unpack8(u0, f0); unpack8(u1, f1);
#pragma unroll
        for (int j = 0; j < 8; ++j) { vn[it][j] = f0[j]; vn[it][8 + j] = f1[j]; o[it][j] = 0.f; o[it][8 + j] = 0.f; } }
#pragma unroll
    for (int kt = 0; kt < 4; ++kt) { const bf16x8 b0 = pack_step<0>(S[kt]), b1 = pack_step<1>(S[kt]);
#pragma unroll
        for (int it = 0; it < 2; ++it) {
            const bf16x8 w0 = *(const LAS bf16x8*)(buf + G::OFF_WN + (32 * it + r) * 272 + (2 * kt) * 32 + hh * 16), w1 = *(const LAS bf16x8*)(buf + G::OFF_WN + (32 * it + r) * 272 + (2 * kt + 1) * 32 + hh * 16);
            const bf16x8 q0 = *(const LAS bf16x8*)(buf + G::OFF_QS + (32 * it + r) * 272 + (2 * kt) * 32 + hh * 16), q1 = *(const LAS bf16x8*)(buf + G::OFF_QS + (32 * it + r) * 272 + (2 * kt + 1) * 32 + hh * 16);
            vn[it] = MFMA32(w0, b0, vn[it]); o[it] = MFMA32(q0, b0, o[it]); vn[it] = MFMA32(w1, b1, vn[it]); o[it] = MFMA32(q1, b1, o[it]); }
        __builtin_amdgcn_sched_barrier(0); }
#pragma unroll
    for (int it = 0; it < 2; ++it)
#pragma unroll
        for (int g = 0; g < 4; ++g) { const f32x4 e = *(const LAS f32x4*)(buf + G::OFF_SC + (32 * it + 8 * g + 4 * hh) * 4);
#pragma unroll
            for (int j = 0; j < 4; ++j) o[it][4 * g + j] *= e[j]; }
    __builtin_amdgcn_sched_barrier(0);
#pragma unroll
    for (int jt = 0; jt < 2; ++jt) { const bf16x8 p0 = pack_step<0>(vn[jt]), p1 = pack_step<1>(vn[jt]);
#pragma unroll
        for (int it = 0; it < 2; ++it) { const bf16x8 a0 = *(const LAS bf16x8*)(buf + G::OFF_AQK + (32 * it + r) * 144 + (2 * jt) * 32 + hh * 16), a1 = *(const LAS bf16x8*)(buf + G::OFF_AQK + (32 * it + r) * 144 + (2 * jt + 1) * 32 + hh * 16);
            o[it] = MFMA32(a0, p0, o[it]); o[it] = MFMA32(a1, p1, o[it]); } }
    __builtin_amdgcn_sched_barrier(0);
#pragma unroll
    for (int jt = 0; jt < 2; ++jt)
#pragma unroll
        for (int g = 0; g < 4; ++g) { const f32x4 e = *(const LAS f32x4*)(buf + G::OFF_SC + 256 + (32 * jt + 8 * g + 4 * hh) * 4);
#pragma unroll
            for (int j = 0; j < 4; ++j) vn[jt][4 * g + j] *= e[j]; }
    const float glast = *(const LAS float*)(buf + G::OFF_SC + 512);
    const bf16x8 p00 = pack_step<0>(vn[0]), p01 = pack_step<1>(vn[0]), p10 = pack_step<0>(vn[1]), p11 = pack_step<1>(vn[1]);
    __builtin_amdgcn_sched_barrier(0);
#pragma unroll
    for (int kt = 0; kt < 4; ++kt) {
#pragma unroll
        for (int i = 0; i < 16; ++i) S[kt][i] *= glast;
        const LAS unsigned char* kb = buf + G::OFF_KT + (32 * kt + r) * 144 + hh * 16;
        S[kt] = MFMA32(*(const LAS bf16x8*)(kb), p00, S[kt]); S[kt] = MFMA32(*(const LAS bf16x8*)(kb + 32), p01, S[kt]);
        S[kt] = MFMA32(*(const LAS bf16x8*)(kb + 64), p10, S[kt]); S[kt] = MFMA32(*(const LAS bf16x8*)(kb + 96), p11, S[kt]);
        __builtin_amdgcn_sched_barrier(0); }
#pragma unroll
    for (int it = 0; it < 2; ++it)
#pragma unroll
        for (int i = 0; i < 16; ++i) orow[(size_t)(32 * it + crow16(i, hh)) * 2048 + 32 * vs + r] = f2bf(o[it][i]);
}
template <int L>
__device__ __forceinline__ void chain_dnc(const Ctx& c, int b, int h, int d) {
    ARGS_REF a = *c.a;
    const unsigned char* scr = a.ws + WS_SCR;
    LAS unsigned char* buf = c.lds + LDS_SCR;
#define CHUNK_OF(m) (d ? ((m) < 4 ? 3 - (m) : 263 - (m)) : (m))
    __syncthreads();
    if (c.wave < 4) {
        bf16_t* ORAW = (bf16_t*)(a.ws + WS_ORAW) + (size_t)d * MT * 2048 + 2 * 512 + h * 128;
        f32x16 S[4];
#pragma unroll
        for (int kt = 0; kt < 4; ++kt)
#pragma unroll
            for (int i = 0; i < 16; ++i) S[kt][i] = 0.f;
        LBAR();
#pragma unroll 1
        for (int m = 0; m < 260; ++m) {
            dchunk_compute(buf, S, ORAW + chunk_rowbase(b, CHUNK_OF(m)) * 2048, c.wave, c.lane);
            LBAR();
            LBAR();
        }
    } else {
        const int lt = c.tid - 256;
        u32x4 pfA[DChunk::NRL], pfB[DChunk::NRL]; f32x4 scA = {0.f, 0.f, 0.f, 0.f}, scB = scA;
        dchunk_issue(scr, b, h, d, CHUNK_OF(0), lt, pfA, scA);
        dchunk_issue(scr, b, h, d, CHUNK_OF(1), lt, pfB, scB);
        dchunk_commit(buf, lt, pfA, scA);
        dchunk_issue(scr, b, h, d, CHUNK_OF(2), lt, pfA, scA);
        LBAR();
#pragma unroll 1
        for (int m = 0; m < 260; m += 2) {
            LBAR();
            dchunk_commit(buf, lt, pfB, scB);
            if (m + 3 < 260) dchunk_issue(scr, b, h, d, CHUNK_OF(m + 3), lt, pfB, scB);
            LBAR();
            LBAR();
            if (m + 2 < 260) dchunk_commit(buf, lt, pfA, scA);
            if (m + 4 < 260) dchunk_issue(scr, b, h, d, CHUNK_OF(m + 4), lt, pfA, scA);
            LBAR();
        }
    }
#undef CHUNK_OF
}
template <int L>
__device__ __forceinline__ void intra_phase(const Ctx& c) {
#pragma unroll 1
    for (int item = c.wg; item < 2080; item += c.G) rgprep_item<L>(c, item);
#pragma unroll 1
    for (int item = (c.wg + 96) % c.G; item < 2080; item += c.G) { const int bh = item / 260, n = item % 260; intra_g_item<L, 0>(c, bh >> 2, bh & 3, n); }
#pragma unroll 1
    for (int item = (c.wg + 192) % c.G; item < 2080; item += c.G) { const int bh = item / 260, n = item % 260; intra_g_item<L, 1>(c, bh >> 2, bh & 3, n); }
#pragma unroll 1
    for (int item = (c.wg + 32) % c.G; item < 2080; item += c.G) { const int bh = item / 260, n = item % 260; intra_dn_item<L>(c, bh >> 2, bh & 3, n); }
}
template <int L>
__device__ __forceinline__ void chains_phase(const Ctx& c) {
    const int w = c.wg;
    if (w < 32) { const int r = w & 15, b = r >> 3, h = (r >> 1) & 3, d = r & 1;
        if (w < 16) chain_g<L, 0>(c, b, h, d); else chain_g<L, 1>(c, b, h, d); }
    else if (w < 48) { const int r = w - 32, b = r >> 3, h = (r >> 1) & 3, d = r & 1; chain_dnc<L>(c, b, h, d); }
    else if (w < 50) chain_rg(c, (w - 48) * 8 + c.wave);
}
template <int L>
__device__ __forceinline__ void combine_phase(const Ctx& c) {
    ARGS_REF a = *c.a; const int gw = c.wg * 8 + c.wave, nw = c.G * 8, lane = c.lane;
    const bf16_t* PM = (const bf16_t*)(a.ws + WS_PMIX); const bf16_t* O0 = (const bf16_t*)(a.ws + WS_ORAW); const bf16_t* O1 = O0 + (size_t)MT * 2048;
    bf16_t* O = (bf16_t*)(a.ws + WS_O);
    const int cb = lane * 8, hv = cb & 127;
    float nwv[3][8];
#pragma unroll
    for (int j = 0; j < 8; ++j) { nwv[0][j] = a.in[I_GLA_NW][L * 128 + hv + j]; nwv[1][j] = a.in[I_HG_NW][L * 128 + hv + j]; nwv[2][j] = a.in[I_DN_NW][L * 128 + hv + j]; }
    const int nrows = (L == 0) ? MT : ML;
    for (int r = gw; r < nrows; r += nw) {
        const bf16_t* pm = PM + (size_t)r * NMIXP;
#pragma unroll
        for (int br = 0; br < 3; ++br) {
            const int gcol = br == 0 ? C_GLA_G : (br == 1 ? C_HG_G : C_DN_G);
            float x0[8], x1[8], g[8], o[8];
            { const u32x4 w = *(const u32x4*)(O0 + (size_t)r * 2048 + br * 512 + cb); unpack8(w, x0); }
            { const u32x4 w = *(const u32x4*)(O1 + (size_t)r * 2048 + br * 512 + cb); unpack8(w, x1); }
            { const u32x4 w = *(const u32x4*)(pm + gcol + cb); unpack8(w, g); }
            float ss = 0.f;
#pragma unroll
            for (int j = 0; j < 8; ++j) { o[j] = x0[j] + x1[j]; ss += o[j] * o[j]; }
            ss += __shfl_xor(ss, 1); ss += __shfl_xor(ss, 2); ss += __shfl_xor(ss, 4); ss += __shfl_xor(ss, 8);
            const float rs = rsqrtf(ss * (1.0f / 128.0f) + EPS);
#pragma unroll
            for (int j = 0; j < 8; ++j) o[j] = o[j] * rs * nwv[br][j] * siluf(g[j]);
            *(u32x4*)(O + ((size_t)br * MT + r) * 512 + cb) = pack8(o);
        }
        {   float x0[8], x1[8], y[8], o[8];
            { const u32x4 w = *(const u32x4*)(O0 + (size_t)r * 2048 + 1536 + cb); unpack8(w, x0); }
            { const u32x4 w = *(const u32x4*)(O1 + (size_t)r * 2048 + 1536 + cb); unpack8(w, x1); }
            { const u32x4 w = *(const u32x4*)(pm + C_RG_Y + cb); unpack8(w, y); }
#pragma unroll
            for (int j = 0; j < 8; ++j) o[j] = gelu_tanh(y[j]) * (x0[j] + x1[j]);
            *(u32x4*)(O + ((size_t)3 * MT + r) * 512 + cb) = pack8(o);
        }
    }
}

__device__ __forceinline__ void route1_phase(const Ctx& c) {
    ARGS_REF a = *c.a; const int lane = c.lane;
    const float* modv = (const float*)(a.ws + WS_MOD) + (size_t)1 * 3 * 12288 + 3 * 2048;
    const float* normw = a.in[I_NORMW] + (1 * 2 + 1) * 2048;
    const float* router = a.in[I_ROUTER];
    bf16_t* H = (bf16_t*)(a.ws + WS_H);
    unsigned* topi = (unsigned*)(a.ws + WS_TOPI); float* topw = (float*)(a.ws + WS_TOPW);
    volatile LAS int* hist = (volatile LAS int*)(c.lds + LDS_AUX);
    if (c.tid < 8) hist[c.tid] = 0;
    __syncthreads();
    const int rpw = ML / c.G;
    for (int rr = c.wave; rr < rpw; rr += 8) {
        const int r = c.wg * rpw + rr, b = r >> 14;
        const float* src = (const float*)a.out + (size_t)r * D;
        f32x4 v[8];
#pragma unroll
        for (int j = 0; j < 8; ++j) v[j] = *(const f32x4*)(src + (j * 64 + lane) * 4);
        const float* shift = modv + (size_t)b * 12288;
        modnorm_row(v, normw, shift, shift + 2048, lane);
        store_row_bf16(v, H + (size_t)r * D, lane);
        float lg[8];
#pragma unroll
        for (int e = 0; e < 8; ++e) lg[e] = 0.f;
#pragma unroll
        for (int j = 0; j < 8; ++j)
#pragma unroll
            for (int q = 0; q < 4; ++q) { const int cc = (j * 64 + lane) * 4 + q; const f32x4 r0 = *(const f32x4*)(router + cc * 8), r1 = *(const f32x4*)(router + cc * 8 + 4); const float x = v[j][q];
                lg[0] += x * r0[0]; lg[1] += x * r0[1]; lg[2] += x * r0[2]; lg[3] += x * r0[3]; lg[4] += x * r1[0]; lg[5] += x * r1[1]; lg[6] += x * r1[2]; lg[7] += x * r1[3]; }
#pragma unroll
        for (int e = 0; e < 8; ++e) lg[e] = wave_sum(lg[e]);
        int e0 = 0; float m0 = lg[0];
#pragma unroll
        for (int e = 1; e < 8; ++e) if (lg[e] > m0) { m0 = lg[e]; e0 = e; }
        int e1 = -1; float m1 = -3.0e38f;
#pragma unroll
        for (int e = 0; e < 8; ++e) if (e != e0 && lg[e] > m1) { m1 = lg[e]; e1 = e; }
        if (e1 < 0) { e1 = (e0 + 1) & 7; m1 = m0; }
        if (lane == 0) { const float ex = __expf(m1 - m0); const float w0 = 1.0f / (1.0f + ex); topi[r] = (unsigned)e0 | ((unsigned)e1 << 8); topw[2 * r] = w0; topw[2 * r + 1] = ex * w0;
            lds_add(&hist[e0]); lds_add(&hist[e1]); }
    }
    __syncthreads();
    if (c.tid < 8) ((int*)(a.ws + WS_CTL + CTL_WGH))[c.wg * 8 + c.tid] = hist[c.tid];
}
__device__ __forceinline__ void route2_phase(const Ctx& c) {
    ARGS_REF a = *c.a; const int lane = c.lane, tid = c.tid;
    const int* wgh = (const int*)(a.ws + WS_CTL + CTL_WGH);
    volatile LAS int* tab = (volatile LAS int*)(c.lds + LDS_AUX);
    if (tid < 8) { int tot = 0, base = 0; for (int w = 0; w < c.G; ++w) { const int v = wgh[w * 8 + tid]; tot += v; if (w < c.wg) base += v; } tab[tid] = tot; tab[8 + tid] = base; tab[24 + tid] = 0; tab[32 + tid] = (tot + 255) / 256 * 256; }
    __syncthreads();
    if (tid == 0) { int acc = 0; for (int e = 0; e < 8; ++e) { tab[16 + e] = acc; acc += tab[32 + e]; }
        if (c.wg == 0) { int* meta = (int*)(a.ws + WS_CTL + CTL_META); int cum = 0; for (int e = 0; e < 8; ++e) { cum += tab[32 + e] / 256; meta[e] = cum; } meta[8] = cum; } }
    __syncthreads();
    const bf16_t* H = (const bf16_t*)(a.ws + WS_H); bf16_t* GATH = (bf16_t*)(a.ws + WS_GATH);
    const unsigned* topi = (const unsigned*)(a.ws + WS_TOPI); int* dest = (int*)(a.ws + WS_DEST);
    const int rpw = ML / c.G;
    for (int rr = c.wave; rr < rpw; rr += 8) {
        const int r = c.wg * rpw + rr; const unsigned ti = topi[r]; const int e0 = ti & 255, e1 = (ti >> 8) & 255;
        int d0 = 0, d1 = 0;
        if (lane == 0) { d0 = tab[16 + e0] + tab[8 + e0] + lds_add(&tab[24 + e0]); d1 = tab[16 + e1] + tab[8 + e1] + lds_add(&tab[24 + e1]); dest[2 * r] = d0; dest[2 * r + 1] = d1; }
        d0 = __shfl(d0, 0); d1 = __shfl(d1, 0);
        const u32x4* sp = (const u32x4*)(H + (size_t)r * D); u32x4* p0 = (u32x4*)(GATH + (size_t)d0 * D); u32x4* p1 = (u32x4*)(GATH + (size_t)d1 * D);
#pragma unroll
        for (int j = 0; j < 4; ++j) { const u32x4 w = sp[j * 64 + lane]; p0[j * 64 + lane] = w; p1[j * 64 + lane] = w; }
    }
    if (c.wg < 8) { const int e = c.wg; const int lo = tab[16 + e] + tab[e], hi = tab[16 + e] + tab[32 + e]; const u32x4 z = {0u, 0u, 0u, 0u};
        for (int r = lo + c.wave; r < hi; r += 8) { u32x4* p = (u32x4*)(GATH + (size_t)r * D);
#pragma unroll
            for (int j = 0; j < 4; ++j) p[j * 64 + lane] = z; } }
}
__device__ __forceinline__ void final_phase(const Ctx& c) {
    ARGS_REF a = *c.a; const int gw = c.wg * 8 + c.wave, nw = c.G * 8, lane = c.lane;
    const float* modv = (const float*)(a.ws + WS_MOD) + (size_t)1 * 3 * 12288 + 5 * 2048;
    const bf16_t* Y = (const bf16_t*)(a.ws + WS_GATH); const int* dest = (const int*)(a.ws + WS_DEST); const float* topw = (const float*)(a.ws + WS_TOPW);
    const float* fw = a.in[I_FNORMW];
    for (int r = gw; r < ML; r += nw) {
        const int b = r >> 14; float* xr = a.out + (size_t)r * D; const float* mg = modv + (size_t)b * 12288;
        const int d0 = dest[2 * r], d1 = dest[2 * r + 1]; const float w0 = topw[2 * r], w1 = topw[2 * r + 1];
        const bf16_t* y0 = Y + (size_t)d0 * D; const bf16_t* y1 = Y + (size_t)d1 * D;
        f32x4 v[8]; float ss = 0.f;
#pragma unroll
        for (int j = 0; j < 8; ++j) { const int cc = (j * 64 + lane) * 4; const f32x4 x = *(const f32x4*)(xr + cc), g = *(const f32x4*)(mg + cc);
            const u32x2 a0 = *(const u32x2*)(y0 + cc), a1 = *(const u32x2*)(y1 + cc);
            f32x4 m; m[0] = w0 * bflo(a0.x) + w1 * bflo(a1.x); m[1] = w0 * bfhi(a0.x) + w1 * bfhi(a1.x); m[2] = w0 * bflo(a0.y) + w1 * bflo(a1.y); m[3] = w0 * bfhi(a0.y) + w1 * bfhi(a1.y);
            v[j] = x + g * m; ss += v[j][0] * v[j][0] + v[j][1] * v[j][1] + v[j][2] * v[j][2] + v[j][3] * v[j][3]; }
        ss = wave_sum(ss); const float rstd = rsqrtf(ss * (1.0f / 2048.0f) + EPS);
#pragma unroll
        for (int j = 0; j < 8; ++j) { const int cc = (j * 64 + lane) * 4; const f32x4 w = *(const f32x4*)(fw + cc); *(f32x4*)(xr + cc) = v[j] * rstd * w; }
    }
}

#ifndef N_LAUNCHES
#define N_LAUNCHES 1
#endif
constexpr int N_PHASES = 25;

template <int L>
__device__ __forceinline__ void gemm_projmix(const Ctx& c) {
    ARGS_REF a = *c.a;
    pg8::Gemm g{(const bf16_t*)(a.ws + WS_H), (const bf16_t*)(a.ws + WS_WIN + (size_t)L * WIN_BYTES), MT, NMIXP, D};
    pg8::StaticOrder S; S.init(MT, NMIXP, c.G, c.wg);
    pg8::EpiBf16S<false> E{(bf16_t*)(a.ws + WS_PMIX), NMIXP};
    pg8::gemm_phase<pg8::EpiBf16S<false>, pg8::StaticOrder, true, true>(c.lds + LDS_SCR, g, S, E);
}
template <int L>
__device__ __forceinline__ void gemm_gate(const Ctx& c) {
    ARGS_REF a = *c.a; constexpr int M = (L == 0) ? MT : ML;
    pg8::Gemm g{(const bf16_t*)(a.ws + WS_H), (const bf16_t*)(a.ws + WS_WIN + (size_t)L * WIN_BYTES + (size_t)NMIXP * D * 2), M, NGATE, D};
    pg8::StaticOrder S; S.init(M, NGATE, c.G, c.wg);
    pg8::EpiBf16S<true> E{(bf16_t*)(a.ws + WS_PGATE), NGATE};
    pg8::gemm_phase<pg8::EpiBf16S<true>, pg8::StaticOrder, true, true>(c.lds + LDS_SCR, g, S, E);
}
template <int L>
__device__ __forceinline__ void gemm_upgate(const Ctx& c) {
    ARGS_REF a = *c.a; constexpr int M = (L == 0) ? MT : ML;
    pg8::Gemm g{(const bf16_t*)(a.ws + WS_O), (const bf16_t*)(a.ws + WS_WUP + (size_t)L * 8388608), M, 2048, 512};
    pg8::UpGateOrder S; S.init(M, c.G, c.wg, MT / 256);
    pg8::EpiUpGate E{(const bf16_t*)(a.ws + WS_PGATE), (float*)(a.ws + WS_MACC), (bf16_t*)(a.ws + WS_MERGED), MT / 256};
    pg8::gemm_phase<pg8::EpiUpGate, pg8::UpGateOrder, true, true>(c.lds + LDS_SCR, g, S, E);
}
template <int L>
__device__ __forceinline__ void gemm_wout(const Ctx& c) {
    ARGS_REF a = *c.a; constexpr int M = (L == 0) ? MT : ML;
    pg8::Gemm g{(const bf16_t*)(a.ws + WS_MERGED), (const bf16_t*)(a.ws + WS_WOUT + (size_t)L * 8388608), M, D, D};
    pg8::StaticOrder S; S.init(M, D, c.G, c.wg);
    const float* modv = (const float*)(a.ws + WS_MOD) + (size_t)L * 3 * 12288 + 2 * 2048;
    pg8::EpiResid E{L == 0 ? a.in[I_X] : (const float*)a.out, a.out, L == 0 ? a.in[I_CTX] : (const float*)(a.ws + WS_XC), (float*)(a.ws + WS_XC), modv, L == 1 ? 1 : 0};
    pg8::gemm_phase<pg8::EpiResid, pg8::StaticOrder, true, true>(c.lds + LDS_SCR, g, S, E);
}
__device__ __forceinline__ void gemm_ffn13(const Ctx& c) {
    ARGS_REF a = *c.a;
    pg8::Gemm g{(const bf16_t*)(a.ws + WS_H), (const bf16_t*)(a.ws + WS_F13), MT, 2 * FF, D};
    pg8::StaticOrder S; S.init(MT, 2 * FF, c.G, c.wg);
    pg8::EpiSwiglu E{(bf16_t*)(a.ws + WS_HID), 2 * FF / 256};
    pg8::gemm_phase<pg8::EpiSwiglu, pg8::StaticOrder, true, true>(c.lds + LDS_SCR, g, S, E);
}
__device__ __forceinline__ void gemm_ffn2(const Ctx& c) {
    ARGS_REF a = *c.a;
    pg8::Gemm g{(const bf16_t*)(a.ws + WS_HID), (const bf16_t*)(a.ws + WS_F2), MT, D, FF};
    pg8::StaticOrder S; S.init(MT, D, c.G, c.wg);
    const float* modv = (const float*)(a.ws + WS_MOD) + (size_t)0 * 3 * 12288 + 5 * 2048;
    pg8::EpiResid E{(const float*)a.out, a.out, (const float*)(a.ws + WS_XC), (float*)(a.ws + WS_XC), modv, 0};
    pg8::gemm_phase<pg8::EpiResid, pg8::StaticOrder, true, true>(c.lds + LDS_SCR, g, S, E);
}
__device__ __forceinline__ void gemm_moe13(const Ctx& c) {
    ARGS_REF a = *c.a; const int* meta = (const int*)(a.ws + WS_CTL + CTL_META);
    int be[8];
#pragma unroll
    for (int e = 0; e < 8; ++e) be[e] = __builtin_amdgcn_readfirstlane(meta[e]);
    pg8::Gemm g{(const bf16_t*)(a.ws + WS_GATH), (const bf16_t*)(a.ws + WS_M13), MOE_ROWS, 2 * FF, D};
    pg8::MoeOrder S; S.init(be[7], 2 * FF / 256, c.G, c.wg, be);
    pg8::EpiSwiglu E{(bf16_t*)(a.ws + WS_HIDM), 2 * FF / 256};
    pg8::gemm_phase<pg8::EpiSwiglu, pg8::MoeOrder, true, true>(c.lds + LDS_SCR, g, S, E);
}
__device__ __forceinline__ void gemm_moe2(const Ctx& c) {
    ARGS_REF a = *c.a; const int* meta = (const int*)(a.ws + WS_CTL + CTL_META);
    int be[8];
#pragma unroll
    for (int e = 0; e < 8; ++e) be[e] = __builtin_amdgcn_readfirstlane(meta[e]);
    pg8::Gemm g{(const bf16_t*)(a.ws + WS_HIDM), (const bf16_t*)(a.ws + WS_M2), MOE_ROWS, D, FF};
    pg8::MoeOrder S; S.init(be[7], D / 256, c.G, c.wg, be);
    pg8::EpiPlainBf16 E{(bf16_t*)(a.ws + WS_GATH), D, D / 256};
    pg8::gemm_phase<pg8::EpiPlainBf16, pg8::MoeOrder, true, true>(c.lds + LDS_SCR, g, S, E);
}

__device__ __forceinline__ void prologue_phase(const Ctx& c) {
    ARGS_REF a = *c.a; int rot = 0;
    mod_phase(c);
    for (int l = 0; l < 2; ++l) {
        conv_job<1>(c, a.in[I_WIN] + (size_t)l * D * DIN, nullptr, DIN, D, NPROJ, (bf16_t*)(a.ws + WS_WIN + (size_t)l * WIN_BYTES), rot);
        for (int b = 0; b < 4; ++b) conv_job<0>(c, a.in[I_WUP] + (size_t)(l * 4 + b) * 512 * D, nullptr, D, 512, D, (bf16_t*)(a.ws + WS_WUP + (size_t)l * 8388608 + (size_t)b * 2048 * 512 * 2), rot);
        conv_job<0>(c, a.in[I_WOUT] + (size_t)l * D * D, nullptr, D, D, D, (bf16_t*)(a.ws + WS_WOUT + (size_t)l * 8388608), rot);
    }
    conv_job<2>(c, a.in[I_F1], a.in[I_F3], FF, D, 2 * FF, (bf16_t*)(a.ws + WS_F13), rot);
    conv_job<0>(c, a.in[I_F2], nullptr, D, FF, D, (bf16_t*)(a.ws + WS_F2), rot);
}
__device__ __forceinline__ void moeconv_phase(const Ctx& c) {
    ARGS_REF a = *c.a; int rot = 0;
    for (int e = 0; e < 8; ++e) {
        conv_job<2>(c, a.in[I_M1] + (size_t)e * D * FF, a.in[I_M3] + (size_t)e * D * FF, FF, D, 2 * FF, (bf16_t*)(a.ws + WS_M13 + (size_t)e * 46137344), rot);
        conv_job<0>(c, a.in[I_M2] + (size_t)e * FF * D, nullptr, D, FF, D, (bf16_t*)(a.ws + WS_M2 + (size_t)e * 23068672), rot);
    }
}

__global__ void __launch_bounds__(512, 2) fwd_kernel(Args args) {
    extern __shared__ __attribute__((aligned(16))) unsigned char lds_raw[];
    volatile LAS unsigned* misc = (volatile LAS unsigned*)((LAS unsigned char*)lds_raw + LDS_MISC);
    if (threadIdx.x < 16) misc[threadIdx.x] = 0u;
    __syncthreads();
    const int lo = args.ph_lo, hi = args.ph_hi;
    XcdBarrier bar; bar.bar = (unsigned*)(args.ws + WS_CTL + CTL_BAR); bar.x = 0; bar.st = misc;
    if (hi - lo > 1) bar = xcd_barrier_post((unsigned*)(args.ws + WS_CTL + CTL_BAR), misc);
#define IN(k) (lo <= (k) && (k) < hi)
#define MKCTX Ctx c; { int t_ = threadIdx.x; asm volatile("" : "+v"(t_)); { ArgsP kp_ = (ArgsP)__builtin_amdgcn_kernarg_segment_ptr(); asm volatile("" : "+s"(kp_)); c.a = kp_; } c.lds = (LAS unsigned char*)lds_raw; c.tid = t_; c.lane = t_ & 63; c.wave = __builtin_amdgcn_readfirstlane(t_ >> 6); c.wg = blockIdx.x; c.G = gridDim.x; }
#ifndef PROBE_MASK
#define PROBE_MASK 0u
#endif
#define REP(k, ...) if ((PROBE_MASK >> (k)) & 1u) { __syncthreads(); __VA_ARGS__; }
#define SEAM(k) do { if (IN(k) && IN((k) + 1)) xcd_barrier(bar); } while (0)
    if (IN(0)) { MKCTX prologue_phase(c); REP(0, prologue_phase(c)) } SEAM(0);
    if (IN(1)) { MKCTX norm_phase<0, 0>(c); REP(1, norm_phase<0, 0>(c)) } SEAM(1);
    if (IN(2)) { MKCTX gemm_projmix<0>(c); REP(2, gemm_projmix<0>(c)) } SEAM(2);
    if (IN(3)) { MKCTX intra_phase<0>(c); REP(3, intra_phase<0>(c)) } SEAM(3);
    if (IN(4)) { MKCTX chains_phase<0>(c); REP(4, chains_phase<0>(c)) } SEAM(4);
    if (IN(5)) { MKCTX combine_phase<0>(c); REP(5, combine_phase<0>(c)) } SEAM(5);
    if (IN(6)) { MKCTX gemm_gate<0>(c); REP(6, gemm_gate<0>(c)) } SEAM(6);
    if (IN(7)) { MKCTX gemm_upgate<0>(c); REP(7, gemm_upgate<0>(c)) } SEAM(7);
    if (IN(8)) { MKCTX gemm_wout<0>(c); } SEAM(8);
    if (IN(9)) { MKCTX norm_phase<0, 1>(c); REP(9, norm_phase<0, 1>(c)) } SEAM(9);
    if (IN(10)) { MKCTX gemm_ffn13(c); REP(10, gemm_ffn13(c)) } SEAM(10);
    if (IN(11)) { MKCTX gemm_ffn2(c); } SEAM(11);
    if (IN(12)) { MKCTX norm_phase<1, 0>(c); REP(12, norm_phase<1, 0>(c)) } SEAM(12);
    if (IN(13)) { MKCTX gemm_projmix<1>(c); REP(13, gemm_projmix<1>(c)) } SEAM(13);
    if (IN(14)) { MKCTX intra_phase<1>(c); REP(14, intra_phase<1>(c)) } SEAM(14);
    if (IN(15)) { MKCTX chains_phase<1>(c); REP(15, chains_phase<1>(c)) } SEAM(15);
    if (IN(16)) { MKCTX combine_phase<1>(c); REP(16, combine_phase<1>(c)) } SEAM(16);
    if (IN(17)) { MKCTX gemm_gate<1>(c); REP(17, gemm_gate<1>(c)) } SEAM(17);
    if (IN(18)) { MKCTX gemm_upgate<1>(c); REP(18, gemm_upgate<1>(c)) } SEAM(18);
    if (IN(19)) { MKCTX gemm_wout<1>(c); } SEAM(19);
    if (IN(20)) { MKCTX route1_phase(c); __syncthreads(); moeconv_phase(c); REP(20, route1_phase(c); __syncthreads(); moeconv_phase(c)) } SEAM(20);
    if (IN(21)) { MKCTX route2_phase(c); REP(21, route2_phase(c)) } SEAM(21);
    if (IN(22)) { MKCTX gemm_moe13(c); REP(22, gemm_moe13(c)) } SEAM(22);
    if (IN(23)) { MKCTX gemm_moe2(c); REP(23, gemm_moe2(c)) } SEAM(23);
    if (IN(24)) { MKCTX final_phase(c); }
#undef IN
#undef SEAM
}

extern "C" void kernel_launch(void* const* d_in, const int* in_sizes, int n_in, void* d_out, int out_size, void* d_ws, size_t ws_size, hipStream_t stream) {
    static int grid = 0;
    if (grid == 0) {
        if (n_in != N_IN || out_size != ML * D || ws_size < WS_END) { fprintf(stderr, "kernel_launch: unexpected shapes: n_in %d out %d ws %zu (need %zu)\n", n_in, out_size, ws_size, (size_t)WS_END); grid = -1; return; }
        int dev = 0, cus = 0;
        if (hipGetDevice(&dev) != hipSuccess || hipDeviceGetAttribute(&cus, hipDeviceAttributeMultiprocessorCount, dev) != hipSuccess) { grid = -1; return; }
        if (hipFuncSetAttribute((const void*)fwd_kernel, hipFuncAttributeMaxDynamicSharedMemorySize, LDS_BYTES) != hipSuccess) { fprintf(stderr, "kernel_launch: hipFuncSetAttribute failed\n"); grid = -1; return; }
        int per_cu = 0;
        if (hipOccupancyMaxActiveBlocksPerMultiprocessor(&per_cu, (const void*)fwd_kernel, 512, LDS_BYTES) != hipSuccess || per_cu < 1) { fprintf(stderr, "kernel_launch: occupancy query says %d\n", per_cu); }
        (void)hipGetLastError();
        grid = cus > 256 ? 256 : cus;
    }
    if (grid < 0) return;
    (void)hipMemsetAsync((char*)d_ws + WS_CTL, 0, CTL_BYTES, stream);
    Args a{};
    for (int i = 0; i < N_IN; ++i) a.in[i] = (const float*)d_in[i];
    a.out = (float*)d_out; a.ws = (unsigned char*)d_ws;
#if N_LAUNCHES == 1
    a.ph_lo = 0; a.ph_hi = N_PHASES;
    hipLaunchKernelGGL(fwd_kernel, dim3(grid), dim3(512), LDS_BYTES, stream, a);
#else
    for (int p = 0; p < N_PHASES; ++p) { a.ph_lo = p; a.ph_hi = p + 1; hipLaunchKernelGGL(fwd_kernel, dim3(grid), dim3(512), LDS_BYTES, stream, a); }
#endif
}
```

```cpp
#include <hip/hip_runtime.h>
#include <cstdio>
#include <cstdint>
#define N_LAUNCHES 1
namespace pg8 {
#define PG8_LAS __attribute__((address_space(3)))
typedef unsigned short bf16_t;
typedef short bf16x8 __attribute__((ext_vector_type(8)));
typedef float f32x4 __attribute__((ext_vector_type(4)));
typedef unsigned u32x4 __attribute__((ext_vector_type(4)));
constexpr int BM = 256, BK = 64, HALF = 128, HTB = HALF * BK * 2  , STAGE_BYTES = 8 * HTB, NXCD = 8, WGM = 8;

__host__ __device__ __forceinline__ int lds_byte(int r, int c) { const int st = (r >> 4) * 2 + (c >> 5), rr = r & 15, cc = c & 31, ob = rr * 64 + cc * 2; return st * 1024 + (ob ^ (((ob >> 9) & 1) << 5)); }
__host__ __device__ __forceinline__ void stage_rc(int b, int& R, int& C) { const int st = b / 1024, sb = b % 1024, swz = sb ^ (((sb >> 9) & 1) << 5); R = (st >> 1) * 16 + swz / 64; C = (st & 1) * 32 + (swz % 64) / 2; }
__host__ __device__ __forceinline__ int perm32(int rho) { const int n = rho >> 4, i = rho & 15; return 8 * (i >> 2) + 4 * n + (i & 3); }

struct Unit { int pm, pn; };
struct Gemm { const bf16_t* A; const bf16_t* Bt; int M, N, K; };

struct StaticOrder {
    int nM, nN, nwg, G, c;
    __host__ __device__ void init(int M, int N, int G_, int c_) { nM = M / BM; nN = N / BM; nwg = nM * nN; G = G_; c = c_; }
    __host__ __device__ bool next(int i, Unit& u) const {
        const long L = (long)i * G + c; if (L >= nwg) return false;
        int wgid = (int)L; { const int q = nwg / NXCD, r = nwg % NXCD, xcd = wgid % NXCD, off = wgid / NXCD; wgid = (xcd < r ? xcd * (q + 1) : r * (q + 1) + (xcd - r) * q) + off; }
        const int nig = WGM * nN, gid = wgid / nig, fm = gid * WGM, gsz = (nM - fm) < WGM ? (nM - fm) : WGM;
        u.pm = fm + ((wgid % nig) % gsz); u.pn = (wgid % nig) / gsz; return true;
    }
    __device__ __forceinline__ void a_ready(const Unit&) const {}
    __device__ __forceinline__ void done(const Unit&) const {}
};
__device__ __forceinline__ unsigned cvt_pk_bf16(float lo, float hi) { unsigned r; asm volatile("v_cvt_pk_bf16_f32 %0, %1, %2" : "=v"(r) : "v"(lo), "v"(hi)); return r; }
typedef __bf16 bf16x2_t __attribute__((ext_vector_type(2)));
typedef float f32x2c_t __attribute__((ext_vector_type(2)));
__device__ __forceinline__ unsigned cvt_pk_bf16_safe(float lo, float hi) { const f32x2c_t v = {lo, hi}; return __builtin_bit_cast(unsigned, __builtin_convertvector(v, bf16x2_t)); }
template <class Epi, class Sched, bool ALIGN_EPI = false, bool SP2 = false>
__device__ __forceinline__ void gemm_phase(PG8_LAS unsigned char* lds, const Gemm g, const Sched& S, const Epi& E) {
    int tid_ = threadIdx.x; asm volatile("" : "+v"(tid_));
    const int tid = tid_, wid = __builtin_amdgcn_readfirstlane(tid >> 6), lane = tid & 63, wr = wid >> 2, wc = wid & 3, fr = lane & 15, fq = lane >> 4;
    const int K = g.K, nt = K / BK;
    unsigned voffA[2], voffB[2];
#pragma unroll
    for (int i = 0; i < 2; ++i) { int R, C; stage_rc(tid * 16 + i * 8192, R, C); const int Rb = Epi::PERM ? ((R & ~31) + perm32(R & 31)) : R;
        voffA[i] = (unsigned)(R * K + C) * 2u; voffB[i] = (unsigned)(Rb * K + C) * 2u; }
    const size_t kstep = (size_t)(BK * 2);
    const size_t hstep = (size_t)HALF * K * 2;
    const size_t tstep = 2 * hstep;
    const unsigned ldsw = (unsigned)wid * 1024u;
    const int aoff = lds_byte(wr * 64 + fr, fq * 8), boff = lds_byte(wc * 32 + fr, fq * 8);
#define PG8_SA(b, h) (((b) * 2 + (h)) * HTB)
#define PG8_SB(b, h) ((4 + (b) * 2 + (h)) * HTB)
#define PG8_STAGE(bufoff, gbase, voff) do { _Pragma("unroll") for (int _i = 0; _i < 2; ++_i) \
        __builtin_amdgcn_global_load_lds((const unsigned*)((const char*)(gbase) + (voff)[_i]), (PG8_LAS unsigned*)(lds + (bufoff) + ldsw + _i * 8192), 16, 0, 0); } while (0)
#define PG8_LDA(dst, b, h) do { _Pragma("unroll") for (int m = 0; m < 4; ++m) _Pragma("unroll") for (int k = 0; k < 2; ++k) dst[m][k] = *(const PG8_LAS bf16x8*)(lds + PG8_SA(b, h) + aoff + m * 2048 + k * 1024); } while (0)
#define PG8_LDB(dst, b, h) do { _Pragma("unroll") for (int n = 0; n < 2; ++n) _Pragma("unroll") for (int k = 0; k < 2; ++k) dst[n][k] = *(const PG8_LAS bf16x8*)(lds + PG8_SB(b, h) + boff + n * 2048 + k * 1024); } while (0)
#define PG8_MMA(ai, bj, At, Bt) do { __builtin_amdgcn_s_setprio(1); _Pragma("unroll") for (int m = 0; m < 4; ++m) _Pragma("unroll") for (int n = 0; n < 2; ++n) _Pragma("unroll") for (int k = 0; k < 2; ++k) \
        acc[ai][bj][m][n] = __builtin_amdgcn_mfma_f32_16x16x32_bf16(Bt[n][k], At[m][k], acc[ai][bj][m][n], 0, 0, 0); __builtin_amdgcn_s_setprio(0); } while (0)
#define PG8_WAIT_V(n) asm volatile("s_waitcnt vmcnt(" #n ")" ::: "memory")
#define PG8_WAIT_L(n) asm volatile("s_waitcnt lgkmcnt(" #n ")" ::: "memory")
#define PG8_BAR __builtin_amdgcn_s_barrier()
#define PG8_SCHED __builtin_amdgcn_sched_barrier(0)
    Unit cur, nxt; int ui = 0;
    if (!S.next(0, cur)) return;
    f32x4 acc[2][2][4][2];
#pragma unroll
    for (int a = 0; a < 2; ++a)
#pragma unroll
        for (int b = 0; b < 2; ++b)
#pragma unroll
            for (int m = 0; m < 4; ++m)
#pragma unroll
                for (int n = 0; n < 2; ++n) acc[a][b][m][n] = (f32x4){0.f, 0.f, 0.f, 0.f};
    bf16x8 At[4][2], B0[2][2], B1[2][2];
    const char* cA = (const char*)g.A + (size_t)cur.pm * tstep; const char* cB = (const char*)g.Bt + (size_t)cur.pn * tstep;
    S.a_ready(cur);
    if constexpr (SP2) {
        PG8_STAGE(PG8_SB(0, 0), cB, voffB); PG8_STAGE(PG8_SB(0, 1), cB + hstep, voffB); PG8_STAGE(PG8_SA(0, 0), cA, voffA); PG8_STAGE(PG8_SA(0, 1), cA + hstep, voffA);
        if (wr == 1) PG8_BAR;
        PG8_WAIT_V(2); PG8_BAR;
        PG8_STAGE(PG8_SB(1, 0), cB + kstep, voffB); PG8_STAGE(PG8_SA(1, 0), cA + kstep, voffA); PG8_STAGE(PG8_SB(1, 1), cB + hstep + kstep, voffB);
        PG8_WAIT_V(6); PG8_BAR;
    } else {
        PG8_STAGE(PG8_SB(0, 0), cB, voffB); PG8_STAGE(PG8_SA(0, 0), cA, voffA); PG8_STAGE(PG8_SB(0, 1), cB + hstep, voffB); PG8_STAGE(PG8_SA(0, 1), cA + hstep, voffA);
        if (wr == 1) PG8_BAR;
        PG8_WAIT_V(4); PG8_BAR;
        PG8_STAGE(PG8_SB(1, 0), cB + kstep, voffB); PG8_STAGE(PG8_SA(1, 0), cA + kstep, voffA); PG8_STAGE(PG8_SB(1, 1), cB + hstep + kstep, voffB);
        PG8_WAIT_V(6); PG8_BAR;
    }
    for (;;) {
        const bool has_next = S.next(ui + 1, nxt);
        const char* nA = has_next ? (const char*)g.A + (size_t)nxt.pm * tstep : cA; const char* nB = has_next ? (const char*)g.Bt + (size_t)nxt.pn * tstep : cB;
        for (int t = 0; t < nt; t += 2) {
            const bool last = (t == nt - 2);
            const char* a1 = cA + (size_t)(t + 1) * kstep;
            const char* a2 = last ? nA : cA + (size_t)(t + 2) * kstep; const char* b2 = last ? nB : cB + (size_t)(t + 2) * kstep;
            const char* a3 = a2 + kstep; const char* b3 = b2 + kstep;
            if (last && has_next) S.a_ready(nxt);
            if constexpr (SP2) {
            PG8_LDB(B0, 0, 0); PG8_LDB(B1, 0, 1); PG8_SCHED; PG8_LDA(At, 0, 0); PG8_STAGE(PG8_SA(1, 1), a1 + hstep, voffA);
            PG8_WAIT_V(8); PG8_WAIT_L(0); PG8_BAR; PG8_MMA(0, 0, At, B0); PG8_MMA(0, 1, At, B1); PG8_BAR; PG8_SCHED;
            PG8_LDA(At, 0, 1); PG8_STAGE(PG8_SB(0, 0), b2, voffB); PG8_STAGE(PG8_SB(0, 1), b2 + hstep, voffB); PG8_STAGE(PG8_SA(0, 0), a2, voffA);
            PG8_WAIT_V(8); PG8_WAIT_L(0); PG8_BAR; PG8_MMA(1, 0, At, B0); PG8_MMA(1, 1, At, B1); PG8_BAR; PG8_SCHED;
            PG8_LDB(B0, 1, 0); PG8_LDB(B1, 1, 1); PG8_SCHED; PG8_LDA(At, 1, 0); PG8_STAGE(PG8_SA(0, 1), a2 + hstep, voffA);
            PG8_WAIT_V(8); PG8_WAIT_L(0); PG8_BAR; PG8_MMA(0, 0, At, B0); PG8_MMA(0, 1, At, B1); PG8_BAR; PG8_SCHED;
            PG8_LDA(At, 1, 1); PG8_STAGE(PG8_SB(1, 0), b3, voffB); PG8_STAGE(PG8_SB(1, 1), b3 + hstep, voffB); PG8_STAGE(PG8_SA(1, 0), a3, voffA);
            PG8_WAIT_V(8); PG8_WAIT_L(0); PG8_BAR; PG8_MMA(1, 0, At, B0); PG8_MMA(1, 1, At, B1); PG8_BAR; PG8_SCHED;
            } else {
            PG8_LDB(B0, 0, 0); PG8_SCHED; PG8_LDA(At, 0, 0); PG8_STAGE(PG8_SA(1, 1), a1 + hstep, voffA);
            PG8_WAIT_L(8); PG8_BAR; PG8_WAIT_L(0); PG8_MMA(0, 0, At, B0); PG8_BAR; PG8_SCHED;
            PG8_LDB(B1, 0, 1); PG8_STAGE(PG8_SB(0, 0), b2, voffB);
            PG8_BAR; PG8_WAIT_L(0); PG8_MMA(0, 1, At, B1); PG8_BAR;
            PG8_LDA(At, 0, 1); PG8_STAGE(PG8_SA(0, 0), a2, voffA);
            PG8_BAR; PG8_WAIT_L(0); PG8_MMA(1, 0, At, B0); PG8_BAR; PG8_SCHED;
            PG8_STAGE(PG8_SB(0, 1), b2 + hstep, voffB);
            PG8_WAIT_V(6); PG8_BAR; PG8_MMA(1, 1, At, B1); PG8_BAR;
            PG8_LDB(B0, 1, 0); PG8_SCHED; PG8_LDA(At, 1, 0); PG8_STAGE(PG8_SA(0, 1), a2 + hstep, voffA);
            PG8_WAIT_L(8); PG8_BAR; PG8_WAIT_L(0); PG8_MMA(0, 0, At, B0); PG8_BAR; PG8_SCHED;
            PG8_LDB(B1, 1, 1); PG8_STAGE(PG8_SB(1, 0), b3, voffB);
            PG8_BAR; PG8_WAIT_L(0); PG8_MMA(0, 1, At, B1); PG8_BAR;
            PG8_LDA(At, 1, 1); PG8_STAGE(PG8_SA(1, 0), a3, voffA);
            PG8_BAR; PG8_WAIT_L(0); PG8_MMA(1, 0, At, B0); PG8_BAR; PG8_SCHED;
            PG8_STAGE(PG8_SB(1, 1), b3 + hstep, voffB);
            PG8_WAIT_V(6); PG8_BAR; PG8_MMA(1, 1, At, B1); PG8_BAR;
            }
        }
        if constexpr (ALIGN_EPI) { if (wr == 0) PG8_BAR; }
        if constexpr (!Epi::AFTER_DRAIN) { E(acc, cur, wr, wc, fr, fq); S.done(cur); }
        if (!has_next) break;
#pragma unroll
        for (int a = 0; a < 2; ++a)
#pragma unroll
            for (int b = 0; b < 2; ++b)
#pragma unroll
                for (int m = 0; m < 4; ++m)
#pragma unroll
                    for (int n = 0; n < 2; ++n) acc[a][b][m][n] = (f32x4){0.f, 0.f, 0.f, 0.f};
        cur = nxt; cA = nA; cB = nB; ++ui;
        if constexpr (ALIGN_EPI) { if (wr == 1) PG8_BAR; }
    }
    PG8_WAIT_V(0);
    if constexpr (!ALIGN_EPI) { if (wr == 0) PG8_BAR; }
    PG8_BAR;
    if constexpr (Epi::AFTER_DRAIN) { E.fused(acc, cur, wr, wc, fr, fq, lds, wid, lane); S.done(cur); }
#undef PG8_SA
#undef PG8_SB
#undef PG8_STAGE
#undef PG8_LDA
#undef PG8_LDB
#undef PG8_MMA
#undef PG8_WAIT_V
#undef PG8_WAIT_L
#undef PG8_BAR
#undef PG8_SCHED
}
}
#define XB_TMO      128
#define XB_XCNT(j)  (256  + 64 * (j))
#define XB_XSUB(j)  (1280 + 64 * (j))
#define XB_XGEN(j)  (2304 + 64 * (j))
#define XB_TOP      3328
#define XB_TOPGEN   3392
#define XCD_BAR_WORDS 3456
#define XB_SPIN_CAP (1u << 18)
#define LAS __attribute__((address_space(3)))

__device__ __forceinline__ unsigned xb_ld(unsigned* p)              { return __hip_atomic_load(p, __ATOMIC_RELAXED, __HIP_MEMORY_SCOPE_AGENT); }
__device__ __forceinline__ unsigned xb_add(unsigned* p, unsigned v) { return __hip_atomic_fetch_add(p, v, __ATOMIC_RELAXED, __HIP_MEMORY_SCOPE_AGENT); }
__device__ __forceinline__ unsigned xb_xcc_id() { return (unsigned)__builtin_amdgcn_s_getreg((3 << 11) | 20) & 0xFu; }
#define XB_SPIN(cond, bar) do { unsigned _sp = 0; while (cond) { __builtin_amdgcn_s_sleep(1); \
    if ((++_sp & 255u) == 0u) { if (xb_ld(&(bar)[XB_TMO])) break; if (_sp > XB_SPIN_CAP) { atomicAdd(&(bar)[XB_TMO], 1u); break; } } } } while (0)

struct XcdBarrier {
    unsigned* bar; unsigned x;
    volatile LAS unsigned* st;
};

__device__ __forceinline__ XcdBarrier xcd_barrier_post(unsigned* bar, volatile LAS unsigned* st) {
    XcdBarrier b; b.bar = bar; b.x = xb_xcc_id(); b.st = st;
    if (threadIdx.x == 0) (void)xb_add(&bar[XB_XCNT(b.x)], 1u);
    return b;
}
__device__ __forceinline__ void xcd_barrier_complete(unsigned* bar, unsigned x, unsigned& nloc, unsigned& nx) {
    const unsigned G = gridDim.x * gridDim.y * gridDim.z;
    unsigned sum, cnt, mine, sp = 0u;
    for (;;) {
        sum = 0u; cnt = 0u; mine = 0u;
#pragma unroll
        for (unsigned j = 0; j < 16; ++j) { const unsigned c = xb_ld(&bar[XB_XCNT(j)]); sum += c; cnt += (c > 0u) ? 1u : 0u; mine = (j == x) ? c : mine; }
        if (sum == G) break;
        __builtin_amdgcn_s_sleep(1);
        if ((++sp & 255u) == 0u) { if (xb_ld(&bar[XB_TMO])) break; if (sp > XB_SPIN_CAP) { atomicAdd(&bar[XB_TMO], 1u); break; } }
    }
    nloc = mine > 0u ? mine : 1u; nx = cnt > 0u ? cnt : 1u;
}

__device__ __forceinline__ void xcd_barrier(const XcdBarrier& b) {
    asm volatile("s_waitcnt vmcnt(0)" ::: "memory");
    __syncthreads();
    if (threadIdx.x == 0) {
        unsigned* bar = b.bar;
        __builtin_amdgcn_s_waitcnt(0);
        unsigned nloc = b.st[0], nx = b.st[1];
        if (nloc == 0u) { xcd_barrier_complete(bar, b.x, nloc, nx); b.st[0] = nloc; b.st[1] = nx; }
        const unsigned old = xb_add(&bar[XB_XSUB(b.x)], 1u);
        const unsigned gen = old / nloc;
        if (old + 1u == (gen + 1u) * nloc) {
            __builtin_amdgcn_fence(__ATOMIC_RELEASE, "agent");
            asm volatile("s_waitcnt vmcnt(0)" ::: "memory");
            const unsigned og = xb_add(&bar[XB_TOP], 1u);
            const unsigned tg = og / nx;
            if (og + 1u == (tg + 1u) * nx) xb_add(&bar[XB_TOPGEN], 1u);
            else XB_SPIN(xb_ld(&bar[XB_TOPGEN]) == tg, bar);
            __builtin_amdgcn_fence(__ATOMIC_ACQUIRE, "agent");
            xb_add(&bar[XB_XGEN(b.x)], 1u);
            asm volatile("s_waitcnt vmcnt(0)" ::: "memory");
        } else {
            XB_SPIN(xb_ld(&bar[XB_XGEN(b.x)]) == gen, bar);
            __builtin_amdgcn_fence(__ATOMIC_ACQUIRE, "agent");
            asm volatile("s_waitcnt vmcnt(0)" ::: "memory");
        }
    }
    __syncthreads();
}


typedef pg8::bf16_t bf16_t;
typedef pg8::f32x4 f32x4;
typedef pg8::u32x4 u32x4;
typedef unsigned u32x2 __attribute__((ext_vector_type(2)));

constexpr int D = 2048, NB = 2, T = 16384, CL = 256;
constexpr int ML = NB * T;
constexpr int MC = NB * CL;
constexpr int MT = ML + MC;
constexpr int NMIX = 7216, NMIXP = 7424, NGATE = 8192, NPROJ = NMIXP + NGATE;
constexpr int DIN = 15408;
constexpr int FF = 5632, NE = 8;
constexpr int MOE_ROWS = 67584;
constexpr int C_GLA_Q = 0, C_GLA_K = 256, C_GLA_V = 512, C_GLA_G = 1024, C_GLA_A = 1536;
constexpr int C_HG_Q = 1568, C_HG_F = 2080, C_HG_I = 3104, C_HG_G = 3616;
constexpr int C_DN_Q = 4128, C_DN_K = 4640, C_DN_V = 5152, C_DN_A = 5664, C_DN_B = 5672, C_DN_G = 5680;
constexpr int C_RG_X = 6192, C_RG_Y = 6704;
constexpr float EPS = 1e-6f;

enum { I_X = 0, I_C, I_CTX, I_CCTX, I_WMOD, I_BMOD, I_NORMW, I_FNORMW, I_WIN, I_WUP, I_WOUT, I_GLA_WA2, I_GLA_BA2, I_GLA_NW, I_HG_LB, I_HG_NW,
       I_DN_CW, I_DN_ALOG, I_DN_DTB, I_DN_NW, I_RG_CW, I_RG_CB, I_RG_WR, I_RG_BR, I_RG_WI, I_RG_BI, I_RG_LAM, I_F1, I_F3, I_F2, I_ROUTER, I_M1, I_M3, I_M2, N_IN };

constexpr size_t WS_CTL = 0, CTL_BYTES = 65536;
constexpr size_t CTL_BAR = 0, CTL_WGH = 16384, CTL_META = 24576;
constexpr size_t WS_MOD = WS_CTL + CTL_BYTES;
constexpr size_t WS_XC = WS_MOD + 294912;
constexpr size_t WS_TOPI = WS_XC + 4194304;
constexpr size_t WS_TOPW = WS_TOPI + 131072;
constexpr size_t WS_DEST = WS_TOPW + 262144;
constexpr size_t WIN_BYTES = (size_t)NPROJ * D * 2;
constexpr size_t WS_WIN = WS_DEST + 262144;
constexpr size_t WS_WUP = WS_WIN + 2 * WIN_BYTES;
constexpr size_t WS_WOUT = WS_WUP + 2 * 8388608;
constexpr size_t WS_F13 = WS_WOUT + 2 * 8388608;
constexpr size_t WS_F2 = WS_F13 + 46137344;
constexpr size_t WS_RGW = WS_F2 + 23068672;
constexpr size_t WS_H = WS_RGW + 1048576;
constexpr size_t WS_BIG = WS_H + 136314880;
constexpr size_t WS_PMIX = WS_BIG;
constexpr size_t WS_ORAW = WS_PMIX + 494141440;
constexpr size_t WS_RGLA = WS_ORAW + 272629760;
constexpr size_t WS_RGU = WS_RGLA + 68157440;
constexpr size_t WS_RGTT = WS_RGU, WS_RGCARRY = WS_RGU + 4259840;
constexpr size_t WS_O = WS_RGU + 68157440;
constexpr size_t WS_SCR = WS_O + 136314880;
constexpr size_t SC_GLA_VT = 0, SC_GLA_QP = SC_GLA_VT + 34078720, SC_GLA_KT = SC_GLA_QP + 34078720, SC_GLA_A = SC_GLA_KT + 34078720, SC_GLA_LAM = SC_GLA_A + 34078720;
constexpr size_t SC_HG_VT = SC_GLA_LAM + 1064960, SC_HG_QP = SC_HG_VT + 34078720, SC_HG_KT = SC_HG_QP + 68157440, SC_HG_A = SC_HG_KT + 68157440, SC_HG_LAM = SC_HG_A + 34078720;
constexpr size_t SC_DN_QS = SC_HG_LAM + 2129920, SC_DN_KT = SC_DN_QS + 34078720, SC_DN_UT = SC_DN_KT + 34078720, SC_DN_WN = SC_DN_UT + 68157440, SC_DN_AQK = SC_DN_WN + 68157440, SC_DN_SC = SC_DN_AQK + 34078720;
constexpr size_t SC_END = SC_DN_SC + 4259840;
constexpr size_t WS_PGATE = WS_SCR;
constexpr size_t WS_MACC = WS_PMIX;
constexpr size_t WS_MERGED = WS_PMIX + 272629760;
constexpr size_t WS_HID = WS_BIG;
constexpr size_t WS_M13 = WS_BIG;
constexpr size_t WS_M2 = WS_M13 + 369098752;
constexpr size_t WS_GATH = WS_M2 + 184549376;
constexpr size_t WS_HIDM = WS_GATH + 276824064;
constexpr size_t WS_END_A = WS_HIDM + 761266176, WS_END_B = WS_SCR + (SC_END > 545259520 ? SC_END : 545259520);
constexpr size_t WS_END = WS_END_A > WS_END_B ? WS_END_A : WS_END_B;
static_assert(WS_MERGED + 136314880 <= WS_PMIX + 494141440, "merged fits in pmix region");
static_assert(WS_END <= 2041000000ull, "workspace budget");

constexpr int LDS_SCR = 0;
constexpr int LDS_AUX = 131072;
constexpr int LDS_MISC = 131072 + 8192;
constexpr int LDS_BYTES = 147456;

struct Args { const float* in[N_IN]; float* out; unsigned char* ws; int ph_lo, ph_hi; };

__device__ __forceinline__ float bflo(unsigned w) { return __uint_as_float(w << 16); }
__device__ __forceinline__ float bfhi(unsigned w) { return __uint_as_float(w & 0xffff0000u); }
__device__ __forceinline__ void unpack8(const u32x4 w, float (&f)[8]) { f[0] = bflo(w.x); f[1] = bfhi(w.x); f[2] = bflo(w.y); f[3] = bfhi(w.y); f[4] = bflo(w.z); f[5] = bfhi(w.z); f[6] = bflo(w.w); f[7] = bfhi(w.w); }
typedef __bf16 bfx8_t __attribute__((ext_vector_type(8)));
typedef float f32x8 __attribute__((ext_vector_type(8)));
__device__ __forceinline__ u32x4 pack8(const float (&f)[8]) { f32x8 v;
#pragma unroll
    for (int j = 0; j < 8; ++j) v[j] = f[j];
    return __builtin_bit_cast(u32x4, __builtin_convertvector(v, bfx8_t)); }
__device__ __forceinline__ float bf1(const bf16_t* p) { return __uint_as_float(((unsigned)*p) << 16); }
__device__ __forceinline__ float sigm(float x) { return 1.0f / (1.0f + __expf(-x)); }
__device__ __forceinline__ float siluf(float x) { return x / (1.0f + __expf(-x)); }
__device__ __forceinline__ float softplusf(float x) { return fmaxf(x, 0.f) + log1pf(__expf(-fabsf(x))); }
__device__ __forceinline__ float wave_sum(float v) { v += __shfl_xor(v, 32); v += __shfl_xor(v, 16); v += __shfl_xor(v, 8); v += __shfl_xor(v, 4); v += __shfl_xor(v, 2); v += __shfl_xor(v, 1); return v; }
__device__ __forceinline__ float gelu_tanh(float y) { const float u = 0.7978845608028654f * (y + 0.044715f * y * y * y); const float e = __expf(2.f * u); const float th = 1.f - 2.f / (e + 1.f); return 0.5f * y * (1.f + th); }

namespace pg8 {
template <bool SIG> struct EpiBf16S {
    static constexpr bool PERM = true, AFTER_DRAIN = false;
    bf16_t* O; int ldc;
    __device__ __forceinline__ void operator()(const f32x4 (&acc)[2][2][4][2], const Unit& u, int wr, int wc, int fr, int fq) const {
        const int row0 = u.pm * BM + wr * 64 + fr, col0 = u.pn * BM + wc * 32 + 8 * fq;
#pragma unroll
        for (int ai = 0; ai < 2; ++ai)
#pragma unroll
            for (int m = 0; m < 4; ++m) { bf16_t* rowp = O + (size_t)(row0 + ai * HALF + m * 16) * ldc + col0;
#pragma unroll
                for (int bj = 0; bj < 2; ++bj) { f32x4 v0 = acc[ai][bj][m][0], v1 = acc[ai][bj][m][1];
                    if (SIG) {
#pragma unroll
                        for (int j = 0; j < 4; ++j) { v0[j] = sigm(v0[j]); v1[j] = sigm(v1[j]); } }
                    u32x4 w; w.x = cvt_pk_bf16_safe(v0[0], v0[1]); w.y = cvt_pk_bf16_safe(v0[2], v0[3]); w.z = cvt_pk_bf16_safe(v1[0], v1[1]); w.w = cvt_pk_bf16_safe(v1[2], v1[3]);
                    *(u32x4*)(rowp + bj * HALF) = w; } }
    }
};
struct EpiUpGate {
    static constexpr bool PERM = true, AFTER_DRAIN = false;
    const bf16_t* gate; float* macc; bf16_t* merged; int nMtot;
    __device__ __forceinline__ void operator()(const f32x4 (&acc)[2][2][4][2], const Unit& u, int wr, int wc, int fr, int fq) const {
        const int b = u.pn >> 3, pn = u.pn & 7, pm = u.pm - b * nMtot;
        const int row0 = pm * BM + wr * 64 + fr, col0 = pn * BM + wc * 32 + 8 * fq;
#pragma unroll
        for (int ai = 0; ai < 2; ++ai)
#pragma unroll
            for (int m = 0; m < 4; ++m) { const size_t r = (size_t)(row0 + ai * HALF + m * 16);
#pragma unroll
                for (int bj = 0; bj < 2; ++bj) { const int c = col0 + bj * HALF;
                    const u32x4 gw = *(const u32x4*)(gate + r * NGATE + b * 2048 + c); float g[8]; unpack8(gw, g);
                    f32x4 v0 = acc[ai][bj][m][0], v1 = acc[ai][bj][m][1];
#pragma unroll
                    for (int j = 0; j < 4; ++j) { v0[j] *= g[j]; v1[j] *= g[4 + j]; }
                    float* mp = macc + r * 2048 + c;
                    if (b > 0) { v0 += *(const f32x4*)mp; v1 += *(const f32x4*)(mp + 4); }
                    if (b < 3) { *(f32x4*)mp = v0; *(f32x4*)(mp + 4) = v1; }
                    else { u32x4 w; w.x = cvt_pk_bf16_safe(v0[0], v0[1]); w.y = cvt_pk_bf16_safe(v0[2], v0[3]); w.z = cvt_pk_bf16_safe(v1[0], v1[1]); w.w = cvt_pk_bf16_safe(v1[2], v1[3]);
                           *(u32x4*)(merged + r * 2048 + c) = w; } } }
    }
};
struct EpiResid {
    static constexpr bool PERM = false, AFTER_DRAIN = false;
    const float* srcl; float* dstl; const float* srcc; float* dstc; const float* modv;
    int permute;
    __device__ __forceinline__ void operator()(const f32x4 (&acc)[2][2][4][2], const Unit& u, int wr, int wc, int fr, int fq) const {
        const int row0 = u.pm * BM + wr * 64 + fr, col0 = u.pn * BM + wc * 32 + 4 * fq;
#pragma unroll
        for (int ai = 0; ai < 2; ++ai)
#pragma unroll
            for (int m = 0; m < 4; ++m) { const int r = row0 + ai * HALF + m * 16;
                const float* sp; float* dp; const float* mp;
                if (r < ML) { const int b = r >> 14, s = r & 16383; const int t = permute ? (((s & 255) << 6) | (s >> 8)) : s; const size_t o = ((size_t)(b << 14) + t) * D;
                    sp = srcl + o; dp = dstl + o; mp = modv + b * 12288; }
                else { const size_t o = (size_t)(r - ML) * D; sp = srcc + o; dp = dstc + o; mp = modv + 2 * 12288; }
#pragma unroll
                for (int bj = 0; bj < 2; ++bj)
#pragma unroll
                    for (int n = 0; n < 2; ++n) { const int c = col0 + bj * HALF + n * 16;
                        const f32x4 sv = *(const f32x4*)(sp + c), mv = *(const f32x4*)(mp + c);
                        *(f32x4*)(dp + c) = sv + mv * acc[ai][bj][m][n]; } }
    }
};
struct EpiSwiglu {
    static constexpr bool PERM = true, AFTER_DRAIN = false;
    bf16_t* hid; int nper;
    __device__ __forceinline__ void operator()(const f32x4 (&acc)[2][2][4][2], const Unit& u, int wr, int wc, int fr, int fq) const {
        const int pn = u.pn % nper; const int row0 = u.pm * BM + wr * 64 + fr, col0 = pn * HALF + wc * 32 + 8 * fq;
#pragma unroll
        for (int ai = 0; ai < 2; ++ai)
#pragma unroll
            for (int m = 0; m < 4; ++m) { bf16_t* rowp = hid + (size_t)(row0 + ai * HALF + m * 16) * FF + col0;
                float o[8];
#pragma unroll
                for (int n = 0; n < 2; ++n)
#pragma unroll
                    for (int j = 0; j < 4; ++j) { const float g = acc[ai][0][m][n][j], v = acc[ai][1][m][n][j]; o[n * 4 + j] = siluf(g) * v; }
                u32x4 w; w.x = cvt_pk_bf16_safe(o[0], o[1]); w.y = cvt_pk_bf16_safe(o[2], o[3]); w.z = cvt_pk_bf16_safe(o[4], o[5]); w.w = cvt_pk_bf16_safe(o[6], o[7]);
                *(u32x4*)rowp = w; }
    }
};
struct EpiPlainBf16 {
    static constexpr bool PERM = true, AFTER_DRAIN = false;
    bf16_t* O; int ldc; int nper;
    __device__ __forceinline__ void operator()(const f32x4 (&acc)[2][2][4][2], const Unit& u, int wr, int wc, int fr, int fq) const {
        const int pn = u.pn % nper; const int row0 = u.pm * BM + wr * 64 + fr, col0 = pn * BM + wc * 32 + 8 * fq;
#pragma unroll
        for (int ai = 0; ai < 2; ++ai)
#pragma unroll
            for (int m = 0; m < 4; ++m) { bf16_t* rowp = O + (size_t)(row0 + ai * HALF + m * 16) * ldc + col0;
#pragma unroll
                for (int bj = 0; bj < 2; ++bj) { const f32x4 v0 = acc[ai][bj][m][0], v1 = acc[ai][bj][m][1];
                    u32x4 w; w.x = cvt_pk_bf16_safe(v0[0], v0[1]); w.y = cvt_pk_bf16_safe(v0[2], v0[3]); w.z = cvt_pk_bf16_safe(v1[0], v1[1]); w.w = cvt_pk_bf16_safe(v1[2], v1[3]);
                    *(u32x4*)(rowp + bj * HALF) = w; } }
    }
};
struct UpGateOrder {
    StaticOrder so; int nMtot;
    __device__ void init(int M, int G, int c, int nMtot_) { so.init(M, 2048, G, c); nMtot = nMtot_; }
    __device__ bool next(int i, Unit& u) const { Unit t; if (!so.next(i >> 2, t)) return false; const int b = i & 3; u.pm = b * nMtot + t.pm; u.pn = b * 8 + t.pn; return true; }
    __device__ __forceinline__ void a_ready(const Unit&) const {}
    __device__ __forceinline__ void done(const Unit&) const {}
};
struct MoeOrder {
    StaticOrder so; int be[8]; int nper;
    __device__ void init(int nused, int nper_, int G, int c, const int* be_) { so.init(nused * BM, nper_ * BM, G, c); nper = nper_;
#pragma unroll
        for (int e = 0; e < 8; ++e) be[e] = be_[e]; }
    __device__ bool next(int i, Unit& u) const { Unit t; if (!so.next(i, t)) return false; int e = 0;
#pragma unroll
        for (int j = 0; j < 7; ++j) e += (t.pm >= be[j]) ? 1 : 0;
        u.pm = t.pm; u.pn = e * nper + t.pn; return true; }
    __device__ __forceinline__ void a_ready(const Unit&) const {}
    __device__ __forceinline__ void done(const Unit&) const {}
};
}

__device__ __forceinline__ int lds_add(volatile LAS int* p) { return __hip_atomic_fetch_add((LAS int*)p, 1, __ATOMIC_RELAXED, __HIP_MEMORY_SCOPE_WORKGROUP); }
typedef const __attribute__((address_space(4))) Args* ArgsP;
#define ARGS_REF const __attribute__((address_space(4))) Args&
struct Ctx { ArgsP a; LAS unsigned char* lds; int tid, lane, wave, wg, G; };

__device__ __forceinline__ void conv_tile(const float* src, size_t ldsrc, int nvalid, bf16_t* dst, size_t ldd, LAS float* tile, int tid) {
    const int nn = tid & 63, kk = tid >> 6;
    float v[16];
#pragma unroll
    for (int j = 0; j < 16; ++j) v[j] = (nn < nvalid) ? src[(size_t)(kk + 8 * j) * ldsrc + nn] : 0.f;
#pragma unroll
    for (int j = 0; j < 16; ++j) tile[nn * 129 + kk + 8 * j] = v[j];
    __syncthreads();
    const int lane = tid & 63, w = tid >> 6;
#pragma unroll
    for (int p = 0; p < 8; ++p) { const int n = w + 8 * p; const float a = tile[n * 129 + 2 * lane], b = tile[n * 129 + 2 * lane + 1];
        *(unsigned*)(dst + (size_t)n * ldd + 2 * lane) = pg8::cvt_pk_bf16_safe(a, b); }
    __syncthreads();
}
template <int KIND>
__device__ __forceinline__ void conv_job(const Ctx& c, const float* src, const float* src2, size_t ldsrc, int K, int Nd, bf16_t* dst, int& rot) {
    LAS float* tile = (LAS float*)(c.lds + LDS_SCR);
    const int nkt = K / 128, nnt = Nd / 64, ntile = nkt * nnt;
    int t0 = (c.wg - rot) % c.G; if (t0 < 0) t0 += c.G;
    for (int t = t0; t < ntile; t += c.G) {
        const int nt = t % nnt, kt = t / nnt, n0 = nt * 64, k0 = kt * 128;
        const float* s = src; int c0 = n0, nvalid = 64;
        if (KIND == 1) { if (n0 >= NMIXP) c0 = n0 - (NMIXP - NMIX); else { nvalid = NMIX - n0; nvalid = nvalid < 0 ? 0 : (nvalid > 64 ? 64 : nvalid); } }
        if (KIND == 2) { const int which = (n0 & 255) >> 7; c0 = (n0 >> 8) * 128 + (n0 & 127); s = which ? src2 : src; }
        conv_tile(s + (size_t)k0 * ldsrc + c0, ldsrc, nvalid, dst + (size_t)n0 * K + k0, (size_t)K, tile, c.tid);
    }
    rot = (rot + ntile) % c.G;
}

__device__ __forceinline__ void mod_phase(const Ctx& c) {
    ARGS_REF a = *c.a; const int tid = c.tid;
    LAS float* s = (LAS float*)(c.lds + LDS_SCR);
    LAS float* red = s + 3 * 2048;
    for (int i = tid; i < 3 * 2048; i += 512) { const int r = i >> 11, k = i & 2047; const float cv = (r < 2) ? a.in[I_C][r * 2048 + k] : a.in[I_CCTX][k]; s[i] = siluf(cv); }
    __syncthreads();
    float* modv = (float*)(a.ws + WS_MOD);
    for (int task = c.wg; task < 192; task += c.G) {
        const int l = task / 96, cb = task % 96, cq = tid & 31, kg = tid >> 5;
        const float* w = a.in[I_WMOD] + (size_t)l * 2048 * 12288 + cb * 128 + cq * 4;
        f32x4 a0 = {0.f, 0.f, 0.f, 0.f}, a1 = a0, a2 = a0;
#pragma unroll 8
        for (int k = kg; k < 2048; k += 16) { const f32x4 wv = *(const f32x4*)(w + (size_t)k * 12288); a0 += s[k] * wv; a1 += s[2048 + k] * wv; a2 += s[4096 + k] * wv; }
#pragma unroll
        for (int j = 0; j < 4; ++j) { red[(kg * 3 + 0) * 128 + cq * 4 + j] = a0[j]; red[(kg * 3 + 1) * 128 + cq * 4 + j] = a1[j]; red[(kg * 3 + 2) * 128 + cq * 4 + j] = a2[j]; }
        __syncthreads();
        if (tid < 384) { const int r = tid >> 7, cc = tid & 127; float sum = 0.f;
#pragma unroll
            for (int g = 0; g < 16; ++g) sum += red[(g * 3 + r) * 128 + cc];
            modv[(size_t)(l * 3 + r) * 12288 + cb * 128 + cc] = sum + a.in[I_BMOD][l * 12288 + cb * 128 + cc]; }
        __syncthreads();
    }
}

__device__ __forceinline__ void modnorm_row(f32x4 (&v)[8], const float* nw, const float* shift, const float* scale, int lane) {
    float ss = 0.f;
#pragma unroll
    for (int j = 0; j < 8; ++j) ss += v[j][0] * v[j][0] + v[j][1] * v[j][1] + v[j][2] * v[j][2] + v[j][3] * v[j][3];
    ss = wave_sum(ss);
    const float rstd = rsqrtf(ss * (1.0f / 2048.0f) + EPS);
#pragma unroll
    for (int j = 0; j < 8; ++j) { const int cc = (j * 64 + lane) * 4; const f32x4 w = *(const f32x4*)(nw + cc), sh = *(const f32x4*)(shift + cc), sc = *(const f32x4*)(scale + cc);
        v[j] = (v[j] * rstd * w) * (1.0f + sc) + sh; }
}
__device__ __forceinline__ void store_row_bf16(const f32x4 (&v)[8], bf16_t* hrow, int lane) {
#pragma unroll
    for (int j = 0; j < 8; ++j) { u32x2 w; w.x = pg8::cvt_pk_bf16_safe(v[j][0], v[j][1]); w.y = pg8::cvt_pk_bf16_safe(v[j][2], v[j][3]); *(u32x2*)(hrow + (j * 64 + lane) * 4) = w; }
}
template <int L, int WHICH>
__device__ __forceinline__ void norm_phase(const Ctx& c) {
    ARGS_REF a = *c.a; const int gw = c.wg * 8 + c.wave, nw = c.G * 8, lane = c.lane;
    const float* modv = (const float*)(a.ws + WS_MOD) + (size_t)L * 3 * 12288 + (WHICH ? 3 : 0) * 2048;
    const float* normw = a.in[I_NORMW] + (L * 2 + WHICH) * 2048;
    const float* xc = (const float*)(a.ws + WS_XC);
    bf16_t* H = (bf16_t*)(a.ws + WS_H);
    for (int r = gw; r < MT; r += nw) {
        const float* src; int mr; size_t hrow;
        if (r < ML) { const int b = r >> 14, t = r & 16383; src = ((L == 0 && WHICH == 0) ? a.in[I_X] : (const float*)a.out) + (size_t)r * D; mr = b;
            hrow = (L == 1 && WHICH == 0) ? (size_t)(b << 14) + ((t & 63) << 8) + (t >> 6) : (size_t)r; }
        else { const int rc = r - ML; src = ((L == 0 && WHICH == 0) ? a.in[I_CTX] : xc) + (size_t)rc * D; mr = 2; hrow = r; }
        f32x4 v[8];
#pragma unroll
        for (int j = 0; j < 8; ++j) v[j] = *(const f32x4*)(src + (j * 64 + lane) * 4);
        const float* shift = modv + (size_t)mr * 12288;
        modnorm_row(v, normw, shift, shift + 2048, lane);
        store_row_bf16(v, H + hrow * D, lane);
    }
}

template <int L>
__device__ __forceinline__ void rgprep_item(const Ctx& c, int item) {
    ARGS_REF a = *c.a; const int tid = c.tid;
    LAS float* xbT = (LAS float*)(c.lds + LDS_SCR);
    const bf16_t* PM = (const bf16_t*)(a.ws + WS_PMIX);
    bf16_t* RGLA = (bf16_t*)(a.ws + WS_RGLA); bf16_t* RGU = (bf16_t*)(a.ws + WS_RGU);
    const float* cw = a.in[I_RG_CW] + L * 4 * 512; const float* cb = a.in[I_RG_CB] + L * 512;
    {
        const int tt = item >> 2, n = item & 3;
        size_t rowbase; int t0, Ls;
        if (tt < 512) { const int b = tt >> 8; rowbase = (size_t)b * T; t0 = (tt & 255) * 64; Ls = T; }
        else { const int tc = tt - 512, b = tc >> 2; rowbase = (size_t)ML + b * CL; t0 = (tc & 3) * 64; Ls = CL; }
        __syncthreads();
        {
            const int tl = tid >> 3, cg = tid & 7, ch0 = n * 128 + cg * 16;
            float acc[16];
#pragma unroll
            for (int j = 0; j < 16; ++j) acc[j] = cb[ch0 + j];
#pragma unroll
            for (int tap = 0; tap < 4; ++tap) { const int ts = t0 + tl + tap - 2;
                if (ts >= 0 && ts < Ls) { const bf16_t* rp = PM + (rowbase + ts) * NMIXP + C_RG_X + ch0; const u32x4 w0 = *(const u32x4*)rp, w1 = *(const u32x4*)(rp + 8);
                    float f[8], g[8]; unpack8(w0, f); unpack8(w1, g);
#pragma unroll
                    for (int j = 0; j < 8; ++j) { acc[j] += cw[tap * 512 + ch0 + j] * f[j]; acc[8 + j] += cw[tap * 512 + ch0 + 8 + j] * g[j]; } } }
#pragma unroll
            for (int j = 0; j < 16; ++j) xbT[(cg * 16 + j) * 68 + tl] = acc[j];
        }
        __syncthreads();
        const int oc = tid & 127, tg = tid >> 7, ch = n * 128 + oc;
#pragma unroll 1
        for (int d = 0; d < 2; ++d) {
            const float* wr = a.in[I_RG_WR] + ((size_t)((L * 2 + d) * 4 + n) * 128) * 128 + oc;
            const float* wi = a.in[I_RG_WI] + ((size_t)((L * 2 + d) * 4 + n) * 128) * 128 + oc;
            float ar[16], ai[16];
#pragma unroll
            for (int j = 0; j < 16; ++j) { ar[j] = 0.f; ai[j] = 0.f; }
#pragma unroll 4
            for (int k = 0; k < 128; ++k) { const float w1 = wr[k * 128], w2 = wi[k * 128];
                const LAS f32x4* xp = (const LAS f32x4*)(xbT + k * 68 + tg * 16);
#pragma unroll
                for (int q = 0; q < 4; ++q) { const f32x4 xv = xp[q];
#pragma unroll
                    for (int j = 0; j < 4; ++j) { ar[q * 4 + j] += xv[j] * w1; ai[q * 4 + j] += xv[j] * w2; } } }
            const float br = a.in[I_RG_BR][(L * 2 + d) * 512 + ch], bi = a.in[I_RG_BI][(L * 2 + d) * 512 + ch];
            const float sp = softplusf(-a.in[I_RG_LAM][(L * 2 + d) * 512 + ch]);
#pragma unroll
            for (int j = 0; j < 16; ++j) { const int tl = tg * 16 + j; const float r = sigm(ar[j] + br), ig = sigm(ai[j] + bi);
                const float la = -8.0f * r * sp; const float xb = xbT[oc * 68 + tl];
                const float u = sqrtf(fmaxf(-expm1f(2.0f * la), 0.f)) * (ig * xb);
                const size_t o = ((size_t)d * MT + rowbase + t0 + tl) * 512 + ch;
                RGLA[o] = (bf16_t)(pg8::cvt_pk_bf16_safe(la, 0.f) & 0xffffu); RGU[o] = (bf16_t)(pg8::cvt_pk_bf16_safe(u, 0.f) & 0xffffu); }
        }
    }
}

template <int L>
__device__ __forceinline__ void chain_gla(const Ctx& c, int b, int h, int d, int vh) {
    ARGS_REF a = *c.a; const int tid = c.tid;
    LAS float* qs = (LAS float*)(c.lds + LDS_SCR); LAS float* ks = qs + 4096; LAS float* fs = ks + 4096; LAS float* vs = fs + 4096; LAS float* os = vs + 4096;
    LAS float* wa = (LAS float*)(c.lds + LDS_AUX);
    const bf16_t* PM = (const bf16_t*)(a.ws + WS_PMIX);
    bf16_t* ORAW = (bf16_t*)(a.ws + WS_ORAW) + (size_t)d * MT * 2048;
    for (int i = tid; i < 1024; i += 512) wa[i] = a.in[I_GLA_WA2][((L * 2 + d) * 16 + (i >> 6)) * 256 + h * 64 + (i & 63)];
    if (tid < 64) wa[1024 + tid] = a.in[I_GLA_BA2][(L * 2 + d) * 256 + h * 64 + tid];
    float s[8];
#pragma unroll
    for (int j = 0; j < 8; ++j) s[j] = 0.f;
    const int vc = tid >> 3, kq = tid & 7;
#pragma unroll 1
    for (int seg = 0; seg < 2; ++seg) {
        const int Ls = seg ? T : CL; const size_t rowbase = seg ? (size_t)b * T : (size_t)ML + b * CL;
#pragma unroll 1
        for (int jb = 0; jb < Ls / 64; ++jb) {
            const int r0 = d ? Ls - 64 * (jb + 1) : 64 * jb;
            __syncthreads();
            {   const int i = tid >> 3, cg = tid & 7, lr = d ? 63 - i : i; const bf16_t* rp = PM + (rowbase + r0 + lr) * NMIXP;
                float fq[8], fk[8], fv[8], fa[16];
                { const u32x4 w = *(const u32x4*)(rp + C_GLA_Q + h * 64 + cg * 8); unpack8(w, fq); }
                { const u32x4 w = *(const u32x4*)(rp + C_GLA_K + h * 64 + cg * 8); unpack8(w, fk); }
                { const u32x4 w = *(const u32x4*)(rp + C_GLA_V + h * 128 + vh * 64 + cg * 8); unpack8(w, fv); }
                { const u32x4 w0 = *(const u32x4*)(rp + C_GLA_A + d * 16), w1 = *(const u32x4*)(rp + C_GLA_A + d * 16 + 8); float t0[8], t1[8]; unpack8(w0, t0); unpack8(w1, t1);
#pragma unroll
                  for (int j = 0; j < 8; ++j) { fa[j] = t0[j]; fa[8 + j] = t1[j]; } }
#pragma unroll
                for (int j = 0; j < 8; ++j) { const int o = i * 64 + cg * 8 + j; qs[o] = fq[j] * 0.125f; ks[o] = fk[j]; vs[o] = fv[j];
                    float z = wa[1024 + cg * 8 + j];
#pragma unroll
                    for (int r = 0; r < 16; ++r) z += fa[r] * wa[r * 64 + cg * 8 + j];
                    fs[o] = __expf(-softplusf(-z) * (1.0f / 16.0f)); }
            }
            __syncthreads();
#pragma unroll 2
            for (int i = 0; i < 64; ++i) {
                const f32x4 f0 = *(const LAS f32x4*)(fs + i * 64 + kq * 8), f1 = *(const LAS f32x4*)(fs + i * 64 + kq * 8 + 4);
                const f32x4 k0 = *(const LAS f32x4*)(ks + i * 64 + kq * 8), k1 = *(const LAS f32x4*)(ks + i * 64 + kq * 8 + 4);
                const f32x4 q0 = *(const LAS f32x4*)(qs + i * 64 + kq * 8), q1 = *(const LAS f32x4*)(qs + i * 64 + kq * 8 + 4);
                const float vv = vs[i * 64 + vc]; float po = 0.f;
#pragma unroll
                for (int j = 0; j < 4; ++j) { s[j] = f0[j] * s[j] + k0[j] * vv; s[4 + j] = f1[j] * s[4 + j] + k1[j] * vv; po += s[j] * q0[j] + s[4 + j] * q1[j]; }
                po += __shfl_xor(po, 1); po += __shfl_xor(po, 2); po += __shfl_xor(po, 4);
                if (kq == 0) os[i * 64 + vc] = po;
            }
            __syncthreads();
            {   const int i = tid >> 3, cg = tid & 7, lr = d ? 63 - i : i; float o[8];
#pragma unroll
                for (int j = 0; j < 8; ++j) o[j] = os[i * 64 + cg * 8 + j];
                *(u32x4*)(ORAW + (rowbase + r0 + lr) * 2048 + 0 * 512 + h * 128 + vh * 64 + cg * 8) = pack8(o); }
        }
    }
}
template <int L>
__device__ __forceinline__ void chain_hg(const Ctx& c, int b, int h, int d, int vh) {
    ARGS_REF a = *c.a; const int tid = c.tid;
    LAS float* qs = (LAS float*)(c.lds + LDS_SCR); LAS float* ks = qs + 8192; LAS float* fs = ks + 8192; LAS float* vs = fs + 8192; LAS float* os = vs + 4096;
    LAS float* lbs = (LAS float*)(c.lds + LDS_AUX);
    const bf16_t* PM = (const bf16_t*)(a.ws + WS_PMIX);
    bf16_t* ORAW = (bf16_t*)(a.ws + WS_ORAW) + (size_t)d * MT * 2048;
    if (tid < 128) { float lb = 0.f; if (L == 1) { const float l0 = a.in[I_HG_LB][h * 128 + tid], l1 = a.in[I_HG_LB][512 + h * 128 + tid]; lb = 1.0f / (1.0f + expf(l0 - l1)); } lbs[tid] = lb; }
    float s[16];
#pragma unroll
    for (int j = 0; j < 16; ++j) s[j] = 0.f;
    const int vc = tid >> 3, kq = tid & 7;
#pragma unroll 1
    for (int seg = 0; seg < 2; ++seg) {
        const int Ls = seg ? T : CL; const size_t rowbase = seg ? (size_t)b * T : (size_t)ML + b * CL;
#pragma unroll 1
        for (int jb = 0; jb < Ls / 64; ++jb) {
            const int r0 = d ? Ls - 64 * (jb + 1) : 64 * jb;
            __syncthreads();
            {   const int i = tid >> 3, cg = tid & 7, lr = d ? 63 - i : i; const bf16_t* rp = PM + (rowbase + r0 + lr) * NMIXP;
#pragma unroll
                for (int hf = 0; hf < 2; ++hf) { const int ch = cg * 16 + hf * 8; float fq[8], fz[8];
                    { const u32x4 w = *(const u32x4*)(rp + C_HG_Q + h * 128 + ch); unpack8(w, fq); }
                    { const u32x4 w = *(const u32x4*)(rp + C_HG_F + d * 512 + h * 128 + ch); unpack8(w, fz); }
#pragma unroll
                    for (int j = 0; j < 8; ++j) { const int o = i * 128 + ch + j; const float lb = lbs[ch + j], sg = sigm(fz[j]);
                        qs[o] = siluf(fq[j]) * 0.08838834764831845f; fs[o] = fmaxf(lb + (1.0f - lb) * sg, 1e-30f); ks[o] = (1.0f - lb) * (1.0f - sg); } }
                float fv[8]; { const u32x4 w = *(const u32x4*)(rp + C_HG_I + h * 128 + vh * 64 + cg * 8); unpack8(w, fv); }
#pragma unroll
                for (int j = 0; j < 8; ++j) vs[i * 64 + cg * 8 + j] = fv[j];
            }
            __syncthreads();
#pragma unroll 2
            for (int i = 0; i < 64; ++i) {
                const float vv = vs[i * 64 + vc]; float po = 0.f;
#pragma unroll
                for (int q4 = 0; q4 < 4; ++q4) {
                    const f32x4 f0 = *(const LAS f32x4*)(fs + i * 128 + kq * 16 + q4 * 4), k0 = *(const LAS f32x4*)(ks + i * 128 + kq * 16 + q4 * 4), q0 = *(const LAS f32x4*)(qs + i * 128 + kq * 16 + q4 * 4);
#pragma unroll
                    for (int j = 0; j < 4; ++j) { s[q4 * 4 + j] = f0[j] * s[q4 * 4 + j] + k0[j] * vv; po += s[q4 * 4 + j] * q0[j]; } }
                po += __shfl_xor(po, 1); po += __shfl_xor(po, 2); po += __shfl_xor(po, 4);
                if (kq == 0) os[i * 64 + vc] = po;
            }
            __syncthreads();
            {   const int i = tid >> 3, cg = tid & 7, lr = d ? 63 - i : i; float o[8];
#pragma unroll
                for (int j = 0; j < 8; ++j) o[j] = os[i * 64 + cg * 8 + j];
                *(u32x4*)(ORAW + (rowbase + r0 + lr) * 2048 + 1 * 512 + h * 128 + vh * 64 + cg * 8) = pack8(o); }
        }
    }
}
template <int L>
__device__ __forceinline__ void chain_dn(const Ctx& c, int b, int h, int d, int vh) {
    ARGS_REF a = *c.a; const int tid = c.tid;
    LAS float* qs = (LAS float*)(c.lds + LDS_SCR); LAS float* ks = qs + 8192; LAS float* vs = ks + 8192; LAS float* os = vs + 4096; LAS float* as = os + 4096; LAS float* bs = as + 64;
    LAS float* cwl = (LAS float*)(c.lds + LDS_AUX);
    const bf16_t* PM = (const bf16_t*)(a.ws + WS_PMIX);
    bf16_t* ORAW = (bf16_t*)(a.ws + WS_ORAW) + (size_t)d * MT * 2048;
    for (int i = tid; i < 4 * 320; i += 512) { const int tap = i / 320, cc = i % 320; const int ch = cc < 128 ? h * 128 + cc : (cc < 256 ? 512 + h * 128 + (cc - 128) : 1024 + h * 128 + vh * 64 + (cc - 256));
        cwl[i] = a.in[I_DN_CW][(L * 4 + tap) * 1536 + ch]; }
    const float neg_ea = -expf(a.in[I_DN_ALOG][(L * 2 + d) * 4 + h]), dtb = a.in[I_DN_DTB][(L * 2 + d) * 4 + h];
    float s[16];
#pragma unroll
    for (int j = 0; j < 16; ++j) s[j] = 0.f;
    const int vc = tid >> 3, kq = tid & 7;
#pragma unroll 1
    for (int seg = 0; seg < 2; ++seg) {
        const int Ls = seg ? T : CL; const size_t rowbase = seg ? (size_t)b * T : (size_t)ML + b * CL;
#pragma unroll 1
        for (int jb = 0; jb < Ls / 64; ++jb) {
            const int r0 = d ? Ls - 64 * (jb + 1) : 64 * jb;
            __syncthreads();
            {   const int i = tid >> 3, cg = tid & 7, lr = d ? 63 - i : i, t = r0 + lr;
                float aq[16], ak[16], av[8];
#pragma unroll
                for (int j = 0; j < 16; ++j) { aq[j] = 0.f; ak[j] = 0.f; }
#pragma unroll
                for (int j = 0; j < 8; ++j) av[j] = 0.f;
#pragma unroll
                for (int tap = 0; tap < 4; ++tap) { const int ts = t + tap - 2;
                    if (ts >= 0 && ts < Ls) { const bf16_t* rp = PM + (rowbase + ts) * NMIXP; const LAS float* w = cwl + tap * 320;
                        float f0[8], f1[8];
                        { const u32x4 w0 = *(const u32x4*)(rp + C_DN_Q + h * 128 + cg * 16), w1 = *(const u32x4*)(rp + C_DN_Q + h * 128 + cg * 16 + 8); unpack8(w0, f0); unpack8(w1, f1); }
#pragma unroll
                        for (int j = 0; j < 8; ++j) { aq[j] += w[cg * 16 + j] * f0[j]; aq[8 + j] += w[cg * 16 + 8 + j] * f1[j]; }
                        { const u32x4 w0 = *(const u32x4*)(rp + C_DN_K + h * 128 + cg * 16), w1 = *(const u32x4*)(rp + C_DN_K + h * 128 + cg * 16 + 8); unpack8(w0, f0); unpack8(w1, f1); }
#pragma unroll
                        for (int j = 0; j < 8; ++j) { ak[j] += w[128 + cg * 16 + j] * f0[j]; ak[8 + j] += w[128 + cg * 16 + 8 + j] * f1[j]; }
                        { const u32x4 w0 = *(const u32x4*)(rp + C_DN_V + h * 128 + vh * 64 + cg * 8); unpack8(w0, f0); }
#pragma unroll
                        for (int j = 0; j < 8; ++j) av[j] += w[256 + cg * 8 + j] * f0[j]; } }
#pragma unroll
                for (int j = 0; j < 16; ++j) { qs[i * 128 + cg * 16 + j] = siluf(aq[j]); ks[i * 128 + cg * 16 + j] = siluf(ak[j]); }
#pragma unroll
                for (int j = 0; j < 8; ++j) vs[i * 64 + cg * 8 + j] = siluf(av[j]);
                if (tid < 64) { const int lr2 = d ? 63 - tid : tid; const bf16_t* rp = PM + (rowbase + r0 + lr2) * NMIXP;
                    const float g = neg_ea * softplusf(bf1(rp + C_DN_A + d * 4 + h) + dtb); as[tid] = __expf(g); bs[tid] = sigm(bf1(rp + C_DN_B + d * 4 + h)); }
            }
            __syncthreads();
            {
                const int rowid = tid >> 2, part = tid & 3; LAS float* p = (rowid < 64 ? qs + rowid * 128 : ks + (rowid - 64) * 128) + part * 32; float ss = 0.f;
#pragma unroll
                for (int j = 0; j < 32; ++j) ss += p[j] * p[j];
                ss += __shfl_xor(ss, 1); ss += __shfl_xor(ss, 2);
                const float rs = rsqrtf(ss + EPS) * (rowid < 64 ? 0.08838834764831845f : 1.0f);
#pragma unroll
                for (int j = 0; j < 32; ++j) p[j] *= rs;
            }
            __syncthreads();
#pragma unroll 2
            for (int i = 0; i < 64; ++i) {
                f32x4 kk[4]; float kts = 0.f;
#pragma unroll
                for (int q4 = 0; q4 < 4; ++q4) { kk[q4] = *(const LAS f32x4*)(ks + i * 128 + kq * 16 + q4 * 4);
#pragma unroll
                    for (int j = 0; j < 4; ++j) kts += s[q4 * 4 + j] * kk[q4][j]; }
                kts += __shfl_xor(kts, 1); kts += __shfl_xor(kts, 2); kts += __shfl_xor(kts, 4);
                const float al = as[i], be = bs[i]; const float vn = be * (vs[i * 64 + vc] - al * kts); float po = 0.f;
#pragma unroll
                for (int q4 = 0; q4 < 4; ++q4) { const f32x4 q0 = *(const LAS f32x4*)(qs + i * 128 + kq * 16 + q4 * 4);
#pragma unroll
                    for (int j = 0; j < 4; ++j) { s[q4 * 4 + j] = al * s[q4 * 4 + j] + kk[q4][j] * vn; po += s[q4 * 4 + j] * q0[j]; } }
                po += __shfl_xor(po, 1); po += __shfl_xor(po, 2); po += __shfl_xor(po, 4);
                if (kq == 0) os[i * 64 + vc] = po;
            }
            __syncthreads();
            {   const int i = tid >> 3, cg = tid & 7, lr = d ? 63 - i : i; float o[8];
#pragma unroll
                for (int j = 0; j < 8; ++j) o[j] = os[i * 64 + cg * 8 + j];
                *(u32x4*)(ORAW + (rowbase + r0 + lr) * 2048 + 2 * 512 + h * 128 + vh * 64 + cg * 8) = pack8(o); }
        }
    }
}
__device__ __forceinline__ void chain_rg(const Ctx& c, int gw  ) {
    ARGS_REF a = *c.a; const int b = gw >> 3, d = (gw >> 2) & 1, ch = (gw & 3) * 128 + c.lane * 2;
    const bf16_t* RGLA = (const bf16_t*)(a.ws + WS_RGLA) + (size_t)d * MT * 512 + ch; const bf16_t* RGU = (const bf16_t*)(a.ws + WS_RGU) + (size_t)d * MT * 512 + ch;
    bf16_t* ORAW = (bf16_t*)(a.ws + WS_ORAW) + (size_t)d * MT * 2048 + 1536 + ch;
    float h0 = 0.f, h1 = 0.f;
#pragma unroll 1
    for (int seg = 0; seg < 2; ++seg) {
        const int Ls = seg ? T : CL; const size_t rowbase = seg ? (size_t)b * T : (size_t)ML + b * CL;
#pragma unroll 1
        for (int s0 = 0; s0 < Ls; s0 += 16) {
            unsigned la[16], uu[16];
#pragma unroll
            for (int j = 0; j < 16; ++j) { const size_t row = rowbase + (d ? Ls - 1 - (s0 + j) : s0 + j); la[j] = *(const unsigned*)(RGLA + row * 512); uu[j] = *(const unsigned*)(RGU + row * 512); }
#pragma unroll
            for (int j = 0; j < 16; ++j) { const size_t row = rowbase + (d ? Ls - 1 - (s0 + j) : s0 + j);
                h0 = __expf(bflo(la[j])) * h0 + bflo(uu[j]); h1 = __expf(bfhi(la[j])) * h1 + bfhi(uu[j]);
                *(unsigned*)(ORAW + row * 2048) = pg8::cvt_pk_bf16_safe(h0, h1); }
        }
    }
}

typedef float f32x16 __attribute__((ext_vector_type(16)));
typedef pg8::bf16x8 bf16x8;
#define MFMA32(a, b, c) __builtin_amdgcn_mfma_f32_32x32x16_bf16((a), (b), (c), 0, 0, 0)
template <int S_> __device__ __forceinline__ bf16x8 pack_step(const f32x16& x) {
    f32x8 v;
#pragma unroll
    for (int j = 0; j < 8; ++j) v[j] = x[8 * S_ + j];
    return __builtin_bit_cast(bf16x8, __builtin_convertvector(v, bfx8_t));
}
__device__ __forceinline__ bf16_t f2bf(float f) { const __bf16 b = (__bf16)f; return __builtin_bit_cast(bf16_t, b); }
__device__ __forceinline__ int permpos(int k) { const int w = k & 15; return (k & ~15) + (((w >> 2) & 1) << 3) + ((w >> 3) << 2) + (w & 3); }
__device__ __forceinline__ int crow16(int idx, int hh) { return (idx & 3) + 8 * (idx >> 2) + 4 * hh; }
__device__ __forceinline__ size_t chunk_rowbase(int b, int n) { return n < 4 ? (size_t)ML + b * CL + n * 64 : (size_t)b * T + (size_t)(n - 4) * 64; }

template <int L, int TY>
__device__ __forceinline__ void intra_g_item(const Ctx& c, int b, int h, int n) {
    constexpr int K = TY ? 128 : 64, NSEG = 512 / K, TS = 64 / NSEG, QPITCH = 2 * K + 16;
    ARGS_REF a = *c.a; const int tid = c.tid;
    const bf16_t* PM = (const bf16_t*)(a.ws + WS_PMIX);
    unsigned char* scr = a.ws + WS_SCR;
    const size_t rowbase = chunk_rowbase(b, n);
    const int rec = (b * 4 + h) * 260 + n;
    LAS unsigned char* Qh = c.lds + LDS_SCR; LAS unsigned char* Kh = Qh + 64 * QPITCH; LAS float* segtot = (LAS float*)(Kh + 64 * QPITCH);
    __syncthreads();
    {
        const int v = tid & 127, t0 = (tid >> 7) * 16; float vals[16];
        const char* vb = (const char*)(PM + rowbase * NMIXP + (TY ? C_HG_I : C_GLA_V) + h * 128); asm volatile("" : "+s"(vb));
        const unsigned vo = (unsigned)(t0 * NMIXP + v) * 2u;
#pragma unroll
        for (int j = 0; j < 16; ++j) vals[j] = bf1((const bf16_t*)(vb + (vo + (unsigned)(j * NMIXP * 2))));
        float v0[8], v1[8];
#pragma unroll
        for (int j = 0; j < 8; ++j) { v0[j] = vals[j]; v1[j] = vals[8 + j]; }
        u32x4* dst = (u32x4*)(scr + (TY ? SC_HG_VT : SC_GLA_VT) + (size_t)rec * 16384 + v * 128 + t0 * 2);
        dst[0] = pack8(v0); dst[1] = pack8(v1);
    }
    const int k = tid & (K - 1), tq = tid / K;
    float lb = 0.f;
    if (TY == 1 && L == 1) { const float l0 = a.in[I_HG_LB][h * 128 + k], l1 = a.in[I_HG_LB][512 + h * 128 + k]; lb = 1.0f / (1.0f + expf(l0 - l1)); }
#pragma unroll 1
    for (int d = 0; d < 2; ++d) {
        float qv[TS], kv[TS], bv[TS];
        const char* pb = (const char*)(PM + rowbase * NMIXP); asm volatile("" : "+s"(pb));
        const unsigned ro = (unsigned)(TS * tq * NMIXP) * 2u;
        if (TY == 0) {
            float w[16]; const float bias = a.in[I_GLA_BA2][(L * 2 + d) * 256 + h * 64 + k];
#pragma unroll
            for (int r = 0; r < 16; ++r) w[r] = a.in[I_GLA_WA2][((L * 2 + d) * 16 + r) * 256 + h * 64 + k];
#pragma unroll
            for (int j = 0; j < TS; ++j) { const bf16_t* rp = (const bf16_t*)(pb + (ro + (unsigned)(j * NMIXP * 2)));
                qv[j] = bf1(rp + C_GLA_Q + h * 64 + k) * 0.125f; kv[j] = bf1(rp + C_GLA_K + h * 64 + k);
                const u32x4 w0 = *(const u32x4*)(rp + C_GLA_A + d * 16), w1 = *(const u32x4*)(rp + C_GLA_A + d * 16 + 8); float f0[8], f1[8]; unpack8(w0, f0); unpack8(w1, f1);
                float z = bias;
#pragma unroll
                for (int r = 0; r < 8; ++r) { z += f0[r] * w[r]; z += f1[r] * w[8 + r]; }
                bv[j] = -softplusf(-z) * (1.0f / 16.0f); }
        } else {
#pragma unroll
            for (int j = 0; j < TS; ++j) { const bf16_t* rp = (const bf16_t*)(pb + (ro + (unsigned)(j * NMIXP * 2)));
                qv[j] = siluf(bf1(rp + C_HG_Q + h * 128 + k)) * 0.08838834764831845f;
                const float sg = sigm(bf1(rp + C_HG_F + d * 512 + h * 128 + k));
                bv[j] = __logf(fmaxf(lb + (1.0f - lb) * sg, 1e-30f)); kv[j] = (1.0f - lb) * (1.0f - sg); }
        }
        float run = 0.f;
        if (d == 0) {
#pragma unroll
            for (int j = 0; j < TS; ++j) { run += bv[j]; bv[j] = run; } }
        else {
#pragma unroll
            for (int j = TS - 1; j >= 0; --j) { run += bv[j]; bv[j] = run; } }
        segtot[tq * K + k] = run;
        __syncthreads();
        float off = 0.f, tot = 0.f, R = 0.f;
#pragma unroll
        for (int sg = 0; sg < NSEG; ++sg) { const float s = segtot[sg * K + k]; tot += s;
            if (d ? (sg > tq) : (sg < tq)) off += s;
            if (d ? (sg >= NSEG / 2) : (sg < NSEG / 2)) R += s; }
        const size_t drec = (size_t)((d * 8 + b * 4 + h) * 260 + n);
        bf16_t* qp = (bf16_t*)(scr + (TY ? SC_HG_QP : SC_GLA_QP) + drec * (64 * K * 2));
        bf16_t* ktp = (bf16_t*)(scr + (TY ? SC_HG_KT : SC_GLA_KT) + drec * (64 * K * 2));
        const int pk = permpos(k);
        float kt[TS];
#pragma unroll
        for (int j = 0; j < TS; ++j) { const int t = TS * tq + j; const float B = off + bv[j];
            qp[t * K + pk] = f2bf(qv[j] * __expf(B));
            kt[j] = kv[j] * __expf(tot - B);
            *(LAS bf16_t*)(Qh + t * QPITCH + k * 2) = f2bf(qv[j] * __expf(fminf(B - R, 60.f)));
            *(LAS bf16_t*)(Kh + t * QPITCH + k * 2) = f2bf(kv[j] * __expf(fminf(R - B, 60.f))); }
        {   u32x4* dst = (u32x4*)(ktp + k * 64 + TS * tq);
#pragma unroll
            for (int g = 0; g < TS / 8; ++g) { float t8[8];
#pragma unroll
                for (int j = 0; j < 8; ++j) t8[j] = kt[g * 8 + j];
                dst[g] = pack8(t8); } }
        if (tq == 0) ((float*)(scr + (TY ? SC_HG_LAM : SC_GLA_LAM) + drec * (K * 4)))[k] = __expf(tot);
        __syncthreads();
        if (c.wave < 4) {
            const int it = c.wave >> 1, jt = c.wave & 1, r = c.lane & 31, hh = c.lane >> 5;
            bf16_t* ap = (bf16_t*)(scr + (TY ? SC_HG_A : SC_GLA_A) + drec * 8192);
            f32x16 acc;
#pragma unroll
            for (int i = 0; i < 16; ++i) acc[i] = 0.f;
            const bool dead = d ? (it == 1 && jt == 0) : (it == 0 && jt == 1);
            if (!dead) {
#pragma unroll
                for (int ks = 0; ks < K / 16; ++ks) { const bf16x8 af = *(const LAS bf16x8*)(Qh + (32 * it + r) * QPITCH + ks * 32 + hh * 16), bfr = *(const LAS bf16x8*)(Kh + (32 * jt + r) * QPITCH + ks * 32 + hh * 16);
                    acc = MFMA32(af, bfr, acc); } }
            const int jj = 32 * jt + r;
#pragma unroll
            for (int i = 0; i < 16; ++i) { const int ii = 32 * it + crow16(i, hh); const bool ok = d ? (jj >= ii) : (jj <= ii); ap[ii * 64 + jj] = f2bf(ok ? acc[i] : 0.f); }
        }
        __syncthreads();
    }
}

template <int TY> struct GChunk {
    static constexpr int K = TY ? 128 : 64, QPITCH = 2 * K + 16, RQ = 64 * K * 2 / 16 / 256  , NRL = 2 * RQ + 2 + 4;
    static constexpr int OFF_QP = 0, OFF_KT = 64 * QPITCH, OFF_A = OFF_KT + K * 144, OFF_VT = OFF_A + 64 * 144, OFF_LAM = OFF_VT + 128 * 144, BYTES = OFF_LAM + K * 4;
};
#define LBAR() do { asm volatile("s_waitcnt lgkmcnt(0)" ::: "memory"); __builtin_amdgcn_s_barrier(); asm volatile("" ::: "memory"); } while (0)
template <int TY>
__device__ __forceinline__ void gchunk_issue(const unsigned char* scr, int b, int h, int d, int n, int lt, u32x4 (&pf)[GChunk<TY>::NRL], float& lamv) {
    typedef GChunk<TY> G; constexpr int K = G::K, RQ = G::RQ;
    const size_t drec = (size_t)((d * 8 + b * 4 + h) * 260 + n), rec = (size_t)((b * 4 + h) * 260 + n);
    const u32x4* qp = (const u32x4*)(scr + (TY ? SC_HG_QP : SC_GLA_QP) + drec * (64 * K * 2));
    const u32x4* kt = (const u32x4*)(scr + (TY ? SC_HG_KT : SC_GLA_KT) + drec * (64 * K * 2));
    const u32x4* ap = (const u32x4*)(scr + (TY ? SC_HG_A : SC_GLA_A) + drec * 8192);
    const u32x4* vt = (const u32x4*)(scr + (TY ? SC_HG_VT : SC_GLA_VT) + rec * 16384);
#pragma unroll
    for (int i = 0; i < RQ; ++i) { pf[i] = qp[i * 256 + lt]; pf[RQ + i] = kt[i * 256 + lt]; }
    pf[2 * RQ] = ap[lt]; pf[2 * RQ + 1] = ap[256 + lt];
#pragma unroll
    for (int i = 0; i < 4; ++i) pf[2 * RQ + 2 + i] = vt[i * 256 + lt];
    if (lt < K) lamv = ((const float*)(scr + (TY ? SC_HG_LAM : SC_GLA_LAM) + drec * (K * 4)))[lt];
}
template <int TY>
__device__ __forceinline__ void gchunk_commit(LAS unsigned char* buf, int lt, const u32x4 (&pf)[GChunk<TY>::NRL], float lamv) {
    typedef GChunk<TY> G; constexpr int K = G::K, PPR = K * 2 / 16, RQ = G::RQ;
#pragma unroll
    for (int i = 0; i < RQ; ++i) { const int p = i * 256 + lt;
        *(LAS u32x4*)(buf + G::OFF_QP + (p / PPR) * G::QPITCH + (p % PPR) * 16) = pf[i];
        *(LAS u32x4*)(buf + G::OFF_KT + (p >> 3) * 144 + (p & 7) * 16) = pf[RQ + i]; }
#pragma unroll
    for (int i = 0; i < 2; ++i) { const int p = i * 256 + lt; *(LAS u32x4*)(buf + G::OFF_A + (p >> 3) * 144 + (p & 7) * 16) = pf[2 * RQ + i]; }
#pragma unroll
    for (int i = 0; i < 4; ++i) { const int p = i * 256 + lt; *(LAS u32x4*)(buf + G::OFF_VT + (p >> 3) * 144 + (p & 7) * 16) = pf[2 * RQ + 2 + i]; }
    if (lt < K) *(LAS float*)(buf + G::OFF_LAM + lt * 4) = lamv;
}
template <int TY>
__device__ __forceinline__ void gchunk_compute(LAS unsigned char* buf, f32x16 (&S)[GChunk<TY>::K / 32], bf16_t* orow, int vs, int lane) {
    typedef GChunk<TY> G; constexpr int K = G::K, KT_ = K / 32;
    const int r = lane & 31, hh = lane >> 5;
    bf16x8 vf[4];
#pragma unroll
    for (int ts = 0; ts < 4; ++ts) vf[ts] = *(const LAS bf16x8*)(buf + G::OFF_VT + (32 * vs + r) * 144 + ts * 32 + hh * 16);
    f32x16 o[2];
#pragma unroll
    for (int it = 0; it < 2; ++it) {
#pragma unroll
        for (int i = 0; i < 16; ++i) o[it][i] = 0.f; }
#pragma unroll
    for (int kt = 0; kt < KT_; ++kt) { const bf16x8 b0 = pack_step<0>(S[kt]), b1 = pack_step<1>(S[kt]);
#pragma unroll
        for (int it = 0; it < 2; ++it) { const bf16x8 q0 = *(const LAS bf16x8*)(buf + G::OFF_QP + (32 * it + r) * G::QPITCH + (2 * kt) * 32 + hh * 16), q1 = *(const LAS bf16x8*)(buf + G::OFF_QP + (32 * it + r) * G::QPITCH + (2 * kt + 1) * 32 + hh * 16);
            o[it] = MFMA32(q0, b0, o[it]); o[it] = MFMA32(q1, b1, o[it]); }
        __builtin_amdgcn_sched_barrier(0); }
#pragma unroll
    for (int ts = 0; ts < 4; ++ts)
#pragma unroll
        for (int it = 0; it < 2; ++it) { const bf16x8 af = *(const LAS bf16x8*)(buf + G::OFF_A + (32 * it + r) * 144 + ts * 32 + hh * 16);
            o[it] = MFMA32(af, vf[ts], o[it]); }
    __builtin_amdgcn_sched_barrier(0);
#pragma unroll
    for (int kt = 0; kt < KT_; ++kt) {
        __builtin_amdgcn_sched_barrier(0);
#pragma unroll
        for (int g = 0; g < 4; ++g) { const f32x4 lm = *(const LAS f32x4*)(buf + G::OFF_LAM + (32 * kt + 8 * g + 4 * hh) * 4);
#pragma unroll
            for (int j = 0; j < 4; ++j) S[kt][4 * g + j] *= lm[j]; }
#pragma unroll
        for (int ts = 0; ts < 4; ++ts) { const bf16x8 kf = *(const LAS bf16x8*)(buf + G::OFF_KT + (32 * kt + r) * 144 + ts * 32 + hh * 16);
            S[kt] = MFMA32(kf, vf[ts], S[kt]); } }
    __builtin_amdgcn_sched_barrier(0);
#pragma unroll
    for (int it = 0; it < 2; ++it)
#pragma unroll
        for (int i = 0; i < 16; ++i) orow[(size_t)(32 * it + crow16(i, hh)) * 2048 + 32 * vs + r] = f2bf(o[it][i]);
}
template <int L, int TY>
__device__ __forceinline__ void chain_g(const Ctx& c, int b, int h, int d) {
    typedef GChunk<TY> G; constexpr int KT_ = G::K / 32;
    ARGS_REF a = *c.a;
    const unsigned char* scr = a.ws + WS_SCR;
    LAS unsigned char* buf = c.lds + LDS_SCR;
    static_assert(G::BYTES <= 65536, "two chunk buffers must fit the scratch region");
#define CHUNK_OF(m) (d ? ((m) < 4 ? 3 - (m) : 263 - (m)) : (m))
    __syncthreads();
    if (c.wave < 4) {
        bf16_t* ORAW = (bf16_t*)(a.ws + WS_ORAW) + (size_t)d * MT * 2048 + TY * 512 + h * 128;
        f32x16 S[KT_];
#pragma unroll
        for (int kt = 0; kt < KT_; ++kt)
#pragma unroll
            for (int i = 0; i < 16; ++i) S[kt][i] = 0.f;
        LBAR();
#pragma unroll 1
        for (int m = 0; m < 260; ++m) {
            gchunk_compute<TY>(buf + (m & 1) * 65536, S, ORAW + chunk_rowbase(b, CHUNK_OF(m)) * 2048, c.wave, c.lane);
            LBAR();
        }
    } else {
        const int lt = c.tid - 256;
        u32x4 pfA[G::NRL], pfB[G::NRL]; float lamA = 0.f, lamB = 0.f;
        gchunk_issue<TY>(scr, b, h, d, CHUNK_OF(0), lt, pfA, lamA);
        gchunk_issue<TY>(scr, b, h, d, CHUNK_OF(1), lt, pfB, lamB);
        gchunk_commit<TY>(buf, lt, pfA, lamA);
        gchunk_issue<TY>(scr, b, h, d, CHUNK_OF(2), lt, pfA, lamA);
        LBAR();
#pragma unroll 1
        for (int m = 0; m < 260; m += 2) {
            gchunk_commit<TY>(buf + 65536, lt, pfB, lamB);
            if (m + 3 < 260) gchunk_issue<TY>(scr, b, h, d, CHUNK_OF(m + 3), lt, pfB, lamB);
            LBAR();
            if (m + 2 < 260) gchunk_commit<TY>(buf, lt, pfA, lamA);
            if (m + 4 < 260) gchunk_issue<TY>(scr, b, h, d, CHUNK_OF(m + 4), lt, pfA, lamA);
            LBAR();
        }
    }
#undef CHUNK_OF
}

__device__ __forceinline__ int posU(int i) { const int w = i & 31; return (i & 32) + (((w >> 2) & 1) << 4) + (w & 3) + ((w >> 3) << 2); }
__device__ __forceinline__ constexpr int pp16(int w) { return (((w >> 2) & 1) << 3) + ((w >> 3) << 2) + (w & 3); }

__device__ __forceinline__ void trisolve64(const LAS float* A, int cidx, float (&Tc)[64]) {
#pragma unroll
    for (int pi = 0; pi < 64; ++pi) {
        float acc = (pi == cidx) ? 1.f : 0.f;
#pragma unroll
        for (int q = 0; q < (pi + 3) / 4; ++q) { const f32x4 av = *(const LAS f32x4*)(A + pi * 64 + 4 * q);
#pragma unroll
            for (int jj = 0; jj < 4; ++jj) if (4 * q + jj < pi) acc -= av[jj] * Tc[4 * q + jj]; }
        Tc[pi] = acc;
        if ((pi & 3) == 3) __builtin_amdgcn_sched_barrier(0);
    }
}

template <int L>
__device__ __forceinline__ void intra_dn_item(const Ctx& c, int b, int h, int n) {
    ARGS_REF a = *c.a; const int tid = c.tid, lane = c.lane, wave = c.wave;
    const bf16_t* PM = (const bf16_t*)(a.ws + WS_PMIX);
    unsigned char* scr = a.ws + WS_SCR;
    const int rec = (b * 4 + h) * 260 + n;
    LAS unsigned char* Qh = c.lds + LDS_SCR;
    LAS unsigned char* Kh = Qh + 17408;
    LAS unsigned char* Tp = Qh;
    LAS unsigned char* KTp = c.lds + LDS_SCR + 36864;
    LAS unsigned char* VTp = KTp + 18432;
    LAS float* Ap = (LAS float*)(VTp + 18432);
    LAS float* sm = (LAS float*)(c.lds + LDS_AUX);
    __syncthreads();
    {
        const int i = tid >> 3, cg = tid & 7;
        const int Ls = n < 4 ? CL : T; const int tseg = (n < 4 ? n : n - 4) * 64 + i; const size_t segbase = n < 4 ? (size_t)ML + b * CL : (size_t)b * T;
        float aq[16], ak[16], av[16];
#pragma unroll
        for (int j = 0; j < 16; ++j) { aq[j] = 0.f; ak[j] = 0.f; av[j] = 0.f; }
        const float* cw = a.in[I_DN_CW] + (size_t)L * 4 * 1536 + h * 128 + cg * 16;
#pragma unroll
        for (int tap = 0; tap < 4; ++tap) { const int ts = tseg + tap - 2;
            if (ts >= 0 && ts < Ls) { const bf16_t* rp = PM + (segbase + ts) * NMIXP + h * 128 + cg * 16; const float* w = cw + tap * 1536;
                float f0[8], f1[8];
                { const u32x4 w0 = *(const u32x4*)(rp + C_DN_Q), w1 = *(const u32x4*)(rp + C_DN_Q + 8); unpack8(w0, f0); unpack8(w1, f1); }
#pragma unroll
                for (int j = 0; j < 8; ++j) { aq[j] += w[j] * f0[j]; aq[8 + j] += w[8 + j] * f1[j]; }
                { const u32x4 w0 = *(const u32x4*)(rp + C_DN_K), w1 = *(const u32x4*)(rp + C_DN_K + 8); unpack8(w0, f0); unpack8(w1, f1); }
#pragma unroll
                for (int j = 0; j < 8; ++j) { ak[j] += w[512 + j] * f0[j]; ak[8 + j] += w[512 + 8 + j] * f1[j]; }
                { const u32x4 w0 = *(const u32x4*)(rp + C_DN_V), w1 = *(const u32x4*)(rp + C_DN_V + 8); unpack8(w0, f0); unpack8(w1, f1); }
#pragma unroll
                for (int j = 0; j < 8; ++j) { av[j] += w[1024 + j] * f0[j]; av[8 + j] += w[1024 + 8 + j] * f1[j]; } } }
        float sq = 0.f, sk = 0.f;
#pragma unroll
        for (int j = 0; j < 16; ++j) { aq[j] = siluf(aq[j]); ak[j] = siluf(ak[j]); av[j] = siluf(av[j]); sq += aq[j] * aq[j]; sk += ak[j] * ak[j]; }
        sq += __shfl_xor(sq, 1); sq += __shfl_xor(sq, 2); sq += __shfl_xor(sq, 4);
        sk += __shfl_xor(sk, 1); sk += __shfl_xor(sk, 2); sk += __shfl_xor(sk, 4);
        const float rq = rsqrtf(sq + EPS) * 0.08838834764831845f, rk = rsqrtf(sk + EPS);
        float qp[16];
#pragma unroll
        for (int j = 0; j < 16; ++j) { aq[j] *= rq; ak[j] *= rk; }
#pragma unroll
        for (int j = 0; j < 16; ++j) qp[pp16(j)] = aq[j];
        {   float x0[8], x1[8];
#pragma unroll
            for (int j = 0; j < 8; ++j) { x0[j] = qp[j]; x1[j] = qp[8 + j]; }
            u32x4* dst = (u32x4*)(scr + SC_DN_QS + (size_t)rec * 16384 + i * 256 + cg * 32); dst[0] = pack8(x0); dst[1] = pack8(x1);
#pragma unroll
            for (int j = 0; j < 8; ++j) { x0[j] = aq[j]; x1[j] = aq[8 + j]; }
            *(LAS u32x4*)(Qh + i * 272 + cg * 32) = pack8(x0); *(LAS u32x4*)(Qh + i * 272 + cg * 32 + 16) = pack8(x1);
#pragma unroll
            for (int j = 0; j < 8; ++j) { x0[j] = ak[j]; x1[j] = ak[8 + j]; }
            *(LAS u32x4*)(Kh + i * 272 + cg * 32) = pack8(x0); *(LAS u32x4*)(Kh + i * 272 + cg * 32 + 16) = pack8(x1); }
        const int pj = permpos(i);
#pragma unroll
        for (int j = 0; j < 16; ++j) { *(LAS bf16_t*)(KTp + (cg * 16 + j) * 144 + pj * 2) = f2bf(ak[j]); *(LAS bf16_t*)(VTp + (cg * 16 + j) * 144 + pj * 2) = f2bf(av[j]); }
        if (tid < 128) { const int d = tid >> 6, t = tid & 63; const bf16_t* rp = PM + (chunk_rowbase(b, n) + t) * NMIXP;
            const float g = -expf(a.in[I_DN_ALOG][(L * 2 + d) * 4 + h]) * softplusf(bf1(rp + C_DN_A + d * 4 + h) + a.in[I_DN_DTB][(L * 2 + d) * 4 + h]);
            sm[d * 256 + t] = g; sm[d * 256 + 128 + t] = sigm(bf1(rp + C_DN_B + d * 4 + h)); }
    }
    __syncthreads();
    const int r = lane & 31, hh = lane >> 5;
    f32x16 gram;
#pragma unroll
    for (int i = 0; i < 16; ++i) gram[i] = 0.f;
    const int t1 = (wave & 3) >> 1, t2 = wave & 1;
#pragma unroll
    for (int ks = 0; ks < 8; ++ks) {
        const bf16x8 af = *(const LAS bf16x8*)(Kh + (32 * (wave < 4 ? t2 : t1) + r) * 272 + ks * 32 + hh * 16);
        const bf16x8 bfr = *(const LAS bf16x8*)((wave < 4 ? Qh : Kh) + (32 * (wave < 4 ? t1 : t2) + r) * 272 + ks * 32 + hh * 16);
        gram = MFMA32(af, bfr, gram); }
    {
        u32x4* dst = (u32x4*)(scr + SC_DN_KT + (size_t)rec * 16384);
#pragma unroll
        for (int q = 0; q < 2; ++q) { const int p = q * 512 + tid; dst[p] = *(const LAS u32x4*)(KTp + (p >> 3) * 144 + (p & 7) * 16); } }
    if (tid < 128) { const int d = tid >> 6, t = tid & 63; float acc = 0.f;
        for (int tt = 0; tt < 64; ++tt) { const float g = sm[d * 256 + tt]; if (d ? (tt >= t) : (tt <= t)) acc += g; }
        sm[d * 256 + 64 + t] = acc; }
    __syncthreads();
#pragma unroll 1
    for (int d = 0; d < 2; ++d) {
        const LAS float* gc = sm + d * 256 + 64; const LAS float* be = sm + d * 256 + 128;
        const size_t drec = (size_t)((d * 8 + b * 4 + h) * 260 + n);
        if (wave < 4) {
            const int i = 32 * t1 + r; const float gi = gc[i]; float o[16];
#pragma unroll
            for (int idx = 0; idx < 16; ++idx) { const int j = 32 * t2 + crow16(idx, hh); const bool ok = d ? (j >= i) : (j <= i); o[idx] = ok ? gram[idx] * __expf(fminf(gi - gc[j], 0.f)) : 0.f; }
            float x0[8], x1[8];
#pragma unroll
            for (int j = 0; j < 8; ++j) { x0[j] = o[j]; x1[j] = o[8 + j]; }
            bf16_t* ap = (bf16_t*)(scr + SC_DN_AQK + drec * 8192) + i * 64 + 32 * t2 + 8 * hh;
            *(u32x4*)ap = pack8(x0); *(u32x4*)(ap + 16) = pack8(x1);
        } else {
            const int j = 32 * t2 + r; const float gj = gc[j]; const int pj = d ? 63 - j : j;
#pragma unroll
            for (int idx = 0; idx < 16; ++idx) { const int i = 32 * t1 + crow16(idx, hh); const int pi = d ? 63 - i : i;
                Ap[d * 4096 + pi * 64 + pj] = (pj < pi) ? be[i] * gram[idx] * __expf(fminf(gc[i] - gj, 0.f)) : 0.f; }
        }
        if (tid < 64) { const float gtot = d ? gc[0] : gc[63]; float* sc = (float*)(scr + SC_DN_SC + drec * 1024);
            const float eg = __expf(gc[tid]); sc[tid] = eg; sc[64 + tid] = __expf(gtot - gc[tid]); if (tid == 0) sc[128] = __expf(gtot); sm[d * 256 + 192 + tid] = eg; }
    }
    __syncthreads();
    if (wave < 2) {
        const int d = wave; float Tc[64];
        trisolve64(Ap + d * 4096, lane, Tc);
        const int j = d ? 63 - lane : lane; const float bj = sm[d * 256 + 128 + j], ej = sm[d * 256 + 192 + j]; const int pj2 = permpos(j) * 2;
        LAS unsigned char* T1 = Tp + d * 18432; LAS unsigned char* T2 = T1 + 9216;
#pragma unroll
        for (int pi = 0; pi < 64; ++pi) { const int i = d ? 63 - pi : pi; const float v1 = Tc[pi] * bj;
            *(LAS bf16_t*)(T1 + i * 144 + pj2) = f2bf(v1); *(LAS bf16_t*)(T2 + i * 144 + pj2) = f2bf(v1 * ej); }
    }
    __syncthreads();
#pragma unroll 1
    for (int q = 0; q < 4; ++q) {
        const int tile = wave * 4 + q, d = tile >> 4, isw = (tile >> 3) & 1, it = (tile >> 2) & 1, xt = tile & 3;
        const size_t drec = (size_t)((d * 8 + b * 4 + h) * 260 + n);
        LAS unsigned char* T1 = Tp + d * 18432; LAS unsigned char* T2 = T1 + 9216;
        f32x16 acc;
#pragma unroll
        for (int i = 0; i < 16; ++i) acc[i] = 0.f;
        if (!isw) {
#pragma unroll
            for (int js = 0; js < 4; ++js) { const bf16x8 af = *(const LAS bf16x8*)(T1 + (32 * it + r) * 144 + js * 32 + hh * 16), bfr = *(const LAS bf16x8*)(VTp + (32 * xt + r) * 144 + js * 32 + hh * 16);
                acc = MFMA32(af, bfr, acc); }
            float x0[8], x1[8];
#pragma unroll
            for (int j = 0; j < 8; ++j) { x0[j] = acc[j]; x1[j] = acc[8 + j]; }
            bf16_t* up = (bf16_t*)(scr + SC_DN_UT + drec * 16384) + (32 * xt + r) * 64 + it * 32 + hh * 16;
            *(u32x4*)up = pack8(x0); *(u32x4*)(up + 8) = pack8(x1);
        } else {
#pragma unroll
            for (int js = 0; js < 4; ++js) { const bf16x8 af = *(const LAS bf16x8*)(KTp + (32 * xt + r) * 144 + js * 32 + hh * 16), bfr = *(const LAS bf16x8*)(T2 + (32 * it + r) * 144 + js * 32 + hh * 16);
                acc = MFMA32(af, bfr, acc); }
            float x0[8], x1[8];
#pragma unroll
            for (int j = 0; j < 8; ++j) { x0[j] = -acc[j]; x1[j] = -acc[8 + j]; }
            bf16_t* wp = (bf16_t*)(scr + SC_DN_WN + drec * 16384) + (32 * it + r) * 128 + 32 * xt + 8 * hh;
            *(u32x4*)wp = pack8(x0); *(u32x4*)(wp + 16) = pack8(x1);
        }
    }
}

struct DChunk { static constexpr int OFF_QS = 0, OFF_KT = 17408, OFF_UT = OFF_KT + 18432, OFF_WN = OFF_UT + 18432, OFF_AQK = OFF_WN + 17408, OFF_SC = OFF_AQK + 9216, BYTES = OFF_SC + 1024, NRL = 18; };
__device__ __forceinline__ void dchunk_issue(const unsigned char* scr, int b, int h, int d, int n, int lt, u32x4 (&pf)[DChunk::NRL], f32x4& scv) {
    const size_t drec = (size_t)((d * 8 + b * 4 + h) * 260 + n), rec = (size_t)((b * 4 + h) * 260 + n);
    const u32x4* qs = (const u32x4*)(scr + SC_DN_QS + rec * 16384); const u32x4* kt = (const u32x4*)(scr + SC_DN_KT + rec * 16384);
    const u32x4* ut = (const u32x4*)(scr + SC_DN_UT + drec * 16384); const u32x4* wn = (const u32x4*)(scr + SC_DN_WN + drec * 16384);
    const u32x4* aq = (const u32x4*)(scr + SC_DN_AQK + drec * 8192);
#pragma unroll
    for (int i = 0; i < 4; ++i) { pf[i] = qs[i * 256 + lt]; pf[4 + i] = kt[i * 256 + lt]; pf[8 + i] = ut[i * 256 + lt]; pf[12 + i] = wn[i * 256 + lt]; }
    pf[16] = aq[lt]; pf[17] = aq[256 + lt];
    if (lt < 64) scv = ((const f32x4*)(scr + SC_DN_SC + drec * 1024))[lt];
}
__device__ __forceinline__ void dchunk_commit(LAS unsigned char* buf, int lt, const u32x4 (&pf)[DChunk::NRL], const f32x4 scv) {
    typedef DChunk G;
#pragma unroll
    for (int i = 0; i < 4; ++i) { const int p = i * 256 + lt;
        *(LAS u32x4*)(buf + G::OFF_QS + (p >> 4) * 272 + (p & 15) * 16) = pf[i];
        *(LAS u32x4*)(buf + G::OFF_KT + (p >> 3) * 144 + (p & 7) * 16) = pf[4 + i];
        *(LAS u32x4*)(buf + G::OFF_UT + (p >> 3) * 144 + (p & 7) * 16) = pf[8 + i];
        *(LAS u32x4*)(buf + G::OFF_WN + (p >> 4) * 272 + (p & 15) * 16) = pf[12 + i]; }
#pragma unroll
    for (int i = 0; i < 2; ++i) { const int p = i * 256 + lt; *(LAS u32x4*)(buf + G::OFF_AQK + (p >> 3) * 144 + (p & 7) * 16) = pf[16 + i]; }
    if (lt < 64) *(LAS f32x4*)(buf + G::OFF_SC + lt * 16) = scv;
}
__device__ __forceinline__ void dchunk_compute(LAS unsigned char* buf, f32x16 (&S)[4], bf16_t* orow, int vs, int lane) {
    typedef DChunk G; const int r = lane & 31, hh = lane >> 5;
    f32x16 vn[2], o[2];
#pragma unroll
    for (int it = 0; it < 2; ++it) { const u32x4 u0 = *(const LAS u32x4*)(buf + G::OFF_UT + (32 * vs + r) * 144 + it * 64 + hh * 32), u1 = *(const LAS u32x4*)(buf + G::OFF_UT + (32 * vs + r) * 144 + it * 64 + hh * 32 + 16);
        float f0[8], f1[8]; unpack8(u0, f0); unpack8(u1, f1);
#pragma unroll
        for (int j = 0; j < 8; ++j) { vn[it][j] = f0[j]; vn[it][8 + j] = f1[j]; o[it][j] = 0.f; o[it][8 + j] = 0.f; } }
#pragma unroll
    for (int kt = 0; kt < 4; ++kt) { const bf16x8 b0 = pack_step<0>(S[kt]), b1 = pack_step<1>(S[kt]);
#pragma unroll
        for (int it = 0; it < 2; ++it) {
            const bf16x8 w0 = *(const LAS bf16x8*)(buf + G::OFF_WN + (32 * it + r) * 272 + (2 * kt) * 32 + hh * 16), w1 = *(const LAS bf16x8*)(buf + G::OFF_WN + (32 * it + r) * 272 + (2 * kt + 1) * 32 + hh * 16);
            const bf16x8 q0 = *(const LAS bf16x8*)(buf + G::OFF_QS + (32 * it + r) * 272 + (2 * kt) * 32 + hh * 16), q1 = *(const LAS bf16x8*)(buf + G::OFF_QS + (32 * it + r) * 272 + (2 * kt + 1) * 32 + hh * 16);
            vn[it] = MFMA32(w0, b0, vn[it]); o[it] = MFMA32(q0, b0, o[it]); vn[it] = MFMA32(w1, b1, vn[it]); o[it] = MFMA32(q1, b1, o[it]); }
        __builtin_amdgcn_sched_barrier(0); }
#pragma unroll
    for (int it = 0; it < 2; ++it)
#pragma unroll
        for (int g = 0; g < 4; ++g) { const f32x4 e = *(const LAS f32x4*)(buf + G::OFF_SC + (32 * it + 8 * g + 4 * hh) * 4);
#pragma unroll
            for (int j = 0; j < 4; ++j) o[it][4 * g + j] *= e[j]; }
    __builtin_amdgcn_sched_barrier(0);
#pragma unroll
    for (int jt = 0; jt < 2; ++jt) { const bf16x8 p0 = pack_step<0>(vn[jt]), p1 = pack_step<1>(vn[jt]);
#pragma unroll
        for (int it = 0; it < 2; ++it) { const bf16x8 a0 = *(const LAS bf16x8*)(buf + G::OFF_AQK + (32 * it + r) * 144 + (2 * jt) * 32 + hh * 16), a1 = *(const LAS bf16x8*)(buf + G::OFF_AQK + (32 * it + r) * 144 + (2 * jt + 1) * 32 + hh * 16);
            o[it] = MFMA32(a0, p0, o[it]); o[it] = MFMA32(a1, p1, o[it]); } }
    __builtin_amdgcn_sched_barrier(0);
#pragma unroll
    for (int jt = 0; jt < 2; ++jt)
#pragma unroll
        for (int g = 0; g < 4; ++g) { const f32x4 e = *(const LAS f32x4*)(buf + G::OFF_SC + 256 + (32 * jt + 8 * g + 4 * hh) * 4);
#pragma unroll
            for (int j = 0; j < 4; ++j) vn[jt][4 * g + j] *= e[j]; }
    const float glast = *(const LAS float*)(buf + G::OFF_SC + 512);
    const bf16x8 p00 = pack_step<0>(vn[0]), p01 = pack_step<1>(vn[0]), p10 = pack_step<0>(vn[1]), p11 = pack_step<1>(vn[1]);
    __builtin_amdgcn_sched_barrier(0);
#pragma unroll
    for (int kt = 0; kt < 4; ++kt) {
#pragma unroll
        for (int i = 0; i < 16; ++i) S[kt][i] *= glast;
        const LAS unsigned char* kb = buf + G::OFF_KT + (32 * kt + r) * 144 + hh * 16;
        S[kt] = MFMA32(*(const LAS bf16x8*)(kb), p00, S[kt]); S[kt] = MFMA32(*(const LAS bf16x8*)(kb + 32), p01, S[kt]);
        S[kt] = MFMA32(*(const LAS bf16x8*)(kb + 64), p10, S[kt]); S[kt] = MFMA32(*(const LAS bf16x8*)(kb + 96), p11, S[kt]);
        __builtin_amdgcn_sched_barrier(0); }
#pragma unroll
    for (int it = 0; it < 2; ++it)
#pragma unroll
        for (int i = 0; i < 16; ++i) orow[(size_t)(32 * it + crow16(i, hh)) * 2048 + 32 * vs + r] = f2bf(o[it][i]);
}
template <int L>
__device__ __forceinline__ void chain_dnc(const Ctx& c, int b, int h, int d) {
    ARGS_REF a = *c.a;
    const unsigned char* scr = a.ws + WS_SCR;
    LAS unsigned char* buf = c.lds + LDS_SCR;
#define CHUNK_OF(m) (d ? ((m) < 4 ? 3 - (m) : 263 - (m)) : (m))
    __syncthreads();
    if (c.wave < 4) {
        bf16_t* ORAW = (bf16_t*)(a.ws + WS_ORAW) + (size_t)d * MT * 2048 + 2 * 512 + h * 128;
        f32x16 S[4];
#pragma unroll
        for (int kt = 0; kt < 4; ++kt)
#pragma unroll
            for (int i = 0; i < 16; ++i) S[kt][i] = 0.f;
        LBAR();
#pragma unroll 1
        for (int m = 0; m < 260; ++m) {
            dchunk_compute(buf, S, ORAW + chunk_rowbase(b, CHUNK_OF(m)) * 2048, c.wave, c.lane);
            LBAR();
            LBAR();
        }
    } else {
        const int lt = c.tid - 256;
        u32x4 pfA[DChunk::NRL], pfB[DChunk::NRL]; f32x4 scA = {0.f, 0.f, 0.f, 0.f}, scB = scA;
        dchunk_issue(scr, b, h, d, CHUNK_OF(0), lt, pfA, scA);
        dchunk_issue(scr, b, h, d, CHUNK_OF(1), lt, pfB, scB);
        dchunk_commit(buf, lt, pfA, scA);
        dchunk_issue(scr, b, h, d, CHUNK_OF(2), lt, pfA, scA);
        LBAR();
#pragma unroll 1
        for (int m = 0; m < 260; m += 2) {
            LBAR();
            dchunk_commit(buf, lt, pfB, scB);
            if (m + 3 < 260) dchunk_issue(scr, b, h, d, CHUNK_OF(m + 3), lt, pfB, scB);
            LBAR();
            LBAR();
            if (m + 2 < 260) dchunk_commit(buf, lt, pfA, scA);
            if (m + 4 < 260) dchunk_issue(scr, b, h, d, CHUNK_OF(m + 4), lt, pfA, scA);
            LBAR();
        }
    }
#undef CHUNK_OF
}

__device__ __forceinline__ void rgw_convert(const Ctx& c) {
    ARGS_REF a = *c.a; bf16_t* dst = (bf16_t*)(a.ws + WS_RGW);
    for (int e = c.wg * 512 + c.tid; e < 32 * 16384; e += c.G * 512) { const int m = e >> 14, oc = (e >> 7) & 127, cc = e & 127, l = m >> 4, d = (m >> 3) & 1, n = (m >> 1) & 3, g = m & 1;
        const float* src = g ? a.in[I_RG_WI] : a.in[I_RG_WR];
        dst[e] = f2bf(src[((size_t)(((l * 2 + d) * 4 + n) * 128 + cc)) * 128 + oc]); }
}
template <int L>
__device__ __forceinline__ void rgprep_item2(const Ctx& c, int item) {
    ARGS_REF a = *c.a; const int tid = c.tid, lane = c.lane, wave = c.wave;
    LAS unsigned char* XB = c.lds + LDS_SCR;
    LAS float* xbT = (LAS float*)(c.lds + LDS_SCR + 17408);
    LAS float* PRE = (LAS float*)(c.lds + LDS_SCR + 52224);
    LAS float* SEG = (LAS float*)(c.lds + LDS_AUX);
    const bf16_t* PM = (const bf16_t*)(a.ws + WS_PMIX);
    bf16_t* RGLA = (bf16_t*)(a.ws + WS_RGLA); bf16_t* ORAW = (bf16_t*)(a.ws + WS_ORAW);
    float* TT = (float*)(a.ws + WS_RGTT);
    const float* cw = a.in[I_RG_CW] + L * 4 * 512; const float* cb = a.in[I_RG_CB] + L * 512;
    const int tt = item >> 2, n = item & 3;
    size_t rowbase; int t0, Ls, bb, nchunk;
    if (tt < 512) { bb = tt >> 8; rowbase = (size_t)bb * T; t0 = (tt & 255) * 64; Ls = T; nchunk = 4 + (tt & 255); }
    else { const int tc = tt - 512; bb = tc >> 2; rowbase = (size_t)ML + bb * CL; t0 = (tc & 3) * 64; Ls = CL; nchunk = tc & 3; }
    __syncthreads();
    {
        const int tl = tid >> 3, cg = tid & 7, ch0 = n * 128 + cg * 16;
        float acc[16];
#pragma unroll
        for (int j = 0; j < 16; ++j) acc[j] = cb[ch0 + j];
#pragma unroll
        for (int tap = 0; tap < 4; ++tap) { const int ts = t0 + tl + tap - 2;
            if (ts >= 0 && ts < Ls) { const bf16_t* rp = PM + (rowbase + ts) * NMIXP + C_RG_X + ch0; const u32x4 w0 = *(const u32x4*)rp, w1 = *(const u32x4*)(rp + 8);
                float f[8], g[8]; unpack8(w0, f); unpack8(w1, g);
#pragma unroll
                for (int j = 0; j < 8; ++j) { acc[j] += cw[tap * 512 + ch0 + j] * f[j]; acc[8 + j] += cw[tap * 512 + ch0 + 8 + j] * g[j]; } } }
#pragma unroll
        for (int j = 0; j < 16; ++j) xbT[(cg * 16 + j) * 68 + tl] = acc[j];
        float x0[8], x1[8];
#pragma unroll
        for (int j = 0; j < 8; ++j) { x0[j] = acc[j]; x1[j] = acc[8 + j]; }
        *(LAS u32x4*)(XB + tl * 272 + cg * 32) = pack8(x0); *(LAS u32x4*)(XB + tl * 272 + cg * 32 + 16) = pack8(x1);
    }
    __syncthreads();
    const int r = lane & 31, hh = lane >> 5, tth = wave & 1, ot = wave >> 1;
    const int oc = tid & 127, tq = tid >> 7, ch = n * 128 + oc;
#pragma unroll 1
    for (int d = 0; d < 2; ++d) {
        {
            const bf16_t* wbase = (const bf16_t*)(a.ws + WS_RGW) + (size_t)(((L * 2 + d) * 4 + n) * 2) * 16384 + (32 * ot + r) * 128 + hh * 8;
#pragma unroll
            for (int g = 0; g < 2; ++g) { f32x16 acc;
#pragma unroll
                for (int i = 0; i < 16; ++i) acc[i] = 0.f;
#pragma unroll
                for (int ks = 0; ks < 8; ++ks) { const bf16x8 af = *(const LAS bf16x8*)(XB + (32 * tth + r) * 272 + ks * 32 + hh * 16); const bf16x8 bfr = *(const bf16x8*)(wbase + g * 16384 + ks * 16);
                    acc = MFMA32(af, bfr, acc); }
#pragma unroll
                for (int gq = 0; gq < 4; ++gq) { f32x4 v = {acc[4 * gq], acc[4 * gq + 1], acc[4 * gq + 2], acc[4 * gq + 3]};
                    *(LAS f32x4*)(PRE + (g * 128 + 32 * ot + r) * 68 + 32 * tth + 8 * gq + 4 * hh) = v; } }
        }
        __syncthreads();
        {
            const float br = a.in[I_RG_BR][(L * 2 + d) * 512 + ch], bi = a.in[I_RG_BI][(L * 2 + d) * 512 + ch];
            const float sp = softplusf(-a.in[I_RG_LAM][(L * 2 + d) * 512 + ch]);
            float la[16], hl[16];
#pragma unroll
            for (int q = 0; q < 4; ++q) { const f32x4 pr = *(const LAS f32x4*)(PRE + oc * 68 + 16 * tq + 4 * q), pi = *(const LAS f32x4*)(PRE + (128 + oc) * 68 + 16 * tq + 4 * q), xv = *(const LAS f32x4*)(xbT + oc * 68 + 16 * tq + 4 * q);
#pragma unroll
                for (int j = 0; j < 4; ++j) { const float rr = sigm(pr[j] + br), ig = sigm(pi[j] + bi); const float l = -8.0f * rr * sp;
                    la[4 * q + j] = l; hl[4 * q + j] = sqrtf(fmaxf(-expm1f(2.0f * l), 0.f)) * (ig * xv[j]); } }
            float hrun = 0.f, lrun = 0.f;
            if (d == 0) {
#pragma unroll
                for (int j = 0; j < 16; ++j) { hrun = __expf(la[j]) * hrun + hl[j]; lrun += la[j]; hl[j] = hrun; la[j] = lrun; } }
            else {
#pragma unroll
                for (int j = 15; j >= 0; --j) { hrun = __expf(la[j]) * hrun + hl[j]; lrun += la[j]; hl[j] = hrun; la[j] = lrun; } }
            SEG[(tq * 128 + oc) * 2] = lrun; SEG[(tq * 128 + oc) * 2 + 1] = hrun;
            __syncthreads();
            float Hin = 0.f, Lin = 0.f, Htot = 0.f, Ltot = 0.f;
#pragma unroll
            for (int s = 0; s < 4; ++s) { const int sg = d ? 3 - s : s; const float ls = SEG[(sg * 128 + oc) * 2], hs = SEG[(sg * 128 + oc) * 2 + 1];
                const bool before = d ? (sg > tq) : (sg < tq);
                if (before) { Hin = __expf(ls) * Hin + hs; Lin += ls; }
                Htot = __expf(ls) * Htot + hs; Ltot += ls; }
            const size_t ob = ((size_t)d * MT + rowbase + t0 + 16 * tq);
#pragma unroll
            for (int j = 0; j < 16; ++j) { const float e = __expf(la[j]);
                ORAW[(ob + j) * 2048 + 1536 + ch] = f2bf(hl[j] + e * Hin);
                RGLA[(ob + j) * 512 + ch] = f2bf(e * __expf(Lin)); }
            if (tq == 0) { float* tp = TT + ((size_t)((d * 2 + bb) * 260 + nchunk) * 512 + ch) * 2; tp[0] = __expf(Ltot); tp[1] = Htot; }
        }
        __syncthreads();
    }
}
__device__ __forceinline__ void rg_carry(const Ctx& c, int part) {
    ARGS_REF a = *c.a; const int gid = part * 512 + c.tid, d = gid >> 10, b = (gid >> 9) & 1, ch = gid & 511;
    typedef float f32x2v __attribute__((ext_vector_type(2)));
    const f32x2v* TT = (const f32x2v*)(a.ws + WS_RGTT) + (size_t)((d * 2 + b) * 260) * 512 + ch;
    float* CR = (float*)(a.ws + WS_RGCARRY) + (size_t)((d * 2 + b) * 260) * 512 + ch;
    float H = 0.f;
#pragma unroll 1
    for (int m0 = 0; m0 < 260; m0 += 20) { f32x2v p[20];
#pragma unroll
        for (int j = 0; j < 20; ++j) { const int m = m0 + j, nn = d ? (m < 4 ? 3 - m : 263 - m) : m; p[j] = TT[(size_t)nn * 512]; }
#pragma unroll
        for (int j = 0; j < 20; ++j) { const int m = m0 + j, nn = d ? (m < 4 ? 3 - m : 263 - m) : m; CR[(size_t)nn * 512] = H; H = p[j].x * H + p[j].y; } }
}
template <int L>
__device__ __forceinline__ void intra_phase(const Ctx& c) {
#pragma unroll 1
    for (int item = c.wg; item < 2080; item += c.G) rgprep_item2<L>(c, item);
#pragma unroll 1
    for (int item = (c.wg + 96) % c.G; item < 2080; item += c.G) { const int bh = item / 260, n = item % 260; intra_g_item<L, 0>(c, bh >> 2, bh & 3, n); }
#pragma unroll 1
    for (int item = (c.wg + 192) % c.G; item < 2080; item += c.G) { const int bh = item / 260, n = item % 260; intra_g_item<L, 1>(c, bh >> 2, bh & 3, n); }
#pragma unroll 1
    for (int item = (c.wg + 32) % c.G; item < 2080; item += c.G) { const int bh = item / 260, n = item % 260; intra_dn_item<L>(c, bh >> 2, bh & 3, n); }
}
template <int L>
__device__ __forceinline__ void chains_phase(const Ctx& c) {
    const int w = c.wg;
    if (w < 32) { const int r = w & 15, b = r >> 3, h = (r >> 1) & 3, d = r & 1;
        if (w < 16) chain_g<L, 0>(c, b, h, d); else chain_g<L, 1>(c, b, h, d); }
    else if (w < 48) { const int r = w - 32, b = r >> 3, h = (r >> 1) & 3, d = r & 1; chain_dnc<L>(c, b, h, d); }
    else if (w < 52) rg_carry(c, w - 48);
}
template <int L>
__device__ __forceinline__ void combine_phase(const Ctx& c) {
    ARGS_REF a = *c.a; const int gw = c.wg * 8 + c.wave, nw = c.G * 8, lane = c.lane;
    const bf16_t* PM = (const bf16_t*)(a.ws + WS_PMIX); const bf16_t* O0 = (const bf16_t*)(a.ws + WS_ORAW); const bf16_t* O1 = O0 + (size_t)MT * 2048;
    bf16_t* O = (bf16_t*)(a.ws + WS_O);
    const int cb = lane * 8, hv = cb & 127;
    float nwv[3][8];
#pragma unroll
    for (int j = 0; j < 8; ++j) { nwv[0][j] = a.in[I_GLA_NW][L * 128 + hv + j]; nwv[1][j] = a.in[I_HG_NW][L * 128 + hv + j]; nwv[2][j] = a.in[I_DN_NW][L * 128 + hv + j]; }
    const int nrows = (L == 0) ? MT : ML;
    for (int r = gw; r < nrows; r += nw) {
        const bf16_t* pm = PM + (size_t)r * NMIXP;
#pragma unroll
        for (int br = 0; br < 3; ++br) {
            const int gcol = br == 0 ? C_GLA_G : (br == 1 ? C_HG_G : C_DN_G);
            float x0[8], x1[8], g[8], o[8];
            { const u32x4 w = *(const u32x4*)(O0 + (size_t)r * 2048 + br * 512 + cb); unpack8(w, x0); }
            { const u32x4 w = *(const u32x4*)(O1 + (size_t)r * 2048 + br * 512 + cb); unpack8(w, x1); }
            { const u32x4 w = *(const u32x4*)(pm + gcol + cb); unpack8(w, g); }
            float ss = 0.f;
#pragma unroll
            for (int j = 0; j < 8; ++j) { o[j] = x0[j] + x1[j]; ss += o[j] * o[j]; }
            ss += __shfl_xor(ss, 1); ss += __shfl_xor(ss, 2); ss += __shfl_xor(ss, 4); ss += __shfl_xor(ss, 8);
            const float rs = rsqrtf(ss * (1.0f / 128.0f) + EPS);
#pragma unroll
            for (int j = 0; j < 8; ++j) o[j] = o[j] * rs * nwv[br][j] * siluf(g[j]);
            *(u32x4*)(O + ((size_t)br * MT + r) * 512 + cb) = pack8(o);
        }
        {   float x0[8], x1[8], p0[8], p1[8], y[8], o[8];
            const int bb = r < ML ? (r >> 14) : ((r - ML) >> 8), nchunk = r < ML ? 4 + ((r & 16383) >> 6) : (((r - ML) & 255) >> 6);
            const bf16_t* RGLA = (const bf16_t*)(a.ws + WS_RGLA); const float* CR = (const float*)(a.ws + WS_RGCARRY);
            { const u32x4 w = *(const u32x4*)(O0 + (size_t)r * 2048 + 1536 + cb); unpack8(w, x0); }
            { const u32x4 w = *(const u32x4*)(O1 + (size_t)r * 2048 + 1536 + cb); unpack8(w, x1); }
            { const u32x4 w = *(const u32x4*)(RGLA + (size_t)r * 512 + cb); unpack8(w, p0); }
            { const u32x4 w = *(const u32x4*)(RGLA + ((size_t)MT + r) * 512 + cb); unpack8(w, p1); }
            { const u32x4 w = *(const u32x4*)(pm + C_RG_Y + cb); unpack8(w, y); }
            const float* c0 = CR + (size_t)((0 * 2 + bb) * 260 + nchunk) * 512 + cb; const float* c1 = CR + (size_t)((1 * 2 + bb) * 260 + nchunk) * 512 + cb;
            const f32x4 ca = *(const f32x4*)c0, cb2 = *(const f32x4*)(c0 + 4), cc = *(const f32x4*)c1, cd = *(const f32x4*)(c1 + 4);
#pragma unroll
            for (int j = 0; j < 8; ++j) { const float k0 = j < 4 ? ca[j & 3] : cb2[j & 3], k1 = j < 4 ? cc[j & 3] : cd[j & 3];
                o[j] = gelu_tanh(y[j]) * ((x0[j] + p0[j] * k0) + (x1[j] + p1[j] * k1)); }
            *(u32x4*)(O + ((size_t)3 * MT + r) * 512 + cb) = pack8(o);
        }
    }
}

__device__ __forceinline__ void route1_phase(const Ctx& c) {
    ARGS_REF a = *c.a; const int lane = c.lane;
    const float* modv = (const float*)(a.ws + WS_MOD) + (size_t)1 * 3 * 12288 + 3 * 2048;
    const float* normw = a.in[I_NORMW] + (1 * 2 + 1) * 2048;
    const float* router = a.in[I_ROUTER];
    bf16_t* H = (bf16_t*)(a.ws + WS_H);
    unsigned* topi = (unsigned*)(a.ws + WS_TOPI); float* topw = (float*)(a.ws + WS_TOPW);
    volatile LAS int* hist = (volatile LAS int*)(c.lds + LDS_AUX);
    if (c.tid < 8) hist[c.tid] = 0;
    __syncthreads();
    const int rpw = ML / c.G;
    for (int rr = c.wave; rr < rpw; rr += 8) {
        const int r = c.wg * rpw + rr, b = r >> 14;
        const float* src = (const float*)a.out + (size_t)r * D;
        f32x4 v[8];
#pragma unroll
        for (int j = 0; j < 8; ++j) v[j] = *(const f32x4*)(src + (j * 64 + lane) * 4);
        const float* shift = modv + (size_t)b * 12288;
        modnorm_row(v, normw, shift, shift + 2048, lane);
        store_row_bf16(v, H + (size_t)r * D, lane);
        float lg[8];
#pragma unroll
        for (int e = 0; e < 8; ++e) lg[e] = 0.f;
#pragma unroll
        for (int j = 0; j < 8; ++j)
#pragma unroll
            for (int q = 0; q < 4; ++q) { const int cc = (j * 64 + lane) * 4 + q; const f32x4 r0 = *(const f32x4*)(router + cc * 8), r1 = *(const f32x4*)(router + cc * 8 + 4); const float x = v[j][q];
                lg[0] += x * r0[0]; lg[1] += x * r0[1]; lg[2] += x * r0[2]; lg[3] += x * r0[3]; lg[4] += x * r1[0]; lg[5] += x * r1[1]; lg[6] += x * r1[2]; lg[7] += x * r1[3]; }
#pragma unroll
        for (int e = 0; e < 8; ++e) lg[e] = wave_sum(lg[e]);
        int e0 = 0; float m0 = lg[0];
#pragma unroll
        for (int e = 1; e < 8; ++e) if (lg[e] > m0) { m0 = lg[e]; e0 = e; }
        int e1 = -1; float m1 = -3.0e38f;
#pragma unroll
        for (int e = 0; e < 8; ++e) if (e != e0 && lg[e] > m1) { m1 = lg[e]; e1 = e; }
        if (e1 < 0) { e1 = (e0 + 1) & 7; m1 = m0; }
        if (lane == 0) { const float ex = __expf(m1 - m0); const float w0 = 1.0f / (1.0f + ex); topi[r] = (unsigned)e0 | ((unsigned)e1 << 8); topw[2 * r] = w0; topw[2 * r + 1] = ex * w0;
            lds_add(&hist[e0]); lds_add(&hist[e1]); }
    }
    __syncthreads();
    if (c.tid < 8) ((int*)(a.ws + WS_CTL + CTL_WGH))[c.wg * 8 + c.tid] = hist[c.tid];
}
__device__ __forceinline__ void route2_phase(const Ctx& c) {
    ARGS_REF a = *c.a; const int lane = c.lane, tid = c.tid;
    const int* wgh = (const int*)(a.ws + WS_CTL + CTL_WGH);
    volatile LAS int* tab = (volatile LAS int*)(c.lds + LDS_AUX);
    if (tid < 8) { int tot = 0, base = 0; for (int w = 0; w < c.G; ++w) { const int v = wgh[w * 8 + tid]; tot += v; if (w < c.wg) base += v; } tab[tid] = tot; tab[8 + tid] = base; tab[24 + tid] = 0; tab[32 + tid] = (tot + 255) / 256 * 256; }
    __syncthreads();
    if (tid == 0) { int acc = 0; for (int e = 0; e < 8; ++e) { tab[16 + e] = acc; acc += tab[32 + e]; }
        if (c.wg == 0) { int* meta = (int*)(a.ws + WS_CTL + CTL_META); int cum = 0; for (int e = 0; e < 8; ++e) { cum += tab[32 + e] / 256; meta[e] = cum; } meta[8] = cum; } }
    __syncthreads();
    const bf16_t* H = (const bf16_t*)(a.ws + WS_H); bf16_t* GATH = (bf16_t*)(a.ws + WS_GATH);
    const unsigned* topi = (const unsigned*)(a.ws + WS_TOPI); int* dest = (int*)(a.ws + WS_DEST);
    const int rpw = ML / c.G;
    for (int rr = c.wave; rr < rpw; rr += 8) {
        const int r = c.wg * rpw + rr; const unsigned ti = topi[r]; const int e0 = ti & 255, e1 = (ti >> 8) & 255;
        int d0 = 0, d1 = 0;
        if (lane == 0) { d0 = tab[16 + e0] + tab[8 + e0] + lds_add(&tab[24 + e0]); d1 = tab[16 + e1] + tab[8 + e1] + lds_add(&tab[24 + e1]); dest[2 * r] = d0; dest[2 * r + 1] = d1; }
        d0 = __shfl(d0, 0); d1 = __shfl(d1, 0);
        const u32x4* sp = (const u32x4*)(H + (size_t)r * D); u32x4* p0 = (u32x4*)(GATH + (size_t)d0 * D); u32x4* p1 = (u32x4*)(GATH + (size_t)d1 * D);
#pragma unroll
        for (int j = 0; j < 4; ++j) { const u32x4 w = sp[j * 64 + lane]; p0[j * 64 + lane] = w; p1[j * 64 + lane] = w; }
    }
    if (c.wg < 8) { const int e = c.wg; const int lo = tab[16 + e] + tab[e], hi = tab[16 + e] + tab[32 + e]; const u32x4 z = {0u, 0u, 0u, 0u};
        for (int r = lo + c.wave; r < hi; r += 8) { u32x4* p = (u32x4*)(GATH + (size_t)r * D);
#pragma unroll
            for (int j = 0; j < 4; ++j) p[j * 64 + lane] = z; } }
}
__device__ __forceinline__ void final_phase(const Ctx& c) {
    ARGS_REF a = *c.a; const int gw = c.wg * 8 + c.wave, nw = c.G * 8, lane = c.lane;
    const float* modv = (const float*)(a.ws + WS_MOD) + (size_t)1 * 3 * 12288 + 5 * 2048;
    const bf16_t* Y = (const bf16_t*)(a.ws + WS_GATH); const int* dest = (const int*)(a.ws + WS_DEST); const float* topw = (const float*)(a.ws + WS_TOPW);
    const float* fw = a.in[I_FNORMW];
    for (int r = gw; r < ML; r += nw) {
        const int b = r >> 14; float* xr = a.out + (size_t)r * D; const float* mg = modv + (size_t)b * 12288;
        const int d0 = dest[2 * r], d1 = dest[2 * r + 1]; const float w0 = topw[2 * r], w1 = topw[2 * r + 1];
        const bf16_t* y0 = Y + (size_t)d0 * D; const bf16_t* y1 = Y + (size_t)d1 * D;
        f32x4 v[8]; float ss = 0.f;
#pragma unroll
        for (int j = 0; j < 8; ++j) { const int cc = (j * 64 + lane) * 4; const f32x4 x = *(const f32x4*)(xr + cc), g = *(const f32x4*)(mg + cc);
            const u32x2 a0 = *(const u32x2*)(y0 + cc), a1 = *(const u32x2*)(y1 + cc);
            f32x4 m; m[0] = w0 * bflo(a0.x) + w1 * bflo(a1.x); m[1] = w0 * bfhi(a0.x) + w1 * bfhi(a1.x); m[2] = w0 * bflo(a0.y) + w1 * bflo(a1.y); m[3] = w0 * bfhi(a0.y) + w1 * bfhi(a1.y);
            v[j] = x + g * m; ss += v[j][0] * v[j][0] + v[j][1] * v[j][1] + v[j][2] * v[j][2] + v[j][3] * v[j][3]; }
        ss = wave_sum(ss); const float rstd = rsqrtf(ss * (1.0f / 2048.0f) + EPS);
#pragma unroll
        for (int j = 0; j < 8; ++j) { const int cc = (j * 64 + lane) * 4; const f32x4 w = *(const f32x4*)(fw + cc); *(f32x4*)(xr + cc) = v[j] * rstd * w; }
    }
}

#ifndef N_LAUNCHES
#define N_LAUNCHES 1
#endif
constexpr int N_PHASES = 25;

template <int L>
__device__ __forceinline__ void gemm_projmix(const Ctx& c) {
    ARGS_REF a = *c.a;
    pg8::Gemm g{(const bf16_t*)(a.ws + WS_H), (const bf16_t*)(a.ws + WS_WIN + (size_t)L * WIN_BYTES), MT, NMIXP, D};
    pg8::StaticOrder S; S.init(MT, NMIXP, c.G, c.wg);
    pg8::EpiBf16S<false> E{(bf16_t*)(a.ws + WS_PMIX), NMIXP};
    pg8::gemm_phase<pg8::EpiBf16S<false>, pg8::StaticOrder, true, true>(c.lds + LDS_SCR, g, S, E);
}
template <int L>
__device__ __forceinline__ void gemm_gate(const Ctx& c) {
    ARGS_REF a = *c.a; constexpr int M = (L == 0) ? MT : ML;
    pg8::Gemm g{(const bf16_t*)(a.ws + WS_H), (const bf16_t*)(a.ws + WS_WIN + (size_t)L * WIN_BYTES + (size_t)NMIXP * D * 2), M, NGATE, D};
    pg8::StaticOrder S; S.init(M, NGATE, c.G, c.wg);
    pg8::EpiBf16S<true> E{(bf16_t*)(a.ws + WS_PGATE), NGATE};
    pg8::gemm_phase<pg8::EpiBf16S<true>, pg8::StaticOrder, true, true>(c.lds + LDS_SCR, g, S, E);
}
template <int L>
__device__ __forceinline__ void gemm_upgate(const Ctx& c) {
    ARGS_REF a = *c.a; constexpr int M = (L == 0) ? MT : ML;
    pg8::Gemm g{(const bf16_t*)(a.ws + WS_O), (const bf16_t*)(a.ws + WS_WUP + (size_t)L * 8388608), M, 2048, 512};
    pg8::UpGateOrder S; S.init(M, c.G, c.wg, MT / 256);
    pg8::EpiUpGate E{(const bf16_t*)(a.ws + WS_PGATE), (float*)(a.ws + WS_MACC), (bf16_t*)(a.ws + WS_MERGED), MT / 256};
    pg8::gemm_phase<pg8::EpiUpGate, pg8::UpGateOrder, true, true>(c.lds + LDS_SCR, g, S, E);
}
template <int L>
__device__ __forceinline__ void gemm_wout(const Ctx& c) {
    ARGS_REF a = *c.a; constexpr int M = (L == 0) ? MT : ML;
    pg8::Gemm g{(const bf16_t*)(a.ws + WS_MERGED), (const bf16_t*)(a.ws + WS_WOUT + (size_t)L * 8388608), M, D, D};
    pg8::StaticOrder S; S.init(M, D, c.G, c.wg);
    const float* modv = (const float*)(a.ws + WS_MOD) + (size_t)L * 3 * 12288 + 2 * 2048;
    pg8::EpiResid E{L == 0 ? a.in[I_X] : (const float*)a.out, a.out, L == 0 ? a.in[I_CTX] : (const float*)(a.ws + WS_XC), (float*)(a.ws + WS_XC), modv, L == 1 ? 1 : 0};
    pg8::gemm_phase<pg8::EpiResid, pg8::StaticOrder, true, true>(c.lds + LDS_SCR, g, S, E);
}
__device__ __forceinline__ void gemm_ffn13(const Ctx& c) {
    ARGS_REF a = *c.a;
    pg8::Gemm g{(const bf16_t*)(a.ws + WS_H), (const bf16_t*)(a.ws + WS_F13), MT, 2 * FF, D};
    pg8::StaticOrder S; S.init(MT, 2 * FF, c.G, c.wg);
    pg8::EpiSwiglu E{(bf16_t*)(a.ws + WS_HID), 2 * FF / 256};
    pg8::gemm_phase<pg8::EpiSwiglu, pg8::StaticOrder, true, true>(c.lds + LDS_SCR, g, S, E);
}
__device__ __forceinline__ void gemm_ffn2(const Ctx& c) {
    ARGS_REF a = *c.a;
    pg8::Gemm g{(const bf16_t*)(a.ws + WS_HID), (const bf16_t*)(a.ws + WS_F2), MT, D, FF};
    pg8::StaticOrder S; S.init(MT, D, c.G, c.wg);
    const float* modv = (const float*)(a.ws + WS_MOD) + (size_t)0 * 3 * 12288 + 5 * 2048;
    pg8::EpiResid E{(const float*)a.out, a.out, (const float*)(a.ws + WS_XC), (float*)(a.ws + WS_XC), modv, 0};
    pg8::gemm_phase<pg8::EpiResid, pg8::StaticOrder, true, true>(c.lds + LDS_SCR, g, S, E);
}
__device__ __forceinline__ void gemm_moe13(const Ctx& c) {
    ARGS_REF a = *c.a; const int* meta = (const int*)(a.ws + WS_CTL + CTL_META);
    int be[8];
#pragma unroll
    for (int e = 0; e < 8; ++e) be[e] = __builtin_amdgcn_readfirstlane(meta[e]);
    pg8::Gemm g{(const bf16_t*)(a.ws + WS_GATH), (const bf16_t*)(a.ws + WS_M13), MOE_ROWS, 2 * FF, D};
    pg8::MoeOrder S; S.init(be[7], 2 * FF / 256, c.G, c.wg, be);
    pg8::EpiSwiglu E{(bf16_t*)(a.ws + WS_HIDM), 2 * FF / 256};
    pg8::gemm_phase<pg8::EpiSwiglu, pg8::MoeOrder, true, true>(c.lds + LDS_SCR, g, S, E);
}
__device__ __forceinline__ void gemm_moe2(const Ctx& c) {
    ARGS_REF a = *c.a; const int* meta = (const int*)(a.ws + WS_CTL + CTL_META);
    int be[8];
#pragma unroll
    for (int e = 0; e < 8; ++e) be[e] = __builtin_amdgcn_readfirstlane(meta[e]);
    pg8::Gemm g{(const bf16_t*)(a.ws + WS_HIDM), (const bf16_t*)(a.ws + WS_M2), MOE_ROWS, D, FF};
    pg8::MoeOrder S; S.init(be[7], D / 256, c.G, c.wg, be);
    pg8::EpiPlainBf16 E{(bf16_t*)(a.ws + WS_GATH), D, D / 256};
    pg8::gemm_phase<pg8::EpiPlainBf16, pg8::MoeOrder, true, true>(c.lds + LDS_SCR, g, S, E);
}

__device__ __forceinline__ void prologue_phase(const Ctx& c) {
    ARGS_REF a = *c.a; int rot = 0;
    mod_phase(c);
    rgw_convert(c);
    for (int l = 0; l < 2; ++l) {
        conv_job<1>(c, a.in[I_WIN] + (size_t)l * D * DIN, nullptr, DIN, D, NPROJ, (bf16_t*)(a.ws + WS_WIN + (size_t)l * WIN_BYTES), rot);
        for (int b = 0; b < 4; ++b) conv_job<0>(c, a.in[I_WUP] + (size_t)(l * 4 + b) * 512 * D, nullptr, D, 512, D, (bf16_t*)(a.ws + WS_WUP + (size_t)l * 8388608 + (size_t)b * 2048 * 512 * 2), rot);
        conv_job<0>(c, a.in[I_WOUT] + (size_t)l * D * D, nullptr, D, D, D, (bf16_t*)(a.ws + WS_WOUT + (size_t)l * 8388608), rot);
    }
    conv_job<2>(c, a.in[I_F1], a.in[I_F3], FF, D, 2 * FF, (bf16_t*)(a.ws + WS_F13), rot);
    conv_job<0>(c, a.in[I_F2], nullptr, D, FF, D, (bf16_t*)(a.ws + WS_F2), rot);
}
__device__ __forceinline__ void moeconv_phase(const Ctx& c) {
    ARGS_REF a = *c.a; int rot = 0;
    for (int e = 0; e < 8; ++e) {
        conv_job<2>(c, a.in[I_M1] + (size_t)e * D * FF, a.in[I_M3] + (size_t)e * D * FF, FF, D, 2 * FF, (bf16_t*)(a.ws + WS_M13 + (size_t)e * 46137344), rot);
        conv_job<0>(c, a.in[I_M2] + (size_t)e * FF * D, nullptr, D, FF, D, (bf16_t*)(a.ws + WS_M2 + (size_t)e * 23068672), rot);
    }
}

__global__ void __launch_bounds__(512, 2) fwd_kernel(Args args) {
    extern __shared__ __attribute__((aligned(16))) unsigned char lds_raw[];
    volatile LAS unsigned* misc = (volatile LAS unsigned*)((LAS unsigned char*)lds_raw + LDS_MISC);
    if (threadIdx.x < 16) misc[threadIdx.x] = 0u;
    __syncthreads();
    const int lo = args.ph_lo, hi = args.ph_hi;
    XcdBarrier bar; bar.bar = (unsigned*)(args.ws + WS_CTL + CTL_BAR); bar.x = 0; bar.st = misc;
    if (hi - lo > 1) bar = xcd_barrier_post((unsigned*)(args.ws + WS_CTL + CTL_BAR), misc);
#define IN(k) (lo <= (k) && (k) < hi)
#define MKCTX Ctx c; { int t_ = threadIdx.x; asm volatile("" : "+v"(t_)); { ArgsP kp_ = (ArgsP)__builtin_amdgcn_kernarg_segment_ptr(); asm volatile("" : "+s"(kp_)); c.a = kp_; } c.lds = (LAS unsigned char*)lds_raw; c.tid = t_; c.lane = t_ & 63; c.wave = __builtin_amdgcn_readfirstlane(t_ >> 6); c.wg = blockIdx.x; c.G = gridDim.x; }
#ifndef PROBE_MASK
#define PROBE_MASK 0u
#endif
#define REP(k, ...) if ((PROBE_MASK >> (k)) & 1u) { __syncthreads(); __VA_ARGS__; }
#define SEAM(k) do { if (IN(k) && IN((k) + 1)) xcd_barrier(bar); } while (0)
    if (IN(0)) { MKCTX prologue_phase(c); REP(0, prologue_phase(c)) } SEAM(0);
    if (IN(1)) { MKCTX norm_phase<0, 0>(c); REP(1, norm_phase<0, 0>(c)) } SEAM(1);
    if (IN(2)) { MKCTX gemm_projmix<0>(c); REP(2, gemm_projmix<0>(c)) } SEAM(2);
    if (IN(3)) { MKCTX intra_phase<0>(c); REP(3, intra_phase<0>(c)) } SEAM(3);
    if (IN(4)) { MKCTX chains_phase<0>(c); REP(4, chains_phase<0>(c)) } SEAM(4);
    if (IN(5)) { MKCTX combine_phase<0>(c); REP(5, combine_phase<0>(c)) } SEAM(5);
    if (IN(6)) { MKCTX gemm_gate<0>(c); REP(6, gemm_gate<0>(c)) } SEAM(6);
    if (IN(7)) { MKCTX gemm_upgate<0>(c); REP(7, gemm_upgate<0>(c)) } SEAM(7);
    if (IN(8)) { MKCTX gemm_wout<0>(c); } SEAM(8);
    if (IN(9)) { MKCTX norm_phase<0, 1>(c); REP(9, norm_phase<0, 1>(c)) } SEAM(9);
    if (IN(10)) { MKCTX gemm_ffn13(c); REP(10, gemm_ffn13(c)) } SEAM(10);
    if (IN(11)) { MKCTX gemm_ffn2(c); } SEAM(11);
    if (IN(12)) { MKCTX norm_phase<1, 0>(c); REP(12, norm_phase<1, 0>(c)) } SEAM(12);
    if (IN(13)) { MKCTX gemm_projmix<1>(c); REP(13, gemm_projmix<1>(c)) } SEAM(13);
    if (IN(14)) { MKCTX intra_phase<1>(c); REP(14, intra_phase<1>(c)) } SEAM(14);
    if (IN(15)) { MKCTX chains_phase<1>(c); REP(15, chains_phase<1>(c)) } SEAM(15);
    if (IN(16)) { MKCTX combine_phase<1>(c); REP(16, combine_phase<1>(c)) } SEAM(16);
    if (IN(17)) { MKCTX gemm_gate<1>(c); REP(17, gemm_gate<1>(c)) } SEAM(17);
    if (IN(18)) { MKCTX gemm_upgate<1>(c); REP(18, gemm_upgate<1>(c)) } SEAM(18);
    if (IN(19)) { MKCTX gemm_wout<1>(c); } SEAM(19);
    if (IN(20)) { MKCTX route1_phase(c); __syncthreads(); moeconv_phase(c); REP(20, route1_phase(c); __syncthreads(); moeconv_phase(c)) } SEAM(20);
    if (IN(21)) { MKCTX route2_phase(c); REP(21, route2_phase(c)) } SEAM(21);
    if (IN(22)) { MKCTX gemm_moe13(c); REP(22, gemm_moe13(c)) } SEAM(22);
    if (IN(23)) { MKCTX gemm_moe2(c); REP(23, gemm_moe2(c)) } SEAM(23);
    if (IN(24)) { MKCTX final_phase(c); }
#undef IN
#undef SEAM
}

extern "C" void kernel_launch(void* const* d_in, const int* in_sizes, int n_in, void* d_out, int out_size, void* d_ws, size_t ws_size, hipStream_t stream) {
    static int grid = 0;
    if (grid == 0) {
        if (n_in != N_IN || out_size != ML * D || ws_size < WS_END) { fprintf(stderr, "kernel_launch: unexpected shapes: n_in %d out %d ws %zu (need %zu)\n", n_in, out_size, ws_size, (size_t)WS_END); grid = -1; return; }
        int dev = 0, cus = 0;
        if (hipGetDevice(&dev) != hipSuccess || hipDeviceGetAttribute(&cus, hipDeviceAttributeMultiprocessorCount, dev) != hipSuccess) { grid = -1; return; }
        if (hipFuncSetAttribute((const void*)fwd_kernel, hipFuncAttributeMaxDynamicSharedMemorySize, LDS_BYTES) != hipSuccess) { fprintf(stderr, "kernel_launch: hipFuncSetAttribute failed\n"); grid = -1; return; }
        int per_cu = 0;
        if (hipOccupancyMaxActiveBlocksPerMultiprocessor(&per_cu, (const void*)fwd_kernel, 512, LDS_BYTES) != hipSuccess || per_cu < 1) { fprintf(stderr, "kernel_launch: occupancy query says %d\n", per_cu); }
        (void)hipGetLastError();
        grid = cus > 256 ? 256 : cus;
    }
    if (grid < 0) return;
    (void)hipMemsetAsync((char*)d_ws + WS_CTL, 0, CTL_BYTES, stream);
    Args a{};
    for (int i = 0; i < N_IN; ++i) a.in[i] = (const float*)d_in[i];
    a.out = (float*)d_out; a.ws = (unsigned char*)d_ws;
#if N_LAUNCHES == 1
    a.ph_lo = 0; a.ph_hi = N_PHASES;
    hipLaunchKernelGGL(fwd_kernel, dim3(grid), dim3(512), LDS_BYTES, stream, a);
#else
    for (int p = 0; p < N_PHASES; ++p) { a.ph_lo = p; a.ph_hi = p + 1; hipLaunchKernelGGL(fwd_kernel, dim3(grid), dim3(512), LDS_BYTES, stream, a); }
#endif
}
```

```cpp
#include <hip/hip_runtime.h>
#include <cstdio>
#include <cstdint>
#define N_LAUNCHES 1
namespace pg8 {
#define PG8_LAS __attribute__((address_space(3)))
typedef unsigned short bf16_t;
typedef short bf16x8 __attribute__((ext_vector_type(8)));
typedef float f32x4 __attribute__((ext_vector_type(4)));
typedef unsigned u32x4 __attribute__((ext_vector_type(4)));
constexpr int BM = 256, BK = 64, HALF = 128, HTB = HALF * BK * 2  , STAGE_BYTES = 8 * HTB, NXCD = 8, WGM = 8;

__host__ __device__ __forceinline__ int lds_byte(int r, int c) { const int st = (r >> 4) * 2 + (c >> 5), rr = r & 15, cc = c & 31, ob = rr * 64 + cc * 2; return st * 1024 + (ob ^ (((ob >> 9) & 1) << 5)); }
__host__ __device__ __forceinline__ void stage_rc(int b, int& R, int& C) { const int st = b / 1024, sb = b % 1024, swz = sb ^ (((sb >> 9) & 1) << 5); R = (st >> 1) * 16 + swz / 64; C = (st & 1) * 32 + (swz % 64) / 2; }
__host__ __device__ __forceinline__ int perm32(int rho) { const int n = rho >> 4, i = rho & 15; return 8 * (i >> 2) + 4 * n + (i & 3); }

struct Unit { int pm, pn; };
struct Gemm { const bf16_t* A; const bf16_t* Bt; int M, N, K; };

struct StaticOrder {
    int nM, nN, nwg, G, c;
    __host__ __device__ void init(int M, int N, int G_, int c_) { nM = M / BM; nN = N / BM; nwg = nM * nN; G = G_; c = c_; }
    __host__ __device__ bool next(int i, Unit& u) const {
        const long L = (long)i * G + c; if (L >= nwg) return false;
        int wgid = (int)L; { const int q = nwg / NXCD, r = nwg % NXCD, xcd = wgid % NXCD, off = wgid / NXCD; wgid = (xcd < r ? xcd * (q + 1) : r * (q + 1) + (xcd - r) * q) + off; }
        const int nig = WGM * nN, gid = wgid / nig, fm = gid * WGM, gsz = (nM - fm) < WGM ? (nM - fm) : WGM;
        u.pm = fm + ((wgid % nig) % gsz); u.pn = (wgid % nig) / gsz; return true;
    }
    __device__ __forceinline__ void a_ready(const Unit&) const {}
    __device__ __forceinline__ void done(const Unit&) const {}
};
__device__ __forceinline__ unsigned cvt_pk_bf16(float lo, float hi) { unsigned r; asm volatile("v_cvt_pk_bf16_f32 %0, %1, %2" : "=v"(r) : "v"(lo), "v"(hi)); return r; }
typedef __bf16 bf16x2_t __attribute__((ext_vector_type(2)));
typedef float f32x2c_t __attribute__((ext_vector_type(2)));
__device__ __forceinline__ unsigned cvt_pk_bf16_safe(float lo, float hi) { const f32x2c_t v = {lo, hi}; return __builtin_bit_cast(unsigned, __builtin_convertvector(v, bf16x2_t)); }
template <class Epi, class Sched, bool ALIGN_EPI = false, bool SP2 = false>
__device__ __forceinline__ void gemm_phase(PG8_LAS unsigned char* lds, const Gemm g, const Sched& S, const Epi& E) {
    int tid_ = threadIdx.x; asm volatile("" : "+v"(tid_));
    const int tid = tid_, wid = __builtin_amdgcn_readfirstlane(tid >> 6), lane = tid & 63, wr = wid >> 2, wc = wid & 3, fr = lane & 15, fq = lane >> 4;
    const int K = g.K, nt = K / BK;
    unsigned voffA[2], voffB[2];
#pragma unroll
    for (int i = 0; i < 2; ++i) { int R, C; stage_rc(tid * 16 + i * 8192, R, C); const int Rb = Epi::PERM ? ((R & ~31) + perm32(R & 31)) : R;
        voffA[i] = (unsigned)(R * K + C) * 2u; voffB[i] = (unsigned)(Rb * K + C) * 2u; }
    const size_t kstep = (size_t)(BK * 2);
    const size_t hstep = (size_t)HALF * K * 2;
    const size_t tstep = 2 * hstep;
    const unsigned ldsw = (unsigned)wid * 1024u;
    const int aoff = lds_byte(wr * 64 + fr, fq * 8), boff = lds_byte(wc * 32 + fr, fq * 8);
#define PG8_SA(b, h) (((b) * 2 + (h)) * HTB)
#define PG8_SB(b, h) ((4 + (b) * 2 + (h)) * HTB)
#define PG8_STAGE(bufoff, gbase, voff) do { _Pragma("unroll") for (int _i = 0; _i < 2; ++_i) \
        __builtin_amdgcn_global_load_lds((const unsigned*)((const char*)(gbase) + (voff)[_i]), (PG8_LAS unsigned*)(lds + (bufoff) + ldsw + _i * 8192), 16, 0, 0); } while (0)
#define PG8_LDA(dst, b, h) do { _Pragma("unroll") for (int m = 0; m < 4; ++m) _Pragma("unroll") for (int k = 0; k < 2; ++k) dst[m][k] = *(const PG8_LAS bf16x8*)(lds + PG8_SA(b, h) + aoff + m * 2048 + k * 1024); } while (0)
#define PG8_LDB(dst, b, h) do { _Pragma("unroll") for (int n = 0; n < 2; ++n) _Pragma("unroll") for (int k = 0; k < 2; ++k) dst[n][k] = *(const PG8_LAS bf16x8*)(lds + PG8_SB(b, h) + boff + n * 2048 + k * 1024); } while (0)
#define PG8_MMA(ai, bj, At, Bt) do { __builtin_amdgcn_s_setprio(1); _Pragma("unroll") for (int m = 0; m < 4; ++m) _Pragma("unroll") for (int n = 0; n < 2; ++n) _Pragma("unroll") for (int k = 0; k < 2; ++k) \
        acc[ai][bj][m][n] = __builtin_amdgcn_mfma_f32_16x16x32_bf16(Bt[n][k], At[m][k], acc[ai][bj][m][n], 0, 0, 0); __builtin_amdgcn_s_setprio(0); } while (0)
#define PG8_WAIT_V(n) asm volatile("s_waitcnt vmcnt(" #n ")" ::: "memory")
#define PG8_WAIT_L(n) asm volatile("s_waitcnt lgkmcnt(" #n ")" ::: "memory")
#define PG8_BAR __builtin_amdgcn_s_barrier()
#define PG8_SCHED __builtin_amdgcn_sched_barrier(0)
    Unit cur, nxt; int ui = 0;
    if (!S.next(0, cur)) return;
    f32x4 acc[2][2][4][2];
#pragma unroll
    for (int a = 0; a < 2; ++a)
#pragma unroll
        for (int b = 0; b < 2; ++b)
#pragma unroll
            for (int m = 0; m < 4; ++m)
#pragma unroll
                for (int n = 0; n < 2; ++n) acc[a][b][m][n] = (f32x4){0.f, 0.f, 0.f, 0.f};
    bf16x8 At[4][2], B0[2][2], B1[2][2];
    const char* cA = (const char*)g.A + (size_t)cur.pm * tstep; const char* cB = (const char*)g.Bt + (size_t)cur.pn * tstep;
    S.a_ready(cur);
    if constexpr (SP2) {
        PG8_STAGE(PG8_SB(0, 0), cB, voffB); PG8_STAGE(PG8_SB(0, 1), cB + hstep, voffB); PG8_STAGE(PG8_SA(0, 0), cA, voffA); PG8_STAGE(PG8_SA(0, 1), cA + hstep, voffA);
        if (wr == 1) PG8_BAR;
        PG8_WAIT_V(2); PG8_BAR;
        PG8_STAGE(PG8_SB(1, 0), cB + kstep, voffB); PG8_STAGE(PG8_SA(1, 0), cA + kstep, voffA); PG8_STAGE(PG8_SB(1, 1), cB + hstep + kstep, voffB);
        PG8_WAIT_V(6); PG8_BAR;
    } else {
        PG8_STAGE(PG8_SB(0, 0), cB, voffB); PG8_STAGE(PG8_SA(0, 0), cA, voffA); PG8_STAGE(PG8_SB(0, 1), cB + hstep, voffB); PG8_STAGE(PG8_SA(0, 1), cA + hstep, voffA);
        if (wr == 1) PG8_BAR;
        PG8_WAIT_V(4); PG8_BAR;
        PG8_STAGE(PG8_SB(1, 0), cB + kstep, voffB); PG8_STAGE(PG8_SA(1, 0), cA + kstep, voffA); PG8_STAGE(PG8_SB(1, 1), cB + hstep + kstep, voffB);
        PG8_WAIT_V(6); PG8_BAR;
    }
    for (;;) {
        const bool has_next = S.next(ui + 1, nxt);
        const char* nA = has_next ? (const char*)g.A + (size_t)nxt.pm * tstep : cA; const char* nB = has_next ? (const char*)g.Bt + (size_t)nxt.pn * tstep : cB;
        for (int t = 0; t < nt; t += 2) {
            const bool last = (t == nt - 2);
            const char* a1 = cA + (size_t)(t + 1) * kstep;
            const char* a2 = last ? nA : cA + (size_t)(t + 2) * kstep; const char* b2 = last ? nB : cB + (size_t)(t + 2) * kstep;
            const char* a3 = a2 + kstep; const char* b3 = b2 + kstep;
            if (last && has_next) S.a_ready(nxt);
            if constexpr (SP2) {
            PG8_LDB(B0, 0, 0); PG8_LDB(B1, 0, 1); PG8_SCHED; PG8_LDA(At, 0, 0); PG8_STAGE(PG8_SA(1, 1), a1 + hstep, voffA);
            PG8_WAIT_V(8); PG8_WAIT_L(0); PG8_BAR; PG8_MMA(0, 0, At, B0); PG8_MMA(0, 1, At, B1); PG8_BAR; PG8_SCHED;
            PG8_LDA(At, 0, 1); PG8_STAGE(PG8_SB(0, 0), b2, voffB); PG8_STAGE(PG8_SB(0, 1), b2 + hstep, voffB); PG8_STAGE(PG8_SA(0, 0), a2, voffA);
            PG8_WAIT_V(8); PG8_WAIT_L(0); PG8_BAR; PG8_MMA(1, 0, At, B0); PG8_MMA(1, 1, At, B1); PG8_BAR; PG8_SCHED;
            PG8_LDB(B0, 1, 0); PG8_LDB(B1, 1, 1); PG8_SCHED; PG8_LDA(At, 1, 0); PG8_STAGE(PG8_SA(0, 1), a2 + hstep, voffA);
            PG8_WAIT_V(8); PG8_WAIT_L(0); PG8_BAR; PG8_MMA(0, 0, At, B0); PG8_MMA(0, 1, At, B1); PG8_BAR; PG8_SCHED;
            PG8_LDA(At, 1, 1); PG8_STAGE(PG8_SB(1, 0), b3, voffB); PG8_STAGE(PG8_SB(1, 1), b3 + hstep, voffB); PG8_STAGE(PG8_SA(1, 0), a3, voffA);
            PG8_WAIT_V(8); PG8_WAIT_L(0); PG8_BAR; PG8_MMA(1, 0, At, B0); PG8_MMA(1, 1, At, B1); PG8_BAR; PG8_SCHED;
            } else {
            PG8_LDB(B0, 0, 0); PG8_SCHED; PG8_LDA(At, 0, 0); PG8_STAGE(PG8_SA(1, 1), a1 + hstep, voffA);
            PG8_WAIT_L(8); PG8_BAR; PG8_WAIT_L(0); PG8_MMA(0, 0, At, B0); PG8_BAR; PG8_SCHED;
            PG8_LDB(B1, 0, 1); PG8_STAGE(PG8_SB(0, 0), b2, voffB);
            PG8_BAR; PG8_WAIT_L(0); PG8_MMA(0, 1, At, B1); PG8_BAR;
            PG8_LDA(At, 0, 1); PG8_STAGE(PG8_SA(0, 0), a2, voffA);
            PG8_BAR; PG8_WAIT_L(0); PG8_MMA(1, 0, At, B0); PG8_BAR; PG8_SCHED;
            PG8_STAGE(PG8_SB(0, 1), b2 + hstep, voffB);
            PG8_WAIT_V(6); PG8_BAR; PG8_MMA(1, 1, At, B1); PG8_BAR;
            PG8_LDB(B0, 1, 0); PG8_SCHED; PG8_LDA(At, 1, 0); PG8_STAGE(PG8_SA(0, 1), a2 + hstep, voffA);
            PG8_WAIT_L(8); PG8_BAR; PG8_WAIT_L(0); PG8_MMA(0, 0, At, B0); PG8_BAR; PG8_SCHED;
            PG8_LDB(B1, 1, 1); PG8_STAGE(PG8_SB(1, 0), b3, voffB);
            PG8_BAR; PG8_WAIT_L(0); PG8_MMA(0, 1, At, B1); PG8_BAR;
            PG8_LDA(At, 1, 1); PG8_STAGE(PG8_SA(1, 0), a3, voffA);
            PG8_BAR; PG8_WAIT_L(0); PG8_MMA(1, 0, At, B0); PG8_BAR; PG8_SCHED;
            PG8_STAGE(PG8_SB(1, 1), b3 + hstep, voffB);
            PG8_WAIT_V(6); PG8_BAR; PG8_MMA(1, 1, At, B1); PG8_BAR;
            }
        }
        if constexpr (ALIGN_EPI) { if (wr == 0) PG8_BAR; }
        if constexpr (!Epi::AFTER_DRAIN) { E(acc, cur, wr, wc, fr, fq); S.done(cur); }
        if (!has_next) break;
#pragma unroll
        for (int a = 0; a < 2; ++a)
#pragma unroll
            for (int b = 0; b < 2; ++b)
#pragma unroll
                for (int m = 0; m < 4; ++m)
#pragma unroll
                    for (int n = 0; n < 2; ++n) acc[a][b][m][n] = (f32x4){0.f, 0.f, 0.f, 0.f};
        cur = nxt; cA = nA; cB = nB; ++ui;
        if constexpr (ALIGN_EPI) { if (wr == 1) PG8_BAR; }
    }
    PG8_WAIT_V(0);
    if constexpr (!ALIGN_EPI) { if (wr == 0) PG8_BAR; }
    PG8_BAR;
    if constexpr (Epi::AFTER_DRAIN) { E.fused(acc, cur, wr, wc, fr, fq, lds, wid, lane); S.done(cur); }
#undef PG8_SA
#undef PG8_SB
#undef PG8_STAGE
#undef PG8_LDA
#undef PG8_LDB
#undef PG8_MMA
#undef PG8_WAIT_V
#undef PG8_WAIT_L
#undef PG8_BAR
#undef PG8_SCHED
}

typedef int i32x4 __attribute__((ext_vector_type(4)));
typedef int i32x8 __attribute__((ext_vector_type(8)));
template <class Epi, class Sched, bool ALIGN_EPI = false, bool SP2 = false>
__device__ __forceinline__ void gemm_phase8(PG8_LAS unsigned char* lds, const Gemm g, const Sched& S, const Epi& E) {
    int tid_ = threadIdx.x; asm volatile("" : "+v"(tid_));
    const int tid = tid_, wid = __builtin_amdgcn_readfirstlane(tid >> 6), lane = tid & 63, wr = wid >> 2, wc = wid & 3, fr = lane & 15, fq = lane >> 4;
    const int K = g.K, nt = K / BK;
    unsigned voffA[2], voffB[2];
#pragma unroll
    for (int i = 0; i < 2; ++i) { int R, C; stage_rc(tid * 16 + i * 8192, R, C); const int Rb = Epi::PERM ? ((R & ~31) + perm32(R & 31)) : R;
        voffA[i] = (unsigned)(R * K + C) * 2u; voffB[i] = (unsigned)(Rb * K + C) * 2u; }
    const size_t kstep = (size_t)(BK * 2);
    const size_t hstep = (size_t)HALF * K * 2;
    const size_t tstep = 2 * hstep;
    const unsigned ldsw = (unsigned)wid * 1024u;
    const int aoff = lds_byte(wr * 64 + fr, fq * 8), boff = lds_byte(wc * 32 + fr, fq * 8);
#define PG8_SA(b, h) (((b) * 2 + (h)) * HTB)
#define PG8_SB(b, h) ((4 + (b) * 2 + (h)) * HTB)
#define PG8_STAGE(bufoff, gbase, voff) do { _Pragma("unroll") for (int _i = 0; _i < 2; ++_i) \
        __builtin_amdgcn_global_load_lds((const unsigned*)((const char*)(gbase) + (voff)[_i]), (PG8_LAS unsigned*)(lds + (bufoff) + ldsw + _i * 8192), 16, 0, 0); } while (0)
#define PG8_LD8(addr) __builtin_shufflevector(__builtin_bit_cast(i32x4, *(const PG8_LAS bf16x8*)(addr)), __builtin_bit_cast(i32x4, *(const PG8_LAS bf16x8*)((addr) + 1024)), 0, 1, 2, 3, 4, 5, 6, 7)
#define PG8_LDA(dst, b, h) do { _Pragma("unroll") for (int m = 0; m < 4; ++m) dst[m] = PG8_LD8(lds + PG8_SA(b, h) + aoff + m * 2048); } while (0)
#define PG8_LDB(dst, b, h) do { _Pragma("unroll") for (int n = 0; n < 2; ++n) dst[n] = PG8_LD8(lds + PG8_SB(b, h) + boff + n * 2048); } while (0)
#define PG8_MMA(ai, bj, At, Bt) do { __builtin_amdgcn_s_setprio(1); _Pragma("unroll") for (int m = 0; m < 4; ++m) _Pragma("unroll") for (int n = 0; n < 2; ++n) \
        asm volatile("v_mfma_f32_16x16x128_f8f6f4 %0, %1, %2, %0" : "+v"(acc[ai][bj][m][n]) : "v"(Bt[n]), "v"(At[m])); __builtin_amdgcn_s_setprio(0); } while (0)
#define PG8_WAIT_V(n) asm volatile("s_waitcnt vmcnt(" #n ")" ::: "memory")
#define PG8_WAIT_L(n) asm volatile("s_waitcnt lgkmcnt(" #n ")" ::: "memory")
#define PG8_BAR __builtin_amdgcn_s_barrier()
#define PG8_SCHED __builtin_amdgcn_sched_barrier(0)
    Unit cur, nxt; int ui = 0;
    if (!S.next(0, cur)) return;
    f32x4 acc[2][2][4][2];
#pragma unroll
    for (int a = 0; a < 2; ++a)
#pragma unroll
        for (int b = 0; b < 2; ++b)
#pragma unroll
            for (int m = 0; m < 4; ++m)
#pragma unroll
                for (int n = 0; n < 2; ++n) acc[a][b][m][n] = (f32x4){0.f, 0.f, 0.f, 0.f};
    i32x8 At[4], B0[2], B1[2];
    const char* cA = (const char*)g.A + (size_t)cur.pm * tstep; const char* cB = (const char*)g.Bt + (size_t)cur.pn * tstep;
    S.a_ready(cur);
    if constexpr (SP2) {
        PG8_STAGE(PG8_SB(0, 0), cB, voffB); PG8_STAGE(PG8_SB(0, 1), cB + hstep, voffB); PG8_STAGE(PG8_SA(0, 0), cA, voffA); PG8_STAGE(PG8_SA(0, 1), cA + hstep, voffA);
        if (wr == 1) PG8_BAR;
        PG8_WAIT_V(2); PG8_BAR;
        PG8_STAGE(PG8_SB(1, 0), cB + kstep, voffB); PG8_STAGE(PG8_SA(1, 0), cA + kstep, voffA); PG8_STAGE(PG8_SB(1, 1), cB + hstep + kstep, voffB);
        PG8_WAIT_V(6); PG8_BAR;
    } else {
        PG8_STAGE(PG8_SB(0, 0), cB, voffB); PG8_STAGE(PG8_SA(0, 0), cA, voffA); PG8_STAGE(PG8_SB(0, 1), cB + hstep, voffB); PG8_STAGE(PG8_SA(0, 1), cA + hstep, voffA);
        if (wr == 1) PG8_BAR;
        PG8_WAIT_V(4); PG8_BAR;
        PG8_STAGE(PG8_SB(1, 0), cB + kstep, voffB); PG8_STAGE(PG8_SA(1, 0), cA + kstep, voffA); PG8_STAGE(PG8_SB(1, 1), cB + hstep + kstep, voffB);
        PG8_WAIT_V(6); PG8_BAR;
    }
    for (;;) {
        const bool has_next = S.next(ui + 1, nxt);
        const char* nA = has_next ? (const char*)g.A + (size_t)nxt.pm * tstep : cA; const char* nB = has_next ? (const char*)g.Bt + (size_t)nxt.pn * tstep : cB;
        for (int t = 0; t < nt; t += 2) {
            const bool last = (t == nt - 2);
            const char* a1 = cA + (size_t)(t + 1) * kstep;
            const char* a2 = last ? nA : cA + (size_t)(t + 2) * kstep; const char* b2 = last ? nB : cB + (size_t)(t + 2) * kstep;
            const char* a3 = a2 + kstep; const char* b3 = b2 + kstep;
            if (last && has_next) S.a_ready(nxt);
            if constexpr (SP2) {
            PG8_LDB(B0, 0, 0); PG8_LDB(B1, 0, 1); PG8_SCHED; PG8_LDA(At, 0, 0); PG8_STAGE(PG8_SA(1, 1), a1 + hstep, voffA);
            PG8_WAIT_V(8); PG8_WAIT_L(0); PG8_BAR; PG8_MMA(0, 0, At, B0); PG8_MMA(0, 1, At, B1); PG8_BAR; PG8_SCHED;
            PG8_LDA(At, 0, 1); PG8_STAGE(PG8_SB(0, 0), b2, voffB); PG8_STAGE(PG8_SB(0, 1), b2 + hstep, voffB); PG8_STAGE(PG8_SA(0, 0), a2, voffA);
            PG8_WAIT_V(8); PG8_WAIT_L(0); PG8_BAR; PG8_MMA(1, 0, At, B0); PG8_MMA(1, 1, At, B1); PG8_BAR; PG8_SCHED;
            PG8_LDB(B0, 1, 0); PG8_LDB(B1, 1, 1); PG8_SCHED; PG8_LDA(At, 1, 0); PG8_STAGE(PG8_SA(0, 1), a2 + hstep, voffA);
            PG8_WAIT_V(8); PG8_WAIT_L(0); PG8_BAR; PG8_MMA(0, 0, At, B0); PG8_MMA(0, 1, At, B1); PG8_BAR; PG8_SCHED;
            PG8_LDA(At, 1, 1); PG8_STAGE(PG8_SB(1, 0), b3, voffB); PG8_STAGE(PG8_SB(1, 1), b3 + hstep, voffB); PG8_STAGE(PG8_SA(1, 0), a3, voffA);
            PG8_WAIT_V(8); PG8_WAIT_L(0); PG8_BAR; PG8_MMA(1, 0, At, B0); PG8_MMA(1, 1, At, B1); PG8_BAR; PG8_SCHED;
            } else {
            PG8_LDB(B0, 0, 0); PG8_SCHED; PG8_LDA(At, 0, 0); PG8_STAGE(PG8_SA(1, 1), a1 + hstep, voffA);
            PG8_WAIT_L(8); PG8_BAR; PG8_WAIT_L(0); PG8_MMA(0, 0, At, B0); PG8_BAR; PG8_SCHED;
            PG8_LDB(B1, 0, 1); PG8_STAGE(PG8_SB(0, 0), b2, voffB);
            PG8_BAR; PG8_WAIT_L(0); PG8_MMA(0, 1, At, B1); PG8_BAR;
            PG8_LDA(At, 0, 1); PG8_STAGE(PG8_SA(0, 0), a2, voffA);
            PG8_BAR; PG8_WAIT_L(0); PG8_MMA(1, 0, At, B0); PG8_BAR; PG8_SCHED;
            PG8_STAGE(PG8_SB(0, 1), b2 + hstep, voffB);
            PG8_WAIT_V(6); PG8_BAR; PG8_MMA(1, 1, At, B1); PG8_BAR;
            PG8_LDB(B0, 1, 0); PG8_SCHED; PG8_LDA(At, 1, 0); PG8_STAGE(PG8_SA(0, 1), a2 + hstep, voffA);
            PG8_WAIT_L(8); PG8_BAR; PG8_WAIT_L(0); PG8_MMA(0, 0, At, B0); PG8_BAR; PG8_SCHED;
            PG8_LDB(B1, 1, 1); PG8_STAGE(PG8_SB(1, 0), b3, voffB);
            PG8_BAR; PG8_WAIT_L(0); PG8_MMA(0, 1, At, B1); PG8_BAR;
            PG8_LDA(At, 1, 1); PG8_STAGE(PG8_SA(1, 0), a3, voffA);
            PG8_BAR; PG8_WAIT_L(0); PG8_MMA(1, 0, At, B0); PG8_BAR; PG8_SCHED;
            PG8_STAGE(PG8_SB(1, 1), b3 + hstep, voffB);
            PG8_WAIT_V(6); PG8_BAR; PG8_MMA(1, 1, At, B1); PG8_BAR;
            }
        }
        if constexpr (ALIGN_EPI) { if (wr == 0) PG8_BAR; }
        asm volatile("s_nop 15\n\ts_nop 15" ::: "memory");
        if constexpr (!Epi::AFTER_DRAIN) { E(acc, cur, wr, wc, fr, fq); S.done(cur); }
        if (!has_next) break;
#pragma unroll
        for (int a = 0; a < 2; ++a)
#pragma unroll
            for (int b = 0; b < 2; ++b)
#pragma unroll
                for (int m = 0; m < 4; ++m)
#pragma unroll
                    for (int n = 0; n < 2; ++n) acc[a][b][m][n] = (f32x4){0.f, 0.f, 0.f, 0.f};
        cur = nxt; cA = nA; cB = nB; ++ui;
        if constexpr (ALIGN_EPI) { if (wr == 1) PG8_BAR; }
    }
    PG8_WAIT_V(0);
    if constexpr (!ALIGN_EPI) { if (wr == 0) PG8_BAR; }
    PG8_BAR;
    if constexpr (Epi::AFTER_DRAIN) { E.fused(acc, cur, wr, wc, fr, fq, lds, wid, lane); S.done(cur); }
#undef PG8_SA
#undef PG8_SB
#undef PG8_STAGE
#undef PG8_LD8
#undef PG8_LDA
#undef PG8_LDB
#undef PG8_MMA
#undef PG8_WAIT_V
#undef PG8_WAIT_L
#undef PG8_BAR
#undef PG8_SCHED
}
}
#define XB_TMO      128
#define XB_XCNT(j)  (256  + 64 * (j))
#define XB_XSUB(j)  (1280 + 64 * (j))
#define XB_XGEN(j)  (2304 + 64 * (j))
#define XB_TOP      3328
#define XB_TOPGEN   3392
#define XCD_BAR_WORDS 3456
#define XB_SPIN_CAP (1u << 18)
#define LAS __attribute__((address_space(3)))

__device__ __forceinline__ unsigned xb_ld(unsigned* p)              { return __hip_atomic_load(p, __ATOMIC_RELAXED, __HIP_MEMORY_SCOPE_AGENT); }
__device__ __forceinline__ unsigned xb_add(unsigned* p, unsigned v) { return __hip_atomic_fetch_add(p, v, __ATOMIC_RELAXED, __HIP_MEMORY_SCOPE_AGENT); }
__device__ __forceinline__ unsigned xb_xcc_id() { return (unsigned)__builtin_amdgcn_s_getreg((3 << 11) | 20) & 0xFu; }
#define XB_SPIN(cond, bar) do { unsigned _sp = 0; while (cond) { __builtin_amdgcn_s_sleep(1); \
    if ((++_sp & 255u) == 0u) { if (xb_ld(&(bar)[XB_TMO])) break; if (_sp > XB_SPIN_CAP) { atomicAdd(&(bar)[XB_TMO], 1u); break; } } } } while (0)

struct XcdBarrier {
    unsigned* bar; unsigned x;
    volatile LAS unsigned* st;
};

__device__ __forceinline__ XcdBarrier xcd_barrier_post(unsigned* bar, volatile LAS unsigned* st) {
    XcdBarrier b; b.bar = bar; b.x = xb_xcc_id(); b.st = st;
    if (threadIdx.x == 0) (void)xb_add(&bar[XB_XCNT(b.x)], 1u);
    return b;
}
__device__ __forceinline__ void xcd_barrier_complete(unsigned* bar, unsigned x, unsigned& nloc, unsigned& nx) {
    const unsigned G = gridDim.x * gridDim.y * gridDim.z;
    unsigned sum, cnt, mine, sp = 0u;
    for (;;) {
        sum = 0u; cnt = 0u; mine = 0u;
#pragma unroll
        for (unsigned j = 0; j < 16; ++j) { const unsigned c = xb_ld(&bar[XB_XCNT(j)]); sum += c; cnt += (c > 0u) ? 1u : 0u; mine = (j == x) ? c : mine; }
        if (sum == G) break;
        __builtin_amdgcn_s_sleep(1);
        if ((++sp & 255u) == 0u) { if (xb_ld(&bar[XB_TMO])) break; if (sp > XB_SPIN_CAP) { atomicAdd(&bar[XB_TMO], 1u); break; } }
    }
    nloc = mine > 0u ? mine : 1u; nx = cnt > 0u ? cnt : 1u;
}

__device__ __forceinline__ void xcd_barrier(const XcdBarrier& b) {
    asm volatile("s_waitcnt vmcnt(0)" ::: "memory");
    __syncthreads();
    if (threadIdx.x == 0) {
        unsigned* bar = b.bar;
        __builtin_amdgcn_s_waitcnt(0);
        unsigned nloc = b.st[0], nx = b.st[1];
        if (nloc == 0u) { xcd_barrier_complete(bar, b.x, nloc, nx); b.st[0] = nloc; b.st[1] = nx; }
        const unsigned old = xb_add(&bar[XB_XSUB(b.x)], 1u);
        const unsigned gen = old / nloc;
        if (old + 1u == (gen + 1u) * nloc) {
            __builtin_amdgcn_fence(__ATOMIC_RELEASE, "agent");
            asm volatile("s_waitcnt vmcnt(0)" ::: "memory");
            const unsigned og = xb_add(&bar[XB_TOP], 1u);
            const unsigned tg = og / nx;
            if (og + 1u == (tg + 1u) * nx) xb_add(&bar[XB_TOPGEN], 1u);
            else XB_SPIN(xb_ld(&bar[XB_TOPGEN]) == tg, bar);
            __builtin_amdgcn_fence(__ATOMIC_ACQUIRE, "agent");
            xb_add(&bar[XB_XGEN(b.x)], 1u);
            asm volatile("s_waitcnt vmcnt(0)" ::: "memory");
        } else {
            XB_SPIN(xb_ld(&bar[XB_XGEN(b.x)]) == gen, bar);
            __builtin_amdgcn_fence(__ATOMIC_ACQUIRE, "agent");
            asm volatile("s_waitcnt vmcnt(0)" ::: "memory");
        }
    }
    __syncthreads();
}


typedef pg8::bf16_t bf16_t;
typedef pg8::f32x4 f32x4;
typedef pg8::u32x4 u32x4;
typedef unsigned u32x2 __attribute__((ext_vector_type(2)));

constexpr int D = 2048, NB = 2, T = 16384, CL = 256;
constexpr int ML = NB * T;
constexpr int MC = NB * CL;
constexpr int MT = ML + MC;
constexpr int NMIX = 7216, NMIXP = 7424, NGATE = 8192, NPROJ = NMIXP + NGATE;
constexpr int DIN = 15408;
constexpr int FF = 5632, NE = 8;
constexpr int MOE_ROWS = 67584;
constexpr int C_GLA_Q = 0, C_GLA_K = 256, C_GLA_V = 512, C_GLA_G = 1024, C_GLA_A = 1536;
constexpr int C_HG_Q = 1568, C_HG_F = 2080, C_HG_I = 3104, C_HG_G = 3616;
constexpr int C_DN_Q = 4128, C_DN_K = 4640, C_DN_V = 5152, C_DN_A = 5664, C_DN_B = 5672, C_DN_G = 5680;
constexpr int C_RG_X = 6192, C_RG_Y = 6704;
constexpr float EPS = 1e-6f;

enum { I_X = 0, I_C, I_CTX, I_CCTX, I_WMOD, I_BMOD, I_NORMW, I_FNORMW, I_WIN, I_WUP, I_WOUT, I_GLA_WA2, I_GLA_BA2, I_GLA_NW, I_HG_LB, I_HG_NW,
       I_DN_CW, I_DN_ALOG, I_DN_DTB, I_DN_NW, I_RG_CW, I_RG_CB, I_RG_WR, I_RG_BR, I_RG_WI, I_RG_BI, I_RG_LAM, I_F1, I_F3, I_F2, I_ROUTER, I_M1, I_M3, I_M2, N_IN };

constexpr size_t WS_CTL = 0, CTL_BYTES = 65536;
constexpr size_t CTL_BAR = 0, CTL_WGH = 16384, CTL_META = 24576;
constexpr size_t WS_MOD = WS_CTL + CTL_BYTES;
constexpr size_t WS_XC = WS_MOD + 294912;
constexpr size_t WS_TOPI = WS_XC + 4194304;
constexpr size_t WS_TOPW = WS_TOPI + 131072;
constexpr size_t WS_DEST = WS_TOPW + 262144;
constexpr size_t WIN_BYTES = (size_t)NMIXP * D * 2;
constexpr size_t WS_WIN = WS_DEST + 262144;
constexpr size_t WG8_BYTES = (size_t)NGATE * D;
constexpr size_t WS_WG8 = WS_WIN + 2 * WIN_BYTES;
constexpr size_t WS_WUP = WS_WG8 + 2 * WG8_BYTES;
constexpr size_t WS_WOUT = WS_WUP + 2 * 8388608;
constexpr size_t WS_F13 = WS_WOUT + 2 * 8388608;
constexpr size_t WS_F2 = WS_F13 + 46137344;
constexpr size_t WS_RGW = WS_F2 + 23068672;
constexpr size_t WS_H = WS_RGW + 1048576;
constexpr size_t WS_H8 = WS_H + 136314880;
constexpr size_t WS_BIG = WS_H8 + 68157440;
constexpr size_t WS_PMIX = WS_BIG;
constexpr size_t WS_ORAW = WS_PMIX + 494141440;
constexpr size_t WS_RGLA = WS_ORAW + 272629760;
constexpr size_t WS_RGU = WS_RGLA + 68157440;
constexpr size_t WS_RGTT = WS_RGU, WS_RGCARRY = WS_RGU + 4259840;
constexpr size_t WS_O = WS_RGU + 8388608;
constexpr size_t WS_SCR = WS_O + 136314880;
constexpr size_t SC_GLA_VT = 0, SC_GLA_QP = SC_GLA_VT + 34078720, SC_GLA_KT = SC_GLA_QP + 34078720, SC_GLA_A = SC_GLA_KT + 34078720, SC_GLA_LAM = SC_GLA_A + 34078720;
constexpr size_t SC_HG_VT = SC_GLA_LAM + 1064960, SC_HG_QP = SC_HG_VT + 34078720, SC_HG_KT = SC_HG_QP + 68157440, SC_HG_A = SC_HG_KT + 68157440, SC_HG_LAM = SC_HG_A + 34078720;
constexpr size_t SC_DN_QS = SC_HG_LAM + 2129920, SC_DN_KT = SC_DN_QS + 34078720, SC_DN_UT = SC_DN_KT + 34078720, SC_DN_WN = SC_DN_UT + 68157440, SC_DN_AQK = SC_DN_WN + 68157440, SC_DN_SC = SC_DN_AQK + 34078720;
constexpr size_t SC_END = SC_DN_SC + 4259840;
constexpr size_t WS_PGATE = WS_SCR;
constexpr size_t WS_MACC = WS_PMIX;
constexpr size_t WS_MERGED = WS_PMIX + 272629760;
constexpr size_t WS_HID = WS_BIG;
constexpr size_t WS_M13 = WS_BIG;
constexpr size_t WS_M2 = WS_M13 + 369098752;
constexpr size_t WS_GATH = WS_M2 + 184549376;
constexpr size_t WS_HIDM = WS_GATH + 276824064;
constexpr size_t WS_END_A = WS_HIDM + 761266176, WS_END_B = WS_SCR + (SC_END > 545259520 ? SC_END : 545259520);
constexpr size_t WS_END = WS_END_A > WS_END_B ? WS_END_A : WS_END_B;
static_assert(WS_MERGED + 136314880 <= WS_PMIX + 494141440, "merged fits in pmix region");
static_assert(WS_END <= 2041000000ull, "workspace budget");

constexpr int LDS_SCR = 0;
constexpr int LDS_AUX = 131072;
constexpr int LDS_MISC = 131072 + 8192;
constexpr int LDS_BYTES = 147456;

struct Args { const float* in[N_IN]; float* out; unsigned char* ws; int ph_lo, ph_hi; };

__device__ __forceinline__ float bflo(unsigned w) { return __uint_as_float(w << 16); }
__device__ __forceinline__ float bfhi(unsigned w) { return __uint_as_float(w & 0xffff0000u); }
__device__ __forceinline__ void unpack8(const u32x4 w, float (&f)[8]) { f[0] = bflo(w.x); f[1] = bfhi(w.x); f[2] = bflo(w.y); f[3] = bfhi(w.y); f[4] = bflo(w.z); f[5] = bfhi(w.z); f[6] = bflo(w.w); f[7] = bfhi(w.w); }
typedef __bf16 bfx8_t __attribute__((ext_vector_type(8)));
typedef float f32x8 __attribute__((ext_vector_type(8)));
__device__ __forceinline__ u32x4 pack8(const float (&f)[8]) { f32x8 v;
#pragma unroll
    for (int j = 0; j < 8; ++j) v[j] = f[j];
    return __builtin_bit_cast(u32x4, __builtin_convertvector(v, bfx8_t)); }
__device__ __forceinline__ unsigned pk_fp8x4(float a, float b, float c, float d) {
    a = fminf(fmaxf(a, -448.f), 448.f); b = fminf(fmaxf(b, -448.f), 448.f); c = fminf(fmaxf(c, -448.f), 448.f); d = fminf(fmaxf(d, -448.f), 448.f);
    unsigned p = __builtin_amdgcn_cvt_pk_fp8_f32(a, b, 0, false); return __builtin_amdgcn_cvt_pk_fp8_f32(c, d, p, true); }
__device__ __forceinline__ float bf1(const bf16_t* p) { return __uint_as_float(((unsigned)*p) << 16); }
__device__ __forceinline__ float sigm(float x) { return __builtin_amdgcn_rcpf(1.0f + __expf(-x)); }
__device__ __forceinline__ float siluf(float x) { return x * __builtin_amdgcn_rcpf(1.0f + __expf(-x)); }
__device__ __forceinline__ float softplusf(float x) { return fmaxf(x, 0.f) + __logf(1.0f + __expf(-fabsf(x))); }
__device__ __forceinline__ float wave_sum(float v) { v += __shfl_xor(v, 32); v += __shfl_xor(v, 16); v += __shfl_xor(v, 8); v += __shfl_xor(v, 4); v += __shfl_xor(v, 2); v += __shfl_xor(v, 1); return v; }
__device__ __forceinline__ float gelu_tanh(float y) { const float u = 0.7978845608028654f * (y + 0.044715f * y * y * y); const float e = __expf(2.f * u); const float th = 1.f - 2.f * __builtin_amdgcn_rcpf(e + 1.f); return 0.5f * y * (1.f + th); }

namespace pg8 {
template <bool SIG> struct EpiBf16S {
    static constexpr bool PERM = true, AFTER_DRAIN = false;
    bf16_t* O; int ldc; float sc;
    __device__ __forceinline__ void operator()(const f32x4 (&acc)[2][2][4][2], const Unit& u, int wr, int wc, int fr, int fq) const {
        const int row0 = u.pm * BM + wr * 64 + fr, col0 = u.pn * BM + wc * 32 + 8 * fq;
#pragma unroll
        for (int ai = 0; ai < 2; ++ai)
#pragma unroll
            for (int m = 0; m < 4; ++m) { bf16_t* rowp = O + (size_t)(row0 + ai * HALF + m * 16) * ldc + col0;
#pragma unroll
                for (int bj = 0; bj < 2; ++bj) { f32x4 v0 = acc[ai][bj][m][0], v1 = acc[ai][bj][m][1];
                    if (SIG) {
#pragma unroll
                        for (int j = 0; j < 4; ++j) { v0[j] = sigm(v0[j] * sc); v1[j] = sigm(v1[j] * sc); } }
                    u32x4 w; w.x = cvt_pk_bf16_safe(v0[0], v0[1]); w.y = cvt_pk_bf16_safe(v0[2], v0[3]); w.z = cvt_pk_bf16_safe(v1[0], v1[1]); w.w = cvt_pk_bf16_safe(v1[2], v1[3]);
                    *(u32x4*)(rowp + bj * HALF) = w; } }
    }
};
struct EpiUpGate {
    static constexpr bool PERM = true, AFTER_DRAIN = false;
    const bf16_t* gate; float* macc; bf16_t* merged; int nMtot;
    __device__ __forceinline__ void operator()(const f32x4 (&acc)[2][2][4][2], const Unit& u, int wr, int wc, int fr, int fq) const {
        const int b = u.pn >> 3, pn = u.pn & 7, pm = u.pm - b * nMtot;
        const int row0 = pm * BM + wr * 64 + fr, col0 = pn * BM + wc * 32 + 8 * fq;
#pragma unroll
        for (int ai = 0; ai < 2; ++ai)
#pragma unroll
            for (int m = 0; m < 4; ++m) { const size_t r = (size_t)(row0 + ai * HALF + m * 16);
#pragma unroll
                for (int bj = 0; bj < 2; ++bj) { const int c = col0 + bj * HALF;
                    const u32x4 gw = *(const u32x4*)(gate + r * NGATE + b * 2048 + c); float g[8]; unpack8(gw, g);
                    f32x4 v0 = acc[ai][bj][m][0], v1 = acc[ai][bj][m][1];
#pragma unroll
                    for (int j = 0; j < 4; ++j) { v0[j] *= g[j]; v1[j] *= g[4 + j]; }
                    float* mp = macc + r * 2048 + c;
                    if (b > 0) { v0 += *(const f32x4*)mp; v1 += *(const f32x4*)(mp + 4); }
                    if (b < 3) { *(f32x4*)mp = v0; *(f32x4*)(mp + 4) = v1; }
                    else { u32x4 w; w.x = cvt_pk_bf16_safe(v0[0], v0[1]); w.y = cvt_pk_bf16_safe(v0[2], v0[3]); w.z = cvt_pk_bf16_safe(v1[0], v1[1]); w.w = cvt_pk_bf16_safe(v1[2], v1[3]);
                           *(u32x4*)(merged + r * 2048 + c) = w; } } }
    }
};
struct EpiResid {
    static constexpr bool PERM = false, AFTER_DRAIN = false;
    const float* srcl; float* dstl; const float* srcc; float* dstc; const float* modv;
    int permute;
    __device__ __forceinline__ void operator()(const f32x4 (&acc)[2][2][4][2], const Unit& u, int wr, int wc, int fr, int fq) const {
        const int row0 = u.pm * BM + wr * 64 + fr, col0 = u.pn * BM + wc * 32 + 4 * fq;
#pragma unroll
        for (int ai = 0; ai < 2; ++ai)
#pragma unroll
            for (int m = 0; m < 4; ++m) { const int r = row0 + ai * HALF + m * 16;
                const float* sp; float* dp; const float* mp;
                if (r < ML) { const int b = r >> 14, s = r & 16383; const int t = permute ? (((s & 255) << 6) | (s >> 8)) : s; const size_t o = ((size_t)(b << 14) + t) * D;
                    sp = srcl + o; dp = dstl + o; mp = modv + b * 12288; }
                else { const size_t o = (size_t)(r - ML) * D; sp = srcc + o; dp = dstc + o; mp = modv + 2 * 12288; }
#pragma unroll
                for (int bj = 0; bj < 2; ++bj)
#pragma unroll
                    for (int n = 0; n < 2; ++n) { const int c = col0 + bj * HALF + n * 16;
                        const f32x4 sv = *(const f32x4*)(sp + c), mv = *(const f32x4*)(mp + c);
                        *(f32x4*)(dp + c) = sv + mv * acc[ai][bj][m][n]; } }
    }
};
struct EpiSwiglu {
    static constexpr bool PERM = true, AFTER_DRAIN = false;
    bf16_t* hid; int nper;
    __device__ __forceinline__ void operator()(const f32x4 (&acc)[2][2][4][2], const Unit& u, int wr, int wc, int fr, int fq) const {
        const int pn = u.pn % nper; const int row0 = u.pm * BM + wr * 64 + fr, col0 = pn * HALF + wc * 32 + 8 * fq;
#pragma unroll
        for (int ai = 0; ai < 2; ++ai)
#pragma unroll
            for (int m = 0; m < 4; ++m) { bf16_t* rowp = hid + (size_t)(row0 + ai * HALF + m * 16) * FF + col0;
                float o[8];
#pragma unroll
                for (int n = 0; n < 2; ++n)
#pragma unroll
                    for (int j = 0; j < 4; ++j) { const float g = acc[ai][0][m][n][j], v = acc[ai][1][m][n][j]; o[n * 4 + j] = siluf(g) * v; }
                u32x4 w; w.x = cvt_pk_bf16_safe(o[0], o[1]); w.y = cvt_pk_bf16_safe(o[2], o[3]); w.z = cvt_pk_bf16_safe(o[4], o[5]); w.w = cvt_pk_bf16_safe(o[6], o[7]);
                *(u32x4*)rowp = w; }
    }
};
struct EpiPlainBf16 {
    static constexpr bool PERM = true, AFTER_DRAIN = false;
    bf16_t* O; int ldc; int nper;
    __device__ __forceinline__ void operator()(const f32x4 (&acc)[2][2][4][2], const Unit& u, int wr, int wc, int fr, int fq) const {
        const int pn = u.pn % nper; const int row0 = u.pm * BM + wr * 64 + fr, col0 = pn * BM + wc * 32 + 8 * fq;
#pragma unroll
        for (int ai = 0; ai < 2; ++ai)
#pragma unroll
            for (int m = 0; m < 4; ++m) { bf16_t* rowp = O + (size_t)(row0 + ai * HALF + m * 16) * ldc + col0;
#pragma unroll
                for (int bj = 0; bj < 2; ++bj) { const f32x4 v0 = acc[ai][bj][m][0], v1 = acc[ai][bj][m][1];
                    u32x4 w; w.x = cvt_pk_bf16_safe(v0[0], v0[1]); w.y = cvt_pk_bf16_safe(v0[2], v0[3]); w.z = cvt_pk_bf16_safe(v1[0], v1[1]); w.w = cvt_pk_bf16_safe(v1[2], v1[3]);
                    *(u32x4*)(rowp + bj * HALF) = w; } }
    }
};
struct UpGateOrder {
    StaticOrder so; int nMtot;
    __device__ void init(int M, int G, int c, int nMtot_) { so.init(M, 2048, G, c); nMtot = nMtot_; }
    __device__ bool next(int i, Unit& u) const { Unit t; if (!so.next(i >> 2, t)) return false; const int b = i & 3; u.pm = b * nMtot + t.pm; u.pn = b * 8 + t.pn; return true; }
    __device__ __forceinline__ void a_ready(const Unit&) const {}
    __device__ __forceinline__ void done(const Unit&) const {}
};
struct MoeOrder {
    StaticOrder so; int be[8]; int nper;
    __device__ void init(int nused, int nper_, int G, int c, const int* be_) { so.init(nused * BM, nper_ * BM, G, c); nper = nper_;
#pragma unroll
        for (int e = 0; e < 8; ++e) be[e] = be_[e]; }
    __device__ bool next(int i, Unit& u) const { Unit t; if (!so.next(i, t)) return false; int e = 0;
#pragma unroll
        for (int j = 0; j < 7; ++j) e += (t.pm >= be[j]) ? 1 : 0;
        u.pm = t.pm; u.pn = e * nper + t.pn; return true; }
    __device__ __forceinline__ void a_ready(const Unit&) const {}
    __device__ __forceinline__ void done(const Unit&) const {}
};
}

__device__ __forceinline__ int lds_add(volatile LAS int* p) { return __hip_atomic_fetch_add((LAS int*)p, 1, __ATOMIC_RELAXED, __HIP_MEMORY_SCOPE_WORKGROUP); }
typedef const __attribute__((address_space(4))) Args* ArgsP;
#define ARGS_REF const __attribute__((address_space(4))) Args&
struct Ctx { ArgsP a; LAS unsigned char* lds; int tid, lane, wave, wg, G; };

__device__ __forceinline__ void conv_tile(const float* src, size_t ldsrc, int nvalid, bf16_t* dst, size_t ldd, LAS float* tile, int tid) {
    const int nn = tid & 63, kk = tid >> 6;
    float v[16];
#pragma unroll
    for (int j = 0; j < 16; ++j) v[j] = (nn < nvalid) ? src[(size_t)(kk + 8 * j) * ldsrc + nn] : 0.f;
#pragma unroll
    for (int j = 0; j < 16; ++j) tile[nn * 129 + kk + 8 * j] = v[j];
    __syncthreads();
    const int lane = tid & 63, w = tid >> 6;
#pragma unroll
    for (int p = 0; p < 8; ++p) { const int n = w + 8 * p; const float a = tile[n * 129 + 2 * lane], b = tile[n * 129 + 2 * lane + 1];
        *(unsigned*)(dst + (size_t)n * ldd + 2 * lane) = pg8::cvt_pk_bf16_safe(a, b); }
    __syncthreads();
}
template <int KIND>
__device__ __forceinline__ void conv_job(const Ctx& c, const float* src, const float* src2, size_t ldsrc, int K, int Nd, bf16_t* dst, int& rot) {
    LAS float* tile = (LAS float*)(c.lds + LDS_SCR);
    const int nkt = K / 128, nnt = Nd / 64, ntile = nkt * nnt;
    int t0 = (c.wg - rot) % c.G; if (t0 < 0) t0 += c.G;
    for (int t = t0; t < ntile; t += c.G) {
        const int nt = t % nnt, kt = t / nnt, n0 = nt * 64, k0 = kt * 128;
        const float* s = src; int c0 = n0, nvalid = 64;
        if (KIND == 1) { if (n0 >= NMIXP) c0 = n0 - (NMIXP - NMIX); else { nvalid = NMIX - n0; nvalid = nvalid < 0 ? 0 : (nvalid > 64 ? 64 : nvalid); } }
        if (KIND == 2) { const int which = (n0 & 255) >> 7; c0 = (n0 >> 8) * 128 + (n0 & 127); s = which ? src2 : src; }
        conv_tile(s + (size_t)k0 * ldsrc + c0, ldsrc, nvalid, dst + (size_t)n0 * K + k0, (size_t)K, tile, c.tid);
    }
    rot = (rot + ntile) % c.G;
}

__device__ __forceinline__ void conv_tile8(const float* src, size_t ldsrc, unsigned char* dst, size_t ldd, float wscale, LAS float* tile, int tid) {
    const int nn = tid & 63, kk = tid >> 6;
#pragma unroll 8
    for (int j = 0; j < 32; ++j) tile[nn * 257 + kk + 8 * j] = src[(size_t)(kk + 8 * j) * ldsrc + nn] * wscale;
    __syncthreads();
    const int lane = tid & 63, w = tid >> 6;
#pragma unroll
    for (int p = 0; p < 8; ++p) { const int n = w + 8 * p; const LAS float* t = tile + n * 257 + 4 * lane;
        *(unsigned*)(dst + (size_t)n * ldd + 4 * lane) = pk_fp8x4(t[0], t[1], t[2], t[3]); }
    __syncthreads();
}
__device__ __forceinline__ void conv_job8(const Ctx& c, const float* src, size_t ldsrc, int K, int Nd, unsigned char* dst, float wscale, int& rot) {
    LAS float* tile = (LAS float*)(c.lds + LDS_SCR);
    const int nkt = K / 256, nnt = Nd / 64, ntile = nkt * nnt;
    int t0 = (c.wg - rot) % c.G; if (t0 < 0) t0 += c.G;
    for (int t = t0; t < ntile; t += c.G) { const int nt = t % nnt, kt = t / nnt, n0 = nt * 64, k0 = kt * 256;
        conv_tile8(src + (size_t)k0 * ldsrc + n0, ldsrc, dst + (size_t)n0 * K + k0, (size_t)K, wscale, tile, c.tid); }
    rot = (rot + ntile) % c.G;
}

__device__ __forceinline__ void mod_phase(const Ctx& c) {
    ARGS_REF a = *c.a; const int tid = c.tid;
    LAS float* s = (LAS float*)(c.lds + LDS_SCR);
    LAS float* red = s + 3 * 2048;
    for (int i = tid; i < 3 * 2048; i += 512) { const int r = i >> 11, k = i & 2047; const float cv = (r < 2) ? a.in[I_C][r * 2048 + k] : a.in[I_CCTX][k]; s[i] = siluf(cv); }
    __syncthreads();
    float* modv = (float*)(a.ws + WS_MOD);
    for (int task = c.wg; task < 192; task += c.G) {
        const int l = task / 96, cb = task % 96, cq = tid & 31, kg = tid >> 5;
        const float* w = a.in[I_WMOD] + (size_t)l * 2048 * 12288 + cb * 128 + cq * 4;
        f32x4 a0 = {0.f, 0.f, 0.f, 0.f}, a1 = a0, a2 = a0;
#pragma unroll 8
        for (int k = kg; k < 2048; k += 16) { const f32x4 wv = *(const f32x4*)(w + (size_t)k * 12288); a0 += s[k] * wv; a1 += s[2048 + k] * wv; a2 += s[4096 + k] * wv; }
#pragma unroll
        for (int j = 0; j < 4; ++j) { red[(kg * 3 + 0) * 128 + cq * 4 + j] = a0[j]; red[(kg * 3 + 1) * 128 + cq * 4 + j] = a1[j]; red[(kg * 3 + 2) * 128 + cq * 4 + j] = a2[j]; }
        __syncthreads();
        if (tid < 384) { const int r = tid >> 7, cc = tid & 127; float sum = 0.f;
#pragma unroll
            for (int g = 0; g < 16; ++g) sum += red[(g * 3 + r) * 128 + cc];
            modv[(size_t)(l * 3 + r) * 12288 + cb * 128 + cc] = sum + a.in[I_BMOD][l * 12288 + cb * 128 + cc]; }
        __syncthreads();
    }
}

__device__ __forceinline__ void modnorm_row(f32x4 (&v)[8], const float* nw, const float* shift, const float* scale, int lane) {
    float ss = 0.f;
#pragma unroll
    for (int j = 0; j < 8; ++j) ss += v[j][0] * v[j][0] + v[j][1] * v[j][1] + v[j][2] * v[j][2] + v[j][3] * v[j][3];
    ss = wave_sum(ss);
    const float rstd = __builtin_amdgcn_rsqf(ss * (1.0f / 2048.0f) + EPS);
#pragma unroll
    for (int j = 0; j < 8; ++j) { const int cc = (j * 64 + lane) * 4; const f32x4 w = *(const f32x4*)(nw + cc), sh = *(const f32x4*)(shift + cc), sc = *(const f32x4*)(scale + cc);
        v[j] = (v[j] * rstd * w) * (1.0f + sc) + sh; }
}
__device__ __forceinline__ void store_row_bf16(const f32x4 (&v)[8], bf16_t* hrow, int lane) {
#pragma unroll
    for (int j = 0; j < 8; ++j) { u32x2 w; w.x = pg8::cvt_pk_bf16_safe(v[j][0], v[j][1]); w.y = pg8::cvt_pk_bf16_safe(v[j][2], v[j][3]); *(u32x2*)(hrow + (j * 64 + lane) * 4) = w; }
}
template <int L, int WHICH>
__device__ __forceinline__ void norm_phase(const Ctx& c) {
    ARGS_REF a = *c.a; const int gw = c.wg * 8 + c.wave, nw = c.G * 8, lane = c.lane;
    const float* modv = (const float*)(a.ws + WS_MOD) + (size_t)L * 3 * 12288 + (WHICH ? 3 : 0) * 2048;
    const float* normw = a.in[I_NORMW] + (L * 2 + WHICH) * 2048;
    const float* xc = (const float*)(a.ws + WS_XC);
    bf16_t* H = (bf16_t*)(a.ws + WS_H);
    for (int r = gw; r < MT; r += nw) {
        const float* src; int mr; size_t hrow;
        if (r < ML) { const int b = r >> 14, t = r & 16383; src = ((L == 0 && WHICH == 0) ? a.in[I_X] : (const float*)a.out) + (size_t)r * D; mr = b;
            hrow = (L == 1 && WHICH == 0) ? (size_t)(b << 14) + ((t & 63) << 8) + (t >> 6) : (size_t)r; }
        else { const int rc = r - ML; src = ((L == 0 && WHICH == 0) ? a.in[I_CTX] : xc) + (size_t)rc * D; mr = 2; hrow = r; }
        f32x4 v[8];
#pragma unroll
        for (int j = 0; j < 8; ++j) v[j] = *(const f32x4*)(src + (j * 64 + lane) * 4);
        const float* shift = modv + (size_t)mr * 12288;
        modnorm_row(v, normw, shift, shift + 2048, lane);
        store_row_bf16(v, H + hrow * D, lane);
        if (WHICH == 0) { unsigned char* h8 = (unsigned char*)(a.ws + WS_H8) + hrow * D;
#pragma unroll
            for (int j = 0; j < 8; ++j) *(unsigned*)(h8 + (j * 64 + lane) * 4) = pk_fp8x4(v[j][0] * 4.f, v[j][1] * 4.f, v[j][2] * 4.f, v[j][3] * 4.f); }
    }
}

template <int L>
__device__ __forceinline__ void rgprep_item(const Ctx& c, int item) {
    ARGS_REF a = *c.a; const int tid = c.tid;
    LAS float* xbT = (LAS float*)(c.lds + LDS_SCR);
    const bf16_t* PM = (const bf16_t*)(a.ws + WS_PMIX);
    bf16_t* RGLA = (bf16_t*)(a.ws + WS_RGLA); bf16_t* RGU = (bf16_t*)(a.ws + WS_RGU);
    const float* cw = a.in[I_RG_CW] + L * 4 * 512; const float* cb = a.in[I_RG_CB] + L * 512;
    {
        const int tt = item >> 2, n = item & 3;
        size_t rowbase; int t0, Ls;
        if (tt < 512) { const int b = tt >> 8; rowbase = (size_t)b * T; t0 = (tt & 255) * 64; Ls = T; }
        else { const int tc = tt - 512, b = tc >> 2; rowbase = (size_t)ML + b * CL; t0 = (tc & 3) * 64; Ls = CL; }
        __syncthreads();
        {
            const int tl = tid >> 3, cg = tid & 7, ch0 = n * 128 + cg * 16;
            float acc[16];
#pragma unroll
            for (int j = 0; j < 16; ++j) acc[j] = cb[ch0 + j];
#pragma unroll
            for (int tap = 0; tap < 4; ++tap) { const int ts = t0 + tl + tap - 2;
                if (ts >= 0 && ts < Ls) { const bf16_t* rp = PM + (rowbase + ts) * NMIXP + C_RG_X + ch0; const u32x4 w0 = *(const u32x4*)rp, w1 = *(const u32x4*)(rp + 8);
                    float f[8], g[8]; unpack8(w0, f); unpack8(w1, g);
#pragma unroll
                    for (int j = 0; j < 8; ++j) { acc[j] += cw[tap * 512 + ch0 + j] * f[j]; acc[8 + j] += cw[tap * 512 + ch0 + 8 + j] * g[j]; } } }
#pragma unroll
            for (int j = 0; j < 16; ++j) xbT[(cg * 16 + j) * 68 + tl] = acc[j];
        }
        __syncthreads();
        const int oc = tid & 127, tg = tid >> 7, ch = n * 128 + oc;
#pragma unroll 1
        for (int d = 0; d < 2; ++d) {
            const float* wr = a.in[I_RG_WR] + ((size_t)((L * 2 + d) * 4 + n) * 128) * 128 + oc;
            const float* wi = a.in[I_RG_WI] + ((size_t)((L * 2 + d) * 4 + n) * 128) * 128 + oc;
            float ar[16], ai[16];
#pragma unroll
            for (int j = 0; j < 16; ++j) { ar[j] = 0.f; ai[j] = 0.f; }
#pragma unroll 4
            for (int k = 0; k < 128; ++k) { const float w1 = wr[k * 128], w2 = wi[k * 128];
                const LAS f32x4* xp = (const LAS f32x4*)(xbT + k * 68 + tg * 16);
#pragma unroll
                for (int q = 0; q < 4; ++q) { const f32x4 xv = xp[q];
#pragma unroll
                    for (int j = 0; j < 4; ++j) { ar[q * 4 + j] += xv[j] * w1; ai[q * 4 + j] += xv[j] * w2; } } }
            const float br = a.in[I_RG_BR][(L * 2 + d) * 512 + ch], bi = a.in[I_RG_BI][(L * 2 + d) * 512 + ch];
            const float sp = softplusf(-a.in[I_RG_LAM][(L * 2 + d) * 512 + ch]);
#pragma unroll
            for (int j = 0; j < 16; ++j) { const int tl = tg * 16 + j; const float r = sigm(ar[j] + br), ig = sigm(ai[j] + bi);
                const float la = -8.0f * r * sp; const float xb = xbT[oc * 68 + tl];
                const float u = sqrtf(fmaxf(-expm1f(2.0f * la), 0.f)) * (ig * xb);
                const size_t o = ((size_t)d * MT + rowbase + t0 + tl) * 512 + ch;
                RGLA[o] = (bf16_t)(pg8::cvt_pk_bf16_safe(la, 0.f) & 0xffffu); RGU[o] = (bf16_t)(pg8::cvt_pk_bf16_safe(u, 0.f) & 0xffffu); }
        }
    }
}

template <int L>
__device__ __forceinline__ void chain_gla(const Ctx& c, int b, int h, int d, int vh) {
    ARGS_REF a = *c.a; const int tid = c.tid;
    LAS float* qs = (LAS float*)(c.lds + LDS_SCR); LAS float* ks = qs + 4096; LAS float* fs = ks + 4096; LAS float* vs = fs + 4096; LAS float* os = vs + 4096;
    LAS float* wa = (LAS float*)(c.lds + LDS_AUX);
    const bf16_t* PM = (const bf16_t*)(a.ws + WS_PMIX);
    bf16_t* ORAW = (bf16_t*)(a.ws + WS_ORAW) + (size_t)d * MT * 2048;
    for (int i = tid; i < 1024; i += 512) wa[i] = a.in[I_GLA_WA2][((L * 2 + d) * 16 + (i >> 6)) * 256 + h * 64 + (i & 63)];
    if (tid < 64) wa[1024 + tid] = a.in[I_GLA_BA2][(L * 2 + d) * 256 + h * 64 + tid];
    float s[8];
#pragma unroll
    for (int j = 0; j < 8; ++j) s[j] = 0.f;
    const int vc = tid >> 3, kq = tid & 7;
#pragma unroll 1
    for (int seg = 0; seg < 2; ++seg) {
        const int Ls = seg ? T : CL; const size_t rowbase = seg ? (size_t)b * T : (size_t)ML + b * CL;
#pragma unroll 1
        for (int jb = 0; jb < Ls / 64; ++jb) {
            const int r0 = d ? Ls - 64 * (jb + 1) : 64 * jb;
            __syncthreads();
            {   const int i = tid >> 3, cg = tid & 7, lr = d ? 63 - i : i; const bf16_t* rp = PM + (rowbase + r0 + lr) * NMIXP;
                float fq[8], fk[8], fv[8], fa[16];
                { const u32x4 w = *(const u32x4*)(rp + C_GLA_Q + h * 64 + cg * 8); unpack8(w, fq); }
                { const u32x4 w = *(const u32x4*)(rp + C_GLA_K + h * 64 + cg * 8); unpack8(w, fk); }
                { const u32x4 w = *(const u32x4*)(rp + C_GLA_V + h * 128 + vh * 64 + cg * 8); unpack8(w, fv); }
                { const u32x4 w0 = *(const u32x4*)(rp + C_GLA_A + d * 16), w1 = *(const u32x4*)(rp + C_GLA_A + d * 16 + 8); float t0[8], t1[8]; unpack8(w0, t0); unpack8(w1, t1);
#pragma unroll
                  for (int j = 0; j < 8; ++j) { fa[j] = t0[j]; fa[8 + j] = t1[j]; } }
#pragma unroll
                for (int j = 0; j < 8; ++j) { const int o = i * 64 + cg * 8 + j; qs[o] = fq[j] * 0.125f; ks[o] = fk[j]; vs[o] = fv[j];
                    float z = wa[1024 + cg * 8 + j];
#pragma unroll
                    for (int r = 0; r < 16; ++r) z += fa[r] * wa[r * 64 + cg * 8 + j];
                    fs[o] = __expf(-softplusf(-z) * (1.0f / 16.0f)); }
            }
            __syncthreads();
#pragma unroll 2
            for (int i = 0; i < 64; ++i) {
                const f32x4 f0 = *(const LAS f32x4*)(fs + i * 64 + kq * 8), f1 = *(const LAS f32x4*)(fs + i * 64 + kq * 8 + 4);
                const f32x4 k0 = *(const LAS f32x4*)(ks + i * 64 + kq * 8), k1 = *(const LAS f32x4*)(ks + i * 64 + kq * 8 + 4);
                const f32x4 q0 = *(const LAS f32x4*)(qs + i * 64 + kq * 8), q1 = *(const LAS f32x4*)(qs + i * 64 + kq * 8 + 4);
                const float vv = vs[i * 64 + vc]; float po = 0.f;
#pragma unroll
                for (int j = 0; j < 4; ++j) { s[j] = f0[j] * s[j] + k0[j] * vv; s[4 + j] = f1[j] * s[4 + j] + k1[j] * vv; po += s[j] * q0[j] + s[4 + j] * q1[j]; }
                po += __shfl_xor(po, 1); po += __shfl_xor(po, 2); po += __shfl_xor(po, 4);
                if (kq == 0) os[i * 64 + vc] = po;
            }
            __syncthreads();
            {   const int i = tid >> 3, cg = tid & 7, lr = d ? 63 - i : i; float o[8];
#pragma unroll
                for (int j = 0; j < 8; ++j) o[j] = os[i * 64 + cg * 8 + j];
                *(u32x4*)(ORAW + (rowbase + r0 + lr) * 2048 + 0 * 512 + h * 128 + vh * 64 + cg * 8) = pack8(o); }
        }
    }
}
template <int L>
__device__ __forceinline__ void chain_hg(const Ctx& c, int b, int h, int d, int vh) {
    ARGS_REF a = *c.a; const int tid = c.tid;
    LAS float* qs = (LAS float*)(c.lds + LDS_SCR); LAS float* ks = qs + 8192; LAS float* fs = ks + 8192; LAS float* vs = fs + 8192; LAS float* os = vs + 4096;
    LAS float* lbs = (LAS float*)(c.lds + LDS_AUX);
    const bf16_t* PM = (const bf16_t*)(a.ws + WS_PMIX);
    bf16_t* ORAW = (bf16_t*)(a.ws + WS_ORAW) + (size_t)d * MT * 2048;
    if (tid < 128) { float lb = 0.f; if (L == 1) { const float l0 = a.in[I_HG_LB][h * 128 + tid], l1 = a.in[I_HG_LB][512 + h * 128 + tid]; lb = __builtin_amdgcn_rcpf(1.0f + __expf(l0 - l1)); } lbs[tid] = lb; }
    float s[16];
#pragma unroll
    for (int j = 0; j < 16; ++j) s[j] = 0.f;
    const int vc = tid >> 3, kq = tid & 7;
#pragma unroll 1
    for (int seg = 0; seg < 2; ++seg) {
        const int Ls = seg ? T : CL; const size_t rowbase = seg ? (size_t)b * T : (size_t)ML + b * CL;
#pragma unroll 1
        for (int jb = 0; jb < Ls / 64; ++jb) {
            const int r0 = d ? Ls - 64 * (jb + 1) : 64 * jb;
            __syncthreads();
            {   const int i = tid >> 3, cg = tid & 7, lr = d ? 63 - i : i; const bf16_t* rp = PM + (rowbase + r0 + lr) * NMIXP;
#pragma unroll
                for (int hf = 0; hf < 2; ++hf) { const int ch = cg * 16 + hf * 8; float fq[8], fz[8];
                    { const u32x4 w = *(const u32x4*)(rp + C_HG_Q + h * 128 + ch); unpack8(w, fq); }
                    { const u32x4 w = *(const u32x4*)(rp + C_HG_F + d * 512 + h * 128 + ch); unpack8(w, fz); }
#pragma unroll
                    for (int j = 0; j < 8; ++j) { const int o = i * 128 + ch + j; const float lb = lbs[ch + j], sg = sigm(fz[j]);
                        qs[o] = siluf(fq[j]) * 0.08838834764831845f; fs[o] = fmaxf(lb + (1.0f - lb) * sg, 1e-30f); ks[o] = (1.0f - lb) * (1.0f - sg); } }
                float fv[8]; { const u32x4 w = *(const u32x4*)(rp + C_HG_I + h * 128 + vh * 64 + cg * 8); unpack8(w, fv); }
#pragma unroll
                for (int j = 0; j < 8; ++j) vs[i * 64 + cg * 8 + j] = fv[j];
            }
            __syncthreads();
#pragma unroll 2
            for (int i = 0; i < 64; ++i) {
                const float vv = vs[i * 64 + vc]; float po = 0.f;
#pragma unroll
                for (int q4 = 0; q4 < 4; ++q4) {
                    const f32x4 f0 = *(const LAS f32x4*)(fs + i * 128 + kq * 16 + q4 * 4), k0 = *(const LAS f32x4*)(ks + i * 128 + kq * 16 + q4 * 4), q0 = *(const LAS f32x4*)(qs + i * 128 + kq * 16 + q4 * 4);
#pragma unroll
                    for (int j = 0; j < 4; ++j) { s[q4 * 4 + j] = f0[j] * s[q4 * 4 + j] + k0[j] * vv; po += s[q4 * 4 + j] * q0[j]; } }
                po += __shfl_xor(po, 1); po += __shfl_xor(po, 2); po += __shfl_xor(po, 4);
                if (kq == 0) os[i * 64 + vc] = po;
            }
            __syncthreads();
            {   const int i = tid >> 3, cg = tid & 7, lr = d ? 63 - i : i; float o[8];
#pragma unroll
                for (int j = 0; j < 8; ++j) o[j] = os[i * 64 + cg * 8 + j];
                *(u32x4*)(ORAW + (rowbase + r0 + lr) * 2048 + 1 * 512 + h * 128 + vh * 64 + cg * 8) = pack8(o); }
        }
    }
}
template <int L>
__device__ __forceinline__ void chain_dn(const Ctx& c, int b, int h, int d, int vh) {
    ARGS_REF a = *c.a; const int tid = c.tid;
    LAS float* qs = (LAS float*)(c.lds + LDS_SCR); LAS float* ks = qs + 8192; LAS float* vs = ks + 8192; LAS float* os = vs + 4096; LAS float* as = os + 4096; LAS float* bs = as + 64;
    LAS float* cwl = (LAS float*)(c.lds + LDS_AUX);
    const bf16_t* PM = (const bf16_t*)(a.ws + WS_PMIX);
    bf16_t* ORAW = (bf16_t*)(a.ws + WS_ORAW) + (size_t)d * MT * 2048;
    for (int i = tid; i < 4 * 320; i += 512) { const int tap = i / 320, cc = i % 320; const int ch = cc < 128 ? h * 128 + cc : (cc < 256 ? 512 + h * 128 + (cc - 128) : 1024 + h * 128 + vh * 64 + (cc - 256));
        cwl[i] = a.in[I_DN_CW][(L * 4 + tap) * 1536 + ch]; }
    const float neg_ea = -expf(a.in[I_DN_ALOG][(L * 2 + d) * 4 + h]), dtb = a.in[I_DN_DTB][(L * 2 + d) * 4 + h];
    float s[16];
#pragma unroll
    for (int j = 0; j < 16; ++j) s[j] = 0.f;
    const int vc = tid >> 3, kq = tid & 7;
#pragma unroll 1
    for (int seg = 0; seg < 2; ++seg) {
        const int Ls = seg ? T : CL; const size_t rowbase = seg ? (size_t)b * T : (size_t)ML + b * CL;
#pragma unroll 1
        for (int jb = 0; jb < Ls / 64; ++jb) {
            const int r0 = d ? Ls - 64 * (jb + 1) : 64 * jb;
            __syncthreads();
            {   const int i = tid >> 3, cg = tid & 7, lr = d ? 63 - i : i, t = r0 + lr;
                float aq[16], ak[16], av[8];
#pragma unroll
                for (int j = 0; j < 16; ++j) { aq[j] = 0.f; ak[j] = 0.f; }
#pragma unroll
                for (int j = 0; j < 8; ++j) av[j] = 0.f;
#pragma unroll
                for (int tap = 0; tap < 4; ++tap) { const int ts = t + tap - 2;
                    if (ts >= 0 && ts < Ls) { const bf16_t* rp = PM + (rowbase + ts) * NMIXP; const LAS float* w = cwl + tap * 320;
                        float f0[8], f1[8];
                        { const u32x4 w0 = *(const u32x4*)(rp + C_DN_Q + h * 128 + cg * 16), w1 = *(const u32x4*)(rp + C_DN_Q + h * 128 + cg * 16 + 8); unpack8(w0, f0); unpack8(w1, f1); }
#pragma unroll
                        for (int j = 0; j < 8; ++j) { aq[j] += w[cg * 16 + j] * f0[j]; aq[8 + j] += w[cg * 16 + 8 + j] * f1[j]; }
                        { const u32x4 w0 = *(const u32x4*)(rp + C_DN_K + h * 128 + cg * 16), w1 = *(const u32x4*)(rp + C_DN_K + h * 128 + cg * 16 + 8); unpack8(w0, f0); unpack8(w1, f1); }
#pragma unroll
                        for (int j = 0; j < 8; ++j) { ak[j] += w[128 + cg * 16 + j] * f0[j]; ak[8 + j] += w[128 + cg * 16 + 8 + j] * f1[j]; }
                        { const u32x4 w0 = *(const u32x4*)(rp + C_DN_V + h * 128 + vh * 64 + cg * 8); unpack8(w0, f0); }
#pragma unroll
                        for (int j = 0; j < 8; ++j) av[j] += w[256 + cg * 8 + j] * f0[j]; } }
#pragma unroll
                for (int j = 0; j < 16; ++j) { qs[i * 128 + cg * 16 + j] = siluf(aq[j]); ks[i * 128 + cg * 16 + j] = siluf(ak[j]); }
#pragma unroll
                for (int j = 0; j < 8; ++j) vs[i * 64 + cg * 8 + j] = siluf(av[j]);
                if (tid < 64) { const int lr2 = d ? 63 - tid : tid; const bf16_t* rp = PM + (rowbase + r0 + lr2) * NMIXP;
                    const float g = neg_ea * softplusf(bf1(rp + C_DN_A + d * 4 + h) + dtb); as[tid] = __expf(g); bs[tid] = sigm(bf1(rp + C_DN_B + d * 4 + h)); }
            }
            __syncthreads();
            {
                const int rowid = tid >> 2, part = tid & 3; LAS float* p = (rowid < 64 ? qs + rowid * 128 : ks + (rowid - 64) * 128) + part * 32; float ss = 0.f;
#pragma unroll
                for (int j = 0; j < 32; ++j) ss += p[j] * p[j];
                ss += __shfl_xor(ss, 1); ss += __shfl_xor(ss, 2);
                const float rs = __builtin_amdgcn_rsqf(ss + EPS) * (rowid < 64 ? 0.08838834764831845f : 1.0f);
#pragma unroll
                for (int j = 0; j < 32; ++j) p[j] *= rs;
            }
            __syncthreads();
#pragma unroll 2
            for (int i = 0; i < 64; ++i) {
                f32x4 kk[4]; float kts = 0.f;
#pragma unroll
                for (int q4 = 0; q4 < 4; ++q4) { kk[q4] = *(const LAS f32x4*)(ks + i * 128 + kq * 16 + q4 * 4);
#pragma unroll
                    for (int j = 0; j < 4; ++j) kts += s[q4 * 4 + j] * kk[q4][j]; }
                kts += __shfl_xor(kts, 1); kts += __shfl_xor(kts, 2); kts += __shfl_xor(kts, 4);
                const float al = as[i], be = bs[i]; const float vn = be * (vs[i * 64 + vc] - al * kts); float po = 0.f;
#pragma unroll
                for (int q4 = 0; q4 < 4; ++q4) { const f32x4 q0 = *(const LAS f32x4*)(qs + i * 128 + kq * 16 + q4 * 4);
#pragma unroll
                    for (int j = 0; j < 4; ++j) { s[q4 * 4 + j] = al * s[q4 * 4 + j] + kk[q4][j] * vn; po += s[q4 * 4 + j] * q0[j]; } }
                po += __shfl_xor(po, 1); po += __shfl_xor(po, 2); po += __shfl_xor(po, 4);
                if (kq == 0) os[i * 64 + vc] = po;
            }
            __syncthreads();
            {   const int i = tid >> 3, cg = tid & 7, lr = d ? 63 - i : i; float o[8];
#pragma unroll
                for (int j = 0; j < 8; ++j) o[j] = os[i * 64 + cg * 8 + j];
                *(u32x4*)(ORAW + (rowbase + r0 + lr) * 2048 + 2 * 512 + h * 128 + vh * 64 + cg * 8) = pack8(o); }
        }
    }
}
__device__ __forceinline__ void chain_rg(const Ctx& c, int gw  ) {
    ARGS_REF a = *c.a; const int b = gw >> 3, d = (gw >> 2) & 1, ch = (gw & 3) * 128 + c.lane * 2;
    const bf16_t* RGLA = (const bf16_t*)(a.ws + WS_RGLA) + (size_t)d * MT * 512 + ch; const bf16_t* RGU = (const bf16_t*)(a.ws + WS_RGU) + (size_t)d * MT * 512 + ch;
    bf16_t* ORAW = (bf16_t*)(a.ws + WS_ORAW) + (size_t)d * MT * 2048 + 1536 + ch;
    float h0 = 0.f, h1 = 0.f;
#pragma unroll 1
    for (int seg = 0; seg < 2; ++seg) {
        const int Ls = seg ? T : CL; const size_t rowbase = seg ? (size_t)b * T : (size_t)ML + b * CL;
#pragma unroll 1
        for (int s0 = 0; s0 < Ls; s0 += 16) {
            unsigned la[16], uu[16];
#pragma unroll
            for (int j = 0; j < 16; ++j) { const size_t row = rowbase + (d ? Ls - 1 - (s0 + j) : s0 + j); la[j] = *(const unsigned*)(RGLA + row * 512); uu[j] = *(const unsigned*)(RGU + row * 512); }
#pragma unroll
            for (int j = 0; j < 16; ++j) { const size_t row = rowbase + (d ? Ls - 1 - (s0 + j) : s0 + j);
                h0 = __expf(bflo(la[j])) * h0 + bflo(uu[j]); h1 = __expf(bfhi(la[j])) * h1 + bfhi(uu[j]);
                *(unsigned*)(ORAW + row * 2048) = pg8::cvt_pk_bf16_safe(h0, h1); }
        }
    }
}

typedef float f32x16 __attribute__((ext_vector_type(16)));
typedef pg8::bf16x8 bf16x8;
#define LBAR() do { asm volatile("s_waitcnt lgkmcnt(0)" ::: "memory"); __builtin_amdgcn_s_barrier(); asm volatile("" ::: "memory"); } while (0)
#define MFMA32(a, b, c) __builtin_amdgcn_mfma_f32_32x32x16_bf16((a), (b), (c), 0, 0, 0)
template <int S_> __device__ __forceinline__ bf16x8 pack_step(const f32x16& x) {
    f32x8 v;
#pragma unroll
    for (int j = 0; j < 8; ++j) v[j] = x[8 * S_ + j];
    return __builtin_bit_cast(bf16x8, __builtin_convertvector(v, bfx8_t));
}
__device__ __forceinline__ bf16_t f2bf(float f) { const __bf16 b = (__bf16)f; return __builtin_bit_cast(bf16_t, b); }
__device__ __forceinline__ int permpos(int k) { const int w = k & 15; return (k & ~15) + (((w >> 2) & 1) << 3) + ((w >> 3) << 2) + (w & 3); }
__device__ __forceinline__ int crow16(int idx, int hh) { return (idx & 3) + 8 * (idx >> 2) + 4 * hh; }
__device__ __forceinline__ size_t chunk_rowbase(int b, int n) { return n < 4 ? (size_t)ML + b * CL + n * 64 : (size_t)b * T + (size_t)(n - 4) * 64; }

template <int L, int TY>
__device__ __forceinline__ void intra_g_item(const Ctx& c, int b, int h, int n) {
    constexpr int K = TY ? 128 : 64, NSEG = 512 / K, TS = 64 / NSEG, QPITCH = 2 * K + 16;
    ARGS_REF a = *c.a; const int tid = c.tid;
    const bf16_t* PM = (const bf16_t*)(a.ws + WS_PMIX);
    unsigned char* scr = a.ws + WS_SCR;
    const size_t rowbase = chunk_rowbase(b, n);
    const int rec = (b * 4 + h) * 260 + n;
    LAS unsigned char* Qh = c.lds + LDS_SCR; LAS unsigned char* Kh = Qh + 64 * QPITCH; LAS float* segtot = (LAS float*)(Kh + 64 * QPITCH);
    LBAR();
    {
        const int v = tid & 127, t0 = (tid >> 7) * 16; float vals[16];
        const char* vb = (const char*)(PM + rowbase * NMIXP + (TY ? C_HG_I : C_GLA_V) + h * 128); asm volatile("" : "+s"(vb));
        const unsigned vo = (unsigned)(t0 * NMIXP + v) * 2u;
#pragma unroll
        for (int j = 0; j < 16; ++j) vals[j] = bf1((const bf16_t*)(vb + (vo + (unsigned)(j * NMIXP * 2))));
        float v0[8], v1[8];
#pragma unroll
        for (int j = 0; j < 8; ++j) { v0[j] = vals[j]; v1[j] = vals[8 + j]; }
        u32x4* dst = (u32x4*)(scr + (TY ? SC_HG_VT : SC_GLA_VT) + (size_t)rec * 16384 + v * 128 + t0 * 2);
        dst[0] = pack8(v0); dst[1] = pack8(v1);
    }
    const int k = tid & (K - 1), tq = tid / K;
    float lb = 0.f;
    if (TY == 1 && L == 1) { const float l0 = a.in[I_HG_LB][h * 128 + k], l1 = a.in[I_HG_LB][512 + h * 128 + k]; lb = __builtin_amdgcn_rcpf(1.0f + __expf(l0 - l1)); }
#pragma unroll 1
    for (int d = 0; d < 2; ++d) {
        float qv[TS], kv[TS], bv[TS];
        const char* pb = (const char*)(PM + rowbase * NMIXP); asm volatile("" : "+s"(pb));
        const unsigned ro = (unsigned)(TS * tq * NMIXP) * 2u;
        if (TY == 0) {
            float w[16]; const float bias = a.in[I_GLA_BA2][(L * 2 + d) * 256 + h * 64 + k];
#pragma unroll
            for (int r = 0; r < 16; ++r) w[r] = a.in[I_GLA_WA2][((L * 2 + d) * 16 + r) * 256 + h * 64 + k];
#pragma unroll
            for (int j = 0; j < TS; ++j) { const bf16_t* rp = (const bf16_t*)(pb + (ro + (unsigned)(j * NMIXP * 2)));
                qv[j] = bf1(rp + C_GLA_Q + h * 64 + k) * 0.125f; kv[j] = bf1(rp + C_GLA_K + h * 64 + k);
                const u32x4 w0 = *(const u32x4*)(rp + C_GLA_A + d * 16), w1 = *(const u32x4*)(rp + C_GLA_A + d * 16 + 8); float f0[8], f1[8]; unpack8(w0, f0); unpack8(w1, f1);
                float z = bias;
#pragma unroll
                for (int r = 0; r < 8; ++r) { z += f0[r] * w[r]; z += f1[r] * w[8 + r]; }
                bv[j] = -softplusf(-z) * (1.0f / 16.0f); }
        } else {
#pragma unroll
            for (int j = 0; j < TS; ++j) { const bf16_t* rp = (const bf16_t*)(pb + (ro + (unsigned)(j * NMIXP * 2)));
                qv[j] = siluf(bf1(rp + C_HG_Q + h * 128 + k)) * 0.08838834764831845f;
                const float sg = sigm(bf1(rp + C_HG_F + d * 512 + h * 128 + k));
                bv[j] = __logf(fmaxf(lb + (1.0f - lb) * sg, 1e-30f)); kv[j] = (1.0f - lb) * (1.0f - sg); }
        }
        float run = 0.f;
        if (d == 0) {
#pragma unroll
            for (int j = 0; j < TS; ++j) { run += bv[j]; bv[j] = run; } }
        else {
#pragma unroll
            for (int j = TS - 1; j >= 0; --j) { run += bv[j]; bv[j] = run; } }
        segtot[tq * K + k] = run;
        LBAR();
        float off = 0.f, tot = 0.f, R = 0.f;
#pragma unroll
        for (int sg = 0; sg < NSEG; ++sg) { const float s = segtot[sg * K + k]; tot += s;
            if (d ? (sg > tq) : (sg < tq)) off += s;
            if (d ? (sg >= NSEG / 2) : (sg < NSEG / 2)) R += s; }
        const size_t drec = (size_t)((d * 8 + b * 4 + h) * 260 + n);
        bf16_t* qp = (bf16_t*)(scr + (TY ? SC_HG_QP : SC_GLA_QP) + drec * (64 * K * 2));
        bf16_t* ktp = (bf16_t*)(scr + (TY ? SC_HG_KT : SC_GLA_KT) + drec * (64 * K * 2));
        const int pk = permpos(k);
        float kt[TS];
#pragma unroll
        for (int j = 0; j < TS; ++j) { const int t = TS * tq + j; const float B = off + bv[j];
            qp[t * K + pk] = f2bf(qv[j] * __expf(B));
            kt[j] = kv[j] * __expf(tot - B);
            *(LAS bf16_t*)(Qh + t * QPITCH + k * 2) = f2bf(qv[j] * __expf(fminf(B - R, 60.f)));
            *(LAS bf16_t*)(Kh + t * QPITCH + k * 2) = f2bf(kv[j] * __expf(fminf(R - B, 60.f))); }
        {   u32x4* dst = (u32x4*)(ktp + k * 64 + TS * tq);
#pragma unroll
            for (int g = 0; g < TS / 8; ++g) { float t8[8];
#pragma unroll
                for (int j = 0; j < 8; ++j) t8[j] = kt[g * 8 + j];
                dst[g] = pack8(t8); } }
        if (tq == 0) ((float*)(scr + (TY ? SC_HG_LAM : SC_GLA_LAM) + drec * (K * 4)))[k] = __expf(tot);
        LBAR();
        if (c.wave < 4) {
            const int it = c.wave >> 1, jt = c.wave & 1, r = c.lane & 31, hh = c.lane >> 5;
            bf16_t* ap = (bf16_t*)(scr + (TY ? SC_HG_A : SC_GLA_A) + drec * 8192);
            f32x16 acc;
#pragma unroll
            for (int i = 0; i < 16; ++i) acc[i] = 0.f;
            const bool dead = d ? (it == 1 && jt == 0) : (it == 0 && jt == 1);
            if (!dead) {
#pragma unroll
                for (int ks = 0; ks < K / 16; ++ks) { const bf16x8 af = *(const LAS bf16x8*)(Qh + (32 * it + r) * QPITCH + ks * 32 + hh * 16), bfr = *(const LAS bf16x8*)(Kh + (32 * jt + r) * QPITCH + ks * 32 + hh * 16);
                    acc = MFMA32(af, bfr, acc); } }
            const int jj = 32 * jt + r;
#pragma unroll
            for (int i = 0; i < 16; ++i) { const int ii = 32 * it + crow16(i, hh); const bool ok = d ? (jj >= ii) : (jj <= ii); ap[ii * 64 + jj] = f2bf(ok ? acc[i] : 0.f); }
        }
        LBAR();
    }
}

template <int TY> struct GChunk {
    static constexpr int K = TY ? 128 : 64, QPITCH = 2 * K + 16, RQ = 64 * K * 2 / 16 / 256  , NRL = 2 * RQ + 2 + 4;
    static constexpr int OFF_QP = 0, OFF_KT = 64 * QPITCH, OFF_A = OFF_KT + K * 144, OFF_VT = OFF_A + 64 * 144, OFF_LAM = OFF_VT + 128 * 144, BYTES = OFF_LAM + K * 4;
};
template <int TY>
__device__ __forceinline__ void gchunk_issue(const unsigned char* scr, int b, int h, int d, int n, int lt, u32x4 (&pf)[GChunk<TY>::NRL], float& lamv) {
    typedef GChunk<TY> G; constexpr int K = G::K, RQ = G::RQ;
    const size_t drec = (size_t)((d * 8 + b * 4 + h) * 260 + n), rec = (size_t)((b * 4 + h) * 260 + n);
    const u32x4* qp = (const u32x4*)(scr + (TY ? SC_HG_QP : SC_GLA_QP) + drec * (64 * K * 2));
    const u32x4* kt = (const u32x4*)(scr + (TY ? SC_HG_KT : SC_GLA_KT) + drec * (64 * K * 2));
    const u32x4* ap = (const u32x4*)(scr + (TY ? SC_HG_A : SC_GLA_A) + drec * 8192);
    const u32x4* vt = (const u32x4*)(scr + (TY ? SC_HG_VT : SC_GLA_VT) + rec * 16384);
#pragma unroll
    for (int i = 0; i < RQ; ++i) { pf[i] = qp[i * 256 + lt]; pf[RQ + i] = kt[i * 256 + lt]; }
    pf[2 * RQ] = ap[lt]; pf[2 * RQ + 1] = ap[256 + lt];
#pragma unroll
    for (int i = 0; i < 4; ++i) pf[2 * RQ + 2 + i] = vt[i * 256 + lt];
    if (lt < K) lamv = ((const float*)(scr + (TY ? SC_HG_LAM : SC_GLA_LAM) + drec * (K * 4)))[lt];
}
template <int TY>
__device__ __forceinline__ void gchunk_commit(LAS unsigned char* buf, int lt, const u32x4 (&pf)[GChunk<TY>::NRL], float lamv) {
    typedef GChunk<TY> G; constexpr int K = G::K, PPR = K * 2 / 16, RQ = G::RQ;
#pragma unroll
    for (int i = 0; i < RQ; ++i) { const int p = i * 256 + lt;
        *(LAS u32x4*)(buf + G::OFF_QP + (p / PPR) * G::QPITCH + (p % PPR) * 16) = pf[i];
        *(LAS u32x4*)(buf + G::OFF_KT + (p >> 3) * 144 + (p & 7) * 16) = pf[RQ + i]; }
#pragma unroll
    for (int i = 0; i < 2; ++i) { const int p = i * 256 + lt; *(LAS u32x4*)(buf + G::OFF_A + (p >> 3) * 144 + (p & 7) * 16) = pf[2 * RQ + i]; }
#pragma unroll
    for (int i = 0; i < 4; ++i) { const int p = i * 256 + lt; *(LAS u32x4*)(buf + G::OFF_VT + (p >> 3) * 144 + (p & 7) * 16) = pf[2 * RQ + 2 + i]; }
    if (lt < K) *(LAS float*)(buf + G::OFF_LAM + lt * 4) = lamv;
}
template <int TY>
__device__ __forceinline__ void gchunk_compute(LAS unsigned char* buf, f32x16 (&S)[GChunk<TY>::K / 32], bf16_t* orow, int vs, int lane) {
    typedef GChunk<TY> G; constexpr int K = G::K, KT_ = K / 32;
    const int r = lane & 31, hh = lane >> 5;
    bf16x8 vf[4];
#pragma unroll
    for (int ts = 0; ts < 4; ++ts) vf[ts] = *(const LAS bf16x8*)(buf + G::OFF_VT + (32 * vs + r) * 144 + ts * 32 + hh * 16);
    f32x16 o[2];
#pragma unroll
    for (int it = 0; it < 2; ++it) {
#pragma unroll
        for (int i = 0; i < 16; ++i) o[it][i] = 0.f; }
#pragma unroll
    for (int kt = 0; kt < KT_; ++kt) { const bf16x8 b0 = pack_step<0>(S[kt]), b1 = pack_step<1>(S[kt]);
#pragma unroll
        for (int it = 0; it < 2; ++it) { const bf16x8 q0 = *(const LAS bf16x8*)(buf + G::OFF_QP + (32 * it + r) * G::QPITCH + (2 * kt) * 32 + hh * 16), q1 = *(const LAS bf16x8*)(buf + G::OFF_QP + (32 * it + r) * G::QPITCH + (2 * kt + 1) * 32 + hh * 16);
            o[it] = MFMA32(q0, b0, o[it]); o[it] = MFMA32(q1, b1, o[it]); }
        __builtin_amdgcn_sched_barrier(0); }
#pragma unroll
    for (int ts = 0; ts < 4; ++ts)
#pragma unroll
        for (int it = 0; it < 2; ++it) { const bf16x8 af = *(const LAS bf16x8*)(buf + G::OFF_A + (32 * it + r) * 144 + ts * 32 + hh * 16);
            o[it] = MFMA32(af, vf[ts], o[it]); }
    __builtin_amdgcn_sched_barrier(0);
#pragma unroll
    for (int kt = 0; kt < KT_; ++kt) {
        __builtin_amdgcn_sched_barrier(0);
#pragma unroll
        for (int g = 0; g < 4; ++g) { const f32x4 lm = *(const LAS f32x4*)(buf + G::OFF_LAM + (32 * kt + 8 * g + 4 * hh) * 4);
#pragma unroll
            for (int j = 0; j < 4; ++j) S[kt][4 * g + j] *= lm[j]; }
#pragma unroll
        for (int ts = 0; ts < 4; ++ts) { const bf16x8 kf = *(const LAS bf16x8*)(buf + G::OFF_KT + (32 * kt + r) * 144 + ts * 32 + hh * 16);
            S[kt] = MFMA32(kf, vf[ts], S[kt]); } }
    __builtin_amdgcn_sched_barrier(0);
#pragma unroll
    for (int it = 0; it < 2; ++it)
#pragma unroll
        for (int i = 0; i < 16; ++i) orow[(size_t)(32 * it + crow16(i, hh)) * 2048 + 32 * vs + r] = f2bf(o[it][i]);
}
template <int L, int TY>
__device__ __forceinline__ void chain_g(const Ctx& c, int b, int h, int d) {
    typedef GChunk<TY> G; constexpr int KT_ = G::K / 32;
    ARGS_REF a = *c.a;
    const unsigned char* scr = a.ws + WS_SCR;
    LAS unsigned char* buf = c.lds + LDS_SCR;
    static_assert(G::BYTES <= 65536, "two chunk buffers must fit the scratch region");
#define CHUNK_OF(m) (d ? ((m) < 4 ? 3 - (m) : 263 - (m)) : (m))
    __syncthreads();
    if (c.wave < 4) {
        bf16_t* ORAW = (bf16_t*)(a.ws + WS_ORAW) + (size_t)d * MT * 2048 + TY * 512 + h * 128;
        f32x16 S[KT_];
#pragma unroll
        for (int kt = 0; kt < KT_; ++kt)
#pragma unroll
            for (int i = 0; i < 16; ++i) S[kt][i] = 0.f;
        LBAR();
#pragma unroll 1
        for (int m = 0; m < 260; ++m) {
            gchunk_compute<TY>(buf + (m & 1) * 65536, S, ORAW + chunk_rowbase(b, CHUNK_OF(m)) * 2048, c.wave, c.lane);
            LBAR();
        }
    } else {
        const int lt = c.tid - 256;
        u32x4 pfA[G::NRL], pfB[G::NRL]; float lamA = 0.f, lamB = 0.f;
        gchunk_issue<TY>(scr, b, h, d, CHUNK_OF(0), lt, pfA, lamA);
        gchunk_issue<TY>(scr, b, h, d, CHUNK_OF(1), lt, pfB, lamB);
        gchunk_commit<TY>(buf, lt, pfA, lamA);
        gchunk_issue<TY>(scr, b, h, d, CHUNK_OF(2), lt, pfA, lamA);
        LBAR();
#pragma unroll 1
        for (int m = 0; m < 260; m += 2) {
            gchunk_commit<TY>(buf + 65536, lt, pfB, lamB);
            if (m + 3 < 260) gchunk_issue<TY>(scr, b, h, d, CHUNK_OF(m + 3), lt, pfB, lamB);
            LBAR();
            if (m + 2 < 260) gchunk_commit<TY>(buf, lt, pfA, lamA);
            if (m + 4 < 260) gchunk_issue<TY>(scr, b, h, d, CHUNK_OF(m + 4), lt, pfA, lamA);
            LBAR();
        }
    }
#undef CHUNK_OF
}

__device__ __forceinline__ int posU(int i) { const int w = i & 31; return (i & 32) + (((w >> 2) & 1) << 4) + (w & 3) + ((w >> 3) << 2); }
__device__ __forceinline__ constexpr int pp16(int w) { return (((w >> 2) & 1) << 3) + ((w >> 3) << 2) + (w & 3); }

__device__ __forceinline__ void trisolve64(const LAS float* A, int cidx, float (&Tc)[64]) {
#pragma unroll
    for (int pi = 0; pi < 64; ++pi) {
        float acc = (pi == cidx) ? 1.f : 0.f;
#pragma unroll
        for (int q = 0; q < (pi + 3) / 4; ++q) { const f32x4 av = *(const LAS f32x4*)(A + pi * 64 + 4 * q);
#pragma unroll
            for (int jj = 0; jj < 4; ++jj) if (4 * q + jj < pi) acc -= av[jj] * Tc[4 * q + jj]; }
        Tc[pi] = acc;
        if ((pi & 3) == 3) __builtin_amdgcn_sched_barrier(0);
    }
}

template <int L>
__device__ __forceinline__ void intra_dn_item(const Ctx& c, int b, int h, int n) {
    ARGS_REF a = *c.a; const int tid = c.tid, lane = c.lane, wave = c.wave;
    const bf16_t* PM = (const bf16_t*)(a.ws + WS_PMIX);
    unsigned char* scr = a.ws + WS_SCR;
    const int rec = (b * 4 + h) * 260 + n;
    LAS unsigned char* Qh = c.lds + LDS_SCR;
    LAS unsigned char* Kh = Qh + 17408;
    LAS unsigned char* Tp = Qh;
    LAS unsigned char* KTp = c.lds + LDS_SCR + 36864;
    LAS unsigned char* VTp = KTp + 18432;
    LAS float* Ap = (LAS float*)(VTp + 18432);
    LAS float* sm = (LAS float*)(c.lds + LDS_AUX);
    LBAR();
    {
        const int i = tid >> 3, cg = tid & 7;
        const int Ls = n < 4 ? CL : T; const int tseg = (n < 4 ? n : n - 4) * 64 + i; const size_t segbase = n < 4 ? (size_t)ML + b * CL : (size_t)b * T;
        float aq[16], ak[16], av[16];
#pragma unroll
        for (int j = 0; j < 16; ++j) { aq[j] = 0.f; ak[j] = 0.f; av[j] = 0.f; }
        const float* cw = a.in[I_DN_CW] + (size_t)L * 4 * 1536 + h * 128 + cg * 16;
#pragma unroll
        for (int tap = 0; tap < 4; ++tap) { const int ts = tseg + tap - 2;
            if (ts >= 0 && ts < Ls) { const bf16_t* rp = PM + (segbase + ts) * NMIXP + h * 128 + cg * 16; const float* w = cw + tap * 1536;
                float f0[8], f1[8];
                { const u32x4 w0 = *(const u32x4*)(rp + C_DN_Q), w1 = *(const u32x4*)(rp + C_DN_Q + 8); unpack8(w0, f0); unpack8(w1, f1); }
#pragma unroll
                for (int j = 0; j < 8; ++j) { aq[j] += w[j] * f0[j]; aq[8 + j] += w[8 + j] * f1[j]; }
                { const u32x4 w0 = *(const u32x4*)(rp + C_DN_K), w1 = *(const u32x4*)(rp + C_DN_K + 8); unpack8(w0, f0); unpack8(w1, f1); }
#pragma unroll
                for (int j = 0; j < 8; ++j) { ak[j] += w[512 + j] * f0[j]; ak[8 + j] += w[512 + 8 + j] * f1[j]; }
                { const u32x4 w0 = *(const u32x4*)(rp + C_DN_V), w1 = *(const u32x4*)(rp + C_DN_V + 8); unpack8(w0, f0); unpack8(w1, f1); }
#pragma unroll
                for (int j = 0; j < 8; ++j) { av[j] += w[1024 + j] * f0[j]; av[8 + j] += w[1024 + 8 + j] * f1[j]; } } }
        float sq = 0.f, sk = 0.f;
#pragma unroll
        for (int j = 0; j < 16; ++j) { aq[j] = siluf(aq[j]); ak[j] = siluf(ak[j]); av[j] = siluf(av[j]); sq += aq[j] * aq[j]; sk += ak[j] * ak[j]; }
        sq += __shfl_xor(sq, 1); sq += __shfl_xor(sq, 2); sq += __shfl_xor(sq, 4);
        sk += __shfl_xor(sk, 1); sk += __shfl_xor(sk, 2); sk += __shfl_xor(sk, 4);
        const float rq = __builtin_amdgcn_rsqf(sq + EPS) * 0.08838834764831845f, rk = __builtin_amdgcn_rsqf(sk + EPS);
        float qp[16];
#pragma unroll
        for (int j = 0; j < 16; ++j) { aq[j] *= rq; ak[j] *= rk; }
#pragma unroll
        for (int j = 0; j < 16; ++j) qp[pp16(j)] = aq[j];
        {   float x0[8], x1[8];
#pragma unroll
            for (int j = 0; j < 8; ++j) { x0[j] = qp[j]; x1[j] = qp[8 + j]; }
            u32x4* dst = (u32x4*)(scr + SC_DN_QS + (size_t)rec * 16384 + i * 256 + cg * 32); dst[0] = pack8(x0); dst[1] = pack8(x1);
#pragma unroll
            for (int j = 0; j < 8; ++j) { x0[j] = aq[j]; x1[j] = aq[8 + j]; }
            *(LAS u32x4*)(Qh + i * 272 + cg * 32) = pack8(x0); *(LAS u32x4*)(Qh + i * 272 + cg * 32 + 16) = pack8(x1);
#pragma unroll
            for (int j = 0; j < 8; ++j) { x0[j] = ak[j]; x1[j] = ak[8 + j]; }
            *(LAS u32x4*)(Kh + i * 272 + cg * 32) = pack8(x0); *(LAS u32x4*)(Kh + i * 272 + cg * 32 + 16) = pack8(x1); }
        const int pj = permpos(i);
#pragma unroll
        for (int j = 0; j < 16; ++j) { *(LAS bf16_t*)(KTp + (cg * 16 + j) * 144 + pj * 2) = f2bf(ak[j]); *(LAS bf16_t*)(VTp + (cg * 16 + j) * 144 + pj * 2) = f2bf(av[j]); }
        if (tid < 128) { const int d = tid >> 6, t = tid & 63; const bf16_t* rp = PM + (chunk_rowbase(b, n) + t) * NMIXP;
            const float g = -expf(a.in[I_DN_ALOG][(L * 2 + d) * 4 + h]) * softplusf(bf1(rp + C_DN_A + d * 4 + h) + a.in[I_DN_DTB][(L * 2 + d) * 4 + h]);
            sm[d * 256 + t] = g; sm[d * 256 + 128 + t] = sigm(bf1(rp + C_DN_B + d * 4 + h)); }
    }
    LBAR();
    const int r = lane & 31, hh = lane >> 5;
    f32x16 gram;
#pragma unroll
    for (int i = 0; i < 16; ++i) gram[i] = 0.f;
    const int t1 = (wave & 3) >> 1, t2 = wave & 1;
#pragma unroll
    for (int ks = 0; ks < 8; ++ks) {
        const bf16x8 af = *(const LAS bf16x8*)(Kh + (32 * (wave < 4 ? t2 : t1) + r) * 272 + ks * 32 + hh * 16);
        const bf16x8 bfr = *(const LAS bf16x8*)((wave < 4 ? Qh : Kh) + (32 * (wave < 4 ? t1 : t2) + r) * 272 + ks * 32 + hh * 16);
        gram = MFMA32(af, bfr, gram); }
    {
        u32x4* dst = (u32x4*)(scr + SC_DN_KT + (size_t)rec * 16384);
#pragma unroll
        for (int q = 0; q < 2; ++q) { const int p = q * 512 + tid; dst[p] = *(const LAS u32x4*)(KTp + (p >> 3) * 144 + (p & 7) * 16); } }
    if (tid < 128) { const int d = tid >> 6, t = tid & 63; float acc = 0.f;
        for (int tt = 0; tt < 64; ++tt) { const float g = sm[d * 256 + tt]; if (d ? (tt >= t) : (tt <= t)) acc += g; }
        sm[d * 256 + 64 + t] = acc; }
    LBAR();
#pragma unroll 1
    for (int d = 0; d < 2; ++d) {
        const LAS float* gc = sm + d * 256 + 64; const LAS float* be = sm + d * 256 + 128;
        const size_t drec = (size_t)((d * 8 + b * 4 + h) * 260 + n);
        if (wave < 4) {
            const int i = 32 * t1 + r; const float gi = gc[i]; float o[16];
#pragma unroll
            for (int idx = 0; idx < 16; ++idx) { const int j = 32 * t2 + crow16(idx, hh); const bool ok = d ? (j >= i) : (j <= i); o[idx] = ok ? gram[idx] * __expf(fminf(gi - gc[j], 0.f)) : 0.f; }
            float x0[8], x1[8];
#pragma unroll
            for (int j = 0; j < 8; ++j) { x0[j] = o[j]; x1[j] = o[8 + j]; }
            bf16_t* ap = (bf16_t*)(scr + SC_DN_AQK + drec * 8192) + i * 64 + 32 * t2 + 8 * hh;
            *(u32x4*)ap = pack8(x0); *(u32x4*)(ap + 16) = pack8(x1);
        } else {
            const int j = 32 * t2 + r; const float gj = gc[j]; const int pj = d ? 63 - j : j;
#pragma unroll
            for (int idx = 0; idx < 16; ++idx) { const int i = 32 * t1 + crow16(idx, hh); const int pi = d ? 63 - i : i;
                Ap[d * 4096 + pi * 64 + pj] = (pj < pi) ? be[i] * gram[idx] * __expf(fminf(gc[i] - gj, 0.f)) : 0.f; }
        }
        if (tid < 64) { const float gtot = d ? gc[0] : gc[63]; float* sc = (float*)(scr + SC_DN_SC + drec * 1024);
            const float eg = __expf(gc[tid]); sc[tid] = eg; sc[64 + tid] = __expf(gtot - gc[tid]); if (tid == 0) sc[128] = __expf(gtot); sm[d * 256 + 192 + tid] = eg; }
    }
    LBAR();
    if (wave < 2) {
        const int d = wave; float Tc[64];
        trisolve64(Ap + d * 4096, lane, Tc);
        const int j = d ? 63 - lane : lane; const float bj = sm[d * 256 + 128 + j], ej = sm[d * 256 + 192 + j]; const int pj2 = permpos(j) * 2;
        LAS unsigned char* T1 = Tp + d * 18432; LAS unsigned char* T2 = T1 + 9216;
#pragma unroll
        for (int pi = 0; pi < 64; ++pi) { const int i = d ? 63 - pi : pi; const float v1 = Tc[pi] * bj;
            *(LAS bf16_t*)(T1 + i * 144 + pj2) = f2bf(v1); *(LAS bf16_t*)(T2 + i * 144 + pj2) = f2bf(v1 * ej); }
    }
    LBAR();
#pragma unroll 1
    for (int q = 0; q < 4; ++q) {
        const int tile = wave * 4 + q, d = tile >> 4, isw = (tile >> 3) & 1, it = (tile >> 2) & 1, xt = tile & 3;
        const size_t drec = (size_t)((d * 8 + b * 4 + h) * 260 + n);
        LAS unsigned char* T1 = Tp + d * 18432; LAS unsigned char* T2 = T1 + 9216;
        f32x16 acc;
#pragma unroll
        for (int i = 0; i < 16; ++i) acc[i] = 0.f;
        if (!isw) {
#pragma unroll
            for (int js = 0; js < 4; ++js) { const bf16x8 af = *(const LAS bf16x8*)(T1 + (32 * it + r) * 144 + js * 32 + hh * 16), bfr = *(const LAS bf16x8*)(VTp + (32 * xt + r) * 144 + js * 32 + hh * 16);
                acc = MFMA32(af, bfr, acc); }
            float x0[8], x1[8];
#pragma unroll
            for (int j = 0; j < 8; ++j) { x0[j] = acc[j]; x1[j] = acc[8 + j]; }
            bf16_t* up = (bf16_t*)(scr + SC_DN_UT + drec * 16384) + (32 * xt + r) * 64 + it * 32 + hh * 16;
            *(u32x4*)up = pack8(x0); *(u32x4*)(up + 8) = pack8(x1);
        } else {
#pragma unroll
            for (int js = 0; js < 4; ++js) { const bf16x8 af = *(const LAS bf16x8*)(KTp + (32 * xt + r) * 144 + js * 32 + hh * 16), bfr = *(const LAS bf16x8*)(T2 + (32 * it + r) * 144 + js * 32 + hh * 16);
                acc = MFMA32(af, bfr, acc); }
            float x0[8], x1[8];
#pragma unroll
            for (int j = 0; j < 8; ++j) { x0[j] = -acc[j]; x1[j] = -acc[8 + j]; }
            bf16_t* wp = (bf16_t*)(scr + SC_DN_WN + drec * 16384) + (32 * it + r) * 128 + 32 * xt + 8 * hh;
            *(u32x4*)wp = pack8(x0); *(u32x4*)(wp + 16) = pack8(x1);
        }
    }
}

struct DChunk { static constexpr int OFF_QS = 0, OFF_KT = 17408, OFF_UT = OFF_KT + 18432, OFF_WN = OFF_UT + 18432, OFF_AQK = OFF_WN + 17408, OFF_SC = OFF_AQK + 9216, BYTES = OFF_SC + 1024, NRL = 18; };
__device__ __forceinline__ void dchunk_issue(const unsigned char* scr, int b, int h, int d, int n, int lt, u32x4 (&pf)[DChunk::NRL], f32x4& scv) {
    const size_t drec = (size_t)((d * 8 + b * 4 + h) * 260 + n), rec = (size_t)((b * 4 + h) * 260 + n);
    const u32x4* qs = (const u32x4*)(scr + SC_DN_QS + rec * 16384); const u32x4* kt = (const u32x4*)(scr + SC_DN_KT + rec * 16384);
    const u32x4* ut = (const u32x4*)(scr + SC_DN_UT + drec * 16384); const u32x4* wn = (const u32x4*)(scr + SC_DN_WN + drec * 16384);
    const u32x4* aq = (const u32x4*)(scr + SC_DN_AQK + drec * 8192);
#pragma unroll
    for (int i = 0; i < 4; ++i) { pf[i] = qs[i * 256 + lt]; pf[4 + i] = kt[i * 256 + lt]; pf[8 + i] = ut[i * 256 + lt]; pf[12 + i] = wn[i * 256 + lt]; }
    pf[16] = aq[lt]; pf[17] = aq[256 + lt];
    if (lt < 64) scv = ((const f32x4*)(scr + SC_DN_SC + drec * 1024))[lt];
}
__device__ __forceinline__ void dchunk_commit(LAS unsigned char* buf, int lt, const u32x4 (&pf)[DChunk::NRL], const f32x4 scv) {
    typedef DChunk G;
#pragma unroll
    for (int i = 0; i < 4; ++i) { const int p = i * 256 + lt;
        *(LAS u32x4*)(buf + G::OFF_QS + (p >> 4) * 272 + (p & 15) * 16) = pf[i];
        *(LAS u32x4*)(buf + G::OFF_KT + (p >> 3) * 144 + (p & 7) * 16) = pf[4 + i];
        *(LAS u32x4*)(buf + G::OFF_UT + (p >> 3) * 144 + (p & 7) * 16) = pf[8 + i];
        *(LAS u32x4*)(buf + G::OFF_WN + (p >> 4) * 272 + (p & 15) * 16) = pf[12 + i]; }
#pragma unroll
    for (int i = 0; i < 2; ++i) { const int p = i * 256 + lt; *(LAS u32x4*)(buf + G::OFF_AQK + (p >> 3) * 144 + (p & 7) * 16) = pf[16 + i]; }
    if (lt < 64) *(LAS f32x4*)(buf + G::OFF_SC + lt * 16) = scv;
}
__device__ __forceinline__ void dchunk_compute(LAS unsigned char* buf, f32x16 (&S)[4], bf16_t* orow, int vs, int lane) {
    typedef DChunk G; const int r = lane & 31, hh = lane >> 5;
    f32x16 vn[2], o[2];
#pragma unroll
    for (int it = 0; it < 2; ++it) { const u32x4 u0 = *(const LAS u32x4*)(buf + G::OFF_UT + (32 * vs + r) * 144 + it * 64 + hh * 32), u1 = *(const LAS u32x4*)(buf + G::OFF_UT + (32 * vs + r) * 144 + it * 64 + hh * 32 + 16);
        float f0[8], f1[8]; unpack8(u0, f0); unpack8(u1, f1);
#pragma unroll
        for (int j = 0; j < 8; ++j) { vn[it][j] = f0[j]; vn[it][8 + j] = f1[j]; o[it][j] = 0.f; o[it][8 + j] = 0.f; } }
#pragma unroll
    for (int kt = 0; kt < 4; ++kt) { const bf16x8 b0 = pack_step<0>(S[kt]), b1 = pack_step<1>(S[kt]);
#pragma unroll
        for (int it = 0; it < 2; ++it) {
            const bf16x8 w0 = *(const LAS bf16x8*)(buf + G::OFF_WN + (32 * it + r) * 272 + (2 * kt) * 32 + hh * 16), w1 = *(const LAS bf16x8*)(buf + G::OFF_WN + (32 * it + r) * 272 + (2 * kt + 1) * 32 + hh * 16);
            const bf16x8 q0 = *(const LAS bf16x8*)(buf + G::OFF_QS + (32 * it + r) * 272 + (2 * kt) * 32 + hh * 16), q1 = *(const LAS bf16x8*)(buf + G::OFF_QS + (32 * it + r) * 272 + (2 * kt + 1) * 32 + hh * 16);
            vn[it] = MFMA32(w0, b0, vn[it]); o[it] = MFMA32(q0, b0, o[it]); vn[it] = MFMA32(w1, b1, vn[it]); o[it] = MFMA32(q1, b1, o[it]); }
        __builtin_amdgcn_sched_barrier(0); }
#pragma unroll
    for (int it = 0; it < 2; ++it)
#pragma unroll
        for (int g = 0; g < 4; ++g) { const f32x4 e = *(const LAS f32x4*)(buf + G::OFF_SC + (32 * it + 8 * g + 4 * hh) * 4);
#pragma unroll
            for (int j = 0; j < 4; ++j) o[it][4 * g + j] *= e[j]; }
    __builtin_amdgcn_sched_barrier(0);
#pragma unroll
    for (int jt = 0; jt < 2; ++jt) { const bf16x8 p0 = pack_step<0>(vn[jt]), p1 = pack_step<1>(vn[jt]);
#pragma unroll
        for (int it = 0; it < 2; ++it) { const bf16x8 a0 = *(const LAS bf16x8*)(buf + G::OFF_AQK + (32 * it + r) * 144 + (2 * jt) * 32 + hh * 16), a1 = *(const LAS bf16x8*)(buf + G::OFF_AQK + (32 * it + r) * 144 + (2 * jt + 1) * 32 + hh * 16);
            o[it] = MFMA32(a0, p0, o[it]); o[it] = MFMA32(a1, p1, o[it]); } }
    __builtin_amdgcn_sched_barrier(0);
#pragma unroll
    for (int jt = 0; jt < 2; ++jt)
#pragma unroll
        for (int g = 0; g < 4; ++g) { const f32x4 e = *(const LAS f32x4*)(buf + G::OFF_SC + 256 + (32 * jt + 8 * g + 4 * hh) * 4);
#pragma unroll
            for (int j = 0; j < 4; ++j) vn[jt][4 * g + j] *= e[j]; }
    const float glast = *(const LAS float*)(buf + G::OFF_SC + 512);
    const bf16x8 p00 = pack_step<0>(vn[0]), p01 = pack_step<1>(vn[0]), p10 = pack_step<0>(vn[1]), p11 = pack_step<1>(vn[1]);
    __builtin_amdgcn_sched_barrier(0);
#pragma unroll
    for (int kt = 0; kt < 4; ++kt) {
#pragma unroll
        for (int i = 0; i < 16; ++i) S[kt][i] *= glast;
        const LAS unsigned char* kb = buf + G::OFF_KT + (32 * kt + r) * 144 + hh * 16;
        S[kt] = MFMA32(*(const LAS bf16x8*)(kb), p00, S[kt]); S[kt] = MFMA32(*(const LAS bf16x8*)(kb + 32), p01, S[kt]);
        S[kt] = MFMA32(*(const LAS bf16x8*)(kb + 64), p10, S[kt]); S[kt] = MFMA32(*(const LAS bf16x8*)(kb + 96), p11, S[kt]);
        __builtin_amdgcn_sched_barrier(0); }
#pragma unroll
    for (int it = 0; it < 2; ++it)
#pragma unroll
        for (int i = 0; i < 16; ++i) orow[(size_t)(32 * it + crow16(i, hh)) * 2048 + 32 * vs + r] = f2bf(o[it][i]);
}
template <int L>
__device__ __forceinline__ void chain_dnc(const Ctx& c, int b, int h, int d) {
    ARGS_REF a = *c.a;
    const unsigned char* scr = a.ws + WS_SCR;
    LAS unsigned char* buf = c.lds + LDS_SCR;
#define CHUNK_OF(m) (d ? ((m) < 4 ? 3 - (m) : 263 - (m)) : (m))
    __syncthreads();
    if (c.wave < 4) {
        bf16_t* ORAW = (bf16_t*)(a.ws + WS_ORAW) + (size_t)d * MT * 2048 + 2 * 512 + h * 128;
        f32x16 S[4];
#pragma unroll
        for (int kt = 0; kt < 4; ++kt)
#pragma unroll
            for (int i = 0; i < 16; ++i) S[kt][i] = 0.f;
        LBAR();
#pragma unroll 1
        for (int m = 0; m < 260; ++m) {
            dchunk_compute(buf, S, ORAW + chunk_rowbase(b, CHUNK_OF(m)) * 2048, c.wave, c.lane);
            LBAR();
            LBAR();
        }
    } else {
        const int lt = c.tid - 256;
        u32x4 pfA[DChunk::NRL], pfB[DChunk::NRL]; f32x4 scA = {0.f, 0.f, 0.f, 0.f}, scB = scA;
        dchunk_issue(scr, b, h, d, CHUNK_OF(0), lt, pfA, scA);
        dchunk_issue(scr, b, h, d, CHUNK_OF(1), lt, pfB, scB);
        dchunk_commit(buf, lt, pfA, scA);
        dchunk_issue(scr, b, h, d, CHUNK_OF(2), lt, pfA, scA);
        LBAR();
#pragma unroll 1
        for (int m = 0; m < 260; m += 2) {
            LBAR();
            dchunk_commit(buf, lt, pfB, scB);
            if (m + 3 < 260) dchunk_issue(scr, b, h, d, CHUNK_OF(m + 3), lt, pfB, scB);
            LBAR();
            LBAR();
            if (m + 2 < 260) dchunk_commit(buf, lt, pfA, scA);
            if (m + 4 < 260) dchunk_issue(scr, b, h, d, CHUNK_OF(m + 4), lt, pfA, scA);
            LBAR();
        }
    }
#undef CHUNK_OF
}

__device__ __forceinline__ void rgw_convert(const Ctx& c) {
    ARGS_REF a = *c.a; bf16_t* dst = (bf16_t*)(a.ws + WS_RGW);
    for (int e = c.wg * 512 + c.tid; e < 32 * 16384; e += c.G * 512) { const int m = e >> 14, oc = (e >> 7) & 127, cc = e & 127, l = m >> 4, d = (m >> 3) & 1, n = (m >> 1) & 3, g = m & 1;
        const float* src = g ? a.in[I_RG_WI] : a.in[I_RG_WR];
        dst[e] = f2bf(src[((size_t)(((l * 2 + d) * 4 + n) * 128 + cc)) * 128 + oc]); }
}
template <int L>
__device__ __forceinline__ void rgprep_item2(const Ctx& c, int item) {
    ARGS_REF a = *c.a; const int tid = c.tid, lane = c.lane, wave = c.wave;
    LAS unsigned char* XB = c.lds + LDS_SCR;
    LAS float* xbT = (LAS float*)(c.lds + LDS_SCR + 17408);
    LAS float* PRE = (LAS float*)(c.lds + LDS_SCR + 52224);
    LAS float* SEG = (LAS float*)(c.lds + LDS_AUX);
    const bf16_t* PM = (const bf16_t*)(a.ws + WS_PMIX);
    bf16_t* RGLA = (bf16_t*)(a.ws + WS_RGLA); bf16_t* ORAW = (bf16_t*)(a.ws + WS_ORAW);
    float* TT = (float*)(a.ws + WS_RGTT);
    const float* cw = a.in[I_RG_CW] + L * 4 * 512; const float* cb = a.in[I_RG_CB] + L * 512;
    const int tt = item >> 2, n = item & 3;
    size_t rowbase; int t0, Ls, bb, nchunk;
    if (tt < 512) { bb = tt >> 8; rowbase = (size_t)bb * T; t0 = (tt & 255) * 64; Ls = T; nchunk = 4 + (tt & 255); }
    else { const int tc = tt - 512; bb = tc >> 2; rowbase = (size_t)ML + bb * CL; t0 = (tc & 3) * 64; Ls = CL; nchunk = tc & 3; }
    LBAR();
    {
        const int tl = tid >> 3, cg = tid & 7, ch0 = n * 128 + cg * 16;
        float acc[16];
#pragma unroll
        for (int j = 0; j < 16; ++j) acc[j] = cb[ch0 + j];
#pragma unroll
        for (int tap = 0; tap < 4; ++tap) { const int ts = t0 + tl + tap - 2;
            if (ts >= 0 && ts < Ls) { const bf16_t* rp = PM + (rowbase + ts) * NMIXP + C_RG_X + ch0; const u32x4 w0 = *(const u32x4*)rp, w1 = *(const u32x4*)(rp + 8);
                float f[8], g[8]; unpack8(w0, f); unpack8(w1, g);
#pragma unroll
                for (int j = 0; j < 8; ++j) { acc[j] += cw[tap * 512 + ch0 + j] * f[j]; acc[8 + j] += cw[tap * 512 + ch0 + 8 + j] * g[j]; } } }
#pragma unroll
        for (int j = 0; j < 16; ++j) xbT[(cg * 16 + j) * 68 + tl] = acc[j];
        float x0[8], x1[8];
#pragma unroll
        for (int j = 0; j < 8; ++j) { x0[j] = acc[j]; x1[j] = acc[8 + j]; }
        *(LAS u32x4*)(XB + tl * 272 + cg * 32) = pack8(x0); *(LAS u32x4*)(XB + tl * 272 + cg * 32 + 16) = pack8(x1);
    }
    LBAR();
    const int r = lane & 31, hh = lane >> 5, tth = wave & 1, ot = wave >> 1;
    const int oc = tid & 127, tq = tid >> 7, ch = n * 128 + oc;
#pragma unroll 1
    for (int d = 0; d < 2; ++d) {
        {
            const bf16_t* wbase = (const bf16_t*)(a.ws + WS_RGW) + (size_t)(((L * 2 + d) * 4 + n) * 2) * 16384 + (32 * ot + r) * 128 + hh * 8;
#pragma unroll
            for (int g = 0; g < 2; ++g) { f32x16 acc;
#pragma unroll
                for (int i = 0; i < 16; ++i) acc[i] = 0.f;
#pragma unroll
                for (int ks = 0; ks < 8; ++ks) { const bf16x8 af = *(const LAS bf16x8*)(XB + (32 * tth + r) * 272 + ks * 32 + hh * 16); const bf16x8 bfr = *(const bf16x8*)(wbase + g * 16384 + ks * 16);
                    acc = MFMA32(af, bfr, acc); }
#pragma unroll
                for (int gq = 0; gq < 4; ++gq) { f32x4 v = {acc[4 * gq], acc[4 * gq + 1], acc[4 * gq + 2], acc[4 * gq + 3]};
                    *(LAS f32x4*)(PRE + (g * 128 + 32 * ot + r) * 68 + 32 * tth + 8 * gq + 4 * hh) = v; } }
        }
        LBAR();
        {
            const float br = a.in[I_RG_BR][(L * 2 + d) * 512 + ch], bi = a.in[I_RG_BI][(L * 2 + d) * 512 + ch];
            const float sp = softplusf(-a.in[I_RG_LAM][(L * 2 + d) * 512 + ch]);
            float la[16], hl[16];
#pragma unroll
            for (int q = 0; q < 4; ++q) { const f32x4 pr = *(const LAS f32x4*)(PRE + oc * 68 + 16 * tq + 4 * q), pi = *(const LAS f32x4*)(PRE + (128 + oc) * 68 + 16 * tq + 4 * q), xv = *(const LAS f32x4*)(xbT + oc * 68 + 16 * tq + 4 * q);
#pragma unroll
                for (int j = 0; j < 4; ++j) { const float rr = sigm(pr[j] + br), ig = sigm(pi[j] + bi); const float l = -8.0f * rr * sp;
                    la[4 * q + j] = l; hl[4 * q + j] = __builtin_amdgcn_sqrtf(fmaxf(1.0f - __expf(2.0f * l), 0.f)) * (ig * xv[j]); } }
            float hrun = 0.f, lrun = 0.f;
            if (d == 0) {
#pragma unroll
                for (int j = 0; j < 16; ++j) { hrun = __expf(la[j]) * hrun + hl[j]; lrun += la[j]; hl[j] = hrun; la[j] = lrun; } }
            else {
#pragma unroll
                for (int j = 15; j >= 0; --j) { hrun = __expf(la[j]) * hrun + hl[j]; lrun += la[j]; hl[j] = hrun; la[j] = lrun; } }
            SEG[(tq * 128 + oc) * 2] = lrun; SEG[(tq * 128 + oc) * 2 + 1] = hrun;
            LBAR();
            float Hin = 0.f, Lin = 0.f, Htot = 0.f, Ltot = 0.f;
#pragma unroll
            for (int s = 0; s < 4; ++s) { const int sg = d ? 3 - s : s; const float ls = SEG[(sg * 128 + oc) * 2], hs = SEG[(sg * 128 + oc) * 2 + 1];
                const bool before = d ? (sg > tq) : (sg < tq);
                if (before) { Hin = __expf(ls) * Hin + hs; Lin += ls; }
                Htot = __expf(ls) * Htot + hs; Ltot += ls; }
            const size_t ob = ((size_t)d * MT + rowbase + t0 + 16 * tq);
#pragma unroll
            for (int j = 0; j < 16; ++j) { const float e = __expf(la[j]);
                ORAW[(ob + j) * 2048 + 1536 + ch] = f2bf(hl[j] + e * Hin);
                RGLA[(ob + j) * 512 + ch] = f2bf(e * __expf(Lin)); }
            if (tq == 0) { float* tp = TT + ((size_t)((d * 2 + bb) * 260 + nchunk) * 512 + ch) * 2; tp[0] = __expf(Ltot); tp[1] = Htot; }
        }
        LBAR();
    }
}
__device__ __forceinline__ void rg_carry(const Ctx& c, int part) {
    ARGS_REF a = *c.a; const int gid = part * 512 + c.tid, d = gid >> 10, b = (gid >> 9) & 1, ch = gid & 511;
    typedef float f32x2v __attribute__((ext_vector_type(2)));
    const f32x2v* TT = (const f32x2v*)(a.ws + WS_RGTT) + (size_t)((d * 2 + b) * 260) * 512 + ch;
    float* CR = (float*)(a.ws + WS_RGCARRY) + (size_t)((d * 2 + b) * 260) * 512 + ch;
    float H = 0.f;
#pragma unroll 1
    for (int m0 = 0; m0 < 260; m0 += 20) { f32x2v p[20];
#pragma unroll
        for (int j = 0; j < 20; ++j) { const int m = m0 + j, nn = d ? (m < 4 ? 3 - m : 263 - m) : m; p[j] = TT[(size_t)nn * 512]; }
#pragma unroll
        for (int j = 0; j < 20; ++j) { const int m = m0 + j, nn = d ? (m < 4 ? 3 - m : 263 - m) : m; CR[(size_t)nn * 512] = H; H = p[j].x * H + p[j].y; } }
}
#ifndef PROBE_SUB
#define PROBE_SUB 0
#endif
template <int L>
__device__ __forceinline__ void intra_phase(const Ctx& c) {
#pragma unroll 1
    for (int rep = 0; rep < ((PROBE_SUB & 1) ? 2 : 1); ++rep)
#pragma unroll 1
    for (int item = c.wg; item < 2080; item += c.G) rgprep_item2<L>(c, item);
#pragma unroll 1
    for (int rep = 0; rep < ((PROBE_SUB & 2) ? 2 : 1); ++rep)
#pragma unroll 1
    for (int item = (c.wg + 96) % c.G; item < 2080; item += c.G) { const int bh = item / 260, n = item % 260; intra_g_item<L, 0>(c, bh >> 2, bh & 3, n); }
#pragma unroll 1
    for (int rep = 0; rep < ((PROBE_SUB & 4) ? 2 : 1); ++rep)
#pragma unroll 1
    for (int item = (c.wg + 192) % c.G; item < 2080; item += c.G) { const int bh = item / 260, n = item % 260; intra_g_item<L, 1>(c, bh >> 2, bh & 3, n); }
#pragma unroll 1
    for (int rep = 0; rep < ((PROBE_SUB & 8) ? 2 : 1); ++rep)
#pragma unroll 1
    for (int item = (c.wg + 32) % c.G; item < 2080; item += c.G) { const int bh = item / 260, n = item % 260; intra_dn_item<L>(c, bh >> 2, bh & 3, n); }
}
template <int L>
__device__ __forceinline__ void chains_phase(const Ctx& c) {
    const int w = c.wg;
    if (w < 32) { const int r = w & 15, b = r >> 3, h = (r >> 1) & 3, d = r & 1;
        if (w < 16) chain_g<L, 0>(c, b, h, d); else chain_g<L, 1>(c, b, h, d); }
    else if (w < 48) { const int r = w - 32, b = r >> 3, h = (r >> 1) & 3, d = r & 1; chain_dnc<L>(c, b, h, d); }
    else if (w < 52) rg_carry(c, w - 48);
}
template <int L>
__device__ __forceinline__ void combine_phase(const Ctx& c) {
    ARGS_REF a = *c.a; const int gw = c.wg * 8 + c.wave, nw = c.G * 8, lane = c.lane;
    const bf16_t* PM = (const bf16_t*)(a.ws + WS_PMIX); const bf16_t* O0 = (const bf16_t*)(a.ws + WS_ORAW); const bf16_t* O1 = O0 + (size_t)MT * 2048;
    bf16_t* O = (bf16_t*)(a.ws + WS_O);
    const int cb = lane * 8, hv = cb & 127;
    float nwv[3][8];
#pragma unroll
    for (int j = 0; j < 8; ++j) { nwv[0][j] = a.in[I_GLA_NW][L * 128 + hv + j]; nwv[1][j] = a.in[I_HG_NW][L * 128 + hv + j]; nwv[2][j] = a.in[I_DN_NW][L * 128 + hv + j]; }
    const int nrows = (L == 0) ? MT : ML;
    for (int r = gw; r < nrows; r += nw) {
        const bf16_t* pm = PM + (size_t)r * NMIXP;
#pragma unroll
        for (int br = 0; br < 3; ++br) {
            const int gcol = br == 0 ? C_GLA_G : (br == 1 ? C_HG_G : C_DN_G);
            float x0[8], x1[8], g[8], o[8];
            { const u32x4 w = *(const u32x4*)(O0 + (size_t)r * 2048 + br * 512 + cb); unpack8(w, x0); }
            { const u32x4 w = *(const u32x4*)(O1 + (size_t)r * 2048 + br * 512 + cb); unpack8(w, x1); }
            { const u32x4 w = *(const u32x4*)(pm + gcol + cb); unpack8(w, g); }
            float ss = 0.f;
#pragma unroll
            for (int j = 0; j < 8; ++j) { o[j] = x0[j] + x1[j]; ss += o[j] * o[j]; }
            ss += __shfl_xor(ss, 1); ss += __shfl_xor(ss, 2); ss += __shfl_xor(ss, 4); ss += __shfl_xor(ss, 8);
            const float rs = __builtin_amdgcn_rsqf(ss * (1.0f / 128.0f) + EPS);
#pragma unroll
            for (int j = 0; j < 8; ++j) o[j] = o[j] * rs * nwv[br][j] * siluf(g[j]);
            *(u32x4*)(O + ((size_t)br * MT + r) * 512 + cb) = pack8(o);
        }
        {   float x0[8], x1[8], p0[8], p1[8], y[8], o[8];
            const int bb = r < ML ? (r >> 14) : ((r - ML) >> 8), nchunk = r < ML ? 4 + ((r & 16383) >> 6) : (((r - ML) & 255) >> 6);
            const bf16_t* RGLA = (const bf16_t*)(a.ws + WS_RGLA); const float* CR = (const float*)(a.ws + WS_RGCARRY);
            { const u32x4 w = *(const u32x4*)(O0 + (size_t)r * 2048 + 1536 + cb); unpack8(w, x0); }
            { const u32x4 w = *(const u32x4*)(O1 + (size_t)r * 2048 + 1536 + cb); unpack8(w, x1); }
            { const u32x4 w = *(const u32x4*)(RGLA + (size_t)r * 512 + cb); unpack8(w, p0); }
            { const u32x4 w = *(const u32x4*)(RGLA + ((size_t)MT + r) * 512 + cb); unpack8(w, p1); }
            { const u32x4 w = *(const u32x4*)(pm + C_RG_Y + cb); unpack8(w, y); }
            const float* c0 = CR + (size_t)((0 * 2 + bb) * 260 + nchunk) * 512 + cb; const float* c1 = CR + (size_t)((1 * 2 + bb) * 260 + nchunk) * 512 + cb;
            const f32x4 ca = *(const f32x4*)c0, cb2 = *(const f32x4*)(c0 + 4), cc = *(const f32x4*)c1, cd = *(const f32x4*)(c1 + 4);
#pragma unroll
            for (int j = 0; j < 8; ++j) { const float k0 = j < 4 ? ca[j & 3] : cb2[j & 3], k1 = j < 4 ? cc[j & 3] : cd[j & 3];
                o[j] = gelu_tanh(y[j]) * ((x0[j] + p0[j] * k0) + (x1[j] + p1[j] * k1)); }
            *(u32x4*)(O + ((size_t)3 * MT + r) * 512 + cb) = pack8(o);
        }
    }
}

__device__ __forceinline__ void route1_phase(const Ctx& c) {
    ARGS_REF a = *c.a; const int lane = c.lane;
    const float* modv = (const float*)(a.ws + WS_MOD) + (size_t)1 * 3 * 12288 + 3 * 2048;
    const float* normw = a.in[I_NORMW] + (1 * 2 + 1) * 2048;
    const float* router = a.in[I_ROUTER];
    bf16_t* H = (bf16_t*)(a.ws + WS_H);
    unsigned* topi = (unsigned*)(a.ws + WS_TOPI); float* topw = (float*)(a.ws + WS_TOPW);
    volatile LAS int* hist = (volatile LAS int*)(c.lds + LDS_AUX);
    if (c.tid < 8) hist[c.tid] = 0;
    __syncthreads();
    const int rpw = ML / c.G;
    for (int rr = c.wave; rr < rpw; rr += 8) {
        const int r = c.wg * rpw + rr, b = r >> 14;
        const float* src = (const float*)a.out + (size_t)r * D;
        f32x4 v[8];
#pragma unroll
        for (int j = 0; j < 8; ++j) v[j] = *(const f32x4*)(src + (j * 64 + lane) * 4);
        const float* shift = modv + (size_t)b * 12288;
        modnorm_row(v, normw, shift, shift + 2048, lane);
        store_row_bf16(v, H + (size_t)r * D, lane);
        float lg[8];
#pragma unroll
        for (int e = 0; e < 8; ++e) lg[e] = 0.f;
#pragma unroll
        for (int j = 0; j < 8; ++j)
#pragma unroll
            for (int q = 0; q < 4; ++q) { const int cc = (j * 64 + lane) * 4 + q; const f32x4 r0 = *(const f32x4*)(router + cc * 8), r1 = *(const f32x4*)(router + cc * 8 + 4); const float x = v[j][q];
                lg[0] += x * r0[0]; lg[1] += x * r0[1]; lg[2] += x * r0[2]; lg[3] += x * r0[3]; lg[4] += x * r1[0]; lg[5] += x * r1[1]; lg[6] += x * r1[2]; lg[7] += x * r1[3]; }
#pragma unroll
        for (int e = 0; e < 8; ++e) lg[e] = wave_sum(lg[e]);
        int e0 = 0; float m0 = lg[0];
#pragma unroll
        for (int e = 1; e < 8; ++e) if (lg[e] > m0) { m0 = lg[e]; e0 = e; }
        int e1 = -1; float m1 = -3.0e38f;
#pragma unroll
        for (int e = 0; e < 8; ++e) if (e != e0 && lg[e] > m1) { m1 = lg[e]; e1 = e; }
        if (e1 < 0) { e1 = (e0 + 1) & 7; m1 = m0; }
        if (lane == 0) { const float ex = __expf(m1 - m0); const float w0 = 1.0f / (1.0f + ex); topi[r] = (unsigned)e0 | ((unsigned)e1 << 8); topw[2 * r] = w0; topw[2 * r + 1] = ex * w0;
            lds_add(&hist[e0]); lds_add(&hist[e1]); }
    }
    __syncthreads();
    if (c.tid < 8) ((int*)(a.ws + WS_CTL + CTL_WGH))[c.wg * 8 + c.tid] = hist[c.tid];
}
__device__ __forceinline__ void route2_phase(const Ctx& c) {
    ARGS_REF a = *c.a; const int lane = c.lane, tid = c.tid;
    const int* wgh = (const int*)(a.ws + WS_CTL + CTL_WGH);
    volatile LAS int* tab = (volatile LAS int*)(c.lds + LDS_AUX);
    if (tid < 8) { int tot = 0, base = 0; for (int w = 0; w < c.G; ++w) { const int v = wgh[w * 8 + tid]; tot += v; if (w < c.wg) base += v; } tab[tid] = tot; tab[8 + tid] = base; tab[24 + tid] = 0; tab[32 + tid] = (tot + 255) / 256 * 256; }
    __syncthreads();
    if (tid == 0) { int acc = 0; for (int e = 0; e < 8; ++e) { tab[16 + e] = acc; acc += tab[32 + e]; }
        if (c.wg == 0) { int* meta = (int*)(a.ws + WS_CTL + CTL_META); int cum = 0; for (int e = 0; e < 8; ++e) { cum += tab[32 + e] / 256; meta[e] = cum; } meta[8] = cum; } }
    __syncthreads();
    const bf16_t* H = (const bf16_t*)(a.ws + WS_H); bf16_t* GATH = (bf16_t*)(a.ws + WS_GATH);
    const unsigned* topi = (const unsigned*)(a.ws + WS_TOPI); int* dest = (int*)(a.ws + WS_DEST);
    const int rpw = ML / c.G;
    for (int rr = c.wave; rr < rpw; rr += 8) {
        const int r = c.wg * rpw + rr; const unsigned ti = topi[r]; const int e0 = ti & 255, e1 = (ti >> 8) & 255;
        int d0 = 0, d1 = 0;
        if (lane == 0) { d0 = tab[16 + e0] + tab[8 + e0] + lds_add(&tab[24 + e0]); d1 = tab[16 + e1] + tab[8 + e1] + lds_add(&tab[24 + e1]); dest[2 * r] = d0; dest[2 * r + 1] = d1; }
        d0 = __shfl(d0, 0); d1 = __shfl(d1, 0);
        const u32x4* sp = (const u32x4*)(H + (size_t)r * D); u32x4* p0 = (u32x4*)(GATH + (size_t)d0 * D); u32x4* p1 = (u32x4*)(GATH + (size_t)d1 * D);
#pragma unroll
        for (int j = 0; j < 4; ++j) { const u32x4 w = sp[j * 64 + lane]; p0[j * 64 + lane] = w; p1[j * 64 + lane] = w; }
    }
    if (c.wg < 8) { const int e = c.wg; const int lo = tab[16 + e] + tab[e], hi = tab[16 + e] + tab[32 + e]; const u32x4 z = {0u, 0u, 0u, 0u};
        for (int r = lo + c.wave; r < hi; r += 8) { u32x4* p = (u32x4*)(GATH + (size_t)r * D);
#pragma unroll
            for (int j = 0; j < 4; ++j) p[j * 64 + lane] = z; } }
}
__device__ __forceinline__ void final_phase(const Ctx& c) {
    ARGS_REF a = *c.a; const int gw = c.wg * 8 + c.wave, nw = c.G * 8, lane = c.lane;
    const float* modv = (const float*)(a.ws + WS_MOD) + (size_t)1 * 3 * 12288 + 5 * 2048;
    const bf16_t* Y = (const bf16_t*)(a.ws + WS_GATH); const int* dest = (const int*)(a.ws + WS_DEST); const float* topw = (const float*)(a.ws + WS_TOPW);
    const float* fw = a.in[I_FNORMW];
    for (int r = gw; r < ML; r += nw) {
        const int b = r >> 14; float* xr = a.out + (size_t)r * D; const float* mg = modv + (size_t)b * 12288;
        const int d0 = dest[2 * r], d1 = dest[2 * r + 1]; const float w0 = topw[2 * r], w1 = topw[2 * r + 1];
        const bf16_t* y0 = Y + (size_t)d0 * D; const bf16_t* y1 = Y + (size_t)d1 * D;
        f32x4 v[8]; float ss = 0.f;
#pragma unroll
        for (int j = 0; j < 8; ++j) { const int cc = (j * 64 + lane) * 4; const f32x4 x = *(const f32x4*)(xr + cc), g = *(const f32x4*)(mg + cc);
            const u32x2 a0 = *(const u32x2*)(y0 + cc), a1 = *(const u32x2*)(y1 + cc);
            f32x4 m; m[0] = w0 * bflo(a0.x) + w1 * bflo(a1.x); m[1] = w0 * bfhi(a0.x) + w1 * bfhi(a1.x); m[2] = w0 * bflo(a0.y) + w1 * bflo(a1.y); m[3] = w0 * bfhi(a0.y) + w1 * bfhi(a1.y);
            v[j] = x + g * m; ss += v[j][0] * v[j][0] + v[j][1] * v[j][1] + v[j][2] * v[j][2] + v[j][3] * v[j][3]; }
        ss = wave_sum(ss); const float rstd = __builtin_amdgcn_rsqf(ss * (1.0f / 2048.0f) + EPS);
#pragma unroll
        for (int j = 0; j < 8; ++j) { const int cc = (j * 64 + lane) * 4; const f32x4 w = *(const f32x4*)(fw + cc); *(f32x4*)(xr + cc) = v[j] * rstd * w; }
    }
}

#ifndef N_LAUNCHES
#define N_LAUNCHES 1
#endif
constexpr int N_PHASES = 25;

template <int L>
__device__ __forceinline__ void gemm_projmix(const Ctx& c) {
    ARGS_REF a = *c.a;
    pg8::Gemm g{(const bf16_t*)(a.ws + WS_H), (const bf16_t*)(a.ws + WS_WIN + (size_t)L * WIN_BYTES), MT, NMIXP, D};
    pg8::StaticOrder S; S.init(MT, NMIXP, c.G, c.wg);
    pg8::EpiBf16S<false> E{(bf16_t*)(a.ws + WS_PMIX), NMIXP, 1.0f};
    pg8::gemm_phase<pg8::EpiBf16S<false>, pg8::StaticOrder, true, true>(c.lds + LDS_SCR, g, S, E);
}
template <int L>
__device__ __forceinline__ void gemm_gate(const Ctx& c) {
    ARGS_REF a = *c.a; constexpr int M = (L == 0) ? MT : ML;
    pg8::Gemm g{(const bf16_t*)(a.ws + WS_H8), (const bf16_t*)(a.ws + WS_WG8 + (size_t)L * WG8_BYTES), M, NGATE, D / 2};
    pg8::StaticOrder S; S.init(M, NGATE, c.G, c.wg);
    pg8::EpiBf16S<true> E{(bf16_t*)(a.ws + WS_PGATE), NGATE, 1.0f / 256.0f};
    pg8::gemm_phase8<pg8::EpiBf16S<true>, pg8::StaticOrder, true, true>(c.lds + LDS_SCR, g, S, E);
}
template <int L>
__device__ __forceinline__ void gemm_upgate(const Ctx& c) {
    ARGS_REF a = *c.a; constexpr int M = (L == 0) ? MT : ML;
    pg8::Gemm g{(const bf16_t*)(a.ws + WS_O), (const bf16_t*)(a.ws + WS_WUP + (size_t)L * 8388608), M, 2048, 512};
    pg8::UpGateOrder S; S.init(M, c.G, c.wg, MT / 256);
    pg8::EpiUpGate E{(const bf16_t*)(a.ws + WS_PGATE), (float*)(a.ws + WS_MACC), (bf16_t*)(a.ws + WS_MERGED), MT / 256};
    pg8::gemm_phase<pg8::EpiUpGate, pg8::UpGateOrder, true, true>(c.lds + LDS_SCR, g, S, E);
}
template <int L>
__device__ __forceinline__ void gemm_wout(const Ctx& c) {
    ARGS_REF a = *c.a; constexpr int M = (L == 0) ? MT : ML;
    pg8::Gemm g{(const bf16_t*)(a.ws + WS_MERGED), (const bf16_t*)(a.ws + WS_WOUT + (size_t)L * 8388608), M, D, D};
    pg8::StaticOrder S; S.init(M, D, c.G, c.wg);
    const float* modv = (const float*)(a.ws + WS_MOD) + (size_t)L * 3 * 12288 + 2 * 2048;
    pg8::EpiResid E{L == 0 ? a.in[I_X] : (const float*)a.out, a.out, L == 0 ? a.in[I_CTX] : (const float*)(a.ws + WS_XC), (float*)(a.ws + WS_XC), modv, L == 1 ? 1 : 0};
    pg8::gemm_phase<pg8::EpiResid, pg8::StaticOrder, true, true>(c.lds + LDS_SCR, g, S, E);
}
__device__ __forceinline__ void gemm_ffn13(const Ctx& c) {
    ARGS_REF a = *c.a;
    pg8::Gemm g{(const bf16_t*)(a.ws + WS_H), (const bf16_t*)(a.ws + WS_F13), MT, 2 * FF, D};
    pg8::StaticOrder S; S.init(MT, 2 * FF, c.G, c.wg);
    pg8::EpiSwiglu E{(bf16_t*)(a.ws + WS_HID), 2 * FF / 256};
    pg8::gemm_phase<pg8::EpiSwiglu, pg8::StaticOrder, true, true>(c.lds + LDS_SCR, g, S, E);
}
__device__ __forceinline__ void gemm_ffn2(const Ctx& c) {
    ARGS_REF a = *c.a;
    pg8::Gemm g{(const bf16_t*)(a.ws + WS_HID), (const bf16_t*)(a.ws + WS_F2), MT, D, FF};
    pg8::StaticOrder S; S.init(MT, D, c.G, c.wg);
    const float* modv = (const float*)(a.ws + WS_MOD) + (size_t)0 * 3 * 12288 + 5 * 2048;
    pg8::EpiResid E{(const float*)a.out, a.out, (const float*)(a.ws + WS_XC), (float*)(a.ws + WS_XC), modv, 0};
    pg8::gemm_phase<pg8::EpiResid, pg8::StaticOrder, true, true>(c.lds + LDS_SCR, g, S, E);
}
__device__ __forceinline__ void gemm_moe13(const Ctx& c) {
    ARGS_REF a = *c.a; const int* meta = (const int*)(a.ws + WS_CTL + CTL_META);
    int be[8];
#pragma unroll
    for (int e = 0; e < 8; ++e) be[e] = __builtin_amdgcn_readfirstlane(meta[e]);
    pg8::Gemm g{(const bf16_t*)(a.ws + WS_GATH), (const bf16_t*)(a.ws + WS_M13), MOE_ROWS, 2 * FF, D};
    pg8::MoeOrder S; S.init(be[7], 2 * FF / 256, c.G, c.wg, be);
    pg8::EpiSwiglu E{(bf16_t*)(a.ws + WS_HIDM), 2 * FF / 256};
    pg8::gemm_phase<pg8::EpiSwiglu, pg8::MoeOrder, true, true>(c.lds + LDS_SCR, g, S, E);
}
__device__ __forceinline__ void gemm_moe2(const Ctx& c) {
    ARGS_REF a = *c.a; const int* meta = (const int*)(a.ws + WS_CTL + CTL_META);
    int be[8];
#pragma unroll
    for (int e = 0; e < 8; ++e) be[e] = __builtin_amdgcn_readfirstlane(meta[e]);
    pg8::Gemm g{(const bf16_t*)(a.ws + WS_HIDM), (const bf16_t*)(a.ws + WS_M2), MOE_ROWS, D, FF};
    pg8::MoeOrder S; S.init(be[7], D / 256, c.G, c.wg, be);
    pg8::EpiPlainBf16 E{(bf16_t*)(a.ws + WS_GATH), D, D / 256};
    pg8::gemm_phase<pg8::EpiPlainBf16, pg8::MoeOrder, true, true>(c.lds + LDS_SCR, g, S, E);
}

__device__ __forceinline__ void prologue_phase(const Ctx& c) {
    ARGS_REF a = *c.a; int rot = 0;
    mod_phase(c);
    rgw_convert(c);
    for (int l = 0; l < 2; ++l) {
        conv_job<1>(c, a.in[I_WIN] + (size_t)l * D * DIN, nullptr, DIN, D, NMIXP, (bf16_t*)(a.ws + WS_WIN + (size_t)l * WIN_BYTES), rot);
        conv_job8(c, a.in[I_WIN] + (size_t)l * D * DIN + NMIX, DIN, D, NGATE, (unsigned char*)(a.ws + WS_WG8 + (size_t)l * WG8_BYTES), 64.0f, rot);
        for (int b = 0; b < 4; ++b) conv_job<0>(c, a.in[I_WUP] + (size_t)(l * 4 + b) * 512 * D, nullptr, D, 512, D, (bf16_t*)(a.ws + WS_WUP + (size_t)l * 8388608 + (size_t)b * 2048 * 512 * 2), rot);
        conv_job<0>(c, a.in[I_WOUT] + (size_t)l * D * D, nullptr, D, D, D, (bf16_t*)(a.ws + WS_WOUT + (size_t)l * 8388608), rot);
    }
    conv_job<2>(c, a.in[I_F1], a.in[I_F3], FF, D, 2 * FF, (bf16_t*)(a.ws + WS_F13), rot);
    conv_job<0>(c, a.in[I_F2], nullptr, D, FF, D, (bf16_t*)(a.ws + WS_F2), rot);
}
__device__ __forceinline__ void moeconv_phase(const Ctx& c) {
    ARGS_REF a = *c.a; int rot = 0;
    for (int e = 0; e < 8; ++e) {
        conv_job<2>(c, a.in[I_M1] + (size_t)e * D * FF, a.in[I_M3] + (size_t)e * D * FF, FF, D, 2 * FF, (bf16_t*)(a.ws + WS_M13 + (size_t)e * 46137344), rot);
        conv_job<0>(c, a.in[I_M2] + (size_t)e * FF * D, nullptr, D, FF, D, (bf16_t*)(a.ws + WS_M2 + (size_t)e * 23068672), rot);
    }
}

template <int L>
__device__ __forceinline__ void gemm_gate_test(const Ctx& c) {
    ARGS_REF a = *c.a; constexpr int M = (L == 0) ? MT : ML;
    pg8::Gemm g{(const bf16_t*)(a.ws + WS_H8), (const bf16_t*)(a.ws + WS_WG8 + (size_t)L * WG8_BYTES), M, NGATE, D / 2};
    pg8::StaticOrder S; S.init(M, NGATE, c.G, c.wg);
    pg8::EpiBf16S<false> E{(bf16_t*)(a.ws + WS_PGATE), NGATE, 1.0f / 256.0f};
    pg8::gemm_phase8<pg8::EpiBf16S<false>, pg8::StaticOrder, true, true>(c.lds + LDS_SCR, g, S, E);
}

__global__ void __launch_bounds__(512, 2) fwd_kernel(Args args) {
    extern __shared__ __attribute__((aligned(16))) unsigned char lds_raw[];
    volatile LAS unsigned* misc = (volatile LAS unsigned*)((LAS unsigned char*)lds_raw + LDS_MISC);
    if (threadIdx.x < 16) misc[threadIdx.x] = 0u;
    __syncthreads();
    const int lo = args.ph_lo, hi = args.ph_hi;
    XcdBarrier bar; bar.bar = (unsigned*)(args.ws + WS_CTL + CTL_BAR); bar.x = 0; bar.st = misc;
    if (hi - lo > 1) bar = xcd_barrier_post((unsigned*)(args.ws + WS_CTL + CTL_BAR), misc);
#define IN(k) (lo <= (k) && (k) < hi)
#define MKCTX Ctx c; { int t_ = threadIdx.x; asm volatile("" : "+v"(t_)); { ArgsP kp_ = (ArgsP)__builtin_amdgcn_kernarg_segment_ptr(); asm volatile("" : "+s"(kp_)); c.a = kp_; } c.lds = (LAS unsigned char*)lds_raw; c.tid = t_; c.lane = t_ & 63; c.wave = __builtin_amdgcn_readfirstlane(t_ >> 6); c.wg = blockIdx.x; c.G = gridDim.x; }
#ifndef PROBE_MASK
#define PROBE_MASK 0u
#endif
#define REP(k, ...) if ((PROBE_MASK >> (k)) & 1u) { __syncthreads(); __VA_ARGS__; }
#define SEAM(k) do { if (IN(k) && IN((k) + 1)) xcd_barrier(bar); } while (0)
    if (IN(0)) { MKCTX prologue_phase(c); REP(0, prologue_phase(c)) } SEAM(0);
    if (IN(1)) { MKCTX norm_phase<0, 0>(c); REP(1, norm_phase<0, 0>(c)) } SEAM(1);
    if (IN(2)) { MKCTX gemm_projmix<0>(c); REP(2, gemm_projmix<0>(c)) } SEAM(2);
    if (IN(3)) { MKCTX intra_phase<0>(c); REP(3, intra_phase<0>(c)) } SEAM(3);
    if (IN(4)) { MKCTX chains_phase<0>(c); REP(4, chains_phase<0>(c)) } SEAM(4);
    if (IN(5)) { MKCTX combine_phase<0>(c); REP(5, combine_phase<0>(c)) } SEAM(5);
    if (IN(6)) { MKCTX gemm_gate<0>(c); REP(6, gemm_gate<0>(c)) } SEAM(6);
    if (IN(7)) { MKCTX gemm_upgate<0>(c); REP(7, gemm_upgate<0>(c)) } SEAM(7);
    if (IN(8)) { MKCTX gemm_wout<0>(c); } SEAM(8);
    if (IN(9)) { MKCTX norm_phase<0, 1>(c); REP(9, norm_phase<0, 1>(c)) } SEAM(9);
    if (IN(10)) { MKCTX gemm_ffn13(c); REP(10, gemm_ffn13(c)) } SEAM(10);
    if (IN(11)) { MKCTX gemm_ffn2(c); } SEAM(11);
    if (IN(12)) { MKCTX norm_phase<1, 0>(c); REP(12, norm_phase<1, 0>(c)) } SEAM(12);
    if (IN(13)) { MKCTX gemm_projmix<1>(c); REP(13, gemm_projmix<1>(c)) } SEAM(13);
    if (IN(14)) { MKCTX intra_phase<1>(c); REP(14, intra_phase<1>(c)) } SEAM(14);
    if (IN(15)) { MKCTX chains_phase<1>(c); REP(15, chains_phase<1>(c)) } SEAM(15);
    if (IN(16)) { MKCTX combine_phase<1>(c); REP(16, combine_phase<1>(c)) } SEAM(16);
    if (IN(17)) { MKCTX gemm_gate<1>(c); REP(17, gemm_gate<1>(c)) } SEAM(17);
    if (IN(18)) { MKCTX gemm_upgate<1>(c); REP(18, gemm_upgate<1>(c)) } SEAM(18);
    if (IN(19)) { MKCTX gemm_wout<1>(c); } SEAM(19);
    if (IN(20)) { MKCTX route1_phase(c); __syncthreads(); moeconv_phase(c); REP(20, route1_phase(c); __syncthreads(); moeconv_phase(c)) } SEAM(20);
    if (IN(21)) { MKCTX route2_phase(c); REP(21, route2_phase(c)) } SEAM(21);
    if (IN(22)) { MKCTX gemm_moe13(c); REP(22, gemm_moe13(c)) } SEAM(22);
    if (IN(23)) { MKCTX gemm_moe2(c); REP(23, gemm_moe2(c)) } SEAM(23);
    if (IN(24)) { MKCTX final_phase(c); }
#undef IN
#undef SEAM
}

extern "C" void kernel_launch(void* const* d_in, const int* in_sizes, int n_in, void* d_out, int out_size, void* d_ws, size_t ws_size, hipStream_t stream) {
    static int grid = 0;
    if (grid == 0) {
        if (n_in != N_IN || out_size != ML * D || ws_size < WS_END) { fprintf(stderr, "kernel_launch: unexpected shapes: n_in %d out %d ws %zu (need %zu)\n", n_in, out_size, ws_size, (size_t)WS_END); grid = -1; return; }
        int dev = 0, cus = 0;
        if (hipGetDevice(&dev) != hipSuccess || hipDeviceGetAttribute(&cus, hipDeviceAttributeMultiprocessorCount, dev) != hipSuccess) { grid = -1; return; }
        if (hipFuncSetAttribute((const void*)fwd_kernel, hipFuncAttributeMaxDynamicSharedMemorySize, LDS_BYTES) != hipSuccess) { fprintf(stderr, "kernel_launch: hipFuncSetAttribute failed\n"); grid = -1; return; }
        int per_cu = 0;
        if (hipOccupancyMaxActiveBlocksPerMultiprocessor(&per_cu, (const void*)fwd_kernel, 512, LDS_BYTES) != hipSuccess || per_cu < 1) { fprintf(stderr, "kernel_launch: occupancy query says %d\n", per_cu); }
        (void)hipGetLastError();
        grid = cus > 256 ? 256 : cus;
    }
    if (grid < 0) return;
    (void)hipMemsetAsync((char*)d_ws + WS_CTL, 0, CTL_BYTES, stream);
    Args a{};
    for (int i = 0; i < N_IN; ++i) a.in[i] = (const float*)d_in[i];
    a.out = (float*)d_out; a.ws = (unsigned char*)d_ws;
#if N_LAUNCHES == 1
    a.ph_lo = 0; a.ph_hi = N_PHASES;
    hipLaunchKernelGGL(fwd_kernel, dim3(grid), dim3(512), LDS_BYTES, stream, a);
#else
    for (int p = 0; p < N_PHASES; ++p) { a.ph_lo = p; a.ph_hi = p + 1; hipLaunchKernelGGL(fwd_kernel, dim3(grid), dim3(512), LDS_BYTES, stream, a); }
#endif
}
```

```cpp
#include <hip/hip_runtime.h>
#include <cstdio>
#include <cstdint>
#define N_LAUNCHES 1
namespace pg8 {
#define PG8_LAS __attribute__((address_space(3)))
typedef unsigned short bf16_t;
typedef short bf16x8 __attribute__((ext_vector_type(8)));
typedef float f32x4 __attribute__((ext_vector_type(4)));
typedef unsigned u32x4 __attribute__((ext_vector_type(4)));
constexpr int BM = 256, BK = 64, HALF = 128, HTB = HALF * BK * 2  , STAGE_BYTES = 8 * HTB, NXCD = 8, WGM = 8;

__host__ __device__ __forceinline__ int lds_byte(int r, int c) { const int st = (r >> 4) * 2 + (c >> 5), rr = r & 15, cc = c & 31, ob = rr * 64 + cc * 2; return st * 1024 + (ob ^ (((ob >> 9) & 1) << 5)); }
__host__ __device__ __forceinline__ void stage_rc(int b, int& R, int& C) { const int st = b / 1024, sb = b % 1024, swz = sb ^ (((sb >> 9) & 1) << 5); R = (st >> 1) * 16 + swz / 64; C = (st & 1) * 32 + (swz % 64) / 2; }
__host__ __device__ __forceinline__ int perm32(int rho) { const int n = rho >> 4, i = rho & 15; return 8 * (i >> 2) + 4 * n + (i & 3); }

struct Unit { int pm, pn; };
struct Gemm { const bf16_t* A; const bf16_t* Bt; int M, N, K; };

struct StaticOrder {
    int nM, nN, nwg, G, c;
    __host__ __device__ void init(int M, int N, int G_, int c_) { nM = M / BM; nN = N / BM; nwg = nM * nN; G = G_; c = c_; }
    __host__ __device__ bool next(int i, Unit& u) const {
        const long L = (long)i * G + c; if (L >= nwg) return false;
        int wgid = (int)L; { const int q = nwg / NXCD, r = nwg % NXCD, xcd = wgid % NXCD, off = wgid / NXCD; wgid = (xcd < r ? xcd * (q + 1) : r * (q + 1) + (xcd - r) * q) + off; }
        const int nig = WGM * nN, gid = wgid / nig, fm = gid * WGM, gsz = (nM - fm) < WGM ? (nM - fm) : WGM;
        u.pm = fm + ((wgid % nig) % gsz); u.pn = (wgid % nig) / gsz; return true;
    }
    __device__ __forceinline__ void a_ready(const Unit&) const {}
    __device__ __forceinline__ void done(const Unit&) const {}
};
__device__ __forceinline__ unsigned cvt_pk_bf16(float lo, float hi) { unsigned r; asm volatile("v_cvt_pk_bf16_f32 %0, %1, %2" : "=v"(r) : "v"(lo), "v"(hi)); return r; }
typedef __bf16 bf16x2_t __attribute__((ext_vector_type(2)));
typedef float f32x2c_t __attribute__((ext_vector_type(2)));
__device__ __forceinline__ unsigned cvt_pk_bf16_safe(float lo, float hi) { const f32x2c_t v = {lo, hi}; return __builtin_bit_cast(unsigned, __builtin_convertvector(v, bf16x2_t)); }
template <class Epi, class Sched, bool ALIGN_EPI = false, bool SP2 = false>
__device__ __forceinline__ void gemm_phase(PG8_LAS unsigned char* lds, const Gemm g, const Sched& S, const Epi& E) {
    int tid_ = threadIdx.x; asm volatile("" : "+v"(tid_));
    const int tid = tid_, wid = __builtin_amdgcn_readfirstlane(tid >> 6), lane = tid & 63, wr = wid >> 2, wc = wid & 3, fr = lane & 15, fq = lane >> 4;
    const int K = g.K, nt = K / BK;
    unsigned voffA[2], voffB[2];
#pragma unroll
    for (int i = 0; i < 2; ++i) { int R, C; stage_rc(tid * 16 + i * 8192, R, C); const int Rb = Epi::PERM ? ((R & ~31) + perm32(R & 31)) : R;
        voffA[i] = (unsigned)(R * K + C) * 2u; voffB[i] = (unsigned)(Rb * K + C) * 2u; }
    const size_t kstep = (size_t)(BK * 2);
    const size_t hstep = (size_t)HALF * K * 2;
    const size_t tstep = 2 * hstep;
    const unsigned ldsw = (unsigned)wid * 1024u;
    const int aoff = lds_byte(wr * 64 + fr, fq * 8), boff = lds_byte(wc * 32 + fr, fq * 8);
#define PG8_SA(b, h) (((b) * 2 + (h)) * HTB)
#define PG8_SB(b, h) ((4 + (b) * 2 + (h)) * HTB)
#define PG8_STAGE(bufoff, gbase, voff) do { _Pragma("unroll") for (int _i = 0; _i < 2; ++_i) \
        __builtin_amdgcn_global_load_lds((const unsigned*)((const char*)(gbase) + (voff)[_i]), (PG8_LAS unsigned*)(lds + (bufoff) + ldsw + _i * 8192), 16, 0, 0); } while (0)
#define PG8_LDA(dst, b, h) do { _Pragma("unroll") for (int m = 0; m < 4; ++m) _Pragma("unroll") for (int k = 0; k < 2; ++k) dst[m][k] = *(const PG8_LAS bf16x8*)(lds + PG8_SA(b, h) + aoff + m * 2048 + k * 1024); } while (0)
#define PG8_LDB(dst, b, h) do { _Pragma("unroll") for (int n = 0; n < 2; ++n) _Pragma("unroll") for (int k = 0; k < 2; ++k) dst[n][k] = *(const PG8_LAS bf16x8*)(lds + PG8_SB(b, h) + boff + n * 2048 + k * 1024); } while (0)
#define PG8_MMA(ai, bj, At, Bt) do { __builtin_amdgcn_s_setprio(1); _Pragma("unroll") for (int m = 0; m < 4; ++m) _Pragma("unroll") for (int n = 0; n < 2; ++n) _Pragma("unroll") for (int k = 0; k < 2; ++k) \
        acc[ai][bj][m][n] = __builtin_amdgcn_mfma_f32_16x16x32_bf16(Bt[n][k], At[m][k], acc[ai][bj][m][n], 0, 0, 0); __builtin_amdgcn_s_setprio(0); } while (0)
#define PG8_WAIT_V(n) asm volatile("s_waitcnt vmcnt(" #n ")" ::: "memory")
#define PG8_WAIT_L(n) asm volatile("s_waitcnt lgkmcnt(" #n ")" ::: "memory")
#define PG8_BAR __builtin_amdgcn_s_barrier()
#define PG8_SCHED __builtin_amdgcn_sched_barrier(0)
    Unit cur, nxt; int ui = 0;
    if (!S.next(0, cur)) return;
    f32x4 acc[2][2][4][2];
#pragma unroll
    for (int a = 0; a < 2; ++a)
#pragma unroll
        for (int b = 0; b < 2; ++b)
#pragma unroll
            for (int m = 0; m < 4; ++m)
#pragma unroll
                for (int n = 0; n < 2; ++n) acc[a][b][m][n] = (f32x4){0.f, 0.f, 0.f, 0.f};
    bf16x8 At[4][2], B0[2][2], B1[2][2];
    const char* cA = (const char*)g.A + (size_t)cur.pm * tstep; const char* cB = (const char*)g.Bt + (size_t)cur.pn * tstep;
    S.a_ready(cur);
    if constexpr (SP2) {
        PG8_STAGE(PG8_SB(0, 0), cB, voffB); PG8_STAGE(PG8_SB(0, 1), cB + hstep, voffB); PG8_STAGE(PG8_SA(0, 0), cA, voffA); PG8_STAGE(PG8_SA(0, 1), cA + hstep, voffA);
        if (wr == 1) PG8_BAR;
        PG8_WAIT_V(2); PG8_BAR;
        PG8_STAGE(PG8_SB(1, 0), cB + kstep, voffB); PG8_STAGE(PG8_SA(1, 0), cA + kstep, voffA); PG8_STAGE(PG8_SB(1, 1), cB + hstep + kstep, voffB);
        PG8_WAIT_V(6); PG8_BAR;
    } else {
        PG8_STAGE(PG8_SB(0, 0), cB, voffB); PG8_STAGE(PG8_SA(0, 0), cA, voffA); PG8_STAGE(PG8_SB(0, 1), cB + hstep, voffB); PG8_STAGE(PG8_SA(0, 1), cA + hstep, voffA);
        if (wr == 1) PG8_BAR;
        PG8_WAIT_V(4); PG8_BAR;
        PG8_STAGE(PG8_SB(1, 0), cB + kstep, voffB); PG8_STAGE(PG8_SA(1, 0), cA + kstep, voffA); PG8_STAGE(PG8_SB(1, 1), cB + hstep + kstep, voffB);
        PG8_WAIT_V(6); PG8_BAR;
    }
    for (;;) {
        const bool has_next = S.next(ui + 1, nxt);
        const char* nA = has_next ? (const char*)g.A + (size_t)nxt.pm * tstep : cA; const char* nB = has_next ? (const char*)g.Bt + (size_t)nxt.pn * tstep : cB;
        for (int t = 0; t < nt; t += 2) {
            const bool last = (t == nt - 2);
            const char* a1 = cA + (size_t)(t + 1) * kstep;
            const char* a2 = last ? nA : cA + (size_t)(t + 2) * kstep; const char* b2 = last ? nB : cB + (size_t)(t + 2) * kstep;
            const char* a3 = a2 + kstep; const char* b3 = b2 + kstep;
            if (last && has_next) S.a_ready(nxt);
            if constexpr (SP2) {
            PG8_LDB(B0, 0, 0); PG8_LDB(B1, 0, 1); PG8_SCHED; PG8_LDA(At, 0, 0); PG8_STAGE(PG8_SA(1, 1), a1 + hstep, voffA);
            PG8_WAIT_V(8); PG8_WAIT_L(0); PG8_BAR; PG8_MMA(0, 0, At, B0); PG8_MMA(0, 1, At, B1); PG8_BAR; PG8_SCHED;
            PG8_LDA(At, 0, 1); PG8_STAGE(PG8_SB(0, 0), b2, voffB); PG8_STAGE(PG8_SB(0, 1), b2 + hstep, voffB); PG8_STAGE(PG8_SA(0, 0), a2, voffA);
            PG8_WAIT_V(8); PG8_WAIT_L(0); PG8_BAR; PG8_MMA(1, 0, At, B0); PG8_MMA(1, 1, At, B1); PG8_BAR; PG8_SCHED;
            PG8_LDB(B0, 1, 0); PG8_LDB(B1, 1, 1); PG8_SCHED; PG8_LDA(At, 1, 0); PG8_STAGE(PG8_SA(0, 1), a2 + hstep, voffA);
            PG8_WAIT_V(8); PG8_WAIT_L(0); PG8_BAR; PG8_MMA(0, 0, At, B0); PG8_MMA(0, 1, At, B1); PG8_BAR; PG8_SCHED;
            PG8_LDA(At, 1, 1); PG8_STAGE(PG8_SB(1, 0), b3, voffB); PG8_STAGE(PG8_SB(1, 1), b3 + hstep, voffB); PG8_STAGE(PG8_SA(1, 0), a3, voffA);
            PG8_WAIT_V(8); PG8_WAIT_L(0); PG8_BAR; PG8_MMA(1, 0, At, B0); PG8_MMA(1, 1, At, B1); PG8_BAR; PG8_SCHED;
            } else {
            PG8_LDB(B0, 0, 0); PG8_SCHED; PG8_LDA(At, 0, 0); PG8_STAGE(PG8_SA(1, 1), a1 + hstep, voffA);
            PG8_WAIT_L(8); PG8_BAR; PG8_WAIT_L(0); PG8_MMA(0, 0, At, B0); PG8_BAR; PG8_SCHED;
            PG8_LDB(B1, 0, 1); PG8_STAGE(PG8_SB(0, 0), b2, voffB);
            PG8_BAR; PG8_WAIT_L(0); PG8_MMA(0, 1, At, B1); PG8_BAR;
            PG8_LDA(At, 0, 1); PG8_STAGE(PG8_SA(0, 0), a2, voffA);
            PG8_BAR; PG8_WAIT_L(0); PG8_MMA(1, 0, At, B0); PG8_BAR; PG8_SCHED;
            PG8_STAGE(PG8_SB(0, 1), b2 + hstep, voffB);
            PG8_WAIT_V(6); PG8_BAR; PG8_MMA(1, 1, At, B1); PG8_BAR;
            PG8_LDB(B0, 1, 0); PG8_SCHED; PG8_LDA(At, 1, 0); PG8_STAGE(PG8_SA(0, 1), a2 + hstep, voffA);
            PG8_WAIT_L(8); PG8_BAR; PG8_WAIT_L(0); PG8_MMA(0, 0, At, B0); PG8_BAR; PG8_SCHED;
            PG8_LDB(B1, 1, 1); PG8_STAGE(PG8_SB(1, 0), b3, voffB);
            PG8_BAR; PG8_WAIT_L(0); PG8_MMA(0, 1, At, B1); PG8_BAR;
            PG8_LDA(At, 1, 1); PG8_STAGE(PG8_SA(1, 0), a3, voffA);
            PG8_BAR; PG8_WAIT_L(0); PG8_MMA(1, 0, At, B0); PG8_BAR; PG8_SCHED;
            PG8_STAGE(PG8_SB(1, 1), b3 + hstep, voffB);
            PG8_WAIT_V(6); PG8_BAR; PG8_MMA(1, 1, At, B1); PG8_BAR;
            }
        }
        if constexpr (ALIGN_EPI) { if (wr == 0) PG8_BAR; }
        if constexpr (!Epi::AFTER_DRAIN) { E(acc, cur, wr, wc, fr, fq); S.done(cur); }
        if (!has_next) break;
#pragma unroll
        for (int a = 0; a < 2; ++a)
#pragma unroll
            for (int b = 0; b < 2; ++b)
#pragma unroll
                for (int m = 0; m < 4; ++m)
#pragma unroll
                    for (int n = 0; n < 2; ++n) acc[a][b][m][n] = (f32x4){0.f, 0.f, 0.f, 0.f};
        cur = nxt; cA = nA; cB = nB; ++ui;
        if constexpr (ALIGN_EPI) { if (wr == 1) PG8_BAR; }
    }
    PG8_WAIT_V(0);
    if constexpr (!ALIGN_EPI) { if (wr == 0) PG8_BAR; }
    PG8_BAR;
    if constexpr (Epi::AFTER_DRAIN) { E.fused(acc, cur, wr, wc, fr, fq, lds, wid, lane); S.done(cur); }
#undef PG8_SA
#undef PG8_SB
#undef PG8_STAGE
#undef PG8_LDA
#undef PG8_LDB
#undef PG8_MMA
#undef PG8_WAIT_V
#undef PG8_WAIT_L
#undef PG8_BAR
#undef PG8_SCHED
}

typedef int i32x4 __attribute__((ext_vector_type(4)));
typedef int i32x8 __attribute__((ext_vector_type(8)));
template <class Epi, class Sched, bool ALIGN_EPI = false, bool SP2 = false>
__device__ __forceinline__ void gemm_phase8(PG8_LAS unsigned char* lds, const Gemm g, const Sched& S, const Epi& E) {
    int tid_ = threadIdx.x; asm volatile("" : "+v"(tid_));
    const int tid = tid_, wid = __builtin_amdgcn_readfirstlane(tid >> 6), lane = tid & 63, wr = wid >> 2, wc = wid & 3, fr = lane & 15, fq = lane >> 4;
    const int K = g.K, nt = K / BK;
    unsigned voffA[2], voffB[2];
#pragma unroll
    for (int i = 0; i < 2; ++i) { int R, C; stage_rc(tid * 16 + i * 8192, R, C); const int Rb = Epi::PERM ? ((R & ~31) + perm32(R & 31)) : R;
        voffA[i] = (unsigned)(R * K + C) * 2u; voffB[i] = (unsigned)(Rb * K + C) * 2u; }
    const size_t kstep = (size_t)(BK * 2);
    const size_t hstep = (size_t)HALF * K * 2;
    const size_t tstep = 2 * hstep;
    const unsigned ldsw = (unsigned)wid * 1024u;
    const int aoff = lds_byte(wr * 64 + fr, fq * 8), boff = lds_byte(wc * 32 + fr, fq * 8);
#define PG8_SA(b, h) (((b) * 2 + (h)) * HTB)
#define PG8_SB(b, h) ((4 + (b) * 2 + (h)) * HTB)
#define PG8_STAGE(bufoff, gbase, voff) do { _Pragma("unroll") for (int _i = 0; _i < 2; ++_i) \
        __builtin_amdgcn_global_load_lds((const unsigned*)((const char*)(gbase) + (voff)[_i]), (PG8_LAS unsigned*)(lds + (bufoff) + ldsw + _i * 8192), 16, 0, 0); } while (0)
#define PG8_LD8(addr) __builtin_shufflevector(__builtin_bit_cast(i32x4, *(const PG8_LAS bf16x8*)(addr)), __builtin_bit_cast(i32x4, *(const PG8_LAS bf16x8*)((addr) + 1024)), 0, 1, 2, 3, 4, 5, 6, 7)
#define PG8_LDA(dst, b, h) do { _Pragma("unroll") for (int m = 0; m < 4; ++m) dst[m] = PG8_LD8(lds + PG8_SA(b, h) + aoff + m * 2048); } while (0)
#define PG8_LDB(dst, b, h) do { _Pragma("unroll") for (int n = 0; n < 2; ++n) dst[n] = PG8_LD8(lds + PG8_SB(b, h) + boff + n * 2048); } while (0)
#define PG8_MMA(ai, bj, At, Bt) do { __builtin_amdgcn_s_setprio(1); _Pragma("unroll") for (int m = 0; m < 4; ++m) _Pragma("unroll") for (int n = 0; n < 2; ++n) \
        asm volatile("v_mfma_f32_16x16x128_f8f6f4 %0, %1, %2, %0" : "+v"(acc[ai][bj][m][n]) : "v"(Bt[n]), "v"(At[m])); __builtin_amdgcn_s_setprio(0); } while (0)
#define PG8_WAIT_V(n) asm volatile("s_waitcnt vmcnt(" #n ")" ::: "memory")
#define PG8_WAIT_L(n) asm volatile("s_waitcnt lgkmcnt(" #n ")" ::: "memory")
#define PG8_BAR __builtin_amdgcn_s_barrier()
#define PG8_SCHED __builtin_amdgcn_sched_barrier(0)
    Unit cur, nxt; int ui = 0;
    if (!S.next(0, cur)) return;
    f32x4 acc[2][2][4][2];
#pragma unroll
    for (int a = 0; a < 2; ++a)
#pragma unroll
        for (int b = 0; b < 2; ++b)
#pragma unroll
            for (int m = 0; m < 4; ++m)
#pragma unroll
                for (int n = 0; n < 2; ++n) acc[a][b][m][n] = (f32x4){0.f, 0.f, 0.f, 0.f};
    i32x8 At[4], B0[2], B1[2];
    const char* cA = (const char*)g.A + (size_t)cur.pm * tstep; const char* cB = (const char*)g.Bt + (size_t)cur.pn * tstep;
    S.a_ready(cur);
    if constexpr (SP2) {
        PG8_STAGE(PG8_SB(0, 0), cB, voffB); PG8_STAGE(PG8_SB(0, 1), cB + hstep, voffB); PG8_STAGE(PG8_SA(0, 0), cA, voffA); PG8_STAGE(PG8_SA(0, 1), cA + hstep, voffA);
        if (wr == 1) PG8_BAR;
        PG8_WAIT_V(2); PG8_BAR;
        PG8_STAGE(PG8_SB(1, 0), cB + kstep, voffB); PG8_STAGE(PG8_SA(1, 0), cA + kstep, voffA); PG8_STAGE(PG8_SB(1, 1), cB + hstep + kstep, voffB);
        PG8_WAIT_V(6); PG8_BAR;
    } else {
        PG8_STAGE(PG8_SB(0, 0), cB, voffB); PG8_STAGE(PG8_SA(0, 0), cA, voffA); PG8_STAGE(PG8_SB(0, 1), cB + hstep, voffB); PG8_STAGE(PG8_SA(0, 1), cA + hstep, voffA);
        if (wr == 1) PG8_BAR;
        PG8_WAIT_V(4); PG8_BAR;
        PG8_STAGE(PG8_SB(1, 0), cB + kstep, voffB); PG8_STAGE(PG8_SA(1, 0), cA + kstep, voffA); PG8_STAGE(PG8_SB(1, 1), cB + hstep + kstep, voffB);
        PG8_WAIT_V(6); PG8_BAR;
    }
    for (;;) {
        const bool has_next = S.next(ui + 1, nxt);
        const char* nA = has_next ? (const char*)g.A + (size_t)nxt.pm * tstep : cA; const char* nB = has_next ? (const char*)g.Bt + (size_t)nxt.pn * tstep : cB;
        for (int t = 0; t < nt; t += 2) {
            const bool last = (t == nt - 2);
            const char* a1 = cA + (size_t)(t + 1) * kstep;
            const char* a2 = last ? nA : cA + (size_t)(t + 2) * kstep; const char* b2 = last ? nB : cB + (size_t)(t + 2) * kstep;
            const char* a3 = a2 + kstep; const char* b3 = b2 + kstep;
            if (last && has_next) S.a_ready(nxt);
            if constexpr (SP2) {
            PG8_LDB(B0, 0, 0); PG8_LDB(B1, 0, 1); PG8_SCHED; PG8_LDA(At, 0, 0); PG8_STAGE(PG8_SA(1, 1), a1 + hstep, voffA);
            PG8_WAIT_V(8); PG8_WAIT_L(0); PG8_BAR; PG8_MMA(0, 0, At, B0); PG8_MMA(0, 1, At, B1); PG8_BAR; PG8_SCHED;
            PG8_LDA(At, 0, 1); PG8_STAGE(PG8_SB(0, 0), b2, voffB); PG8_STAGE(PG8_SB(0, 1), b2 + hstep, voffB); PG8_STAGE(PG8_SA(0, 0), a2, voffA);
            PG8_WAIT_V(8); PG8_WAIT_L(0); PG8_BAR; PG8_MMA(1, 0, At, B0); PG8_MMA(1, 1, At, B1); PG8_BAR; PG8_SCHED;
            PG8_LDB(B0, 1, 0); PG8_LDB(B1, 1, 1); PG8_SCHED; PG8_LDA(At, 1, 0); PG8_STAGE(PG8_SA(0, 1), a2 + hstep, voffA);
            PG8_WAIT_V(8); PG8_WAIT_L(0); PG8_BAR; PG8_MMA(0, 0, At, B0); PG8_MMA(0, 1, At, B1); PG8_BAR; PG8_SCHED;
            PG8_LDA(At, 1, 1); PG8_STAGE(PG8_SB(1, 0), b3, voffB); PG8_STAGE(PG8_SB(1, 1), b3 + hstep, voffB); PG8_STAGE(PG8_SA(1, 0), a3, voffA);
            PG8_WAIT_V(8); PG8_WAIT_L(0); PG8_BAR; PG8_MMA(1, 0, At, B0); PG8_MMA(1, 1, At, B1); PG8_BAR; PG8_SCHED;
            } else {
            PG8_LDB(B0, 0, 0); PG8_SCHED; PG8_LDA(At, 0, 0); PG8_STAGE(PG8_SA(1, 1), a1 + hstep, voffA);
            PG8_WAIT_L(8); PG8_BAR; PG8_WAIT_L(0); PG8_MMA(0, 0, At, B0); PG8_BAR; PG8_SCHED;
            PG8_LDB(B1, 0, 1); PG8_STAGE(PG8_SB(0, 0), b2, voffB);
            PG8_BAR; PG8_WAIT_L(0); PG8_MMA(0, 1, At, B1); PG8_BAR;
            PG8_LDA(At, 0, 1); PG8_STAGE(PG8_SA(0, 0), a2, voffA);
            PG8_BAR; PG8_WAIT_L(0); PG8_MMA(1, 0, At, B0); PG8_BAR; PG8_SCHED;
            PG8_STAGE(PG8_SB(0, 1), b2 + hstep, voffB);
            PG8_WAIT_V(6); PG8_BAR; PG8_MMA(1, 1, At, B1); PG8_BAR;
            PG8_LDB(B0, 1, 0); PG8_SCHED; PG8_LDA(At, 1, 0); PG8_STAGE(PG8_SA(0, 1), a2 + hstep, voffA);
            PG8_WAIT_L(8); PG8_BAR; PG8_WAIT_L(0); PG8_MMA(0, 0, At, B0); PG8_BAR; PG8_SCHED;
            PG8_LDB(B1, 1, 1); PG8_STAGE(PG8_SB(1, 0), b3, voffB);
            PG8_BAR; PG8_WAIT_L(0); PG8_MMA(0, 1, At, B1); PG8_BAR;
            PG8_LDA(At, 1, 1); PG8_STAGE(PG8_SA(1, 0), a3, voffA);
            PG8_BAR; PG8_WAIT_L(0); PG8_MMA(1, 0, At, B0); PG8_BAR; PG8_SCHED;
            PG8_STAGE(PG8_SB(1, 1), b3 + hstep, voffB);
            PG8_WAIT_V(6); PG8_BAR; PG8_MMA(1, 1, At, B1); PG8_BAR;
            }
        }
        if constexpr (ALIGN_EPI) { if (wr == 0) PG8_BAR; }
        asm volatile("s_nop 15\n\ts_nop 15" ::: "memory");
        if constexpr (!Epi::AFTER_DRAIN) { E(acc, cur, wr, wc, fr, fq); S.done(cur); }
        if (!has_next) break;
#pragma unroll
        for (int a = 0; a < 2; ++a)
#pragma unroll
            for (int b = 0; b < 2; ++b)
#pragma unroll
                for (int m = 0; m < 4; ++m)
#pragma unroll
                    for (int n = 0; n < 2; ++n) acc[a][b][m][n] = (f32x4){0.f, 0.f, 0.f, 0.f};
        cur = nxt; cA = nA; cB = nB; ++ui;
        if constexpr (ALIGN_EPI) { if (wr == 1) PG8_BAR; }
    }
    PG8_WAIT_V(0);
    if constexpr (!ALIGN_EPI) { if (wr == 0) PG8_BAR; }
    PG8_BAR;
    if constexpr (Epi::AFTER_DRAIN) { E.fused(acc, cur, wr, wc, fr, fq, lds, wid, lane); S.done(cur); }
#undef PG8_SA
#undef PG8_SB
#undef PG8_STAGE
#undef PG8_LD8
#undef PG8_LDA
#undef PG8_LDB
#undef PG8_MMA
#undef PG8_WAIT_V
#undef PG8_WAIT_L
#undef PG8_BAR
#undef PG8_SCHED
}
}
#define XB_TMO      128
#define XB_XCNT(j)  (256  + 64 * (j))
#define XB_XSUB(j)  (1280 + 64 * (j))
#define XB_XGEN(j)  (2304 + 64 * (j))
#define XB_TOP      3328
#define XB_TOPGEN   3392
#define XCD_BAR_WORDS 3456
#define XB_SPIN_CAP (1u << 18)
#define LAS __attribute__((address_space(3)))

__device__ __forceinline__ unsigned xb_ld(unsigned* p)              { return __hip_atomic_load(p, __ATOMIC_RELAXED, __HIP_MEMORY_SCOPE_AGENT); }
__device__ __forceinline__ unsigned xb_add(unsigned* p, unsigned v) { return __hip_atomic_fetch_add(p, v, __ATOMIC_RELAXED, __HIP_MEMORY_SCOPE_AGENT); }
__device__ __forceinline__ unsigned xb_xcc_id() { return (unsigned)__builtin_amdgcn_s_getreg((3 << 11) | 20) & 0xFu; }
#define XB_SPIN(cond, bar) do { unsigned _sp = 0; while (cond) { __builtin_amdgcn_s_sleep(1); \
    if ((++_sp & 255u) == 0u) { if (xb_ld(&(bar)[XB_TMO])) break; if (_sp > XB_SPIN_CAP) { atomicAdd(&(bar)[XB_TMO], 1u); break; } } } } while (0)

struct XcdBarrier {
    unsigned* bar; unsigned x;
    volatile LAS unsigned* st;
};

__device__ __forceinline__ XcdBarrier xcd_barrier_post(unsigned* bar, volatile LAS unsigned* st) {
    XcdBarrier b; b.bar = bar; b.x = xb_xcc_id(); b.st = st;
    if (threadIdx.x == 0) (void)xb_add(&bar[XB_XCNT(b.x)], 1u);
    return b;
}
__device__ __forceinline__ void xcd_barrier_complete(unsigned* bar, unsigned x, unsigned& nloc, unsigned& nx) {
    const unsigned G = gridDim.x * gridDim.y * gridDim.z;
    unsigned sum, cnt, mine, sp = 0u;
    for (;;) {
        sum = 0u; cnt = 0u; mine = 0u;
#pragma unroll
        for (unsigned j = 0; j < 16; ++j) { const unsigned c = xb_ld(&bar[XB_XCNT(j)]); sum += c; cnt += (c > 0u) ? 1u : 0u; mine = (j == x) ? c : mine; }
        if (sum == G) break;
        __builtin_amdgcn_s_sleep(1);
        if ((++sp & 255u) == 0u) { if (xb_ld(&bar[XB_TMO])) break; if (sp > XB_SPIN_CAP) { atomicAdd(&bar[XB_TMO], 1u); break; } }
    }
    nloc = mine > 0u ? mine : 1u; nx = cnt > 0u ? cnt : 1u;
}

__device__ __forceinline__ void xcd_barrier(const XcdBarrier& b) {
    asm volatile("s_waitcnt vmcnt(0)" ::: "memory");
    __syncthreads();
    if (threadIdx.x == 0) {
        unsigned* bar = b.bar;
        __builtin_amdgcn_s_waitcnt(0);
        unsigned nloc = b.st[0], nx = b.st[1];
        if (nloc == 0u) { xcd_barrier_complete(bar, b.x, nloc, nx); b.st[0] = nloc; b.st[1] = nx; }
        const unsigned old = xb_add(&bar[XB_XSUB(b.x)], 1u);
        const unsigned gen = old / nloc;
        if (old + 1u == (gen + 1u) * nloc) {
            __builtin_amdgcn_fence(__ATOMIC_RELEASE, "agent");
            asm volatile("s_waitcnt vmcnt(0)" ::: "memory");
            const unsigned og = xb_add(&bar[XB_TOP], 1u);
            const unsigned tg = og / nx;
            if (og + 1u == (tg + 1u) * nx) xb_add(&bar[XB_TOPGEN], 1u);
            else XB_SPIN(xb_ld(&bar[XB_TOPGEN]) == tg, bar);
            __builtin_amdgcn_fence(__ATOMIC_ACQUIRE, "agent");
            xb_add(&bar[XB_XGEN(b.x)], 1u);
            asm volatile("s_waitcnt vmcnt(0)" ::: "memory");
        } else {
            XB_SPIN(xb_ld(&bar[XB_XGEN(b.x)]) == gen, bar);
            __builtin_amdgcn_fence(__ATOMIC_ACQUIRE, "agent");
            asm volatile("s_waitcnt vmcnt(0)" ::: "memory");
        }
    }
    __syncthreads();
}


typedef pg8::bf16_t bf16_t;
typedef pg8::f32x4 f32x4;
typedef pg8::u32x4 u32x4;
typedef unsigned u32x2 __attribute__((ext_vector_type(2)));

constexpr int D = 2048, NB = 2, T = 16384, CL = 256;
constexpr int ML = NB * T;
constexpr int MC = NB * CL;
constexpr int MT = ML + MC;
constexpr int NMIX = 7216, NMIXP = 7424, NGATE = 8192, NPROJ = NMIXP + NGATE;
constexpr int DIN = 15408;
constexpr int FF = 5632, NE = 8;
constexpr int MOE_ROWS = 67584;
constexpr int C_GLA_Q = 0, C_GLA_K = 256, C_GLA_V = 512, C_GLA_G = 1024, C_GLA_A = 1536;
constexpr int C_HG_Q = 1568, C_HG_F = 2080, C_HG_I = 3104, C_HG_G = 3616;
constexpr int C_DN_Q = 4128, C_DN_K = 4640, C_DN_V = 5152, C_DN_A = 5664, C_DN_B = 5672, C_DN_G = 5680;
constexpr int C_RG_X = 6192, C_RG_Y = 6704;
constexpr float EPS = 1e-6f;

enum { I_X = 0, I_C, I_CTX, I_CCTX, I_WMOD, I_BMOD, I_NORMW, I_FNORMW, I_WIN, I_WUP, I_WOUT, I_GLA_WA2, I_GLA_BA2, I_GLA_NW, I_HG_LB, I_HG_NW,
       I_DN_CW, I_DN_ALOG, I_DN_DTB, I_DN_NW, I_RG_CW, I_RG_CB, I_RG_WR, I_RG_BR, I_RG_WI, I_RG_BI, I_RG_LAM, I_F1, I_F3, I_F2, I_ROUTER, I_M1, I_M3, I_M2, N_IN };

constexpr size_t WS_CTL = 0, CTL_BYTES = 65536;
constexpr size_t CTL_BAR = 0, CTL_WGH = 16384, CTL_META = 24576;
constexpr size_t WS_MOD = WS_CTL + CTL_BYTES;
constexpr size_t WS_XC = WS_MOD + 294912;
constexpr size_t WS_TOPI = WS_XC + 4194304;
constexpr size_t WS_TOPW = WS_TOPI + 131072;
constexpr size_t WS_DEST = WS_TOPW + 262144;
constexpr size_t WIN_BYTES = (size_t)NMIXP * D * 2;
constexpr size_t WS_WIN = WS_DEST + 262144;
constexpr size_t WG8_BYTES = (size_t)NGATE * D;
constexpr size_t WS_WG8 = WS_WIN + 2 * WIN_BYTES;
constexpr size_t WS_WUP = WS_WG8 + 2 * WG8_BYTES;
constexpr size_t WS_WOUT = WS_WUP + 2 * 8388608;
constexpr size_t WS_F13 = WS_WOUT + 2 * 8388608;
constexpr size_t WS_F2 = WS_F13 + 46137344;
constexpr size_t WS_RGW = WS_F2 + 23068672;
constexpr size_t WS_H = WS_RGW + 1048576;
constexpr size_t WS_H8 = WS_H + 136314880;
constexpr size_t WS_BIG = WS_H8 + 68157440;
constexpr size_t WS_PMIX = WS_BIG;
constexpr size_t WS_PGATE = WS_BIG;
constexpr size_t WS_ORAW = WS_BIG + 545259520;
constexpr size_t WS_RGLA = WS_ORAW + 272629760;
constexpr size_t WS_RGU = WS_RGLA + 68157440;
constexpr size_t WS_RGTT = WS_RGU, WS_RGCARRY = WS_RGU + 4259840;
constexpr size_t WS_GC = WS_RGU + 8388608;
constexpr size_t WS_SCR = WS_GC + 136314880;
constexpr size_t SC_GLA_VT = 0, SC_GLA_QP = SC_GLA_VT + 34078720, SC_GLA_KT = SC_GLA_QP + 34078720, SC_GLA_A = SC_GLA_KT + 34078720, SC_GLA_LAM = SC_GLA_A + 34078720;
constexpr size_t SC_HG_VT = SC_GLA_LAM + 1064960, SC_HG_QP = SC_HG_VT + 34078720, SC_HG_KT = SC_HG_QP + 68157440, SC_HG_A = SC_HG_KT + 68157440, SC_HG_LAM = SC_HG_A + 34078720;
constexpr size_t SC_DN_QS = SC_HG_LAM + 2129920, SC_DN_KT = SC_DN_QS + 34078720, SC_DN_UT = SC_DN_KT + 34078720, SC_DN_WN = SC_DN_UT + 68157440, SC_DN_AQK = SC_DN_WN + 68157440, SC_DN_SC = SC_DN_AQK + 34078720;
constexpr size_t SC_END = SC_DN_SC + 4259840;
constexpr size_t WS_O = WS_SCR;
constexpr size_t WS_MACC = WS_SCR + 136314880;
constexpr size_t WS_MERGED = WS_MACC + 272629760;
constexpr size_t WS_HID = WS_BIG;
constexpr size_t WS_M13 = WS_BIG;
constexpr size_t WS_M2 = WS_M13 + 369098752;
constexpr size_t WS_GATH = WS_M2 + 184549376;
constexpr size_t WS_HIDM = WS_GATH + 276824064;
constexpr size_t WS_END_A = WS_HIDM + 761266176, WS_END_B = WS_SCR + SC_END;
constexpr size_t WS_END = WS_END_A > WS_END_B ? WS_END_A : WS_END_B;
static_assert(WS_MERGED + 136314880 <= WS_SCR + SC_END, "O, MACC, MERGED fit in the record region");
static_assert(WS_END <= 2041000000ull, "workspace budget");

constexpr int LDS_SCR = 0;
constexpr int LDS_AUX = 131072;
constexpr int LDS_MISC = 131072 + 8192;
constexpr int LDS_BYTES = 147456;

struct Args { const float* in[N_IN]; float* out; unsigned char* ws; int ph_lo, ph_hi; };

__device__ __forceinline__ float bflo(unsigned w) { return __uint_as_float(w << 16); }
__device__ __forceinline__ float bfhi(unsigned w) { return __uint_as_float(w & 0xffff0000u); }
__device__ __forceinline__ void unpack8(const u32x4 w, float (&f)[8]) { f[0] = bflo(w.x); f[1] = bfhi(w.x); f[2] = bflo(w.y); f[3] = bfhi(w.y); f[4] = bflo(w.z); f[5] = bfhi(w.z); f[6] = bflo(w.w); f[7] = bfhi(w.w); }
typedef __bf16 bfx8_t __attribute__((ext_vector_type(8)));
typedef float f32x8 __attribute__((ext_vector_type(8)));
__device__ __forceinline__ u32x4 pack8(const float (&f)[8]) { f32x8 v;
#pragma unroll
    for (int j = 0; j < 8; ++j) v[j] = f[j];
    return __builtin_bit_cast(u32x4, __builtin_convertvector(v, bfx8_t)); }
__device__ __forceinline__ unsigned pk_fp8x4(float a, float b, float c, float d) {
    a = fminf(fmaxf(a, -448.f), 448.f); b = fminf(fmaxf(b, -448.f), 448.f); c = fminf(fmaxf(c, -448.f), 448.f); d = fminf(fmaxf(d, -448.f), 448.f);
    unsigned p = __builtin_amdgcn_cvt_pk_fp8_f32(a, b, 0, false); return __builtin_amdgcn_cvt_pk_fp8_f32(c, d, p, true); }
__device__ __forceinline__ float bf1(const bf16_t* p) { return __uint_as_float(((unsigned)*p) << 16); }
__device__ __forceinline__ float sigm(float x) { return __builtin_amdgcn_rcpf(1.0f + __expf(-x)); }
__device__ __forceinline__ float siluf(float x) { return x * __builtin_amdgcn_rcpf(1.0f + __expf(-x)); }
__device__ __forceinline__ float softplusf(float x) { return fmaxf(x, 0.f) + __logf(1.0f + __expf(-fabsf(x))); }
__device__ __forceinline__ float wave_sum(float v) { v += __shfl_xor(v, 32); v += __shfl_xor(v, 16); v += __shfl_xor(v, 8); v += __shfl_xor(v, 4); v += __shfl_xor(v, 2); v += __shfl_xor(v, 1); return v; }
__device__ __forceinline__ float gelu_tanh(float y) { const float u = 0.7978845608028654f * (y + 0.044715f * y * y * y); const float e = __expf(2.f * u); const float th = 1.f - 2.f * __builtin_amdgcn_rcpf(e + 1.f); return 0.5f * y * (1.f + th); }

namespace pg8 {
template <bool SIG> struct EpiBf16S {
    static constexpr bool PERM = true, AFTER_DRAIN = false;
    bf16_t* O; int ldc; float sc;
    __device__ __forceinline__ void operator()(const f32x4 (&acc)[2][2][4][2], const Unit& u, int wr, int wc, int fr, int fq) const {
        const int row0 = u.pm * BM + wr * 64 + fr, col0 = u.pn * BM + wc * 32 + 8 * fq;
#pragma unroll
        for (int ai = 0; ai < 2; ++ai)
#pragma unroll
            for (int m = 0; m < 4; ++m) { bf16_t* rowp = O + (size_t)(row0 + ai * HALF + m * 16) * ldc + col0;
#pragma unroll
                for (int bj = 0; bj < 2; ++bj) { f32x4 v0 = acc[ai][bj][m][0], v1 = acc[ai][bj][m][1];
                    if (SIG) {
#pragma unroll
                        for (int j = 0; j < 4; ++j) { v0[j] = sigm(v0[j] * sc); v1[j] = sigm(v1[j] * sc); } }
                    u32x4 w; w.x = cvt_pk_bf16_safe(v0[0], v0[1]); w.y = cvt_pk_bf16_safe(v0[2], v0[3]); w.z = cvt_pk_bf16_safe(v1[0], v1[1]); w.w = cvt_pk_bf16_safe(v1[2], v1[3]);
                    *(u32x4*)(rowp + bj * HALF) = w; } }
    }
};
struct EpiUpGate {
    static constexpr bool PERM = true, AFTER_DRAIN = false;
    const bf16_t* gate; float* macc; bf16_t* merged; int nMtot;
    __device__ __forceinline__ void operator()(const f32x4 (&acc)[2][2][4][2], const Unit& u, int wr, int wc, int fr, int fq) const {
        const int b = u.pn >> 3, pn = u.pn & 7, pm = u.pm - b * nMtot;
        const int row0 = pm * BM + wr * 64 + fr, col0 = pn * BM + wc * 32 + 8 * fq;
#pragma unroll
        for (int ai = 0; ai < 2; ++ai)
#pragma unroll
            for (int m = 0; m < 4; ++m) { const size_t r = (size_t)(row0 + ai * HALF + m * 16);
#pragma unroll
                for (int bj = 0; bj < 2; ++bj) { const int c = col0 + bj * HALF;
                    const u32x4 gw = *(const u32x4*)(gate + r * NGATE + b * 2048 + c); float g[8]; unpack8(gw, g);
                    f32x4 v0 = acc[ai][bj][m][0], v1 = acc[ai][bj][m][1];
#pragma unroll
                    for (int j = 0; j < 4; ++j) { v0[j] *= g[j]; v1[j] *= g[4 + j]; }
                    float* mp = macc + r * 2048 + c;
                    if (b > 0) { v0 += *(const f32x4*)mp; v1 += *(const f32x4*)(mp + 4); }
                    if (b < 3) { *(f32x4*)mp = v0; *(f32x4*)(mp + 4) = v1; }
                    else { u32x4 w; w.x = cvt_pk_bf16_safe(v0[0], v0[1]); w.y = cvt_pk_bf16_safe(v0[2], v0[3]); w.z = cvt_pk_bf16_safe(v1[0], v1[1]); w.w = cvt_pk_bf16_safe(v1[2], v1[3]);
                           *(u32x4*)(merged + r * 2048 + c) = w; } } }
    }
};
struct EpiResid {
    static constexpr bool PERM = false, AFTER_DRAIN = false;
    const float* srcl; float* dstl; const float* srcc; float* dstc; const float* modv;
    int permute;
    __device__ __forceinline__ void operator()(const f32x4 (&acc)[2][2][4][2], const Unit& u, int wr, int wc, int fr, int fq) const {
        const int row0 = u.pm * BM + wr * 64 + fr, col0 = u.pn * BM + wc * 32 + 4 * fq;
#pragma unroll
        for (int ai = 0; ai < 2; ++ai)
#pragma unroll
            for (int m = 0; m < 4; ++m) { const int r = row0 + ai * HALF + m * 16;
                const float* sp; float* dp; const float* mp;
                if (r < ML) { const int b = r >> 14, s = r & 16383; const int t = permute ? (((s & 255) << 6) | (s >> 8)) : s; const size_t o = ((size_t)(b << 14) + t) * D;
                    sp = srcl + o; dp = dstl + o; mp = modv + b * 12288; }
                else { const size_t o = (size_t)(r - ML) * D; sp = srcc + o; dp = dstc + o; mp = modv + 2 * 12288; }
#pragma unroll
                for (int bj = 0; bj < 2; ++bj)
#pragma unroll
                    for (int n = 0; n < 2; ++n) { const int c = col0 + bj * HALF + n * 16;
                        const f32x4 sv = *(const f32x4*)(sp + c), mv = *(const f32x4*)(mp + c);
                        *(f32x4*)(dp + c) = sv + mv * acc[ai][bj][m][n]; } }
    }
};
struct EpiSwiglu {
    static constexpr bool PERM = true, AFTER_DRAIN = false;
    bf16_t* hid; int nper;
    __device__ __forceinline__ void operator()(const f32x4 (&acc)[2][2][4][2], const Unit& u, int wr, int wc, int fr, int fq) const {
        const int pn = u.pn % nper; const int row0 = u.pm * BM + wr * 64 + fr, col0 = pn * HALF + wc * 32 + 8 * fq;
#pragma unroll
        for (int ai = 0; ai < 2; ++ai)
#pragma unroll
            for (int m = 0; m < 4; ++m) { bf16_t* rowp = hid + (size_t)(row0 + ai * HALF + m * 16) * FF + col0;
                float o[8];
#pragma unroll
                for (int n = 0; n < 2; ++n)
#pragma unroll
                    for (int j = 0; j < 4; ++j) { const float g = acc[ai][0][m][n][j], v = acc[ai][1][m][n][j]; o[n * 4 + j] = siluf(g) * v; }
                u32x4 w; w.x = cvt_pk_bf16_safe(o[0], o[1]); w.y = cvt_pk_bf16_safe(o[2], o[3]); w.z = cvt_pk_bf16_safe(o[4], o[5]); w.w = cvt_pk_bf16_safe(o[6], o[7]);
                *(u32x4*)rowp = w; }
    }
};
struct EpiPlainBf16 {
    static constexpr bool PERM = true, AFTER_DRAIN = false;
    bf16_t* O; int ldc; int nper;
    __device__ __forceinline__ void operator()(const f32x4 (&acc)[2][2][4][2], const Unit& u, int wr, int wc, int fr, int fq) const {
        const int pn = u.pn % nper; const int row0 = u.pm * BM + wr * 64 + fr, col0 = pn * BM + wc * 32 + 8 * fq;
#pragma unroll
        for (int ai = 0; ai < 2; ++ai)
#pragma unroll
            for (int m = 0; m < 4; ++m) { bf16_t* rowp = O + (size_t)(row0 + ai * HALF + m * 16) * ldc + col0;
#pragma unroll
                for (int bj = 0; bj < 2; ++bj) { const f32x4 v0 = acc[ai][bj][m][0], v1 = acc[ai][bj][m][1];
                    u32x4 w; w.x = cvt_pk_bf16_safe(v0[0], v0[1]); w.y = cvt_pk_bf16_safe(v0[2], v0[3]); w.z = cvt_pk_bf16_safe(v1[0], v1[1]); w.w = cvt_pk_bf16_safe(v1[2], v1[3]);
                    *(u32x4*)(rowp + bj * HALF) = w; } }
    }
};
struct UpGateOrder {
    StaticOrder so; int nMtot;
    __device__ void init(int M, int G, int c, int nMtot_) { so.init(M, 2048, G, c); nMtot = nMtot_; }
    __device__ bool next(int i, Unit& u) const { Unit t; if (!so.next(i >> 2, t)) return false; const int b = i & 3; u.pm = b * nMtot + t.pm; u.pn = b * 8 + t.pn; return true; }
    __device__ __forceinline__ void a_ready(const Unit&) const {}
    __device__ __forceinline__ void done(const Unit&) const {}
};
struct MoeOrder {
    StaticOrder so; int be[8]; int nper;
    __device__ void init(int nused, int nper_, int G, int c, const int* be_) { so.init(nused * BM, nper_ * BM, G, c); nper = nper_;
#pragma unroll
        for (int e = 0; e < 8; ++e) be[e] = be_[e]; }
    __device__ bool next(int i, Unit& u) const { Unit t; if (!so.next(i, t)) return false; int e = 0;
#pragma unroll
        for (int j = 0; j < 7; ++j) e += (t.pm >= be[j]) ? 1 : 0;
        u.pm = t.pm; u.pn = e * nper + t.pn; return true; }
    __device__ __forceinline__ void a_ready(const Unit&) const {}
    __device__ __forceinline__ void done(const Unit&) const {}
};
}

__device__ __forceinline__ int lds_add(volatile LAS int* p) { return __hip_atomic_fetch_add((LAS int*)p, 1, __ATOMIC_RELAXED, __HIP_MEMORY_SCOPE_WORKGROUP); }
typedef const __attribute__((address_space(4))) Args* ArgsP;
#define ARGS_REF const __attribute__((address_space(4))) Args&
struct Ctx { ArgsP a; LAS unsigned char* lds; int tid, lane, wave, wg, G; };

__device__ __forceinline__ void conv_tile(const float* src, size_t ldsrc, int nvalid, bf16_t* dst, size_t ldd, LAS float* tile, int tid) {
    const int nn = tid & 63, kk = tid >> 6;
    float v[16];
#pragma unroll
    for (int j = 0; j < 16; ++j) v[j] = (nn < nvalid) ? src[(size_t)(kk + 8 * j) * ldsrc + nn] : 0.f;
#pragma unroll
    for (int j = 0; j < 16; ++j) tile[nn * 129 + kk + 8 * j] = v[j];
    __syncthreads();
    const int lane = tid & 63, w = tid >> 6;
#pragma unroll
    for (int p = 0; p < 8; ++p) { const int n = w + 8 * p; const float a = tile[n * 129 + 2 * lane], b = tile[n * 129 + 2 * lane + 1];
        *(unsigned*)(dst + (size_t)n * ldd + 2 * lane) = pg8::cvt_pk_bf16_safe(a, b); }
    __syncthreads();
}
template <int KIND>
__device__ __forceinline__ void conv_job(const Ctx& c, const float* src, const float* src2, size_t ldsrc, int K, int Nd, bf16_t* dst, int& rot) {
    LAS float* tile = (LAS float*)(c.lds + LDS_SCR);
    const int nkt = K / 128, nnt = Nd / 64, ntile = nkt * nnt;
    int t0 = (c.wg - rot) % c.G; if (t0 < 0) t0 += c.G;
    for (int t = t0; t < ntile; t += c.G) {
        const int nt = t % nnt, kt = t / nnt, n0 = nt * 64, k0 = kt * 128;
        const float* s = src; int c0 = n0, nvalid = 64;
        if (KIND == 1) { if (n0 >= NMIXP) c0 = n0 - (NMIXP - NMIX); else { nvalid = NMIX - n0; nvalid = nvalid < 0 ? 0 : (nvalid > 64 ? 64 : nvalid); } }
        if (KIND == 2) { const int which = (n0 & 255) >> 7; c0 = (n0 >> 8) * 128 + (n0 & 127); s = which ? src2 : src; }
        conv_tile(s + (size_t)k0 * ldsrc + c0, ldsrc, nvalid, dst + (size_t)n0 * K + k0, (size_t)K, tile, c.tid);
    }
    rot = (rot + ntile) % c.G;
}

__device__ __forceinline__ void conv_tile8(const float* src, size_t ldsrc, unsigned char* dst, size_t ldd, float wscale, LAS float* tile, int tid) {
    const int nn = tid & 63, kk = tid >> 6;
#pragma unroll 8
    for (int j = 0; j < 32; ++j) tile[nn * 257 + kk + 8 * j] = src[(size_t)(kk + 8 * j) * ldsrc + nn] * wscale;
    __syncthreads();
    const int lane = tid & 63, w = tid >> 6;
#pragma unroll
    for (int p = 0; p < 8; ++p) { const int n = w + 8 * p; const LAS float* t = tile + n * 257 + 4 * lane;
        *(unsigned*)(dst + (size_t)n * ldd + 4 * lane) = pk_fp8x4(t[0], t[1], t[2], t[3]); }
    __syncthreads();
}
__device__ __forceinline__ void conv_job8(const Ctx& c, const float* src, size_t ldsrc, int K, int Nd, unsigned char* dst, float wscale, int& rot) {
    LAS float* tile = (LAS float*)(c.lds + LDS_SCR);
    const int nkt = K / 256, nnt = Nd / 64, ntile = nkt * nnt;
    int t0 = (c.wg - rot) % c.G; if (t0 < 0) t0 += c.G;
    for (int t = t0; t < ntile; t += c.G) { const int nt = t % nnt, kt = t / nnt, n0 = nt * 64, k0 = kt * 256;
        conv_tile8(src + (size_t)k0 * ldsrc + n0, ldsrc, dst + (size_t)n0 * K + k0, (size_t)K, wscale, tile, c.tid); }
    rot = (rot + ntile) % c.G;
}

__device__ __forceinline__ void mod_phase(const Ctx& c) {
    ARGS_REF a = *c.a; const int tid = c.tid;
    LAS float* s = (LAS float*)(c.lds + LDS_SCR);
    LAS float* red = s + 3 * 2048;
    for (int i = tid; i < 3 * 2048; i += 512) { const int r = i >> 11, k = i & 2047; const float cv = (r < 2) ? a.in[I_C][r * 2048 + k] : a.in[I_CCTX][k]; s[i] = siluf(cv); }
    __syncthreads();
    float* modv = (float*)(a.ws + WS_MOD);
    for (int task = c.wg; task < 192; task += c.G) {
        const int l = task / 96, cb = task % 96, cq = tid & 31, kg = tid >> 5;
        const float* w = a.in[I_WMOD] + (size_t)l * 2048 * 12288 + cb * 128 + cq * 4;
        f32x4 a0 = {0.f, 0.f, 0.f, 0.f}, a1 = a0, a2 = a0;
#pragma unroll 8
        for (int k = kg; k < 2048; k += 16) { const f32x4 wv = *(const f32x4*)(w + (size_t)k * 12288); a0 += s[k] * wv; a1 += s[2048 + k] * wv; a2 += s[4096 + k] * wv; }
#pragma unroll
        for (int j = 0; j < 4; ++j) { red[(kg * 3 + 0) * 128 + cq * 4 + j] = a0[j]; red[(kg * 3 + 1) * 128 + cq * 4 + j] = a1[j]; red[(kg * 3 + 2) * 128 + cq * 4 + j] = a2[j]; }
        __syncthreads();
        if (tid < 384) { const int r = tid >> 7, cc = tid & 127; float sum = 0.f;
#pragma unroll
            for (int g = 0; g < 16; ++g) sum += red[(g * 3 + r) * 128 + cc];
            modv[(size_t)(l * 3 + r) * 12288 + cb * 128 + cc] = sum + a.in[I_BMOD][l * 12288 + cb * 128 + cc]; }
        __syncthreads();
    }
}

__device__ __forceinline__ void modnorm_row(f32x4 (&v)[8], const float* nw, const float* shift, const float* scale, int lane) {
    float ss = 0.f;
#pragma unroll
    for (int j = 0; j < 8; ++j) ss += v[j][0] * v[j][0] + v[j][1] * v[j][1] + v[j][2] * v[j][2] + v[j][3] * v[j][3];
    ss = wave_sum(ss);
    const float rstd = __builtin_amdgcn_rsqf(ss * (1.0f / 2048.0f) + EPS);
#pragma unroll
    for (int j = 0; j < 8; ++j) { const int cc = (j * 64 + lane) * 4; const f32x4 w = *(const f32x4*)(nw + cc), sh = *(const f32x4*)(shift + cc), sc = *(const f32x4*)(scale + cc);
        v[j] = (v[j] * rstd * w) * (1.0f + sc) + sh; }
}
__device__ __forceinline__ void store_row_bf16(const f32x4 (&v)[8], bf16_t* hrow, int lane) {
#pragma unroll
    for (int j = 0; j < 8; ++j) { u32x2 w; w.x = pg8::cvt_pk_bf16_safe(v[j][0], v[j][1]); w.y = pg8::cvt_pk_bf16_safe(v[j][2], v[j][3]); *(u32x2*)(hrow + (j * 64 + lane) * 4) = w; }
}
template <int L, int WHICH>
__device__ __forceinline__ void norm_phase(const Ctx& c) {
    ARGS_REF a = *c.a; const int gw = c.wg * 8 + c.wave, nw = c.G * 8, lane = c.lane;
    const float* modv = (const float*)(a.ws + WS_MOD) + (size_t)L * 3 * 12288 + (WHICH ? 3 : 0) * 2048;
    const float* normw = a.in[I_NORMW] + (L * 2 + WHICH) * 2048;
    const float* xc = (const float*)(a.ws + WS_XC);
    bf16_t* H = (bf16_t*)(a.ws + WS_H);
    for (int r = gw; r < MT; r += nw) {
        const float* src; int mr; size_t hrow;
        if (r < ML) { const int b = r >> 14, t = r & 16383; src = ((L == 0 && WHICH == 0) ? a.in[I_X] : (const float*)a.out) + (size_t)r * D; mr = b;
            hrow = (L == 1 && WHICH == 0) ? (size_t)(b << 14) + ((t & 63) << 8) + (t >> 6) : (size_t)r; }
        else { const int rc = r - ML; src = ((L == 0 && WHICH == 0) ? a.in[I_CTX] : xc) + (size_t)rc * D; mr = 2; hrow = r; }
        f32x4 v[8];
#pragma unroll
        for (int j = 0; j < 8; ++j) v[j] = *(const f32x4*)(src + (j * 64 + lane) * 4);
        const float* shift = modv + (size_t)mr * 12288;
        modnorm_row(v, normw, shift, shift + 2048, lane);
        store_row_bf16(v, H + hrow * D, lane);
        if (WHICH == 0) { unsigned char* h8 = (unsigned char*)(a.ws + WS_H8) + hrow * D;
#pragma unroll
            for (int j = 0; j < 8; ++j) *(unsigned*)(h8 + (j * 64 + lane) * 4) = pk_fp8x4(v[j][0] * 4.f, v[j][1] * 4.f, v[j][2] * 4.f, v[j][3] * 4.f); }
    }
}

template <int L>
__device__ __forceinline__ void rgprep_item(const Ctx& c, int item) {
    ARGS_REF a = *c.a; const int tid = c.tid;
    LAS float* xbT = (LAS float*)(c.lds + LDS_SCR);
    const bf16_t* PM = (const bf16_t*)(a.ws + WS_PMIX);
    bf16_t* RGLA = (bf16_t*)(a.ws + WS_RGLA); bf16_t* RGU = (bf16_t*)(a.ws + WS_RGU);
    const float* cw = a.in[I_RG_CW] + L * 4 * 512; const float* cb = a.in[I_RG_CB] + L * 512;
    {
        const int tt = item >> 2, n = item & 3;
        size_t rowbase; int t0, Ls;
        if (tt < 512) { const int b = tt >> 8; rowbase = (size_t)b * T; t0 = (tt & 255) * 64; Ls = T; }
        else { const int tc = tt - 512, b = tc >> 2; rowbase = (size_t)ML + b * CL; t0 = (tc & 3) * 64; Ls = CL; }
        __syncthreads();
        {
            const int tl = tid >> 3, cg = tid & 7, ch0 = n * 128 + cg * 16;
            float acc[16];
#pragma unroll
            for (int j = 0; j < 16; ++j) acc[j] = cb[ch0 + j];
#pragma unroll
            for (int tap = 0; tap < 4; ++tap) { const int ts = t0 + tl + tap - 2;
                if (ts >= 0 && ts < Ls) { const bf16_t* rp = PM + (rowbase + ts) * NMIXP + C_RG_X + ch0; const u32x4 w0 = *(const u32x4*)rp, w1 = *(const u32x4*)(rp + 8);
                    float f[8], g[8]; unpack8(w0, f); unpack8(w1, g);
#pragma unroll
                    for (int j = 0; j < 8; ++j) { acc[j] += cw[tap * 512 + ch0 + j] * f[j]; acc[8 + j] += cw[tap * 512 + ch0 + 8 + j] * g[j]; } } }
#pragma unroll
            for (int j = 0; j < 16; ++j) xbT[(cg * 16 + j) * 68 + tl] = acc[j];
        }
        __syncthreads();
        const int oc = tid & 127, tg = tid >> 7, ch = n * 128 + oc;
#pragma unroll 1
        for (int d = 0; d < 2; ++d) {
            const float* wr = a.in[I_RG_WR] + ((size_t)((L * 2 + d) * 4 + n) * 128) * 128 + oc;
            const float* wi = a.in[I_RG_WI] + ((size_t)((L * 2 + d) * 4 + n) * 128) * 128 + oc;
            float ar[16], ai[16];
#pragma unroll
            for (int j = 0; j < 16; ++j) { ar[j] = 0.f; ai[j] = 0.f; }
#pragma unroll 4
            for (int k = 0; k < 128; ++k) { const float w1 = wr[k * 128], w2 = wi[k * 128];
                const LAS f32x4* xp = (const LAS f32x4*)(xbT + k * 68 + tg * 16);
#pragma unroll
                for (int q = 0; q < 4; ++q) { const f32x4 xv = xp[q];
#pragma unroll
                    for (int j = 0; j < 4; ++j) { ar[q * 4 + j] += xv[j] * w1; ai[q * 4 + j] += xv[j] * w2; } } }
            const float br = a.in[I_RG_BR][(L * 2 + d) * 512 + ch], bi = a.in[I_RG_BI][(L * 2 + d) * 512 + ch];
            const float sp = softplusf(-a.in[I_RG_LAM][(L * 2 + d) * 512 + ch]);
#pragma unroll
            for (int j = 0; j < 16; ++j) { const int tl = tg * 16 + j; const float r = sigm(ar[j] + br), ig = sigm(ai[j] + bi);
                const float la = -8.0f * r * sp; const float xb = xbT[oc * 68 + tl];
                const float u = sqrtf(fmaxf(-expm1f(2.0f * la), 0.f)) * (ig * xb);
                const size_t o = ((size_t)d * MT + rowbase + t0 + tl) * 512 + ch;
                RGLA[o] = (bf16_t)(pg8::cvt_pk_bf16_safe(la, 0.f) & 0xffffu); RGU[o] = (bf16_t)(pg8::cvt_pk_bf16_safe(u, 0.f) & 0xffffu); }
        }
    }
}

template <int L>
__device__ __forceinline__ void chain_gla(const Ctx& c, int b, int h, int d, int vh) {
    ARGS_REF a = *c.a; const int tid = c.tid;
    LAS float* qs = (LAS float*)(c.lds + LDS_SCR); LAS float* ks = qs + 4096; LAS float* fs = ks + 4096; LAS float* vs = fs + 4096; LAS float* os = vs + 4096;
    LAS float* wa = (LAS float*)(c.lds + LDS_AUX);
    const bf16_t* PM = (const bf16_t*)(a.ws + WS_PMIX);
    bf16_t* ORAW = (bf16_t*)(a.ws + WS_ORAW) + (size_t)d * MT * 2048;
    for (int i = tid; i < 1024; i += 512) wa[i] = a.in[I_GLA_WA2][((L * 2 + d) * 16 + (i >> 6)) * 256 + h * 64 + (i & 63)];
    if (tid < 64) wa[1024 + tid] = a.in[I_GLA_BA2][(L * 2 + d) * 256 + h * 64 + tid];
    float s[8];
#pragma unroll
    for (int j = 0; j < 8; ++j) s[j] = 0.f;
    const int vc = tid >> 3, kq = tid & 7;
#pragma unroll 1
    for (int seg = 0; seg < 2; ++seg) {
        const int Ls = seg ? T : CL; const size_t rowbase = seg ? (size_t)b * T : (size_t)ML + b * CL;
#pragma unroll 1
        for (int jb = 0; jb < Ls / 64; ++jb) {
            const int r0 = d ? Ls - 64 * (jb + 1) : 64 * jb;
            __syncthreads();
            {   const int i = tid >> 3, cg = tid & 7, lr = d ? 63 - i : i; const bf16_t* rp = PM + (rowbase + r0 + lr) * NMIXP;
                float fq[8], fk[8], fv[8], fa[16];
                { const u32x4 w = *(const u32x4*)(rp + C_GLA_Q + h * 64 + cg * 8); unpack8(w, fq); }
                { const u32x4 w = *(const u32x4*)(rp + C_GLA_K + h * 64 + cg * 8); unpack8(w, fk); }
                { const u32x4 w = *(const u32x4*)(rp + C_GLA_V + h * 128 + vh * 64 + cg * 8); unpack8(w, fv); }
                { const u32x4 w0 = *(const u32x4*)(rp + C_GLA_A + d * 16), w1 = *(const u32x4*)(rp + C_GLA_A + d * 16 + 8); float t0[8], t1[8]; unpack8(w0, t0); unpack8(w1, t1);
#pragma unroll
                  for (int j = 0; j < 8; ++j) { fa[j] = t0[j]; fa[8 + j] = t1[j]; } }
#pragma unroll
                for (int j = 0; j < 8; ++j) { const int o = i * 64 + cg * 8 + j; qs[o] = fq[j] * 0.125f; ks[o] = fk[j]; vs[o] = fv[j];
                    float z = wa[1024 + cg * 8 + j];
#pragma unroll
                    for (int r = 0; r < 16; ++r) z += fa[r] * wa[r * 64 + cg * 8 + j];
                    fs[o] = __expf(-softplusf(-z) * (1.0f / 16.0f)); }
            }
            __syncthreads();
#pragma unroll 2
            for (int i = 0; i < 64; ++i) {
                const f32x4 f0 = *(const LAS f32x4*)(fs + i * 64 + kq * 8), f1 = *(const LAS f32x4*)(fs + i * 64 + kq * 8 + 4);
                const f32x4 k0 = *(const LAS f32x4*)(ks + i * 64 + kq * 8), k1 = *(const LAS f32x4*)(ks + i * 64 + kq * 8 + 4);
                const f32x4 q0 = *(const LAS f32x4*)(qs + i * 64 + kq * 8), q1 = *(const LAS f32x4*)(qs + i * 64 + kq * 8 + 4);
                const float vv = vs[i * 64 + vc]; float po = 0.f;
#pragma unroll
                for (int j = 0; j < 4; ++j) { s[j] = f0[j] * s[j] + k0[j] * vv; s[4 + j] = f1[j] * s[4 + j] + k1[j] * vv; po += s[j] * q0[j] + s[4 + j] * q1[j]; }
                po += __shfl_xor(po, 1); po += __shfl_xor(po, 2); po += __shfl_xor(po, 4);
                if (kq == 0) os[i * 64 + vc] = po;
            }
            __syncthreads();
            {   const int i = tid >> 3, cg = tid & 7, lr = d ? 63 - i : i; float o[8];
#pragma unroll
                for (int j = 0; j < 8; ++j) o[j] = os[i * 64 + cg * 8 + j];
                *(u32x4*)(ORAW + (rowbase + r0 + lr) * 2048 + 0 * 512 + h * 128 + vh * 64 + cg * 8) = pack8(o); }
        }
    }
}
template <int L>
__device__ __forceinline__ void chain_hg(const Ctx& c, int b, int h, int d, int vh) {
    ARGS_REF a = *c.a; const int tid = c.tid;
    LAS float* qs = (LAS float*)(c.lds + LDS_SCR); LAS float* ks = qs + 8192; LAS float* fs = ks + 8192; LAS float* vs = fs + 8192; LAS float* os = vs + 4096;
    LAS float* lbs = (LAS float*)(c.lds + LDS_AUX);
    const bf16_t* PM = (const bf16_t*)(a.ws + WS_PMIX);
    bf16_t* ORAW = (bf16_t*)(a.ws + WS_ORAW) + (size_t)d * MT * 2048;
    if (tid < 128) { float lb = 0.f; if (L == 1) { const float l0 = a.in[I_HG_LB][h * 128 + tid], l1 = a.in[I_HG_LB][512 + h * 128 + tid]; lb = __builtin_amdgcn_rcpf(1.0f + __expf(l0 - l1)); } lbs[tid] = lb; }
    float s[16];
#pragma unroll
    for (int j = 0; j < 16; ++j) s[j] = 0.f;
    const int vc = tid >> 3, kq = tid & 7;
#pragma unroll 1
    for (int seg = 0; seg < 2; ++seg) {
        const int Ls = seg ? T : CL; const size_t rowbase = seg ? (size_t)b * T : (size_t)ML + b * CL;
#pragma unroll 1
        for (int jb = 0; jb < Ls / 64; ++jb) {
            const int r0 = d ? Ls - 64 * (jb + 1) : 64 * jb;
            __syncthreads();
            {   const int i = tid >> 3, cg = tid & 7, lr = d ? 63 - i : i; const bf16_t* rp = PM + (rowbase + r0 + lr) * NMIXP;
#pragma unroll
                for (int hf = 0; hf < 2; ++hf) { const int ch = cg * 16 + hf * 8; float fq[8], fz[8];
                    { const u32x4 w = *(const u32x4*)(rp + C_HG_Q + h * 128 + ch); unpack8(w, fq); }
                    { const u32x4 w = *(const u32x4*)(rp + C_HG_F + d * 512 + h * 128 + ch); unpack8(w, fz); }
#pragma unroll
                    for (int j = 0; j < 8; ++j) { const int o = i * 128 + ch + j; const float lb = lbs[ch + j], sg = sigm(fz[j]);
                        qs[o] = siluf(fq[j]) * 0.08838834764831845f; fs[o] = fmaxf(lb + (1.0f - lb) * sg, 1e-30f); ks[o] = (1.0f - lb) * (1.0f - sg); } }
                float fv[8]; { const u32x4 w = *(const u32x4*)(rp + C_HG_I + h * 128 + vh * 64 + cg * 8); unpack8(w, fv); }
#pragma unroll
                for (int j = 0; j < 8; ++j) vs[i * 64 + cg * 8 + j] = fv[j];
            }
            __syncthreads();
#pragma unroll 2
            for (int i = 0; i < 64; ++i) {
                const float vv = vs[i * 64 + vc]; float po = 0.f;
#pragma unroll
                for (int q4 = 0; q4 < 4; ++q4) {
                    const f32x4 f0 = *(const LAS f32x4*)(fs + i * 128 + kq * 16 + q4 * 4), k0 = *(const LAS f32x4*)(ks + i * 128 + kq * 16 + q4 * 4), q0 = *(const LAS f32x4*)(qs + i * 128 + kq * 16 + q4 * 4);
#pragma unroll
                    for (int j = 0; j < 4; ++j) { s[q4 * 4 + j] = f0[j] * s[q4 * 4 + j] + k0[j] * vv; po += s[q4 * 4 + j] * q0[j]; } }
                po += __shfl_xor(po, 1); po += __shfl_xor(po, 2); po += __shfl_xor(po, 4);
                if (kq == 0) os[i * 64 + vc] = po;
            }
            __syncthreads();
            {   const int i = tid >> 3, cg = tid & 7, lr = d ? 63 - i : i; float o[8];
#pragma unroll
                for (int j = 0; j < 8; ++j) o[j] = os[i * 64 + cg * 8 + j];
                *(u32x4*)(ORAW + (rowbase + r0 + lr) * 2048 + 1 * 512 + h * 128 + vh * 64 + cg * 8) = pack8(o); }
        }
    }
}
template <int L>
__device__ __forceinline__ void chain_dn(const Ctx& c, int b, int h, int d, int vh) {
    ARGS_REF a = *c.a; const int tid = c.tid;
    LAS float* qs = (LAS float*)(c.lds + LDS_SCR); LAS float* ks = qs + 8192; LAS float* vs = ks + 8192; LAS float* os = vs + 4096; LAS float* as = os + 4096; LAS float* bs = as + 64;
    LAS float* cwl = (LAS float*)(c.lds + LDS_AUX);
    const bf16_t* PM = (const bf16_t*)(a.ws + WS_PMIX);
    bf16_t* ORAW = (bf16_t*)(a.ws + WS_ORAW) + (size_t)d * MT * 2048;
    for (int i = tid; i < 4 * 320; i += 512) { const int tap = i / 320, cc = i % 320; const int ch = cc < 128 ? h * 128 + cc : (cc < 256 ? 512 + h * 128 + (cc - 128) : 1024 + h * 128 + vh * 64 + (cc - 256));
        cwl[i] = a.in[I_DN_CW][(L * 4 + tap) * 1536 + ch]; }
    const float neg_ea = -expf(a.in[I_DN_ALOG][(L * 2 + d) * 4 + h]), dtb = a.in[I_DN_DTB][(L * 2 + d) * 4 + h];
    float s[16];
#pragma unroll
    for (int j = 0; j < 16; ++j) s[j] = 0.f;
    const int vc = tid >> 3, kq = tid & 7;
#pragma unroll 1
    for (int seg = 0; seg < 2; ++seg) {
        const int Ls = seg ? T : CL; const size_t rowbase = seg ? (size_t)b * T : (size_t)ML + b * CL;
#pragma unroll 1
        for (int jb = 0; jb < Ls / 64; ++jb) {
            const int r0 = d ? Ls - 64 * (jb + 1) : 64 * jb;
            __syncthreads();
            {   const int i = tid >> 3, cg = tid & 7, lr = d ? 63 - i : i, t = r0 + lr;
                float aq[16], ak[16], av[8];
#pragma unroll
                for (int j = 0; j < 16; ++j) { aq[j] = 0.f; ak[j] = 0.f; }
#pragma unroll
                for (int j = 0; j < 8; ++j) av[j] = 0.f;
#pragma unroll
                for (int tap = 0; tap < 4; ++tap) { const int ts = t + tap - 2;
                    if (ts >= 0 && ts < Ls) { const bf16_t* rp = PM + (rowbase + ts) * NMIXP; const LAS float* w = cwl + tap * 320;
                        float f0[8], f1[8];
                        { const u32x4 w0 = *(const u32x4*)(rp + C_DN_Q + h * 128 + cg * 16), w1 = *(const u32x4*)(rp + C_DN_Q + h * 128 + cg * 16 + 8); unpack8(w0, f0); unpack8(w1, f1); }
#pragma unroll
                        for (int j = 0; j < 8; ++j) { aq[j] += w[cg * 16 + j] * f0[j]; aq[8 + j] += w[cg * 16 + 8 + j] * f1[j]; }
                        { const u32x4 w0 = *(const u32x4*)(rp + C_DN_K + h * 128 + cg * 16), w1 = *(const u32x4*)(rp + C_DN_K + h * 128 + cg * 16 + 8); unpack8(w0, f0); unpack8(w1, f1); }
#pragma unroll
                        for (int j = 0; j < 8; ++j) { ak[j] += w[128 + cg * 16 + j] * f0[j]; ak[8 + j] += w[128 + cg * 16 + 8 + j] * f1[j]; }
                        { const u32x4 w0 = *(const u32x4*)(rp + C_DN_V + h * 128 + vh * 64 + cg * 8); unpack8(w0, f0); }
#pragma unroll
                        for (int j = 0; j < 8; ++j) av[j] += w[256 + cg * 8 + j] * f0[j]; } }
#pragma unroll
                for (int j = 0; j < 16; ++j) { qs[i * 128 + cg * 16 + j] = siluf(aq[j]); ks[i * 128 + cg * 16 + j] = siluf(ak[j]); }
#pragma unroll
                for (int j = 0; j < 8; ++j) vs[i * 64 + cg * 8 + j] = siluf(av[j]);
                if (tid < 64) { const int lr2 = d ? 63 - tid : tid; const bf16_t* rp = PM + (rowbase + r0 + lr2) * NMIXP;
                    const float g = neg_ea * softplusf(bf1(rp + C_DN_A + d * 4 + h) + dtb); as[tid] = __expf(g); bs[tid] = sigm(bf1(rp + C_DN_B + d * 4 + h)); }
            }
            __syncthreads();
            {
                const int rowid = tid >> 2, part = tid & 3; LAS float* p = (rowid < 64 ? qs + rowid * 128 : ks + (rowid - 64) * 128) + part * 32; float ss = 0.f;
#pragma unroll
                for (int j = 0; j < 32; ++j) ss += p[j] * p[j];
                ss += __shfl_xor(ss, 1); ss += __shfl_xor(ss, 2);
                const float rs = __builtin_amdgcn_rsqf(ss + EPS) * (rowid < 64 ? 0.08838834764831845f : 1.0f);
#pragma unroll
                for (int j = 0; j < 32; ++j) p[j] *= rs;
            }
            __syncthreads();
#pragma unroll 2
            for (int i = 0; i < 64; ++i) {
                f32x4 kk[4]; float kts = 0.f;
#pragma unroll
                for (int q4 = 0; q4 < 4; ++q4) { kk[q4] = *(const LAS f32x4*)(ks + i * 128 + kq * 16 + q4 * 4);
#pragma unroll
                    for (int j = 0; j < 4; ++j) kts += s[q4 * 4 + j] * kk[q4][j]; }
                kts += __shfl_xor(kts, 1); kts += __shfl_xor(kts, 2); kts += __shfl_xor(kts, 4);
                const float al = as[i], be = bs[i]; const float vn = be * (vs[i * 64 + vc] - al * kts); float po = 0.f;
#pragma unroll
                for (int q4 = 0; q4 < 4; ++q4) { const f32x4 q0 = *(const LAS f32x4*)(qs + i * 128 + kq * 16 + q4 * 4);
#pragma unroll
                    for (int j = 0; j < 4; ++j) { s[q4 * 4 + j] = al * s[q4 * 4 + j] + kk[q4][j] * vn; po += s[q4 * 4 + j] * q0[j]; } }
                po += __shfl_xor(po, 1); po += __shfl_xor(po, 2); po += __shfl_xor(po, 4);
                if (kq == 0) os[i * 64 + vc] = po;
            }
            __syncthreads();
            {   const int i = tid >> 3, cg = tid & 7, lr = d ? 63 - i : i; float o[8];
#pragma unroll
                for (int j = 0; j < 8; ++j) o[j] = os[i * 64 + cg * 8 + j];
                *(u32x4*)(ORAW + (rowbase + r0 + lr) * 2048 + 2 * 512 + h * 128 + vh * 64 + cg * 8) = pack8(o); }
        }
    }
}
__device__ __forceinline__ void chain_rg(const Ctx& c, int gw  ) {
    ARGS_REF a = *c.a; const int b = gw >> 3, d = (gw >> 2) & 1, ch = (gw & 3) * 128 + c.lane * 2;
    const bf16_t* RGLA = (const bf16_t*)(a.ws + WS_RGLA) + (size_t)d * MT * 512 + ch; const bf16_t* RGU = (const bf16_t*)(a.ws + WS_RGU) + (size_t)d * MT * 512 + ch;
    bf16_t* ORAW = (bf16_t*)(a.ws + WS_ORAW) + (size_t)d * MT * 2048 + 1536 + ch;
    float h0 = 0.f, h1 = 0.f;
#pragma unroll 1
    for (int seg = 0; seg < 2; ++seg) {
        const int Ls = seg ? T : CL; const size_t rowbase = seg ? (size_t)b * T : (size_t)ML + b * CL;
#pragma unroll 1
        for (int s0 = 0; s0 < Ls; s0 += 16) {
            unsigned la[16], uu[16];
#pragma unroll
            for (int j = 0; j < 16; ++j) { const size_t row = rowbase + (d ? Ls - 1 - (s0 + j) : s0 + j); la[j] = *(const unsigned*)(RGLA + row * 512); uu[j] = *(const unsigned*)(RGU + row * 512); }
#pragma unroll
            for (int j = 0; j < 16; ++j) { const size_t row = rowbase + (d ? Ls - 1 - (s0 + j) : s0 + j);
                h0 = __expf(bflo(la[j])) * h0 + bflo(uu[j]); h1 = __expf(bfhi(la[j])) * h1 + bfhi(uu[j]);
                *(unsigned*)(ORAW + row * 2048) = pg8::cvt_pk_bf16_safe(h0, h1); }
        }
    }
}

typedef float f32x16 __attribute__((ext_vector_type(16)));
typedef pg8::bf16x8 bf16x8;
#define LBAR() do { asm volatile("s_waitcnt lgkmcnt(0)" ::: "memory"); __builtin_amdgcn_s_barrier(); asm volatile("" ::: "memory"); } while (0)
#define MFMA32(a, b, c) __builtin_amdgcn_mfma_f32_32x32x16_bf16((a), (b), (c), 0, 0, 0)
template <int S_> __device__ __forceinline__ bf16x8 pack_step(const f32x16& x) {
    f32x8 v;
#pragma unroll
    for (int j = 0; j < 8; ++j) v[j] = x[8 * S_ + j];
    return __builtin_bit_cast(bf16x8, __builtin_convertvector(v, bfx8_t));
}
__device__ __forceinline__ bf16_t f2bf(float f) { const __bf16 b = (__bf16)f; return __builtin_bit_cast(bf16_t, b); }
__device__ __forceinline__ int permpos(int k) { const int w = k & 15; return (k & ~15) + (((w >> 2) & 1) << 3) + ((w >> 3) << 2) + (w & 3); }
__device__ __forceinline__ int crow16(int idx, int hh) { return (idx & 3) + 8 * (idx >> 2) + 4 * hh; }
__device__ __forceinline__ size_t chunk_rowbase(int b, int n) { return n < 4 ? (size_t)ML + b * CL + n * 64 : (size_t)b * T + (size_t)(n - 4) * 64; }

template <int L, int TY>
__device__ __forceinline__ void intra_g_item(const Ctx& c, int b, int h, int n) {
    constexpr int K = TY ? 128 : 64, NSEG = 512 / K, TS = 64 / NSEG, QPITCH = 2 * K + 16;
    ARGS_REF a = *c.a; const int tid = c.tid;
    const bf16_t* PM = (const bf16_t*)(a.ws + WS_PMIX);
    unsigned char* scr = a.ws + WS_SCR;
    const size_t rowbase = chunk_rowbase(b, n);
    const int rec = (b * 4 + h) * 260 + n;
    LAS unsigned char* Qh = c.lds + LDS_SCR; LAS unsigned char* Kh = Qh + 64 * QPITCH; LAS float* segtot = (LAS float*)(Kh + 64 * QPITCH);
    LBAR();
    {
        const int v = tid & 127, t0 = (tid >> 7) * 16; float vals[16];
        const char* vb = (const char*)(PM + rowbase * NMIXP + (TY ? C_HG_I : C_GLA_V) + h * 128); asm volatile("" : "+s"(vb));
        const unsigned vo = (unsigned)(t0 * NMIXP + v) * 2u;
#pragma unroll
        for (int j = 0; j < 16; ++j) vals[j] = bf1((const bf16_t*)(vb + (vo + (unsigned)(j * NMIXP * 2))));
        float v0[8], v1[8];
#pragma unroll
        for (int j = 0; j < 8; ++j) { v0[j] = vals[j]; v1[j] = vals[8 + j]; }
        u32x4* dst = (u32x4*)(scr + (TY ? SC_HG_VT : SC_GLA_VT) + (size_t)rec * 16384 + v * 128 + t0 * 2);
        dst[0] = pack8(v0); dst[1] = pack8(v1);
    }
    const int k = tid & (K - 1), tq = tid / K;
    float lb = 0.f;
    if (TY == 1 && L == 1) { const float l0 = a.in[I_HG_LB][h * 128 + k], l1 = a.in[I_HG_LB][512 + h * 128 + k]; lb = __builtin_amdgcn_rcpf(1.0f + __expf(l0 - l1)); }
#pragma unroll 1
    for (int d = 0; d < 2; ++d) {
        float qv[TS], kv[TS], bv[TS];
        const char* pb = (const char*)(PM + rowbase * NMIXP); asm volatile("" : "+s"(pb));
        const unsigned ro = (unsigned)(TS * tq * NMIXP) * 2u;
        if (TY == 0) {
            float w[16]; const float bias = a.in[I_GLA_BA2][(L * 2 + d) * 256 + h * 64 + k];
#pragma unroll
            for (int r = 0; r < 16; ++r) w[r] = a.in[I_GLA_WA2][((L * 2 + d) * 16 + r) * 256 + h * 64 + k];
#pragma unroll
            for (int j = 0; j < TS; ++j) { const bf16_t* rp = (const bf16_t*)(pb + (ro + (unsigned)(j * NMIXP * 2)));
                qv[j] = bf1(rp + C_GLA_Q + h * 64 + k) * 0.125f; kv[j] = bf1(rp + C_GLA_K + h * 64 + k);
                const u32x4 w0 = *(const u32x4*)(rp + C_GLA_A + d * 16), w1 = *(const u32x4*)(rp + C_GLA_A + d * 16 + 8); float f0[8], f1[8]; unpack8(w0, f0); unpack8(w1, f1);
                float z = bias;
#pragma unroll
                for (int r = 0; r < 8; ++r) { z += f0[r] * w[r]; z += f1[r] * w[8 + r]; }
                bv[j] = -softplusf(-z) * (1.0f / 16.0f); }
        } else {
#pragma unroll
            for (int j = 0; j < TS; ++j) { const bf16_t* rp = (const bf16_t*)(pb + (ro + (unsigned)(j * NMIXP * 2)));
                qv[j] = siluf(bf1(rp + C_HG_Q + h * 128 + k)) * 0.08838834764831845f;
                const float sg = sigm(bf1(rp + C_HG_F + d * 512 + h * 128 + k));
                bv[j] = __logf(fmaxf(lb + (1.0f - lb) * sg, 1e-30f)); kv[j] = (1.0f - lb) * (1.0f - sg); }
        }
        float run = 0.f;
        if (d == 0) {
#pragma unroll
            for (int j = 0; j < TS; ++j) { run += bv[j]; bv[j] = run; } }
        else {
#pragma unroll
            for (int j = TS - 1; j >= 0; --j) { run += bv[j]; bv[j] = run; } }
        segtot[tq * K + k] = run;
        LBAR();
        float off = 0.f, tot = 0.f, R = 0.f;
#pragma unroll
        for (int sg = 0; sg < NSEG; ++sg) { const float s = segtot[sg * K + k]; tot += s;
            if (d ? (sg > tq) : (sg < tq)) off += s;
            if (d ? (sg >= NSEG / 2) : (sg < NSEG / 2)) R += s; }
        const size_t drec = (size_t)((d * 8 + b * 4 + h) * 260 + n);
        bf16_t* qp = (bf16_t*)(scr + (TY ? SC_HG_QP : SC_GLA_QP) + drec * (64 * K * 2));
        bf16_t* ktp = (bf16_t*)(scr + (TY ? SC_HG_KT : SC_GLA_KT) + drec * (64 * K * 2));
        const int pk = permpos(k);
        float kt[TS];
#pragma unroll
        for (int j = 0; j < TS; ++j) { const int t = TS * tq + j; const float B = off + bv[j];
            qp[t * K + pk] = f2bf(qv[j] * __expf(B));
            kt[j] = kv[j] * __expf(tot - B);
            *(LAS bf16_t*)(Qh + t * QPITCH + k * 2) = f2bf(qv[j] * __expf(fminf(B - R, 60.f)));
            *(LAS bf16_t*)(Kh + t * QPITCH + k * 2) = f2bf(kv[j] * __expf(fminf(R - B, 60.f))); }
        {   u32x4* dst = (u32x4*)(ktp + k * 64 + TS * tq);
#pragma unroll
            for (int g = 0; g < TS / 8; ++g) { float t8[8];
#pragma unroll
                for (int j = 0; j < 8; ++j) t8[j] = kt[g * 8 + j];
                dst[g] = pack8(t8); } }
        if (tq == 0) ((float*)(scr + (TY ? SC_HG_LAM : SC_GLA_LAM) + drec * (K * 4)))[k] = __expf(tot);
        LBAR();
        if (c.wave < 4) {
            const int it = c.wave >> 1, jt = c.wave & 1, r = c.lane & 31, hh = c.lane >> 5;
            bf16_t* ap = (bf16_t*)(scr + (TY ? SC_HG_A : SC_GLA_A) + drec * 8192);
            f32x16 acc;
#pragma unroll
            for (int i = 0; i < 16; ++i) acc[i] = 0.f;
            const bool dead = d ? (it == 1 && jt == 0) : (it == 0 && jt == 1);
            if (!dead) {
#pragma unroll
                for (int ks = 0; ks < K / 16; ++ks) { const bf16x8 af = *(const LAS bf16x8*)(Qh + (32 * it + r) * QPITCH + ks * 32 + hh * 16), bfr = *(const LAS bf16x8*)(Kh + (32 * jt + r) * QPITCH + ks * 32 + hh * 16);
                    acc = MFMA32(af, bfr, acc); } }
            const int jj = 32 * jt + r;
#pragma unroll
            for (int i = 0; i < 16; ++i) { const int ii = 32 * it + crow16(i, hh); const bool ok = d ? (jj >= ii) : (jj <= ii); ap[ii * 64 + jj] = f2bf(ok ? acc[i] : 0.f); }
        }
        LBAR();
    }
}

template <int TY> struct GChunk {
    static constexpr int K = TY ? 128 : 64, QPITCH = 2 * K + 16, RQ = 64 * K * 2 / 16 / 256  , NRL = 2 * RQ + 2 + 4;
    static constexpr int OFF_QP = 0, OFF_KT = 64 * QPITCH, OFF_A = OFF_KT + K * 144, OFF_VT = OFF_A + 64 * 144, OFF_LAM = OFF_VT + 128 * 144, BYTES = OFF_LAM + K * 4;
};
template <int TY>
__device__ __forceinline__ void gchunk_issue(const unsigned char* scr, int b, int h, int d, int n, int lt, u32x4 (&pf)[GChunk<TY>::NRL], float& lamv) {
    typedef GChunk<TY> G; constexpr int K = G::K, RQ = G::RQ;
    const size_t drec = (size_t)((d * 8 + b * 4 + h) * 260 + n), rec = (size_t)((b * 4 + h) * 260 + n);
    const u32x4* qp = (const u32x4*)(scr + (TY ? SC_HG_QP : SC_GLA_QP) + drec * (64 * K * 2));
    const u32x4* kt = (const u32x4*)(scr + (TY ? SC_HG_KT : SC_GLA_KT) + drec * (64 * K * 2));
    const u32x4* ap = (const u32x4*)(scr + (TY ? SC_HG_A : SC_GLA_A) + drec * 8192);
    const u32x4* vt = (const u32x4*)(scr + (TY ? SC_HG_VT : SC_GLA_VT) + rec * 16384);
#pragma unroll
    for (int i = 0; i < RQ; ++i) { pf[i] = qp[i * 256 + lt]; pf[RQ + i] = kt[i * 256 + lt]; }
    pf[2 * RQ] = ap[lt]; pf[2 * RQ + 1] = ap[256 + lt];
#pragma unroll
    for (int i = 0; i < 4; ++i) pf[2 * RQ + 2 + i] = vt[i * 256 + lt];
    if (lt < K) lamv = ((const float*)(scr + (TY ? SC_HG_LAM : SC_GLA_LAM) + drec * (K * 4)))[lt];
}
template <int TY>
__device__ __forceinline__ void gchunk_commit(LAS unsigned char* buf, int lt, const u32x4 (&pf)[GChunk<TY>::NRL], float lamv) {
    typedef GChunk<TY> G; constexpr int K = G::K, PPR = K * 2 / 16, RQ = G::RQ;
#pragma unroll
    for (int i = 0; i < RQ; ++i) { const int p = i * 256 + lt;
        *(LAS u32x4*)(buf + G::OFF_QP + (p / PPR) * G::QPITCH + (p % PPR) * 16) = pf[i];
        *(LAS u32x4*)(buf + G::OFF_KT + (p >> 3) * 144 + (p & 7) * 16) = pf[RQ + i]; }
#pragma unroll
    for (int i = 0; i < 2; ++i) { const int p = i * 256 + lt; *(LAS u32x4*)(buf + G::OFF_A + (p >> 3) * 144 + (p & 7) * 16) = pf[2 * RQ + i]; }
#pragma unroll
    for (int i = 0; i < 4; ++i) { const int p = i * 256 + lt; *(LAS u32x4*)(buf + G::OFF_VT + (p >> 3) * 144 + (p & 7) * 16) = pf[2 * RQ + 2 + i]; }
    if (lt < K) *(LAS float*)(buf + G::OFF_LAM + lt * 4) = lamv;
}
template <int TY>
__device__ __forceinline__ void gchunk_compute(LAS unsigned char* buf, f32x16 (&S)[GChunk<TY>::K / 32], bf16_t* orow, int vs, int lane) {
    typedef GChunk<TY> G; constexpr int K = G::K, KT_ = K / 32;
    const int r = lane & 31, hh = lane >> 5;
    bf16x8 vf[4];
#pragma unroll
    for (int ts = 0; ts < 4; ++ts) vf[ts] = *(const LAS bf16x8*)(buf + G::OFF_VT + (32 * vs + r) * 144 + ts * 32 + hh * 16);
    f32x16 o[2];
#pragma unroll
    for (int it = 0; it < 2; ++it) {
#pragma unroll
        for (int i = 0; i < 16; ++i) o[it][i] = 0.f; }
#pragma unroll
    for (int kt = 0; kt < KT_; ++kt) { const bf16x8 b0 = pack_step<0>(S[kt]), b1 = pack_step<1>(S[kt]);
#pragma unroll
        for (int it = 0; it < 2; ++it) { const bf16x8 q0 = *(const LAS bf16x8*)(buf + G::OFF_QP + (32 * it + r) * G::QPITCH + (2 * kt) * 32 + hh * 16), q1 = *(const LAS bf16x8*)(buf + G::OFF_QP + (32 * it + r) * G::QPITCH + (2 * kt + 1) * 32 + hh * 16);
            o[it] = MFMA32(q0, b0, o[it]); o[it] = MFMA32(q1, b1, o[it]); }
        __builtin_amdgcn_sched_barrier(0); }
#pragma unroll
    for (int ts = 0; ts < 4; ++ts)
#pragma unroll
        for (int it = 0; it < 2; ++it) { const bf16x8 af = *(const LAS bf16x8*)(buf + G::OFF_A + (32 * it + r) * 144 + ts * 32 + hh * 16);
            o[it] = MFMA32(af, vf[ts], o[it]); }
    __builtin_amdgcn_sched_barrier(0);
#pragma unroll
    for (int kt = 0; kt < KT_; ++kt) {
        __builtin_amdgcn_sched_barrier(0);
#pragma unroll
        for (int g = 0; g < 4; ++g) { const f32x4 lm = *(const LAS f32x4*)(buf + G::OFF_LAM + (32 * kt + 8 * g + 4 * hh) * 4);
#pragma unroll
            for (int j = 0; j < 4; ++j) S[kt][4 * g + j] *= lm[j]; }
#pragma unroll
        for (int ts = 0; ts < 4; ++ts) { const bf16x8 kf = *(const LAS bf16x8*)(buf + G::OFF_KT + (32 * kt + r) * 144 + ts * 32 + hh * 16);
            S[kt] = MFMA32(kf, vf[ts], S[kt]); } }
    __builtin_amdgcn_sched_barrier(0);
#pragma unroll
    for (int it = 0; it < 2; ++it)
#pragma unroll
        for (int i = 0; i < 16; ++i) orow[(size_t)(32 * it + crow16(i, hh)) * 2048 + 32 * vs + r] = f2bf(o[it][i]);
}
template <int L, int TY>
__device__ __forceinline__ void chain_g(const Ctx& c, int b, int h, int d) {
    typedef GChunk<TY> G; constexpr int KT_ = G::K / 32;
    ARGS_REF a = *c.a;
    const unsigned char* scr = a.ws + WS_SCR;
    LAS unsigned char* buf = c.lds + LDS_SCR;
    static_assert(G::BYTES <= 65536, "two chunk buffers must fit the scratch region");
#define CHUNK_OF(m) (d ? ((m) < 4 ? 3 - (m) : 263 - (m)) : (m))
    __syncthreads();
    if (c.wave < 4) {
        bf16_t* ORAW = (bf16_t*)(a.ws + WS_ORAW) + (size_t)d * MT * 2048 + TY * 512 + h * 128;
        f32x16 S[KT_];
#pragma unroll
        for (int kt = 0; kt < KT_; ++kt)
#pragma unroll
            for (int i = 0; i < 16; ++i) S[kt][i] = 0.f;
        LBAR();
#pragma unroll 1
        for (int m = 0; m < 260; ++m) {
            gchunk_compute<TY>(buf + (m & 1) * 65536, S, ORAW + chunk_rowbase(b, CHUNK_OF(m)) * 2048, c.wave, c.lane);
            LBAR();
        }
    } else {
        const int lt = c.tid - 256;
        u32x4 pfA[G::NRL], pfB[G::NRL]; float lamA = 0.f, lamB = 0.f;
        gchunk_issue<TY>(scr, b, h, d, CHUNK_OF(0), lt, pfA, lamA);
        gchunk_issue<TY>(scr, b, h, d, CHUNK_OF(1), lt, pfB, lamB);
        gchunk_commit<TY>(buf, lt, pfA, lamA);
        gchunk_issue<TY>(scr, b, h, d, CHUNK_OF(2), lt, pfA, lamA);
        LBAR();
#pragma unroll 1
        for (int m = 0; m < 260; m += 2) {
            gchunk_commit<TY>(buf + 65536, lt, pfB, lamB);
            if (m + 3 < 260) gchunk_issue<TY>(scr, b, h, d, CHUNK_OF(m + 3), lt, pfB, lamB);
            LBAR();
            if (m + 2 < 260) gchunk_commit<TY>(buf, lt, pfA, lamA);
            if (m + 4 < 260) gchunk_issue<TY>(scr, b, h, d, CHUNK_OF(m + 4), lt, pfA, lamA);
            LBAR();
        }
    }
#undef CHUNK_OF
}

__device__ __forceinline__ int posU(int i) { const int w = i & 31; return (i & 32) + (((w >> 2) & 1) << 4) + (w & 3) + ((w >> 3) << 2); }
__device__ __forceinline__ constexpr int pp16(int w) { return (((w >> 2) & 1) << 3) + ((w >> 3) << 2) + (w & 3); }

__device__ __forceinline__ void trisolve64(const LAS float* A, int cidx, float (&Tc)[64]) {
#pragma unroll
    for (int pi = 0; pi < 64; ++pi) {
        float acc = (pi == cidx) ? 1.f : 0.f;
#pragma unroll
        for (int q = 0; q < (pi + 3) / 4; ++q) { const f32x4 av = *(const LAS f32x4*)(A + pi * 64 + 4 * q);
#pragma unroll
            for (int jj = 0; jj < 4; ++jj) if (4 * q + jj < pi) acc -= av[jj] * Tc[4 * q + jj]; }
        Tc[pi] = acc;
        if ((pi & 3) == 3) __builtin_amdgcn_sched_barrier(0);
    }
}

template <int L>
__device__ __forceinline__ void intra_dn_item(const Ctx& c, int b, int h, int n) {
    ARGS_REF a = *c.a; const int tid = c.tid, lane = c.lane, wave = c.wave;
    const bf16_t* PM = (const bf16_t*)(a.ws + WS_PMIX);
    unsigned char* scr = a.ws + WS_SCR;
    const int rec = (b * 4 + h) * 260 + n;
    LAS unsigned char* Qh = c.lds + LDS_SCR;
    LAS unsigned char* Kh = Qh + 17408;
    LAS unsigned char* Tp = Qh;
    LAS unsigned char* KTp = c.lds + LDS_SCR + 36864;
    LAS unsigned char* VTp = KTp + 18432;
    LAS float* Ap = (LAS float*)(VTp + 18432);
    LAS float* sm = (LAS float*)(c.lds + LDS_AUX);
    LBAR();
    {
        const int i = tid >> 3, cg = tid & 7;
        const int Ls = n < 4 ? CL : T; const int tseg = (n < 4 ? n : n - 4) * 64 + i; const size_t segbase = n < 4 ? (size_t)ML + b * CL : (size_t)b * T;
        float aq[16], ak[16], av[16];
#pragma unroll
        for (int j = 0; j < 16; ++j) { aq[j] = 0.f; ak[j] = 0.f; av[j] = 0.f; }
        const float* cw = a.in[I_DN_CW] + (size_t)L * 4 * 1536 + h * 128 + cg * 16;
#pragma unroll
        for (int tap = 0; tap < 4; ++tap) { const int ts = tseg + tap - 2;
            if (ts >= 0 && ts < Ls) { const bf16_t* rp = PM + (segbase + ts) * NMIXP + h * 128 + cg * 16; const float* w = cw + tap * 1536;
                float f0[8], f1[8];
                { const u32x4 w0 = *(const u32x4*)(rp + C_DN_Q), w1 = *(const u32x4*)(rp + C_DN_Q + 8); unpack8(w0, f0); unpack8(w1, f1); }
#pragma unroll
                for (int j = 0; j < 8; ++j) { aq[j] += w[j] * f0[j]; aq[8 + j] += w[8 + j] * f1[j]; }
                { const u32x4 w0 = *(const u32x4*)(rp + C_DN_K), w1 = *(const u32x4*)(rp + C_DN_K + 8); unpack8(w0, f0); unpack8(w1, f1); }
#pragma unroll
                for (int j = 0; j < 8; ++j) { ak[j] += w[512 + j] * f0[j]; ak[8 + j] += w[512 + 8 + j] * f1[j]; }
                { const u32x4 w0 = *(const u32x4*)(rp + C_DN_V), w1 = *(const u32x4*)(rp + C_DN_V + 8); unpack8(w0, f0); unpack8(w1, f1); }
#pragma unroll
                for (int j = 0; j < 8; ++j) { av[j] += w[1024 + j] * f0[j]; av[8 + j] += w[1024 + 8 + j] * f1[j]; } } }
        float sq = 0.f, sk = 0.f;
#pragma unroll
        for (int j = 0; j < 16; ++j) { aq[j] = siluf(aq[j]); ak[j] = siluf(ak[j]); av[j] = siluf(av[j]); sq += aq[j] * aq[j]; sk += ak[j] * ak[j]; }
        sq += __shfl_xor(sq, 1); sq += __shfl_xor(sq, 2); sq += __shfl_xor(sq, 4);
        sk += __shfl_xor(sk, 1); sk += __shfl_xor(sk, 2); sk += __shfl_xor(sk, 4);
        const float rq = __builtin_amdgcn_rsqf(sq + EPS) * 0.08838834764831845f, rk = __builtin_amdgcn_rsqf(sk + EPS);
        float qp[16];
#pragma unroll
        for (int j = 0; j < 16; ++j) { aq[j] *= rq; ak[j] *= rk; }
#pragma unroll
        for (int j = 0; j < 16; ++j) qp[pp16(j)] = aq[j];
        {   float x0[8], x1[8];
#pragma unroll
            for (int j = 0; j < 8; ++j) { x0[j] = qp[j]; x1[j] = qp[8 + j]; }
            u32x4* dst = (u32x4*)(scr + SC_DN_QS + (size_t)rec * 16384 + i * 256 + cg * 32); dst[0] = pack8(x0); dst[1] = pack8(x1);
#pragma unroll
            for (int j = 0; j < 8; ++j) { x0[j] = aq[j]; x1[j] = aq[8 + j]; }
            *(LAS u32x4*)(Qh + i * 272 + cg * 32) = pack8(x0); *(LAS u32x4*)(Qh + i * 272 + cg * 32 + 16) = pack8(x1);
#pragma unroll
            for (int j = 0; j < 8; ++j) { x0[j] = ak[j]; x1[j] = ak[8 + j]; }
            *(LAS u32x4*)(Kh + i * 272 + cg * 32) = pack8(x0); *(LAS u32x4*)(Kh + i * 272 + cg * 32 + 16) = pack8(x1); }
        const int pj = permpos(i);
#pragma unroll
        for (int j = 0; j < 16; ++j) { *(LAS bf16_t*)(KTp + (cg * 16 + j) * 144 + pj * 2) = f2bf(ak[j]); *(LAS bf16_t*)(VTp + (cg * 16 + j) * 144 + pj * 2) = f2bf(av[j]); }
        if (tid < 128) { const int d = tid >> 6, t = tid & 63; const bf16_t* rp = PM + (chunk_rowbase(b, n) + t) * NMIXP;
            const float g = -expf(a.in[I_DN_ALOG][(L * 2 + d) * 4 + h]) * softplusf(bf1(rp + C_DN_A + d * 4 + h) + a.in[I_DN_DTB][(L * 2 + d) * 4 + h]);
            sm[d * 256 + t] = g; sm[d * 256 + 128 + t] = sigm(bf1(rp + C_DN_B + d * 4 + h)); }
    }
    LBAR();
    const int r = lane & 31, hh = lane >> 5;
    f32x16 gram;
#pragma unroll
    for (int i = 0; i < 16; ++i) gram[i] = 0.f;
    const int t1 = (wave & 3) >> 1, t2 = wave & 1;
#pragma unroll
    for (int ks = 0; ks < 8; ++ks) {
        const bf16x8 af = *(const LAS bf16x8*)(Kh + (32 * (wave < 4 ? t2 : t1) + r) * 272 + ks * 32 + hh * 16);
        const bf16x8 bfr = *(const LAS bf16x8*)((wave < 4 ? Qh : Kh) + (32 * (wave < 4 ? t1 : t2) + r) * 272 + ks * 32 + hh * 16);
        gram = MFMA32(af, bfr, gram); }
    {
        u32x4* dst = (u32x4*)(scr + SC_DN_KT + (size_t)rec * 16384);
#pragma unroll
        for (int q = 0; q < 2; ++q) { const int p = q * 512 + tid; dst[p] = *(const LAS u32x4*)(KTp + (p >> 3) * 144 + (p & 7) * 16); } }
    if (tid < 128) { const int d = tid >> 6, t = tid & 63; float acc = 0.f;
        for (int tt = 0; tt < 64; ++tt) { const float g = sm[d * 256 + tt]; if (d ? (tt >= t) : (tt <= t)) acc += g; }
        sm[d * 256 + 64 + t] = acc; }
    LBAR();
#pragma unroll 1
    for (int d = 0; d < 2; ++d) {
        const LAS float* gc = sm + d * 256 + 64; const LAS float* be = sm + d * 256 + 128;
        const size_t drec = (size_t)((d * 8 + b * 4 + h) * 260 + n);
        if (wave < 4) {
            const int i = 32 * t1 + r; const float gi = gc[i]; float o[16];
#pragma unroll
            for (int idx = 0; idx < 16; ++idx) { const int j = 32 * t2 + crow16(idx, hh); const bool ok = d ? (j >= i) : (j <= i); o[idx] = ok ? gram[idx] * __expf(fminf(gi - gc[j], 0.f)) : 0.f; }
            float x0[8], x1[8];
#pragma unroll
            for (int j = 0; j < 8; ++j) { x0[j] = o[j]; x1[j] = o[8 + j]; }
            bf16_t* ap = (bf16_t*)(scr + SC_DN_AQK + drec * 8192) + i * 64 + 32 * t2 + 8 * hh;
            *(u32x4*)ap = pack8(x0); *(u32x4*)(ap + 16) = pack8(x1);
        } else {
            const int j = 32 * t2 + r; const float gj = gc[j]; const int pj = d ? 63 - j : j;
#pragma unroll
            for (int idx = 0; idx < 16; ++idx) { const int i = 32 * t1 + crow16(idx, hh); const int pi = d ? 63 - i : i;
                Ap[d * 4096 + pi * 64 + pj] = (pj < pi) ? be[i] * gram[idx] * __expf(fminf(gc[i] - gj, 0.f)) : 0.f; }
        }
        if (tid < 64) { const float gtot = d ? gc[0] : gc[63]; float* sc = (float*)(scr + SC_DN_SC + drec * 1024);
            const float eg = __expf(gc[tid]); sc[tid] = eg; sc[64 + tid] = __expf(gtot - gc[tid]); if (tid == 0) sc[128] = __expf(gtot); sm[d * 256 + 192 + tid] = eg; }
    }
    LBAR();
    if (wave < 2) {
        const int d = wave; float Tc[64];
        trisolve64(Ap + d * 4096, lane, Tc);
        const int j = d ? 63 - lane : lane; const float bj = sm[d * 256 + 128 + j], ej = sm[d * 256 + 192 + j]; const int pj2 = permpos(j) * 2;
        LAS unsigned char* T1 = Tp + d * 18432; LAS unsigned char* T2 = T1 + 9216;
#pragma unroll
        for (int pi = 0; pi < 64; ++pi) { const int i = d ? 63 - pi : pi; const float v1 = Tc[pi] * bj;
            *(LAS bf16_t*)(T1 + i * 144 + pj2) = f2bf(v1); *(LAS bf16_t*)(T2 + i * 144 + pj2) = f2bf(v1 * ej); }
    }
    LBAR();
#pragma unroll 1
    for (int q = 0; q < 4; ++q) {
        const int tile = wave * 4 + q, d = tile >> 4, isw = (tile >> 3) & 1, it = (tile >> 2) & 1, xt = tile & 3;
        const size_t drec = (size_t)((d * 8 + b * 4 + h) * 260 + n);
        LAS unsigned char* T1 = Tp + d * 18432; LAS unsigned char* T2 = T1 + 9216;
        f32x16 acc;
#pragma unroll
        for (int i = 0; i < 16; ++i) acc[i] = 0.f;
        if (!isw) {
#pragma unroll
            for (int js = 0; js < 4; ++js) { const bf16x8 af = *(const LAS bf16x8*)(T1 + (32 * it + r) * 144 + js * 32 + hh * 16), bfr = *(const LAS bf16x8*)(VTp + (32 * xt + r) * 144 + js * 32 + hh * 16);
                acc = MFMA32(af, bfr, acc); }
            float x0[8], x1[8];
#pragma unroll
            for (int j = 0; j < 8; ++j) { x0[j] = acc[j]; x1[j] = acc[8 + j]; }
            bf16_t* up = (bf16_t*)(scr + SC_DN_UT + drec * 16384) + (32 * xt + r) * 64 + it * 32 + hh * 16;
            *(u32x4*)up = pack8(x0); *(u32x4*)(up + 8) = pack8(x1);
        } else {
#pragma unroll
            for (int js = 0; js < 4; ++js) { const bf16x8 af = *(const LAS bf16x8*)(KTp + (32 * xt + r) * 144 + js * 32 + hh * 16), bfr = *(const LAS bf16x8*)(T2 + (32 * it + r) * 144 + js * 32 + hh * 16);
                acc = MFMA32(af, bfr, acc); }
            float x0[8], x1[8];
#pragma unroll
            for (int j = 0; j < 8; ++j) { x0[j] = -acc[j]; x1[j] = -acc[8 + j]; }
            bf16_t* wp = (bf16_t*)(scr + SC_DN_WN + drec * 16384) + (32 * it + r) * 128 + 32 * xt + 8 * hh;
            *(u32x4*)wp = pack8(x0); *(u32x4*)(wp + 16) = pack8(x1);
        }
    }
}

struct DChunk { static constexpr int OFF_QS = 0, OFF_KT = 17408, OFF_UT = OFF_KT + 18432, OFF_WN = OFF_UT + 18432, OFF_AQK = OFF_WN + 17408, OFF_SC = OFF_AQK + 9216, BYTES = OFF_SC + 1024, NRL = 18; };
__device__ __forceinline__ void dchunk_issue(const unsigned char* scr, int b, int h, int d, int n, int lt, u32x4 (&pf)[DChunk::NRL], f32x4& scv) {
    const size_t drec = (size_t)((d * 8 + b * 4 + h) * 260 + n), rec = (size_t)((b * 4 + h) * 260 + n);
    const u32x4* qs = (const u32x4*)(scr + SC_DN_QS + rec * 16384); const u32x4* kt = (const u32x4*)(scr + SC_DN_KT + rec * 16384);
    const u32x4* ut = (const u32x4*)(scr + SC_DN_UT + drec * 16384); const u32x4* wn = (const u32x4*)(scr + SC_DN_WN + drec * 16384);
    const u32x4* aq = (const u32x4*)(scr + SC_DN_AQK + drec * 8192);
#pragma unroll
    for (int i = 0; i < 4; ++i) { pf[i] = qs[i * 256 + lt]; pf[4 + i] = kt[i * 256 + lt]; pf[8 + i] = ut[i * 256 + lt]; pf[12 + i] = wn[i * 256 + lt]; }
    pf[16] = aq[lt]; pf[17] = aq[256 + lt];
    if (lt < 64) scv = ((const f32x4*)(scr + SC_DN_SC + drec * 1024))[lt];
}
__device__ __forceinline__ void dchunk_commit(LAS unsigned char* buf, int lt, const u32x4 (&pf)[DChunk::NRL], const f32x4 scv) {
    typedef DChunk G;
#pragma unroll
    for (int i = 0; i < 4; ++i) { const int p = i * 256 + lt;
        *(LAS u32x4*)(buf + G::OFF_QS + (p >> 4) * 272 + (p & 15) * 16) = pf[i];
        *(LAS u32x4*)(buf + G::OFF_KT + (p >> 3) * 144 + (p & 7) * 16) = pf[4 + i];
        *(LAS u32x4*)(buf + G::OFF_UT + (p >> 3) * 144 + (p & 7) * 16) = pf[8 + i];
        *(LAS u32x4*)(buf + G::OFF_WN + (p >> 4) * 272 + (p & 15) * 16) = pf[12 + i]; }
#pragma unroll
    for (int i = 0; i < 2; ++i) { const int p = i * 256 + lt; *(LAS u32x4*)(buf + G::OFF_AQK + (p >> 3) * 144 + (p & 7) * 16) = pf[16 + i]; }
    if (lt < 64) *(LAS f32x4*)(buf + G::OFF_SC + lt * 16) = scv;
}
__device__ __forceinline__ void dchunk_compute(LAS unsigned char* buf, f32x16 (&S)[4], bf16_t* orow, int vs, int lane) {
    typedef DChunk G; const int r = lane & 31, hh = lane >> 5;
    f32x16 vn[2], o[2];
#pragma unroll
    for (int it = 0; it < 2; ++it) { const u32x4 u0 = *(const LAS u32x4*)(buf + G::OFF_UT + (32 * vs + r) * 144 + it * 64 + hh * 32), u1 = *(const LAS u32x4*)(buf + G::OFF_UT + (32 * vs + r) * 144 + it * 64 + hh * 32 + 16);
        float f0[8], f1[8]; unpack8(u0, f0); unpack8(u1, f1);
#pragma unroll
        for (int j = 0; j < 8; ++j) { vn[it][j] = f0[j]; vn[it][8 + j] = f1[j]; o[it][j] = 0.f; o[it][8 + j] = 0.f; } }
#pragma unroll
    for (int kt = 0; kt < 4; ++kt) { const bf16x8 b0 = pack_step<0>(S[kt]), b1 = pack_step<1>(S[kt]);
#pragma unroll
        for (int it = 0; it < 2; ++it) {
            const bf16x8 w0 = *(const LAS bf16x8*)(buf + G::OFF_WN + (32 * it + r) * 272 + (2 * kt) * 32 + hh * 16), w1 = *(const LAS bf16x8*)(buf + G::OFF_WN + (32 * it + r) * 272 + (2 * kt + 1) * 32 + hh * 16);
            const bf16x8 q0 = *(const LAS bf16x8*)(buf + G::OFF_QS + (32 * it + r) * 272 + (2 * kt) * 32 + hh * 16), q1 = *(const LAS bf16x8*)(buf + G::OFF_QS + (32 * it + r) * 272 + (2 * kt + 1) * 32 + hh * 16);
            vn[it] = MFMA32(w0, b0, vn[it]); o[it] = MFMA32(q0, b0, o[it]); vn[it] = MFMA32(w1, b1, vn[it]); o[it] = MFMA32(q1, b1, o[it]); }
        __builtin_amdgcn_sched_barrier(0); }
#pragma unroll
    for (int it = 0; it < 2; ++it)
#pragma unroll
        for (int g = 0; g < 4; ++g) { const f32x4 e = *(const LAS f32x4*)(buf + G::OFF_SC + (32 * it + 8 * g + 4 * hh) * 4);
#pragma unroll
            for (int j = 0; j < 4; ++j) o[it][4 * g + j] *= e[j]; }
    __builtin_amdgcn_sched_barrier(0);
#pragma unroll
    for (int jt = 0; jt < 2; ++jt) { const bf16x8 p0 = pack_step<0>(vn[jt]), p1 = pack_step<1>(vn[jt]);
#pragma unroll
        for (int it = 0; it < 2; ++it) { const bf16x8 a0 = *(const LAS bf16x8*)(buf + G::OFF_AQK + (32 * it + r) * 144 + (2 * jt) * 32 + hh * 16), a1 = *(const LAS bf16x8*)(buf + G::OFF_AQK + (32 * it + r) * 144 + (2 * jt + 1) * 32 + hh * 16);
            o[it] = MFMA32(a0, p0, o[it]); o[it] = MFMA32(a1, p1, o[it]); } }
    __builtin_amdgcn_sched_barrier(0);
#pragma unroll
    for (int jt = 0; jt < 2; ++jt)
#pragma unroll
        for (int g = 0; g < 4; ++g) { const f32x4 e = *(const LAS f32x4*)(buf + G::OFF_SC + 256 + (32 * jt + 8 * g + 4 * hh) * 4);
#pragma unroll
            for (int j = 0; j < 4; ++j) vn[jt][4 * g + j] *= e[j]; }
    const float glast = *(const LAS float*)(buf + G::OFF_SC + 512);
    const bf16x8 p00 = pack_step<0>(vn[0]), p01 = pack_step<1>(vn[0]), p10 = pack_step<0>(vn[1]), p11 = pack_step<1>(vn[1]);
    __builtin_amdgcn_sched_barrier(0);
#pragma unroll
    for (int kt = 0; kt < 4; ++kt) {
#pragma unroll
        for (int i = 0; i < 16; ++i) S[kt][i] *= glast;
        const LAS unsigned char* kb = buf + G::OFF_KT + (32 * kt + r) * 144 + hh * 16;
        S[kt] = MFMA32(*(const LAS bf16x8*)(kb), p00, S[kt]); S[kt] = MFMA32(*(const LAS bf16x8*)(kb + 32), p01, S[kt]);
        S[kt] = MFMA32(*(const LAS bf16x8*)(kb + 64), p10, S[kt]); S[kt] = MFMA32(*(const LAS bf16x8*)(kb + 96), p11, S[kt]);
        __builtin_amdgcn_sched_barrier(0); }
#pragma unroll
    for (int it = 0; it < 2; ++it)
#pragma unroll
        for (int i = 0; i < 16; ++i) orow[(size_t)(32 * it + crow16(i, hh)) * 2048 + 32 * vs + r] = f2bf(o[it][i]);
}
template <int L>
__device__ __forceinline__ void chain_dnc(const Ctx& c, int b, int h, int d) {
    ARGS_REF a = *c.a;
    const unsigned char* scr = a.ws + WS_SCR;
    LAS unsigned char* buf = c.lds + LDS_SCR;
#define CHUNK_OF(m) (d ? ((m) < 4 ? 3 - (m) : 263 - (m)) : (m))
    __syncthreads();
    if (c.wave < 4) {
        bf16_t* ORAW = (bf16_t*)(a.ws + WS_ORAW) + (size_t)d * MT * 2048 + 2 * 512 + h * 128;
        f32x16 S[4];
#pragma unroll
        for (int kt = 0; kt < 4; ++kt)
#pragma unroll
            for (int i = 0; i < 16; ++i) S[kt][i] = 0.f;
        LBAR();
#pragma unroll 1
        for (int m = 0; m < 260; ++m) {
            dchunk_compute(buf, S, ORAW + chunk_rowbase(b, CHUNK_OF(m)) * 2048, c.wave, c.lane);
            LBAR();
            LBAR();
        }
    } else {
        const int lt = c.tid - 256;
        u32x4 pfA[DChunk::NRL], pfB[DChunk::NRL]; f32x4 scA = {0.f, 0.f, 0.f, 0.f}, scB = scA;
        dchunk_issue(scr, b, h, d, CHUNK_OF(0), lt, pfA, scA);
        dchunk_issue(scr, b, h, d, CHUNK_OF(1), lt, pfB, scB);
        dchunk_commit(buf, lt, pfA, scA);
        dchunk_issue(scr, b, h, d, CHUNK_OF(2), lt, pfA, scA);
        LBAR();
#pragma unroll 1
        for (int m = 0; m < 260; m += 2) {
            LBAR();
            dchunk_commit(buf, lt, pfB, scB);
            if (m + 3 < 260) dchunk_issue(scr, b, h, d, CHUNK_OF(m + 3), lt, pfB, scB);
            LBAR();
            LBAR();
            if (m + 2 < 260) dchunk_commit(buf, lt, pfA, scA);
            if (m + 4 < 260) dchunk_issue(scr, b, h, d, CHUNK_OF(m + 4), lt, pfA, scA);
            LBAR();
        }
    }
#undef CHUNK_OF
}

__device__ __forceinline__ void rgw_convert(const Ctx& c) {
    ARGS_REF a = *c.a; bf16_t* dst = (bf16_t*)(a.ws + WS_RGW);
    for (int e = c.wg * 512 + c.tid; e < 32 * 16384; e += c.G * 512) { const int m = e >> 14, oc = (e >> 7) & 127, cc = e & 127, l = m >> 4, d = (m >> 3) & 1, n = (m >> 1) & 3, g = m & 1;
        const float* src = g ? a.in[I_RG_WI] : a.in[I_RG_WR];
        dst[e] = f2bf(src[((size_t)(((l * 2 + d) * 4 + n) * 128 + cc)) * 128 + oc]); }
}
template <int L>
__device__ __forceinline__ void rgprep_item2(const Ctx& c, int item) {
    ARGS_REF a = *c.a; const int tid = c.tid, lane = c.lane, wave = c.wave;
    LAS unsigned char* XB = c.lds + LDS_SCR;
    LAS float* xbT = (LAS float*)(c.lds + LDS_SCR + 17408);
    LAS float* PRE = (LAS float*)(c.lds + LDS_SCR + 52224);
    LAS float* SEG = (LAS float*)(c.lds + LDS_AUX);
    const bf16_t* PM = (const bf16_t*)(a.ws + WS_PMIX);
    bf16_t* RGLA = (bf16_t*)(a.ws + WS_RGLA); bf16_t* ORAW = (bf16_t*)(a.ws + WS_ORAW);
    float* TT = (float*)(a.ws + WS_RGTT);
    const float* cw = a.in[I_RG_CW] + L * 4 * 512; const float* cb = a.in[I_RG_CB] + L * 512;
    const int tt = item >> 2, n = item & 3;
    size_t rowbase; int t0, Ls, bb, nchunk;
    if (tt < 512) { bb = tt >> 8; rowbase = (size_t)bb * T; t0 = (tt & 255) * 64; Ls = T; nchunk = 4 + (tt & 255); }
    else { const int tc = tt - 512; bb = tc >> 2; rowbase = (size_t)ML + bb * CL; t0 = (tc & 3) * 64; Ls = CL; nchunk = tc & 3; }
    LBAR();
    {
        const int tl = tid >> 3, cg = tid & 7, ch0 = n * 128 + cg * 16;
        float acc[16];
#pragma unroll
        for (int j = 0; j < 16; ++j) acc[j] = cb[ch0 + j];
#pragma unroll
        for (int tap = 0; tap < 4; ++tap) { const int ts = t0 + tl + tap - 2;
            if (ts >= 0 && ts < Ls) { const bf16_t* rp = PM + (rowbase + ts) * NMIXP + C_RG_X + ch0; const u32x4 w0 = *(const u32x4*)rp, w1 = *(const u32x4*)(rp + 8);
                float f[8], g[8]; unpack8(w0, f); unpack8(w1, g);
#pragma unroll
                for (int j = 0; j < 8; ++j) { acc[j] += cw[tap * 512 + ch0 + j] * f[j]; acc[8 + j] += cw[tap * 512 + ch0 + 8 + j] * g[j]; } } }
#pragma unroll
        for (int j = 0; j < 16; ++j) xbT[(cg * 16 + j) * 68 + tl] = acc[j];
        float x0[8], x1[8];
#pragma unroll
        for (int j = 0; j < 8; ++j) { x0[j] = acc[j]; x1[j] = acc[8 + j]; }
        *(LAS u32x4*)(XB + tl * 272 + cg * 32) = pack8(x0); *(LAS u32x4*)(XB + tl * 272 + cg * 32 + 16) = pack8(x1);
    }
    LBAR();
    const int r = lane & 31, hh = lane >> 5, tth = wave & 1, ot = wave >> 1;
    const int oc = tid & 127, tq = tid >> 7, ch = n * 128 + oc;
#pragma unroll 1
    for (int d = 0; d < 2; ++d) {
        {
            const bf16_t* wbase = (const bf16_t*)(a.ws + WS_RGW) + (size_t)(((L * 2 + d) * 4 + n) * 2) * 16384 + (32 * ot + r) * 128 + hh * 8;
#pragma unroll
            for (int g = 0; g < 2; ++g) { f32x16 acc;
#pragma unroll
                for (int i = 0; i < 16; ++i) acc[i] = 0.f;
#pragma unroll
                for (int ks = 0; ks < 8; ++ks) { const bf16x8 af = *(const LAS bf16x8*)(XB + (32 * tth + r) * 272 + ks * 32 + hh * 16); const bf16x8 bfr = *(const bf16x8*)(wbase + g * 16384 + ks * 16);
                    acc = MFMA32(af, bfr, acc); }
#pragma unroll
                for (int gq = 0; gq < 4; ++gq) { f32x4 v = {acc[4 * gq], acc[4 * gq + 1], acc[4 * gq + 2], acc[4 * gq + 3]};
                    *(LAS f32x4*)(PRE + (g * 128 + 32 * ot + r) * 68 + 32 * tth + 8 * gq + 4 * hh) = v; } }
        }
        LBAR();
        {
            const float br = a.in[I_RG_BR][(L * 2 + d) * 512 + ch], bi = a.in[I_RG_BI][(L * 2 + d) * 512 + ch];
            const float sp = softplusf(-a.in[I_RG_LAM][(L * 2 + d) * 512 + ch]);
            float la[16], hl[16];
#pragma unroll
            for (int q = 0; q < 4; ++q) { const f32x4 pr = *(const LAS f32x4*)(PRE + oc * 68 + 16 * tq + 4 * q), pi = *(const LAS f32x4*)(PRE + (128 + oc) * 68 + 16 * tq + 4 * q), xv = *(const LAS f32x4*)(xbT + oc * 68 + 16 * tq + 4 * q);
#pragma unroll
                for (int j = 0; j < 4; ++j) { const float rr = sigm(pr[j] + br), ig = sigm(pi[j] + bi); const float l = -8.0f * rr * sp;
                    la[4 * q + j] = l; hl[4 * q + j] = __builtin_amdgcn_sqrtf(fmaxf(1.0f - __expf(2.0f * l), 0.f)) * (ig * xv[j]); } }
            float hrun = 0.f, lrun = 0.f;
            if (d == 0) {
#pragma unroll
                for (int j = 0; j < 16; ++j) { hrun = __expf(la[j]) * hrun + hl[j]; lrun += la[j]; hl[j] = hrun; la[j] = lrun; } }
            else {
#pragma unroll
                for (int j = 15; j >= 0; --j) { hrun = __expf(la[j]) * hrun + hl[j]; lrun += la[j]; hl[j] = hrun; la[j] = lrun; } }
            SEG[(tq * 128 + oc) * 2] = lrun; SEG[(tq * 128 + oc) * 2 + 1] = hrun;
            LBAR();
            float Hin = 0.f, Lin = 0.f, Htot = 0.f, Ltot = 0.f;
#pragma unroll
            for (int s = 0; s < 4; ++s) { const int sg = d ? 3 - s : s; const float ls = SEG[(sg * 128 + oc) * 2], hs = SEG[(sg * 128 + oc) * 2 + 1];
                const bool before = d ? (sg > tq) : (sg < tq);
                if (before) { Hin = __expf(ls) * Hin + hs; Lin += ls; }
                Htot = __expf(ls) * Htot + hs; Ltot += ls; }
            const size_t ob = ((size_t)d * MT + rowbase + t0 + 16 * tq);
#pragma unroll
            for (int j = 0; j < 16; ++j) { const float e = __expf(la[j]);
                ORAW[(ob + j) * 2048 + 1536 + ch] = f2bf(hl[j] + e * Hin);
                RGLA[(ob + j) * 512 + ch] = f2bf(e * __expf(Lin)); }
            if (tq == 0) { float* tp = TT + ((size_t)((d * 2 + bb) * 260 + nchunk) * 512 + ch) * 2; tp[0] = __expf(Ltot); tp[1] = Htot; }
        }
        LBAR();
    }
}
__device__ __forceinline__ void rg_carry(const Ctx& c, int part) {
    ARGS_REF a = *c.a; const int gid = part * 512 + c.tid, d = gid >> 10, b = (gid >> 9) & 1, ch = gid & 511;
    typedef float f32x2v __attribute__((ext_vector_type(2)));
    const f32x2v* TT = (const f32x2v*)(a.ws + WS_RGTT) + (size_t)((d * 2 + b) * 260) * 512 + ch;
    float* CR = (float*)(a.ws + WS_RGCARRY) + (size_t)((d * 2 + b) * 260) * 512 + ch;
    float H = 0.f;
#pragma unroll 1
    for (int m0 = 0; m0 < 260; m0 += 20) { f32x2v p[20];
#pragma unroll
        for (int j = 0; j < 20; ++j) { const int m = m0 + j, nn = d ? (m < 4 ? 3 - m : 263 - m) : m; p[j] = TT[(size_t)nn * 512]; }
#pragma unroll
        for (int j = 0; j < 20; ++j) { const int m = m0 + j, nn = d ? (m < 4 ? 3 - m : 263 - m) : m; CR[(size_t)nn * 512] = H; H = p[j].x * H + p[j].y; } }
}
#ifndef PROBE_SUB
#define PROBE_SUB 0
#endif
template <int L> __device__ __forceinline__ void gemm_gate_part(const Ctx& c, int G2, int c2);
template <int L>
__device__ __forceinline__ void intra_phase(const Ctx& c) {
    {
        ARGS_REF a = *c.a; const bf16_t* PM = (const bf16_t*)(a.ws + WS_PMIX); bf16_t* GC = (bf16_t*)(a.ws + WS_GC);
        for (int r = c.wg * 8 + c.wave; r < MT; r += c.G * 8) { const bf16_t* pm = PM + (size_t)r * NMIXP; bf16_t* gp = GC + (size_t)r * 2048; const int cb = c.lane * 8;
            const u32x4 g0 = *(const u32x4*)(pm + C_GLA_G + cb), g1 = *(const u32x4*)(pm + C_HG_G + cb), g2 = *(const u32x4*)(pm + C_DN_G + cb), g3 = *(const u32x4*)(pm + C_RG_Y + cb);
            *(u32x4*)(gp + cb) = g0; *(u32x4*)(gp + 512 + cb) = g1; *(u32x4*)(gp + 1024 + cb) = g2; *(u32x4*)(gp + 1536 + cb) = g3; } }
#pragma unroll 1
    for (int rep = 0; rep < ((PROBE_SUB & 1) ? 2 : 1); ++rep)
#pragma unroll 1
    for (int item = c.wg; item < 2080; item += c.G) rgprep_item2<L>(c, item);
#pragma unroll 1
    for (int rep = 0; rep < ((PROBE_SUB & 2) ? 2 : 1); ++rep)
#pragma unroll 1
    for (int item = (c.wg + 96) % c.G; item < 2080; item += c.G) { const int bh = item / 260, n = item % 260; intra_g_item<L, 0>(c, bh >> 2, bh & 3, n); }
#pragma unroll 1
    for (int rep = 0; rep < ((PROBE_SUB & 4) ? 2 : 1); ++rep)
#pragma unroll 1
    for (int item = (c.wg + 192) % c.G; item < 2080; item += c.G) { const int bh = item / 260, n = item % 260; intra_g_item<L, 1>(c, bh >> 2, bh & 3, n); }
#pragma unroll 1
    for (int rep = 0; rep < ((PROBE_SUB & 8) ? 2 : 1); ++rep)
#pragma unroll 1
    for (int item = (c.wg + 32) % c.G; item < 2080; item += c.G) { const int bh = item / 260, n = item % 260; intra_dn_item<L>(c, bh >> 2, bh & 3, n); }
}
template <int L>
__device__ __forceinline__ void chains_phase(const Ctx& c) {
    const int w = c.wg;
    if (w < 32) { const int r = w & 15, b = r >> 3, h = (r >> 1) & 3, d = r & 1;
        if (w < 16) chain_g<L, 0>(c, b, h, d); else chain_g<L, 1>(c, b, h, d); }
    else if (w < 48) { const int r = w - 32, b = r >> 3, h = (r >> 1) & 3, d = r & 1; chain_dnc<L>(c, b, h, d); }
    else if (w < 52) rg_carry(c, w - 48);
    else gemm_gate_part<L>(c, c.G - 52, w - 52);
}
template <int L>
__device__ __forceinline__ void combine_phase(const Ctx& c) {
    ARGS_REF a = *c.a; const int gw = c.wg * 8 + c.wave, nw = c.G * 8, lane = c.lane;
    const bf16_t* PM = (const bf16_t*)(a.ws + WS_PMIX); const bf16_t* O0 = (const bf16_t*)(a.ws + WS_ORAW); const bf16_t* O1 = O0 + (size_t)MT * 2048;
    bf16_t* O = (bf16_t*)(a.ws + WS_O);
    const int cb = lane * 8, hv = cb & 127;
    float nwv[3][8];
#pragma unroll
    for (int j = 0; j < 8; ++j) { nwv[0][j] = a.in[I_GLA_NW][L * 128 + hv + j]; nwv[1][j] = a.in[I_HG_NW][L * 128 + hv + j]; nwv[2][j] = a.in[I_DN_NW][L * 128 + hv + j]; }
    const int nrows = (L == 0) ? MT : ML;
    for (int r = gw; r < nrows; r += nw) {
        const bf16_t* pm = (const bf16_t*)(a.ws + WS_GC) + (size_t)r * 2048;
#pragma unroll
        for (int br = 0; br < 3; ++br) {
            const int gcol = br * 512;
            float x0[8], x1[8], g[8], o[8];
            { const u32x4 w = *(const u32x4*)(O0 + (size_t)r * 2048 + br * 512 + cb); unpack8(w, x0); }
            { const u32x4 w = *(const u32x4*)(O1 + (size_t)r * 2048 + br * 512 + cb); unpack8(w, x1); }
            { const u32x4 w = *(const u32x4*)(pm + gcol + cb); unpack8(w, g); }
            float ss = 0.f;
#pragma unroll
            for (int j = 0; j < 8; ++j) { o[j] = x0[j] + x1[j]; ss += o[j] * o[j]; }
            ss += __shfl_xor(ss, 1); ss += __shfl_xor(ss, 2); ss += __shfl_xor(ss, 4); ss += __shfl_xor(ss, 8);
            const float rs = __builtin_amdgcn_rsqf(ss * (1.0f / 128.0f) + EPS);
#pragma unroll
            for (int j = 0; j < 8; ++j) o[j] = o[j] * rs * nwv[br][j] * siluf(g[j]);
            *(u32x4*)(O + ((size_t)br * MT + r) * 512 + cb) = pack8(o);
        }
        {   float x0[8], x1[8], p0[8], p1[8], y[8], o[8];
            const int bb = r < ML ? (r >> 14) : ((r - ML) >> 8), nchunk = r < ML ? 4 + ((r & 16383) >> 6) : (((r - ML) & 255) >> 6);
            const bf16_t* RGLA = (const bf16_t*)(a.ws + WS_RGLA); const float* CR = (const float*)(a.ws + WS_RGCARRY);
            { const u32x4 w = *(const u32x4*)(O0 + (size_t)r * 2048 + 1536 + cb); unpack8(w, x0); }
            { const u32x4 w = *(const u32x4*)(O1 + (size_t)r * 2048 + 1536 + cb); unpack8(w, x1); }
            { const u32x4 w = *(const u32x4*)(RGLA + (size_t)r * 512 + cb); unpack8(w, p0); }
            { const u32x4 w = *(const u32x4*)(RGLA + ((size_t)MT + r) * 512 + cb); unpack8(w, p1); }
            { const u32x4 w = *(const u32x4*)(pm + 3 * 512 + cb); unpack8(w, y); }
            const float* c0 = CR + (size_t)((0 * 2 + bb) * 260 + nchunk) * 512 + cb; const float* c1 = CR + (size_t)((1 * 2 + bb) * 260 + nchunk) * 512 + cb;
            const f32x4 ca = *(const f32x4*)c0, cb2 = *(const f32x4*)(c0 + 4), cc = *(const f32x4*)c1, cd = *(const f32x4*)(c1 + 4);
#pragma unroll
            for (int j = 0; j < 8; ++j) { const float k0 = j < 4 ? ca[j & 3] : cb2[j & 3], k1 = j < 4 ? cc[j & 3] : cd[j & 3];
                o[j] = gelu_tanh(y[j]) * ((x0[j] + p0[j] * k0) + (x1[j] + p1[j] * k1)); }
            *(u32x4*)(O + ((size_t)3 * MT + r) * 512 + cb) = pack8(o);
        }
    }
}

__device__ __forceinline__ void route1_phase(const Ctx& c) {
    ARGS_REF a = *c.a; const int lane = c.lane;
    const float* modv = (const float*)(a.ws + WS_MOD) + (size_t)1 * 3 * 12288 + 3 * 2048;
    const float* normw = a.in[I_NORMW] + (1 * 2 + 1) * 2048;
    const float* router = a.in[I_ROUTER];
    bf16_t* H = (bf16_t*)(a.ws + WS_H);
    unsigned* topi = (unsigned*)(a.ws + WS_TOPI); float* topw = (float*)(a.ws + WS_TOPW);
    volatile LAS int* hist = (volatile LAS int*)(c.lds + LDS_AUX);
    if (c.tid < 8) hist[c.tid] = 0;
    __syncthreads();
    const int rpw = ML / c.G;
    for (int rr = c.wave; rr < rpw; rr += 8) {
        const int r = c.wg * rpw + rr, b = r >> 14;
        const float* src = (const float*)a.out + (size_t)r * D;
        f32x4 v[8];
#pragma unroll
        for (int j = 0; j < 8; ++j) v[j] = *(const f32x4*)(src + (j * 64 + lane) * 4);
        const float* shift = modv + (size_t)b * 12288;
        modnorm_row(v, normw, shift, shift + 2048, lane);
        store_row_bf16(v, H + (size_t)r * D, lane);
        float lg[8];
#pragma unroll
        for (int e = 0; e < 8; ++e) lg[e] = 0.f;
#pragma unroll
        for (int j = 0; j < 8; ++j)
#pragma unroll
            for (int q = 0; q < 4; ++q) { const int cc = (j * 64 + lane) * 4 + q; const f32x4 r0 = *(const f32x4*)(router + cc * 8), r1 = *(const f32x4*)(router + cc * 8 + 4); const float x = v[j][q];
                lg[0] += x * r0[0]; lg[1] += x * r0[1]; lg[2] += x * r0[2]; lg[3] += x * r0[3]; lg[4] += x * r1[0]; lg[5] += x * r1[1]; lg[6] += x * r1[2]; lg[7] += x * r1[3]; }
#pragma unroll
        for (int e = 0; e < 8; ++e) lg[e] = wave_sum(lg[e]);
        int e0 = 0; float m0 = lg[0];
#pragma unroll
        for (int e = 1; e < 8; ++e) if (lg[e] > m0) { m0 = lg[e]; e0 = e; }
        int e1 = -1; float m1 = -3.0e38f;
#pragma unroll
        for (int e = 0; e < 8; ++e) if (e != e0 && lg[e] > m1) { m1 = lg[e]; e1 = e; }
        if (e1 < 0) { e1 = (e0 + 1) & 7; m1 = m0; }
        if (lane == 0) { const float ex = __expf(m1 - m0); const float w0 = 1.0f / (1.0f + ex); topi[r] = (unsigned)e0 | ((unsigned)e1 << 8); topw[2 * r] = w0; topw[2 * r + 1] = ex * w0;
            lds_add(&hist[e0]); lds_add(&hist[e1]); }
    }
    __syncthreads();
    if (c.tid < 8) ((int*)(a.ws + WS_CTL + CTL_WGH))[c.wg * 8 + c.tid] = hist[c.tid];
}
__device__ __forceinline__ void route2_phase(const Ctx& c) {
    ARGS_REF a = *c.a; const int lane = c.lane, tid = c.tid;
    const int* wgh = (const int*)(a.ws + WS_CTL + CTL_WGH);
    volatile LAS int* tab = (volatile LAS int*)(c.lds + LDS_AUX);
    if (tid < 8) { int tot = 0, base = 0; for (int w = 0; w < c.G; ++w) { const int v = wgh[w * 8 + tid]; tot += v; if (w < c.wg) base += v; } tab[tid] = tot; tab[8 + tid] = base; tab[24 + tid] = 0; tab[32 + tid] = (tot + 255) / 256 * 256; }
    __syncthreads();
    if (tid == 0) { int acc = 0; for (int e = 0; e < 8; ++e) { tab[16 + e] = acc; acc += tab[32 + e]; }
        if (c.wg == 0) { int* meta = (int*)(a.ws + WS_CTL + CTL_META); int cum = 0; for (int e = 0; e < 8; ++e) { cum += tab[32 + e] / 256; meta[e] = cum; } meta[8] = cum; } }
    __syncthreads();
    const bf16_t* H = (const bf16_t*)(a.ws + WS_H); bf16_t* GATH = (bf16_t*)(a.ws + WS_GATH);
    const unsigned* topi = (const unsigned*)(a.ws + WS_TOPI); int* dest = (int*)(a.ws + WS_DEST);
    const int rpw = ML / c.G;
    for (int rr = c.wave; rr < rpw; rr += 8) {
        const int r = c.wg * rpw + rr; const unsigned ti = topi[r]; const int e0 = ti & 255, e1 = (ti >> 8) & 255;
        int d0 = 0, d1 = 0;
        if (lane == 0) { d0 = tab[16 + e0] + tab[8 + e0] + lds_add(&tab[24 + e0]); d1 = tab[16 + e1] + tab[8 + e1] + lds_add(&tab[24 + e1]); dest[2 * r] = d0; dest[2 * r + 1] = d1; }
        d0 = __shfl(d0, 0); d1 = __shfl(d1, 0);
        const u32x4* sp = (const u32x4*)(H + (size_t)r * D); u32x4* p0 = (u32x4*)(GATH + (size_t)d0 * D); u32x4* p1 = (u32x4*)(GATH + (size_t)d1 * D);
#pragma unroll
        for (int j = 0; j < 4; ++j) { const u32x4 w = sp[j * 64 + lane]; p0[j * 64 + lane] = w; p1[j * 64 + lane] = w; }
    }
    if (c.wg < 8) { const int e = c.wg; const int lo = tab[16 + e] + tab[e], hi = tab[16 + e] + tab[32 + e]; const u32x4 z = {0u, 0u, 0u, 0u};
        for (int r = lo + c.wave; r < hi; r += 8) { u32x4* p = (u32x4*)(GATH + (size_t)r * D);
#pragma unroll
            for (int j = 0; j < 4; ++j) p[j * 64 + lane] = z; } }
}
__device__ __forceinline__ void final_phase(const Ctx& c) {
    ARGS_REF a = *c.a; const int gw = c.wg * 8 + c.wave, nw = c.G * 8, lane = c.lane;
    const float* modv = (const float*)(a.ws + WS_MOD) + (size_t)1 * 3 * 12288 + 5 * 2048;
    const bf16_t* Y = (const bf16_t*)(a.ws + WS_GATH); const int* dest = (const int*)(a.ws + WS_DEST); const float* topw = (const float*)(a.ws + WS_TOPW);
    const float* fw = a.in[I_FNORMW];
    for (int r = gw; r < ML; r += nw) {
        const int b = r >> 14; float* xr = a.out + (size_t)r * D; const float* mg = modv + (size_t)b * 12288;
        const int d0 = dest[2 * r], d1 = dest[2 * r + 1]; const float w0 = topw[2 * r], w1 = topw[2 * r + 1];
        const bf16_t* y0 = Y + (size_t)d0 * D; const bf16_t* y1 = Y + (size_t)d1 * D;
        f32x4 v[8]; float ss = 0.f;
#pragma unroll
        for (int j = 0; j < 8; ++j) { const int cc = (j * 64 + lane) * 4; const f32x4 x = *(const f32x4*)(xr + cc), g = *(const f32x4*)(mg + cc);
            const u32x2 a0 = *(const u32x2*)(y0 + cc), a1 = *(const u32x2*)(y1 + cc);
            f32x4 m; m[0] = w0 * bflo(a0.x) + w1 * bflo(a1.x); m[1] = w0 * bfhi(a0.x) + w1 * bfhi(a1.x); m[2] = w0 * bflo(a0.y) + w1 * bflo(a1.y); m[3] = w0 * bfhi(a0.y) + w1 * bfhi(a1.y);
            v[j] = x + g * m; ss += v[j][0] * v[j][0] + v[j][1] * v[j][1] + v[j][2] * v[j][2] + v[j][3] * v[j][3]; }
        ss = wave_sum(ss); const float rstd = __builtin_amdgcn_rsqf(ss * (1.0f / 2048.0f) + EPS);
#pragma unroll
        for (int j = 0; j < 8; ++j) { const int cc = (j * 64 + lane) * 4; const f32x4 w = *(const f32x4*)(fw + cc); *(f32x4*)(xr + cc) = v[j] * rstd * w; }
    }
}

#ifndef N_LAUNCHES
#define N_LAUNCHES 1
#endif
constexpr int N_PHASES = 23;

template <int L>
__device__ __forceinline__ void gemm_projmix(const Ctx& c) {
    ARGS_REF a = *c.a;
    pg8::Gemm g{(const bf16_t*)(a.ws + WS_H), (const bf16_t*)(a.ws + WS_WIN + (size_t)L * WIN_BYTES), MT, NMIXP, D};
    pg8::StaticOrder S; S.init(MT, NMIXP, c.G, c.wg);
    pg8::EpiBf16S<false> E{(bf16_t*)(a.ws + WS_PMIX), NMIXP, 1.0f};
    pg8::gemm_phase<pg8::EpiBf16S<false>, pg8::StaticOrder, true, true>(c.lds + LDS_SCR, g, S, E);
}
template <int L>
__device__ __forceinline__ void gemm_gate_part(const Ctx& c, int G2, int c2) {
    ARGS_REF a = *c.a; constexpr int M = (L == 0) ? MT : ML;
    pg8::Gemm g{(const bf16_t*)(a.ws + WS_H8), (const bf16_t*)(a.ws + WS_WG8 + (size_t)L * WG8_BYTES), M, NGATE, D / 2};
    pg8::StaticOrder S; S.init(M, NGATE, G2, c2);
    pg8::EpiBf16S<true> E{(bf16_t*)(a.ws + WS_PGATE), NGATE, 1.0f / 256.0f};
    pg8::gemm_phase8<pg8::EpiBf16S<true>, pg8::StaticOrder, true, true>(c.lds + LDS_SCR, g, S, E);
}
template <int L>
__device__ __forceinline__ void gemm_upgate(const Ctx& c) {
    ARGS_REF a = *c.a; constexpr int M = (L == 0) ? MT : ML;
    pg8::Gemm g{(const bf16_t*)(a.ws + WS_O), (const bf16_t*)(a.ws + WS_WUP + (size_t)L * 8388608), M, 2048, 512};
    pg8::UpGateOrder S; S.init(M, c.G, c.wg, MT / 256);
    pg8::EpiUpGate E{(const bf16_t*)(a.ws + WS_PGATE), (float*)(a.ws + WS_MACC), (bf16_t*)(a.ws + WS_MERGED), MT / 256};
    pg8::gemm_phase<pg8::EpiUpGate, pg8::UpGateOrder, true, true>(c.lds + LDS_SCR, g, S, E);
}
template <int L>
__device__ __forceinline__ void gemm_wout(const Ctx& c) {
    ARGS_REF a = *c.a; constexpr int M = (L == 0) ? MT : ML;
    pg8::Gemm g{(const bf16_t*)(a.ws + WS_MERGED), (const bf16_t*)(a.ws + WS_WOUT + (size_t)L * 8388608), M, D, D};
    pg8::StaticOrder S; S.init(M, D, c.G, c.wg);
    const float* modv = (const float*)(a.ws + WS_MOD) + (size_t)L * 3 * 12288 + 2 * 2048;
    pg8::EpiResid E{L == 0 ? a.in[I_X] : (const float*)a.out, a.out, L == 0 ? a.in[I_CTX] : (const float*)(a.ws + WS_XC), (float*)(a.ws + WS_XC), modv, L == 1 ? 1 : 0};
    pg8::gemm_phase<pg8::EpiResid, pg8::StaticOrder, true, true>(c.lds + LDS_SCR, g, S, E);
}
__device__ __forceinline__ void gemm_ffn13(const Ctx& c) {
    ARGS_REF a = *c.a;
    pg8::Gemm g{(const bf16_t*)(a.ws + WS_H), (const bf16_t*)(a.ws + WS_F13), MT, 2 * FF, D};
    pg8::StaticOrder S; S.init(MT, 2 * FF, c.G, c.wg);
    pg8::EpiSwiglu E{(bf16_t*)(a.ws + WS_HID), 2 * FF / 256};
    pg8::gemm_phase<pg8::EpiSwiglu, pg8::StaticOrder, true, true>(c.lds + LDS_SCR, g, S, E);
}
__device__ __forceinline__ void gemm_ffn2(const Ctx& c) {
    ARGS_REF a = *c.a;
    pg8::Gemm g{(const bf16_t*)(a.ws + WS_HID), (const bf16_t*)(a.ws + WS_F2), MT, D, FF};
    pg8::StaticOrder S; S.init(MT, D, c.G, c.wg);
    const float* modv = (const float*)(a.ws + WS_MOD) + (size_t)0 * 3 * 12288 + 5 * 2048;
    pg8::EpiResid E{(const float*)a.out, a.out, (const float*)(a.ws + WS_XC), (float*)(a.ws + WS_XC), modv, 0};
    pg8::gemm_phase<pg8::EpiResid, pg8::StaticOrder, true, true>(c.lds + LDS_SCR, g, S, E);
}
__device__ __forceinline__ void gemm_moe13(const Ctx& c) {
    ARGS_REF a = *c.a; const int* meta = (const int*)(a.ws + WS_CTL + CTL_META);
    int be[8];
#pragma unroll
    for (int e = 0; e < 8; ++e) be[e] = __builtin_amdgcn_readfirstlane(meta[e]);
    pg8::Gemm g{(const bf16_t*)(a.ws + WS_GATH), (const bf16_t*)(a.ws + WS_M13), MOE_ROWS, 2 * FF, D};
    pg8::MoeOrder S; S.init(be[7], 2 * FF / 256, c.G, c.wg, be);
    pg8::EpiSwiglu E{(bf16_t*)(a.ws + WS_HIDM), 2 * FF / 256};
    pg8::gemm_phase<pg8::EpiSwiglu, pg8::MoeOrder, true, true>(c.lds + LDS_SCR, g, S, E);
}
__device__ __forceinline__ void gemm_moe2(const Ctx& c) {
    ARGS_REF a = *c.a; const int* meta = (const int*)(a.ws + WS_CTL + CTL_META);
    int be[8];
#pragma unroll
    for (int e = 0; e < 8; ++e) be[e] = __builtin_amdgcn_readfirstlane(meta[e]);
    pg8::Gemm g{(const bf16_t*)(a.ws + WS_HIDM), (const bf16_t*)(a.ws + WS_M2), MOE_ROWS, D, FF};
    pg8::MoeOrder S; S.init(be[7], D / 256, c.G, c.wg, be);
    pg8::EpiPlainBf16 E{(bf16_t*)(a.ws + WS_GATH), D, D / 256};
    pg8::gemm_phase<pg8::EpiPlainBf16, pg8::MoeOrder, true, true>(c.lds + LDS_SCR, g, S, E);
}

__device__ __forceinline__ void prologue_phase(const Ctx& c) {
    ARGS_REF a = *c.a; int rot = 0;
    mod_phase(c);
    rgw_convert(c);
    for (int l = 0; l < 2; ++l) {
        conv_job<1>(c, a.in[I_WIN] + (size_t)l * D * DIN, nullptr, DIN, D, NMIXP, (bf16_t*)(a.ws + WS_WIN + (size_t)l * WIN_BYTES), rot);
        conv_job8(c, a.in[I_WIN] + (size_t)l * D * DIN + NMIX, DIN, D, NGATE, (unsigned char*)(a.ws + WS_WG8 + (size_t)l * WG8_BYTES), 64.0f, rot);
        for (int b = 0; b < 4; ++b) conv_job<0>(c, a.in[I_WUP] + (size_t)(l * 4 + b) * 512 * D, nullptr, D, 512, D, (bf16_t*)(a.ws + WS_WUP + (size_t)l * 8388608 + (size_t)b * 2048 * 512 * 2), rot);
        conv_job<0>(c, a.in[I_WOUT] + (size_t)l * D * D, nullptr, D, D, D, (bf16_t*)(a.ws + WS_WOUT + (size_t)l * 8388608), rot);
    }
    conv_job<2>(c, a.in[I_F1], a.in[I_F3], FF, D, 2 * FF, (bf16_t*)(a.ws + WS_F13), rot);
    conv_job<0>(c, a.in[I_F2], nullptr, D, FF, D, (bf16_t*)(a.ws + WS_F2), rot);
}
__device__ __forceinline__ void moeconv_phase(const Ctx& c) {
    ARGS_REF a = *c.a; int rot = 0;
    for (int e = 0; e < 8; ++e) {
        conv_job<2>(c, a.in[I_M1] + (size_t)e * D * FF, a.in[I_M3] + (size_t)e * D * FF, FF, D, 2 * FF, (bf16_t*)(a.ws + WS_M13 + (size_t)e * 46137344), rot);
        conv_job<0>(c, a.in[I_M2] + (size_t)e * FF * D, nullptr, D, FF, D, (bf16_t*)(a.ws + WS_M2 + (size_t)e * 23068672), rot);
    }
}

__global__ void __launch_bounds__(512, 2) fwd_kernel(Args args) {
    extern __shared__ __attribute__((aligned(16))) unsigned char lds_raw[];
    volatile LAS unsigned* misc = (volatile LAS unsigned*)((LAS unsigned char*)lds_raw + LDS_MISC);
    if (threadIdx.x < 16) misc[threadIdx.x] = 0u;
    __syncthreads();
    const int lo = args.ph_lo, hi = args.ph_hi;
    XcdBarrier bar; bar.bar = (unsigned*)(args.ws + WS_CTL + CTL_BAR); bar.x = 0; bar.st = misc;
    if (hi - lo > 1) bar = xcd_barrier_post((unsigned*)(args.ws + WS_CTL + CTL_BAR), misc);
#define IN(k) (lo <= (k) && (k) < hi)
#define MKCTX Ctx c; { int t_ = threadIdx.x; asm volatile("" : "+v"(t_)); { ArgsP kp_ = (ArgsP)__builtin_amdgcn_kernarg_segment_ptr(); asm volatile("" : "+s"(kp_)); c.a = kp_; } c.lds = (LAS unsigned char*)lds_raw; c.tid = t_; c.lane = t_ & 63; c.wave = __builtin_amdgcn_readfirstlane(t_ >> 6); c.wg = blockIdx.x; c.G = gridDim.x; }
#ifndef PROBE_MASK
#define PROBE_MASK 0u
#endif
#define REP(k, ...) if ((PROBE_MASK >> (k)) & 1u) { __syncthreads(); __VA_ARGS__; }
#define SEAM(k) do { if (IN(k) && IN((k) + 1)) xcd_barrier(bar); } while (0)
    if (IN(0)) { MKCTX prologue_phase(c); REP(0, prologue_phase(c)) } SEAM(0);
    if (IN(1)) { MKCTX norm_phase<0, 0>(c); REP(1, norm_phase<0, 0>(c)) } SEAM(1);
    if (IN(2)) { MKCTX gemm_projmix<0>(c); REP(2, gemm_projmix<0>(c)) } SEAM(2);
    if (IN(3)) { MKCTX intra_phase<0>(c); REP(3, intra_phase<0>(c)) } SEAM(3);
    if (IN(4)) { MKCTX chains_phase<0>(c); REP(4, chains_phase<0>(c)) } SEAM(4);
    if (IN(5)) { MKCTX combine_phase<0>(c); REP(5, combine_phase<0>(c)) } SEAM(5);
    if (IN(6)) { MKCTX gemm_upgate<0>(c); REP(6, gemm_upgate<0>(c)) } SEAM(6);
    if (IN(7)) { MKCTX gemm_wout<0>(c); } SEAM(7);
    if (IN(8)) { MKCTX norm_phase<0, 1>(c); REP(8, norm_phase<0, 1>(c)) } SEAM(8);
    if (IN(9)) { MKCTX gemm_ffn13(c); REP(9, gemm_ffn13(c)) } SEAM(9);
    if (IN(10)) { MKCTX gemm_ffn2(c); } SEAM(10);
    if (IN(11)) { MKCTX norm_phase<1, 0>(c); REP(11, norm_phase<1, 0>(c)) } SEAM(11);
    if (IN(12)) { MKCTX gemm_projmix<1>(c); REP(12, gemm_projmix<1>(c)) } SEAM(12);
    if (IN(13)) { MKCTX intra_phase<1>(c); REP(13, intra_phase<1>(c)) } SEAM(13);
    if (IN(14)) { MKCTX chains_phase<1>(c); REP(14, chains_phase<1>(c)) } SEAM(14);
    if (IN(15)) { MKCTX combine_phase<1>(c); REP(15, combine_phase<1>(c)) } SEAM(15);
    if (IN(16)) { MKCTX gemm_upgate<1>(c); REP(16, gemm_upgate<1>(c)) } SEAM(16);
    if (IN(17)) { MKCTX gemm_wout<1>(c); } SEAM(17);
    if (IN(18)) { MKCTX route1_phase(c); __syncthreads(); moeconv_phase(c); REP(18, route1_phase(c); __syncthreads(); moeconv_phase(c)) } SEAM(18);
    if (IN(19)) { MKCTX route2_phase(c); REP(19, route2_phase(c)) } SEAM(19);
    if (IN(20)) { MKCTX gemm_moe13(c); REP(20, gemm_moe13(c)) } SEAM(20);
    if (IN(21)) { MKCTX gemm_moe2(c); REP(21, gemm_moe2(c)) } SEAM(21);
    if (IN(22)) { MKCTX final_phase(c); }
#undef IN
#undef SEAM
}

extern "C" void kernel_launch(void* const* d_in, const int* in_sizes, int n_in, void* d_out, int out_size, void* d_ws, size_t ws_size, hipStream_t stream) {
    static int grid = 0;
    if (grid == 0) {
        if (n_in != N_IN || out_size != ML * D || ws_size < WS_END) { fprintf(stderr, "kernel_launch: unexpected shapes: n_in %d out %d ws %zu (need %zu)\n", n_in, out_size, ws_size, (size_t)WS_END); grid = -1; return; }
        int dev = 0, cus = 0;
        if (hipGetDevice(&dev) != hipSuccess || hipDeviceGetAttribute(&cus, hipDeviceAttributeMultiprocessorCount, dev) != hipSuccess) { grid = -1; return; }
        if (hipFuncSetAttribute((const void*)fwd_kernel, hipFuncAttributeMaxDynamicSharedMemorySize, LDS_BYTES) != hipSuccess) { fprintf(stderr, "kernel_launch: hipFuncSetAttribute failed\n"); grid = -1; return; }
        int per_cu = 0;
        if (hipOccupancyMaxActiveBlocksPerMultiprocessor(&per_cu, (const void*)fwd_kernel, 512, LDS_BYTES) != hipSuccess || per_cu < 1) { fprintf(stderr, "kernel_launch: occupancy query says %d\n", per_cu); }
        (void)hipGetLastError();
        grid = cus > 256 ? 256 : cus;
    }
    if (grid < 0) return;
    (void)hipMemsetAsync((char*)d_ws + WS_CTL, 0, CTL_BYTES, stream);
    Args a{};
    for (int i = 0; i < N_IN; ++i) a.in[i] = (const float*)d_in[i];
    a.out = (float*)d_out; a.ws = (unsigned char*)d_ws;
#if N_LAUNCHES == 1
    a.ph_lo = 0; a.ph_hi = N_PHASES;
    hipLaunchKernelGGL(fwd_kernel, dim3(grid), dim3(512), LDS_BYTES, stream, a);
#else
    for (int p = 0; p < N_PHASES; ++p) { a.ph_lo = p; a.ph_hi = p + 1; hipLaunchKernelGGL(fwd_kernel, dim3(grid), dim3(512), LDS_BYTES, stream, a); }
#endif
}
```

```cpp
#include <hip/hip_runtime.h>
#include <cstdio>
#include <cstdint>
#define N_LAUNCHES 1
namespace pg8 {
#define PG8_LAS __attribute__((address_space(3)))
typedef unsigned short bf16_t;
typedef short bf16x8 __attribute__((ext_vector_type(8)));
typedef float f32x4 __attribute__((ext_vector_type(4)));
typedef unsigned u32x4 __attribute__((ext_vector_type(4)));
constexpr int BM = 256, BK = 64, HALF = 128, HTB = HALF * BK * 2  , STAGE_BYTES = 8 * HTB, NXCD = 8, WGM = 8;

__host__ __device__ __forceinline__ int lds_byte(int r, int c) { const int st = (r >> 4) * 2 + (c >> 5), rr = r & 15, cc = c & 31, ob = rr * 64 + cc * 2; return st * 1024 + (ob ^ (((ob >> 9) & 1) << 5)); }
__host__ __device__ __forceinline__ void stage_rc(int b, int& R, int& C) { const int st = b / 1024, sb = b % 1024, swz = sb ^ (((sb >> 9) & 1) << 5); R = (st >> 1) * 16 + swz / 64; C = (st & 1) * 32 + (swz % 64) / 2; }
__host__ __device__ __forceinline__ int perm32(int rho) { const int n = rho >> 4, i = rho & 15; return 8 * (i >> 2) + 4 * n + (i & 3); }

struct Unit { int pm, pn; };
struct Gemm { const bf16_t* A; const bf16_t* Bt; int M, N, K; };

struct StaticOrder {
    int nM, nN, nwg, G, c;
    __host__ __device__ void init(int M, int N, int G_, int c_) { nM = M / BM; nN = N / BM; nwg = nM * nN; G = G_; c = c_; }
    __host__ __device__ bool next(int i, Unit& u) const {
        const long L = (long)i * G + c; if (L >= nwg) return false;
        int wgid = (int)L; { const int q = nwg / NXCD, r = nwg % NXCD, xcd = wgid % NXCD, off = wgid / NXCD; wgid = (xcd < r ? xcd * (q + 1) : r * (q + 1) + (xcd - r) * q) + off; }
        const int nig = WGM * nN, gid = wgid / nig, fm = gid * WGM, gsz = (nM - fm) < WGM ? (nM - fm) : WGM;
        u.pm = fm + ((wgid % nig) % gsz); u.pn = (wgid % nig) / gsz; return true;
    }
    __device__ __forceinline__ void a_ready(const Unit&) const {}
    __device__ __forceinline__ void done(const Unit&) const {}
};
__device__ __forceinline__ unsigned cvt_pk_bf16(float lo, float hi) { unsigned r; asm volatile("v_cvt_pk_bf16_f32 %0, %1, %2" : "=v"(r) : "v"(lo), "v"(hi)); return r; }
typedef __bf16 bf16x2_t __attribute__((ext_vector_type(2)));
typedef float f32x2c_t __attribute__((ext_vector_type(2)));
__device__ __forceinline__ unsigned cvt_pk_bf16_safe(float lo, float hi) { const f32x2c_t v = {lo, hi}; return __builtin_bit_cast(unsigned, __builtin_convertvector(v, bf16x2_t)); }
template <class Epi, class Sched, bool ALIGN_EPI = false, bool SP2 = false>
__device__ __forceinline__ void gemm_phase(PG8_LAS unsigned char* lds, const Gemm g, const Sched& S, const Epi& E) {
    int tid_ = threadIdx.x; asm volatile("" : "+v"(tid_));
    const int tid = tid_, wid = __builtin_amdgcn_readfirstlane(tid >> 6), lane = tid & 63, wr = wid >> 2, wc = wid & 3, fr = lane & 15, fq = lane >> 4;
    const int K = g.K, nt = K / BK;
    unsigned voffA[2], voffB[2];
#pragma unroll
    for (int i = 0; i < 2; ++i) { int R, C; stage_rc(tid * 16 + i * 8192, R, C); const int Rb = Epi::PERM ? ((R & ~31) + perm32(R & 31)) : R;
        voffA[i] = (unsigned)(R * K + C) * 2u; voffB[i] = (unsigned)(Rb * K + C) * 2u; }
    const size_t kstep = (size_t)(BK * 2);
    const size_t hstep = (size_t)HALF * K * 2;
    const size_t tstep = 2 * hstep;
    const unsigned ldsw = (unsigned)wid * 1024u;
    const int aoff = lds_byte(wr * 64 + fr, fq * 8), boff = lds_byte(wc * 32 + fr, fq * 8);
#define PG8_SA(b, h) (((b) * 2 + (h)) * HTB)
#define PG8_SB(b, h) ((4 + (b) * 2 + (h)) * HTB)
#define PG8_STAGE(bufoff, gbase, voff) do { _Pragma("unroll") for (int _i = 0; _i < 2; ++_i) \
        __builtin_amdgcn_global_load_lds((const unsigned*)((const char*)(gbase) + (voff)[_i]), (PG8_LAS unsigned*)(lds + (bufoff) + ldsw + _i * 8192), 16, 0, 0); } while (0)
#define PG8_LDA(dst, b, h) do { _Pragma("unroll") for (int m = 0; m < 4; ++m) _Pragma("unroll") for (int k = 0; k < 2; ++k) dst[m][k] = *(const PG8_LAS bf16x8*)(lds + PG8_SA(b, h) + aoff + m * 2048 + k * 1024); } while (0)
#define PG8_LDB(dst, b, h) do { _Pragma("unroll") for (int n = 0; n < 2; ++n) _Pragma("unroll") for (int k = 0; k < 2; ++k) dst[n][k] = *(const PG8_LAS bf16x8*)(lds + PG8_SB(b, h) + boff + n * 2048 + k * 1024); } while (0)
#define PG8_MMA(ai, bj, At, Bt) do { __builtin_amdgcn_s_setprio(1); _Pragma("unroll") for (int m = 0; m < 4; ++m) _Pragma("unroll") for (int n = 0; n < 2; ++n) _Pragma("unroll") for (int k = 0; k < 2; ++k) \
        acc[ai][bj][m][n] = __builtin_amdgcn_mfma_f32_16x16x32_bf16(Bt[n][k], At[m][k], acc[ai][bj][m][n], 0, 0, 0); __builtin_amdgcn_s_setprio(0); } while (0)
#define PG8_WAIT_V(n) asm volatile("s_waitcnt vmcnt(" #n ")" ::: "memory")
#define PG8_WAIT_L(n) asm volatile("s_waitcnt lgkmcnt(" #n ")" ::: "memory")
#define PG8_BAR __builtin_amdgcn_s_barrier()
#define PG8_SCHED __builtin_amdgcn_sched_barrier(0)
    Unit cur, nxt; int ui = 0;
    if (!S.next(0, cur)) return;
    f32x4 acc[2][2][4][2];
#pragma unroll
    for (int a = 0; a < 2; ++a)
#pragma unroll
        for (int b = 0; b < 2; ++b)
#pragma unroll
            for (int m = 0; m < 4; ++m)
#pragma unroll
                for (int n = 0; n < 2; ++n) acc[a][b][m][n] = (f32x4){0.f, 0.f, 0.f, 0.f};
    bf16x8 At[4][2], B0[2][2], B1[2][2];
    const char* cA = (const char*)g.A + (size_t)cur.pm * tstep; const char* cB = (const char*)g.Bt + (size_t)cur.pn * tstep;
    S.a_ready(cur);
    if constexpr (SP2) {
        PG8_STAGE(PG8_SB(0, 0), cB, voffB); PG8_STAGE(PG8_SB(0, 1), cB + hstep, voffB); PG8_STAGE(PG8_SA(0, 0), cA, voffA); PG8_STAGE(PG8_SA(0, 1), cA + hstep, voffA);
        if (wr == 1) PG8_BAR;
        PG8_WAIT_V(2); PG8_BAR;
        PG8_STAGE(PG8_SB(1, 0), cB + kstep, voffB); PG8_STAGE(PG8_SA(1, 0), cA + kstep, voffA); PG8_STAGE(PG8_SB(1, 1), cB + hstep + kstep, voffB);
        PG8_WAIT_V(6); PG8_BAR;
    } else {
        PG8_STAGE(PG8_SB(0, 0), cB, voffB); PG8_STAGE(PG8_SA(0, 0), cA, voffA); PG8_STAGE(PG8_SB(0, 1), cB + hstep, voffB); PG8_STAGE(PG8_SA(0, 1), cA + hstep, voffA);
        if (wr == 1) PG8_BAR;
        PG8_WAIT_V(4); PG8_BAR;
        PG8_STAGE(PG8_SB(1, 0), cB + kstep, voffB); PG8_STAGE(PG8_SA(1, 0), cA + kstep, voffA); PG8_STAGE(PG8_SB(1, 1), cB + hstep + kstep, voffB);
        PG8_WAIT_V(6); PG8_BAR;
    }
    for (;;) {
        const bool has_next = S.next(ui + 1, nxt);
        const char* nA = has_next ? (const char*)g.A + (size_t)nxt.pm * tstep : cA; const char* nB = has_next ? (const char*)g.Bt + (size_t)nxt.pn * tstep : cB;
        for (int t = 0; t < nt; t += 2) {
            const bool last = (t == nt - 2);
            const char* a1 = cA + (size_t)(t + 1) * kstep;
            const char* a2 = last ? nA : cA + (size_t)(t + 2) * kstep; const char* b2 = last ? nB : cB + (size_t)(t + 2) * kstep;
            const char* a3 = a2 + kstep; const char* b3 = b2 + kstep;
            if (last && has_next) S.a_ready(nxt);
            if constexpr (SP2) {
            PG8_LDB(B0, 0, 0); PG8_LDB(B1, 0, 1); PG8_SCHED; PG8_LDA(At, 0, 0); PG8_STAGE(PG8_SA(1, 1), a1 + hstep, voffA);
            PG8_WAIT_V(8); PG8_WAIT_L(0); PG8_BAR; PG8_MMA(0, 0, At, B0); PG8_MMA(0, 1, At, B1); PG8_BAR; PG8_SCHED;
            PG8_LDA(At, 0, 1); PG8_STAGE(PG8_SB(0, 0), b2, voffB); PG8_STAGE(PG8_SB(0, 1), b2 + hstep, voffB); PG8_STAGE(PG8_SA(0, 0), a2, voffA);
            PG8_WAIT_V(8); PG8_WAIT_L(0); PG8_BAR; PG8_MMA(1, 0, At, B0); PG8_MMA(1, 1, At, B1); PG8_BAR; PG8_SCHED;
            PG8_LDB(B0, 1, 0); PG8_LDB(B1, 1, 1); PG8_SCHED; PG8_LDA(At, 1, 0); PG8_STAGE(PG8_SA(0, 1), a2 + hstep, voffA);
            PG8_WAIT_V(8); PG8_WAIT_L(0); PG8_BAR; PG8_MMA(0, 0, At, B0); PG8_MMA(0, 1, At, B1); PG8_BAR; PG8_SCHED;
            PG8_LDA(At, 1, 1); PG8_STAGE(PG8_SB(1, 0), b3, voffB); PG8_STAGE(PG8_SB(1, 1), b3 + hstep, voffB); PG8_STAGE(PG8_SA(1, 0), a3, voffA);
            PG8_WAIT_V(8); PG8_WAIT_L(0); PG8_BAR; PG8_MMA(1, 0, At, B0); PG8_MMA(1, 1, At, B1); PG8_BAR; PG8_SCHED;
            } else {
            PG8_LDB(B0, 0, 0); PG8_SCHED; PG8_LDA(At, 0, 0); PG8_STAGE(PG8_SA(1, 1), a1 + hstep, voffA);
            PG8_WAIT_L(8); PG8_BAR; PG8_WAIT_L(0); PG8_MMA(0, 0, At, B0); PG8_BAR; PG8_SCHED;
            PG8_LDB(B1, 0, 1); PG8_STAGE(PG8_SB(0, 0), b2, voffB);
            PG8_BAR; PG8_WAIT_L(0); PG8_MMA(0, 1, At, B1); PG8_BAR;
            PG8_LDA(At, 0, 1); PG8_STAGE(PG8_SA(0, 0), a2, voffA);
            PG8_BAR; PG8_WAIT_L(0); PG8_MMA(1, 0, At, B0); PG8_BAR; PG8_SCHED;
            PG8_STAGE(PG8_SB(0, 1), b2 + hstep, voffB);
            PG8_WAIT_V(6); PG8_BAR; PG8_MMA(1, 1, At, B1); PG8_BAR;
            PG8_LDB(B0, 1, 0); PG8_SCHED; PG8_LDA(At, 1, 0); PG8_STAGE(PG8_SA(0, 1), a2 + hstep, voffA);
            PG8_WAIT_L(8); PG8_BAR; PG8_WAIT_L(0); PG8_MMA(0, 0, At, B0); PG8_BAR; PG8_SCHED;
            PG8_LDB(B1, 1, 1); PG8_STAGE(PG8_SB(1, 0), b3, voffB);
            PG8_BAR; PG8_WAIT_L(0); PG8_MMA(0, 1, At, B1); PG8_BAR;
            PG8_LDA(At, 1, 1); PG8_STAGE(PG8_SA(1, 0), a3, voffA);
            PG8_BAR; PG8_WAIT_L(0); PG8_MMA(1, 0, At, B0); PG8_BAR; PG8_SCHED;
            PG8_STAGE(PG8_SB(1, 1), b3 + hstep, voffB);
            PG8_WAIT_V(6); PG8_BAR; PG8_MMA(1, 1, At, B1); PG8_BAR;
            }
        }
        if constexpr (ALIGN_EPI) { if (wr == 0) PG8_BAR; }
        if constexpr (!Epi::AFTER_DRAIN) { E(acc, cur, wr, wc, fr, fq); S.done(cur); }
        if (!has_next) break;
#pragma unroll
        for (int a = 0; a < 2; ++a)
#pragma unroll
            for (int b = 0; b < 2; ++b)
#pragma unroll
                for (int m = 0; m < 4; ++m)
#pragma unroll
                    for (int n = 0; n < 2; ++n) acc[a][b][m][n] = (f32x4){0.f, 0.f, 0.f, 0.f};
        cur = nxt; cA = nA; cB = nB; ++ui;
        if constexpr (ALIGN_EPI) { if (wr == 1) PG8_BAR; }
    }
    PG8_WAIT_V(0);
    if constexpr (!ALIGN_EPI) { if (wr == 0) PG8_BAR; }
    PG8_BAR;
    if constexpr (Epi::AFTER_DRAIN) { E.fused(acc, cur, wr, wc, fr, fq, lds, wid, lane); S.done(cur); }
#undef PG8_SA
#undef PG8_SB
#undef PG8_STAGE
#undef PG8_LDA
#undef PG8_LDB
#undef PG8_MMA
#undef PG8_WAIT_V
#undef PG8_WAIT_L
#undef PG8_BAR
#undef PG8_SCHED
}

typedef int i32x4 __attribute__((ext_vector_type(4)));
typedef int i32x8 __attribute__((ext_vector_type(8)));
template <class Epi, class Sched, bool ALIGN_EPI = false, bool SP2 = false>
__device__ __forceinline__ void gemm_phase8(PG8_LAS unsigned char* lds, const Gemm g, const Sched& S, const Epi& E) {
    int tid_ = threadIdx.x; asm volatile("" : "+v"(tid_));
    const int tid = tid_, wid = __builtin_amdgcn_readfirstlane(tid >> 6), lane = tid & 63, wr = wid >> 2, wc = wid & 3, fr = lane & 15, fq = lane >> 4;
    const int K = g.K, nt = K / BK;
    unsigned voffA[2], voffB[2];
#pragma unroll
    for (int i = 0; i < 2; ++i) { int R, C; stage_rc(tid * 16 + i * 8192, R, C); const int Rb = Epi::PERM ? ((R & ~31) + perm32(R & 31)) : R;
        voffA[i] = (unsigned)(R * K + C) * 2u; voffB[i] = (unsigned)(Rb * K + C) * 2u; }
    const size_t kstep = (size_t)(BK * 2);
    const size_t hstep = (size_t)HALF * K * 2;
    const size_t tstep = 2 * hstep;
    const unsigned ldsw = (unsigned)wid * 1024u;
    const int aoff = lds_byte(wr * 64 + fr, fq * 8), boff = lds_byte(wc * 32 + fr, fq * 8);
#define PG8_SA(b, h) (((b) * 2 + (h)) * HTB)
#define PG8_SB(b, h) ((4 + (b) * 2 + (h)) * HTB)
#define PG8_STAGE(bufoff, gbase, voff) do { _Pragma("unroll") for (int _i = 0; _i < 2; ++_i) \
        __builtin_amdgcn_global_load_lds((const unsigned*)((const char*)(gbase) + (voff)[_i]), (PG8_LAS unsigned*)(lds + (bufoff) + ldsw + _i * 8192), 16, 0, 0); } while (0)
#define PG8_LD8(addr) __builtin_shufflevector(__builtin_bit_cast(i32x4, *(const PG8_LAS bf16x8*)(addr)), __builtin_bit_cast(i32x4, *(const PG8_LAS bf16x8*)((addr) + 1024)), 0, 1, 2, 3, 4, 5, 6, 7)
#define PG8_LDA(dst, b, h) do { _Pragma("unroll") for (int m = 0; m < 4; ++m) dst[m] = PG8_LD8(lds + PG8_SA(b, h) + aoff + m * 2048); } while (0)
#define PG8_LDB(dst, b, h) do { _Pragma("unroll") for (int n = 0; n < 2; ++n) dst[n] = PG8_LD8(lds + PG8_SB(b, h) + boff + n * 2048); } while (0)
#define PG8_MMA(ai, bj, At, Bt) do { __builtin_amdgcn_s_setprio(1); _Pragma("unroll") for (int m = 0; m < 4; ++m) _Pragma("unroll") for (int n = 0; n < 2; ++n) \
        asm volatile("v_mfma_f32_16x16x128_f8f6f4 %0, %1, %2, %0" : "+v"(acc[ai][bj][m][n]) : "v"(Bt[n]), "v"(At[m])); __builtin_amdgcn_s_setprio(0); } while (0)
#define PG8_WAIT_V(n) asm volatile("s_waitcnt vmcnt(" #n ")" ::: "memory")
#define PG8_WAIT_L(n) asm volatile("s_waitcnt lgkmcnt(" #n ")" ::: "memory")
#define PG8_BAR __builtin_amdgcn_s_barrier()
#define PG8_SCHED __builtin_amdgcn_sched_barrier(0)
    Unit cur, nxt; int ui = 0;
    if (!S.next(0, cur)) return;
    f32x4 acc[2][2][4][2];
#pragma unroll
    for (int a = 0; a < 2; ++a)
#pragma unroll
        for (int b = 0; b < 2; ++b)
#pragma unroll
            for (int m = 0; m < 4; ++m)
#pragma unroll
                for (int n = 0; n < 2; ++n) acc[a][b][m][n] = (f32x4){0.f, 0.f, 0.f, 0.f};
    i32x8 At[4], B0[2], B1[2];
    const char* cA = (const char*)g.A + (size_t)cur.pm * tstep; const char* cB = (const char*)g.Bt + (size_t)cur.pn * tstep;
    S.a_ready(cur);
    if constexpr (SP2) {
        PG8_STAGE(PG8_SB(0, 0), cB, voffB); PG8_STAGE(PG8_SB(0, 1), cB + hstep, voffB); PG8_STAGE(PG8_SA(0, 0), cA, voffA); PG8_STAGE(PG8_SA(0, 1), cA + hstep, voffA);
        if (wr == 1) PG8_BAR;
        PG8_WAIT_V(2); PG8_BAR;
        PG8_STAGE(PG8_SB(1, 0), cB + kstep, voffB); PG8_STAGE(PG8_SA(1, 0), cA + kstep, voffA); PG8_STAGE(PG8_SB(1, 1), cB + hstep + kstep, voffB);
        PG8_WAIT_V(6); PG8_BAR;
    } else {
        PG8_STAGE(PG8_SB(0, 0), cB, voffB); PG8_STAGE(PG8_SA(0, 0), cA, voffA); PG8_STAGE(PG8_SB(0, 1), cB + hstep, voffB); PG8_STAGE(PG8_SA(0, 1), cA + hstep, voffA);
        if (wr == 1) PG8_BAR;
        PG8_WAIT_V(4); PG8_BAR;
        PG8_STAGE(PG8_SB(1, 0), cB + kstep, voffB); PG8_STAGE(PG8_SA(1, 0), cA + kstep, voffA); PG8_STAGE(PG8_SB(1, 1), cB + hstep + kstep, voffB);
        PG8_WAIT_V(6); PG8_BAR;
    }
    for (;;) {
        const bool has_next = S.next(ui + 1, nxt);
        const char* nA = has_next ? (const char*)g.A + (size_t)nxt.pm * tstep : cA; const char* nB = has_next ? (const char*)g.Bt + (size_t)nxt.pn * tstep : cB;
        for (int t = 0; t < nt; t += 2) {
            const bool last = (t == nt - 2);
            const char* a1 = cA + (size_t)(t + 1) * kstep;
            const char* a2 = last ? nA : cA + (size_t)(t + 2) * kstep; const char* b2 = last ? nB : cB + (size_t)(t + 2) * kstep;
            const char* a3 = a2 + kstep; const char* b3 = b2 + kstep;
            if (last && has_next) S.a_ready(nxt);
            if constexpr (SP2) {
            PG8_LDB(B0, 0, 0); PG8_LDB(B1, 0, 1); PG8_SCHED; PG8_LDA(At, 0, 0); PG8_STAGE(PG8_SA(1, 1), a1 + hstep, voffA);
            PG8_WAIT_V(8); PG8_WAIT_L(0); PG8_BAR; PG8_MMA(0, 0, At, B0); PG8_MMA(0, 1, At, B1); PG8_BAR; PG8_SCHED;
            PG8_LDA(At, 0, 1); PG8_STAGE(PG8_SB(0, 0), b2, voffB); PG8_STAGE(PG8_SB(0, 1), b2 + hstep, voffB); PG8_STAGE(PG8_SA(0, 0), a2, voffA);
            PG8_WAIT_V(8); PG8_WAIT_L(0); PG8_BAR; PG8_MMA(1, 0, At, B0); PG8_MMA(1, 1, At, B1); PG8_BAR; PG8_SCHED;
            PG8_LDB(B0, 1, 0); PG8_LDB(B1, 1, 1); PG8_SCHED; PG8_LDA(At, 1, 0); PG8_STAGE(PG8_SA(0, 1), a2 + hstep, voffA);
            PG8_WAIT_V(8); PG8_WAIT_L(0); PG8_BAR; PG8_MMA(0, 0, At, B0); PG8_MMA(0, 1, At, B1); PG8_BAR; PG8_SCHED;
            PG8_LDA(At, 1, 1); PG8_STAGE(PG8_SB(1, 0), b3, voffB); PG8_STAGE(PG8_SB(1, 1), b3 + hstep, voffB); PG8_STAGE(PG8_SA(1, 0), a3, voffA);
            PG8_WAIT_V(8); PG8_WAIT_L(0); PG8_BAR; PG8_MMA(1, 0, At, B0); PG8_MMA(1, 1, At, B1); PG8_BAR; PG8_SCHED;
            } else {
            PG8_LDB(B0, 0, 0); PG8_SCHED; PG8_LDA(At, 0, 0); PG8_STAGE(PG8_SA(1, 1), a1 + hstep, voffA);
            PG8_WAIT_L(8); PG8_BAR; PG8_WAIT_L(0); PG8_MMA(0, 0, At, B0); PG8_BAR; PG8_SCHED;
            PG8_LDB(B1, 0, 1); PG8_STAGE(PG8_SB(0, 0), b2, voffB);
            PG8_BAR; PG8_WAIT_L(0); PG8_MMA(0, 1, At, B1); PG8_BAR;
            PG8_LDA(At, 0, 1); PG8_STAGE(PG8_SA(0, 0), a2, voffA);
            PG8_BAR; PG8_WAIT_L(0); PG8_MMA(1, 0, At, B0); PG8_BAR; PG8_SCHED;
            PG8_STAGE(PG8_SB(0, 1), b2 + hstep, voffB);
            PG8_WAIT_V(6); PG8_BAR; PG8_MMA(1, 1, At, B1); PG8_BAR;
            PG8_LDB(B0, 1, 0); PG8_SCHED; PG8_LDA(At, 1, 0); PG8_STAGE(PG8_SA(0, 1), a2 + hstep, voffA);
            PG8_WAIT_L(8); PG8_BAR; PG8_WAIT_L(0); PG8_MMA(0, 0, At, B0); PG8_BAR; PG8_SCHED;
            PG8_LDB(B1, 1, 1); PG8_STAGE(PG8_SB(1, 0), b3, voffB);
            PG8_BAR; PG8_WAIT_L(0); PG8_MMA(0, 1, At, B1); PG8_BAR;
            PG8_LDA(At, 1, 1); PG8_STAGE(PG8_SA(1, 0), a3, voffA);
            PG8_BAR; PG8_WAIT_L(0); PG8_MMA(1, 0, At, B0); PG8_BAR; PG8_SCHED;
            PG8_STAGE(PG8_SB(1, 1), b3 + hstep, voffB);
            PG8_WAIT_V(6); PG8_BAR; PG8_MMA(1, 1, At, B1); PG8_BAR;
            }
        }
        if constexpr (ALIGN_EPI) { if (wr == 0) PG8_BAR; }
        asm volatile("s_nop 15\n\ts_nop 15" ::: "memory");
        if constexpr (!Epi::AFTER_DRAIN) { E(acc, cur, wr, wc, fr, fq); S.done(cur); }
        if (!has_next) break;
#pragma unroll
        for (int a = 0; a < 2; ++a)
#pragma unroll
            for (int b = 0; b < 2; ++b)
#pragma unroll
                for (int m = 0; m < 4; ++m)
#pragma unroll
                    for (int n = 0; n < 2; ++n) acc[a][b][m][n] = (f32x4){0.f, 0.f, 0.f, 0.f};
        cur = nxt; cA = nA; cB = nB; ++ui;
        if constexpr (ALIGN_EPI) { if (wr == 1) PG8_BAR; }
    }
    PG8_WAIT_V(0);
    if constexpr (!ALIGN_EPI) { if (wr == 0) PG8_BAR; }
    PG8_BAR;
    if constexpr (Epi::AFTER_DRAIN) { E.fused(acc, cur, wr, wc, fr, fq, lds, wid, lane); S.done(cur); }
#undef PG8_SA
#undef PG8_SB
#undef PG8_STAGE
#undef PG8_LD8
#undef PG8_LDA
#undef PG8_LDB
#undef PG8_MMA
#undef PG8_WAIT_V
#undef PG8_WAIT_L
#undef PG8_BAR
#undef PG8_SCHED
}
}
#define XB_TMO      128
#define XB_XCNT(j)  (256  + 64 * (j))
#define XB_XSUB(j)  (1280 + 64 * (j))
#define XB_XGEN(j)  (2304 + 64 * (j))
#define XB_TOP      3328
#define XB_TOPGEN   3392
#define XCD_BAR_WORDS 3456
#define XB_SPIN_CAP (1u << 18)
#define LAS __attribute__((address_space(3)))

__device__ __forceinline__ unsigned xb_ld(unsigned* p)              { return __hip_atomic_load(p, __ATOMIC_RELAXED, __HIP_MEMORY_SCOPE_AGENT); }
__device__ __forceinline__ unsigned xb_add(unsigned* p, unsigned v) { return __hip_atomic_fetch_add(p, v, __ATOMIC_RELAXED, __HIP_MEMORY_SCOPE_AGENT); }
__device__ __forceinline__ unsigned xb_xcc_id() { return (unsigned)__builtin_amdgcn_s_getreg((3 << 11) | 20) & 0xFu; }
#define XB_SPIN(cond, bar) do { unsigned _sp = 0; while (cond) { __builtin_amdgcn_s_sleep(1); \
    if ((++_sp & 255u) == 0u) { if (xb_ld(&(bar)[XB_TMO])) break; if (_sp > XB_SPIN_CAP) { atomicAdd(&(bar)[XB_TMO], 1u); break; } } } } while (0)

struct XcdBarrier {
    unsigned* bar; unsigned x;
    volatile LAS unsigned* st;
};

__device__ __forceinline__ XcdBarrier xcd_barrier_post(unsigned* bar, volatile LAS unsigned* st) {
    XcdBarrier b; b.bar = bar; b.x = xb_xcc_id(); b.st = st;
    if (threadIdx.x == 0) (void)xb_add(&bar[XB_XCNT(b.x)], 1u);
    return b;
}
__device__ __forceinline__ void xcd_barrier_complete(unsigned* bar, unsigned x, unsigned& nloc, unsigned& nx) {
    const unsigned G = gridDim.x * gridDim.y * gridDim.z;
    unsigned sum, cnt, mine, sp = 0u;
    for (;;) {
        sum = 0u; cnt = 0u; mine = 0u;
#pragma unroll
        for (unsigned j = 0; j < 16; ++j) { const unsigned c = xb_ld(&bar[XB_XCNT(j)]); sum += c; cnt += (c > 0u) ? 1u : 0u; mine = (j == x) ? c : mine; }
        if (sum == G) break;
        __builtin_amdgcn_s_sleep(1);
        if ((++sp & 255u) == 0u) { if (xb_ld(&bar[XB_TMO])) break; if (sp > XB_SPIN_CAP) { atomicAdd(&bar[XB_TMO], 1u); break; } }
    }
    nloc = mine > 0u ? mine : 1u; nx = cnt > 0u ? cnt : 1u;
}

__device__ __forceinline__ void xcd_barrier(const XcdBarrier& b) {
    asm volatile("s_waitcnt vmcnt(0)" ::: "memory");
    __syncthreads();
    if (threadIdx.x == 0) {
        unsigned* bar = b.bar;
        __builtin_amdgcn_s_waitcnt(0);
        unsigned nloc = b.st[0], nx = b.st[1];
        if (nloc == 0u) { xcd_barrier_complete(bar, b.x, nloc, nx); b.st[0] = nloc; b.st[1] = nx; }
        const unsigned old = xb_add(&bar[XB_XSUB(b.x)], 1u);
        const unsigned gen = old / nloc;
        if (old + 1u == (gen + 1u) * nloc) {
            __builtin_amdgcn_fence(__ATOMIC_RELEASE, "agent");
            asm volatile("s_waitcnt vmcnt(0)" ::: "memory");
            const unsigned og = xb_add(&bar[XB_TOP], 1u);
            const unsigned tg = og / nx;
            if (og + 1u == (tg + 1u) * nx) xb_add(&bar[XB_TOPGEN], 1u);
            else XB_SPIN(xb_ld(&bar[XB_TOPGEN]) == tg, bar);
            __builtin_amdgcn_fence(__ATOMIC_ACQUIRE, "agent");
            xb_add(&bar[XB_XGEN(b.x)], 1u);
            asm volatile("s_waitcnt vmcnt(0)" ::: "memory");
        } else {
            XB_SPIN(xb_ld(&bar[XB_XGEN(b.x)]) == gen, bar);
            __builtin_amdgcn_fence(__ATOMIC_ACQUIRE, "agent");
            asm volatile("s_waitcnt vmcnt(0)" ::: "memory");
        }
    }
    __syncthreads();
}


typedef pg8::bf16_t bf16_t;
typedef pg8::f32x4 f32x4;
typedef pg8::u32x4 u32x4;
typedef unsigned u32x2 __attribute__((ext_vector_type(2)));

constexpr int D = 2048, NB = 2, T = 16384, CL = 256;
constexpr int ML = NB * T;
constexpr int MC = NB * CL;
constexpr int MT = ML + MC;
constexpr int NMIX = 7216, NMIXP = 7424, NGATE = 8192, NPROJ = NMIXP + NGATE;
constexpr int DIN = 15408;
constexpr int FF = 5632, NE = 8;
constexpr int MOE_ROWS = 67584;
constexpr int C_GLA_Q = 0, C_GLA_K = 256, C_GLA_V = 512, C_GLA_G = 1024, C_GLA_A = 1536;
constexpr int C_HG_Q = 1568, C_HG_F = 2080, C_HG_I = 3104, C_HG_G = 3616;
constexpr int C_DN_Q = 4128, C_DN_K = 4640, C_DN_V = 5152, C_DN_A = 5664, C_DN_B = 5672, C_DN_G = 5680;
constexpr int C_RG_X = 6192, C_RG_Y = 6704;
constexpr float EPS = 1e-6f;

enum { I_X = 0, I_C, I_CTX, I_CCTX, I_WMOD, I_BMOD, I_NORMW, I_FNORMW, I_WIN, I_WUP, I_WOUT, I_GLA_WA2, I_GLA_BA2, I_GLA_NW, I_HG_LB, I_HG_NW,
       I_DN_CW, I_DN_ALOG, I_DN_DTB, I_DN_NW, I_RG_CW, I_RG_CB, I_RG_WR, I_RG_BR, I_RG_WI, I_RG_BI, I_RG_LAM, I_F1, I_F3, I_F2, I_ROUTER, I_M1, I_M3, I_M2, N_IN };

constexpr size_t WS_CTL = 0, CTL_BYTES = 65536;
constexpr size_t CTL_BAR = 0, CTL_WGH = 16384, CTL_META = 24576;
constexpr size_t WS_MOD = WS_CTL + CTL_BYTES;
constexpr size_t WS_XC = WS_MOD + 294912;
constexpr size_t WS_TOPI = WS_XC + 4194304;
constexpr size_t WS_TOPW = WS_TOPI + 131072;
constexpr size_t WS_DEST = WS_TOPW + 262144;
constexpr size_t WIN_BYTES = (size_t)NMIXP * D * 2;
constexpr size_t WS_WIN = WS_DEST + 262144;
constexpr size_t WG8_BYTES = (size_t)NGATE * D;
constexpr size_t WS_WG8 = WS_WIN + 2 * WIN_BYTES;
constexpr size_t WS_WUP = WS_WG8 + 2 * WG8_BYTES;
constexpr size_t WS_WOUT = WS_WUP + 2 * 8388608;
constexpr size_t WS_F13 = WS_WOUT + 2 * 8388608;
constexpr size_t WS_F2 = WS_F13 + 46137344;
constexpr size_t WS_RGW = WS_F2 + 23068672;
constexpr size_t WS_H = WS_RGW + 1048576;
constexpr size_t WS_H8 = WS_H + 136314880;
constexpr size_t WS_BIG = WS_H8 + 68157440;
constexpr size_t WS_PMIX = WS_BIG;
constexpr size_t WS_PGATE = WS_BIG;
constexpr size_t WS_ORAW = WS_BIG + 545259520;
constexpr size_t WS_RGLA = WS_ORAW + 272629760;
constexpr size_t WS_RGU = WS_RGLA + 68157440;
constexpr size_t WS_RGTT = WS_RGU, WS_RGCARRY = WS_RGU + 4259840;
constexpr size_t WS_GC = WS_RGU + 8388608;
constexpr size_t WS_SCR = WS_GC + 136314880;
constexpr size_t SC_GLA_VT = 0, SC_GLA_QP = SC_GLA_VT + 34078720, SC_GLA_KT = SC_GLA_QP + 34078720, SC_GLA_A = SC_GLA_KT + 34078720, SC_GLA_LAM = SC_GLA_A + 34078720;
constexpr size_t SC_HG_VT = SC_GLA_LAM + 1064960, SC_HG_QP = SC_HG_VT + 34078720, SC_HG_KT = SC_HG_QP + 68157440, SC_HG_A = SC_HG_KT + 68157440, SC_HG_LAM = SC_HG_A + 34078720;
constexpr size_t SC_DN_QS = SC_HG_LAM + 2129920, SC_DN_KT = SC_DN_QS + 34078720, SC_DN_UT = SC_DN_KT + 34078720, SC_DN_WN = SC_DN_UT + 68157440, SC_DN_AQK = SC_DN_WN + 68157440, SC_DN_SC = SC_DN_AQK + 34078720;
constexpr size_t SC_END = SC_DN_SC + 4259840;
constexpr size_t WS_O = WS_SCR;
constexpr size_t WS_MACC = WS_SCR + 136314880;
constexpr size_t WS_MERGED = WS_MACC + 272629760;
constexpr size_t WS_HID = WS_BIG;
constexpr size_t WS_M13 = WS_BIG;
constexpr size_t WS_M2 = WS_M13 + 369098752;
constexpr size_t WS_GATH = WS_M2 + 184549376;
constexpr size_t WS_HIDM = WS_GATH + 276824064;
constexpr size_t WS_END_A = WS_HIDM + 761266176, WS_END_B = WS_SCR + SC_END;
constexpr size_t WS_END = WS_END_A > WS_END_B ? WS_END_A : WS_END_B;
static_assert(WS_MERGED + 136314880 <= WS_SCR + SC_END, "O, MACC, MERGED fit in the record region");
static_assert(WS_END <= 2041000000ull, "workspace budget");

constexpr int LDS_SCR = 0;
constexpr int LDS_AUX = 131072;
constexpr int LDS_MISC = 131072 + 8192;
constexpr int LDS_BYTES = 147456;

struct Args { const float* in[N_IN]; float* out; unsigned char* ws; int ph_lo, ph_hi; };

__device__ __forceinline__ float bflo(unsigned w) { return __uint_as_float(w << 16); }
__device__ __forceinline__ float bfhi(unsigned w) { return __uint_as_float(w & 0xffff0000u); }
__device__ __forceinline__ void unpack8(const u32x4 w, float (&f)[8]) { f[0] = bflo(w.x); f[1] = bfhi(w.x); f[2] = bflo(w.y); f[3] = bfhi(w.y); f[4] = bflo(w.z); f[5] = bfhi(w.z); f[6] = bflo(w.w); f[7] = bfhi(w.w); }
typedef __bf16 bfx8_t __attribute__((ext_vector_type(8)));
typedef float f32x8 __attribute__((ext_vector_type(8)));
__device__ __forceinline__ u32x4 pack8(const float (&f)[8]) { f32x8 v;
#pragma unroll
    for (int j = 0; j < 8; ++j) v[j] = f[j];
    return __builtin_bit_cast(u32x4, __builtin_convertvector(v, bfx8_t)); }
__device__ __forceinline__ unsigned pk_fp8x4(float a, float b, float c, float d) {
    a = fminf(fmaxf(a, -448.f), 448.f); b = fminf(fmaxf(b, -448.f), 448.f); c = fminf(fmaxf(c, -448.f), 448.f); d = fminf(fmaxf(d, -448.f), 448.f);
    unsigned p = __builtin_amdgcn_cvt_pk_fp8_f32(a, b, 0, false); return __builtin_amdgcn_cvt_pk_fp8_f32(c, d, p, true); }
__device__ __forceinline__ float bf1(const bf16_t* p) { return __uint_as_float(((unsigned)*p) << 16); }
__device__ __forceinline__ float sigm(float x) { return __builtin_amdgcn_rcpf(1.0f + __expf(-x)); }
__device__ __forceinline__ float siluf(float x) { return x * __builtin_amdgcn_rcpf(1.0f + __expf(-x)); }
__device__ __forceinline__ float softplusf(float x) { return fmaxf(x, 0.f) + __logf(1.0f + __expf(-fabsf(x))); }
__device__ __forceinline__ float wave_sum(float v) { v += __shfl_xor(v, 32); v += __shfl_xor(v, 16); v += __shfl_xor(v, 8); v += __shfl_xor(v, 4); v += __shfl_xor(v, 2); v += __shfl_xor(v, 1); return v; }
__device__ __forceinline__ float gelu_tanh(float y) { const float u = 0.7978845608028654f * (y + 0.044715f * y * y * y); const float e = __expf(2.f * u); const float th = 1.f - 2.f * __builtin_amdgcn_rcpf(e + 1.f); return 0.5f * y * (1.f + th); }

namespace pg8 {
template <bool SIG> struct EpiBf16S {
    static constexpr bool PERM = true, AFTER_DRAIN = false;
    bf16_t* O; int ldc; float sc;
    __device__ __forceinline__ void operator()(const f32x4 (&acc)[2][2][4][2], const Unit& u, int wr, int wc, int fr, int fq) const {
        const int row0 = u.pm * BM + wr * 64 + fr, col0 = u.pn * BM + wc * 32 + 8 * fq;
#pragma unroll
        for (int ai = 0; ai < 2; ++ai)
#pragma unroll
            for (int m = 0; m < 4; ++m) { bf16_t* rowp = O + (size_t)(row0 + ai * HALF + m * 16) * ldc + col0;
#pragma unroll
                for (int bj = 0; bj < 2; ++bj) { f32x4 v0 = acc[ai][bj][m][0], v1 = acc[ai][bj][m][1];
                    if (SIG) {
#pragma unroll
                        for (int j = 0; j < 4; ++j) { v0[j] = sigm(v0[j] * sc); v1[j] = sigm(v1[j] * sc); } }
                    u32x4 w; w.x = cvt_pk_bf16_safe(v0[0], v0[1]); w.y = cvt_pk_bf16_safe(v0[2], v0[3]); w.z = cvt_pk_bf16_safe(v1[0], v1[1]); w.w = cvt_pk_bf16_safe(v1[2], v1[3]);
                    *(u32x4*)(rowp + bj * HALF) = w; } }
    }
};
struct EpiUpGate {
    static constexpr bool PERM = true, AFTER_DRAIN = false;
    const bf16_t* gate; bf16_t* merged; int nMtot;
    __device__ __forceinline__ void operator()(const f32x4 (&acc)[2][2][4][2], const Unit& u, int wr, int wc, int fr, int fq) const {
        const int b = u.pn >> 3, pn = u.pn & 7, pm = u.pm - b * nMtot;
        const int row0 = pm * BM + wr * 64 + fr, col0 = pn * BM + wc * 32 + 8 * fq;
#pragma unroll
        for (int ai = 0; ai < 2; ++ai) {
            u32x4 gw[4][2], ow[4][2];
#pragma unroll
            for (int m = 0; m < 4; ++m) { const size_t r = (size_t)(row0 + ai * HALF + m * 16);
#pragma unroll
                for (int bj = 0; bj < 2; ++bj) { const int c = col0 + bj * HALF; gw[m][bj] = *(const u32x4*)(gate + r * NGATE + b * 2048 + c);
                    if (b > 0) ow[m][bj] = *(const u32x4*)(merged + r * 2048 + c); } }
#pragma unroll
            for (int m = 0; m < 4; ++m) { const size_t r = (size_t)(row0 + ai * HALF + m * 16);
#pragma unroll
                for (int bj = 0; bj < 2; ++bj) { const int c = col0 + bj * HALF; float g[8]; unpack8(gw[m][bj], g);
                    f32x4 v0 = acc[ai][bj][m][0], v1 = acc[ai][bj][m][1];
#pragma unroll
                    for (int j = 0; j < 4; ++j) { v0[j] *= g[j]; v1[j] *= g[4 + j]; }
                    if (b > 0) { float o[8]; unpack8(ow[m][bj], o);
#pragma unroll
                        for (int j = 0; j < 4; ++j) { v0[j] += o[j]; v1[j] += o[4 + j]; } }
                    u32x4 w; w.x = cvt_pk_bf16_safe(v0[0], v0[1]); w.y = cvt_pk_bf16_safe(v0[2], v0[3]); w.z = cvt_pk_bf16_safe(v1[0], v1[1]); w.w = cvt_pk_bf16_safe(v1[2], v1[3]);
                    *(u32x4*)(merged + r * 2048 + c) = w; } }
        }
    }
};
struct EpiResid {
    static constexpr bool PERM = false, AFTER_DRAIN = false;
    const float* srcl; float* dstl; const float* srcc; float* dstc; const float* modv;
    int permute;
    __device__ __forceinline__ void operator()(const f32x4 (&acc)[2][2][4][2], const Unit& u, int wr, int wc, int fr, int fq) const {
        const int row0 = u.pm * BM + wr * 64 + fr, col0 = u.pn * BM + wc * 32 + 4 * fq;
        const int rfirst = u.pm * BM; const float* mp = modv + (rfirst < ML ? (rfirst >> 14) : 2) * 12288;
        f32x4 mv[2][2];
#pragma unroll
        for (int bj = 0; bj < 2; ++bj)
#pragma unroll
            for (int n = 0; n < 2; ++n) mv[bj][n] = *(const f32x4*)(mp + col0 + bj * HALF + n * 16);
        const bool lat = rfirst < ML; const float* sb = lat ? srcl : srcc; float* db = lat ? dstl : dstc; const int bb = rfirst >> 14;
#define EPI_ROWOFF(r) (lat ? ((size_t)(bb << 14) + (size_t)(permute ? ((((r) & 255) << 6) | (((r) & 16383) >> 8)) : ((r) & 16383))) * D : (size_t)((r) - ML) * D)
#pragma unroll
        for (int ai = 0; ai < 2; ++ai) {
            f32x4 sv[4][2][2];
#pragma unroll
            for (int m = 0; m < 4; ++m) { const int r = row0 + ai * HALF + m * 16; const float* sp = sb + EPI_ROWOFF(r);
#pragma unroll
                for (int bj = 0; bj < 2; ++bj)
#pragma unroll
                    for (int n = 0; n < 2; ++n) sv[m][bj][n] = *(const f32x4*)(sp + col0 + bj * HALF + n * 16); }
#pragma unroll
            for (int m = 0; m < 4; ++m) { const int r = row0 + ai * HALF + m * 16; float* dp = db + EPI_ROWOFF(r);
#pragma unroll
                for (int bj = 0; bj < 2; ++bj)
#pragma unroll
                    for (int n = 0; n < 2; ++n) *(f32x4*)(dp + col0 + bj * HALF + n * 16) = sv[m][bj][n] + mv[bj][n] * acc[ai][bj][m][n]; }
        }
#undef EPI_ROWOFF
    }
};
template <bool F8OUT> struct EpiSwiglu {
    static constexpr bool PERM = true, AFTER_DRAIN = false;
    void* hid; int nper; float sc;
    __device__ __forceinline__ void operator()(const f32x4 (&acc)[2][2][4][2], const Unit& u, int wr, int wc, int fr, int fq) const {
        const int pn = u.pn % nper; const int row0 = u.pm * BM + wr * 64 + fr, col0 = pn * HALF + wc * 32 + 8 * fq;
#pragma unroll
        for (int ai = 0; ai < 2; ++ai)
#pragma unroll
            for (int m = 0; m < 4; ++m) { const size_t eo = (size_t)(row0 + ai * HALF + m * 16) * FF + col0;
                float o[8];
#pragma unroll
                for (int n = 0; n < 2; ++n)
#pragma unroll
                    for (int j = 0; j < 4; ++j) { const float g = acc[ai][0][m][n][j] * sc, v = acc[ai][1][m][n][j] * sc; o[n * 4 + j] = siluf(g) * v; }
                if (F8OUT) { u32x2 w; w.x = pk_fp8x4(o[0] * 4.f, o[1] * 4.f, o[2] * 4.f, o[3] * 4.f); w.y = pk_fp8x4(o[4] * 4.f, o[5] * 4.f, o[6] * 4.f, o[7] * 4.f); *(u32x2*)((unsigned char*)hid + eo) = w; }
                else { u32x4 w; w.x = cvt_pk_bf16_safe(o[0], o[1]); w.y = cvt_pk_bf16_safe(o[2], o[3]); w.z = cvt_pk_bf16_safe(o[4], o[5]); w.w = cvt_pk_bf16_safe(o[6], o[7]); *(u32x4*)((bf16_t*)hid + eo) = w; } }
    }
};
struct EpiPlainBf16 {
    static constexpr bool PERM = true, AFTER_DRAIN = false;
    bf16_t* O; int ldc; int nper; float sc;
    __device__ __forceinline__ void operator()(const f32x4 (&acc)[2][2][4][2], const Unit& u, int wr, int wc, int fr, int fq) const {
        const int pn = u.pn % nper; const int row0 = u.pm * BM + wr * 64 + fr, col0 = pn * BM + wc * 32 + 8 * fq;
#pragma unroll
        for (int ai = 0; ai < 2; ++ai)
#pragma unroll
            for (int m = 0; m < 4; ++m) { bf16_t* rowp = O + (size_t)(row0 + ai * HALF + m * 16) * ldc + col0;
#pragma unroll
                for (int bj = 0; bj < 2; ++bj) { const f32x4 v0 = acc[ai][bj][m][0] * sc, v1 = acc[ai][bj][m][1] * sc;
                    u32x4 w; w.x = cvt_pk_bf16_safe(v0[0], v0[1]); w.y = cvt_pk_bf16_safe(v0[2], v0[3]); w.z = cvt_pk_bf16_safe(v1[0], v1[1]); w.w = cvt_pk_bf16_safe(v1[2], v1[3]);
                    *(u32x4*)(rowp + bj * HALF) = w; } }
    }
};
struct UpGateOrder {
    StaticOrder so; int nMtot;
    __device__ void init(int M, int G, int c, int nMtot_) { so.init(M, 2048, G, c); nMtot = nMtot_; }
    __device__ bool next(int i, Unit& u) const { Unit t; if (!so.next(i >> 2, t)) return false; const int b = i & 3; u.pm = b * nMtot + t.pm; u.pn = b * 8 + t.pn; return true; }
    __device__ __forceinline__ void a_ready(const Unit&) const {}
    __device__ __forceinline__ void done(const Unit&) const {}
};
struct MoeOrder {
    StaticOrder so; int be[8]; int nper;
    __device__ void init(int nused, int nper_, int G, int c, const int* be_) { so.init(nused * BM, nper_ * BM, G, c); nper = nper_;
#pragma unroll
        for (int e = 0; e < 8; ++e) be[e] = be_[e]; }
    __device__ bool next(int i, Unit& u) const { Unit t; if (!so.next(i, t)) return false; int e = 0;
#pragma unroll
        for (int j = 0; j < 7; ++j) e += (t.pm >= be[j]) ? 1 : 0;
        u.pm = t.pm; u.pn = e * nper + t.pn; return true; }
    __device__ __forceinline__ void a_ready(const Unit&) const {}
    __device__ __forceinline__ void done(const Unit&) const {}
};
}

__device__ __forceinline__ int lds_add(volatile LAS int* p) { return __hip_atomic_fetch_add((LAS int*)p, 1, __ATOMIC_RELAXED, __HIP_MEMORY_SCOPE_WORKGROUP); }
typedef const __attribute__((address_space(4))) Args* ArgsP;
#define ARGS_REF const __attribute__((address_space(4))) Args&
struct Ctx { ArgsP a; LAS unsigned char* lds; int tid, lane, wave, wg, G; };

__device__ __forceinline__ void conv_tile(const float* src, size_t ldsrc, int nvalid, bf16_t* dst, size_t ldd, LAS float* tile, int tid) {
    const int nn = tid & 63, kk = tid >> 6;
    float v[16];
#pragma unroll
    for (int j = 0; j < 16; ++j) v[j] = (nn < nvalid) ? src[(size_t)(kk + 8 * j) * ldsrc + nn] : 0.f;
#pragma unroll
    for (int j = 0; j < 16; ++j) tile[nn * 129 + kk + 8 * j] = v[j];
    __syncthreads();
    const int lane = tid & 63, w = tid >> 6;
#pragma unroll
    for (int p = 0; p < 8; ++p) { const int n = w + 8 * p; const float a = tile[n * 129 + 2 * lane], b = tile[n * 129 + 2 * lane + 1];
        *(unsigned*)(dst + (size_t)n * ldd + 2 * lane) = pg8::cvt_pk_bf16_safe(a, b); }
    __syncthreads();
}
template <int KIND>
__device__ __forceinline__ void conv_job(const Ctx& c, const float* src, const float* src2, size_t ldsrc, int K, int Nd, bf16_t* dst, int& rot) {
    LAS float* tile = (LAS float*)(c.lds + LDS_SCR);
    const int nkt = K / 128, nnt = Nd / 64, ntile = nkt * nnt;
    int t0 = (c.wg - rot) % c.G; if (t0 < 0) t0 += c.G;
    for (int t = t0; t < ntile; t += c.G) {
        const int nt = t % nnt, kt = t / nnt, n0 = nt * 64, k0 = kt * 128;
        const float* s = src; int c0 = n0, nvalid = 64;
        if (KIND == 1) { if (n0 >= NMIXP) c0 = n0 - (NMIXP - NMIX); else { nvalid = NMIX - n0; nvalid = nvalid < 0 ? 0 : (nvalid > 64 ? 64 : nvalid); } }
        if (KIND == 2) { const int which = (n0 & 255) >> 7; c0 = (n0 >> 8) * 128 + (n0 & 127); s = which ? src2 : src; }
        conv_tile(s + (size_t)k0 * ldsrc + c0, ldsrc, nvalid, dst + (size_t)n0 * K + k0, (size_t)K, tile, c.tid);
    }
    rot = (rot + ntile) % c.G;
}

__device__ __forceinline__ void conv_tile8(const float* src, size_t ldsrc, unsigned char* dst, size_t ldd, float wscale, LAS float* tile, int tid) {
    const int nn = tid & 63, kk = tid >> 6;
#pragma unroll 8
    for (int j = 0; j < 32; ++j) tile[nn * 257 + kk + 8 * j] = src[(size_t)(kk + 8 * j) * ldsrc + nn] * wscale;
    __syncthreads();
    const int lane = tid & 63, w = tid >> 6;
#pragma unroll
    for (int p = 0; p < 8; ++p) { const int n = w + 8 * p; const LAS float* t = tile + n * 257 + 4 * lane;
        *(unsigned*)(dst + (size_t)n * ldd + 4 * lane) = pk_fp8x4(t[0], t[1], t[2], t[3]); }
    __syncthreads();
}
template <int KIND>
__device__ __forceinline__ void conv_job8(const Ctx& c, const float* src, const float* src2, size_t ldsrc, int K, int Nd, unsigned char* dst, float wscale, int& rot) {
    LAS float* tile = (LAS float*)(c.lds + LDS_SCR);
    const int nkt = K / 256, nnt = Nd / 64, ntile = nkt * nnt;
    int t0 = (c.wg - rot) % c.G; if (t0 < 0) t0 += c.G;
    for (int t = t0; t < ntile; t += c.G) { const int nt = t % nnt, kt = t / nnt, n0 = nt * 64, k0 = kt * 256;
        const float* s = src; int c0 = n0;
        if (KIND == 2) { const int which = (n0 & 255) >> 7; c0 = (n0 >> 8) * 128 + (n0 & 127); s = which ? src2 : src; }
        conv_tile8(s + (size_t)k0 * ldsrc + c0, ldsrc, dst + (size_t)n0 * K + k0, (size_t)K, wscale, tile, c.tid); }
    rot = (rot + ntile) % c.G;
}

__device__ __forceinline__ void mod_phase(const Ctx& c) {
    ARGS_REF a = *c.a; const int tid = c.tid;
    LAS float* s = (LAS float*)(c.lds + LDS_SCR);
    LAS float* red = s + 3 * 2048;
    for (int i = tid; i < 3 * 2048; i += 512) { const int r = i >> 11, k = i & 2047; const float cv = (r < 2) ? a.in[I_C][r * 2048 + k] : a.in[I_CCTX][k]; s[i] = siluf(cv); }
    __syncthreads();
    float* modv = (float*)(a.ws + WS_MOD);
    for (int task = c.wg; task < 192; task += c.G) {
        const int l = task / 96, cb = task % 96, cq = tid & 31, kg = tid >> 5;
        const float* w = a.in[I_WMOD] + (size_t)l * 2048 * 12288 + cb * 128 + cq * 4;
        f32x4 a0 = {0.f, 0.f, 0.f, 0.f}, a1 = a0, a2 = a0;
#pragma unroll 8
        for (int k = kg; k < 2048; k += 16) { const f32x4 wv = *(const f32x4*)(w + (size_t)k * 12288); a0 += s[k] * wv; a1 += s[2048 + k] * wv; a2 += s[4096 + k] * wv; }
#pragma unroll
        for (int j = 0; j < 4; ++j) { red[(kg * 3 + 0) * 128 + cq * 4 + j] = a0[j]; red[(kg * 3 + 1) * 128 + cq * 4 + j] = a1[j]; red[(kg * 3 + 2) * 128 + cq * 4 + j] = a2[j]; }
        __syncthreads();
        if (tid < 384) { const int r = tid >> 7, cc = tid & 127; float sum = 0.f;
#pragma unroll
            for (int g = 0; g < 16; ++g) sum += red[(g * 3 + r) * 128 + cc];
            modv[(size_t)(l * 3 + r) * 12288 + cb * 128 + cc] = sum + a.in[I_BMOD][l * 12288 + cb * 128 + cc]; }
        __syncthreads();
    }
}

__device__ __forceinline__ void modnorm_row(f32x4 (&v)[8], const float* nw, const float* shift, const float* scale, int lane) {
    float ss = 0.f;
#pragma unroll
    for (int j = 0; j < 8; ++j) ss += v[j][0] * v[j][0] + v[j][1] * v[j][1] + v[j][2] * v[j][2] + v[j][3] * v[j][3];
    ss = wave_sum(ss);
    const float rstd = __builtin_amdgcn_rsqf(ss * (1.0f / 2048.0f) + EPS);
#pragma unroll
    for (int j = 0; j < 8; ++j) { const int cc = (j * 64 + lane) * 4; const f32x4 w = *(const f32x4*)(nw + cc), sh = *(const f32x4*)(shift + cc), sc = *(const f32x4*)(scale + cc);
        v[j] = (v[j] * rstd * w) * (1.0f + sc) + sh; }
}
__device__ __forceinline__ void store_row_bf16(const f32x4 (&v)[8], bf16_t* hrow, int lane) {
#pragma unroll
    for (int j = 0; j < 8; ++j) { u32x2 w; w.x = pg8::cvt_pk_bf16_safe(v[j][0], v[j][1]); w.y = pg8::cvt_pk_bf16_safe(v[j][2], v[j][3]); *(u32x2*)(hrow + (j * 64 + lane) * 4) = w; }
}
template <int L, int WHICH>
__device__ __forceinline__ void norm_phase(const Ctx& c) {
    ARGS_REF a = *c.a; const int gw = c.wg * 8 + c.wave, nw = c.G * 8, lane = c.lane;
    const float* modv = (const float*)(a.ws + WS_MOD) + (size_t)L * 3 * 12288 + (WHICH ? 3 : 0) * 2048;
    const float* normw = a.in[I_NORMW] + (L * 2 + WHICH) * 2048;
    const float* xc = (const float*)(a.ws + WS_XC);
    bf16_t* H = (bf16_t*)(a.ws + WS_H);
    for (int r = gw; r < MT; r += nw) {
        const float* src; int mr; size_t hrow;
        if (r < ML) { const int b = r >> 14, t = r & 16383; src = ((L == 0 && WHICH == 0) ? a.in[I_X] : (const float*)a.out) + (size_t)r * D; mr = b;
            hrow = (L == 1 && WHICH == 0) ? (size_t)(b << 14) + ((t & 63) << 8) + (t >> 6) : (size_t)r; }
        else { const int rc = r - ML; src = ((L == 0 && WHICH == 0) ? a.in[I_CTX] : xc) + (size_t)rc * D; mr = 2; hrow = r; }
        f32x4 v[8];
#pragma unroll
        for (int j = 0; j < 8; ++j) v[j] = *(const f32x4*)(src + (j * 64 + lane) * 4);
        const float* shift = modv + (size_t)mr * 12288;
        modnorm_row(v, normw, shift, shift + 2048, lane);
        store_row_bf16(v, H + hrow * D, lane);
        if (WHICH == 0 || L == 0) { unsigned char* h8 = (unsigned char*)(a.ws + WS_H8) + hrow * D;
#pragma unroll
            for (int j = 0; j < 8; ++j) *(unsigned*)(h8 + (j * 64 + lane) * 4) = pk_fp8x4(v[j][0] * 4.f, v[j][1] * 4.f, v[j][2] * 4.f, v[j][3] * 4.f); }
    }
}

template <int L>
__device__ __forceinline__ void rgprep_item(const Ctx& c, int item) {
    ARGS_REF a = *c.a; const int tid = c.tid;
    LAS float* xbT = (LAS float*)(c.lds + LDS_SCR);
    const bf16_t* PM = (const bf16_t*)(a.ws + WS_PMIX);
    bf16_t* RGLA = (bf16_t*)(a.ws + WS_RGLA); bf16_t* RGU = (bf16_t*)(a.ws + WS_RGU);
    const float* cw = a.in[I_RG_CW] + L * 4 * 512; const float* cb = a.in[I_RG_CB] + L * 512;
    {
        const int tt = item >> 2, n = item & 3;
        size_t rowbase; int t0, Ls;
        if (tt < 512) { const int b = tt >> 8; rowbase = (size_t)b * T; t0 = (tt & 255) * 64; Ls = T; }
        else { const int tc = tt - 512, b = tc >> 2; rowbase = (size_t)ML + b * CL; t0 = (tc & 3) * 64; Ls = CL; }
        __syncthreads();
        {
            const int tl = tid >> 3, cg = tid & 7, ch0 = n * 128 + cg * 16;
            float acc[16];
#pragma unroll
            for (int j = 0; j < 16; ++j) acc[j] = cb[ch0 + j];
#pragma unroll
            for (int tap = 0; tap < 4; ++tap) { const int ts = t0 + tl + tap - 2;
                if (ts >= 0 && ts < Ls) { const bf16_t* rp = PM + (rowbase + ts) * NMIXP + C_RG_X + ch0; const u32x4 w0 = *(const u32x4*)rp, w1 = *(const u32x4*)(rp + 8);
                    float f[8], g[8]; unpack8(w0, f); unpack8(w1, g);
#pragma unroll
                    for (int j = 0; j < 8; ++j) { acc[j] += cw[tap * 512 + ch0 + j] * f[j]; acc[8 + j] += cw[tap * 512 + ch0 + 8 + j] * g[j]; } } }
#pragma unroll
            for (int j = 0; j < 16; ++j) xbT[(cg * 16 + j) * 68 + tl] = acc[j];
        }
        __syncthreads();
        const int oc = tid & 127, tg = tid >> 7, ch = n * 128 + oc;
#pragma unroll 1
        for (int d = 0; d < 2; ++d) {
            const float* wr = a.in[I_RG_WR] + ((size_t)((L * 2 + d) * 4 + n) * 128) * 128 + oc;
            const float* wi = a.in[I_RG_WI] + ((size_t)((L * 2 + d) * 4 + n) * 128) * 128 + oc;
            float ar[16], ai[16];
#pragma unroll
            for (int j = 0; j < 16; ++j) { ar[j] = 0.f; ai[j] = 0.f; }
#pragma unroll 4
            for (int k = 0; k < 128; ++k) { const float w1 = wr[k * 128], w2 = wi[k * 128];
                const LAS f32x4* xp = (const LAS f32x4*)(xbT + k * 68 + tg * 16);
#pragma unroll
                for (int q = 0; q < 4; ++q) { const f32x4 xv = xp[q];
#pragma unroll
                    for (int j = 0; j < 4; ++j) { ar[q * 4 + j] += xv[j] * w1; ai[q * 4 + j] += xv[j] * w2; } } }
            const float br = a.in[I_RG_BR][(L * 2 + d) * 512 + ch], bi = a.in[I_RG_BI][(L * 2 + d) * 512 + ch];
            const float sp = softplusf(-a.in[I_RG_LAM][(L * 2 + d) * 512 + ch]);
#pragma unroll
            for (int j = 0; j < 16; ++j) { const int tl = tg * 16 + j; const float r = sigm(ar[j] + br), ig = sigm(ai[j] + bi);
                const float la = -8.0f * r * sp; const float xb = xbT[oc * 68 + tl];
                const float u = sqrtf(fmaxf(-expm1f(2.0f * la), 0.f)) * (ig * xb);
                const size_t o = ((size_t)d * MT + rowbase + t0 + tl) * 512 + ch;
                RGLA[o] = (bf16_t)(pg8::cvt_pk_bf16_safe(la, 0.f) & 0xffffu); RGU[o] = (bf16_t)(pg8::cvt_pk_bf16_safe(u, 0.f) & 0xffffu); }
        }
    }
}

template <int L>
__device__ __forceinline__ void chain_gla(const Ctx& c, int b, int h, int d, int vh) {
    ARGS_REF a = *c.a; const int tid = c.tid;
    LAS float* qs = (LAS float*)(c.lds + LDS_SCR); LAS float* ks = qs + 4096; LAS float* fs = ks + 4096; LAS float* vs = fs + 4096; LAS float* os = vs + 4096;
    LAS float* wa = (LAS float*)(c.lds + LDS_AUX);
    const bf16_t* PM = (const bf16_t*)(a.ws + WS_PMIX);
    bf16_t* ORAW = (bf16_t*)(a.ws + WS_ORAW) + (size_t)d * MT * 2048;
    for (int i = tid; i < 1024; i += 512) wa[i] = a.in[I_GLA_WA2][((L * 2 + d) * 16 + (i >> 6)) * 256 + h * 64 + (i & 63)];
    if (tid < 64) wa[1024 + tid] = a.in[I_GLA_BA2][(L * 2 + d) * 256 + h * 64 + tid];
    float s[8];
#pragma unroll
    for (int j = 0; j < 8; ++j) s[j] = 0.f;
    const int vc = tid >> 3, kq = tid & 7;
#pragma unroll 1
    for (int seg = 0; seg < 2; ++seg) {
        const int Ls = seg ? T : CL; const size_t rowbase = seg ? (size_t)b * T : (size_t)ML + b * CL;
#pragma unroll 1
        for (int jb = 0; jb < Ls / 64; ++jb) {
            const int r0 = d ? Ls - 64 * (jb + 1) : 64 * jb;
            __syncthreads();
            {   const int i = tid >> 3, cg = tid & 7, lr = d ? 63 - i : i; const bf16_t* rp = PM + (rowbase + r0 + lr) * NMIXP;
                float fq[8], fk[8], fv[8], fa[16];
                { const u32x4 w = *(const u32x4*)(rp + C_GLA_Q + h * 64 + cg * 8); unpack8(w, fq); }
                { const u32x4 w = *(const u32x4*)(rp + C_GLA_K + h * 64 + cg * 8); unpack8(w, fk); }
                { const u32x4 w = *(const u32x4*)(rp + C_GLA_V + h * 128 + vh * 64 + cg * 8); unpack8(w, fv); }
                { const u32x4 w0 = *(const u32x4*)(rp + C_GLA_A + d * 16), w1 = *(const u32x4*)(rp + C_GLA_A + d * 16 + 8); float t0[8], t1[8]; unpack8(w0, t0); unpack8(w1, t1);
#pragma unroll
                  for (int j = 0; j < 8; ++j) { fa[j] = t0[j]; fa[8 + j] = t1[j]; } }
#pragma unroll
                for (int j = 0; j < 8; ++j) { const int o = i * 64 + cg * 8 + j; qs[o] = fq[j] * 0.125f; ks[o] = fk[j]; vs[o] = fv[j];
                    float z = wa[1024 + cg * 8 + j];
#pragma unroll
                    for (int r = 0; r < 16; ++r) z += fa[r] * wa[r * 64 + cg * 8 + j];
                    fs[o] = __expf(-softplusf(-z) * (1.0f / 16.0f)); }
            }
            __syncthreads();
#pragma unroll 2
            for (int i = 0; i < 64; ++i) {
                const f32x4 f0 = *(const LAS f32x4*)(fs + i * 64 + kq * 8), f1 = *(const LAS f32x4*)(fs + i * 64 + kq * 8 + 4);
                const f32x4 k0 = *(const LAS f32x4*)(ks + i * 64 + kq * 8), k1 = *(const LAS f32x4*)(ks + i * 64 + kq * 8 + 4);
                const f32x4 q0 = *(const LAS f32x4*)(qs + i * 64 + kq * 8), q1 = *(const LAS f32x4*)(qs + i * 64 + kq * 8 + 4);
                const float vv = vs[i * 64 + vc]; float po = 0.f;
#pragma unroll
                for (int j = 0; j < 4; ++j) { s[j] = f0[j] * s[j] + k0[j] * vv; s[4 + j] = f1[j] * s[4 + j] + k1[j] * vv; po += s[j] * q0[j] + s[4 + j] * q1[j]; }
                po += __shfl_xor(po, 1); po += __shfl_xor(po, 2); po += __shfl_xor(po, 4);
                if (kq == 0) os[i * 64 + vc] = po;
            }
            __syncthreads();
            {   const int i = tid >> 3, cg = tid & 7, lr = d ? 63 - i : i; float o[8];
#pragma unroll
                for (int j = 0; j < 8; ++j) o[j] = os[i * 64 + cg * 8 + j];
                *(u32x4*)(ORAW + (rowbase + r0 + lr) * 2048 + 0 * 512 + h * 128 + vh * 64 + cg * 8) = pack8(o); }
        }
    }
}
template <int L>
__device__ __forceinline__ void chain_hg(const Ctx& c, int b, int h, int d, int vh) {
    ARGS_REF a = *c.a; const int tid = c.tid;
    LAS float* qs = (LAS float*)(c.lds + LDS_SCR); LAS float* ks = qs + 8192; LAS float* fs = ks + 8192; LAS float* vs = fs + 8192; LAS float* os = vs + 4096;
    LAS float* lbs = (LAS float*)(c.lds + LDS_AUX);
    const bf16_t* PM = (const bf16_t*)(a.ws + WS_PMIX);
    bf16_t* ORAW = (bf16_t*)(a.ws + WS_ORAW) + (size_t)d * MT * 2048;
    if (tid < 128) { float lb = 0.f; if (L == 1) { const float l0 = a.in[I_HG_LB][h * 128 + tid], l1 = a.in[I_HG_LB][512 + h * 128 + tid]; lb = __builtin_amdgcn_rcpf(1.0f + __expf(l0 - l1)); } lbs[tid] = lb; }
    float s[16];
#pragma unroll
    for (int j = 0; j < 16; ++j) s[j] = 0.f;
    const int vc = tid >> 3, kq = tid & 7;
#pragma unroll 1
    for (int seg = 0; seg < 2; ++seg) {
        const int Ls = seg ? T : CL; const size_t rowbase = seg ? (size_t)b * T : (size_t)ML + b * CL;
#pragma unroll 1
        for (int jb = 0; jb < Ls / 64; ++jb) {
            const int r0 = d ? Ls - 64 * (jb + 1) : 64 * jb;
            __syncthreads();
            {   const int i = tid >> 3, cg = tid & 7, lr = d ? 63 - i : i; const bf16_t* rp = PM + (rowbase + r0 + lr) * NMIXP;
#pragma unroll
                for (int hf = 0; hf < 2; ++hf) { const int ch = cg * 16 + hf * 8; float fq[8], fz[8];
                    { const u32x4 w = *(const u32x4*)(rp + C_HG_Q + h * 128 + ch); unpack8(w, fq); }
                    { const u32x4 w = *(const u32x4*)(rp + C_HG_F + d * 512 + h * 128 + ch); unpack8(w, fz); }
#pragma unroll
                    for (int j = 0; j < 8; ++j) { const int o = i * 128 + ch + j; const float lb = lbs[ch + j], sg = sigm(fz[j]);
                        qs[o] = siluf(fq[j]) * 0.08838834764831845f; fs[o] = fmaxf(lb + (1.0f - lb) * sg, 1e-30f); ks[o] = (1.0f - lb) * (1.0f - sg); } }
                float fv[8]; { const u32x4 w = *(const u32x4*)(rp + C_HG_I + h * 128 + vh * 64 + cg * 8); unpack8(w, fv); }
#pragma unroll
                for (int j = 0; j < 8; ++j) vs[i * 64 + cg * 8 + j] = fv[j];
            }
            __syncthreads();
#pragma unroll 2
            for (int i = 0; i < 64; ++i) {
                const float vv = vs[i * 64 + vc]; float po = 0.f;
#pragma unroll
                for (int q4 = 0; q4 < 4; ++q4) {
                    const f32x4 f0 = *(const LAS f32x4*)(fs + i * 128 + kq * 16 + q4 * 4), k0 = *(const LAS f32x4*)(ks + i * 128 + kq * 16 + q4 * 4), q0 = *(const LAS f32x4*)(qs + i * 128 + kq * 16 + q4 * 4);
#pragma unroll
                    for (int j = 0; j < 4; ++j) { s[q4 * 4 + j] = f0[j] * s[q4 * 4 + j] + k0[j] * vv; po += s[q4 * 4 + j] * q0[j]; } }
                po += __shfl_xor(po, 1); po += __shfl_xor(po, 2); po += __shfl_xor(po, 4);
                if (kq == 0) os[i * 64 + vc] = po;
            }
            __syncthreads();
            {   const int i = tid >> 3, cg = tid & 7, lr = d ? 63 - i : i; float o[8];
#pragma unroll
                for (int j = 0; j < 8; ++j) o[j] = os[i * 64 + cg * 8 + j];
                *(u32x4*)(ORAW + (rowbase + r0 + lr) * 2048 + 1 * 512 + h * 128 + vh * 64 + cg * 8) = pack8(o); }
        }
    }
}
template <int L>
__device__ __forceinline__ void chain_dn(const Ctx& c, int b, int h, int d, int vh) {
    ARGS_REF a = *c.a; const int tid = c.tid;
    LAS float* qs = (LAS float*)(c.lds + LDS_SCR); LAS float* ks = qs + 8192; LAS float* vs = ks + 8192; LAS float* os = vs + 4096; LAS float* as = os + 4096; LAS float* bs = as + 64;
    LAS float* cwl = (LAS float*)(c.lds + LDS_AUX);
    const bf16_t* PM = (const bf16_t*)(a.ws + WS_PMIX);
    bf16_t* ORAW = (bf16_t*)(a.ws + WS_ORAW) + (size_t)d * MT * 2048;
    for (int i = tid; i < 4 * 320; i += 512) { const int tap = i / 320, cc = i % 320; const int ch = cc < 128 ? h * 128 + cc : (cc < 256 ? 512 + h * 128 + (cc - 128) : 1024 + h * 128 + vh * 64 + (cc - 256));
        cwl[i] = a.in[I_DN_CW][(L * 4 + tap) * 1536 + ch]; }
    const float neg_ea = -expf(a.in[I_DN_ALOG][(L * 2 + d) * 4 + h]), dtb = a.in[I_DN_DTB][(L * 2 + d) * 4 + h];
    float s[16];
#pragma unroll
    for (int j = 0; j < 16; ++j) s[j] = 0.f;
    const int vc = tid >> 3, kq = tid & 7;
#pragma unroll 1
    for (int seg = 0; seg < 2; ++seg) {
        const int Ls = seg ? T : CL; const size_t rowbase = seg ? (size_t)b * T : (size_t)ML + b * CL;
#pragma unroll 1
        for (int jb = 0; jb < Ls / 64; ++jb) {
            const int r0 = d ? Ls - 64 * (jb + 1) : 64 * jb;
            __syncthreads();
            {   const int i = tid >> 3, cg = tid & 7, lr = d ? 63 - i : i, t = r0 + lr;
                float aq[16], ak[16], av[8];
#pragma unroll
                for (int j = 0; j < 16; ++j) { aq[j] = 0.f; ak[j] = 0.f; }
#pragma unroll
                for (int j = 0; j < 8; ++j) av[j] = 0.f;
#pragma unroll
                for (int tap = 0; tap < 4; ++tap) { const int ts = t + tap - 2;
                    if (ts >= 0 && ts < Ls) { const bf16_t* rp = PM + (rowbase + ts) * NMIXP; const LAS float* w = cwl + tap * 320;
                        float f0[8], f1[8];
                        { const u32x4 w0 = *(const u32x4*)(rp + C_DN_Q + h * 128 + cg * 16), w1 = *(const u32x4*)(rp + C_DN_Q + h * 128 + cg * 16 + 8); unpack8(w0, f0); unpack8(w1, f1); }
#pragma unroll
                        for (int j = 0; j < 8; ++j) { aq[j] += w[cg * 16 + j] * f0[j]; aq[8 + j] += w[cg * 16 + 8 + j] * f1[j]; }
                        { const u32x4 w0 = *(const u32x4*)(rp + C_DN_K + h * 128 + cg * 16), w1 = *(const u32x4*)(rp + C_DN_K + h * 128 + cg * 16 + 8); unpack8(w0, f0); unpack8(w1, f1); }
#pragma unroll
                        for (int j = 0; j < 8; ++j) { ak[j] += w[128 + cg * 16 + j] * f0[j]; ak[8 + j] += w[128 + cg * 16 + 8 + j] * f1[j]; }
                        { const u32x4 w0 = *(const u32x4*)(rp + C_DN_V + h * 128 + vh * 64 + cg * 8); unpack8(w0, f0); }
#pragma unroll
                        for (int j = 0; j < 8; ++j) av[j] += w[256 + cg * 8 + j] * f0[j]; } }
#pragma unroll
                for (int j = 0; j < 16; ++j) { qs[i * 128 + cg * 16 + j] = siluf(aq[j]); ks[i * 128 + cg * 16 + j] = siluf(ak[j]); }
#pragma unroll
                for (int j = 0; j < 8; ++j) vs[i * 64 + cg * 8 + j] = siluf(av[j]);
                if (tid < 64) { const int lr2 = d ? 63 - tid : tid; const bf16_t* rp = PM + (rowbase + r0 + lr2) * NMIXP;
                    const float g = neg_ea * softplusf(bf1(rp + C_DN_A + d * 4 + h) + dtb); as[tid] = __expf(g); bs[tid] = sigm(bf1(rp + C_DN_B + d * 4 + h)); }
            }
            __syncthreads();
            {
                const int rowid = tid >> 2, part = tid & 3; LAS float* p = (rowid < 64 ? qs + rowid * 128 : ks + (rowid - 64) * 128) + part * 32; float ss = 0.f;
#pragma unroll
                for (int j = 0; j < 32; ++j) ss += p[j] * p[j];
                ss += __shfl_xor(ss, 1); ss += __shfl_xor(ss, 2);
                const float rs = __builtin_amdgcn_rsqf(ss + EPS) * (rowid < 64 ? 0.08838834764831845f : 1.0f);
#pragma unroll
                for (int j = 0; j < 32; ++j) p[j] *= rs;
            }
            __syncthreads();
#pragma unroll 2
            for (int i = 0; i < 64; ++i) {
                f32x4 kk[4]; float kts = 0.f;
#pragma unroll
                for (int q4 = 0; q4 < 4; ++q4) { kk[q4] = *(const LAS f32x4*)(ks + i * 128 + kq * 16 + q4 * 4);
#pragma unroll
                    for (int j = 0; j < 4; ++j) kts += s[q4 * 4 + j] * kk[q4][j]; }
                kts += __shfl_xor(kts, 1); kts += __shfl_xor(kts, 2); kts += __shfl_xor(kts, 4);
                const float al = as[i], be = bs[i]; const float vn = be * (vs[i * 64 + vc] - al * kts); float po = 0.f;
#pragma unroll
                for (int q4 = 0; q4 < 4; ++q4) { const f32x4 q0 = *(const LAS f32x4*)(qs + i * 128 + kq * 16 + q4 * 4);
#pragma unroll
                    for (int j = 0; j < 4; ++j) { s[q4 * 4 + j] = al * s[q4 * 4 + j] + kk[q4][j] * vn; po += s[q4 * 4 + j] * q0[j]; } }
                po += __shfl_xor(po, 1); po += __shfl_xor(po, 2); po += __shfl_xor(po, 4);
                if (kq == 0) os[i * 64 + vc] = po;
            }
            __syncthreads();
            {   const int i = tid >> 3, cg = tid & 7, lr = d ? 63 - i : i; float o[8];
#pragma unroll
                for (int j = 0; j < 8; ++j) o[j] = os[i * 64 + cg * 8 + j];
                *(u32x4*)(ORAW + (rowbase + r0 + lr) * 2048 + 2 * 512 + h * 128 + vh * 64 + cg * 8) = pack8(o); }
        }
    }
}
__device__ __forceinline__ void chain_rg(const Ctx& c, int gw  ) {
    ARGS_REF a = *c.a; const int b = gw >> 3, d = (gw >> 2) & 1, ch = (gw & 3) * 128 + c.lane * 2;
    const bf16_t* RGLA = (const bf16_t*)(a.ws + WS_RGLA) + (size_t)d * MT * 512 + ch; const bf16_t* RGU = (const bf16_t*)(a.ws + WS_RGU) + (size_t)d * MT * 512 + ch;
    bf16_t* ORAW = (bf16_t*)(a.ws + WS_ORAW) + (size_t)d * MT * 2048 + 1536 + ch;
    float h0 = 0.f, h1 = 0.f;
#pragma unroll 1
    for (int seg = 0; seg < 2; ++seg) {
        const int Ls = seg ? T : CL; const size_t rowbase = seg ? (size_t)b * T : (size_t)ML + b * CL;
#pragma unroll 1
        for (int s0 = 0; s0 < Ls; s0 += 16) {
            unsigned la[16], uu[16];
#pragma unroll
            for (int j = 0; j < 16; ++j) { const size_t row = rowbase + (d ? Ls - 1 - (s0 + j) : s0 + j); la[j] = *(const unsigned*)(RGLA + row * 512); uu[j] = *(const unsigned*)(RGU + row * 512); }
#pragma unroll
            for (int j = 0; j < 16; ++j) { const size_t row = rowbase + (d ? Ls - 1 - (s0 + j) : s0 + j);
                h0 = __expf(bflo(la[j])) * h0 + bflo(uu[j]); h1 = __expf(bfhi(la[j])) * h1 + bfhi(uu[j]);
                *(unsigned*)(ORAW + row * 2048) = pg8::cvt_pk_bf16_safe(h0, h1); }
        }
    }
}

typedef float f32x16 __attribute__((ext_vector_type(16)));
typedef pg8::bf16x8 bf16x8;
#define LBAR() do { asm volatile("s_waitcnt lgkmcnt(0)" ::: "memory"); __builtin_amdgcn_s_barrier(); asm volatile("" ::: "memory"); } while (0)
#define MFMA32(a, b, c) __builtin_amdgcn_mfma_f32_32x32x16_bf16((a), (b), (c), 0, 0, 0)
template <int S_> __device__ __forceinline__ bf16x8 pack_step(const f32x16& x) {
    f32x8 v;
#pragma unroll
    for (int j = 0; j < 8; ++j) v[j] = x[8 * S_ + j];
    return __builtin_bit_cast(bf16x8, __builtin_convertvector(v, bfx8_t));
}
__device__ __forceinline__ bf16_t f2bf(float f) { const __bf16 b = (__bf16)f; return __builtin_bit_cast(bf16_t, b); }
__device__ __forceinline__ int permpos(int k) { const int w = k & 15; return (k & ~15) + (((w >> 2) & 1) << 3) + ((w >> 3) << 2) + (w & 3); }
__device__ __forceinline__ int crow16(int idx, int hh) { return (idx & 3) + 8 * (idx >> 2) + 4 * hh; }
__device__ __forceinline__ size_t chunk_rowbase(int b, int n) { return n < 4 ? (size_t)ML + b * CL + n * 64 : (size_t)b * T + (size_t)(n - 4) * 64; }

template <int L, int TY>
__device__ __forceinline__ void intra_g_item(const Ctx& c, int b, int h, int n) {
    constexpr int K = TY ? 128 : 64, NSEG = 512 / K, TS = 64 / NSEG, QPITCH = 2 * K + 16;
    ARGS_REF a = *c.a; const int tid = c.tid;
    const bf16_t* PM = (const bf16_t*)(a.ws + WS_PMIX);
    unsigned char* scr = a.ws + WS_SCR;
    const size_t rowbase = chunk_rowbase(b, n);
    const int rec = (b * 4 + h) * 260 + n;
    LAS unsigned char* Qh = c.lds + LDS_SCR; LAS unsigned char* Kh = Qh + 64 * QPITCH; LAS float* segtot = (LAS float*)(Kh + 64 * QPITCH);
    LBAR();
    {
        const int v = tid & 127, t0 = (tid >> 7) * 16; float vals[16];
        const char* vb = (const char*)(PM + rowbase * NMIXP + (TY ? C_HG_I : C_GLA_V) + h * 128); asm volatile("" : "+s"(vb));
        const unsigned vo = (unsigned)(t0 * NMIXP + v) * 2u;
#pragma unroll
        for (int j = 0; j < 16; ++j) vals[j] = bf1((const bf16_t*)(vb + (vo + (unsigned)(j * NMIXP * 2))));
        float v0[8], v1[8];
#pragma unroll
        for (int j = 0; j < 8; ++j) { v0[j] = vals[j]; v1[j] = vals[8 + j]; }
        u32x4* dst = (u32x4*)(scr + (TY ? SC_HG_VT : SC_GLA_VT) + (size_t)rec * 16384 + v * 128 + t0 * 2);
        dst[0] = pack8(v0); dst[1] = pack8(v1);
    }
    const int k = tid & (K - 1), tq = tid / K;
    float lb = 0.f;
    if (TY == 1 && L == 1) { const float l0 = a.in[I_HG_LB][h * 128 + k], l1 = a.in[I_HG_LB][512 + h * 128 + k]; lb = __builtin_amdgcn_rcpf(1.0f + __expf(l0 - l1)); }
#pragma unroll 1
    for (int d = 0; d < 2; ++d) {
        float qv[TS], kv[TS], bv[TS];
        const char* pb = (const char*)(PM + rowbase * NMIXP); asm volatile("" : "+s"(pb));
        const unsigned ro = (unsigned)(TS * tq * NMIXP) * 2u;
        if (TY == 0) {
            float w[16]; const float bias = a.in[I_GLA_BA2][(L * 2 + d) * 256 + h * 64 + k];
#pragma unroll
            for (int r = 0; r < 16; ++r) w[r] = a.in[I_GLA_WA2][((L * 2 + d) * 16 + r) * 256 + h * 64 + k];
#pragma unroll
            for (int j = 0; j < TS; ++j) { const bf16_t* rp = (const bf16_t*)(pb + (ro + (unsigned)(j * NMIXP * 2)));
                qv[j] = bf1(rp + C_GLA_Q + h * 64 + k) * 0.125f; kv[j] = bf1(rp + C_GLA_K + h * 64 + k);
                const u32x4 w0 = *(const u32x4*)(rp + C_GLA_A + d * 16), w1 = *(const u32x4*)(rp + C_GLA_A + d * 16 + 8); float f0[8], f1[8]; unpack8(w0, f0); unpack8(w1, f1);
                float z = bias;
#pragma unroll
                for (int r = 0; r < 8; ++r) { z += f0[r] * w[r]; z += f1[r] * w[8 + r]; }
                bv[j] = -softplusf(-z) * (1.0f / 16.0f); }
        } else {
#pragma unroll
            for (int j = 0; j < TS; ++j) { const bf16_t* rp = (const bf16_t*)(pb + (ro + (unsigned)(j * NMIXP * 2)));
                qv[j] = siluf(bf1(rp + C_HG_Q + h * 128 + k)) * 0.08838834764831845f;
                const float sg = sigm(bf1(rp + C_HG_F + d * 512 + h * 128 + k));
                bv[j] = __logf(fmaxf(lb + (1.0f - lb) * sg, 1e-30f)); kv[j] = (1.0f - lb) * (1.0f - sg); }
        }
        float run = 0.f;
        if (d == 0) {
#pragma unroll
            for (int j = 0; j < TS; ++j) { run += bv[j]; bv[j] = run; } }
        else {
#pragma unroll
            for (int j = TS - 1; j >= 0; --j) { run += bv[j]; bv[j] = run; } }
        segtot[tq * K + k] = run;
        LBAR();
        float off = 0.f, tot = 0.f, R = 0.f;
#pragma unroll
        for (int sg = 0; sg < NSEG; ++sg) { const float s = segtot[sg * K + k]; tot += s;
            if (d ? (sg > tq) : (sg < tq)) off += s;
            if (d ? (sg >= NSEG / 2) : (sg < NSEG / 2)) R += s; }
        const size_t drec = (size_t)((d * 8 + b * 4 + h) * 260 + n);
        bf16_t* qp = (bf16_t*)(scr + (TY ? SC_HG_QP : SC_GLA_QP) + drec * (64 * K * 2));
        bf16_t* ktp = (bf16_t*)(scr + (TY ? SC_HG_KT : SC_GLA_KT) + drec * (64 * K * 2));
        const int pk = permpos(k);
        float kt[TS];
#pragma unroll
        for (int j = 0; j < TS; ++j) { const int t = TS * tq + j; const float B = off + bv[j];
            qp[t * K + pk] = f2bf(qv[j] * __expf(B));
            kt[j] = kv[j] * __expf(tot - B);
            *(LAS bf16_t*)(Qh + t * QPITCH + k * 2) = f2bf(qv[j] * __expf(fminf(B - R, 60.f)));
            *(LAS bf16_t*)(Kh + t * QPITCH + k * 2) = f2bf(kv[j] * __expf(fminf(R - B, 60.f))); }
        {   u32x4* dst = (u32x4*)(ktp + k * 64 + TS * tq);
#pragma unroll
            for (int g = 0; g < TS / 8; ++g) { float t8[8];
#pragma unroll
                for (int j = 0; j < 8; ++j) t8[j] = kt[g * 8 + j];
                dst[g] = pack8(t8); } }
        if (tq == 0) ((float*)(scr + (TY ? SC_HG_LAM : SC_GLA_LAM) + drec * (K * 4)))[k] = __expf(tot);
        LBAR();
        if (c.wave < 4) {
            const int it = c.wave >> 1, jt = c.wave & 1, r = c.lane & 31, hh = c.lane >> 5;
            bf16_t* ap = (bf16_t*)(scr + (TY ? SC_HG_A : SC_GLA_A) + drec * 8192);
            f32x16 acc;
#pragma unroll
            for (int i = 0; i < 16; ++i) acc[i] = 0.f;
            const bool dead = d ? (it == 1 && jt == 0) : (it == 0 && jt == 1);
            if (!dead) {
#pragma unroll
                for (int ks = 0; ks < K / 16; ++ks) { const bf16x8 af = *(const LAS bf16x8*)(Qh + (32 * it + r) * QPITCH + ks * 32 + hh * 16), bfr = *(const LAS bf16x8*)(Kh + (32 * jt + r) * QPITCH + ks * 32 + hh * 16);
                    acc = MFMA32(af, bfr, acc); } }
            const int jj = 32 * jt + r;
#pragma unroll
            for (int i = 0; i < 16; ++i) { const int ii = 32 * it + crow16(i, hh); const bool ok = d ? (jj >= ii) : (jj <= ii); ap[ii * 64 + jj] = f2bf(ok ? acc[i] : 0.f); }
        }
        LBAR();
    }
}

template <int TY> struct GChunk {
    static constexpr int K = TY ? 128 : 64, QPITCH = 2 * K + 16, RQ = 64 * K * 2 / 16 / 256  , NRL = 2 * RQ + 2 + 4;
    static constexpr int OFF_QP = 0, OFF_KT = 64 * QPITCH, OFF_A = OFF_KT + K * 144, OFF_VT = OFF_A + 64 * 144, OFF_LAM = OFF_VT + 128 * 144, BYTES = OFF_LAM + K * 4;
};
template <int TY>
__device__ __forceinline__ void gchunk_issue(const unsigned char* scr, int b, int h, int d, int n, int lt, u32x4 (&pf)[GChunk<TY>::NRL], float& lamv) {
    typedef GChunk<TY> G; constexpr int K = G::K, RQ = G::RQ;
    const size_t drec = (size_t)((d * 8 + b * 4 + h) * 260 + n), rec = (size_t)((b * 4 + h) * 260 + n);
    const u32x4* qp = (const u32x4*)(scr + (TY ? SC_HG_QP : SC_GLA_QP) + drec * (64 * K * 2));
    const u32x4* kt = (const u32x4*)(scr + (TY ? SC_HG_KT : SC_GLA_KT) + drec * (64 * K * 2));
    const u32x4* ap = (const u32x4*)(scr + (TY ? SC_HG_A : SC_GLA_A) + drec * 8192);
    const u32x4* vt = (const u32x4*)(scr + (TY ? SC_HG_VT : SC_GLA_VT) + rec * 16384);
#pragma unroll
    for (int i = 0; i < RQ; ++i) { pf[i] = qp[i * 256 + lt]; pf[RQ + i] = kt[i * 256 + lt]; }
    pf[2 * RQ] = ap[lt]; pf[2 * RQ + 1] = ap[256 + lt];
#pragma unroll
    for (int i = 0; i < 4; ++i) pf[2 * RQ + 2 + i] = vt[i * 256 + lt];
    if (lt < K) lamv = ((const float*)(scr + (TY ? SC_HG_LAM : SC_GLA_LAM) + drec * (K * 4)))[lt];
}
template <int TY>
__device__ __forceinline__ void gchunk_commit(LAS unsigned char* buf, int lt, const u32x4 (&pf)[GChunk<TY>::NRL], float lamv) {
    typedef GChunk<TY> G; constexpr int K = G::K, PPR = K * 2 / 16, RQ = G::RQ;
#pragma unroll
    for (int i = 0; i < RQ; ++i) { const int p = i * 256 + lt;
        *(LAS u32x4*)(buf + G::OFF_QP + (p / PPR) * G::QPITCH + (p % PPR) * 16) = pf[i];
        *(LAS u32x4*)(buf + G::OFF_KT + (p >> 3) * 144 + (p & 7) * 16) = pf[RQ + i]; }
#pragma unroll
    for (int i = 0; i < 2; ++i) { const int p = i * 256 + lt; *(LAS u32x4*)(buf + G::OFF_A + (p >> 3) * 144 + (p & 7) * 16) = pf[2 * RQ + i]; }
#pragma unroll
    for (int i = 0; i < 4; ++i) { const int p = i * 256 + lt; *(LAS u32x4*)(buf + G::OFF_VT + (p >> 3) * 144 + (p & 7) * 16) = pf[2 * RQ + 2 + i]; }
    if (lt < K) *(LAS float*)(buf + G::OFF_LAM + lt * 4) = lamv;
}
template <int TY>
__device__ __forceinline__ void gchunk_compute(LAS unsigned char* buf, f32x16 (&S)[GChunk<TY>::K / 32], bf16_t* orow, int vs, int lane) {
    typedef GChunk<TY> G; constexpr int K = G::K, KT_ = K / 32;
    const int r = lane & 31, hh = lane >> 5;
    bf16x8 vf[4];
#pragma unroll
    for (int ts = 0; ts < 4; ++ts) vf[ts] = *(const LAS bf16x8*)(buf + G::OFF_VT + (32 * vs + r) * 144 + ts * 32 + hh * 16);
    f32x16 o[2];
#pragma unroll
    for (int it = 0; it < 2; ++it) {
#pragma unroll
        for (int i = 0; i < 16; ++i) o[it][i] = 0.f; }
#pragma unroll
    for (int kt = 0; kt < KT_; ++kt) { const bf16x8 b0 = pack_step<0>(S[kt]), b1 = pack_step<1>(S[kt]);
#pragma unroll
        for (int it = 0; it < 2; ++it) { const bf16x8 q0 = *(const LAS bf16x8*)(buf + G::OFF_QP + (32 * it + r) * G::QPITCH + (2 * kt) * 32 + hh * 16), q1 = *(const LAS bf16x8*)(buf + G::OFF_QP + (32 * it + r) * G::QPITCH + (2 * kt + 1) * 32 + hh * 16);
            o[it] = MFMA32(q0, b0, o[it]); o[it] = MFMA32(q1, b1, o[it]); }
        __builtin_amdgcn_sched_barrier(0); }
#pragma unroll
    for (int ts = 0; ts < 4; ++ts)
#pragma unroll
        for (int it = 0; it < 2; ++it) { const bf16x8 af = *(const LAS bf16x8*)(buf + G::OFF_A + (32 * it + r) * 144 + ts * 32 + hh * 16);
            o[it] = MFMA32(af, vf[ts], o[it]); }
    __builtin_amdgcn_sched_barrier(0);
#pragma unroll
    for (int kt = 0; kt < KT_; ++kt) {
        __builtin_amdgcn_sched_barrier(0);
#pragma unroll
        for (int g = 0; g < 4; ++g) { const f32x4 lm = *(const LAS f32x4*)(buf + G::OFF_LAM + (32 * kt + 8 * g + 4 * hh) * 4);
#pragma unroll
            for (int j = 0; j < 4; ++j) S[kt][4 * g + j] *= lm[j]; }
#pragma unroll
        for (int ts = 0; ts < 4; ++ts) { const bf16x8 kf = *(const LAS bf16x8*)(buf + G::OFF_KT + (32 * kt + r) * 144 + ts * 32 + hh * 16);
            S[kt] = MFMA32(kf, vf[ts], S[kt]); } }
    __builtin_amdgcn_sched_barrier(0);
#pragma unroll
    for (int it = 0; it < 2; ++it)
#pragma unroll
        for (int i = 0; i < 16; ++i) orow[(size_t)(32 * it + crow16(i, hh)) * 2048 + 32 * vs + r] = f2bf(o[it][i]);
}
template <int L, int TY>
__device__ __forceinline__ void chain_g(const Ctx& c, int b, int h, int d) {
    typedef GChunk<TY> G; constexpr int KT_ = G::K / 32;
    ARGS_REF a = *c.a;
    const unsigned char* scr = a.ws + WS_SCR;
    LAS unsigned char* buf = c.lds + LDS_SCR;
    static_assert(G::BYTES <= 65536, "two chunk buffers must fit the scratch region");
#define CHUNK_OF(m) (d ? ((m) < 4 ? 3 - (m) : 263 - (m)) : (m))
    __syncthreads();
    if (c.wave < 4) {
        bf16_t* ORAW = (bf16_t*)(a.ws + WS_ORAW) + (size_t)d * MT * 2048 + TY * 512 + h * 128;
        f32x16 S[KT_];
#pragma unroll
        for (int kt = 0; kt < KT_; ++kt)
#pragma unroll
            for (int i = 0; i < 16; ++i) S[kt][i] = 0.f;
        LBAR();
#pragma unroll 1
        for (int m = 0; m < 260; ++m) {
            gchunk_compute<TY>(buf + (m & 1) * 65536, S, ORAW + chunk_rowbase(b, CHUNK_OF(m)) * 2048, c.wave, c.lane);
            LBAR();
        }
    } else {
        const int lt = c.tid - 256;
        u32x4 pfA[G::NRL], pfB[G::NRL]; float lamA = 0.f, lamB = 0.f;
        gchunk_issue<TY>(scr, b, h, d, CHUNK_OF(0), lt, pfA, lamA);
        gchunk_issue<TY>(scr, b, h, d, CHUNK_OF(1), lt, pfB, lamB);
        gchunk_commit<TY>(buf, lt, pfA, lamA);
        gchunk_issue<TY>(scr, b, h, d, CHUNK_OF(2), lt, pfA, lamA);
        LBAR();
#pragma unroll 1
        for (int m = 0; m < 260; m += 2) {
            gchunk_commit<TY>(buf + 65536, lt, pfB, lamB);
            if (m + 3 < 260) gchunk_issue<TY>(scr, b, h, d, CHUNK_OF(m + 3), lt, pfB, lamB);
            LBAR();
            if (m + 2 < 260) gchunk_commit<TY>(buf, lt, pfA, lamA);
            if (m + 4 < 260) gchunk_issue<TY>(scr, b, h, d, CHUNK_OF(m + 4), lt, pfA, lamA);
            LBAR();
        }
    }
#undef CHUNK_OF
}

__device__ __forceinline__ int posU(int i) { const int w = i & 31; return (i & 32) + (((w >> 2) & 1) << 4) + (w & 3) + ((w >> 3) << 2); }
__device__ __forceinline__ constexpr int pp16(int w) { return (((w >> 2) & 1) << 3) + ((w >> 3) << 2) + (w & 3); }

__device__ __forceinline__ void trisolve64(const LAS float* A, int cidx, float (&Tc)[64]) {
#pragma unroll
    for (int pi = 0; pi < 64; ++pi) {
        float acc = (pi == cidx) ? 1.f : 0.f;
#pragma unroll
        for (int q = 0; q < (pi + 3) / 4; ++q) { const f32x4 av = *(const LAS f32x4*)(A + pi * 64 + 4 * q);
#pragma unroll
            for (int jj = 0; jj < 4; ++jj) if (4 * q + jj < pi) acc -= av[jj] * Tc[4 * q + jj]; }
        Tc[pi] = acc;
        if ((pi & 3) == 3) __builtin_amdgcn_sched_barrier(0);
    }
}

template <int L>
__device__ __forceinline__ void intra_dn_item(const Ctx& c, int b, int h, int n) {
    ARGS_REF a = *c.a; const int tid = c.tid, lane = c.lane, wave = c.wave;
    const bf16_t* PM = (const bf16_t*)(a.ws + WS_PMIX);
    unsigned char* scr = a.ws + WS_SCR;
    const int rec = (b * 4 + h) * 260 + n;
    LAS unsigned char* Qh = c.lds + LDS_SCR;
    LAS unsigned char* Kh = Qh + 17408;
    LAS unsigned char* Tp = Qh;
    LAS unsigned char* KTp = c.lds + LDS_SCR + 36864;
    LAS unsigned char* VTp = KTp + 18432;
    LAS float* Ap = (LAS float*)(VTp + 18432);
    LAS float* sm = (LAS float*)(c.lds + LDS_AUX);
    LBAR();
    {
        const int i = tid >> 3, cg = tid & 7;
        const int Ls = n < 4 ? CL : T; const int tseg = (n < 4 ? n : n - 4) * 64 + i; const size_t segbase = n < 4 ? (size_t)ML + b * CL : (size_t)b * T;
        float aq[16], ak[16], av[16];
#pragma unroll
        for (int j = 0; j < 16; ++j) { aq[j] = 0.f; ak[j] = 0.f; av[j] = 0.f; }
        const float* cw = a.in[I_DN_CW] + (size_t)L * 4 * 1536 + h * 128 + cg * 16;
#pragma unroll
        for (int tap = 0; tap < 4; ++tap) { const int ts = tseg + tap - 2;
            if (ts >= 0 && ts < Ls) { const bf16_t* rp = PM + (segbase + ts) * NMIXP + h * 128 + cg * 16; const float* w = cw + tap * 1536;
                float f0[8], f1[8];
                { const u32x4 w0 = *(const u32x4*)(rp + C_DN_Q), w1 = *(const u32x4*)(rp + C_DN_Q + 8); unpack8(w0, f0); unpack8(w1, f1); }
#pragma unroll
                for (int j = 0; j < 8; ++j) { aq[j] += w[j] * f0[j]; aq[8 + j] += w[8 + j] * f1[j]; }
                { const u32x4 w0 = *(const u32x4*)(rp + C_DN_K), w1 = *(const u32x4*)(rp + C_DN_K + 8); unpack8(w0, f0); unpack8(w1, f1); }
#pragma unroll
                for (int j = 0; j < 8; ++j) { ak[j] += w[512 + j] * f0[j]; ak[8 + j] += w[512 + 8 + j] * f1[j]; }
                { const u32x4 w0 = *(const u32x4*)(rp + C_DN_V), w1 = *(const u32x4*)(rp + C_DN_V + 8); unpack8(w0, f0); unpack8(w1, f1); }
#pragma unroll
                for (int j = 0; j < 8; ++j) { av[j] += w[1024 + j] * f0[j]; av[8 + j] += w[1024 + 8 + j] * f1[j]; } } }
        float sq = 0.f, sk = 0.f;
#pragma unroll
        for (int j = 0; j < 16; ++j) { aq[j] = siluf(aq[j]); ak[j] = siluf(ak[j]); av[j] = siluf(av[j]); sq += aq[j] * aq[j]; sk += ak[j] * ak[j]; }
        sq += __shfl_xor(sq, 1); sq += __shfl_xor(sq, 2); sq += __shfl_xor(sq, 4);
        sk += __shfl_xor(sk, 1); sk += __shfl_xor(sk, 2); sk += __shfl_xor(sk, 4);
        const float rq = __builtin_amdgcn_rsqf(sq + EPS) * 0.08838834764831845f, rk = __builtin_amdgcn_rsqf(sk + EPS);
        float qp[16];
#pragma unroll
        for (int j = 0; j < 16; ++j) { aq[j] *= rq; ak[j] *= rk; }
#pragma unroll
        for (int j = 0; j < 16; ++j) qp[pp16(j)] = aq[j];
        {   float x0[8], x1[8];
#pragma unroll
            for (int j = 0; j < 8; ++j) { x0[j] = qp[j]; x1[j] = qp[8 + j]; }
            u32x4* dst = (u32x4*)(scr + SC_DN_QS + (size_t)rec * 16384 + i * 256 + cg * 32); dst[0] = pack8(x0); dst[1] = pack8(x1);
#pragma unroll
            for (int j = 0; j < 8; ++j) { x0[j] = aq[j]; x1[j] = aq[8 + j]; }
            *(LAS u32x4*)(Qh + i * 272 + cg * 32) = pack8(x0); *(LAS u32x4*)(Qh + i * 272 + cg * 32 + 16) = pack8(x1);
#pragma unroll
            for (int j = 0; j < 8; ++j) { x0[j] = ak[j]; x1[j] = ak[8 + j]; }
            *(LAS u32x4*)(Kh + i * 272 + cg * 32) = pack8(x0); *(LAS u32x4*)(Kh + i * 272 + cg * 32 + 16) = pack8(x1); }
        const int pj = permpos(i);
#pragma unroll
        for (int j = 0; j < 16; ++j) { *(LAS bf16_t*)(KTp + (cg * 16 + j) * 144 + pj * 2) = f2bf(ak[j]); *(LAS bf16_t*)(VTp + (cg * 16 + j) * 144 + pj * 2) = f2bf(av[j]); }
        if (tid < 128) { const int d = tid >> 6, t = tid & 63; const bf16_t* rp = PM + (chunk_rowbase(b, n) + t) * NMIXP;
            const float g = -expf(a.in[I_DN_ALOG][(L * 2 + d) * 4 + h]) * softplusf(bf1(rp + C_DN_A + d * 4 + h) + a.in[I_DN_DTB][(L * 2 + d) * 4 + h]);
            sm[d * 256 + t] = g; sm[d * 256 + 128 + t] = sigm(bf1(rp + C_DN_B + d * 4 + h)); }
    }
    LBAR();
    const int r = lane & 31, hh = lane >> 5;
    f32x16 gram;
#pragma unroll
    for (int i = 0; i < 16; ++i) gram[i] = 0.f;
    const int t1 = (wave & 3) >> 1, t2 = wave & 1;
#pragma unroll
    for (int ks = 0; ks < 8; ++ks) {
        const bf16x8 af = *(const LAS bf16x8*)(Kh + (32 * (wave < 4 ? t2 : t1) + r) * 272 + ks * 32 + hh * 16);
        const bf16x8 bfr = *(const LAS bf16x8*)((wave < 4 ? Qh : Kh) + (32 * (wave < 4 ? t1 : t2) + r) * 272 + ks * 32 + hh * 16);
        gram = MFMA32(af, bfr, gram); }
    {
        u32x4* dst = (u32x4*)(scr + SC_DN_KT + (size_t)rec * 16384);
#pragma unroll
        for (int q = 0; q < 2; ++q) { const int p = q * 512 + tid; dst[p] = *(const LAS u32x4*)(KTp + (p >> 3) * 144 + (p & 7) * 16); } }
    if (tid < 128) { const int d = tid >> 6, t = tid & 63; float acc = 0.f;
        for (int tt = 0; tt < 64; ++tt) { const float g = sm[d * 256 + tt]; if (d ? (tt >= t) : (tt <= t)) acc += g; }
        sm[d * 256 + 64 + t] = acc; }
    LBAR();
#pragma unroll 1
    for (int d = 0; d < 2; ++d) {
        const LAS float* gc = sm + d * 256 + 64; const LAS float* be = sm + d * 256 + 128;
        const size_t drec = (size_t)((d * 8 + b * 4 + h) * 260 + n);
        if (wave < 4) {
            const int i = 32 * t1 + r; const float gi = gc[i]; float o[16];
#pragma unroll
            for (int idx = 0; idx < 16; ++idx) { const int j = 32 * t2 + crow16(idx, hh); const bool ok = d ? (j >= i) : (j <= i); o[idx] = ok ? gram[idx] * __expf(fminf(gi - gc[j], 0.f)) : 0.f; }
            float x0[8], x1[8];
#pragma unroll
            for (int j = 0; j < 8; ++j) { x0[j] = o[j]; x1[j] = o[8 + j]; }
            bf16_t* ap = (bf16_t*)(scr + SC_DN_AQK + drec * 8192) + i * 64 + 32 * t2 + 8 * hh;
            *(u32x4*)ap = pack8(x0); *(u32x4*)(ap + 16) = pack8(x1);
        } else {
            const int j = 32 * t2 + r; const float gj = gc[j]; const int pj = d ? 63 - j : j;
#pragma unroll
            for (int idx = 0; idx < 16; ++idx) { const int i = 32 * t1 + crow16(idx, hh); const int pi = d ? 63 - i : i;
                Ap[d * 4096 + pi * 64 + pj] = (pj < pi) ? be[i] * gram[idx] * __expf(fminf(gc[i] - gj, 0.f)) : 0.f; }
        }
        if (tid < 64) { const float gtot = d ? gc[0] : gc[63]; float* sc = (float*)(scr + SC_DN_SC + drec * 1024);
            const float eg = __expf(gc[tid]); sc[tid] = eg; sc[64 + tid] = __expf(gtot - gc[tid]); if (tid == 0) sc[128] = __expf(gtot); sm[d * 256 + 192 + tid] = eg; }
    }
    LBAR();
    if (wave < 2) {
        const int d = wave; float Tc[64];
        trisolve64(Ap + d * 4096, lane, Tc);
        const int j = d ? 63 - lane : lane; const float bj = sm[d * 256 + 128 + j], ej = sm[d * 256 + 192 + j]; const int pj2 = permpos(j) * 2;
        LAS unsigned char* T1 = Tp + d * 18432; LAS unsigned char* T2 = T1 + 9216;
#pragma unroll
        for (int pi = 0; pi < 64; ++pi) { const int i = d ? 63 - pi : pi; const float v1 = Tc[pi] * bj;
            *(LAS bf16_t*)(T1 + i * 144 + pj2) = f2bf(v1); *(LAS bf16_t*)(T2 + i * 144 + pj2) = f2bf(v1 * ej); }
    }
    LBAR();
#pragma unroll 1
    for (int q = 0; q < 4; ++q) {
        const int tile = wave * 4 + q, d = tile >> 4, isw = (tile >> 3) & 1, it = (tile >> 2) & 1, xt = tile & 3;
        const size_t drec = (size_t)((d * 8 + b * 4 + h) * 260 + n);
        LAS unsigned char* T1 = Tp + d * 18432; LAS unsigned char* T2 = T1 + 9216;
        f32x16 acc;
#pragma unroll
        for (int i = 0; i < 16; ++i) acc[i] = 0.f;
        if (!isw) {
#pragma unroll
            for (int js = 0; js < 4; ++js) { const bf16x8 af = *(const LAS bf16x8*)(T1 + (32 * it + r) * 144 + js * 32 + hh * 16), bfr = *(const LAS bf16x8*)(VTp + (32 * xt + r) * 144 + js * 32 + hh * 16);
                acc = MFMA32(af, bfr, acc); }
            float x0[8], x1[8];
#pragma unroll
            for (int j = 0; j < 8; ++j) { x0[j] = acc[j]; x1[j] = acc[8 + j]; }
            bf16_t* up = (bf16_t*)(scr + SC_DN_UT + drec * 16384) + (32 * xt + r) * 64 + it * 32 + hh * 16;
            *(u32x4*)up = pack8(x0); *(u32x4*)(up + 8) = pack8(x1);
        } else {
#pragma unroll
            for (int js = 0; js < 4; ++js) { const bf16x8 af = *(const LAS bf16x8*)(KTp + (32 * xt + r) * 144 + js * 32 + hh * 16), bfr = *(const LAS bf16x8*)(T2 + (32 * it + r) * 144 + js * 32 + hh * 16);
                acc = MFMA32(af, bfr, acc); }
            float x0[8], x1[8];
#pragma unroll
            for (int j = 0; j < 8; ++j) { x0[j] = -acc[j]; x1[j] = -acc[8 + j]; }
            bf16_t* wp = (bf16_t*)(scr + SC_DN_WN + drec * 16384) + (32 * it + r) * 128 + 32 * xt + 8 * hh;
            *(u32x4*)wp = pack8(x0); *(u32x4*)(wp + 16) = pack8(x1);
        }
    }
}

struct DChunk { static constexpr int OFF_QS = 0, OFF_KT = 17408, OFF_WN = OFF_KT + 18432, OFF_AQK = OFF_WN + 17408, OFF_SC = OFF_AQK + 9216, BYTES = OFF_SC + 1024, NRL = 14; };
static_assert(DChunk::BYTES <= 65536, "two DeltaNet chunk images must fit the scratch region");
__device__ __forceinline__ void dchunk_issue(const unsigned char* scr, int b, int h, int d, int n, int lt, u32x4 (&pf)[DChunk::NRL], f32x4& scv) {
    const size_t drec = (size_t)((d * 8 + b * 4 + h) * 260 + n), rec = (size_t)((b * 4 + h) * 260 + n);
    const u32x4* qs = (const u32x4*)(scr + SC_DN_QS + rec * 16384); const u32x4* kt = (const u32x4*)(scr + SC_DN_KT + rec * 16384);
    const u32x4* wn = (const u32x4*)(scr + SC_DN_WN + drec * 16384); const u32x4* aq = (const u32x4*)(scr + SC_DN_AQK + drec * 8192);
#pragma unroll
    for (int i = 0; i < 4; ++i) { pf[i] = qs[i * 256 + lt]; pf[4 + i] = kt[i * 256 + lt]; pf[8 + i] = wn[i * 256 + lt]; }
    pf[12] = aq[lt]; pf[13] = aq[256 + lt];
    if (lt < 64) scv = ((const f32x4*)(scr + SC_DN_SC + drec * 1024))[lt];
}
__device__ __forceinline__ void dchunk_commit(LAS unsigned char* buf, int lt, const u32x4 (&pf)[DChunk::NRL], const f32x4 scv) {
    typedef DChunk G;
#pragma unroll
    for (int i = 0; i < 4; ++i) { const int p = i * 256 + lt;
        *(LAS u32x4*)(buf + G::OFF_QS + (p >> 4) * 272 + (p & 15) * 16) = pf[i];
        *(LAS u32x4*)(buf + G::OFF_KT + (p >> 3) * 144 + (p & 7) * 16) = pf[4 + i];
        *(LAS u32x4*)(buf + G::OFF_WN + (p >> 4) * 272 + (p & 15) * 16) = pf[8 + i]; }
#pragma unroll
    for (int i = 0; i < 2; ++i) { const int p = i * 256 + lt; *(LAS u32x4*)(buf + G::OFF_AQK + (p >> 3) * 144 + (p & 7) * 16) = pf[12 + i]; }
    if (lt < 64) *(LAS f32x4*)(buf + G::OFF_SC + lt * 16) = scv;
}
__device__ __forceinline__ void dchunk_loadu(const unsigned char* scr, int b, int h, int d, int n, int vs, int lane, u32x4 (&uu)[4]) {
    const size_t drec = (size_t)((d * 8 + b * 4 + h) * 260 + n); const int r = lane & 31, hh = lane >> 5;
    const u32x4* up = (const u32x4*)(scr + SC_DN_UT + drec * 16384 + (32 * vs + r) * 128 + hh * 32);
    uu[0] = up[0]; uu[1] = up[1]; uu[2] = up[4]; uu[3] = up[5];
}
__device__ __forceinline__ void dchunk_compute(LAS unsigned char* buf, f32x16 (&S)[4], bf16_t* orow, int vs, int lane, const u32x4 (&uu)[4]) {
    typedef DChunk G; const int r = lane & 31, hh = lane >> 5;
    f32x16 vn[2], o[2];
#pragma unroll
    for (int it = 0; it < 2; ++it) { const u32x4 u0 = uu[2 * it], u1 = uu[2 * it + 1];
        float f0[8], f1[8]; unpack8(u0, f0); unpack8(u1, f1);
#pragma unroll
        for (int j = 0; j < 8; ++j) { vn[it][j] = f0[j]; vn[it][8 + j] = f1[j]; o[it][j] = 0.f; o[it][8 + j] = 0.f; } }
#pragma unroll
    for (int kt = 0; kt < 4; ++kt) { const bf16x8 b0 = pack_step<0>(S[kt]), b1 = pack_step<1>(S[kt]);
#pragma unroll
        for (int it = 0; it < 2; ++it) {
            const bf16x8 w0 = *(const LAS bf16x8*)(buf + G::OFF_WN + (32 * it + r) * 272 + (2 * kt) * 32 + hh * 16), w1 = *(const LAS bf16x8*)(buf + G::OFF_WN + (32 * it + r) * 272 + (2 * kt + 1) * 32 + hh * 16);
            const bf16x8 q0 = *(const LAS bf16x8*)(buf + G::OFF_QS + (32 * it + r) * 272 + (2 * kt) * 32 + hh * 16), q1 = *(const LAS bf16x8*)(buf + G::OFF_QS + (32 * it + r) * 272 + (2 * kt + 1) * 32 + hh * 16);
            vn[it] = MFMA32(w0, b0, vn[it]); o[it] = MFMA32(q0, b0, o[it]); vn[it] = MFMA32(w1, b1, vn[it]); o[it] = MFMA32(q1, b1, o[it]); }
        __builtin_amdgcn_sched_barrier(0); }
#pragma unroll
    for (int it = 0; it < 2; ++it)
#pragma unroll
        for (int g = 0; g < 4; ++g) { const f32x4 e = *(const LAS f32x4*)(buf + G::OFF_SC + (32 * it + 8 * g + 4 * hh) * 4);
#pragma unroll
            for (int j = 0; j < 4; ++j) o[it][4 * g + j] *= e[j]; }
    __builtin_amdgcn_sched_barrier(0);
#pragma unroll
    for (int jt = 0; jt < 2; ++jt) { const bf16x8 p0 = pack_step<0>(vn[jt]), p1 = pack_step<1>(vn[jt]);
#pragma unroll
        for (int it = 0; it < 2; ++it) { const bf16x8 a0 = *(const LAS bf16x8*)(buf + G::OFF_AQK + (32 * it + r) * 144 + (2 * jt) * 32 + hh * 16), a1 = *(const LAS bf16x8*)(buf + G::OFF_AQK + (32 * it + r) * 144 + (2 * jt + 1) * 32 + hh * 16);
            o[it] = MFMA32(a0, p0, o[it]); o[it] = MFMA32(a1, p1, o[it]); } }
    __builtin_amdgcn_sched_barrier(0);
#pragma unroll
    for (int jt = 0; jt < 2; ++jt)
#pragma unroll
        for (int g = 0; g < 4; ++g) { const f32x4 e = *(const LAS f32x4*)(buf + G::OFF_SC + 256 + (32 * jt + 8 * g + 4 * hh) * 4);
#pragma unroll
            for (int j = 0; j < 4; ++j) vn[jt][4 * g + j] *= e[j]; }
    const float glast = *(const LAS float*)(buf + G::OFF_SC + 512);
    const bf16x8 p00 = pack_step<0>(vn[0]), p01 = pack_step<1>(vn[0]), p10 = pack_step<0>(vn[1]), p11 = pack_step<1>(vn[1]);
    __builtin_amdgcn_sched_barrier(0);
#pragma unroll
    for (int kt = 0; kt < 4; ++kt) {
#pragma unroll
        for (int i = 0; i < 16; ++i) S[kt][i] *= glast;
        const LAS unsigned char* kb = buf + G::OFF_KT + (32 * kt + r) * 144 + hh * 16;
        S[kt] = MFMA32(*(const LAS bf16x8*)(kb), p00, S[kt]); S[kt] = MFMA32(*(const LAS bf16x8*)(kb + 32), p01, S[kt]);
        S[kt] = MFMA32(*(const LAS bf16x8*)(kb + 64), p10, S[kt]); S[kt] = MFMA32(*(const LAS bf16x8*)(kb + 96), p11, S[kt]);
        __builtin_amdgcn_sched_barrier(0); }
#pragma unroll
    for (int it = 0; it < 2; ++it)
#pragma unroll
        for (int i = 0; i < 16; ++i) orow[(size_t)(32 * it + crow16(i, hh)) * 2048 + 32 * vs + r] = f2bf(o[it][i]);
}
template <int L>
__device__ __forceinline__ void chain_dnc(const Ctx& c, int b, int h, int d) {
    ARGS_REF a = *c.a;
    const unsigned char* scr = a.ws + WS_SCR;
    LAS unsigned char* buf = c.lds + LDS_SCR;
#define CHUNK_OF(m) (d ? ((m) < 4 ? 3 - (m) : 263 - (m)) : (m))
    __syncthreads();
    if (c.wave < 4) {
        bf16_t* ORAW = (bf16_t*)(a.ws + WS_ORAW) + (size_t)d * MT * 2048 + 2 * 512 + h * 128;
        f32x16 S[4];
#pragma unroll
        for (int kt = 0; kt < 4; ++kt)
#pragma unroll
            for (int i = 0; i < 16; ++i) S[kt][i] = 0.f;
        u32x4 ua[4], un[4];
        dchunk_loadu(scr, b, h, d, CHUNK_OF(0), c.wave, c.lane, ua);
        LBAR();
#pragma unroll 1
        for (int m = 0; m < 260; ++m) {
            if (m + 1 < 260) dchunk_loadu(scr, b, h, d, CHUNK_OF(m + 1), c.wave, c.lane, un);
            dchunk_compute(buf + (m & 1) * 65536, S, ORAW + chunk_rowbase(b, CHUNK_OF(m)) * 2048, c.wave, c.lane, ua);
            LBAR();
#pragma unroll
            for (int i = 0; i < 4; ++i) ua[i] = un[i];
        }
    } else {
        const int lt = c.tid - 256;
        u32x4 pfA[DChunk::NRL], pfB[DChunk::NRL]; f32x4 scA = {0.f, 0.f, 0.f, 0.f}, scB = scA;
        dchunk_issue(scr, b, h, d, CHUNK_OF(0), lt, pfA, scA);
        dchunk_issue(scr, b, h, d, CHUNK_OF(1), lt, pfB, scB);
        dchunk_commit(buf, lt, pfA, scA);
        dchunk_issue(scr, b, h, d, CHUNK_OF(2), lt, pfA, scA);
        LBAR();
#pragma unroll 1
        for (int m = 0; m < 260; m += 2) {
            dchunk_commit(buf + 65536, lt, pfB, scB);
            if (m + 3 < 260) dchunk_issue(scr, b, h, d, CHUNK_OF(m + 3), lt, pfB, scB);
            LBAR();
            if (m + 2 < 260) dchunk_commit(buf, lt, pfA, scA);
            if (m + 4 < 260) dchunk_issue(scr, b, h, d, CHUNK_OF(m + 4), lt, pfA, scA);
            LBAR();
        }
    }
#undef CHUNK_OF
}

__device__ __forceinline__ void rgw_convert(const Ctx& c) {
    ARGS_REF a = *c.a; bf16_t* dst = (bf16_t*)(a.ws + WS_RGW);
    for (int e = c.wg * 512 + c.tid; e < 32 * 16384; e += c.G * 512) { const int m = e >> 14, oc = (e >> 7) & 127, cc = e & 127, l = m >> 4, d = (m >> 3) & 1, n = (m >> 1) & 3, g = m & 1;
        const float* src = g ? a.in[I_RG_WI] : a.in[I_RG_WR];
        dst[e] = f2bf(src[((size_t)(((l * 2 + d) * 4 + n) * 128 + cc)) * 128 + oc]); }
}
template <int L>
__device__ __forceinline__ void rgprep_item2(const Ctx& c, int item) {
    ARGS_REF a = *c.a; const int tid = c.tid, lane = c.lane, wave = c.wave;
    LAS unsigned char* XB = c.lds + LDS_SCR;
    LAS float* xbT = (LAS float*)(c.lds + LDS_SCR + 17408);
    LAS float* PRE = (LAS float*)(c.lds + LDS_SCR + 52224);
    LAS float* SEG = (LAS float*)(c.lds + LDS_AUX);
    const bf16_t* PM = (const bf16_t*)(a.ws + WS_PMIX);
    bf16_t* RGLA = (bf16_t*)(a.ws + WS_RGLA); bf16_t* ORAW = (bf16_t*)(a.ws + WS_ORAW);
    float* TT = (float*)(a.ws + WS_RGTT);
    const float* cw = a.in[I_RG_CW] + L * 4 * 512; const float* cb = a.in[I_RG_CB] + L * 512;
    const int tt = item >> 2, n = item & 3;
    size_t rowbase; int t0, Ls, bb, nchunk;
    if (tt < 512) { bb = tt >> 8; rowbase = (size_t)bb * T; t0 = (tt & 255) * 64; Ls = T; nchunk = 4 + (tt & 255); }
    else { const int tc = tt - 512; bb = tc >> 2; rowbase = (size_t)ML + bb * CL; t0 = (tc & 3) * 64; Ls = CL; nchunk = tc & 3; }
    LBAR();
    {
        const int tl = tid >> 3, cg = tid & 7, ch0 = n * 128 + cg * 16;
        float acc[16];
#pragma unroll
        for (int j = 0; j < 16; ++j) acc[j] = cb[ch0 + j];
#pragma unroll
        for (int tap = 0; tap < 4; ++tap) { const int ts = t0 + tl + tap - 2;
            if (ts >= 0 && ts < Ls) { const bf16_t* rp = PM + (rowbase + ts) * NMIXP + C_RG_X + ch0; const u32x4 w0 = *(const u32x4*)rp, w1 = *(const u32x4*)(rp + 8);
                float f[8], g[8]; unpack8(w0, f); unpack8(w1, g);
#pragma unroll
                for (int j = 0; j < 8; ++j) { acc[j] += cw[tap * 512 + ch0 + j] * f[j]; acc[8 + j] += cw[tap * 512 + ch0 + 8 + j] * g[j]; } } }
#pragma unroll
        for (int j = 0; j < 16; ++j) xbT[(cg * 16 + j) * 68 + tl] = acc[j];
        float x0[8], x1[8];
#pragma unroll
        for (int j = 0; j < 8; ++j) { x0[j] = acc[j]; x1[j] = acc[8 + j]; }
        *(LAS u32x4*)(XB + tl * 272 + cg * 32) = pack8(x0); *(LAS u32x4*)(XB + tl * 272 + cg * 32 + 16) = pack8(x1);
    }
    LBAR();
    const int r = lane & 31, hh = lane >> 5, tth = wave & 1, ot = wave >> 1;
    const int oc = tid & 127, tq = tid >> 7, ch = n * 128 + oc;
#pragma unroll 1
    for (int d = 0; d < 2; ++d) {
        {
            const bf16_t* wbase = (const bf16_t*)(a.ws + WS_RGW) + (size_t)(((L * 2 + d) * 4 + n) * 2) * 16384 + (32 * ot + r) * 128 + hh * 8;
#pragma unroll
            for (int g = 0; g < 2; ++g) { f32x16 acc;
#pragma unroll
                for (int i = 0; i < 16; ++i) acc[i] = 0.f;
#pragma unroll
                for (int ks = 0; ks < 8; ++ks) { const bf16x8 af = *(const LAS bf16x8*)(XB + (32 * tth + r) * 272 + ks * 32 + hh * 16); const bf16x8 bfr = *(const bf16x8*)(wbase + g * 16384 + ks * 16);
                    acc = MFMA32(af, bfr, acc); }
#pragma unroll
                for (int gq = 0; gq < 4; ++gq) { f32x4 v = {acc[4 * gq], acc[4 * gq + 1], acc[4 * gq + 2], acc[4 * gq + 3]};
                    *(LAS f32x4*)(PRE + (g * 128 + 32 * ot + r) * 68 + 32 * tth + 8 * gq + 4 * hh) = v; } }
        }
        LBAR();
        {
            const float br = a.in[I_RG_BR][(L * 2 + d) * 512 + ch], bi = a.in[I_RG_BI][(L * 2 + d) * 512 + ch];
            const float sp = softplusf(-a.in[I_RG_LAM][(L * 2 + d) * 512 + ch]);
            float la[16], hl[16];
#pragma unroll
            for (int q = 0; q < 4; ++q) { const f32x4 pr = *(const LAS f32x4*)(PRE + oc * 68 + 16 * tq + 4 * q), pi = *(const LAS f32x4*)(PRE + (128 + oc) * 68 + 16 * tq + 4 * q), xv = *(const LAS f32x4*)(xbT + oc * 68 + 16 * tq + 4 * q);
#pragma unroll
                for (int j = 0; j < 4; ++j) { const float rr = sigm(pr[j] + br), ig = sigm(pi[j] + bi); const float l = -8.0f * rr * sp;
                    la[4 * q + j] = l; hl[4 * q + j] = __builtin_amdgcn_sqrtf(fmaxf(1.0f - __expf(2.0f * l), 0.f)) * (ig * xv[j]); } }
            float hrun = 0.f, lrun = 0.f;
            if (d == 0) {
#pragma unroll
                for (int j = 0; j < 16; ++j) { hrun = __expf(la[j]) * hrun + hl[j]; lrun += la[j]; hl[j] = hrun; la[j] = lrun; } }
            else {
#pragma unroll
                for (int j = 15; j >= 0; --j) { hrun = __expf(la[j]) * hrun + hl[j]; lrun += la[j]; hl[j] = hrun; la[j] = lrun; } }
            SEG[(tq * 128 + oc) * 2] = lrun; SEG[(tq * 128 + oc) * 2 + 1] = hrun;
            LBAR();
            float Hin = 0.f, Lin = 0.f, Htot = 0.f, Ltot = 0.f;
#pragma unroll
            for (int s = 0; s < 4; ++s) { const int sg = d ? 3 - s : s; const float ls = SEG[(sg * 128 + oc) * 2], hs = SEG[(sg * 128 + oc) * 2 + 1];
                const bool before = d ? (sg > tq) : (sg < tq);
                if (before) { Hin = __expf(ls) * Hin + hs; Lin += ls; }
                Htot = __expf(ls) * Htot + hs; Ltot += ls; }
            const size_t ob = ((size_t)d * MT + rowbase + t0 + 16 * tq);
#pragma unroll
            for (int j = 0; j < 16; ++j) { const float e = __expf(la[j]);
                ORAW[(ob + j) * 2048 + 1536 + ch] = f2bf(hl[j] + e * Hin);
                RGLA[(ob + j) * 512 + ch] = f2bf(e * __expf(Lin)); }
            if (tq == 0) { float* tp = TT + ((size_t)((d * 2 + bb) * 260 + nchunk) * 512 + ch) * 2; tp[0] = __expf(Ltot); tp[1] = Htot; }
        }
        LBAR();
    }
}
__device__ __forceinline__ void rg_carry(const Ctx& c, int part) {
    ARGS_REF a = *c.a; const int gid = part * 512 + c.tid, d = gid >> 10, b = (gid >> 9) & 1, ch = gid & 511;
    typedef float f32x2v __attribute__((ext_vector_type(2)));
    const f32x2v* TT = (const f32x2v*)(a.ws + WS_RGTT) + (size_t)((d * 2 + b) * 260) * 512 + ch;
    float* CR = (float*)(a.ws + WS_RGCARRY) + (size_t)((d * 2 + b) * 260) * 512 + ch;
    float H = 0.f;
#pragma unroll 1
    for (int m0 = 0; m0 < 260; m0 += 20) { f32x2v p[20];
#pragma unroll
        for (int j = 0; j < 20; ++j) { const int m = m0 + j, nn = d ? (m < 4 ? 3 - m : 263 - m) : m; p[j] = TT[(size_t)nn * 512]; }
#pragma unroll
        for (int j = 0; j < 20; ++j) { const int m = m0 + j, nn = d ? (m < 4 ? 3 - m : 263 - m) : m; CR[(size_t)nn * 512] = H; H = p[j].x * H + p[j].y; } }
}
#ifndef PROBE_SUB
#define PROBE_SUB 0
#endif
template <int L> __device__ __forceinline__ void gemm_gate_part(const Ctx& c, int G2, int c2);
template <int L>
__device__ __forceinline__ void intra_phase(const Ctx& c) {
    {
        ARGS_REF a = *c.a; const bf16_t* PM = (const bf16_t*)(a.ws + WS_PMIX); bf16_t* GC = (bf16_t*)(a.ws + WS_GC);
        for (int r = c.wg * 8 + c.wave; r < MT; r += c.G * 8) { const bf16_t* pm = PM + (size_t)r * NMIXP; bf16_t* gp = GC + (size_t)r * 2048; const int cb = c.lane * 8;
            const u32x4 g0 = *(const u32x4*)(pm + C_GLA_G + cb), g1 = *(const u32x4*)(pm + C_HG_G + cb), g2 = *(const u32x4*)(pm + C_DN_G + cb), g3 = *(const u32x4*)(pm + C_RG_Y + cb);
            *(u32x4*)(gp + cb) = g0; *(u32x4*)(gp + 512 + cb) = g1; *(u32x4*)(gp + 1024 + cb) = g2; *(u32x4*)(gp + 1536 + cb) = g3; } }
#pragma unroll 1
    for (int rep = 0; rep < ((PROBE_SUB & 1) ? 2 : 1); ++rep)
#pragma unroll 1
    for (int item = c.wg; item < 2080; item += c.G) rgprep_item2<L>(c, item);
#pragma unroll 1
    for (int rep = 0; rep < ((PROBE_SUB & 2) ? 2 : 1); ++rep)
#pragma unroll 1
    for (int item = (c.wg + 96) % c.G; item < 2080; item += c.G) { const int bh = item / 260, n = item % 260; intra_g_item<L, 0>(c, bh >> 2, bh & 3, n); }
#pragma unroll 1
    for (int rep = 0; rep < ((PROBE_SUB & 4) ? 2 : 1); ++rep)
#pragma unroll 1
    for (int item = (c.wg + 192) % c.G; item < 2080; item += c.G) { const int bh = item / 260, n = item % 260; intra_g_item<L, 1>(c, bh >> 2, bh & 3, n); }
#pragma unroll 1
    for (int rep = 0; rep < ((PROBE_SUB & 8) ? 2 : 1); ++rep)
#pragma unroll 1
    for (int item = (c.wg + 32) % c.G; item < 2080; item += c.G) { const int bh = item / 260, n = item % 260; intra_dn_item<L>(c, bh >> 2, bh & 3, n); }
}
template <int L>
__device__ __forceinline__ void chains_phase(const Ctx& c) {
    const int w = c.wg;
    if (w < 32) { const int r = w & 15, b = r >> 3, h = (r >> 1) & 3, d = r & 1;
        if (w < 16) chain_g<L, 0>(c, b, h, d); else chain_g<L, 1>(c, b, h, d); }
    else if (w < 48) { const int r = w - 32, b = r >> 3, h = (r >> 1) & 3, d = r & 1; chain_dnc<L>(c, b, h, d); }
    else if (w < 52) rg_carry(c, w - 48);
    else gemm_gate_part<L>(c, c.G - 52, w - 52);
}
template <int L>
__device__ __forceinline__ void combine_phase(const Ctx& c) {
    ARGS_REF a = *c.a; const int gw = c.wg * 8 + c.wave, nw = c.G * 8, lane = c.lane;
    const bf16_t* PM = (const bf16_t*)(a.ws + WS_PMIX); const bf16_t* O0 = (const bf16_t*)(a.ws + WS_ORAW); const bf16_t* O1 = O0 + (size_t)MT * 2048;
    bf16_t* O = (bf16_t*)(a.ws + WS_O);
    const int cb = lane * 8, hv = cb & 127;
    float nwv[3][8];
#pragma unroll
    for (int j = 0; j < 8; ++j) { nwv[0][j] = a.in[I_GLA_NW][L * 128 + hv + j]; nwv[1][j] = a.in[I_HG_NW][L * 128 + hv + j]; nwv[2][j] = a.in[I_DN_NW][L * 128 + hv + j]; }
    const int nrows = (L == 0) ? MT : ML;
    for (int r = gw; r < nrows; r += nw) {
        const bf16_t* pm = (const bf16_t*)(a.ws + WS_GC) + (size_t)r * 2048;
#pragma unroll
        for (int br = 0; br < 3; ++br) {
            const int gcol = br * 512;
            float x0[8], x1[8], g[8], o[8];
            { const u32x4 w = *(const u32x4*)(O0 + (size_t)r * 2048 + br * 512 + cb); unpack8(w, x0); }
            { const u32x4 w = *(const u32x4*)(O1 + (size_t)r * 2048 + br * 512 + cb); unpack8(w, x1); }
            { const u32x4 w = *(const u32x4*)(pm + gcol + cb); unpack8(w, g); }
            float ss = 0.f;
#pragma unroll
            for (int j = 0; j < 8; ++j) { o[j] = x0[j] + x1[j]; ss += o[j] * o[j]; }
            ss += __shfl_xor(ss, 1); ss += __shfl_xor(ss, 2); ss += __shfl_xor(ss, 4); ss += __shfl_xor(ss, 8);
            const float rs = __builtin_amdgcn_rsqf(ss * (1.0f / 128.0f) + EPS);
#pragma unroll
            for (int j = 0; j < 8; ++j) o[j] = o[j] * rs * nwv[br][j] * siluf(g[j]);
            *(u32x4*)(O + ((size_t)br * MT + r) * 512 + cb) = pack8(o);
        }
        {   float x0[8], x1[8], p0[8], p1[8], y[8], o[8];
            const int bb = r < ML ? (r >> 14) : ((r - ML) >> 8), nchunk = r < ML ? 4 + ((r & 16383) >> 6) : (((r - ML) & 255) >> 6);
            const bf16_t* RGLA = (const bf16_t*)(a.ws + WS_RGLA); const float* CR = (const float*)(a.ws + WS_RGCARRY);
            { const u32x4 w = *(const u32x4*)(O0 + (size_t)r * 2048 + 1536 + cb); unpack8(w, x0); }
            { const u32x4 w = *(const u32x4*)(O1 + (size_t)r * 2048 + 1536 + cb); unpack8(w, x1); }
            { const u32x4 w = *(const u32x4*)(RGLA + (size_t)r * 512 + cb); unpack8(w, p0); }
            { const u32x4 w = *(const u32x4*)(RGLA + ((size_t)MT + r) * 512 + cb); unpack8(w, p1); }
            { const u32x4 w = *(const u32x4*)(pm + 3 * 512 + cb); unpack8(w, y); }
            const float* c0 = CR + (size_t)((0 * 2 + bb) * 260 + nchunk) * 512 + cb; const float* c1 = CR + (size_t)((1 * 2 + bb) * 260 + nchunk) * 512 + cb;
            const f32x4 ca = *(const f32x4*)c0, cb2 = *(const f32x4*)(c0 + 4), cc = *(const f32x4*)c1, cd = *(const f32x4*)(c1 + 4);
#pragma unroll
            for (int j = 0; j < 8; ++j) { const float k0 = j < 4 ? ca[j & 3] : cb2[j & 3], k1 = j < 4 ? cc[j & 3] : cd[j & 3];
                o[j] = gelu_tanh(y[j]) * ((x0[j] + p0[j] * k0) + (x1[j] + p1[j] * k1)); }
            *(u32x4*)(O + ((size_t)3 * MT + r) * 512 + cb) = pack8(o);
        }
    }
}

__device__ __forceinline__ void route1_phase(const Ctx& c) {
    ARGS_REF a = *c.a; const int lane = c.lane;
    const float* modv = (const float*)(a.ws + WS_MOD) + (size_t)1 * 3 * 12288 + 3 * 2048;
    const float* normw = a.in[I_NORMW] + (1 * 2 + 1) * 2048;
    const float* router = a.in[I_ROUTER];
    bf16_t* H = (bf16_t*)(a.ws + WS_H);
    unsigned* topi = (unsigned*)(a.ws + WS_TOPI); float* topw = (float*)(a.ws + WS_TOPW);
    volatile LAS int* hist = (volatile LAS int*)(c.lds + LDS_AUX);
    if (c.tid < 8) hist[c.tid] = 0;
    __syncthreads();
    const int rpw = ML / c.G;
    for (int rr = c.wave; rr < rpw; rr += 8) {
        const int r = c.wg * rpw + rr, b = r >> 14;
        const float* src = (const float*)a.out + (size_t)r * D;
        f32x4 v[8];
#pragma unroll
        for (int j = 0; j < 8; ++j) v[j] = *(const f32x4*)(src + (j * 64 + lane) * 4);
        const float* shift = modv + (size_t)b * 12288;
        modnorm_row(v, normw, shift, shift + 2048, lane);
        { unsigned char* h8 = (unsigned char*)(a.ws + WS_H8) + (size_t)r * D;
#pragma unroll
            for (int j = 0; j < 8; ++j) *(unsigned*)(h8 + (j * 64 + lane) * 4) = pk_fp8x4(v[j][0] * 4.f, v[j][1] * 4.f, v[j][2] * 4.f, v[j][3] * 4.f); }
        float lg[8];
#pragma unroll
        for (int e = 0; e < 8; ++e) lg[e] = 0.f;
#pragma unroll
        for (int j = 0; j < 8; ++j)
#pragma unroll
            for (int q = 0; q < 4; ++q) { const int cc = (j * 64 + lane) * 4 + q; const f32x4 r0 = *(const f32x4*)(router + cc * 8), r1 = *(const f32x4*)(router + cc * 8 + 4); const float x = v[j][q];
                lg[0] += x * r0[0]; lg[1] += x * r0[1]; lg[2] += x * r0[2]; lg[3] += x * r0[3]; lg[4] += x * r1[0]; lg[5] += x * r1[1]; lg[6] += x * r1[2]; lg[7] += x * r1[3]; }
#pragma unroll
        for (int e = 0; e < 8; ++e) lg[e] = wave_sum(lg[e]);
        int e0 = 0; float m0 = lg[0];
#pragma unroll
        for (int e = 1; e < 8; ++e) if (lg[e] > m0) { m0 = lg[e]; e0 = e; }
        int e1 = -1; float m1 = -3.0e38f;
#pragma unroll
        for (int e = 0; e < 8; ++e) if (e != e0 && lg[e] > m1) { m1 = lg[e]; e1 = e; }
        if (e1 < 0) { e1 = (e0 + 1) & 7; m1 = m0; }
        if (lane == 0) { const float ex = __expf(m1 - m0); const float w0 = 1.0f / (1.0f + ex); topi[r] = (unsigned)e0 | ((unsigned)e1 << 8); topw[2 * r] = w0; topw[2 * r + 1] = ex * w0;
            lds_add(&hist[e0]); lds_add(&hist[e1]); }
    }
    __syncthreads();
    if (c.tid < 8) ((int*)(a.ws + WS_CTL + CTL_WGH))[c.wg * 8 + c.tid] = hist[c.tid];
}
__device__ __forceinline__ void route2_phase(const Ctx& c) {
    ARGS_REF a = *c.a; const int lane = c.lane, tid = c.tid;
    const int* wgh = (const int*)(a.ws + WS_CTL + CTL_WGH);
    volatile LAS int* tab = (volatile LAS int*)(c.lds + LDS_AUX);
    if (tid < 8) { int tot = 0, base = 0; for (int w = 0; w < c.G; ++w) { const int v = wgh[w * 8 + tid]; tot += v; if (w < c.wg) base += v; } tab[tid] = tot; tab[8 + tid] = base; tab[24 + tid] = 0; tab[32 + tid] = (tot + 255) / 256 * 256; }
    __syncthreads();
    if (tid == 0) { int acc = 0; for (int e = 0; e < 8; ++e) { tab[16 + e] = acc; acc += tab[32 + e]; }
        if (c.wg == 0) { int* meta = (int*)(a.ws + WS_CTL + CTL_META); int cum = 0; for (int e = 0; e < 8; ++e) { cum += tab[32 + e] / 256; meta[e] = cum; } meta[8] = cum; } }
    __syncthreads();
    const unsigned char* H8 = (const unsigned char*)(a.ws + WS_H8); unsigned char* GATH8 = (unsigned char*)(a.ws + WS_GATH);
    const unsigned* topi = (const unsigned*)(a.ws + WS_TOPI); int* dest = (int*)(a.ws + WS_DEST);
    const int rpw = ML / c.G;
    for (int rr = c.wave; rr < rpw; rr += 8) {
        const int r = c.wg * rpw + rr; const unsigned ti = topi[r]; const int e0 = ti & 255, e1 = (ti >> 8) & 255;
        int d0 = 0, d1 = 0;
        if (lane == 0) { d0 = tab[16 + e0] + tab[8 + e0] + lds_add(&tab[24 + e0]); d1 = tab[16 + e1] + tab[8 + e1] + lds_add(&tab[24 + e1]); dest[2 * r] = d0; dest[2 * r + 1] = d1; }
        d0 = __shfl(d0, 0); d1 = __shfl(d1, 0);
        const u32x4* sp = (const u32x4*)(H8 + (size_t)r * D); u32x4* p0 = (u32x4*)(GATH8 + (size_t)d0 * D); u32x4* p1 = (u32x4*)(GATH8 + (size_t)d1 * D);
#pragma unroll
        for (int j = 0; j < 2; ++j) { const u32x4 w = sp[j * 64 + lane]; p0[j * 64 + lane] = w; p1[j * 64 + lane] = w; }
    }
    if (c.wg < 8) { const int e = c.wg; const int lo = tab[16 + e] + tab[e], hi = tab[16 + e] + tab[32 + e]; const u32x4 z = {0u, 0u, 0u, 0u};
        for (int r = lo + c.wave; r < hi; r += 8) { u32x4* p = (u32x4*)(GATH8 + (size_t)r * D);
#pragma unroll
            for (int j = 0; j < 2; ++j) p[j * 64 + lane] = z; } }
}
__device__ __forceinline__ void final_phase(const Ctx& c) {
    ARGS_REF a = *c.a; const int gw = c.wg * 8 + c.wave, nw = c.G * 8, lane = c.lane;
    const float* modv = (const float*)(a.ws + WS_MOD) + (size_t)1 * 3 * 12288 + 5 * 2048;
    const bf16_t* Y = (const bf16_t*)(a.ws + WS_GATH); const int* dest = (const int*)(a.ws + WS_DEST); const float* topw = (const float*)(a.ws + WS_TOPW);
    const float* fw = a.in[I_FNORMW];
    for (int r = gw; r < ML; r += nw) {
        const int b = r >> 14; float* xr = a.out + (size_t)r * D; const float* mg = modv + (size_t)b * 12288;
        const int d0 = dest[2 * r], d1 = dest[2 * r + 1]; const float w0 = topw[2 * r], w1 = topw[2 * r + 1];
        const bf16_t* y0 = Y + (size_t)d0 * D; const bf16_t* y1 = Y + (size_t)d1 * D;
        f32x4 v[8]; float ss = 0.f;
#pragma unroll
        for (int j = 0; j < 8; ++j) { const int cc = (j * 64 + lane) * 4; const f32x4 x = *(const f32x4*)(xr + cc), g = *(const f32x4*)(mg + cc);
            const u32x2 a0 = *(const u32x2*)(y0 + cc), a1 = *(const u32x2*)(y1 + cc);
            f32x4 m; m[0] = w0 * bflo(a0.x) + w1 * bflo(a1.x); m[1] = w0 * bfhi(a0.x) + w1 * bfhi(a1.x); m[2] = w0 * bflo(a0.y) + w1 * bflo(a1.y); m[3] = w0 * bfhi(a0.y) + w1 * bfhi(a1.y);
            v[j] = x + g * m; ss += v[j][0] * v[j][0] + v[j][1] * v[j][1] + v[j][2] * v[j][2] + v[j][3] * v[j][3]; }
        ss = wave_sum(ss); const float rstd = __builtin_amdgcn_rsqf(ss * (1.0f / 2048.0f) + EPS);
#pragma unroll
        for (int j = 0; j < 8; ++j) { const int cc = (j * 64 + lane) * 4; const f32x4 w = *(const f32x4*)(fw + cc); *(f32x4*)(xr + cc) = v[j] * rstd * w; }
    }
}

#ifndef N_LAUNCHES
#define N_LAUNCHES 1
#endif
constexpr int N_PHASES = 23;

template <int L>
__device__ __forceinline__ void gemm_projmix(const Ctx& c) {
    ARGS_REF a = *c.a;
    pg8::Gemm g{(const bf16_t*)(a.ws + WS_H), (const bf16_t*)(a.ws + WS_WIN + (size_t)L * WIN_BYTES), MT, NMIXP, D};
    pg8::StaticOrder S; S.init(MT, NMIXP, c.G, c.wg);
    pg8::EpiBf16S<false> E{(bf16_t*)(a.ws + WS_PMIX), NMIXP, 1.0f};
    pg8::gemm_phase<pg8::EpiBf16S<false>, pg8::StaticOrder, true, true>(c.lds + LDS_SCR, g, S, E);
}
template <int L>
__device__ __forceinline__ void gemm_gate_part(const Ctx& c, int G2, int c2) {
    ARGS_REF a = *c.a; constexpr int M = (L == 0) ? MT : ML;
    pg8::Gemm g{(const bf16_t*)(a.ws + WS_H8), (const bf16_t*)(a.ws + WS_WG8 + (size_t)L * WG8_BYTES), M, NGATE, D / 2};
    pg8::StaticOrder S; S.init(M, NGATE, G2, c2);
    pg8::EpiBf16S<true> E{(bf16_t*)(a.ws + WS_PGATE), NGATE, 1.0f / 256.0f};
    pg8::gemm_phase8<pg8::EpiBf16S<true>, pg8::StaticOrder, true, true>(c.lds + LDS_SCR, g, S, E);
}
template <int L>
__device__ __forceinline__ void gemm_upgate(const Ctx& c) {
    ARGS_REF a = *c.a; constexpr int M = (L == 0) ? MT : ML;
    pg8::Gemm g{(const bf16_t*)(a.ws + WS_O), (const bf16_t*)(a.ws + WS_WUP + (size_t)L * 8388608), M, 2048, 512};
    pg8::UpGateOrder S; S.init(M, c.G, c.wg, MT / 256);
    pg8::EpiUpGate E{(const bf16_t*)(a.ws + WS_PGATE), (bf16_t*)(a.ws + WS_MERGED), MT / 256};
    pg8::gemm_phase<pg8::EpiUpGate, pg8::UpGateOrder, true, true>(c.lds + LDS_SCR, g, S, E);
}
template <int L>
__device__ __forceinline__ void gemm_wout(const Ctx& c) {
    ARGS_REF a = *c.a; constexpr int M = (L == 0) ? MT : ML;
    pg8::Gemm g{(const bf16_t*)(a.ws + WS_MERGED), (const bf16_t*)(a.ws + WS_WOUT + (size_t)L * 8388608), M, D, D};
    pg8::StaticOrder S; S.init(M, D, c.G, c.wg);
    const float* modv = (const float*)(a.ws + WS_MOD) + (size_t)L * 3 * 12288 + 2 * 2048;
    pg8::EpiResid E{L == 0 ? a.in[I_X] : (const float*)a.out, a.out, L == 0 ? a.in[I_CTX] : (const float*)(a.ws + WS_XC), (float*)(a.ws + WS_XC), modv, L == 1 ? 1 : 0};
    pg8::gemm_phase<pg8::EpiResid, pg8::StaticOrder, true, true>(c.lds + LDS_SCR, g, S, E);
}
__device__ __forceinline__ void gemm_ffn13(const Ctx& c) {
    ARGS_REF a = *c.a;
    pg8::Gemm g{(const bf16_t*)(a.ws + WS_H8), (const bf16_t*)(a.ws + WS_F13), MT, 2 * FF, D / 2};
    pg8::StaticOrder S; S.init(MT, 2 * FF, c.G, c.wg);
    pg8::EpiSwiglu<false> E{(void*)(a.ws + WS_HID), 2 * FF / 256, 1.0f / 256.0f};
    pg8::gemm_phase8<pg8::EpiSwiglu<false>, pg8::StaticOrder, true, true>(c.lds + LDS_SCR, g, S, E);
}
__device__ __forceinline__ void gemm_ffn2(const Ctx& c) {
    ARGS_REF a = *c.a;
    pg8::Gemm g{(const bf16_t*)(a.ws + WS_HID), (const bf16_t*)(a.ws + WS_F2), MT, D, FF};
    pg8::StaticOrder S; S.init(MT, D, c.G, c.wg);
    const float* modv = (const float*)(a.ws + WS_MOD) + (size_t)0 * 3 * 12288 + 5 * 2048;
    pg8::EpiResid E{(const float*)a.out, a.out, (const float*)(a.ws + WS_XC), (float*)(a.ws + WS_XC), modv, 0};
    pg8::gemm_phase<pg8::EpiResid, pg8::StaticOrder, true, true>(c.lds + LDS_SCR, g, S, E);
}
__device__ __forceinline__ void gemm_moe13(const Ctx& c) {
    ARGS_REF a = *c.a; const int* meta = (const int*)(a.ws + WS_CTL + CTL_META);
    int be[8];
#pragma unroll
    for (int e = 0; e < 8; ++e) be[e] = __builtin_amdgcn_readfirstlane(meta[e]);
    pg8::Gemm g{(const bf16_t*)(a.ws + WS_GATH), (const bf16_t*)(a.ws + WS_M13), MOE_ROWS, 2 * FF, D / 2};
    pg8::MoeOrder S; S.init(be[7], 2 * FF / 256, c.G, c.wg, be);
    pg8::EpiSwiglu<true> E{(void*)(a.ws + WS_HIDM), 2 * FF / 256, 1.0f / 256.0f};
    pg8::gemm_phase8<pg8::EpiSwiglu<true>, pg8::MoeOrder, true, true>(c.lds + LDS_SCR, g, S, E);
}
__device__ __forceinline__ void gemm_moe2(const Ctx& c) {
    ARGS_REF a = *c.a; const int* meta = (const int*)(a.ws + WS_CTL + CTL_META);
    int be[8];
#pragma unroll
    for (int e = 0; e < 8; ++e) be[e] = __builtin_amdgcn_readfirstlane(meta[e]);
    pg8::Gemm g{(const bf16_t*)(a.ws + WS_HIDM), (const bf16_t*)(a.ws + WS_M2), MOE_ROWS, D, FF / 2};
    pg8::MoeOrder S; S.init(be[7], D / 256, c.G, c.wg, be);
    pg8::EpiPlainBf16 E{(bf16_t*)(a.ws + WS_GATH), D, D / 256, 1.0f / 256.0f};
    pg8::gemm_phase8<pg8::EpiPlainBf16, pg8::MoeOrder, true, true>(c.lds + LDS_SCR, g, S, E);
}

__device__ __forceinline__ void prologue_phase(const Ctx& c) {
    ARGS_REF a = *c.a; int rot = 0;
    mod_phase(c);
    rgw_convert(c);
    for (int l = 0; l < 2; ++l) {
        conv_job<1>(c, a.in[I_WIN] + (size_t)l * D * DIN, nullptr, DIN, D, NMIXP, (bf16_t*)(a.ws + WS_WIN + (size_t)l * WIN_BYTES), rot);
        conv_job8<0>(c, a.in[I_WIN] + (size_t)l * D * DIN + NMIX, nullptr, DIN, D, NGATE, (unsigned char*)(a.ws + WS_WG8 + (size_t)l * WG8_BYTES), 64.0f, rot);
        for (int b = 0; b < 4; ++b) conv_job<0>(c, a.in[I_WUP] + (size_t)(l * 4 + b) * 512 * D, nullptr, D, 512, D, (bf16_t*)(a.ws + WS_WUP + (size_t)l * 8388608 + (size_t)b * 2048 * 512 * 2), rot);
        conv_job<0>(c, a.in[I_WOUT] + (size_t)l * D * D, nullptr, D, D, D, (bf16_t*)(a.ws + WS_WOUT + (size_t)l * 8388608), rot);
    }
    conv_job8<2>(c, a.in[I_F1], a.in[I_F3], FF, D, 2 * FF, (unsigned char*)(a.ws + WS_F13), 64.0f, rot);
    conv_job<0>(c, a.in[I_F2], nullptr, D, FF, D, (bf16_t*)(a.ws + WS_F2), rot);
}
__device__ __forceinline__ void moeconv_phase(const Ctx& c) {
    ARGS_REF a = *c.a; int rot = 0;
    for (int e = 0; e < 8; ++e) {
        conv_job8<2>(c, a.in[I_M1] + (size_t)e * D * FF, a.in[I_M3] + (size_t)e * D * FF, FF, D, 2 * FF, (unsigned char*)(a.ws + WS_M13 + (size_t)e * 23068672), 64.0f, rot);
        conv_job8<0>(c, a.in[I_M2] + (size_t)e * FF * D, nullptr, D, FF, D, (unsigned char*)(a.ws + WS_M2 + (size_t)e * 11534336), 64.0f, rot);
    }
}

__global__ void __launch_bounds__(512, 2) fwd_kernel(Args args) {
    extern __shared__ __attribute__((aligned(16))) unsigned char lds_raw[];
    volatile LAS unsigned* misc = (volatile LAS unsigned*)((LAS unsigned char*)lds_raw + LDS_MISC);
    if (threadIdx.x < 16) misc[threadIdx.x] = 0u;
    __syncthreads();
    const int lo = args.ph_lo, hi = args.ph_hi;
    XcdBarrier bar; bar.bar = (unsigned*)(args.ws + WS_CTL + CTL_BAR); bar.x = 0; bar.st = misc;
    if (hi - lo > 1) bar = xcd_barrier_post((unsigned*)(args.ws + WS_CTL + CTL_BAR), misc);
#define IN(k) (lo <= (k) && (k) < hi)
#define MKCTX Ctx c; { int t_ = threadIdx.x; asm volatile("" : "+v"(t_)); { ArgsP kp_ = (ArgsP)__builtin_amdgcn_kernarg_segment_ptr(); asm volatile("" : "+s"(kp_)); c.a = kp_; } c.lds = (LAS unsigned char*)lds_raw; c.tid = t_; c.lane = t_ & 63; c.wave = __builtin_amdgcn_readfirstlane(t_ >> 6); c.wg = blockIdx.x; c.G = gridDim.x; }
#ifndef PROBE_MASK
#define PROBE_MASK 0u
#endif
#define REP(k, ...) if ((PROBE_MASK >> (k)) & 1u) { __syncthreads(); __VA_ARGS__; }
#define SEAM(k) do { if (IN(k) && IN((k) + 1)) xcd_barrier(bar); } while (0)
    if (IN(0)) { MKCTX prologue_phase(c); REP(0, prologue_phase(c)) } SEAM(0);
    if (IN(1)) { MKCTX norm_phase<0, 0>(c); REP(1, norm_phase<0, 0>(c)) } SEAM(1);
    if (IN(2)) { MKCTX gemm_projmix<0>(c); REP(2, gemm_projmix<0>(c)) } SEAM(2);
    if (IN(3)) { MKCTX intra_phase<0>(c); REP(3, intra_phase<0>(c)) } SEAM(3);
    if (IN(4)) { MKCTX chains_phase<0>(c); REP(4, chains_phase<0>(c)) } SEAM(4);
    if (IN(5)) { MKCTX combine_phase<0>(c); REP(5, combine_phase<0>(c)) } SEAM(5);
    if (IN(6)) { MKCTX gemm_upgate<0>(c); REP(6, gemm_upgate<0>(c)) } SEAM(6);
    if (IN(7)) { MKCTX gemm_wout<0>(c); } SEAM(7);
    if (IN(8)) { MKCTX norm_phase<0, 1>(c); REP(8, norm_phase<0, 1>(c)) } SEAM(8);
    if (IN(9)) { MKCTX gemm_ffn13(c); REP(9, gemm_ffn13(c)) } SEAM(9);
    if (IN(10)) { MKCTX gemm_ffn2(c); } SEAM(10);
    if (IN(11)) { MKCTX norm_phase<1, 0>(c); REP(11, norm_phase<1, 0>(c)) } SEAM(11);
    if (IN(12)) { MKCTX gemm_projmix<1>(c); REP(12, gemm_projmix<1>(c)) } SEAM(12);
    if (IN(13)) { MKCTX intra_phase<1>(c); REP(13, intra_phase<1>(c)) } SEAM(13);
    if (IN(14)) { MKCTX chains_phase<1>(c); REP(14, chains_phase<1>(c)) } SEAM(14);
    if (IN(15)) { MKCTX combine_phase<1>(c); REP(15, combine_phase<1>(c)) } SEAM(15);
    if (IN(16)) { MKCTX gemm_upgate<1>(c); REP(16, gemm_upgate<1>(c)) } SEAM(16);
    if (IN(17)) { MKCTX gemm_wout<1>(c); } SEAM(17);
    if (IN(18)) { MKCTX route1_phase(c); __syncthreads(); moeconv_phase(c); REP(18, route1_phase(c); __syncthreads(); moeconv_phase(c)) } SEAM(18);
    if (IN(19)) { MKCTX route2_phase(c); REP(19, route2_phase(c)) } SEAM(19);
    if (IN(20)) { MKCTX gemm_moe13(c); REP(20, gemm_moe13(c)) } SEAM(20);
    if (IN(21)) { MKCTX gemm_moe2(c); REP(21, gemm_moe2(c)) } SEAM(21);
    if (IN(22)) { MKCTX final_phase(c); }
#undef IN
#undef SEAM
}

extern "C" void kernel_launch(void* const* d_in, const int* in_sizes, int n_in, void* d_out, int out_size, void* d_ws, size_t ws_size, hipStream_t stream) {
    static int grid = 0;
    if (grid == 0) {
        if (n_in != N_IN || out_size != ML * D || ws_size < WS_END) { fprintf(stderr, "kernel_launch: unexpected shapes: n_in %d out %d ws %zu (need %zu)\n", n_in, out_size, ws_size, (size_t)WS_END); grid = -1; return; }
        int dev = 0, cus = 0;
        if (hipGetDevice(&dev) != hipSuccess || hipDeviceGetAttribute(&cus, hipDeviceAttributeMultiprocessorCount, dev) != hipSuccess) { grid = -1; return; }
        if (hipFuncSetAttribute((const void*)fwd_kernel, hipFuncAttributeMaxDynamicSharedMemorySize, LDS_BYTES) != hipSuccess) { fprintf(stderr, "kernel_launch: hipFuncSetAttribute failed\n"); grid = -1; return; }
        int per_cu = 0;
        if (hipOccupancyMaxActiveBlocksPerMultiprocessor(&per_cu, (const void*)fwd_kernel, 512, LDS_BYTES) != hipSuccess || per_cu < 1) { fprintf(stderr, "kernel_launch: occupancy query says %d\n", per_cu); }
        (void)hipGetLastError();
        grid = cus > 256 ? 256 : cus;
    }
    if (grid < 0) return;
    (void)hipMemsetAsync((char*)d_ws + WS_CTL, 0, CTL_BYTES, stream);
    Args a{};
    for (int i = 0; i < N_IN; ++i) a.in[i] = (const float*)d_in[i];
    a.out = (float*)d_out; a.ws = (unsigned char*)d_ws;
#if N_LAUNCHES == 1
    a.ph_lo = 0; a.ph_hi = N_PHASES;
    hipLaunchKernelGGL(fwd_kernel, dim3(grid), dim3(512), LDS_BYTES, stream, a);
#else
    for (int p = 0; p < N_PHASES; ++p) { a.ph_lo = p; a.ph_hi = p + 1; hipLaunchKernelGGL(fwd_kernel, dim3(grid), dim3(512), LDS_BYTES, stream, a); }
#endif
}
```

```cpp
#include <hip/hip_runtime.h>
#include <cstdio>
#include <cstdint>
#define N_LAUNCHES 1
namespace pg8 {
#define PG8_LAS __attribute__((address_space(3)))
typedef unsigned short bf16_t;
typedef short bf16x8 __attribute__((ext_vector_type(8)));
typedef float f32x4 __attribute__((ext_vector_type(4)));
typedef unsigned u32x4 __attribute__((ext_vector_type(4)));
constexpr int BM = 256, BK = 64, HALF = 128, HTB = HALF * BK * 2  , STAGE_BYTES = 8 * HTB, NXCD = 8, WGM = 4;

__host__ __device__ __forceinline__ int lds_byte(int r, int c) { const int st = (r >> 4) * 2 + (c >> 5), rr = r & 15, cc = c & 31, ob = rr * 64 + cc * 2; return st * 1024 + (ob ^ (((ob >> 9) & 1) << 5)); }
__host__ __device__ __forceinline__ void stage_rc(int b, int& R, int& C) { const int st = b / 1024, sb = b % 1024, swz = sb ^ (((sb >> 9) & 1) << 5); R = (st >> 1) * 16 + swz / 64; C = (st & 1) * 32 + (swz % 64) / 2; }
__host__ __device__ __forceinline__ int perm32(int rho) { const int n = rho >> 4, i = rho & 15; return 8 * (i >> 2) + 4 * n + (i & 3); }

struct Unit { int pm, pn; };
struct Gemm { const bf16_t* A; const bf16_t* Bt; int M, N, K; int ld = 0; };

struct StaticOrder {
    int nM, nN, nwg, G, c, wgm;
    __host__ __device__ void init(int M, int N, int G_, int c_, int wgm_ = WGM) { nM = M / BM; nN = N / BM; nwg = nM * nN; G = G_; c = c_; wgm = wgm_; }
    __host__ __device__ bool next(int i, Unit& u) const {
        const long L = (long)i * G + c; if (L >= nwg) return false;
        int wgid = (int)L; { const int q = nwg / NXCD, r = nwg % NXCD, xcd = wgid % NXCD, off = wgid / NXCD; wgid = (xcd < r ? xcd * (q + 1) : r * (q + 1) + (xcd - r) * q) + off; }
        const int nig = wgm * nN, gid = wgid / nig, fm = gid * wgm, gsz = (nM - fm) < wgm ? (nM - fm) : wgm;
        u.pm = fm + ((wgid % nig) % gsz); u.pn = (wgid % nig) / gsz; return true;
    }
    __device__ __forceinline__ void a_ready(const Unit&) const {}
    __device__ __forceinline__ void done(const Unit&) const {}
};
__device__ __forceinline__ unsigned cvt_pk_bf16(float lo, float hi) { unsigned r; asm volatile("v_cvt_pk_bf16_f32 %0, %1, %2" : "=v"(r) : "v"(lo), "v"(hi)); return r; }
typedef __bf16 bf16x2_t __attribute__((ext_vector_type(2)));
typedef float f32x2c_t __attribute__((ext_vector_type(2)));
__device__ __forceinline__ unsigned cvt_pk_bf16_safe(float lo, float hi) { const f32x2c_t v = {lo, hi}; return __builtin_bit_cast(unsigned, __builtin_convertvector(v, bf16x2_t)); }
template <class Epi, class = void> struct pg8_has_carry { static constexpr bool value = false; };
template <class Epi> struct pg8_has_carry<Epi, decltype((void)Epi::CARRY)> { static constexpr bool value = Epi::CARRY; };
template <class Epi> __device__ __forceinline__ bool pg8_carry(const Unit& nxt) { if constexpr (pg8_has_carry<Epi>::value) return Epi::carry(nxt); else return false; }
template <class Epi, class Sched, bool ALIGN_EPI = false, bool SP2 = false>
__device__ __forceinline__ void gemm_phase(PG8_LAS unsigned char* lds, const Gemm g, const Sched& S, const Epi& E) {
    int tid_ = threadIdx.x; asm volatile("" : "+v"(tid_));
    const int tid = tid_, wid = __builtin_amdgcn_readfirstlane(tid >> 6), lane = tid & 63, wr = wid >> 2, wc = wid & 3, fr = lane & 15, fq = lane >> 4;
    const int K = g.K, nt = K / BK, LD = g.ld ? g.ld : g.K;
    unsigned voffA[2], voffB[2];
#pragma unroll
    for (int i = 0; i < 2; ++i) { int R, C; stage_rc(tid * 16 + i * 8192, R, C); const int Rb = Epi::PERM ? ((R & ~31) + perm32(R & 31)) : R;
        voffA[i] = (unsigned)(R * LD + C) * 2u; voffB[i] = (unsigned)(Rb * LD + C) * 2u; }
    const size_t kstep = (size_t)(BK * 2);
    const size_t hstep = (size_t)HALF * LD * 2;
    const size_t tstep = 2 * hstep;
    const unsigned ldsw = (unsigned)wid * 1024u;
    const int aoff = lds_byte(wr * 64 + fr, fq * 8), boff = lds_byte(wc * 32 + fr, fq * 8);
#define PG8_SA(b, h) (((b) * 2 + (h)) * HTB)
#define PG8_SB(b, h) ((4 + (b) * 2 + (h)) * HTB)
#define PG8_STAGE(bufoff, gbase, voff) do { _Pragma("unroll") for (int _i = 0; _i < 2; ++_i) \
        __builtin_amdgcn_global_load_lds((const unsigned*)((const char*)(gbase) + (voff)[_i]), (PG8_LAS unsigned*)(lds + (bufoff) + ldsw + _i * 8192), 16, 0, 0); } while (0)
#define PG8_LDA(dst, b, h) do { _Pragma("unroll") for (int m = 0; m < 4; ++m) _Pragma("unroll") for (int k = 0; k < 2; ++k) dst[m][k] = *(const PG8_LAS bf16x8*)(lds + PG8_SA(b, h) + aoff + m * 2048 + k * 1024); } while (0)
#define PG8_LDB(dst, b, h) do { _Pragma("unroll") for (int n = 0; n < 2; ++n) _Pragma("unroll") for (int k = 0; k < 2; ++k) dst[n][k] = *(const PG8_LAS bf16x8*)(lds + PG8_SB(b, h) + boff + n * 2048 + k * 1024); } while (0)
#define PG8_MMA(ai, bj, At, Bt) do { __builtin_amdgcn_s_setprio(1); _Pragma("unroll") for (int m = 0; m < 4; ++m) _Pragma("unroll") for (int n = 0; n < 2; ++n) _Pragma("unroll") for (int k = 0; k < 2; ++k) \
        acc[ai][bj][m][n] = __builtin_amdgcn_mfma_f32_16x16x32_bf16(Bt[n][k], At[m][k], acc[ai][bj][m][n], 0, 0, 0); __builtin_amdgcn_s_setprio(0); } while (0)
#define PG8_WAIT_V(n) asm volatile("s_waitcnt vmcnt(" #n ")" ::: "memory")
#define PG8_WAIT_L(n) asm volatile("s_waitcnt lgkmcnt(" #n ")" ::: "memory")
#define PG8_BAR __builtin_amdgcn_s_barrier()
#define PG8_SCHED __builtin_amdgcn_sched_barrier(0)
    Unit cur, nxt; int ui = 0;
    if (!S.next(0, cur)) return;
    f32x4 acc[2][2][4][2];
#pragma unroll
    for (int a = 0; a < 2; ++a)
#pragma unroll
        for (int b = 0; b < 2; ++b)
#pragma unroll
            for (int m = 0; m < 4; ++m)
#pragma unroll
                for (int n = 0; n < 2; ++n) acc[a][b][m][n] = (f32x4){0.f, 0.f, 0.f, 0.f};
    bf16x8 At[4][2], B0[2][2], B1[2][2];
    const char* cA = (const char*)g.A + (size_t)cur.pm * tstep; const char* cB = (const char*)g.Bt + (size_t)cur.pn * tstep;
    S.a_ready(cur);
    if constexpr (SP2) {
        PG8_STAGE(PG8_SB(0, 0), cB, voffB); PG8_STAGE(PG8_SB(0, 1), cB + hstep, voffB); PG8_STAGE(PG8_SA(0, 0), cA, voffA); PG8_STAGE(PG8_SA(0, 1), cA + hstep, voffA);
        if (wr == 1) PG8_BAR;
        PG8_WAIT_V(2); PG8_BAR;
        PG8_STAGE(PG8_SB(1, 0), cB + kstep, voffB); PG8_STAGE(PG8_SA(1, 0), cA + kstep, voffA); PG8_STAGE(PG8_SB(1, 1), cB + hstep + kstep, voffB);
        PG8_WAIT_V(6); PG8_BAR;
    } else {
        PG8_STAGE(PG8_SB(0, 0), cB, voffB); PG8_STAGE(PG8_SA(0, 0), cA, voffA); PG8_STAGE(PG8_SB(0, 1), cB + hstep, voffB); PG8_STAGE(PG8_SA(0, 1), cA + hstep, voffA);
        if (wr == 1) PG8_BAR;
        PG8_WAIT_V(4); PG8_BAR;
        PG8_STAGE(PG8_SB(1, 0), cB + kstep, voffB); PG8_STAGE(PG8_SA(1, 0), cA + kstep, voffA); PG8_STAGE(PG8_SB(1, 1), cB + hstep + kstep, voffB);
        PG8_WAIT_V(6); PG8_BAR;
    }
    for (;;) {
        const bool has_next = S.next(ui + 1, nxt);
        const char* nA = has_next ? (const char*)g.A + (size_t)nxt.pm * tstep : cA; const char* nB = has_next ? (const char*)g.Bt + (size_t)nxt.pn * tstep : cB;
        for (int t = 0; t < nt; t += 2) {
            const bool last = (t == nt - 2);
            const char* a1 = cA + (size_t)(t + 1) * kstep;
            const char* a2 = last ? nA : cA + (size_t)(t + 2) * kstep; const char* b2 = last ? nB : cB + (size_t)(t + 2) * kstep;
            const char* a3 = a2 + kstep; const char* b3 = b2 + kstep;
            if (last && has_next) S.a_ready(nxt);
            if constexpr (SP2) {
            PG8_LDB(B0, 0, 0); PG8_LDB(B1, 0, 1); PG8_SCHED; PG8_LDA(At, 0, 0); PG8_STAGE(PG8_SA(1, 1), a1 + hstep, voffA);
            PG8_WAIT_V(8); PG8_WAIT_L(0); PG8_BAR; PG8_MMA(0, 0, At, B0); PG8_MMA(0, 1, At, B1); PG8_BAR; PG8_SCHED;
            PG8_LDA(At, 0, 1); PG8_STAGE(PG8_SB(0, 0), b2, voffB); PG8_STAGE(PG8_SB(0, 1), b2 + hstep, voffB); PG8_STAGE(PG8_SA(0, 0), a2, voffA);
            PG8_WAIT_V(8); PG8_WAIT_L(0); PG8_BAR; PG8_MMA(1, 0, At, B0); PG8_MMA(1, 1, At, B1); PG8_BAR; PG8_SCHED;
            PG8_LDB(B0, 1, 0); PG8_LDB(B1, 1, 1); PG8_SCHED; PG8_LDA(At, 1, 0); PG8_STAGE(PG8_SA(0, 1), a2 + hstep, voffA);
            PG8_WAIT_V(8); PG8_WAIT_L(0); PG8_BAR; PG8_MMA(0, 0, At, B0); PG8_MMA(0, 1, At, B1); PG8_BAR; PG8_SCHED;
            PG8_LDA(At, 1, 1); PG8_STAGE(PG8_SB(1, 0), b3, voffB); PG8_STAGE(PG8_SB(1, 1), b3 + hstep, voffB); PG8_STAGE(PG8_SA(1, 0), a3, voffA);
            PG8_WAIT_V(8); PG8_WAIT_L(0); PG8_BAR; PG8_MMA(1, 0, At, B0); PG8_MMA(1, 1, At, B1); PG8_BAR; PG8_SCHED;
            } else {
            PG8_LDB(B0, 0, 0); PG8_SCHED; PG8_LDA(At, 0, 0); PG8_STAGE(PG8_SA(1, 1), a1 + hstep, voffA);
            PG8_WAIT_L(8); PG8_BAR; PG8_WAIT_L(0); PG8_MMA(0, 0, At, B0); PG8_BAR; PG8_SCHED;
            PG8_LDB(B1, 0, 1); PG8_STAGE(PG8_SB(0, 0), b2, voffB);
            PG8_BAR; PG8_WAIT_L(0); PG8_MMA(0, 1, At, B1); PG8_BAR;
            PG8_LDA(At, 0, 1); PG8_STAGE(PG8_SA(0, 0), a2, voffA);
            PG8_BAR; PG8_WAIT_L(0); PG8_MMA(1, 0, At, B0); PG8_BAR; PG8_SCHED;
            PG8_STAGE(PG8_SB(0, 1), b2 + hstep, voffB);
            PG8_WAIT_V(6); PG8_BAR; PG8_MMA(1, 1, At, B1); PG8_BAR;
            PG8_LDB(B0, 1, 0); PG8_SCHED; PG8_LDA(At, 1, 0); PG8_STAGE(PG8_SA(0, 1), a2 + hstep, voffA);
            PG8_WAIT_L(8); PG8_BAR; PG8_WAIT_L(0); PG8_MMA(0, 0, At, B0); PG8_BAR; PG8_SCHED;
            PG8_LDB(B1, 1, 1); PG8_STAGE(PG8_SB(1, 0), b3, voffB);
            PG8_BAR; PG8_WAIT_L(0); PG8_MMA(0, 1, At, B1); PG8_BAR;
            PG8_LDA(At, 1, 1); PG8_STAGE(PG8_SA(1, 0), a3, voffA);
            PG8_BAR; PG8_WAIT_L(0); PG8_MMA(1, 0, At, B0); PG8_BAR; PG8_SCHED;
            PG8_STAGE(PG8_SB(1, 1), b3 + hstep, voffB);
            PG8_WAIT_V(6); PG8_BAR; PG8_MMA(1, 1, At, B1); PG8_BAR;
            }
        }
        if constexpr (ALIGN_EPI) { if (wr == 0) PG8_BAR; }
        if constexpr (!Epi::AFTER_DRAIN) { E(acc, cur, wr, wc, fr, fq); S.done(cur); }
        if (!has_next) break;
        if (!pg8_carry<Epi>(nxt)) {
#pragma unroll
        for (int a = 0; a < 2; ++a)
#pragma unroll
            for (int b = 0; b < 2; ++b)
#pragma unroll
                for (int m = 0; m < 4; ++m)
#pragma unroll
                    for (int n = 0; n < 2; ++n) acc[a][b][m][n] = (f32x4){0.f, 0.f, 0.f, 0.f};
        }
        cur = nxt; cA = nA; cB = nB; ++ui;
        if constexpr (ALIGN_EPI) { if (wr == 1) PG8_BAR; }
    }
    PG8_WAIT_V(0);
    if constexpr (!ALIGN_EPI) { if (wr == 0) PG8_BAR; }
    PG8_BAR;
    if constexpr (Epi::AFTER_DRAIN) { E.fused(acc, cur, wr, wc, fr, fq, lds, wid, lane); S.done(cur); }
#undef PG8_SA
#undef PG8_SB
#undef PG8_STAGE
#undef PG8_LDA
#undef PG8_LDB
#undef PG8_MMA
#undef PG8_WAIT_V
#undef PG8_WAIT_L
#undef PG8_BAR
#undef PG8_SCHED
}

typedef int i32x4 __attribute__((ext_vector_type(4)));
typedef int i32x8 __attribute__((ext_vector_type(8)));
template <class Epi, class Sched, bool ALIGN_EPI = false, bool SP2 = false>
__device__ __forceinline__ void gemm_phase8(PG8_LAS unsigned char* lds, const Gemm g, const Sched& S, const Epi& E) {
    int tid_ = threadIdx.x; asm volatile("" : "+v"(tid_));
    const int tid = tid_, wid = __builtin_amdgcn_readfirstlane(tid >> 6), lane = tid & 63, wr = wid >> 2, wc = wid & 3, fr = lane & 15, fq = lane >> 4;
    const int K = g.K, nt = K / BK, LD = g.ld ? g.ld : g.K;
    unsigned voffA[2], voffB[2];
#pragma unroll
    for (int i = 0; i < 2; ++i) { int R, C; stage_rc(tid * 16 + i * 8192, R, C); const int Rb = Epi::PERM ? ((R & ~31) + perm32(R & 31)) : R;
        voffA[i] = (unsigned)(R * LD + C) * 2u; voffB[i] = (unsigned)(Rb * LD + C) * 2u; }
    const size_t kstep = (size_t)(BK * 2);
    const size_t hstep = (size_t)HALF * LD * 2;
    const size_t tstep = 2 * hstep;
    const unsigned ldsw = (unsigned)wid * 1024u;
    const int aoff = lds_byte(wr * 64 + fr, fq * 8), boff = lds_byte(wc * 32 + fr, fq * 8);
#define PG8_SA(b, h) (((b) * 2 + (h)) * HTB)
#define PG8_SB(b, h) ((4 + (b) * 2 + (h)) * HTB)
#define PG8_STAGE(bufoff, gbase, voff) do { _Pragma("unroll") for (int _i = 0; _i < 2; ++_i) \
        __builtin_amdgcn_global_load_lds((const unsigned*)((const char*)(gbase) + (voff)[_i]), (PG8_LAS unsigned*)(lds + (bufoff) + ldsw + _i * 8192), 16, 0, 0); } while (0)
#define PG8_LD8(addr) __builtin_shufflevector(__builtin_bit_cast(i32x4, *(const PG8_LAS bf16x8*)(addr)), __builtin_bit_cast(i32x4, *(const PG8_LAS bf16x8*)((addr) + 1024)), 0, 1, 2, 3, 4, 5, 6, 7)
#define PG8_LDA(dst, b, h) do { _Pragma("unroll") for (int m = 0; m < 4; ++m) dst[m] = PG8_LD8(lds + PG8_SA(b, h) + aoff + m * 2048); } while (0)
#define PG8_LDB(dst, b, h) do { _Pragma("unroll") for (int n = 0; n < 2; ++n) dst[n] = PG8_LD8(lds + PG8_SB(b, h) + boff + n * 2048); } while (0)
#define PG8_MMA(ai, bj, At, Bt) do { __builtin_amdgcn_s_setprio(1); _Pragma("unroll") for (int m = 0; m < 4; ++m) _Pragma("unroll") for (int n = 0; n < 2; ++n) \
        asm volatile("v_mfma_f32_16x16x128_f8f6f4 %0, %1, %2, %0" : "+v"(acc[ai][bj][m][n]) : "v"(Bt[n]), "v"(At[m])); __builtin_amdgcn_s_setprio(0); } while (0)
#define PG8_WAIT_V(n) asm volatile("s_waitcnt vmcnt(" #n ")" ::: "memory")
#define PG8_WAIT_L(n) asm volatile("s_waitcnt lgkmcnt(" #n ")" ::: "memory")
#define PG8_BAR __builtin_amdgcn_s_barrier()
#define PG8_SCHED __builtin_amdgcn_sched_barrier(0)
    Unit cur, nxt; int ui = 0;
    if (!S.next(0, cur)) return;
    f32x4 acc[2][2][4][2];
#pragma unroll
    for (int a = 0; a < 2; ++a)
#pragma unroll
        for (int b = 0; b < 2; ++b)
#pragma unroll
            for (int m = 0; m < 4; ++m)
#pragma unroll
                for (int n = 0; n < 2; ++n) acc[a][b][m][n] = (f32x4){0.f, 0.f, 0.f, 0.f};
    i32x8 At[4], B0[2], B1[2];
    const char* cA = (const char*)g.A + (size_t)cur.pm * tstep; const char* cB = (const char*)g.Bt + (size_t)cur.pn * tstep;
    S.a_ready(cur);
    if constexpr (SP2) {
        PG8_STAGE(PG8_SB(0, 0), cB, voffB); PG8_STAGE(PG8_SB(0, 1), cB + hstep, voffB); PG8_STAGE(PG8_SA(0, 0), cA, voffA); PG8_STAGE(PG8_SA(0, 1), cA + hstep, voffA);
        if (wr == 1) PG8_BAR;
        PG8_WAIT_V(2); PG8_BAR;
        PG8_STAGE(PG8_SB(1, 0), cB + kstep, voffB); PG8_STAGE(PG8_SA(1, 0), cA + kstep, voffA); PG8_STAGE(PG8_SB(1, 1), cB + hstep + kstep, voffB);
        PG8_WAIT_V(6); PG8_BAR;
    } else {
        PG8_STAGE(PG8_SB(0, 0), cB, voffB); PG8_STAGE(PG8_SA(0, 0), cA, voffA); PG8_STAGE(PG8_SB(0, 1), cB + hstep, voffB); PG8_STAGE(PG8_SA(0, 1), cA + hstep, voffA);
        if (wr == 1) PG8_BAR;
        PG8_WAIT_V(4); PG8_BAR;
        PG8_STAGE(PG8_SB(1, 0), cB + kstep, voffB); PG8_STAGE(PG8_SA(1, 0), cA + kstep, voffA); PG8_STAGE(PG8_SB(1, 1), cB + hstep + kstep, voffB);
        PG8_WAIT_V(6); PG8_BAR;
    }
    for (;;) {
        const bool has_next = S.next(ui + 1, nxt);
        const char* nA = has_next ? (const char*)g.A + (size_t)nxt.pm * tstep : cA; const char* nB = has_next ? (const char*)g.Bt + (size_t)nxt.pn * tstep : cB;
        for (int t = 0; t < nt; t += 2) {
            const bool last = (t == nt - 2);
            const char* a1 = cA + (size_t)(t + 1) * kstep;
            const char* a2 = last ? nA : cA + (size_t)(t + 2) * kstep; const char* b2 = last ? nB : cB + (size_t)(t + 2) * kstep;
            const char* a3 = a2 + kstep; const char* b3 = b2 + kstep;
            if (last && has_next) S.a_ready(nxt);
            if constexpr (SP2) {
            PG8_LDB(B0, 0, 0); PG8_LDB(B1, 0, 1); PG8_SCHED; PG8_LDA(At, 0, 0); PG8_STAGE(PG8_SA(1, 1), a1 + hstep, voffA);
            PG8_WAIT_V(8); PG8_WAIT_L(0); PG8_BAR; PG8_MMA(0, 0, At, B0); PG8_MMA(0, 1, At, B1); PG8_BAR; PG8_SCHED;
            PG8_LDA(At, 0, 1); PG8_STAGE(PG8_SB(0, 0), b2, voffB); PG8_STAGE(PG8_SB(0, 1), b2 + hstep, voffB); PG8_STAGE(PG8_SA(0, 0), a2, voffA);
            PG8_WAIT_V(8); PG8_WAIT_L(0); PG8_BAR; PG8_MMA(1, 0, At, B0); PG8_MMA(1, 1, At, B1); PG8_BAR; PG8_SCHED;
            PG8_LDB(B0, 1, 0); PG8_LDB(B1, 1, 1); PG8_SCHED; PG8_LDA(At, 1, 0); PG8_STAGE(PG8_SA(0, 1), a2 + hstep, voffA);
            PG8_WAIT_V(8); PG8_WAIT_L(0); PG8_BAR; PG8_MMA(0, 0, At, B0); PG8_MMA(0, 1, At, B1); PG8_BAR; PG8_SCHED;
            PG8_LDA(At, 1, 1); PG8_STAGE(PG8_SB(1, 0), b3, voffB); PG8_STAGE(PG8_SB(1, 1), b3 + hstep, voffB); PG8_STAGE(PG8_SA(1, 0), a3, voffA);
            PG8_WAIT_V(8); PG8_WAIT_L(0); PG8_BAR; PG8_MMA(1, 0, At, B0); PG8_MMA(1, 1, At, B1); PG8_BAR; PG8_SCHED;
            } else {
            PG8_LDB(B0, 0, 0); PG8_SCHED; PG8_LDA(At, 0, 0); PG8_STAGE(PG8_SA(1, 1), a1 + hstep, voffA);
            PG8_WAIT_L(8); PG8_BAR; PG8_WAIT_L(0); PG8_MMA(0, 0, At, B0); PG8_BAR; PG8_SCHED;
            PG8_LDB(B1, 0, 1); PG8_STAGE(PG8_SB(0, 0), b2, voffB);
            PG8_BAR; PG8_WAIT_L(0); PG8_MMA(0, 1, At, B1); PG8_BAR;
            PG8_LDA(At, 0, 1); PG8_STAGE(PG8_SA(0, 0), a2, voffA);
            PG8_BAR; PG8_WAIT_L(0); PG8_MMA(1, 0, At, B0); PG8_BAR; PG8_SCHED;
            PG8_STAGE(PG8_SB(0, 1), b2 + hstep, voffB);
            PG8_WAIT_V(6); PG8_BAR; PG8_MMA(1, 1, At, B1); PG8_BAR;
            PG8_LDB(B0, 1, 0); PG8_SCHED; PG8_LDA(At, 1, 0); PG8_STAGE(PG8_SA(0, 1), a2 + hstep, voffA);
            PG8_WAIT_L(8); PG8_BAR; PG8_WAIT_L(0); PG8_MMA(0, 0, At, B0); PG8_BAR; PG8_SCHED;
            PG8_LDB(B1, 1, 1); PG8_STAGE(PG8_SB(1, 0), b3, voffB);
            PG8_BAR; PG8_WAIT_L(0); PG8_MMA(0, 1, At, B1); PG8_BAR;
            PG8_LDA(At, 1, 1); PG8_STAGE(PG8_SA(1, 0), a3, voffA);
            PG8_BAR; PG8_WAIT_L(0); PG8_MMA(1, 0, At, B0); PG8_BAR; PG8_SCHED;
            PG8_STAGE(PG8_SB(1, 1), b3 + hstep, voffB);
            PG8_WAIT_V(6); PG8_BAR; PG8_MMA(1, 1, At, B1); PG8_BAR;
            }
        }
        if constexpr (ALIGN_EPI) { if (wr == 0) PG8_BAR; }
        asm volatile("s_nop 15\n\ts_nop 15" ::: "memory");
        if constexpr (!Epi::AFTER_DRAIN) { E(acc, cur, wr, wc, fr, fq); S.done(cur); }
        if (!has_next) break;
#pragma unroll
        for (int a = 0; a < 2; ++a)
#pragma unroll
            for (int b = 0; b < 2; ++b)
#pragma unroll
                for (int m = 0; m < 4; ++m)
#pragma unroll
                    for (int n = 0; n < 2; ++n) acc[a][b][m][n] = (f32x4){0.f, 0.f, 0.f, 0.f};
        cur = nxt; cA = nA; cB = nB; ++ui;
        if constexpr (ALIGN_EPI) { if (wr == 1) PG8_BAR; }
    }
    PG8_WAIT_V(0);
    if constexpr (!ALIGN_EPI) { if (wr == 0) PG8_BAR; }
    PG8_BAR;
    if constexpr (Epi::AFTER_DRAIN) { E.fused(acc, cur, wr, wc, fr, fq, lds, wid, lane); S.done(cur); }
#undef PG8_SA
#undef PG8_SB
#undef PG8_STAGE
#undef PG8_LD8
#undef PG8_LDA
#undef PG8_LDB
#undef PG8_MMA
#undef PG8_WAIT_V
#undef PG8_WAIT_L
#undef PG8_BAR
#undef PG8_SCHED
}
}
#define XB_TMO      128
#define XB_XCNT(j)  (256  + 64 * (j))
#define XB_XSUB(j)  (1280 + 64 * (j))
#define XB_XGEN(j)  (2304 + 64 * (j))
#define XB_TOP      3328
#define XB_TOPGEN   3392
#define XCD_BAR_WORDS 3456
#define XB_SPIN_CAP (1u << 18)
#define LAS __attribute__((address_space(3)))

__device__ __forceinline__ unsigned xb_ld(unsigned* p)              { return __hip_atomic_load(p, __ATOMIC_RELAXED, __HIP_MEMORY_SCOPE_AGENT); }
__device__ __forceinline__ unsigned xb_add(unsigned* p, unsigned v) { return __hip_atomic_fetch_add(p, v, __ATOMIC_RELAXED, __HIP_MEMORY_SCOPE_AGENT); }
__device__ __forceinline__ unsigned xb_xcc_id() { return (unsigned)__builtin_amdgcn_s_getreg((3 << 11) | 20) & 0xFu; }
#define XB_SPIN(cond, bar) do { unsigned _sp = 0; while (cond) { __builtin_amdgcn_s_sleep(1); \
    if ((++_sp & 255u) == 0u) { if (xb_ld(&(bar)[XB_TMO])) break; if (_sp > XB_SPIN_CAP) { atomicAdd(&(bar)[XB_TMO], 1u); break; } } } } while (0)

struct XcdBarrier {
    unsigned* bar; unsigned x;
    volatile LAS unsigned* st;
};

__device__ __forceinline__ XcdBarrier xcd_barrier_post(unsigned* bar, volatile LAS unsigned* st) {
    XcdBarrier b; b.bar = bar; b.x = xb_xcc_id(); b.st = st;
    if (threadIdx.x == 0) (void)xb_add(&bar[XB_XCNT(b.x)], 1u);
    return b;
}
__device__ __forceinline__ void xcd_barrier_complete(unsigned* bar, unsigned x, unsigned& nloc, unsigned& nx) {
    const unsigned G = gridDim.x * gridDim.y * gridDim.z;
    unsigned sum, cnt, mine, sp = 0u;
    for (;;) {
        sum = 0u; cnt = 0u; mine = 0u;
#pragma unroll
        for (unsigned j = 0; j < 16; ++j) { const unsigned c = xb_ld(&bar[XB_XCNT(j)]); sum += c; cnt += (c > 0u) ? 1u : 0u; mine = (j == x) ? c : mine; }
        if (sum == G) break;
        __builtin_amdgcn_s_sleep(1);
        if ((++sp & 255u) == 0u) { if (xb_ld(&bar[XB_TMO])) break; if (sp > XB_SPIN_CAP) { atomicAdd(&bar[XB_TMO], 1u); break; } }
    }
    nloc = mine > 0u ? mine : 1u; nx = cnt > 0u ? cnt : 1u;
}

__device__ __forceinline__ void xcd_barrier(const XcdBarrier& b) {
    asm volatile("s_waitcnt vmcnt(0)" ::: "memory");
    __syncthreads();
    if (threadIdx.x == 0) {
        unsigned* bar = b.bar;
        __builtin_amdgcn_s_waitcnt(0);
        unsigned nloc = b.st[0], nx = b.st[1];
        if (nloc == 0u) { xcd_barrier_complete(bar, b.x, nloc, nx); b.st[0] = nloc; b.st[1] = nx; }
        const unsigned old = xb_add(&bar[XB_XSUB(b.x)], 1u);
        const unsigned gen = old / nloc;
        if (old + 1u == (gen + 1u) * nloc) {
            __builtin_amdgcn_fence(__ATOMIC_RELEASE, "agent");
            asm volatile("s_waitcnt vmcnt(0)" ::: "memory");
            const unsigned og = xb_add(&bar[XB_TOP], 1u);
            const unsigned tg = og / nx;
            if (og + 1u == (tg + 1u) * nx) xb_add(&bar[XB_TOPGEN], 1u);
            else XB_SPIN(xb_ld(&bar[XB_TOPGEN]) == tg, bar);
            __builtin_amdgcn_fence(__ATOMIC_ACQUIRE, "agent");
            xb_add(&bar[XB_XGEN(b.x)], 1u);
            asm volatile("s_waitcnt vmcnt(0)" ::: "memory");
        } else {
            XB_SPIN(xb_ld(&bar[XB_XGEN(b.x)]) == gen, bar);
            __builtin_amdgcn_fence(__ATOMIC_ACQUIRE, "agent");
            asm volatile("s_waitcnt vmcnt(0)" ::: "memory");
        }
    }
    __syncthreads();
}


typedef pg8::bf16_t bf16_t;
typedef pg8::f32x4 f32x4;
typedef pg8::u32x4 u32x4;
typedef unsigned u32x2 __attribute__((ext_vector_type(2)));

constexpr int D = 2048, NB = 2, T = 16384, CL = 256;
constexpr int ML = NB * T;
constexpr int MC = NB * CL;
constexpr int MT = ML + MC;
constexpr int NMIX = 7216, NMIXP = 7424, NGATE = 8192, NPROJ = NMIXP + NGATE;
constexpr int DIN = 15408;
constexpr int FF = 5632, NE = 8;
constexpr int MOE_ROWS = 67584;
constexpr int C_GLA_Q = 0, C_GLA_K = 256, C_GLA_V = 512, C_GLA_G = 1024, C_GLA_A = 1536;
constexpr int C_HG_Q = 1568, C_HG_F = 2080, C_HG_I = 3104, C_HG_G = 3616;
constexpr int C_DN_Q = 4128, C_DN_K = 4640, C_DN_V = 5152, C_DN_A = 5664, C_DN_B = 5672, C_DN_G = 5680;
constexpr int C_RG_X = 6192, C_RG_Y = 6704;
constexpr float EPS = 1e-6f;

enum { I_X = 0, I_C, I_CTX, I_CCTX, I_WMOD, I_BMOD, I_NORMW, I_FNORMW, I_WIN, I_WUP, I_WOUT, I_GLA_WA2, I_GLA_BA2, I_GLA_NW, I_HG_LB, I_HG_NW,
       I_DN_CW, I_DN_ALOG, I_DN_DTB, I_DN_NW, I_RG_CW, I_RG_CB, I_RG_WR, I_RG_BR, I_RG_WI, I_RG_BI, I_RG_LAM, I_F1, I_F3, I_F2, I_ROUTER, I_M1, I_M3, I_M2, N_IN };

constexpr size_t WS_CTL = 0, CTL_BYTES = 65536;
constexpr size_t CTL_BAR = 0, CTL_WGH = 16384, CTL_META = 24576;
constexpr size_t WS_MOD = WS_CTL + CTL_BYTES;
constexpr size_t WS_XC = WS_MOD + 294912;
constexpr size_t WS_TOPI = WS_XC + 4194304;
constexpr size_t WS_TOPW = WS_TOPI + 131072;
constexpr size_t WS_DEST = WS_TOPW + 262144;
constexpr size_t WIN_BYTES = (size_t)NMIXP * D * 2;
constexpr size_t WS_WIN = WS_DEST + 262144;
constexpr size_t WG8_BYTES = (size_t)NGATE * D;
constexpr size_t WS_WG8 = WS_WIN + 2 * WIN_BYTES;
constexpr size_t WS_WUP = WS_WG8 + 2 * WG8_BYTES;
constexpr size_t WS_WOUT = WS_WUP + 2 * 8388608;
constexpr size_t WS_F13 = WS_WOUT + 2 * 8388608;
constexpr size_t WS_F2 = WS_F13 + 46137344;
constexpr size_t WS_RGW = WS_F2 + 23068672;
constexpr size_t WS_H = WS_RGW + 1048576;
constexpr size_t WS_H8 = WS_H + 136314880;
constexpr size_t WS_BIG = WS_H8 + 68157440;
constexpr size_t WS_PMIX = WS_BIG;
constexpr size_t WS_PGATE = WS_BIG;
constexpr size_t WS_ORAW = WS_BIG + 545259520;
constexpr size_t WS_RGLA = WS_ORAW + 272629760;
constexpr size_t WS_RGU = WS_RGLA + 68157440;
constexpr size_t WS_RGTT = WS_RGU, WS_RGCARRY = WS_RGU + 4259840;
constexpr size_t WS_GC = WS_RGU + 8388608;
constexpr size_t WS_SCR = WS_GC + 136314880;
constexpr size_t SC_GLA_VT = 0, SC_GLA_QP = SC_GLA_VT + 34078720, SC_GLA_KT = SC_GLA_QP + 34078720, SC_GLA_A = SC_GLA_KT + 34078720, SC_GLA_LAM = SC_GLA_A + 34078720;
constexpr size_t SC_HG_VT = SC_GLA_LAM + 1064960, SC_HG_QP = SC_HG_VT + 34078720, SC_HG_KT = SC_HG_QP + 68157440, SC_HG_A = SC_HG_KT + 68157440, SC_HG_LAM = SC_HG_A + 34078720;
constexpr size_t SC_DN_QS = SC_HG_LAM + 2129920, SC_DN_KT = SC_DN_QS + 34078720, SC_DN_UT = SC_DN_KT + 34078720, SC_DN_WN = SC_DN_UT + 68157440, SC_DN_AQK = SC_DN_WN + 68157440, SC_DN_SC = SC_DN_AQK + 34078720;
constexpr size_t SC_END = SC_DN_SC + 4259840;
constexpr size_t WS_O = WS_SCR;
constexpr size_t WS_MACC = WS_SCR + 136314880;
constexpr size_t WS_MERGED = WS_MACC + 272629760;
constexpr size_t WS_PF = WS_BIG + 419430400;
constexpr size_t WS_PW = WS_RGLA;
constexpr size_t WS_PU = WS_RGLA + 33554432;
constexpr size_t WS_HID = WS_BIG;
constexpr size_t WS_M13 = WS_BIG;
constexpr size_t WS_M2 = WS_M13 + 369098752;
constexpr size_t WS_GATH = WS_M2 + 184549376;
constexpr size_t WS_HIDM = WS_GATH + 276824064;
constexpr size_t WS_PM2 = WS_HIDM + 402653184;
constexpr size_t WS_END_A = WS_HIDM + 761266176, WS_END_B = WS_SCR + SC_END;
constexpr size_t WS_END = WS_END_A > WS_END_B ? WS_END_A : WS_END_B;
static_assert(WS_MERGED + 136314880 <= WS_SCR + SC_END, "O, MACC, MERGED fit in the record region");
static_assert(WS_END <= 2041000000ull, "workspace budget");

constexpr int LDS_SCR = 0;
constexpr int LDS_AUX = 147456;
constexpr int LDS_MISC = 147456 + 8192;
constexpr int LDS_BYTES = 163840;

constexpr size_t CTL_PT = 32768;
#ifdef PROBE_T
#define PT_START(k) unsigned long long pt_##k = (threadIdx.x == 0) ? wall_clock64() : 0ull
#define PT_STOP(k, ws) do { if (threadIdx.x == 0) atomicAdd((unsigned long long*)((ws) + WS_CTL + CTL_PT) + (k), (unsigned long long)(wall_clock64() - pt_##k)); } while (0)
#else
#define PT_START(k)
#define PT_STOP(k, ws)
#endif
#ifndef PROBE_SUB
#define PROBE_SUB 0
#endif
struct Args { const float* in[N_IN]; float* out; unsigned char* ws; int ph_lo, ph_hi; };

__device__ __forceinline__ float bflo(unsigned w) { return __uint_as_float(w << 16); }
__device__ __forceinline__ float bfhi(unsigned w) { return __uint_as_float(w & 0xffff0000u); }
__device__ __forceinline__ void unpack8(const u32x4 w, float (&f)[8]) { f[0] = bflo(w.x); f[1] = bfhi(w.x); f[2] = bflo(w.y); f[3] = bfhi(w.y); f[4] = bflo(w.z); f[5] = bfhi(w.z); f[6] = bflo(w.w); f[7] = bfhi(w.w); }
typedef __bf16 bfx8_t __attribute__((ext_vector_type(8)));
typedef float f32x8 __attribute__((ext_vector_type(8)));
__device__ __forceinline__ u32x4 pack8(const float (&f)[8]) { f32x8 v;
#pragma unroll
    for (int j = 0; j < 8; ++j) v[j] = f[j];
    return __builtin_bit_cast(u32x4, __builtin_convertvector(v, bfx8_t)); }
__device__ __forceinline__ unsigned pk_fp8x4(float a, float b, float c, float d) {
    a = fminf(fmaxf(a, -448.f), 448.f); b = fminf(fmaxf(b, -448.f), 448.f); c = fminf(fmaxf(c, -448.f), 448.f); d = fminf(fmaxf(d, -448.f), 448.f);
    unsigned p = __builtin_amdgcn_cvt_pk_fp8_f32(a, b, 0, false); return __builtin_amdgcn_cvt_pk_fp8_f32(c, d, p, true); }
__device__ __forceinline__ float bf1(const bf16_t* p) { return __uint_as_float(((unsigned)*p) << 16); }
__device__ __forceinline__ float sigm(float x) { return __builtin_amdgcn_rcpf(1.0f + __expf(-x)); }
__device__ __forceinline__ float siluf(float x) { return x * __builtin_amdgcn_rcpf(1.0f + __expf(-x)); }
__device__ __forceinline__ float softplusf(float x) { return fmaxf(x, 0.f) + __logf(1.0f + __expf(-fabsf(x))); }
__device__ __forceinline__ float wave_sum(float v) { v += __shfl_xor(v, 32); v += __shfl_xor(v, 16); v += __shfl_xor(v, 8); v += __shfl_xor(v, 4); v += __shfl_xor(v, 2); v += __shfl_xor(v, 1); return v; }
__device__ __forceinline__ float gelu_tanh(float y) { const float u = 0.7978845608028654f * (y + 0.044715f * y * y * y); const float e = __expf(2.f * u); const float th = 1.f - 2.f * __builtin_amdgcn_rcpf(e + 1.f); return 0.5f * y * (1.f + th); }

namespace pg8 {
template <bool SIG> struct EpiBf16S {
    static constexpr bool PERM = true, AFTER_DRAIN = false;
    bf16_t* O; int ldc; float sc;
    __device__ __forceinline__ void operator()(const f32x4 (&acc)[2][2][4][2], const Unit& u, int wr, int wc, int fr, int fq) const {
        const int row0 = u.pm * BM + wr * 64 + fr, col0 = u.pn * BM + wc * 32 + 8 * fq;
#pragma unroll
        for (int ai = 0; ai < 2; ++ai)
#pragma unroll
            for (int m = 0; m < 4; ++m) { bf16_t* rowp = O + (size_t)(row0 + ai * HALF + m * 16) * ldc + col0;
#pragma unroll
                for (int bj = 0; bj < 2; ++bj) { f32x4 v0 = acc[ai][bj][m][0], v1 = acc[ai][bj][m][1];
                    if (SIG) {
#pragma unroll
                        for (int j = 0; j < 4; ++j) { v0[j] = sigm(v0[j] * sc); v1[j] = sigm(v1[j] * sc); } }
                    u32x4 w; w.x = cvt_pk_bf16_safe(v0[0], v0[1]); w.y = cvt_pk_bf16_safe(v0[2], v0[3]); w.z = cvt_pk_bf16_safe(v1[0], v1[1]); w.w = cvt_pk_bf16_safe(v1[2], v1[3]);
                    *(u32x4*)(rowp + bj * HALF) = w; } }
    }
};
struct EpiProjMix {
    static constexpr bool PERM = true, AFTER_DRAIN = false;
    bf16_t* pmix; bf16_t* gc;
    __device__ __forceinline__ void operator()(const f32x4 (&acc)[2][2][4][2], const Unit& u, int wr, int wc, int fr, int fq) const {
        const int row0 = u.pm * BM + wr * 64 + fr, col0 = u.pn * BM + wc * 32 + 8 * fq;
#pragma unroll
        for (int bj = 0; bj < 2; ++bj) { const int c = col0 + bj * HALF;
            int g = -1, off = 0;
            if (c >= C_GLA_G && c < C_GLA_G + 512) { g = 0; off = c - C_GLA_G; }
            else if (c >= C_HG_G && c < C_HG_G + 512) { g = 1; off = c - C_HG_G; }
            else if (c >= C_DN_G && c < C_DN_G + 512) { g = 2; off = c - C_DN_G; }
            else if (c >= C_RG_Y && c < C_RG_Y + 512) { g = 3; off = c - C_RG_Y; }
            bf16_t* base = g >= 0 ? gc + g * 512 + off : pmix + c; const size_t ld = g >= 0 ? 2048 : NMIXP;
#pragma unroll
            for (int ai = 0; ai < 2; ++ai)
#pragma unroll
                for (int m = 0; m < 4; ++m) { const f32x4 v0 = acc[ai][bj][m][0], v1 = acc[ai][bj][m][1];
                    u32x4 w; w.x = cvt_pk_bf16_safe(v0[0], v0[1]); w.y = cvt_pk_bf16_safe(v0[2], v0[3]); w.z = cvt_pk_bf16_safe(v1[0], v1[1]); w.w = cvt_pk_bf16_safe(v1[2], v1[3]);
                    *(u32x4*)(base + (size_t)(row0 + ai * HALF + m * 16) * ld) = w; } }
    }
};
struct EpiUpGate {
    static constexpr bool PERM = true, AFTER_DRAIN = false, CARRY = true;
    static __device__ __forceinline__ bool carry(const Unit& nxt) { return (nxt.pn >> 3) != 0; }
    const bf16_t* gate; bf16_t* merged; int nMtot;
    __device__ __forceinline__ void operator()(f32x4 (&acc)[2][2][4][2], const Unit& u, int wr, int wc, int fr, int fq) const {
        const int b = u.pn >> 3, pn = u.pn & 7, pm = u.pm - b * nMtot;
        const int row0 = pm * BM + wr * 64 + fr, col0 = pn * BM + wc * 32 + 8 * fq;
#pragma unroll
        for (int ai = 0; ai < 2; ++ai) {
            u32x4 gw[4][2], gn[4][2];
#pragma unroll
            for (int m = 0; m < 4; ++m) { const size_t r = (size_t)(row0 + ai * HALF + m * 16);
#pragma unroll
                for (int bj = 0; bj < 2; ++bj) { const int c = col0 + bj * HALF; gw[m][bj] = *(const u32x4*)(gate + r * NGATE + b * 2048 + c);
                    if (b < 3) gn[m][bj] = *(const u32x4*)(gate + r * NGATE + (b + 1) * 2048 + c); } }
#pragma unroll
            for (int m = 0; m < 4; ++m) { const size_t r = (size_t)(row0 + ai * HALF + m * 16);
#pragma unroll
                for (int bj = 0; bj < 2; ++bj) { const int c = col0 + bj * HALF; float g[8]; unpack8(gw[m][bj], g);
#pragma unroll
                    for (int j = 0; j < 8; ++j) g[j] = fmaxf(g[j], 1e-6f);
                    if (b < 3) { float h[8]; unpack8(gn[m][bj], h);
#pragma unroll
                        for (int j = 0; j < 8; ++j) g[j] *= __builtin_amdgcn_rcpf(fmaxf(h[j], 1e-6f)); }
                    f32x4 v0 = acc[ai][bj][m][0], v1 = acc[ai][bj][m][1];
#pragma unroll
                    for (int j = 0; j < 4; ++j) { v0[j] *= g[j]; v1[j] *= g[4 + j]; }
                    if (b < 3) { acc[ai][bj][m][0] = v0; acc[ai][bj][m][1] = v1; }
                    else { u32x4 w; w.x = cvt_pk_bf16_safe(v0[0], v0[1]); w.y = cvt_pk_bf16_safe(v0[2], v0[3]); w.z = cvt_pk_bf16_safe(v1[0], v1[1]); w.w = cvt_pk_bf16_safe(v1[2], v1[3]);
                        *(u32x4*)(merged + r * 2048 + c) = w; } } }
        }
    }
};
struct EpiGatePartial {
    static constexpr bool PERM = true, AFTER_DRAIN = false;
    const bf16_t* gate; float* P; int nMtot;
    __device__ __forceinline__ void operator()(const f32x4 (&acc)[2][2][4][2], const Unit& u, int wr, int wc, int fr, int fq) const {
        const int b = u.pn >> 3, pn = u.pn & 7, pm = u.pm - b * nMtot;
        const int row0 = pm * BM + wr * 64 + fr, col0 = pn * BM + wc * 32 + 8 * fq;
#pragma unroll
        for (int ai = 0; ai < 2; ++ai) {
            u32x4 gw[4][2];
#pragma unroll
            for (int m = 0; m < 4; ++m) { const size_t r = (size_t)(row0 + ai * HALF + m * 16);
#pragma unroll
                for (int bj = 0; bj < 2; ++bj) gw[m][bj] = *(const u32x4*)(gate + r * NGATE + b * 2048 + col0 + bj * HALF); }
#pragma unroll
            for (int m = 0; m < 4; ++m) { const int r = row0 + ai * HALF + m * 16;
#pragma unroll
                for (int bj = 0; bj < 2; ++bj) { float g[8]; unpack8(gw[m][bj], g);
                    f32x4 v0 = acc[ai][bj][m][0], v1 = acc[ai][bj][m][1];
#pragma unroll
                    for (int j = 0; j < 4; ++j) { v0[j] *= fmaxf(g[j], 1e-6f); v1[j] *= fmaxf(g[4 + j], 1e-6f); }
                    float* p = P + ((size_t)b * MC + (size_t)(r - ML)) * 2048 + col0 + bj * HALF; *(f32x4*)p = v0; *(f32x4*)(p + 4) = v1; } }
        }
    }
};
template <bool SRCF32> struct EpiResid {
    static constexpr bool PERM = true, AFTER_DRAIN = false;
    const void* src; bf16_t* dst; const float* modv;
    int permute; float sc = 1.0f;
    __device__ __forceinline__ void operator()(const f32x4 (&acc)[2][2][4][2], const Unit& u, int wr, int wc, int fr, int fq) const {
        const int row0 = u.pm * BM + wr * 64 + fr, col0 = u.pn * BM + wc * 32 + 8 * fq;
        const int rfirst = u.pm * BM, bb = rfirst >> 14; const float* mp = modv + bb * 12288;
        f32x4 mv[2][2];
#pragma unroll
        for (int bj = 0; bj < 2; ++bj)
#pragma unroll
            for (int n = 0; n < 2; ++n) mv[bj][n] = *(const f32x4*)(mp + col0 + bj * HALF + n * 4) * sc;
#define EPI_ROWOFF(r) ((size_t)(bb << 14) + (size_t)(permute ? ((((r) & 255) << 6) | (((r) & 16383) >> 8)) : ((r) & 16383)))
#pragma unroll
        for (int ai = 0; ai < 2; ++ai) {
            if constexpr (SRCF32) {
#pragma unroll
                for (int mh = 0; mh < 2; ++mh) {
                f32x4 sv[2][2][2];
#pragma unroll
                for (int m = 0; m < 2; ++m) { const int r = row0 + ai * HALF + (mh * 2 + m) * 16; const float* sp = (const float*)src + EPI_ROWOFF(r) * D + col0;
#pragma unroll
                    for (int bj = 0; bj < 2; ++bj)
#pragma unroll
                        for (int n = 0; n < 2; ++n) sv[m][bj][n] = *(const f32x4*)(sp + bj * HALF + n * 4); }
#pragma unroll
                for (int m = 0; m < 2; ++m) { const int r = row0 + ai * HALF + (mh * 2 + m) * 16; bf16_t* dp = dst + EPI_ROWOFF(r) * (2 * D) + col0;
#pragma unroll
                    for (int bj = 0; bj < 2; ++bj) { const f32x4 v0 = sv[m][bj][0] + mv[bj][0] * acc[ai][bj][mh * 2 + m][0], v1 = sv[m][bj][1] + mv[bj][1] * acc[ai][bj][mh * 2 + m][1];
                        u32x4 w; w.x = cvt_pk_bf16_safe(v0[0], v0[1]); w.y = cvt_pk_bf16_safe(v0[2], v0[3]); w.z = cvt_pk_bf16_safe(v1[0], v1[1]); w.w = cvt_pk_bf16_safe(v1[2], v1[3]);
                        *(u32x4*)(dp + bj * HALF) = w; } }
                }
            } else {
                u32x4 sw[4][2];
#pragma unroll
                for (int m = 0; m < 4; ++m) { const int r = row0 + ai * HALF + m * 16; const bf16_t* sp = (const bf16_t*)src + EPI_ROWOFF(r) * (2 * D) + col0;
#pragma unroll
                    for (int bj = 0; bj < 2; ++bj) sw[m][bj] = *(const u32x4*)(sp + bj * HALF); }
#pragma unroll
                for (int m = 0; m < 4; ++m) { const int r = row0 + ai * HALF + m * 16; bf16_t* dp = dst + EPI_ROWOFF(r) * (2 * D) + col0;
#pragma unroll
                    for (int bj = 0; bj < 2; ++bj) { const u32x4 s = sw[m][bj]; f32x4 v0, v1;
                        v0[0] = __uint_as_float(s.x << 16); v0[1] = __uint_as_float(s.x & 0xffff0000u); v0[2] = __uint_as_float(s.y << 16); v0[3] = __uint_as_float(s.y & 0xffff0000u);
                        v1[0] = __uint_as_float(s.z << 16); v1[1] = __uint_as_float(s.z & 0xffff0000u); v1[2] = __uint_as_float(s.w << 16); v1[3] = __uint_as_float(s.w & 0xffff0000u);
                        v0 += mv[bj][0] * acc[ai][bj][m][0]; v1 += mv[bj][1] * acc[ai][bj][m][1];
                        u32x4 w; w.x = cvt_pk_bf16_safe(v0[0], v0[1]); w.y = cvt_pk_bf16_safe(v0[2], v0[3]); w.z = cvt_pk_bf16_safe(v1[0], v1[1]); w.w = cvt_pk_bf16_safe(v1[2], v1[3]);
                        *(u32x4*)(dp + bj * HALF) = w; } }
            }
        }
#undef EPI_ROWOFF
    }
};
template <bool F8OUT> struct EpiSwiglu {
    static constexpr bool PERM = true, AFTER_DRAIN = false;
    void* hid; int nper; float sc;
    __device__ __forceinline__ void operator()(const f32x4 (&acc)[2][2][4][2], const Unit& u, int wr, int wc, int fr, int fq) const {
        const int pn = u.pn % nper; const int row0 = u.pm * BM + wr * 64 + fr, col0 = pn * HALF + wc * 32 + 8 * fq;
#pragma unroll
        for (int ai = 0; ai < 2; ++ai)
#pragma unroll
            for (int m = 0; m < 4; ++m) { const size_t eo = (size_t)(row0 + ai * HALF + m * 16) * FF + col0;
                float o[8];
#pragma unroll
                for (int n = 0; n < 2; ++n)
#pragma unroll
                    for (int j = 0; j < 4; ++j) { const float g = acc[ai][0][m][n][j] * sc, v = acc[ai][1][m][n][j] * sc; o[n * 4 + j] = siluf(g) * v; }
                if (F8OUT) { u32x2 w; w.x = pk_fp8x4(o[0] * 4.f, o[1] * 4.f, o[2] * 4.f, o[3] * 4.f); w.y = pk_fp8x4(o[4] * 4.f, o[5] * 4.f, o[6] * 4.f, o[7] * 4.f); *(u32x2*)((unsigned char*)hid + eo) = w; }
                else { u32x4 w; w.x = cvt_pk_bf16_safe(o[0], o[1]); w.y = cvt_pk_bf16_safe(o[2], o[3]); w.z = cvt_pk_bf16_safe(o[4], o[5]); w.w = cvt_pk_bf16_safe(o[6], o[7]); *(u32x4*)((bf16_t*)hid + eo) = w; } }
    }
};
struct EpiPlainBf16 {
    static constexpr bool PERM = true, AFTER_DRAIN = false;
    bf16_t* O; int ldc; int nper; float sc;
    __device__ __forceinline__ void operator()(const f32x4 (&acc)[2][2][4][2], const Unit& u, int wr, int wc, int fr, int fq) const {
        const int pn = u.pn % nper; const int row0 = u.pm * BM + wr * 64 + fr, col0 = pn * BM + wc * 32 + 8 * fq;
#pragma unroll
        for (int ai = 0; ai < 2; ++ai)
#pragma unroll
            for (int m = 0; m < 4; ++m) { bf16_t* rowp = O + (size_t)(row0 + ai * HALF + m * 16) * ldc + col0;
#pragma unroll
                for (int bj = 0; bj < 2; ++bj) { const f32x4 v0 = acc[ai][bj][m][0] * sc, v1 = acc[ai][bj][m][1] * sc;
                    u32x4 w; w.x = cvt_pk_bf16_safe(v0[0], v0[1]); w.y = cvt_pk_bf16_safe(v0[2], v0[3]); w.z = cvt_pk_bf16_safe(v1[0], v1[1]); w.w = cvt_pk_bf16_safe(v1[2], v1[3]);
                    *(u32x4*)(rowp + bj * HALF) = w; } }
    }
};
struct EpiPartial {
    static constexpr bool PERM = false, AFTER_DRAIN = false;
    float* P; int row_off; int nper = 1 << 20;
    __device__ __forceinline__ void operator()(const f32x4 (&acc)[2][2][4][2], const Unit& u, int wr, int wc, int fr, int fq) const {
        const int row0 = u.pm * BM + wr * 64 + fr - row_off, col0 = (u.pn % nper) * BM + wc * 32 + 4 * fq;
#pragma unroll
        for (int ai = 0; ai < 2; ++ai)
#pragma unroll
            for (int m = 0; m < 4; ++m) { float* rowp = P + (size_t)(row0 + ai * HALF + m * 16) * 2048 + col0;
#pragma unroll
                for (int bj = 0; bj < 2; ++bj)
#pragma unroll
                    for (int n = 0; n < 2; ++n) *(f32x4*)(rowp + bj * HALF + n * 16) = acc[ai][bj][m][n]; }
    }
};
struct OneUnit {
    Unit u; bool has;
    __device__ bool next(int i, Unit& o) const { if (i != 0 || !has) return false; o = u; return true; }
    __device__ __forceinline__ void a_ready(const Unit&) const {}
    __device__ __forceinline__ void done(const Unit&) const {}
};
struct UpGateOrder {
    StaticOrder so; int nMtot;
    __device__ void init(int M, int G, int c, int nMtot_, int wgm) { so.init(M, 2048, G, c, wgm); nMtot = nMtot_; }
    __device__ bool next(int i, Unit& u) const { Unit t; if (!so.next(i >> 2, t)) return false; const int b = i & 3; u.pm = b * nMtot + t.pm; u.pn = b * 8 + t.pn; return true; }
    __device__ __forceinline__ void a_ready(const Unit&) const {}
    __device__ __forceinline__ void done(const Unit&) const {}
};
struct MoeOrder {
    StaticOrder so; int be[8]; int nper;
    __device__ void init(int nused, int nper_, int G, int c, const int* be_, int wgm) { so.init(nused * BM, nper_ * BM, G, c, wgm); nper = nper_;
#pragma unroll
        for (int e = 0; e < 8; ++e) be[e] = be_[e]; }
    __device__ bool next(int i, Unit& u) const { Unit t; if (!so.next(i, t)) return false; int e = 0;
#pragma unroll
        for (int j = 0; j < 7; ++j) e += (t.pm >= be[j]) ? 1 : 0;
        u.pm = t.pm; u.pn = e * nper + t.pn; return true; }
    __device__ __forceinline__ void a_ready(const Unit&) const {}
    __device__ __forceinline__ void done(const Unit&) const {}
};
}

__device__ __forceinline__ int lds_add(volatile LAS int* p) { return __hip_atomic_fetch_add((LAS int*)p, 1, __ATOMIC_RELAXED, __HIP_MEMORY_SCOPE_WORKGROUP); }
typedef const __attribute__((address_space(4))) Args* ArgsP;
#define ARGS_REF const __attribute__((address_space(4))) Args&
struct Ctx { ArgsP a; LAS unsigned char* lds; int tid, lane, wave, wg, G; };

template <int KIND, bool F8>
__device__ __forceinline__ void conv_job_t(const Ctx& c, const float* src, const float* src2, size_t ldsrc, int K, int Nd, void* dstv, float wscale, int& rot) {
    constexpr int KT = F8 ? 256 : 128, NJ = KT / 32, PITCH = KT + 1;
    LAS float* tile = (LAS float*)(c.lds + LDS_SCR);
    const int nkt = K / KT, nnt = Nd / 64, ntile = nkt * nnt, tid = c.tid;
    const int nn4 = tid & 15, kk = tid >> 4;
    int t = (c.wg - rot) % c.G; if (t < 0) t += c.G;
    f32x4 v[NJ];
#define CONV_LOAD(tt) do { const int nt_ = (tt) % nnt, kt_ = (tt) / nnt, n0_ = nt_ * 64, k0_ = kt_ * KT; const float* s_ = src; int c0_ = n0_, nvalid_ = 64; \
        if (KIND == 1) { if (n0_ >= NMIX) nvalid_ = 0; else { nvalid_ = NMIX - n0_; nvalid_ = nvalid_ > 64 ? 64 : nvalid_; } } \
        if (KIND == 2) { const int which_ = (n0_ & 255) >> 7; c0_ = (n0_ >> 8) * 128 + (n0_ & 127); s_ = which_ ? src2 : src; } \
        const float* p_ = s_ + (size_t)(k0_ + kk) * ldsrc + c0_ + 4 * nn4; const bool ok_ = 4 * nn4 < nvalid_; \
        _Pragma("unroll") for (int j = 0; j < NJ; ++j) v[j] = ok_ ? *(const f32x4*)(p_ + (size_t)(32 * j) * ldsrc) : (f32x4){0.f, 0.f, 0.f, 0.f}; } while (0)
    if (t < ntile) CONV_LOAD(t);
    for (; t < ntile; t += c.G) {
#pragma unroll
        for (int j = 0; j < NJ; ++j)
#pragma unroll
            for (int q = 0; q < 4; ++q) tile[(4 * nn4 + q) * PITCH + kk + 32 * j] = v[j][q] * wscale;
        const int nt = t % nnt, kt = t / nnt, n0 = nt * 64, k0 = kt * KT;
        if (t + c.G < ntile) CONV_LOAD(t + c.G);
        __syncthreads();
        const int lane = tid & 63, w = tid >> 6;
#pragma unroll
        for (int p = 0; p < 8; ++p) { const int n = w + 8 * p;
            if (F8) { const LAS float* tp = tile + n * PITCH + 4 * lane; *(unsigned*)((unsigned char*)dstv + (size_t)(n0 + n) * K + k0 + 4 * lane) = pk_fp8x4(tp[0], tp[1], tp[2], tp[3]); }
            else { const LAS float* tp = tile + n * PITCH + 2 * lane; *(unsigned*)((bf16_t*)dstv + (size_t)(n0 + n) * K + k0 + 2 * lane) = pg8::cvt_pk_bf16_safe(tp[0], tp[1]); } }
        __syncthreads();
    }
#undef CONV_LOAD
    rot = (rot + ntile) % c.G;
}
template <int KIND>
__device__ __forceinline__ void conv_job(const Ctx& c, const float* src, const float* src2, size_t ldsrc, int K, int Nd, bf16_t* dst, int& rot) { conv_job_t<KIND, false>(c, src, src2, ldsrc, K, Nd, dst, 1.0f, rot); }
template <int KIND>
__device__ __forceinline__ void conv_job8(const Ctx& c, const float* src, const float* src2, size_t ldsrc, int K, int Nd, unsigned char* dst, float wscale, int& rot) { conv_job_t<KIND, true>(c, src, src2, ldsrc, K, Nd, dst, wscale, rot); }

__device__ __forceinline__ void mod_phase(const Ctx& c) {
    ARGS_REF a = *c.a; const int tid = c.tid;
    LAS float* s = (LAS float*)(c.lds + LDS_SCR);
    LAS float* red = s + 3 * 2048;
    for (int i = tid; i < 3 * 2048; i += 512) { const int r = i >> 11, k = i & 2047; const float cv = (r < 2) ? a.in[I_C][r * 2048 + k] : a.in[I_CCTX][k]; s[i] = siluf(cv); }
    __syncthreads();
    float* modv = (float*)(a.ws + WS_MOD);
    for (int task = c.wg; task < 192; task += c.G) {
        const int l = task / 96, cb = task % 96, cq = tid & 31, kg = tid >> 5;
        const float* w = a.in[I_WMOD] + (size_t)l * 2048 * 12288 + cb * 128 + cq * 4;
        f32x4 a0 = {0.f, 0.f, 0.f, 0.f}, a1 = a0, a2 = a0;
#pragma unroll 8
        for (int k = kg; k < 2048; k += 16) { const f32x4 wv = *(const f32x4*)(w + (size_t)k * 12288); a0 += s[k] * wv; a1 += s[2048 + k] * wv; a2 += s[4096 + k] * wv; }
#pragma unroll
        for (int j = 0; j < 4; ++j) { red[(kg * 3 + 0) * 128 + cq * 4 + j] = a0[j]; red[(kg * 3 + 1) * 128 + cq * 4 + j] = a1[j]; red[(kg * 3 + 2) * 128 + cq * 4 + j] = a2[j]; }
        __syncthreads();
        if (tid < 384) { const int r = tid >> 7, cc = tid & 127; float sum = 0.f;
#pragma unroll
            for (int g = 0; g < 16; ++g) sum += red[(g * 3 + r) * 128 + cc];
            modv[(size_t)(l * 3 + r) * 12288 + cb * 128 + cc] = sum + a.in[I_BMOD][l * 12288 + cb * 128 + cc]; }
        __syncthreads();
    }
}

__device__ __forceinline__ void modnorm_row(f32x4 (&v)[8], const float* nw, const float* shift, const float* scale, int lane) {
    float ss = 0.f;
#pragma unroll
    for (int j = 0; j < 8; ++j) ss += v[j][0] * v[j][0] + v[j][1] * v[j][1] + v[j][2] * v[j][2] + v[j][3] * v[j][3];
    ss = wave_sum(ss);
    const float rstd = __builtin_amdgcn_rsqf(ss * (1.0f / 2048.0f) + EPS);
#pragma unroll
    for (int j = 0; j < 8; ++j) { const int cc = (j * 64 + lane) * 4; const f32x4 w = *(const f32x4*)(nw + cc), sh = *(const f32x4*)(shift + cc), sc = *(const f32x4*)(scale + cc);
        v[j] = (v[j] * rstd * w) * (1.0f + sc) + sh; }
}
__device__ __forceinline__ void store_row_bf16(const f32x4 (&v)[8], bf16_t* hrow, int lane) {
#pragma unroll
    for (int j = 0; j < 8; ++j) { u32x2 w; w.x = pg8::cvt_pk_bf16_safe(v[j][0], v[j][1]); w.y = pg8::cvt_pk_bf16_safe(v[j][2], v[j][3]); *(u32x2*)(hrow + (j * 64 + lane) * 4) = w; }
}
__device__ __forceinline__ void load_xres(f32x4 (&v)[8], const bf16_t* p, int lane) {
#pragma unroll
    for (int j = 0; j < 8; ++j) { const u32x2 w = *(const u32x2*)(p + (j * 64 + lane) * 4); v[j][0] = bflo(w.x); v[j][1] = bfhi(w.x); v[j][2] = bflo(w.y); v[j][3] = bfhi(w.y); }
}
#ifndef FFN2_FP8
#define FFN2_FP8 1
#endif
#define PF_SCALE (FFN2_FP8 ? (1.0f / 256.0f) : 1.0f)
template <int L, int WHICH>
__device__ __forceinline__ void norm_finish(const Ctx& c, f32x4 (&v)[8], int mr, size_t hrow) {
    ARGS_REF a = *c.a; const int lane = c.lane;
    const float* modv = (const float*)(a.ws + WS_MOD) + (size_t)L * 3 * 12288 + (WHICH ? 3 : 0) * 2048;
    const float* normw = a.in[I_NORMW] + (L * 2 + WHICH) * 2048;
    bf16_t* H = (bf16_t*)(a.ws + WS_H);
    const float* shift = modv + (size_t)mr * 12288;
    modnorm_row(v, normw, shift, shift + 2048, lane);
#ifndef FFN13_FP8
#define FFN13_FP8 1
#endif
    if (!(FFN13_FP8 && L == 0 && WHICH == 1)) store_row_bf16(v, H + hrow * D, lane);
    if (WHICH == 0 || L == 0) { unsigned char* h8 = (unsigned char*)(a.ws + WS_H8) + hrow * D;
#pragma unroll
        for (int j = 0; j < 8; ++j) *(unsigned*)(h8 + (j * 64 + lane) * 4) = pk_fp8x4(v[j][0] * 4.f, v[j][1] * 4.f, v[j][2] * 4.f, v[j][3] * 4.f); }
}
template <int L, int WHICH>
__device__ __forceinline__ void norm_phase(const Ctx& c) {
    ARGS_REF a = *c.a; const int gw = c.wg * 8 + c.wave, nw = c.G * 8, lane = c.lane;
#pragma unroll 1
    for (int r = gw; r < ML; r += nw) {
        const int b = r >> 14, t = r & 16383; const size_t hrow = (L == 1 && WHICH == 0) ? (size_t)(b << 14) + ((t & 63) << 8) + (t >> 6) : (size_t)r;
        f32x4 v[8];
        if (L == 0 && WHICH == 0) { const float* src = a.in[I_X] + (size_t)r * D;
#pragma unroll
            for (int j = 0; j < 8; ++j) v[j] = *(const f32x4*)(src + (j * 64 + lane) * 4); }
        else load_xres(v, (const bf16_t*)(a.out + (size_t)r * D), lane);
        norm_finish<L, WHICH>(c, v, b, hrow);
    }
#pragma unroll 1
    for (int rc = gw; rc < MC; rc += nw) {
        int lane = c.lane; asm volatile("" : "+v"(lane));
        const float* src = ((L == 0 && WHICH == 0) ? a.in[I_CTX] : (const float*)(a.ws + WS_XC)) + (size_t)rc * D;
        f32x4 v[8];
#pragma unroll
        for (int j = 0; j < 8; ++j) v[j] = *(const f32x4*)(src + (j * 64 + lane) * 4);
        if (L == 0 && WHICH == 1) {
            const float* pw = (const float*)(a.ws + WS_PW) + (size_t)rc * D; const float* g2 = (const float*)(a.ws + WS_MOD) + (size_t)(0 * 3 + 2) * 12288 + 2 * 2048;
            const float* cin = a.in[I_CTX] + (size_t)rc * D; float* xcw = (float*)(a.ws + WS_XC) + (size_t)rc * D;
#pragma unroll
            for (int j = 0; j < 8; ++j) { const int cc = (j * 64 + lane) * 4; f32x4 sum = *(const f32x4*)(pw + cc);
#pragma unroll
                for (int ks = 1; ks < 8; ++ks) sum += *(const f32x4*)(pw + (size_t)ks * MC * D + cc);
                v[j] = *(const f32x4*)(cin + cc) + *(const f32x4*)(g2 + cc) * sum; *(f32x4*)(xcw + cc) = v[j];
                if (j & 1) __builtin_amdgcn_sched_barrier(0); } }
        if (L == 1 && WHICH == 0) {
            const float* pf = (const float*)(a.ws + WS_PF) + (size_t)rc * D; const float* g5 = (const float*)(a.ws + WS_MOD) + (size_t)(0 * 3 + 2) * 12288 + 5 * 2048;
#pragma unroll
            for (int j = 0; j < 8; ++j) { const int cc = (j * 64 + lane) * 4; f32x4 sum = *(const f32x4*)(pf + cc);
#pragma unroll
                for (int ks = 1; ks < 11; ++ks) sum += *(const f32x4*)(pf + (size_t)ks * MC * D + cc);
                v[j] += *(const f32x4*)(g5 + cc) * sum * PF_SCALE;
                if (j & 1) __builtin_amdgcn_sched_barrier(0); } }
        norm_finish<L, WHICH>(c, v, 2, (size_t)(ML + rc));
    }
}

template <int L>
__device__ __forceinline__ void rgprep_item(const Ctx& c, int item) {
    ARGS_REF a = *c.a; const int tid = c.tid;
    LAS float* xbT = (LAS float*)(c.lds + LDS_SCR);
    const bf16_t* PM = (const bf16_t*)(a.ws + WS_PMIX);
    bf16_t* RGLA = (bf16_t*)(a.ws + WS_RGLA); bf16_t* RGU = (bf16_t*)(a.ws + WS_RGU);
    const float* cw = a.in[I_RG_CW] + L * 4 * 512; const float* cb = a.in[I_RG_CB] + L * 512;
    {
        const int tt = item >> 2, n = item & 3;
        size_t rowbase; int t0, Ls;
        if (tt < 512) { const int b = tt >> 8; rowbase = (size_t)b * T; t0 = (tt & 255) * 64; Ls = T; }
        else { const int tc = tt - 512, b = tc >> 2; rowbase = (size_t)ML + b * CL; t0 = (tc & 3) * 64; Ls = CL; }
        __syncthreads();
        {
            const int tl = tid >> 3, cg = tid & 7, ch0 = n * 128 + cg * 16;
            float acc[16];
#pragma unroll
            for (int j = 0; j < 16; ++j) acc[j] = cb[ch0 + j];
#pragma unroll
            for (int tap = 0; tap < 4; ++tap) { const int ts = t0 + tl + tap - 2;
                if (ts >= 0 && ts < Ls) { const bf16_t* rp = PM + (rowbase + ts) * NMIXP + C_RG_X + ch0; const u32x4 w0 = *(const u32x4*)rp, w1 = *(const u32x4*)(rp + 8);
                    float f[8], g[8]; unpack8(w0, f); unpack8(w1, g);
#pragma unroll
                    for (int j = 0; j < 8; ++j) { acc[j] += cw[tap * 512 + ch0 + j] * f[j]; acc[8 + j] += cw[tap * 512 + ch0 + 8 + j] * g[j]; } } }
#pragma unroll
            for (int j = 0; j < 16; ++j) xbT[(cg * 16 + j) * 68 + tl] = acc[j];
        }
        __syncthreads();
        const int oc = tid & 127, tg = tid >> 7, ch = n * 128 + oc;
#pragma unroll 1
        for (int d = 0; d < 2; ++d) {
            const float* wr = a.in[I_RG_WR] + ((size_t)((L * 2 + d) * 4 + n) * 128) * 128 + oc;
            const float* wi = a.in[I_RG_WI] + ((size_t)((L * 2 + d) * 4 + n) * 128) * 128 + oc;
            float ar[16], ai[16];
#pragma unroll
            for (int j = 0; j < 16; ++j) { ar[j] = 0.f; ai[j] = 0.f; }
#pragma unroll 4
            for (int k = 0; k < 128; ++k) { const float w1 = wr[k * 128], w2 = wi[k * 128];
                const LAS f32x4* xp = (const LAS f32x4*)(xbT + k * 68 + tg * 16);
#pragma unroll
                for (int q = 0; q < 4; ++q) { const f32x4 xv = xp[q];
#pragma unroll
                    for (int j = 0; j < 4; ++j) { ar[q * 4 + j] += xv[j] * w1; ai[q * 4 + j] += xv[j] * w2; } } }
            const float br = a.in[I_RG_BR][(L * 2 + d) * 512 + ch], bi = a.in[I_RG_BI][(L * 2 + d) * 512 + ch];
            const float sp = softplusf(-a.in[I_RG_LAM][(L * 2 + d) * 512 + ch]);
#pragma unroll
            for (int j = 0; j < 16; ++j) { const int tl = tg * 16 + j; const float r = sigm(ar[j] + br), ig = sigm(ai[j] + bi);
                const float la = -8.0f * r * sp; const float xb = xbT[oc * 68 + tl];
                const float u = sqrtf(fmaxf(-expm1f(2.0f * la), 0.f)) * (ig * xb);
                const size_t o = ((size_t)d * MT + rowbase + t0 + tl) * 512 + ch;
                RGLA[o] = (bf16_t)(pg8::cvt_pk_bf16_safe(la, 0.f) & 0xffffu); RGU[o] = (bf16_t)(pg8::cvt_pk_bf16_safe(u, 0.f) & 0xffffu); }
        }
    }
}

template <int L>
__device__ __forceinline__ void chain_gla(const Ctx& c, int b, int h, int d, int vh) {
    ARGS_REF a = *c.a; const int tid = c.tid;
    LAS float* qs = (LAS float*)(c.lds + LDS_SCR); LAS float* ks = qs + 4096; LAS float* fs = ks + 4096; LAS float* vs = fs + 4096; LAS float* os = vs + 4096;
    LAS float* wa = (LAS float*)(c.lds + LDS_AUX);
    const bf16_t* PM = (const bf16_t*)(a.ws + WS_PMIX);
    bf16_t* ORAW = (bf16_t*)(a.ws + WS_ORAW) + (size_t)d * MT * 2048;
    for (int i = tid; i < 1024; i += 512) wa[i] = a.in[I_GLA_WA2][((L * 2 + d) * 16 + (i >> 6)) * 256 + h * 64 + (i & 63)];
    if (tid < 64) wa[1024 + tid] = a.in[I_GLA_BA2][(L * 2 + d) * 256 + h * 64 + tid];
    float s[8];
#pragma unroll
    for (int j = 0; j < 8; ++j) s[j] = 0.f;
    const int vc = tid >> 3, kq = tid & 7;
#pragma unroll 1
    for (int seg = 0; seg < 2; ++seg) {
        const int Ls = seg ? T : CL; const size_t rowbase = seg ? (size_t)b * T : (size_t)ML + b * CL;
#pragma unroll 1
        for (int jb = 0; jb < Ls / 64; ++jb) {
            const int r0 = d ? Ls - 64 * (jb + 1) : 64 * jb;
            __syncthreads();
            {   const int i = tid >> 3, cg = tid & 7, lr = d ? 63 - i : i; const bf16_t* rp = PM + (rowbase + r0 + lr) * NMIXP;
                float fq[8], fk[8], fv[8], fa[16];
                { const u32x4 w = *(const u32x4*)(rp + C_GLA_Q + h * 64 + cg * 8); unpack8(w, fq); }
                { const u32x4 w = *(const u32x4*)(rp + C_GLA_K + h * 64 + cg * 8); unpack8(w, fk); }
                { const u32x4 w = *(const u32x4*)(rp + C_GLA_V + h * 128 + vh * 64 + cg * 8); unpack8(w, fv); }
                { const u32x4 w0 = *(const u32x4*)(rp + C_GLA_A + d * 16), w1 = *(const u32x4*)(rp + C_GLA_A + d * 16 + 8); float t0[8], t1[8]; unpack8(w0, t0); unpack8(w1, t1);
#pragma unroll
                  for (int j = 0; j < 8; ++j) { fa[j] = t0[j]; fa[8 + j] = t1[j]; } }
#pragma unroll
                for (int j = 0; j < 8; ++j) { const int o = i * 64 + cg * 8 + j; qs[o] = fq[j] * 0.125f; ks[o] = fk[j]; vs[o] = fv[j];
                    float z = wa[1024 + cg * 8 + j];
#pragma unroll
                    for (int r = 0; r < 16; ++r) z += fa[r] * wa[r * 64 + cg * 8 + j];
                    fs[o] = __expf(-softplusf(-z) * (1.0f / 16.0f)); }
            }
            __syncthreads();
#pragma unroll 2
            for (int i = 0; i < 64; ++i) {
                const f32x4 f0 = *(const LAS f32x4*)(fs + i * 64 + kq * 8), f1 = *(const LAS f32x4*)(fs + i * 64 + kq * 8 + 4);
                const f32x4 k0 = *(const LAS f32x4*)(ks + i * 64 + kq * 8), k1 = *(const LAS f32x4*)(ks + i * 64 + kq * 8 + 4);
                const f32x4 q0 = *(const LAS f32x4*)(qs + i * 64 + kq * 8), q1 = *(const LAS f32x4*)(qs + i * 64 + kq * 8 + 4);
                const float vv = vs[i * 64 + vc]; float po = 0.f;
#pragma unroll
                for (int j = 0; j < 4; ++j) { s[j] = f0[j] * s[j] + k0[j] * vv; s[4 + j] = f1[j] * s[4 + j] + k1[j] * vv; po += s[j] * q0[j] + s[4 + j] * q1[j]; }
                po += __shfl_xor(po, 1); po += __shfl_xor(po, 2); po += __shfl_xor(po, 4);
                if (kq == 0) os[i * 64 + vc] = po;
            }
            __syncthreads();
            {   const int i = tid >> 3, cg = tid & 7, lr = d ? 63 - i : i; float o[8];
#pragma unroll
                for (int j = 0; j < 8; ++j) o[j] = os[i * 64 + cg * 8 + j];
                *(u32x4*)(ORAW + (rowbase + r0 + lr) * 2048 + 0 * 512 + h * 128 + vh * 64 + cg * 8) = pack8(o); }
        }
    }
}
template <int L>
__device__ __forceinline__ void chain_hg(const Ctx& c, int b, int h, int d, int vh) {
    ARGS_REF a = *c.a; const int tid = c.tid;
    LAS float* qs = (LAS float*)(c.lds + LDS_SCR); LAS float* ks = qs + 8192; LAS float* fs = ks + 8192; LAS float* vs = fs + 8192; LAS float* os = vs + 4096;
    LAS float* lbs = (LAS float*)(c.lds + LDS_AUX);
    const bf16_t* PM = (const bf16_t*)(a.ws + WS_PMIX);
    bf16_t* ORAW = (bf16_t*)(a.ws + WS_ORAW) + (size_t)d * MT * 2048;
    if (tid < 128) { float lb = 0.f; if (L == 1) { const float l0 = a.in[I_HG_LB][h * 128 + tid], l1 = a.in[I_HG_LB][512 + h * 128 + tid]; lb = __builtin_amdgcn_rcpf(1.0f + __expf(l0 - l1)); } lbs[tid] = lb; }
    float s[16];
#pragma unroll
    for (int j = 0; j < 16; ++j) s[j] = 0.f;
    const int vc = tid >> 3, kq = tid & 7;
#pragma unroll 1
    for (int seg = 0; seg < 2; ++seg) {
        const int Ls = seg ? T : CL; const size_t rowbase = seg ? (size_t)b * T : (size_t)ML + b * CL;
#pragma unroll 1
        for (int jb = 0; jb < Ls / 64; ++jb) {
            const int r0 = d ? Ls - 64 * (jb + 1) : 64 * jb;
            __syncthreads();
            {   const int i = tid >> 3, cg = tid & 7, lr = d ? 63 - i : i; const bf16_t* rp = PM + (rowbase + r0 + lr) * NMIXP;
#pragma unroll
                for (int hf = 0; hf < 2; ++hf) { const int ch = cg * 16 + hf * 8; float fq[8], fz[8];
                    { const u32x4 w = *(const u32x4*)(rp + C_HG_Q + h * 128 + ch); unpack8(w, fq); }
                    { const u32x4 w = *(const u32x4*)(rp + C_HG_F + d * 512 + h * 128 + ch); unpack8(w, fz); }
#pragma unroll
                    for (int j = 0; j < 8; ++j) { const int o = i * 128 + ch + j; const float lb = lbs[ch + j], sg = sigm(fz[j]);
                        qs[o] = siluf(fq[j]) * 0.08838834764831845f; fs[o] = fmaxf(lb + (1.0f - lb) * sg, 1e-30f); ks[o] = (1.0f - lb) * (1.0f - sg); } }
                float fv[8]; { const u32x4 w = *(const u32x4*)(rp + C_HG_I + h * 128 + vh * 64 + cg * 8); unpack8(w, fv); }
#pragma unroll
                for (int j = 0; j < 8; ++j) vs[i * 64 + cg * 8 + j] = fv[j];
            }
            __syncthreads();
#pragma unroll 2
            for (int i = 0; i < 64; ++i) {
                const float vv = vs[i * 64 + vc]; float po = 0.f;
#pragma unroll
                for (int q4 = 0; q4 < 4; ++q4) {
                    const f32x4 f0 = *(const LAS f32x4*)(fs + i * 128 + kq * 16 + q4 * 4), k0 = *(const LAS f32x4*)(ks + i * 128 + kq * 16 + q4 * 4), q0 = *(const LAS f32x4*)(qs + i * 128 + kq * 16 + q4 * 4);
#pragma unroll
                    for (int j = 0; j < 4; ++j) { s[q4 * 4 + j] = f0[j] * s[q4 * 4 + j] + k0[j] * vv; po += s[q4 * 4 + j] * q0[j]; } }
                po += __shfl_xor(po, 1); po += __shfl_xor(po, 2); po += __shfl_xor(po, 4);
                if (kq == 0) os[i * 64 + vc] = po;
            }
            __syncthreads();
            {   const int i = tid >> 3, cg = tid & 7, lr = d ? 63 - i : i; float o[8];
#pragma unroll
                for (int j = 0; j < 8; ++j) o[j] = os[i * 64 + cg * 8 + j];
                *(u32x4*)(ORAW + (rowbase + r0 + lr) * 2048 + 1 * 512 + h * 128 + vh * 64 + cg * 8) = pack8(o); }
        }
    }
}
template <int L>
__device__ __forceinline__ void chain_dn(const Ctx& c, int b, int h, int d, int vh) {
    ARGS_REF a = *c.a; const int tid = c.tid;
    LAS float* qs = (LAS float*)(c.lds + LDS_SCR); LAS float* ks = qs + 8192; LAS float* vs = ks + 8192; LAS float* os = vs + 4096; LAS float* as = os + 4096; LAS float* bs = as + 64;
    LAS float* cwl = (LAS float*)(c.lds + LDS_AUX);
    const bf16_t* PM = (const bf16_t*)(a.ws + WS_PMIX);
    bf16_t* ORAW = (bf16_t*)(a.ws + WS_ORAW) + (size_t)d * MT * 2048;
    for (int i = tid; i < 4 * 320; i += 512) { const int tap = i / 320, cc = i % 320; const int ch = cc < 128 ? h * 128 + cc : (cc < 256 ? 512 + h * 128 + (cc - 128) : 1024 + h * 128 + vh * 64 + (cc - 256));
        cwl[i] = a.in[I_DN_CW][(L * 4 + tap) * 1536 + ch]; }
    const float neg_ea = -expf(a.in[I_DN_ALOG][(L * 2 + d) * 4 + h]), dtb = a.in[I_DN_DTB][(L * 2 + d) * 4 + h];
    float s[16];
#pragma unroll
    for (int j = 0; j < 16; ++j) s[j] = 0.f;
    const int vc = tid >> 3, kq = tid & 7;
#pragma unroll 1
    for (int seg = 0; seg < 2; ++seg) {
        const int Ls = seg ? T : CL; const size_t rowbase = seg ? (size_t)b * T : (size_t)ML + b * CL;
#pragma unroll 1
        for (int jb = 0; jb < Ls / 64; ++jb) {
            const int r0 = d ? Ls - 64 * (jb + 1) : 64 * jb;
            __syncthreads();
            {   const int i = tid >> 3, cg = tid & 7, lr = d ? 63 - i : i, t = r0 + lr;
                float aq[16], ak[16], av[8];
#pragma unroll
                for (int j = 0; j < 16; ++j) { aq[j] = 0.f; ak[j] = 0.f; }
#pragma unroll
                for (int j = 0; j < 8; ++j) av[j] = 0.f;
#pragma unroll
                for (int tap = 0; tap < 4; ++tap) { const int ts = t + tap - 2;
                    if (ts >= 0 && ts < Ls) { const bf16_t* rp = PM + (rowbase + ts) * NMIXP; const LAS float* w = cwl + tap * 320;
                        float f0[8], f1[8];
                        { const u32x4 w0 = *(const u32x4*)(rp + C_DN_Q + h * 128 + cg * 16), w1 = *(const u32x4*)(rp + C_DN_Q + h * 128 + cg * 16 + 8); unpack8(w0, f0); unpack8(w1, f1); }
#pragma unroll
                        for (int j = 0; j < 8; ++j) { aq[j] += w[cg * 16 + j] * f0[j]; aq[8 + j] += w[cg * 16 + 8 + j] * f1[j]; }
                        { const u32x4 w0 = *(const u32x4*)(rp + C_DN_K + h * 128 + cg * 16), w1 = *(const u32x4*)(rp + C_DN_K + h * 128 + cg * 16 + 8); unpack8(w0, f0); unpack8(w1, f1); }
#pragma unroll
                        for (int j = 0; j < 8; ++j) { ak[j] += w[128 + cg * 16 + j] * f0[j]; ak[8 + j] += w[128 + cg * 16 + 8 + j] * f1[j]; }
                        { const u32x4 w0 = *(const u32x4*)(rp + C_DN_V + h * 128 + vh * 64 + cg * 8); unpack8(w0, f0); }
#pragma unroll
                        for (int j = 0; j < 8; ++j) av[j] += w[256 + cg * 8 + j] * f0[j]; } }
#pragma unroll
                for (int j = 0; j < 16; ++j) { qs[i * 128 + cg * 16 + j] = siluf(aq[j]); ks[i * 128 + cg * 16 + j] = siluf(ak[j]); }
#pragma unroll
                for (int j = 0; j < 8; ++j) vs[i * 64 + cg * 8 + j] = siluf(av[j]);
                if (tid < 64) { const int lr2 = d ? 63 - tid : tid; const bf16_t* rp = PM + (rowbase + r0 + lr2) * NMIXP;
                    const float g = neg_ea * softplusf(bf1(rp + C_DN_A + d * 4 + h) + dtb); as[tid] = __expf(g); bs[tid] = sigm(bf1(rp + C_DN_B + d * 4 + h)); }
            }
            __syncthreads();
            {
                const int rowid = tid >> 2, part = tid & 3; LAS float* p = (rowid < 64 ? qs + rowid * 128 : ks + (rowid - 64) * 128) + part * 32; float ss = 0.f;
#pragma unroll
                for (int j = 0; j < 32; ++j) ss += p[j] * p[j];
                ss += __shfl_xor(ss, 1); ss += __shfl_xor(ss, 2);
                const float rs = __builtin_amdgcn_rsqf(ss + EPS) * (rowid < 64 ? 0.08838834764831845f : 1.0f);
#pragma unroll
                for (int j = 0; j < 32; ++j) p[j] *= rs;
            }
            __syncthreads();
#pragma unroll 2
            for (int i = 0; i < 64; ++i) {
                f32x4 kk[4]; float kts = 0.f;
#pragma unroll
                for (int q4 = 0; q4 < 4; ++q4) { kk[q4] = *(const LAS f32x4*)(ks + i * 128 + kq * 16 + q4 * 4);
#pragma unroll
                    for (int j = 0; j < 4; ++j) kts += s[q4 * 4 + j] * kk[q4][j]; }
                kts += __shfl_xor(kts, 1); kts += __shfl_xor(kts, 2); kts += __shfl_xor(kts, 4);
                const float al = as[i], be = bs[i]; const float vn = be * (vs[i * 64 + vc] - al * kts); float po = 0.f;
#pragma unroll
                for (int q4 = 0; q4 < 4; ++q4) { const f32x4 q0 = *(const LAS f32x4*)(qs + i * 128 + kq * 16 + q4 * 4);
#pragma unroll
                    for (int j = 0; j < 4; ++j) { s[q4 * 4 + j] = al * s[q4 * 4 + j] + kk[q4][j] * vn; po += s[q4 * 4 + j] * q0[j]; } }
                po += __shfl_xor(po, 1); po += __shfl_xor(po, 2); po += __shfl_xor(po, 4);
                if (kq == 0) os[i * 64 + vc] = po;
            }
            __syncthreads();
            {   const int i = tid >> 3, cg = tid & 7, lr = d ? 63 - i : i; float o[8];
#pragma unroll
                for (int j = 0; j < 8; ++j) o[j] = os[i * 64 + cg * 8 + j];
                *(u32x4*)(ORAW + (rowbase + r0 + lr) * 2048 + 2 * 512 + h * 128 + vh * 64 + cg * 8) = pack8(o); }
        }
    }
}
__device__ __forceinline__ void chain_rg(const Ctx& c, int gw  ) {
    ARGS_REF a = *c.a; const int b = gw >> 3, d = (gw >> 2) & 1, ch = (gw & 3) * 128 + c.lane * 2;
    const bf16_t* RGLA = (const bf16_t*)(a.ws + WS_RGLA) + (size_t)d * MT * 512 + ch; const bf16_t* RGU = (const bf16_t*)(a.ws + WS_RGU) + (size_t)d * MT * 512 + ch;
    bf16_t* ORAW = (bf16_t*)(a.ws + WS_ORAW) + (size_t)d * MT * 2048 + 1536 + ch;
    float h0 = 0.f, h1 = 0.f;
#pragma unroll 1
    for (int seg = 0; seg < 2; ++seg) {
        const int Ls = seg ? T : CL; const size_t rowbase = seg ? (size_t)b * T : (size_t)ML + b * CL;
#pragma unroll 1
        for (int s0 = 0; s0 < Ls; s0 += 16) {
            unsigned la[16], uu[16];
#pragma unroll
            for (int j = 0; j < 16; ++j) { const size_t row = rowbase + (d ? Ls - 1 - (s0 + j) : s0 + j); la[j] = *(const unsigned*)(RGLA + row * 512); uu[j] = *(const unsigned*)(RGU + row * 512); }
#pragma unroll
            for (int j = 0; j < 16; ++j) { const size_t row = rowbase + (d ? Ls - 1 - (s0 + j) : s0 + j);
                h0 = __expf(bflo(la[j])) * h0 + bflo(uu[j]); h1 = __expf(bfhi(la[j])) * h1 + bfhi(uu[j]);
                *(unsigned*)(ORAW + row * 2048) = pg8::cvt_pk_bf16_safe(h0, h1); }
        }
    }
}

typedef float f32x16 __attribute__((ext_vector_type(16)));
typedef pg8::bf16x8 bf16x8;
#define LBAR() do { asm volatile("s_waitcnt lgkmcnt(0)" ::: "memory"); __builtin_amdgcn_s_barrier(); asm volatile("" ::: "memory"); } while (0)
#define MFMA32(a, b, c) __builtin_amdgcn_mfma_f32_32x32x16_bf16((a), (b), (c), 0, 0, 0)
template <int S_> __device__ __forceinline__ bf16x8 pack_step(const f32x16& x) {
    f32x8 v;
#pragma unroll
    for (int j = 0; j < 8; ++j) v[j] = x[8 * S_ + j];
    return __builtin_bit_cast(bf16x8, __builtin_convertvector(v, bfx8_t));
}
__device__ __forceinline__ float bf1(const LAS bf16_t* p) { return __uint_as_float(((unsigned)*p) << 16); }
__device__ __forceinline__ bf16_t f2bf(float f) { const __bf16 b = (__bf16)f; return __builtin_bit_cast(bf16_t, b); }
__device__ __forceinline__ int permpos(int k) { const int w = k & 15; return (k & ~15) + (((w >> 2) & 1) << 3) + ((w >> 3) << 2) + (w & 3); }
__device__ __forceinline__ int crow16(int idx, int hh) { return (idx & 3) + 8 * (idx >> 2) + 4 * hh; }
__device__ __forceinline__ size_t chunk_rowbase(int b, int n) { return n < 4 ? (size_t)ML + b * CL + n * 64 : (size_t)b * T + (size_t)(n - 4) * 64; }

template <int L, int TY>
__device__ __forceinline__ void intra_g_item(const Ctx& c, int b, int h, int n) {
    constexpr int K = TY ? 128 : 64, NSEG = 512 / K, TS = 64 / NSEG, QPITCH = 2 * K + 16, RP = 2 * K;
    constexpr int O_RQ = 0, O_RZ0 = O_RQ + 64 * RP, O_RZ1 = O_RZ0 + 64 * RP  , O_RV = O_RZ1 + 64 * RP, O_QH = O_RV + 64 * 256,
                  O_KH = O_QH + 64 * QPITCH, O_SEG = O_KH + 64 * QPITCH, O_QO = O_SEG + 2048, O_AO = O_QO + 64 * RP, O_END = O_AO + 8192;
    static_assert(O_END <= 147456, "intra_g LDS");
    ARGS_REF a = *c.a; const int tid = c.tid;
    const bf16_t* PM = (const bf16_t*)(a.ws + WS_PMIX);
    unsigned char* scr = a.ws + WS_SCR;
    const size_t rowbase = chunk_rowbase(b, n);
    const int rec = (b * 4 + h) * 260 + n;
    LAS unsigned char* lds = c.lds + LDS_SCR;
    LAS unsigned char* Qh = lds + O_QH; LAS unsigned char* Kh = lds + O_KH; LAS float* segtot = (LAS float*)(lds + O_SEG);
    LBAR();
    {
        const char* pb = (const char*)(PM + rowbase * NMIXP); asm volatile("" : "+s"(pb));
        constexpr int PPR = K / 8;
#pragma unroll
        for (int i = 0; i < 64 * PPR / 512; ++i) { const int p = i * 512 + tid, t = p / PPR, cc = p % PPR; const unsigned ro = (unsigned)(t * NMIXP) * 2u + cc * 16;
            *(LAS u32x4*)(lds + O_RQ + p * 16) = *(const u32x4*)(pb + ro + ((TY ? C_HG_Q : C_GLA_Q) + h * K) * 2);
            if (TY) { *(LAS u32x4*)(lds + O_RZ0 + p * 16) = *(const u32x4*)(pb + ro + (C_HG_F + h * 128) * 2); *(LAS u32x4*)(lds + O_RZ1 + p * 16) = *(const u32x4*)(pb + ro + (C_HG_F + 512 + h * 128) * 2); }
            else *(LAS u32x4*)(lds + O_RZ0 + p * 16) = *(const u32x4*)(pb + ro + (C_GLA_K + h * 64) * 2); }
        if (TY == 0 && tid < 256) { const int t = tid >> 2, cc = tid & 3; *(LAS u32x4*)(lds + O_RZ1 + tid * 16) = *(const u32x4*)(pb + (unsigned)(t * NMIXP) * 2u + cc * 16 + C_GLA_A * 2); }
#pragma unroll
        for (int i = 0; i < 2; ++i) { const int p = i * 512 + tid, t = p >> 4, cc = p & 15;
            *(LAS u32x4*)(lds + O_RV + p * 16) = *(const u32x4*)(pb + (unsigned)(t * NMIXP) * 2u + cc * 16 + ((TY ? C_HG_I : C_GLA_V) + h * 128) * 2); }
    }
    LBAR();
    {
        const int v = tid & 127, t0 = (tid >> 7) * 16; float v0[8], v1[8];
#pragma unroll
        for (int j = 0; j < 8; ++j) { v0[j] = bf1((const LAS bf16_t*)(lds + O_RV + (t0 + j) * 256 + v * 2)); v1[j] = bf1((const LAS bf16_t*)(lds + O_RV + (t0 + 8 + j) * 256 + v * 2)); }
        u32x4* dst = (u32x4*)(scr + (TY ? SC_HG_VT : SC_GLA_VT) + (size_t)rec * 16384 + v * 128 + t0 * 2);
        dst[0] = pack8(v0); dst[1] = pack8(v1);
    }
    const int k = tid & (K - 1), tq = tid / K;
    float lb = 0.f;
    if (TY == 1 && L == 1) { const float l0 = a.in[I_HG_LB][h * 128 + k], l1 = a.in[I_HG_LB][512 + h * 128 + k]; lb = __builtin_amdgcn_rcpf(1.0f + __expf(l0 - l1)); }
#pragma unroll 1
    for (int d = 0; d < 2; ++d) {
        float qv[TS], kv[TS], bv[TS];
        if (TY == 0) {
            float w[16]; const float bias = a.in[I_GLA_BA2][(L * 2 + d) * 256 + h * 64 + k];
#pragma unroll
            for (int r = 0; r < 16; ++r) w[r] = a.in[I_GLA_WA2][((L * 2 + d) * 16 + r) * 256 + h * 64 + k];
#pragma unroll
            for (int j = 0; j < TS; ++j) { const int t = TS * tq + j;
                qv[j] = bf1((const LAS bf16_t*)(lds + O_RQ + t * RP + k * 2)) * 0.125f; kv[j] = bf1((const LAS bf16_t*)(lds + O_RZ0 + t * RP + k * 2));
                const u32x4 w0 = *(const LAS u32x4*)(lds + O_RZ1 + t * 64 + d * 32), w1 = *(const LAS u32x4*)(lds + O_RZ1 + t * 64 + d * 32 + 16); float f0[8], f1[8]; unpack8(w0, f0); unpack8(w1, f1);
                float z = bias;
#pragma unroll
                for (int r = 0; r < 8; ++r) { z += f0[r] * w[r]; z += f1[r] * w[8 + r]; }
                bv[j] = -softplusf(-z) * (1.0f / 16.0f); }
        } else {
#pragma unroll
            for (int j = 0; j < TS; ++j) { const int t = TS * tq + j;
                qv[j] = siluf(bf1((const LAS bf16_t*)(lds + O_RQ + t * RP + k * 2))) * 0.08838834764831845f;
                const float sg = sigm(bf1((const LAS bf16_t*)(lds + (d ? O_RZ1 : O_RZ0) + t * RP + k * 2)));
                bv[j] = __logf(fmaxf(lb + (1.0f - lb) * sg, 1e-30f)); kv[j] = (1.0f - lb) * (1.0f - sg); }
        }
        float run = 0.f;
        if (d == 0) {
#pragma unroll
            for (int j = 0; j < TS; ++j) { run += bv[j]; bv[j] = run; } }
        else {
#pragma unroll
            for (int j = TS - 1; j >= 0; --j) { run += bv[j]; bv[j] = run; } }
        segtot[tq * K + k] = run;
        LBAR();
        float off = 0.f, tot = 0.f, R = 0.f;
#pragma unroll
        for (int sg = 0; sg < NSEG; ++sg) { const float s = segtot[sg * K + k]; tot += s;
            if (d ? (sg > tq) : (sg < tq)) off += s;
            if (d ? (sg >= NSEG / 2) : (sg < NSEG / 2)) R += s; }
        const size_t drec = (size_t)((d * 8 + b * 4 + h) * 260 + n);
        bf16_t* ktp = (bf16_t*)(scr + (TY ? SC_HG_KT : SC_GLA_KT) + drec * (64 * K * 2));
        const int pk = permpos(k);
        float kt[TS];
#pragma unroll
        for (int j = 0; j < TS; ++j) { const int t = TS * tq + j; const float B = off + bv[j];
            *(LAS bf16_t*)(lds + O_QO + t * RP + pk * 2) = f2bf(qv[j] * __expf(B));
            kt[j] = kv[j] * __expf(tot - B);
            *(LAS bf16_t*)(Qh + t * QPITCH + k * 2) = f2bf(qv[j] * __expf(fminf(B - R, 60.f)));
            *(LAS bf16_t*)(Kh + t * QPITCH + k * 2) = f2bf(kv[j] * __expf(fminf(R - B, 60.f))); }
        {   u32x4* dst = (u32x4*)(ktp + k * 64 + TS * tq);
#pragma unroll
            for (int g = 0; g < TS / 8; ++g) { float t8[8];
#pragma unroll
                for (int j = 0; j < 8; ++j) t8[j] = kt[g * 8 + j];
                dst[g] = pack8(t8); } }
        if (tq == 0) ((float*)(scr + (TY ? SC_HG_LAM : SC_GLA_LAM) + drec * (K * 4)))[k] = __expf(tot);
        LBAR();
        if (c.wave < 4) {
            const int it = c.wave >> 1, jt = c.wave & 1, r = c.lane & 31, hh = c.lane >> 5;
            f32x16 acc;
#pragma unroll
            for (int i = 0; i < 16; ++i) acc[i] = 0.f;
            const bool dead = d ? (it == 1 && jt == 0) : (it == 0 && jt == 1);
            if (!dead) {
#pragma unroll
                for (int ks = 0; ks < K / 16; ++ks) { const bf16x8 af = *(const LAS bf16x8*)(Qh + (32 * it + r) * QPITCH + ks * 32 + hh * 16), bfr = *(const LAS bf16x8*)(Kh + (32 * jt + r) * QPITCH + ks * 32 + hh * 16);
                    acc = MFMA32(af, bfr, acc); } }
            const int jj = 32 * jt + r;
#pragma unroll
            for (int i = 0; i < 16; ++i) { const int ii = 32 * it + crow16(i, hh); const bool ok = d ? (jj >= ii) : (jj <= ii); *(LAS bf16_t*)(lds + O_AO + ii * 128 + jj * 2) = f2bf(ok ? acc[i] : 0.f); }
        }
        LBAR();
        {
            u32x4* qp = (u32x4*)(scr + (TY ? SC_HG_QP : SC_GLA_QP) + drec * (64 * K * 2)); u32x4* ap = (u32x4*)(scr + (TY ? SC_HG_A : SC_GLA_A) + drec * 8192);
#pragma unroll
            for (int i = 0; i < 64 * K * 2 / 16 / 512; ++i) qp[i * 512 + tid] = *(const LAS u32x4*)(lds + O_QO + (i * 512 + tid) * 16);
            ap[tid] = *(const LAS u32x4*)(lds + O_AO + tid * 16);
        }
    }
}

template <int TY> struct GChunk {
    static constexpr int K = TY ? 128 : 64, QPITCH = 2 * K + 16, RQ = 64 * K * 2 / 16 / 256  , NRL = 2 * RQ + 2 + 4;
    static constexpr int OFF_QP = 0, OFF_KT = 64 * QPITCH, OFF_A = OFF_KT + K * 144, OFF_VT = OFF_A + 64 * 144, OFF_LAM = OFF_VT + 128 * 144, BYTES = OFF_LAM + K * 4;
};
template <int TY>
__device__ __forceinline__ void gchunk_issue(const unsigned char* scr, int b, int h, int d, int n, int lt, u32x4 (&pf)[GChunk<TY>::NRL], float& lamv) {
    typedef GChunk<TY> G; constexpr int K = G::K, RQ = G::RQ;
    const size_t drec = (size_t)((d * 8 + b * 4 + h) * 260 + n), rec = (size_t)((b * 4 + h) * 260 + n);
    const u32x4* qp = (const u32x4*)(scr + (TY ? SC_HG_QP : SC_GLA_QP) + drec * (64 * K * 2));
    const u32x4* kt = (const u32x4*)(scr + (TY ? SC_HG_KT : SC_GLA_KT) + drec * (64 * K * 2));
    const u32x4* ap = (const u32x4*)(scr + (TY ? SC_HG_A : SC_GLA_A) + drec * 8192);
    const u32x4* vt = (const u32x4*)(scr + (TY ? SC_HG_VT : SC_GLA_VT) + rec * 16384);
#pragma unroll
    for (int i = 0; i < RQ; ++i) { pf[i] = qp[i * 256 + lt]; pf[RQ + i] = kt[i * 256 + lt]; }
    pf[2 * RQ] = ap[lt]; pf[2 * RQ + 1] = ap[256 + lt];
#pragma unroll
    for (int i = 0; i < 4; ++i) pf[2 * RQ + 2 + i] = vt[i * 256 + lt];
    if (lt < K) lamv = ((const float*)(scr + (TY ? SC_HG_LAM : SC_GLA_LAM) + drec * (K * 4)))[lt];
}
template <int TY>
__device__ __forceinline__ void gchunk_commit(LAS unsigned char* buf, int lt, const u32x4 (&pf)[GChunk<TY>::NRL], float lamv) {
    typedef GChunk<TY> G; constexpr int K = G::K, PPR = K * 2 / 16, RQ = G::RQ;
#pragma unroll
    for (int i = 0; i < RQ; ++i) { const int p = i * 256 + lt;
        *(LAS u32x4*)(buf + G::OFF_QP + (p / PPR) * G::QPITCH + (p % PPR) * 16) = pf[i];
        *(LAS u32x4*)(buf + G::OFF_KT + (p >> 3) * 144 + (p & 7) * 16) = pf[RQ + i]; }
#pragma unroll
    for (int i = 0; i < 2; ++i) { const int p = i * 256 + lt; *(LAS u32x4*)(buf + G::OFF_A + (p >> 3) * 144 + (p & 7) * 16) = pf[2 * RQ + i]; }
#pragma unroll
    for (int i = 0; i < 4; ++i) { const int p = i * 256 + lt; *(LAS u32x4*)(buf + G::OFF_VT + (p >> 3) * 144 + (p & 7) * 16) = pf[2 * RQ + 2 + i]; }
    if (lt < K) *(LAS float*)(buf + G::OFF_LAM + lt * 4) = lamv;
}
template <int TY>
__device__ __forceinline__ void gchunk_compute(LAS unsigned char* buf, f32x16 (&S)[GChunk<TY>::K / 32], bf16_t* orow, int vs, int lane) {
    typedef GChunk<TY> G; constexpr int K = G::K, KT_ = K / 32;
    const int r = lane & 31, hh = lane >> 5;
    const LAS unsigned char* qpp = buf + G::OFF_QP + r * G::QPITCH + hh * 16;
    const LAS unsigned char* app = buf + G::OFF_A + r * 144 + hh * 16;
    const LAS unsigned char* ktp = buf + G::OFF_KT + r * 144 + hh * 16;
#define G_SB() __builtin_amdgcn_sched_barrier(0)
#define G_LDQ(F, kt) do { F[0] = *(const LAS bf16x8*)(qpp + (2 * (kt)) * 32); F[1] = *(const LAS bf16x8*)(qpp + (2 * (kt) + 1) * 32); \
        F[2] = *(const LAS bf16x8*)(qpp + 32 * G::QPITCH + (2 * (kt)) * 32); F[3] = *(const LAS bf16x8*)(qpp + 32 * G::QPITCH + (2 * (kt) + 1) * 32); } while (0)
#define G_MMQ(F, kt) do { const bf16x8 b0 = pack_step<0>(S[kt]), b1 = pack_step<1>(S[kt]); o[0] = MFMA32(F[0], b0, o[0]); o[1] = MFMA32(F[2], b0, o[1]); o[0] = MFMA32(F[1], b1, o[0]); o[1] = MFMA32(F[3], b1, o[1]); } while (0)
#define G_LD4(F, base) do { _Pragma("unroll") for (int ts = 0; ts < 4; ++ts) F[ts] = *(const LAS bf16x8*)((base) + ts * 32); } while (0)
#define G_MMA(F, it) do { _Pragma("unroll") for (int ts = 0; ts < 4; ++ts) o[it] = MFMA32(F[ts], vf[ts], o[it]); } while (0)
#define G_LAM(kt) do { _Pragma("unroll") for (int g = 0; g < 4; ++g) { const f32x4 lm = *(const LAS f32x4*)(buf + G::OFF_LAM + (32 * (kt) + 8 * g + 4 * hh) * 4); \
        _Pragma("unroll") for (int j = 0; j < 4; ++j) S[kt][4 * g + j] *= lm[j]; } } while (0)
#define G_MMK(F, kt) do { _Pragma("unroll") for (int ts = 0; ts < 4; ++ts) S[kt] = MFMA32(F[ts], vf[ts], S[kt]); } while (0)
    bf16x8 vf[4], fa[4], fb[4];
    G_LDQ(fa, 0);
#pragma unroll
    for (int ts = 0; ts < 4; ++ts) vf[ts] = *(const LAS bf16x8*)(buf + G::OFF_VT + (32 * vs + r) * 144 + ts * 32 + hh * 16);
    f32x16 o[2];
#pragma unroll
    for (int it = 0; it < 2; ++it) {
#pragma unroll
        for (int i = 0; i < 16; ++i) o[it][i] = 0.f; }
    if (KT_ == 2) {
        G_LDQ(fb, 1); G_SB(); G_MMQ(fa, 0); G_SB();
        G_LD4(fa, app); G_SB(); G_MMQ(fb, 1); G_SB();
    } else {
        G_LDQ(fb, 1); G_SB(); G_MMQ(fa, 0); G_SB();
        G_LDQ(fa, 2); G_SB(); G_MMQ(fb, 1); G_SB();
        G_LDQ(fb, 3); G_SB(); G_MMQ(fa, 2); G_SB();
        G_LD4(fa, app); G_SB(); G_MMQ(fb, 3); G_SB();
    }
    G_LD4(fb, app + 32 * 144); G_SB(); G_MMA(fa, 0); G_SB();
    G_LD4(fa, ktp); G_LAM(0); G_SB(); G_MMA(fb, 1); G_SB();
    if (KT_ == 2) {
        G_LD4(fb, ktp + 32 * 144); G_LAM(1); G_SB(); G_MMK(fa, 0); G_SB();
        G_MMK(fb, 1); G_SB();
    } else {
        G_LD4(fb, ktp + 32 * 144); G_LAM(1); G_SB(); G_MMK(fa, 0); G_SB();
        G_LD4(fa, ktp + 64 * 144); G_LAM(2); G_SB(); G_MMK(fb, 1); G_SB();
        G_LD4(fb, ktp + 96 * 144); G_LAM(3); G_SB(); G_MMK(fa, 2); G_SB();
        G_MMK(fb, 3); G_SB();
    }
#pragma unroll
    for (int it = 0; it < 2; ++it)
#pragma unroll
        for (int i = 0; i < 16; ++i) orow[(size_t)(32 * it + crow16(i, hh)) * 2048 + 32 * vs + r] = f2bf(o[it][i]);
#undef G_SB
#undef G_LDQ
#undef G_MMQ
#undef G_LD4
#undef G_MMA
#undef G_LAM
#undef G_MMK
}
template <int L, int TY>
__device__ __forceinline__ void chain_g(const Ctx& c, int b, int h, int d) {
    typedef GChunk<TY> G; constexpr int KT_ = G::K / 32;
    ARGS_REF a = *c.a;
    const unsigned char* scr = a.ws + WS_SCR;
    LAS unsigned char* buf = c.lds + LDS_SCR;
    static_assert(G::BYTES <= 65536, "two chunk buffers must fit the scratch region");
#define CHUNK_OF(m) (d ? ((m) < 4 ? 3 - (m) : 263 - (m)) : (m))
    __syncthreads();
    if (c.wave < 4) {
        bf16_t* ORAW = (bf16_t*)(a.ws + WS_ORAW) + (size_t)d * MT * 2048 + TY * 512 + h * 128;
        f32x16 S[KT_];
#pragma unroll
        for (int kt = 0; kt < KT_; ++kt)
#pragma unroll
            for (int i = 0; i < 16; ++i) S[kt][i] = 0.f;
        LBAR();
#pragma unroll 1
        for (int m = 0; m < 260; ++m) {
            gchunk_compute<TY>(buf + (m & 1) * 65536, S, ORAW + chunk_rowbase(b, CHUNK_OF(m)) * 2048, c.wave, c.lane);
            LBAR();
        }
    } else {
        const int lt = c.tid - 256;
        u32x4 p0[G::NRL], p1[G::NRL], p2[G::NRL]; float l0 = 0.f, l1 = 0.f, l2 = 0.f;
        gchunk_issue<TY>(scr, b, h, d, CHUNK_OF(0), lt, p0, l0);
        gchunk_issue<TY>(scr, b, h, d, CHUNK_OF(1), lt, p1, l1);
        gchunk_issue<TY>(scr, b, h, d, CHUNK_OF(2), lt, p2, l2);
        gchunk_commit<TY>(buf, lt, p0, l0);
        gchunk_issue<TY>(scr, b, h, d, CHUNK_OF(3), lt, p0, l0);
        LBAR();
#pragma unroll 1
        for (int m = 0; m < 258; m += 3) {
            gchunk_commit<TY>(buf + ((m + 1) & 1) * 65536, lt, p1, l1); if (m + 4 < 260) gchunk_issue<TY>(scr, b, h, d, CHUNK_OF(m + 4), lt, p1, l1); LBAR();
            gchunk_commit<TY>(buf + ((m + 2) & 1) * 65536, lt, p2, l2); if (m + 5 < 260) gchunk_issue<TY>(scr, b, h, d, CHUNK_OF(m + 5), lt, p2, l2); LBAR();
            gchunk_commit<TY>(buf + ((m + 3) & 1) * 65536, lt, p0, l0); if (m + 6 < 260) gchunk_issue<TY>(scr, b, h, d, CHUNK_OF(m + 6), lt, p0, l0); LBAR();
        }
        gchunk_commit<TY>(buf + (259 & 1) * 65536, lt, p1, l1); LBAR();
        LBAR();
    }
#undef CHUNK_OF
}

__device__ __forceinline__ int posU(int i) { const int w = i & 31; return (i & 32) + (((w >> 2) & 1) << 4) + (w & 3) + ((w >> 3) << 2); }
__device__ __forceinline__ constexpr int pp16(int w) { return (((w >> 2) & 1) << 3) + ((w >> 3) << 2) + (w & 3); }

__device__ __forceinline__ void trisolve64(const LAS float* A, LAS float* TL, int cidx) {
    LAS float* tl = TL + cidx * 68;
#pragma unroll 1
    for (int blk = 0; blk < 4; ++blk) {
        float acc[16];
#pragma unroll
        for (int r = 0; r < 16; ++r) acc[r] = (16 * blk + r == cidx) ? 1.f : 0.f;
        const LAS float* Ab = A + (16 * blk) * 64;
#pragma unroll 1
        for (int pj = 0; pj < 16 * blk; pj += 4) { const f32x4 t4 = *(const LAS f32x4*)(tl + pj);
#pragma unroll
            for (int r = 0; r < 16; ++r) { const f32x4 a4 = *(const LAS f32x4*)(Ab + r * 64 + pj); acc[r] -= a4[0] * t4[0] + a4[1] * t4[1] + a4[2] * t4[2] + a4[3] * t4[3]; } }
#pragma unroll
        for (int r = 1; r < 16; ++r) {
#pragma unroll
            for (int q = 0; q < (r + 3) / 4; ++q) { const f32x4 a4 = *(const LAS f32x4*)(Ab + r * 64 + 16 * blk + 4 * q);
#pragma unroll
                for (int jj = 0; jj < 4; ++jj) if (4 * q + jj < r) acc[r] -= a4[jj] * acc[4 * q + jj]; } }
#pragma unroll
        for (int q = 0; q < 4; ++q) { f32x4 v = {acc[4 * q], acc[4 * q + 1], acc[4 * q + 2], acc[4 * q + 3]}; *(LAS f32x4*)(tl + 16 * blk + 4 * q) = v; }
    }
}

template <int L>
__device__ __forceinline__ void intra_dn_item(const Ctx& c, int b, int h, int n) {
    ARGS_REF a = *c.a; const int tid = c.tid, lane = c.lane, wave = c.wave;
    const bf16_t* PM = (const bf16_t*)(a.ws + WS_PMIX);
    unsigned char* scr = a.ws + WS_SCR;
    const int rec = (b * 4 + h) * 260 + n;
    LAS unsigned char* Qh = c.lds + LDS_SCR;
    LAS unsigned char* Kh = Qh + 17408;
    LAS unsigned char* Tp = c.lds + LDS_SCR + 106496;
    LAS float* TLb = (LAS float*)Qh;
    LAS unsigned char* KTp = c.lds + LDS_SCR + 36864;
    LAS unsigned char* VTp = KTp + 18432;
    LAS float* Ap = (LAS float*)(VTp + 18432);
    LAS float* sm = (LAS float*)(c.lds + LDS_AUX);
    LBAR();
    PT_START(0); PT_START(5);
#pragma unroll 1
    for (int rep1_ = 0; rep1_ < ((PROBE_SUB & 32) ? 2 : 1); ++rep1_)
    {
        const int i = tid >> 3, cg = tid & 7;
        const int Ls = n < 4 ? CL : T; const int tseg = (n < 4 ? n : n - 4) * 64 + i; const size_t segbase = n < 4 ? (size_t)ML + b * CL : (size_t)b * T;
        float aq[16], ak[16], av[16];
#pragma unroll
        for (int j = 0; j < 16; ++j) { aq[j] = 0.f; ak[j] = 0.f; av[j] = 0.f; }
        const float* cw = a.in[I_DN_CW] + (size_t)L * 4 * 1536 + h * 128 + cg * 16;
#pragma unroll
        for (int tap = 0; tap < 4; ++tap) { const int ts = tseg + tap - 2;
            if (ts >= 0 && ts < Ls) { const bf16_t* rp = PM + (segbase + ts) * NMIXP + h * 128 + cg * 16; const float* w = cw + tap * 1536;
                float f0[8], f1[8]; float wq[16], wk[16], wv[16];
#pragma unroll
                for (int q4 = 0; q4 < 4; ++q4) { const f32x4 a4 = *(const f32x4*)(w + 4 * q4), b4 = *(const f32x4*)(w + 512 + 4 * q4), c4 = *(const f32x4*)(w + 1024 + 4 * q4);
#pragma unroll
                    for (int j = 0; j < 4; ++j) { wq[4 * q4 + j] = a4[j]; wk[4 * q4 + j] = b4[j]; wv[4 * q4 + j] = c4[j]; } }
                { const u32x4 w0 = *(const u32x4*)(rp + C_DN_Q), w1 = *(const u32x4*)(rp + C_DN_Q + 8); unpack8(w0, f0); unpack8(w1, f1); }
#pragma unroll
                for (int j = 0; j < 8; ++j) { aq[j] += wq[j] * f0[j]; aq[8 + j] += wq[8 + j] * f1[j]; }
                { const u32x4 w0 = *(const u32x4*)(rp + C_DN_K), w1 = *(const u32x4*)(rp + C_DN_K + 8); unpack8(w0, f0); unpack8(w1, f1); }
#pragma unroll
                for (int j = 0; j < 8; ++j) { ak[j] += wk[j] * f0[j]; ak[8 + j] += wk[8 + j] * f1[j]; }
                { const u32x4 w0 = *(const u32x4*)(rp + C_DN_V), w1 = *(const u32x4*)(rp + C_DN_V + 8); unpack8(w0, f0); unpack8(w1, f1); }
#pragma unroll
                for (int j = 0; j < 8; ++j) { av[j] += wv[j] * f0[j]; av[8 + j] += wv[8 + j] * f1[j]; } } }
        float sq = 0.f, sk = 0.f;
#pragma unroll
        for (int j = 0; j < 16; ++j) { aq[j] = siluf(aq[j]); ak[j] = siluf(ak[j]); av[j] = siluf(av[j]); sq += aq[j] * aq[j]; sk += ak[j] * ak[j]; }
        sq += __shfl_xor(sq, 1); sq += __shfl_xor(sq, 2); sq += __shfl_xor(sq, 4);
        sk += __shfl_xor(sk, 1); sk += __shfl_xor(sk, 2); sk += __shfl_xor(sk, 4);
        const float rq = __builtin_amdgcn_rsqf(sq + EPS) * 0.08838834764831845f, rk = __builtin_amdgcn_rsqf(sk + EPS);
        float qp[16];
#pragma unroll
        for (int j = 0; j < 16; ++j) { aq[j] *= rq; ak[j] *= rk; }
#pragma unroll
        for (int j = 0; j < 16; ++j) qp[pp16(j)] = aq[j];
        {   float x0[8], x1[8];
#pragma unroll
            for (int j = 0; j < 8; ++j) { x0[j] = qp[j]; x1[j] = qp[8 + j]; }
            u32x4* dst = (u32x4*)(scr + SC_DN_QS + (size_t)rec * 16384 + i * 256 + cg * 32); dst[0] = pack8(x0); dst[1] = pack8(x1);
#pragma unroll
            for (int j = 0; j < 8; ++j) { x0[j] = aq[j]; x1[j] = aq[8 + j]; }
            *(LAS u32x4*)(Qh + i * 272 + cg * 32) = pack8(x0); *(LAS u32x4*)(Qh + i * 272 + cg * 32 + 16) = pack8(x1);
#pragma unroll
            for (int j = 0; j < 8; ++j) { x0[j] = ak[j]; x1[j] = ak[8 + j]; }
            *(LAS u32x4*)(Kh + i * 272 + cg * 32) = pack8(x0); *(LAS u32x4*)(Kh + i * 272 + cg * 32 + 16) = pack8(x1); }
        const int pj = permpos(i);
#pragma unroll
        for (int j = 0; j < 16; ++j) { *(LAS bf16_t*)(KTp + (cg * 16 + j) * 144 + pj * 2) = f2bf(ak[j]); *(LAS bf16_t*)(VTp + (cg * 16 + j) * 144 + pj * 2) = f2bf(av[j]); }
        if (tid < 128) { const int d = tid >> 6, t = tid & 63; const bf16_t* rp = PM + (chunk_rowbase(b, n) + t) * NMIXP;
            const float g = -expf(a.in[I_DN_ALOG][(L * 2 + d) * 4 + h]) * softplusf(bf1(rp + C_DN_A + d * 4 + h) + a.in[I_DN_DTB][(L * 2 + d) * 4 + h]);
            sm[d * 256 + t] = g; sm[d * 256 + 128 + t] = sigm(bf1(rp + C_DN_B + d * 4 + h)); }
    }
    LBAR();
    PT_STOP(0, a.ws); PT_START(1);
    const int r = lane & 31, hh = lane >> 5;
    f32x16 gram;
#pragma unroll
    for (int i = 0; i < 16; ++i) gram[i] = 0.f;
    const int t1 = (wave & 3) >> 1, t2 = wave & 1;
#pragma unroll
    for (int ks = 0; ks < 8; ++ks) {
        const bf16x8 af = *(const LAS bf16x8*)(Kh + (32 * (wave < 4 ? t2 : t1) + r) * 272 + ks * 32 + hh * 16);
        const bf16x8 bfr = *(const LAS bf16x8*)((wave < 4 ? Qh : Kh) + (32 * (wave < 4 ? t1 : t2) + r) * 272 + ks * 32 + hh * 16);
        gram = MFMA32(af, bfr, gram); }
    {
        u32x4* dst = (u32x4*)(scr + SC_DN_KT + (size_t)rec * 16384);
#pragma unroll
        for (int q = 0; q < 2; ++q) { const int p = q * 512 + tid; dst[p] = *(const LAS u32x4*)(KTp + (p >> 3) * 144 + (p & 7) * 16); } }
    if (tid < 128) { const int d = tid >> 6, t = tid & 63; float acc = 0.f;
#pragma unroll 16
        for (int tt = 0; tt < 64; ++tt) { const float g = sm[d * 256 + tt]; acc += (d ? (tt >= t) : (tt <= t)) ? g : 0.f; }
        sm[d * 256 + 64 + t] = acc; }
    LBAR();
    PT_STOP(1, a.ws); PT_START(2);
#pragma unroll 1
    for (int d = 0; d < 2; ++d) {
        const LAS float* gc = sm + d * 256 + 64; const LAS float* be = sm + d * 256 + 128;
        const size_t drec = (size_t)((d * 8 + b * 4 + h) * 260 + n);
        if (wave < 4) {
            const int i = 32 * t1 + r; const float gi = gc[i]; float o[16];
#pragma unroll
            for (int g4 = 0; g4 < 4; ++g4) { const f32x4 gj4 = *(const LAS f32x4*)(gc + 32 * t2 + 8 * g4 + 4 * hh);
#pragma unroll
                for (int q = 0; q < 4; ++q) { const int idx = 4 * g4 + q; const int j = 32 * t2 + crow16(idx, hh); const float e = __expf(fminf(gi - gj4[q], 0.f)) * gram[idx]; const bool ok = d ? (j >= i) : (j <= i); o[idx] = ok ? e : 0.f; } }
            float x0[8], x1[8];
#pragma unroll
            for (int j = 0; j < 8; ++j) { x0[j] = o[j]; x1[j] = o[8 + j]; }
            bf16_t* ap = (bf16_t*)(scr + SC_DN_AQK + drec * 8192) + i * 64 + 32 * t2 + 8 * hh;
            *(u32x4*)ap = pack8(x0); *(u32x4*)(ap + 16) = pack8(x1);
        } else {
            const int j = 32 * t2 + r; const float gj = gc[j]; const int pj = d ? 63 - j : j;
#pragma unroll
            for (int g4 = 0; g4 < 4; ++g4) { const f32x4 gi4 = *(const LAS f32x4*)(gc + 32 * t1 + 8 * g4 + 4 * hh), be4 = *(const LAS f32x4*)(be + 32 * t1 + 8 * g4 + 4 * hh);
#pragma unroll
                for (int q = 0; q < 4; ++q) { const int idx = 4 * g4 + q; const int i = 32 * t1 + crow16(idx, hh); const int pi = d ? 63 - i : i;
                    const float v = be4[q] * gram[idx] * __expf(fminf(gi4[q] - gj, 0.f)); Ap[d * 4096 + pi * 64 + pj] = (pj < pi) ? v : 0.f; } }
        }
        if (tid < 64) { const float gtot = d ? gc[0] : gc[63]; float* sc = (float*)(scr + SC_DN_SC + drec * 1024);
            const float eg = __expf(gc[tid]); sc[tid] = eg; sc[64 + tid] = __expf(gtot - gc[tid]); if (tid == 0) sc[128] = __expf(gtot); sm[d * 256 + 192 + tid] = eg; }
    }
    LBAR();
    PT_STOP(2, a.ws); PT_START(3);
#if defined(DN_SOLVE_VALU)
    if (wave < 2) {
        const int d = wave; LAS float* TL = TLb + d * 4352;
        trisolve64(Ap + d * 4096, TL, lane);
        const int j = d ? 63 - lane : lane; const float bj = sm[d * 256 + 128 + j], ej = sm[d * 256 + 192 + j]; const int pj2 = permpos(j) * 2;
        LAS unsigned char* T1 = Tp + d * 18432; LAS unsigned char* T2 = T1 + 9216;
#pragma unroll 4
        for (int pi = 0; pi < 64; ++pi) { const int i = d ? 63 - pi : pi; const float v1 = TL[lane * 68 + pi] * bj;
            *(LAS bf16_t*)(T1 + i * 144 + pj2) = f2bf(v1); *(LAS bf16_t*)(T2 + i * 144 + pj2) = f2bf(v1 * ej); }
    }
#else
    {
        LAS unsigned char* EA = c.lds + LDS_SCR;
        LAS unsigned char* EB = EA + 9216;
        LAS unsigned char* S1 = EB + 9216;
        LAS unsigned char* MA = S1 + 9216;
        LAS unsigned char* S2 = c.lds + LDS_SCR + 73728;
#pragma unroll 1
        for (int d = 0; d < 2; ++d) {
            const LAS float* Ad = Ap + d * 4096;
            {   const u32x4 z = {0u, 0u, 0u, 0u};
                for (int p16 = tid; p16 < 2 * 576; p16 += 512) *(LAS u32x4*)(EA + p16 * 16) = z;
                const int j = tid >> 3, i8 = (tid & 7) * 8; float nv[8];
#pragma unroll
                for (int ii = 0; ii < 8; ++ii) { const int i = i8 + ii; const float v = Ad[i * 64 + j]; nv[ii] = ((i >> 4) > (j >> 4)) ? v : 0.f; }
                *(LAS u32x4*)(S1 + j * 144 + i8 * 2) = pack8(nv); }
            LBAR();
            if (wave == 0) {
                const int bq = lane >> 4, cq = lane & 15; float e[16];
#pragma unroll
                for (int rr = 0; rr < 16; ++rr) e[rr] = (rr == cq) ? 1.f : 0.f;
#pragma unroll
                for (int rr = 1; rr < 16; ++rr) {
#pragma unroll
                    for (int q4 = 0; q4 < (rr + 3) / 4; ++q4) { const f32x4 a4 = *(const LAS f32x4*)(Ad + (16 * bq + rr) * 64 + 16 * bq + 4 * q4);
#pragma unroll
                        for (int jj = 0; jj < 4; ++jj) if (4 * q4 + jj < rr) e[rr] -= a4[jj] * e[4 * q4 + jj]; } }
#pragma unroll
                for (int rr = 0; rr < 16; ++rr) *(LAS bf16_t*)(EA + (16 * bq + rr) * 144 + (16 * bq + cq) * 2) = f2bf(e[rr]);
                float x0[8], x1[8];
#pragma unroll
                for (int jj = 0; jj < 8; ++jj) { x0[jj] = e[jj]; x1[jj] = e[8 + jj]; }
                *(LAS u32x4*)(EB + (16 * bq + cq) * 144 + 32 * bq) = pack8(x0); *(LAS u32x4*)(EB + (16 * bq + cq) * 144 + 32 * bq + 16) = pack8(x1);
            }
            LBAR();
            const int it = (wave >> 1) & 1, jt = wave & 1;
            f32x16 aM, aM2, aT;
#pragma unroll
            for (int i = 0; i < 16; ++i) { aM[i] = 0.f; aM2[i] = 0.f; aT[i] = 0.f; }
            if (wave < 4) {
#pragma unroll
                for (int ks = 0; ks < 4; ++ks) aM = MFMA32(*(const LAS bf16x8*)(EA + (32 * it + r) * 144 + ks * 32 + hh * 16), *(const LAS bf16x8*)(S1 + (32 * jt + r) * 144 + ks * 32 + hh * 16), aM);
#pragma unroll
                for (int i = 0; i < 16; ++i) *(LAS bf16_t*)(MA + (32 * it + crow16(i, hh)) * 144 + (32 * jt + r) * 2) = f2bf(aM[i]);
#pragma unroll
                for (int g4 = 0; g4 < 4; ++g4) { u32x2 w; w.x = pg8::cvt_pk_bf16_safe(aM[4 * g4], aM[4 * g4 + 1]); w.y = pg8::cvt_pk_bf16_safe(aM[4 * g4 + 2], aM[4 * g4 + 3]);
                    *(LAS u32x2*)(S2 + (32 * jt + r) * 144 + (32 * it + 8 * g4 + 4 * hh) * 2) = w; }
            }
            LBAR();
            if (wave < 4) {
#pragma unroll
                for (int ks = 0; ks < 4; ++ks) aM2 = MFMA32(*(const LAS bf16x8*)(MA + (32 * it + r) * 144 + ks * 32 + hh * 16), *(const LAS bf16x8*)(S2 + (32 * jt + r) * 144 + ks * 32 + hh * 16), aM2);
#pragma unroll
                for (int g4 = 0; g4 < 4; ++g4) { u32x2 w; w.x = pg8::cvt_pk_bf16_safe(aM2[4 * g4], aM2[4 * g4 + 1]); w.y = pg8::cvt_pk_bf16_safe(aM2[4 * g4 + 2], aM2[4 * g4 + 3]);
                    *(LAS u32x2*)(S1 + (32 * jt + r) * 144 + (32 * it + 8 * g4 + 4 * hh) * 2) = w; }
            }
            LBAR();
            if (wave < 4) {
                f32x16 aM3;
#pragma unroll
                for (int i = 0; i < 16; ++i) aM3[i] = 0.f;
#pragma unroll
                for (int ks = 0; ks < 4; ++ks) aM3 = MFMA32(*(const LAS bf16x8*)(MA + (32 * it + r) * 144 + ks * 32 + hh * 16), *(const LAS bf16x8*)(S1 + (32 * jt + r) * 144 + ks * 32 + hh * 16), aM3);
#pragma unroll
                for (int i = 0; i < 16; ++i) { const int pp = 32 * it + crow16(i, hh), qq = 32 * jt + r; const float qv = ((pp == qq) ? 1.f : 0.f) - aM[i] + aM2[i] - aM3[i];
                    *(LAS bf16_t*)(S2 + pp * 144 + qq * 2) = f2bf(qv); }
            }
            LBAR();
            if (wave < 4) {
#pragma unroll
                for (int ks = 0; ks < 4; ++ks) aT = MFMA32(*(const LAS bf16x8*)(S2 + (32 * it + r) * 144 + ks * 32 + hh * 16), *(const LAS bf16x8*)(EB + (32 * jt + r) * 144 + ks * 32 + hh * 16), aT);
                const int qq = 32 * jt + r, j = d ? 63 - qq : qq; const float bj = sm[d * 256 + 128 + j], ej = sm[d * 256 + 192 + j]; const int pj2 = permpos(j) * 2;
                LAS unsigned char* T1 = Tp + d * 18432; LAS unsigned char* T2 = T1 + 9216;
#pragma unroll
                for (int i = 0; i < 16; ++i) { const int pp = 32 * it + crow16(i, hh), ii = d ? 63 - pp : pp; const float v1 = aT[i] * bj;
                    *(LAS bf16_t*)(T1 + ii * 144 + pj2) = f2bf(v1); *(LAS bf16_t*)(T2 + ii * 144 + pj2) = f2bf(v1 * ej); }
            }
            LBAR();
        }
    }
#endif
    LBAR();
    PT_STOP(3, a.ws); PT_START(4);
#pragma unroll 1
    for (int rep5_ = 0; rep5_ < ((PROBE_SUB & 64) ? 2 : 1); ++rep5_)
#pragma unroll 2
    for (int q = 0; q < 4; ++q) {
        const int tile = wave * 4 + q, d = tile >> 4, isw = (tile >> 3) & 1, it = (tile >> 2) & 1, xt = tile & 3;
        const size_t drec = (size_t)((d * 8 + b * 4 + h) * 260 + n);
        LAS unsigned char* T1 = Tp + d * 18432; LAS unsigned char* T2 = T1 + 9216;
        f32x16 acc;
#pragma unroll
        for (int i = 0; i < 16; ++i) acc[i] = 0.f;
        if (!isw) {
#pragma unroll
            for (int js = 0; js < 4; ++js) { const bf16x8 af = *(const LAS bf16x8*)(T1 + (32 * it + r) * 144 + js * 32 + hh * 16), bfr = *(const LAS bf16x8*)(VTp + (32 * xt + r) * 144 + js * 32 + hh * 16);
                acc = MFMA32(af, bfr, acc); }
            float x0[8], x1[8];
#pragma unroll
            for (int j = 0; j < 8; ++j) { x0[j] = acc[j]; x1[j] = acc[8 + j]; }
            bf16_t* up = (bf16_t*)(scr + SC_DN_UT + drec * 16384) + (32 * xt + r) * 64 + it * 32 + hh * 16;
            *(u32x4*)up = pack8(x0); *(u32x4*)(up + 8) = pack8(x1);
        } else {
#pragma unroll
            for (int js = 0; js < 4; ++js) { const bf16x8 af = *(const LAS bf16x8*)(KTp + (32 * xt + r) * 144 + js * 32 + hh * 16), bfr = *(const LAS bf16x8*)(T2 + (32 * it + r) * 144 + js * 32 + hh * 16);
                acc = MFMA32(af, bfr, acc); }
            float x0[8], x1[8];
#pragma unroll
            for (int j = 0; j < 8; ++j) { x0[j] = -acc[j]; x1[j] = -acc[8 + j]; }
            bf16_t* wp = (bf16_t*)(scr + SC_DN_WN + drec * 16384) + (32 * it + r) * 128 + 32 * xt + 8 * hh;
            *(u32x4*)wp = pack8(x0); *(u32x4*)(wp + 16) = pack8(x1);
        }
    }
    PT_STOP(4, a.ws); PT_STOP(5, a.ws);
}

struct DChunk { static constexpr int OFF_QS = 0, OFF_KT = 17408, OFF_WN = OFF_KT + 18432, OFF_AQK = OFF_WN + 17408, OFF_SC = OFF_AQK + 9216, BYTES = OFF_SC + 1024, NRL = 14; };
static_assert(DChunk::BYTES <= 65536, "two DeltaNet chunk images must fit the scratch region");
__device__ __forceinline__ void dchunk_issue(const unsigned char* scr, int b, int h, int d, int n, int lt, u32x4 (&pf)[DChunk::NRL], f32x4& scv) {
    const size_t drec = (size_t)((d * 8 + b * 4 + h) * 260 + n), rec = (size_t)((b * 4 + h) * 260 + n);
    const u32x4* qs = (const u32x4*)(scr + SC_DN_QS + rec * 16384); const u32x4* kt = (const u32x4*)(scr + SC_DN_KT + rec * 16384);
    const u32x4* wn = (const u32x4*)(scr + SC_DN_WN + drec * 16384); const u32x4* aq = (const u32x4*)(scr + SC_DN_AQK + drec * 8192);
#pragma unroll
    for (int i = 0; i < 4; ++i) { pf[i] = qs[i * 256 + lt]; pf[4 + i] = kt[i * 256 + lt]; pf[8 + i] = wn[i * 256 + lt]; }
    pf[12] = aq[lt]; pf[13] = aq[256 + lt];
    if (lt < 64) scv = ((const f32x4*)(scr + SC_DN_SC + drec * 1024))[lt];
}
__device__ __forceinline__ void dchunk_commit(LAS unsigned char* buf, int lt, const u32x4 (&pf)[DChunk::NRL], const f32x4 scv) {
    typedef DChunk G;
#pragma unroll
    for (int i = 0; i < 4; ++i) { const int p = i * 256 + lt;
        *(LAS u32x4*)(buf + G::OFF_QS + (p >> 4) * 272 + (p & 15) * 16) = pf[i];
        *(LAS u32x4*)(buf + G::OFF_KT + (p >> 3) * 144 + (p & 7) * 16) = pf[4 + i];
        *(LAS u32x4*)(buf + G::OFF_WN + (p >> 4) * 272 + (p & 15) * 16) = pf[8 + i]; }
#pragma unroll
    for (int i = 0; i < 2; ++i) { const int p = i * 256 + lt; *(LAS u32x4*)(buf + G::OFF_AQK + (p >> 3) * 144 + (p & 7) * 16) = pf[12 + i]; }
    if (lt < 64) *(LAS f32x4*)(buf + G::OFF_SC + lt * 16) = scv;
}
__device__ __forceinline__ void dchunk_loadu(const unsigned char* scr, int b, int h, int d, int n, int vs, int lane, u32x4 (&uu)[4]) {
    const size_t drec = (size_t)((d * 8 + b * 4 + h) * 260 + n); const int r = lane & 31, hh = lane >> 5;
    const u32x4* up = (const u32x4*)(scr + SC_DN_UT + drec * 16384 + (32 * vs + r) * 128 + hh * 32);
    uu[0] = up[0]; uu[1] = up[1]; uu[2] = up[4]; uu[3] = up[5];
}
__device__ __forceinline__ void dchunk_compute(LAS unsigned char* buf, f32x16 (&S)[4], bf16_t* orow, int vs, int lane, u32x4 (&uu)[4], const u32x4* unext) {
    typedef DChunk G; const int r = lane & 31, hh = lane >> 5;
    const LAS unsigned char* wq = buf + r * 272 + hh * 16;
    const LAS unsigned char* aqp = buf + G::OFF_AQK + r * 144 + hh * 16;
    const LAS unsigned char* ktp = buf + G::OFF_KT + r * 144 + hh * 16;
#define DN_LDWQ(F, kt, it) do { F[0] = *(const LAS bf16x8*)(wq + G::OFF_WN + (it) * 8704 + (2 * (kt)) * 32); F[1] = *(const LAS bf16x8*)(wq + G::OFF_WN + (it) * 8704 + (2 * (kt) + 1) * 32); \
        F[2] = *(const LAS bf16x8*)(wq + G::OFF_QS + (it) * 8704 + (2 * (kt)) * 32); F[3] = *(const LAS bf16x8*)(wq + G::OFF_QS + (it) * 8704 + (2 * (kt) + 1) * 32); } while (0)
#define DN_MMWQ(F, it) do { vn[it] = MFMA32(F[0], b0, vn[it]); o[it] = MFMA32(F[2], b0, o[it]); vn[it] = MFMA32(F[1], b1, vn[it]); o[it] = MFMA32(F[3], b1, o[it]); } while (0)
#define DN_SB() __builtin_amdgcn_sched_barrier(0)
    f32x16 vn[2], o[2];
    bf16x8 fa[4], fb[4];
    DN_LDWQ(fa, 0, 0);
#pragma unroll
    for (int it = 0; it < 2; ++it) { const u32x4 u0 = uu[2 * it], u1 = uu[2 * it + 1];
        float f0[8], f1[8]; unpack8(u0, f0); unpack8(u1, f1);
#pragma unroll
        for (int j = 0; j < 8; ++j) { vn[it][j] = f0[j]; vn[it][8 + j] = f1[j]; o[it][j] = 0.f; o[it][8 + j] = 0.f; } }
    if (unext) { uu[0] = unext[0]; uu[1] = unext[1]; uu[2] = unext[4]; uu[3] = unext[5]; }
    {   bf16x8 b0 = pack_step<0>(S[0]), b1 = pack_step<1>(S[0]);
        DN_LDWQ(fb, 0, 1); DN_SB(); DN_MMWQ(fa, 0); DN_SB();
        DN_LDWQ(fa, 1, 0); DN_SB(); DN_MMWQ(fb, 1); DN_SB();
        b0 = pack_step<0>(S[1]); b1 = pack_step<1>(S[1]);
        DN_LDWQ(fb, 1, 1); DN_SB(); DN_MMWQ(fa, 0); DN_SB();
        DN_LDWQ(fa, 2, 0); DN_SB(); DN_MMWQ(fb, 1); DN_SB();
        b0 = pack_step<0>(S[2]); b1 = pack_step<1>(S[2]);
        DN_LDWQ(fb, 2, 1); DN_SB(); DN_MMWQ(fa, 0); DN_SB();
        DN_LDWQ(fa, 3, 0); DN_SB(); DN_MMWQ(fb, 1); DN_SB();
        b0 = pack_step<0>(S[3]); b1 = pack_step<1>(S[3]);
        DN_LDWQ(fb, 3, 1); DN_SB(); DN_MMWQ(fa, 0); DN_SB();
#pragma unroll
        for (int js = 0; js < 4; ++js) fa[js] = *(const LAS bf16x8*)(aqp + js * 32);
        DN_SB(); DN_MMWQ(fb, 1); DN_SB(); }
#pragma unroll
    for (int it = 0; it < 2; ++it) { f32x4 eg[4];
#pragma unroll
        for (int g = 0; g < 4; ++g) eg[g] = *(const LAS f32x4*)(buf + G::OFF_SC + (32 * it + 8 * g + 4 * hh) * 4);
#pragma unroll
        for (int g = 0; g < 4; ++g)
#pragma unroll
            for (int j = 0; j < 4; ++j) o[it][4 * g + j] *= eg[g][j]; }
    {   const bf16x8 p00 = pack_step<0>(vn[0]), p01 = pack_step<1>(vn[0]), p10 = pack_step<0>(vn[1]), p11 = pack_step<1>(vn[1]);
#pragma unroll
        for (int js = 0; js < 4; ++js) fb[js] = *(const LAS bf16x8*)(aqp + 4608 + js * 32);
        DN_SB();
        o[0] = MFMA32(fa[0], p00, o[0]); o[0] = MFMA32(fa[1], p01, o[0]); o[0] = MFMA32(fa[2], p10, o[0]); o[0] = MFMA32(fa[3], p11, o[0]); DN_SB();
#pragma unroll
        for (int js = 0; js < 4; ++js) fa[js] = *(const LAS bf16x8*)(ktp + js * 32);
        DN_SB();
        o[1] = MFMA32(fb[0], p00, o[1]); o[1] = MFMA32(fb[1], p01, o[1]); o[1] = MFMA32(fb[2], p10, o[1]); o[1] = MFMA32(fb[3], p11, o[1]); DN_SB(); }
#pragma unroll
    for (int jt = 0; jt < 2; ++jt) { f32x4 ek[4];
#pragma unroll
        for (int g = 0; g < 4; ++g) ek[g] = *(const LAS f32x4*)(buf + G::OFF_SC + 256 + (32 * jt + 8 * g + 4 * hh) * 4);
#pragma unroll
        for (int g = 0; g < 4; ++g)
#pragma unroll
            for (int j = 0; j < 4; ++j) vn[jt][4 * g + j] *= ek[g][j]; }
    const float glast = *(const LAS float*)(buf + G::OFF_SC + 512);
    const bf16x8 q00 = pack_step<0>(vn[0]), q01 = pack_step<1>(vn[0]), q10 = pack_step<0>(vn[1]), q11 = pack_step<1>(vn[1]);
    DN_SB();
#define DN_SUPD(F, kt) do { _Pragma("unroll") for (int i = 0; i < 16; ++i) S[kt][i] *= glast; \
        S[kt] = MFMA32(F[0], q00, S[kt]); S[kt] = MFMA32(F[1], q01, S[kt]); S[kt] = MFMA32(F[2], q10, S[kt]); S[kt] = MFMA32(F[3], q11, S[kt]); } while (0)
#define DN_LDK(F, kt) do { _Pragma("unroll") for (int js = 0; js < 4; ++js) F[js] = *(const LAS bf16x8*)(ktp + (kt) * 4608 + js * 32); } while (0)
    DN_LDK(fb, 1); DN_SB(); DN_SUPD(fa, 0); DN_SB();
    DN_LDK(fa, 2); DN_SB(); DN_SUPD(fb, 1); DN_SB();
    DN_LDK(fb, 3); DN_SB(); DN_SUPD(fa, 2); DN_SB();
    DN_SUPD(fb, 3); DN_SB();
#pragma unroll
    for (int it = 0; it < 2; ++it)
#pragma unroll
        for (int i = 0; i < 16; ++i) orow[(size_t)(32 * it + crow16(i, hh)) * 2048 + 32 * vs + r] = f2bf(o[it][i]);
#undef DN_LDWQ
#undef DN_MMWQ
#undef DN_SUPD
#undef DN_LDK
#undef DN_SB
}
template <int L>
__device__ __forceinline__ void chain_dnc(const Ctx& c, int b, int h, int d, int vh) {
    ARGS_REF a = *c.a;
    const unsigned char* scr = a.ws + WS_SCR;
    LAS unsigned char* buf = c.lds + LDS_SCR;
#define CHUNK_OF(m) (d ? ((m) < 4 ? 3 - (m) : 263 - (m)) : (m))
    __syncthreads();
    if (c.wave >= 2 && c.wave < 4) { LBAR();
#pragma unroll 1
        for (int m = 0; m < 260; ++m) LBAR(); }
    else if (c.wave < 2) {
        const int vs = vh * 2 + c.wave;
        bf16_t* ORAW = (bf16_t*)(a.ws + WS_ORAW) + (size_t)d * MT * 2048 + 2 * 512 + h * 128;
        f32x16 S[4];
#pragma unroll
        for (int kt = 0; kt < 4; ++kt)
#pragma unroll
            for (int i = 0; i < 16; ++i) S[kt][i] = 0.f;
        u32x4 ua[4];
        dchunk_loadu(scr, b, h, d, CHUNK_OF(0), vs, c.lane, ua);
        LBAR();
#pragma unroll 1
        for (int m = 0; m < 260; ++m) {
            const int nn = CHUNK_OF(m + 1);
            const u32x4* unext = (m + 1 < 260) ? (const u32x4*)(scr + SC_DN_UT + (size_t)((d * 8 + b * 4 + h) * 260 + nn) * 16384 + (32 * vs + (c.lane & 31)) * 128 + (c.lane >> 5) * 32) : nullptr;
            dchunk_compute(buf + (m & 1) * 65536, S, ORAW + chunk_rowbase(b, CHUNK_OF(m)) * 2048, vs, c.lane, ua, unext);
            LBAR();
        }
    } else {
        const int lt = c.tid - 256;
        u32x4 p0[DChunk::NRL], p1[DChunk::NRL], p2[DChunk::NRL]; f32x4 s0 = {0.f, 0.f, 0.f, 0.f}, s1 = s0, s2 = s0;
        dchunk_issue(scr, b, h, d, CHUNK_OF(0), lt, p0, s0);
        dchunk_issue(scr, b, h, d, CHUNK_OF(1), lt, p1, s1);
        dchunk_issue(scr, b, h, d, CHUNK_OF(2), lt, p2, s2);
        dchunk_commit(buf, lt, p0, s0);
        dchunk_issue(scr, b, h, d, CHUNK_OF(3), lt, p0, s0);
        LBAR();
#pragma unroll 1
        for (int m = 0; m < 258; m += 3) {
            dchunk_commit(buf + ((m + 1) & 1) * 65536, lt, p1, s1); if (m + 4 < 260) dchunk_issue(scr, b, h, d, CHUNK_OF(m + 4), lt, p1, s1); LBAR();
            dchunk_commit(buf + ((m + 2) & 1) * 65536, lt, p2, s2); if (m + 5 < 260) dchunk_issue(scr, b, h, d, CHUNK_OF(m + 5), lt, p2, s2); LBAR();
            dchunk_commit(buf + ((m + 3) & 1) * 65536, lt, p0, s0); if (m + 6 < 260) dchunk_issue(scr, b, h, d, CHUNK_OF(m + 6), lt, p0, s0); LBAR();
        }
        dchunk_commit(buf + (259 & 1) * 65536, lt, p1, s1); LBAR();
        LBAR();
    }
#undef CHUNK_OF
}

__device__ __forceinline__ void rgw_convert(const Ctx& c) {
    ARGS_REF a = *c.a; bf16_t* dst = (bf16_t*)(a.ws + WS_RGW);
    for (int e = c.wg * 512 + c.tid; e < 32 * 16384; e += c.G * 512) { const int m = e >> 14, oc = (e >> 7) & 127, cc = e & 127, l = m >> 4, d = (m >> 3) & 1, n = (m >> 1) & 3, g = m & 1;
        const float* src = g ? a.in[I_RG_WI] : a.in[I_RG_WR];
        dst[e] = f2bf(src[((size_t)(((l * 2 + d) * 4 + n) * 128 + cc)) * 128 + oc]); }
}
template <int L>
__device__ __forceinline__ void rgprep_item2(const Ctx& c, int item) {
    ARGS_REF a = *c.a; const int tid = c.tid, lane = c.lane, wave = c.wave;
    LAS unsigned char* XB = c.lds + LDS_SCR;
    LAS float* xbT = (LAS float*)(c.lds + LDS_SCR + 17408);
    LAS float* PRE = (LAS float*)(c.lds + LDS_SCR + 52224);
    LAS float* SEG = (LAS float*)(c.lds + LDS_AUX);
    const bf16_t* PM = (const bf16_t*)(a.ws + WS_PMIX);
    bf16_t* RGLA = (bf16_t*)(a.ws + WS_RGLA); bf16_t* ORAW = (bf16_t*)(a.ws + WS_ORAW);
    float* TT = (float*)(a.ws + WS_RGTT);
    const float* cw = a.in[I_RG_CW] + L * 4 * 512; const float* cb = a.in[I_RG_CB] + L * 512;
    const int tt = item >> 2, n = item & 3;
    size_t rowbase; int t0, Ls, bb, nchunk;
    if (tt < 512) { bb = tt >> 8; rowbase = (size_t)bb * T; t0 = (tt & 255) * 64; Ls = T; nchunk = 4 + (tt & 255); }
    else { const int tc = tt - 512; bb = tc >> 2; rowbase = (size_t)ML + bb * CL; t0 = (tc & 3) * 64; Ls = CL; nchunk = tc & 3; }
    LBAR();
#pragma unroll 1
    for (int repc_ = 0; repc_ < ((PROBE_SUB & 1024) ? 2 : 1); ++repc_)
    {
        const int tl = tid >> 3, cg = tid & 7, ch0 = n * 128 + cg * 16;
        float acc[16];
#pragma unroll
        for (int q4 = 0; q4 < 4; ++q4) { const f32x4 b4 = *(const f32x4*)(cb + ch0 + 4 * q4);
#pragma unroll
            for (int j = 0; j < 4; ++j) acc[4 * q4 + j] = b4[j]; }
#pragma unroll
        for (int tap = 0; tap < 4; ++tap) { const int ts = t0 + tl + tap - 2;
            if (ts >= 0 && ts < Ls) { const bf16_t* rp = PM + (rowbase + ts) * NMIXP + C_RG_X + ch0; const u32x4 w0 = *(const u32x4*)rp, w1 = *(const u32x4*)(rp + 8);
                float f[8], g[8]; unpack8(w0, f); unpack8(w1, g); float wv[16];
#pragma unroll
                for (int q4 = 0; q4 < 4; ++q4) { const f32x4 a4 = *(const f32x4*)(cw + tap * 512 + ch0 + 4 * q4);
#pragma unroll
                    for (int j = 0; j < 4; ++j) wv[4 * q4 + j] = a4[j]; }
#pragma unroll
                for (int j = 0; j < 8; ++j) { acc[j] += wv[j] * f[j]; acc[8 + j] += wv[8 + j] * g[j]; } } }
#pragma unroll
        for (int j = 0; j < 16; ++j) xbT[(cg * 16 + j) * 68 + tl] = acc[j];
        float x0[8], x1[8];
#pragma unroll
        for (int j = 0; j < 8; ++j) { x0[j] = acc[j]; x1[j] = acc[8 + j]; }
        *(LAS u32x4*)(XB + tl * 272 + cg * 32) = pack8(x0); *(LAS u32x4*)(XB + tl * 272 + cg * 32 + 16) = pack8(x1);
    }
    LBAR();
    const int r = lane & 31, hh = lane >> 5, tth = wave & 1, ot = wave >> 1;
    const int oc = tid & 127, tq = tid >> 7, ch = n * 128 + oc;
#pragma unroll 1
    for (int dd_ = 0; dd_ < ((PROBE_SUB & 2048) ? 4 : 2); ++dd_) { const int d = dd_ & 1;
        {
            const bf16_t* wbase = (const bf16_t*)(a.ws + WS_RGW) + (size_t)(((L * 2 + d) * 4 + n) * 2) * 16384 + (32 * ot + r) * 128 + hh * 8;
#pragma unroll
            for (int g = 0; g < 2; ++g) { f32x16 acc;
#pragma unroll
                for (int i = 0; i < 16; ++i) acc[i] = 0.f;
#pragma unroll
                for (int ks = 0; ks < 8; ++ks) { const bf16x8 af = *(const LAS bf16x8*)(XB + (32 * tth + r) * 272 + ks * 32 + hh * 16); const bf16x8 bfr = *(const bf16x8*)(wbase + g * 16384 + ks * 16);
                    acc = MFMA32(af, bfr, acc); }
#pragma unroll
                for (int gq = 0; gq < 4; ++gq) { f32x4 v = {acc[4 * gq], acc[4 * gq + 1], acc[4 * gq + 2], acc[4 * gq + 3]};
                    *(LAS f32x4*)(PRE + (g * 128 + 32 * ot + r) * 68 + 32 * tth + 8 * gq + 4 * hh) = v; } }
        }
        LBAR();
#pragma unroll 1
        for (int repe_ = 0; repe_ < ((PROBE_SUB & 4096) ? 2 : 1); ++repe_)
        {
            const float br = a.in[I_RG_BR][(L * 2 + d) * 512 + ch], bi = a.in[I_RG_BI][(L * 2 + d) * 512 + ch];
            const float sp = softplusf(-a.in[I_RG_LAM][(L * 2 + d) * 512 + ch]);
            float la[16], hl[16];
#pragma unroll
            for (int q = 0; q < 4; ++q) { const f32x4 pr = *(const LAS f32x4*)(PRE + oc * 68 + 16 * tq + 4 * q), pi = *(const LAS f32x4*)(PRE + (128 + oc) * 68 + 16 * tq + 4 * q), xv = *(const LAS f32x4*)(xbT + oc * 68 + 16 * tq + 4 * q);
#pragma unroll
                for (int j = 0; j < 4; ++j) { const float rr = sigm(pr[j] + br), ig = sigm(pi[j] + bi); const float l = -8.0f * rr * sp;
                    la[4 * q + j] = l; hl[4 * q + j] = __builtin_amdgcn_sqrtf(fmaxf(1.0f - __expf(2.0f * l), 0.f)) * (ig * xv[j]); } }
            float hrun = 0.f, lrun = 0.f;
            if (d == 0) {
#pragma unroll
                for (int j = 0; j < 16; ++j) { hrun = __expf(la[j]) * hrun + hl[j]; lrun += la[j]; hl[j] = hrun; la[j] = lrun; } }
            else {
#pragma unroll
                for (int j = 15; j >= 0; --j) { hrun = __expf(la[j]) * hrun + hl[j]; lrun += la[j]; hl[j] = hrun; la[j] = lrun; } }
            SEG[(tq * 128 + oc) * 2] = lrun; SEG[(tq * 128 + oc) * 2 + 1] = hrun;
            LBAR();
            float Hin = 0.f, Lin = 0.f, Htot = 0.f, Ltot = 0.f;
#pragma unroll
            for (int s = 0; s < 4; ++s) { const int sg = d ? 3 - s : s; const float ls = SEG[(sg * 128 + oc) * 2], hs = SEG[(sg * 128 + oc) * 2 + 1];
                const bool before = d ? (sg > tq) : (sg < tq);
                if (before) { Hin = __expf(ls) * Hin + hs; Lin += ls; }
                Htot = __expf(ls) * Htot + hs; Ltot += ls; }
            LAS unsigned char* HT = (LAS unsigned char*)PRE; LAS unsigned char* PT = HT + 34816;
            const float eLin = __expf(Lin);
#pragma unroll
            for (int j = 0; j < 16; ++j) { const float e = __expf(la[j]);
                *(LAS bf16_t*)(HT + (16 * tq + j) * 256 + oc * 2) = f2bf(hl[j] + e * Hin);
                *(LAS bf16_t*)(PT + (16 * tq + j) * 256 + oc * 2) = f2bf(e * eLin); }
            if (tq == 0) { float* tp = TT + ((size_t)((d * 2 + bb) * 260 + nchunk) * 512 + ch) * 2; tp[0] = __expf(Ltot); tp[1] = Htot; }
            LBAR();
            const size_t ob = ((size_t)d * MT + rowbase + t0);
#pragma unroll
            for (int i = 0; i < 2; ++i) { const int p = i * 512 + tid, t = p >> 4, cc = p & 15;
                *(u32x4*)(ORAW + (ob + t) * 2048 + 1536 + n * 128 + cc * 8) = *(const LAS u32x4*)(HT + p * 16);
                *(u32x4*)(RGLA + (ob + t) * 512 + n * 128 + cc * 8) = *(const LAS u32x4*)(PT + p * 16); }
        }
        LBAR();
    }
}
__device__ __forceinline__ void rg_carry(const Ctx& c, int part) {
    ARGS_REF a = *c.a; const int gid = part * 512 + c.tid, d = gid >> 10, b = (gid >> 9) & 1, ch = gid & 511;
    typedef float f32x2v __attribute__((ext_vector_type(2)));
    const f32x2v* TT = (const f32x2v*)(a.ws + WS_RGTT) + (size_t)((d * 2 + b) * 260) * 512 + ch;
    float* CR = (float*)(a.ws + WS_RGCARRY) + (size_t)((d * 2 + b) * 260) * 512 + ch;
    float H = 0.f;
#pragma unroll 1
    for (int m0 = 0; m0 < 260; m0 += 20) { f32x2v p[20];
#pragma unroll
        for (int j = 0; j < 20; ++j) { const int m = m0 + j, nn = d ? (m < 4 ? 3 - m : 263 - m) : m; p[j] = TT[(size_t)nn * 512]; }
#pragma unroll
        for (int j = 0; j < 20; ++j) { const int m = m0 + j, nn = d ? (m < 4 ? 3 - m : 263 - m) : m; CR[(size_t)nn * 512] = H; H = p[j].x * H + p[j].y; } }
}
#ifndef PROBE_SUB
#define PROBE_SUB 0
#endif
template <int L> __device__ __forceinline__ void gemm_gate_part(const Ctx& c, int G2, int c2);
template <int L>
__device__ __forceinline__ void intra_phase(const Ctx& c) {
#pragma unroll 1
    for (int rep = 0; rep < ((PROBE_SUB & 1) ? 2 : 1); ++rep)
#pragma unroll 1
    for (int item = c.wg; item < 2080; item += c.G) rgprep_item2<L>(c, item);
#pragma unroll 1
    for (int rep = 0; rep < ((PROBE_SUB & 2) ? 2 : 1); ++rep)
#pragma unroll 1
    for (int item = (c.wg + 96) % c.G; item < 2080; item += c.G) { const int bh = item / 260, n = item % 260; intra_g_item<L, 0>(c, bh >> 2, bh & 3, n); }
#pragma unroll 1
    for (int rep = 0; rep < ((PROBE_SUB & 4) ? 2 : 1); ++rep)
#pragma unroll 1
    for (int item = (c.wg + 192) % c.G; item < 2080; item += c.G) { const int bh = item / 260, n = item % 260; intra_g_item<L, 1>(c, bh >> 2, bh & 3, n); }
#pragma unroll 1
    for (int rep = 0; rep < ((PROBE_SUB & 8) ? 2 : 1); ++rep)
#pragma unroll 1
    for (int item = (c.wg + 32) % c.G; item < 2080; item += c.G) { const int bh = item / 260, n = item % 260; intra_dn_item<L>(c, bh >> 2, bh & 3, n); }
}
template <int L>
__device__ __forceinline__ void chains_phase(const Ctx& c) {
    const int w = c.wg;
    if (w < 64) {
        if (w < 32) { const int r = w & 15, b = r >> 3, h = (r >> 1) & 3, d = r & 1;
            if (w < 16) { chain_g<L, 0>(c, b, h, d); if (PROBE_SUB & 65536) chain_g<L, 0>(c, b, h, d); }
            else { chain_g<L, 1>(c, b, h, d); if (PROBE_SUB & 32768) chain_g<L, 1>(c, b, h, d); } }
        else { const int r = w - 32, b = r >> 4, h = (r >> 2) & 3, d = (r >> 1) & 1, vh = r & 1; chain_dnc<L>(c, b, h, d, vh); }
    }
    else { if (w < 68) { rg_carry(c, w - 64); __syncthreads(); }
#pragma unroll 1
        for (int rep_ = 0; rep_ < ((PROBE_SUB & 8192) ? 2 : 1); ++rep_)
        gemm_gate_part<L>(c, c.G - 64, w < 68 ? c.G - 68 + (w - 64) : w - 68); }
}
template <int L>
__device__ __forceinline__ void combine_phase(const Ctx& c) {
    ARGS_REF a = *c.a; const int gw = c.wg * 8 + c.wave, nw = c.G * 8, lane = c.lane;
    const bf16_t* PM = (const bf16_t*)(a.ws + WS_PMIX); const bf16_t* O0 = (const bf16_t*)(a.ws + WS_ORAW); const bf16_t* O1 = O0 + (size_t)MT * 2048;
    bf16_t* O = (bf16_t*)(a.ws + WS_O);
    const int cb = lane * 8, hv = cb & 127;
    float nwv[3][8];
#pragma unroll
    for (int j = 0; j < 8; ++j) { nwv[0][j] = a.in[I_GLA_NW][L * 128 + hv + j]; nwv[1][j] = a.in[I_HG_NW][L * 128 + hv + j]; nwv[2][j] = a.in[I_DN_NW][L * 128 + hv + j]; }
    const int nrows = (L == 0) ? MT : ML;
    for (int r = gw; r < nrows; r += nw) {
        const bf16_t* pm = (const bf16_t*)(a.ws + WS_GC) + (size_t)r * 2048;
#pragma unroll
        for (int br = 0; br < 3; ++br) {
            const int gcol = br * 512;
            float x0[8], x1[8], g[8], o[8];
            { const u32x4 w = *(const u32x4*)(O0 + (size_t)r * 2048 + br * 512 + cb); unpack8(w, x0); }
            { const u32x4 w = *(const u32x4*)(O1 + (size_t)r * 2048 + br * 512 + cb); unpack8(w, x1); }
            { const u32x4 w = *(const u32x4*)(pm + gcol + cb); unpack8(w, g); }
            float ss = 0.f;
#pragma unroll
            for (int j = 0; j < 8; ++j) { o[j] = x0[j] + x1[j]; ss += o[j] * o[j]; }
            ss += __shfl_xor(ss, 1); ss += __shfl_xor(ss, 2); ss += __shfl_xor(ss, 4); ss += __shfl_xor(ss, 8);
            const float rs = __builtin_amdgcn_rsqf(ss * (1.0f / 128.0f) + EPS);
#pragma unroll
            for (int j = 0; j < 8; ++j) o[j] = o[j] * rs * nwv[br][j] * siluf(g[j]);
            *(u32x4*)(O + ((size_t)br * MT + r) * 512 + cb) = pack8(o);
        }
        {   float x0[8], x1[8], p0[8], p1[8], y[8], o[8];
            const int bb = r < ML ? (r >> 14) : ((r - ML) >> 8), nchunk = r < ML ? 4 + ((r & 16383) >> 6) : (((r - ML) & 255) >> 6);
            const bf16_t* RGLA = (const bf16_t*)(a.ws + WS_RGLA); const float* CR = (const float*)(a.ws + WS_RGCARRY);
            { const u32x4 w = *(const u32x4*)(O0 + (size_t)r * 2048 + 1536 + cb); unpack8(w, x0); }
            { const u32x4 w = *(const u32x4*)(O1 + (size_t)r * 2048 + 1536 + cb); unpack8(w, x1); }
            { const u32x4 w = *(const u32x4*)(RGLA + (size_t)r * 512 + cb); unpack8(w, p0); }
            { const u32x4 w = *(const u32x4*)(RGLA + ((size_t)MT + r) * 512 + cb); unpack8(w, p1); }
            { const u32x4 w = *(const u32x4*)(pm + 3 * 512 + cb); unpack8(w, y); }
            const float* c0 = CR + (size_t)((0 * 2 + bb) * 260 + nchunk) * 512 + cb; const float* c1 = CR + (size_t)((1 * 2 + bb) * 260 + nchunk) * 512 + cb;
            const f32x4 ca = *(const f32x4*)c0, cb2 = *(const f32x4*)(c0 + 4), cc = *(const f32x4*)c1, cd = *(const f32x4*)(c1 + 4);
#pragma unroll
            for (int j = 0; j < 8; ++j) { const float k0 = j < 4 ? ca[j & 3] : cb2[j & 3], k1 = j < 4 ? cc[j & 3] : cd[j & 3];
                o[j] = gelu_tanh(y[j]) * ((x0[j] + p0[j] * k0) + (x1[j] + p1[j] * k1)); }
            *(u32x4*)(O + ((size_t)3 * MT + r) * 512 + cb) = pack8(o);
        }
    }
}

__device__ __forceinline__ void route1_phase(const Ctx& c) {
    ARGS_REF a = *c.a; const int lane = c.lane;
    const float* modv = (const float*)(a.ws + WS_MOD) + (size_t)1 * 3 * 12288 + 3 * 2048;
    const float* normw = a.in[I_NORMW] + (1 * 2 + 1) * 2048;
    const float* router = a.in[I_ROUTER];
    bf16_t* H = (bf16_t*)(a.ws + WS_H);
    unsigned* topi = (unsigned*)(a.ws + WS_TOPI); float* topw = (float*)(a.ws + WS_TOPW);
    volatile LAS int* hist = (volatile LAS int*)(c.lds + LDS_AUX);
    if (c.tid < 8) hist[c.tid] = 0;
    LAS f32x4* RT = (LAS f32x4*)(c.lds + LDS_SCR);
#pragma unroll
    for (int i = 0; i < 8; ++i) { const int e = c.tid + 512 * i, k = e >> 6, ln = e & 63, cc = ((k >> 3) * 64 + ln) * 4 + ((k >> 1) & 3); RT[e] = *(const f32x4*)(router + cc * 8 + (k & 1) * 4); }
    __syncthreads();
    const int rpw = ML / c.G;
    u32x2 nx[8];
    { const bf16_t* p = (const bf16_t*)(a.out + (size_t)(c.wg * rpw + c.wave) * D);
#pragma unroll
      for (int j = 0; j < 8; ++j) nx[j] = *(const u32x2*)(p + (j * 64 + lane) * 4); }
    for (int rr = c.wave; rr < rpw; rr += 8) {
        const int r = c.wg * rpw + rr, b = r >> 14;
        f32x4 v[8];
#pragma unroll
        for (int j = 0; j < 8; ++j) { v[j][0] = bflo(nx[j].x); v[j][1] = bfhi(nx[j].x); v[j][2] = bflo(nx[j].y); v[j][3] = bfhi(nx[j].y); }
        if (rr + 8 < rpw) { const bf16_t* p = (const bf16_t*)(a.out + (size_t)(r + 8) * D);
#pragma unroll
            for (int j = 0; j < 8; ++j) nx[j] = *(const u32x2*)(p + (j * 64 + lane) * 4); }
        const float* shift = modv + (size_t)b * 12288;
        modnorm_row(v, normw, shift, shift + 2048, lane);
        { unsigned char* h8 = (unsigned char*)(a.ws + WS_H8) + (size_t)r * D;
#pragma unroll
            for (int j = 0; j < 8; ++j) *(unsigned*)(h8 + (j * 64 + lane) * 4) = pk_fp8x4(v[j][0] * 4.f, v[j][1] * 4.f, v[j][2] * 4.f, v[j][3] * 4.f); }
        float lg[8];
#pragma unroll
        for (int e = 0; e < 8; ++e) lg[e] = 0.f;
        LAS f32x4* rt = RT; asm volatile("" : "+v"(rt));
#pragma unroll
        for (int j = 0; j < 8; ++j)
#pragma unroll
            for (int q = 0; q < 4; ++q) { const f32x4 r0 = rt[((j * 4 + q) * 2) * 64 + lane], r1 = rt[((j * 4 + q) * 2 + 1) * 64 + lane]; const float x = v[j][q];
                lg[0] += x * r0[0]; lg[1] += x * r0[1]; lg[2] += x * r0[2]; lg[3] += x * r0[3]; lg[4] += x * r1[0]; lg[5] += x * r1[1]; lg[6] += x * r1[2]; lg[7] += x * r1[3]; }
#pragma unroll
        for (int e = 0; e < 8; ++e) lg[e] = wave_sum(lg[e]);
        int e0 = 0; float m0 = lg[0];
#pragma unroll
        for (int e = 1; e < 8; ++e) if (lg[e] > m0) { m0 = lg[e]; e0 = e; }
        int e1 = -1; float m1 = -3.0e38f;
#pragma unroll
        for (int e = 0; e < 8; ++e) if (e != e0 && lg[e] > m1) { m1 = lg[e]; e1 = e; }
        if (e1 < 0) { e1 = (e0 + 1) & 7; m1 = m0; }
        if (lane == 0) { const float ex = __expf(m1 - m0); const float w0 = 1.0f / (1.0f + ex); topi[r] = (unsigned)e0 | ((unsigned)e1 << 8); topw[2 * r] = w0; topw[2 * r + 1] = ex * w0;
            lds_add(&hist[e0]); lds_add(&hist[e1]); }
    }
    __syncthreads();
    if (c.tid < 8) ((int*)(a.ws + WS_CTL + CTL_WGH))[c.wg * 8 + c.tid] = hist[c.tid];
}
__device__ __forceinline__ void route2_phase(const Ctx& c) {
    ARGS_REF a = *c.a; const int lane = c.lane, tid = c.tid;
    const int* wgh = (const int*)(a.ws + WS_CTL + CTL_WGH);
    volatile LAS int* tab = (volatile LAS int*)(c.lds + LDS_AUX);
    if (tid < 8) { int tot = 0, base = 0; for (int w = 0; w < c.G; ++w) { const int v = wgh[w * 8 + tid]; tot += v; if (w < c.wg) base += v; } tab[tid] = tot; tab[8 + tid] = base; tab[24 + tid] = 0; tab[32 + tid] = (tot + 255) / 256 * 256; }
    __syncthreads();
    if (tid == 0) { int acc = 0; for (int e = 0; e < 8; ++e) { tab[16 + e] = acc; acc += tab[32 + e]; }
        if (c.wg == 0) { int* meta = (int*)(a.ws + WS_CTL + CTL_META); int cum = 0; for (int e = 0; e < 8; ++e) { cum += tab[32 + e] / 256; meta[e] = cum; } meta[8] = cum; } }
    __syncthreads();
    const unsigned char* H8 = (const unsigned char*)(a.ws + WS_H8); unsigned char* GATH8 = (unsigned char*)(a.ws + WS_GATH);
    const unsigned* topi = (const unsigned*)(a.ws + WS_TOPI); int* dest = (int*)(a.ws + WS_DEST);
    const int rpw = ML / c.G;
    unsigned ti_n = topi[c.wg * rpw + c.wave];
    for (int rr = c.wave; rr < rpw; rr += 8) {
        const int r = c.wg * rpw + rr; const unsigned ti = ti_n; const int e0 = ti & 255, e1 = (ti >> 8) & 255;
        const u32x4* spre = (const u32x4*)(H8 + (size_t)r * D); const u32x4 wpre0 = spre[lane], wpre1 = spre[64 + lane];
        if (rr + 8 < rpw) ti_n = topi[r + 8];
        int d0 = 0, d1 = 0;
        if (lane == 0) { d0 = tab[16 + e0] + tab[8 + e0] + lds_add(&tab[24 + e0]); d1 = tab[16 + e1] + tab[8 + e1] + lds_add(&tab[24 + e1]); dest[2 * r] = d0; dest[2 * r + 1] = d1; }
        d0 = __shfl(d0, 0); d1 = __shfl(d1, 0);
        u32x4* p0 = (u32x4*)(GATH8 + (size_t)d0 * D); u32x4* p1 = (u32x4*)(GATH8 + (size_t)d1 * D);
        p0[lane] = wpre0; p1[lane] = wpre0; p0[64 + lane] = wpre1; p1[64 + lane] = wpre1;
    }
    if (c.wg < 8) { const int e = c.wg; const int lo = tab[16 + e] + tab[e], hi = tab[16 + e] + tab[32 + e]; const u32x4 z = {0u, 0u, 0u, 0u};
        for (int r = lo + c.wave; r < hi; r += 8) { u32x4* p = (u32x4*)(GATH8 + (size_t)r * D);
#pragma unroll
            for (int j = 0; j < 2; ++j) p[j * 64 + lane] = z; } }
}
__device__ __forceinline__ void load_yrow8(f32x4 (&y)[8], const bf16_t* Y, const float* PM2, int d, int lane) {
    if (d < 65536) { const bf16_t* p = Y + (size_t)d * D;
#pragma unroll
        for (int j = 0; j < 8; ++j) { const u32x2 w = *(const u32x2*)(p + (j * 64 + lane) * 4); y[j][0] = bflo(w.x); y[j][1] = bfhi(w.x); y[j][2] = bflo(w.y); y[j][3] = bfhi(w.y); } }
    else { const float* p = PM2 + (size_t)(d - 65536) * D;
#pragma unroll
        for (int j = 0; j < 8; ++j) { const float* q = p + (j * 64 + lane) * 4;
            y[j] = ((*(const f32x4*)q + *(const f32x4*)(q + (size_t)2048 * D)) + (*(const f32x4*)(q + (size_t)2 * 2048 * D) + *(const f32x4*)(q + (size_t)3 * 2048 * D))) * (1.0f / 256.0f); } }
}
__device__ __forceinline__ void final_phase(const Ctx& c) {
    ARGS_REF a = *c.a; const int gw = c.wg * 8 + c.wave, nw = c.G * 8, lane = c.lane;
    const float* modv = (const float*)(a.ws + WS_MOD) + (size_t)1 * 3 * 12288 + 5 * 2048;
    const bf16_t* Y = (const bf16_t*)(a.ws + WS_GATH); const int* dest = (const int*)(a.ws + WS_DEST); const float* topw = (const float*)(a.ws + WS_TOPW);
    const float* fw = a.in[I_FNORMW]; const float* PM2 = (const float*)(a.ws + WS_PM2);
    for (int r = gw; r < ML; r += nw) {
        const int b = r >> 14; float* xr = a.out + (size_t)r * D; const float* mg = modv + (size_t)b * 12288;
        const int d0 = dest[2 * r], d1 = dest[2 * r + 1]; const float w0 = topw[2 * r], w1 = topw[2 * r + 1];
        f32x4 v[8], ya[8], yb[8]; float ss = 0.f;
        load_yrow8(ya, Y, PM2, d0, lane); load_yrow8(yb, Y, PM2, d1, lane);
#pragma unroll
        for (int j = 0; j < 8; ++j) { const int cc = (j * 64 + lane) * 4; const u32x2 xw = *(const u32x2*)((const bf16_t*)xr + cc); const f32x4 x = {bflo(xw.x), bfhi(xw.x), bflo(xw.y), bfhi(xw.y)}, g = *(const f32x4*)(mg + cc);
            const f32x4 m = w0 * ya[j] + w1 * yb[j];
            v[j] = x + g * m; ss += v[j][0] * v[j][0] + v[j][1] * v[j][1] + v[j][2] * v[j][2] + v[j][3] * v[j][3]; }
        ss = wave_sum(ss); float rstd = __builtin_amdgcn_rsqf(ss * (1.0f / 2048.0f) + EPS);
#ifdef PROBE_T
        { const unsigned long long tk = ((const unsigned long long*)(a.ws + WS_CTL + CTL_PT))[PROBE_T]; const float xq = floorf((float)tk * (0.01f / 256.0f / 1000.0f) * 25.0f) * 0.04f + 0.02f; rstd *= 1.0f + xq; }
#endif
#pragma unroll
        for (int j = 0; j < 8; ++j) { const int cc = (j * 64 + lane) * 4; const f32x4 w = *(const f32x4*)(fw + cc); *(f32x4*)(xr + cc) = v[j] * rstd * w; }
    }
}

#ifndef N_LAUNCHES
#define N_LAUNCHES 1
#endif
constexpr int N_PHASES = 23;
#ifndef WGM_BIGN
#define WGM_BIGN 4
#endif
#ifndef WGM_MOE
#define WGM_MOE 4
#endif
#ifndef WGM_MOE2
#define WGM_MOE2 4
#endif
#ifndef WGM_SMALLN
#define WGM_SMALLN 4
#endif

template <int L>
__device__ __forceinline__ void gemm_projmix(const Ctx& c) {
    ARGS_REF a = *c.a;
    pg8::Gemm g{(const bf16_t*)(a.ws + WS_H), (const bf16_t*)(a.ws + WS_WIN + (size_t)L * WIN_BYTES), MT, NMIXP, D};
    pg8::StaticOrder S; S.init(MT, NMIXP, c.G, c.wg, WGM_BIGN);
    pg8::EpiProjMix E{(bf16_t*)(a.ws + WS_PMIX), (bf16_t*)(a.ws + WS_GC)};
    pg8::gemm_phase<pg8::EpiProjMix, pg8::StaticOrder, true, true>(c.lds + LDS_SCR, g, S, E);
}
template <int L>
__device__ __forceinline__ void gemm_gate_part(const Ctx& c, int G2, int c2) {
    ARGS_REF a = *c.a; constexpr int M = (L == 0) ? MT : ML;
    pg8::Gemm g{(const bf16_t*)(a.ws + WS_H8), (const bf16_t*)(a.ws + WS_WG8 + (size_t)L * WG8_BYTES), M, NGATE, D / 2};
    pg8::StaticOrder S; S.init(M, NGATE, G2, c2, WGM_BIGN);
    pg8::EpiBf16S<true> E{(bf16_t*)(a.ws + WS_PGATE), NGATE, 1.0f / 256.0f};
    pg8::gemm_phase8<pg8::EpiBf16S<true>, pg8::StaticOrder, true, true>(c.lds + LDS_SCR, g, S, E);
}
template <int L>
__device__ __forceinline__ void gemm_upgate(const Ctx& c) {
    ARGS_REF a = *c.a; constexpr int M = ML;
    pg8::Gemm g{(const bf16_t*)(a.ws + WS_O), (const bf16_t*)(a.ws + WS_WUP + (size_t)L * 8388608), M, 2048, 512};
    {
        pg8::UpGateOrder S; S.init(M, c.G, c.wg, MT / 256, WGM_SMALLN);
        pg8::EpiUpGate E{(const bf16_t*)(a.ws + WS_PGATE), (bf16_t*)(a.ws + WS_MERGED), MT / 256};
        pg8::gemm_phase<pg8::EpiUpGate, pg8::UpGateOrder, true, true>(c.lds + LDS_SCR, g, S, E);
    }
    if (L == 0) {
        const int w = c.wg, t = w >> 2, b = w & 3;
        pg8::OneUnit S; S.u.pm = b * (MT / 256) + ML / 256 + (t >> 3); S.u.pn = b * 8 + (t & 7); S.has = w < 64;
        pg8::EpiGatePartial E{(const bf16_t*)(a.ws + WS_PGATE), (float*)(a.ws + WS_PU), MT / 256};
        pg8::gemm_phase<pg8::EpiGatePartial, pg8::OneUnit, true, true>(c.lds + LDS_SCR, g, S, E);
    }
}
template <int L>
__device__ __forceinline__ void gemm_wout(const Ctx& c) {
    ARGS_REF a = *c.a;
    {
        pg8::Gemm g{(const bf16_t*)(a.ws + WS_MERGED), (const bf16_t*)(a.ws + WS_WOUT + (size_t)L * 8388608), ML, D, D};
        pg8::StaticOrder S; S.init(ML, D, c.G, c.wg, WGM_SMALLN);
        const float* modv = (const float*)(a.ws + WS_MOD) + (size_t)L * 3 * 12288 + 2 * 2048;
        pg8::EpiResid<L == 0> E{L == 0 ? (const void*)a.in[I_X] : (const void*)a.out, (bf16_t*)a.out, modv, L == 1 ? 1 : 0};
        pg8::gemm_phase<pg8::EpiResid<L == 0>, pg8::StaticOrder, true, true>(c.lds + LDS_SCR, g, S, E);
    }
    if (L == 0) {
        const int ks = c.wg >> 4, t = c.wg & 15;
        if (c.wg < 128) {
            const float* PU = (const float*)(a.ws + WS_PU); bf16_t* MG = (bf16_t*)(a.ws + WS_MERGED) + (size_t)ML * 2048;
#pragma unroll 1
            for (int i = c.tid; i < 256 * 32; i += 512) { const int r = (t >> 3) * 256 + (i >> 5), col = ks * 256 + (i & 31) * 8; const float* p = PU + (size_t)r * 2048 + col;
                float f[8];
#pragma unroll
                for (int h = 0; h < 2; ++h) { const f32x4 s = (*(const f32x4*)(p + h * 4) + *(const f32x4*)(p + (size_t)MC * 2048 + h * 4)) + (*(const f32x4*)(p + (size_t)2 * MC * 2048 + h * 4) + *(const f32x4*)(p + (size_t)3 * MC * 2048 + h * 4));
                    f[h * 4] = s[0]; f[h * 4 + 1] = s[1]; f[h * 4 + 2] = s[2]; f[h * 4 + 3] = s[3]; }
                *(u32x4*)(MG + (size_t)r * 2048 + col) = pack8(f); }
            __threadfence();
        }
        __syncthreads();
        __atomic_thread_fence(__ATOMIC_ACQUIRE);
        pg8::Gemm g{(const bf16_t*)(a.ws + WS_MERGED) + (size_t)ks * 256, (const bf16_t*)(a.ws + WS_WOUT) + (size_t)ks * 256, MT, D, 256, D};
        pg8::OneUnit S; S.u.pm = ML / 256 + (t >> 3); S.u.pn = t & 7; S.has = c.wg < 128;
        pg8::EpiPartial E{(float*)(a.ws + WS_PW) + (size_t)ks * MC * D, ML};
        pg8::gemm_phase<pg8::EpiPartial, pg8::OneUnit, true, true>(c.lds + LDS_SCR, g, S, E);
    }
}
#ifndef FFN13_FP8
#define FFN13_FP8 1
#endif
#ifndef FFN2_FP8
#define FFN2_FP8 1
#endif
__device__ __forceinline__ void gemm_ffn13(const Ctx& c) {
    ARGS_REF a = *c.a;
    pg8::StaticOrder S; S.init(MT, 2 * FF, c.G, c.wg, WGM_BIGN);
#if FFN13_FP8
    pg8::Gemm g{(const bf16_t*)(a.ws + WS_H8), (const bf16_t*)(a.ws + WS_F13), MT, 2 * FF, D / 2};
    pg8::EpiSwiglu<FFN2_FP8 != 0> E{(void*)(a.ws + WS_HID), 2 * FF / 256, 1.0f / 256.0f};
    pg8::gemm_phase8<pg8::EpiSwiglu<FFN2_FP8 != 0>, pg8::StaticOrder, true, true>(c.lds + LDS_SCR, g, S, E);
#else
    pg8::Gemm g{(const bf16_t*)(a.ws + WS_H), (const bf16_t*)(a.ws + WS_F13), MT, 2 * FF, D};
    pg8::EpiSwiglu<false> E{(void*)(a.ws + WS_HID), 2 * FF / 256, 1.0f};
    pg8::gemm_phase<pg8::EpiSwiglu<false>, pg8::StaticOrder, true, true>(c.lds + LDS_SCR, g, S, E);
#endif
}
__device__ __forceinline__ void gemm_ffn2(const Ctx& c) {
    ARGS_REF a = *c.a;
    {
        pg8::StaticOrder S; S.init(ML, D, c.G, c.wg, WGM_SMALLN);
        const float* modv = (const float*)(a.ws + WS_MOD) + (size_t)0 * 3 * 12288 + 5 * 2048;
#if FFN2_FP8
        pg8::Gemm g{(const bf16_t*)(a.ws + WS_HID), (const bf16_t*)(a.ws + WS_F2), ML, D, FF / 2};
        pg8::EpiResid<false> E{(const void*)a.out, (bf16_t*)a.out, modv, 0, 1.0f / 256.0f};
        pg8::gemm_phase8<pg8::EpiResid<false>, pg8::StaticOrder, true, true>(c.lds + LDS_SCR, g, S, E);
#else
        pg8::Gemm g{(const bf16_t*)(a.ws + WS_HID), (const bf16_t*)(a.ws + WS_F2), ML, D, FF};
        pg8::EpiResid<false> E{(const void*)a.out, (bf16_t*)a.out, modv, 0};
        pg8::gemm_phase<pg8::EpiResid<false>, pg8::StaticOrder, true, true>(c.lds + LDS_SCR, g, S, E);
#endif
    }
    {
        const int ks = c.wg >> 4, t = c.wg & 15;
        pg8::OneUnit S; S.u.pm = ML / 256 + (t >> 3); S.u.pn = t & 7; S.has = c.wg < 176;
        pg8::EpiPartial E{(float*)(a.ws + WS_PF) + (size_t)ks * MC * D, ML};
#if FFN2_FP8
        pg8::Gemm g{(const bf16_t*)(a.ws + WS_HID) + (size_t)ks * 256, (const bf16_t*)(a.ws + WS_F2) + (size_t)ks * 256, MT, D, 256, FF / 2};
        pg8::gemm_phase8<pg8::EpiPartial, pg8::OneUnit, true, true>(c.lds + LDS_SCR, g, S, E);
#else
        pg8::Gemm g{(const bf16_t*)(a.ws + WS_HID) + (size_t)ks * 512, (const bf16_t*)(a.ws + WS_F2) + (size_t)ks * 512, MT, D, 512, FF};
        pg8::gemm_phase<pg8::EpiPartial, pg8::OneUnit, true, true>(c.lds + LDS_SCR, g, S, E);
#endif
    }
}
__device__ __forceinline__ void gemm_moe13(const Ctx& c) {
    ARGS_REF a = *c.a; const int* meta = (const int*)(a.ws + WS_CTL + CTL_META);
    int be[8];
#pragma unroll
    for (int e = 0; e < 8; ++e) be[e] = __builtin_amdgcn_readfirstlane(meta[e]);
    pg8::Gemm g{(const bf16_t*)(a.ws + WS_GATH), (const bf16_t*)(a.ws + WS_M13), MOE_ROWS, 2 * FF, D / 2};
    pg8::MoeOrder S; S.init(be[7], 2 * FF / 256, c.G, c.wg, be, WGM_MOE);
    pg8::EpiSwiglu<true> E{(void*)(a.ws + WS_HIDM), 2 * FF / 256, 1.0f / 256.0f};
    pg8::gemm_phase8<pg8::EpiSwiglu<true>, pg8::MoeOrder, true, true>(c.lds + LDS_SCR, g, S, E);
}
__device__ __forceinline__ void gemm_moe2(const Ctx& c) {
    ARGS_REF a = *c.a; const int* meta = (const int*)(a.ws + WS_CTL + CTL_META);
    int be[8];
#pragma unroll
    for (int e = 0; e < 8; ++e) be[e] = __builtin_amdgcn_readfirstlane(meta[e]);
    {
        pg8::Gemm g{(const bf16_t*)(a.ws + WS_HIDM), (const bf16_t*)(a.ws + WS_M2), MOE_ROWS, D, FF / 2};
        pg8::MoeOrder S; S.init(256, D / 256, c.G, c.wg, be, WGM_MOE2);
        pg8::EpiPlainBf16 E{(bf16_t*)(a.ws + WS_GATH), D, D / 256, 1.0f / 256.0f};
        pg8::gemm_phase8<pg8::EpiPlainBf16, pg8::MoeOrder, true, true>(c.lds + LDS_SCR, g, S, E);
    }
    {
        const int ntail = be[7] - 256, w = c.wg, rt = w >> 5, ct = (w >> 2) & 7, ks = w & 3;
        const int pm = 256 + rt; int e = 0;
#pragma unroll
        for (int j = 0; j < 7; ++j) e += (pm >= be[j]) ? 1 : 0;
        const int k0 = (ks >> 1) * 22 + (ks & 1) * 12, kn = (ks & 1) ? 10 : 12;
        pg8::Gemm g{(const bf16_t*)(a.ws + WS_HIDM) + (size_t)k0 * 64, (const bf16_t*)(a.ws + WS_M2) + (size_t)k0 * 64, MOE_ROWS, D, kn * 64, FF / 2};
        pg8::OneUnit S; S.u.pm = pm; S.u.pn = e * (D / 256) + ct; S.has = w < ntail * 32;
        pg8::EpiPartial E{(float*)(a.ws + WS_PM2) + (size_t)ks * 2048 * D, 65536, D / 256};
        pg8::gemm_phase8<pg8::EpiPartial, pg8::OneUnit, true, true>(c.lds + LDS_SCR, g, S, E);
    }
}

__device__ __forceinline__ void prologue_phase(const Ctx& c) {
    ARGS_REF a = *c.a; int rot = 0;
    mod_phase(c);
    rgw_convert(c);
    for (int l = 0; l < 2; ++l) {
        conv_job<1>(c, a.in[I_WIN] + (size_t)l * D * DIN, nullptr, DIN, D, NMIXP, (bf16_t*)(a.ws + WS_WIN + (size_t)l * WIN_BYTES), rot);
        conv_job8<0>(c, a.in[I_WIN] + (size_t)l * D * DIN + NMIX, nullptr, DIN, D, NGATE, (unsigned char*)(a.ws + WS_WG8 + (size_t)l * WG8_BYTES), 64.0f, rot);
        for (int b = 0; b < 4; ++b) conv_job<0>(c, a.in[I_WUP] + (size_t)(l * 4 + b) * 512 * D, nullptr, D, 512, D, (bf16_t*)(a.ws + WS_WUP + (size_t)l * 8388608 + (size_t)b * 2048 * 512 * 2), rot);
        conv_job<0>(c, a.in[I_WOUT] + (size_t)l * D * D, nullptr, D, D, D, (bf16_t*)(a.ws + WS_WOUT + (size_t)l * 8388608), rot);
    }
#if FFN13_FP8
    conv_job8<2>(c, a.in[I_F1], a.in[I_F3], FF, D, 2 * FF, (unsigned char*)(a.ws + WS_F13), 64.0f, rot);
#else
    conv_job<2>(c, a.in[I_F1], a.in[I_F3], FF, D, 2 * FF, (bf16_t*)(a.ws + WS_F13), rot);
#endif
#if FFN2_FP8
    conv_job8<0>(c, a.in[I_F2], nullptr, D, FF, D, (unsigned char*)(a.ws + WS_F2), 64.0f, rot);
#else
    conv_job<0>(c, a.in[I_F2], nullptr, D, FF, D, (bf16_t*)(a.ws + WS_F2), rot);
#endif
}
__device__ __forceinline__ void moeconv_phase(const Ctx& c) {
    ARGS_REF a = *c.a; int rot = 0;
    for (int e = 0; e < 8; ++e) {
        conv_job8<2>(c, a.in[I_M1] + (size_t)e * D * FF, a.in[I_M3] + (size_t)e * D * FF, FF, D, 2 * FF, (unsigned char*)(a.ws + WS_M13 + (size_t)e * 23068672), 64.0f, rot);
        conv_job8<0>(c, a.in[I_M2] + (size_t)e * FF * D, nullptr, D, FF, D, (unsigned char*)(a.ws + WS_M2 + (size_t)e * 11534336), 64.0f, rot);
    }
}

__global__ void __launch_bounds__(512, 2) fwd_kernel(Args args) {
    extern __shared__ __attribute__((aligned(16))) unsigned char lds_raw[];
    volatile LAS unsigned* misc = (volatile LAS unsigned*)((LAS unsigned char*)lds_raw + LDS_MISC);
    if (threadIdx.x < 16) misc[threadIdx.x] = 0u;
    __syncthreads();
    const int lo = args.ph_lo, hi = args.ph_hi;
    XcdBarrier bar; bar.bar = (unsigned*)(args.ws + WS_CTL + CTL_BAR); bar.x = 0; bar.st = misc;
    if (hi - lo > 1) bar = xcd_barrier_post((unsigned*)(args.ws + WS_CTL + CTL_BAR), misc);
#define IN(k) (lo <= (k) && (k) < hi)
#define MKCTX Ctx c; { int t_ = threadIdx.x; asm volatile("" : "+v"(t_)); { ArgsP kp_ = (ArgsP)__builtin_amdgcn_kernarg_segment_ptr(); asm volatile("" : "+s"(kp_)); c.a = kp_; } c.lds = (LAS unsigned char*)lds_raw; c.tid = t_; c.lane = t_ & 63; c.wave = __builtin_amdgcn_readfirstlane(t_ >> 6); c.wg = blockIdx.x; c.G = gridDim.x; }
#ifndef PROBE_MASK
#define PROBE_MASK 0u
#endif
#define REP(k, ...) if ((PROBE_MASK >> (k)) & 1u) { __syncthreads(); __VA_ARGS__; }
#define SEAM(k) do { if (IN(k) && IN((k) + 1)) xcd_barrier(bar); } while (0)
    if (IN(0)) { MKCTX prologue_phase(c); REP(0, prologue_phase(c)) }
    if (IN(0)) { MKCTX norm_phase<0, 0>(c); REP(1, norm_phase<0, 0>(c)) } SEAM(0);

    if (IN(2)) { MKCTX gemm_projmix<0>(c); REP(2, gemm_projmix<0>(c)) } SEAM(2);
    if (IN(3)) { MKCTX intra_phase<0>(c); REP(3, intra_phase<0>(c)) } SEAM(3);
    if (IN(4)) { MKCTX chains_phase<0>(c); REP(4, chains_phase<0>(c)) } SEAM(4);
    if (IN(5)) { MKCTX combine_phase<0>(c); REP(5, combine_phase<0>(c)) } SEAM(5);
    if (IN(6)) { MKCTX gemm_upgate<0>(c); REP(6, gemm_upgate<0>(c)) } SEAM(6);
    if (IN(7)) { MKCTX gemm_wout<0>(c); } SEAM(7);
    if (IN(8)) { MKCTX norm_phase<0, 1>(c); REP(8, norm_phase<0, 1>(c)) } SEAM(8);
    if (IN(9)) { MKCTX gemm_ffn13(c); REP(9, gemm_ffn13(c)) } SEAM(9);
    if (IN(10)) { MKCTX gemm_ffn2(c); } SEAM(10);
    if (IN(11)) { MKCTX norm_phase<1, 0>(c); REP(11, norm_phase<1, 0>(c)) } SEAM(11);
    if (IN(12)) { MKCTX gemm_projmix<1>(c); REP(12, gemm_projmix<1>(c)) } SEAM(12);
    if (IN(13)) { MKCTX intra_phase<1>(c); REP(13, intra_phase<1>(c)) } SEAM(13);
    if (IN(14)) { MKCTX chains_phase<1>(c); REP(14, chains_phase<1>(c)) } SEAM(14);
    if (IN(15)) { MKCTX combine_phase<1>(c); REP(15, combine_phase<1>(c)) } SEAM(15);
    if (IN(16)) { MKCTX gemm_upgate<1>(c); REP(16, gemm_upgate<1>(c)) } SEAM(16);
    if (IN(17)) { MKCTX gemm_wout<1>(c); } SEAM(17);
    if (IN(18)) { MKCTX route1_phase(c); __syncthreads(); moeconv_phase(c); REP(18, route1_phase(c); __syncthreads(); moeconv_phase(c)) } SEAM(18);
    if (IN(19)) { MKCTX route2_phase(c); REP(19, route2_phase(c)) } SEAM(19);
    if (IN(20)) { MKCTX gemm_moe13(c); REP(20, gemm_moe13(c)) } SEAM(20);
    if (IN(21)) { MKCTX gemm_moe2(c); REP(21, gemm_moe2(c)) } SEAM(21);
    if (IN(22)) { MKCTX final_phase(c); }
#undef IN
#undef SEAM
}

extern "C" void kernel_launch(void* const* d_in, const int* in_sizes, int n_in, void* d_out, int out_size, void* d_ws, size_t ws_size, hipStream_t stream) {
    static int grid = 0;
    if (grid == 0) {
        if (n_in != N_IN || out_size != ML * D || ws_size < WS_END) { fprintf(stderr, "kernel_launch: unexpected shapes: n_in %d out %d ws %zu (need %zu)\n", n_in, out_size, ws_size, (size_t)WS_END); grid = -1; return; }
        int dev = 0, cus = 0;
        if (hipGetDevice(&dev) != hipSuccess || hipDeviceGetAttribute(&cus, hipDeviceAttributeMultiprocessorCount, dev) != hipSuccess) { grid = -1; return; }
        if (hipFuncSetAttribute((const void*)fwd_kernel, hipFuncAttributeMaxDynamicSharedMemorySize, LDS_BYTES) != hipSuccess) { fprintf(stderr, "kernel_launch: hipFuncSetAttribute failed\n"); grid = -1; return; }
        int per_cu = 0;
        if (hipOccupancyMaxActiveBlocksPerMultiprocessor(&per_cu, (const void*)fwd_kernel, 512, LDS_BYTES) != hipSuccess || per_cu < 1) { fprintf(stderr, "kernel_launch: occupancy query says %d\n", per_cu); }
        (void)hipGetLastError();
        grid = cus > 256 ? 256 : cus;
    }
    if (grid < 0) return;
    (void)hipMemsetAsync((char*)d_ws + WS_CTL, 0, CTL_BYTES, stream);
    Args a{};
    for (int i = 0; i < N_IN; ++i) a.in[i] = (const float*)d_in[i];
    a.out = (float*)d_out; a.ws = (unsigned char*)d_ws;
#if N_LAUNCHES == 1
    a.ph_lo = 0; a.ph_hi = N_PHASES;
    hipLaunchKernelGGL(fwd_kernel, dim3(grid), dim3(512), LDS_BYTES, stream, a);
#else
    for (int p = 0; p < N_PHASES; ++p) { a.ph_lo = p; a.ph_hi = p + 1; hipLaunchKernelGGL(fwd_kernel, dim3(grid), dim3(512), LDS_BYTES, stream, a); }
#endif
}
```

```cpp
#include <hip/hip_runtime.h>
#include <cstdio>
#include <cstdint>
#define N_LAUNCHES 1
namespace pg8 {
#define PG8_LAS __attribute__((address_space(3)))
typedef unsigned short bf16_t;
typedef short bf16x8 __attribute__((ext_vector_type(8)));
typedef float f32x4 __attribute__((ext_vector_type(4)));
typedef unsigned u32x4 __attribute__((ext_vector_type(4)));
constexpr int BM = 256, BK = 64, HALF = 128, HTB = HALF * BK * 2  , STAGE_BYTES = 8 * HTB, NXCD = 8, WGM = 4;

__host__ __device__ __forceinline__ int lds_byte(int r, int c) { const int st = (r >> 4) * 2 + (c >> 5), rr = r & 15, cc = c & 31, ob = rr * 64 + cc * 2; return st * 1024 + (ob ^ (((ob >> 9) & 1) << 5)); }
__host__ __device__ __forceinline__ void stage_rc(int b, int& R, int& C) { const int st = b / 1024, sb = b % 1024, swz = sb ^ (((sb >> 9) & 1) << 5); R = (st >> 1) * 16 + swz / 64; C = (st & 1) * 32 + (swz % 64) / 2; }
__host__ __device__ __forceinline__ int perm32(int rho) { const int n = rho >> 4, i = rho & 15; return 8 * (i >> 2) + 4 * n + (i & 3); }

struct Unit { int pm, pn; };
struct Gemm { const bf16_t* A; const bf16_t* Bt; int M, N, K; int ld = 0; };

struct StaticOrder {
    int nM, nN, nwg, G, c, wgm;
    __host__ __device__ void init(int M, int N, int G_, int c_, int wgm_ = WGM) { nM = M / BM; nN = N / BM; nwg = nM * nN; G = G_; c = c_; wgm = wgm_; }
    __host__ __device__ bool next(int i, Unit& u) const {
        const long L = (long)i * G + c; if (L >= nwg) return false;
        int wgid = (int)L; { const int q = nwg / NXCD, r = nwg % NXCD, xcd = wgid % NXCD, off = wgid / NXCD; wgid = (xcd < r ? xcd * (q + 1) : r * (q + 1) + (xcd - r) * q) + off; }
        const int nig = wgm * nN, gid = wgid / nig, fm = gid * wgm, gsz = (nM - fm) < wgm ? (nM - fm) : wgm;
        u.pm = fm + ((wgid % nig) % gsz); u.pn = (wgid % nig) / gsz; return true;
    }
    __device__ __forceinline__ void a_ready(const Unit&) const {}
    __device__ __forceinline__ void done(const Unit&) const {}
};
__device__ __forceinline__ unsigned cvt_pk_bf16(float lo, float hi) { unsigned r; asm volatile("v_cvt_pk_bf16_f32 %0, %1, %2" : "=v"(r) : "v"(lo), "v"(hi)); return r; }
typedef __bf16 bf16x2_t __attribute__((ext_vector_type(2)));
typedef float f32x2c_t __attribute__((ext_vector_type(2)));
__device__ __forceinline__ unsigned cvt_pk_bf16_safe(float lo, float hi) { const f32x2c_t v = {lo, hi}; return __builtin_bit_cast(unsigned, __builtin_convertvector(v, bf16x2_t)); }
template <class Epi, class = void> struct pg8_has_carry { static constexpr bool value = false; };
template <class Epi> struct pg8_has_carry<Epi, decltype((void)Epi::CARRY)> { static constexpr bool value = Epi::CARRY; };
template <class Epi> __device__ __forceinline__ bool pg8_carry(const Unit& nxt) { if constexpr (pg8_has_carry<Epi>::value) return Epi::carry(nxt); else return false; }
template <class Epi, class Sched, bool ALIGN_EPI = false, bool SP2 = false>
__device__ __forceinline__ void gemm_phase(PG8_LAS unsigned char* lds, const Gemm g, const Sched& S, const Epi& E) {
    int tid_ = threadIdx.x; asm volatile("" : "+v"(tid_));
    const int tid = tid_, wid = __builtin_amdgcn_readfirstlane(tid >> 6), lane = tid & 63, wr = wid >> 2, wc = wid & 3, fr = lane & 15, fq = lane >> 4;
    const int K = g.K, nt = K / BK, LD = g.ld ? g.ld : g.K;
    unsigned voffA[2], voffB[2];
#pragma unroll
    for (int i = 0; i < 2; ++i) { int R, C; stage_rc(tid * 16 + i * 8192, R, C); const int Rb = Epi::PERM ? ((R & ~31) + perm32(R & 31)) : R;
        voffA[i] = (unsigned)(R * LD + C) * 2u; voffB[i] = (unsigned)(Rb * LD + C) * 2u; }
    const size_t kstep = (size_t)(BK * 2);
    const size_t hstep = (size_t)HALF * LD * 2;
    const size_t tstep = 2 * hstep;
    const unsigned ldsw = (unsigned)wid * 1024u;
    const int aoff = lds_byte(wr * 64 + fr, fq * 8), boff = lds_byte(wc * 32 + fr, fq * 8);
#define PG8_SA(b, h) (((b) * 2 + (h)) * HTB)
#define PG8_SB(b, h) ((4 + (b) * 2 + (h)) * HTB)
#define PG8_STAGE(bufoff, gbase, voff) do { _Pragma("unroll") for (int _i = 0; _i < 2; ++_i) \
        __builtin_amdgcn_global_load_lds((const unsigned*)((const char*)(gbase) + (voff)[_i]), (PG8_LAS unsigned*)(lds + (bufoff) + ldsw + _i * 8192), 16, 0, 0); } while (0)
#define PG8_LDA(dst, b, h) do { _Pragma("unroll") for (int m = 0; m < 4; ++m) _Pragma("unroll") for (int k = 0; k < 2; ++k) dst[m][k] = *(const PG8_LAS bf16x8*)(lds + PG8_SA(b, h) + aoff + m * 2048 + k * 1024); } while (0)
#define PG8_LDB(dst, b, h) do { _Pragma("unroll") for (int n = 0; n < 2; ++n) _Pragma("unroll") for (int k = 0; k < 2; ++k) dst[n][k] = *(const PG8_LAS bf16x8*)(lds + PG8_SB(b, h) + boff + n * 2048 + k * 1024); } while (0)
#define PG8_MMA(ai, bj, At, Bt) do { __builtin_amdgcn_s_setprio(1); _Pragma("unroll") for (int m = 0; m < 4; ++m) _Pragma("unroll") for (int n = 0; n < 2; ++n) _Pragma("unroll") for (int k = 0; k < 2; ++k) \
        acc[ai][bj][m][n] = __builtin_amdgcn_mfma_f32_16x16x32_bf16(Bt[n][k], At[m][k], acc[ai][bj][m][n], 0, 0, 0); __builtin_amdgcn_s_setprio(0); } while (0)
#define PG8_WAIT_V(n) asm volatile("s_waitcnt vmcnt(" #n ")" ::: "memory")
#define PG8_WAIT_L(n) asm volatile("s_waitcnt lgkmcnt(" #n ")" ::: "memory")
#define PG8_BAR __builtin_amdgcn_s_barrier()
#define PG8_SCHED __builtin_amdgcn_sched_barrier(0)
    Unit cur, nxt; int ui = 0;
    if (!S.next(0, cur)) return;
    f32x4 acc[2][2][4][2];
#pragma unroll
    for (int a = 0; a < 2; ++a)
#pragma unroll
        for (int b = 0; b < 2; ++b)
#pragma unroll
            for (int m = 0; m < 4; ++m)
#pragma unroll
                for (int n = 0; n < 2; ++n) acc[a][b][m][n] = (f32x4){0.f, 0.f, 0.f, 0.f};
    bf16x8 At[4][2], B0[2][2], B1[2][2];
    const char* cA = (const char*)g.A + (size_t)cur.pm * tstep; const char* cB = (const char*)g.Bt + (size_t)cur.pn * tstep;
    S.a_ready(cur);
    if constexpr (SP2) {
        PG8_STAGE(PG8_SB(0, 0), cB, voffB); PG8_STAGE(PG8_SB(0, 1), cB + hstep, voffB); PG8_STAGE(PG8_SA(0, 0), cA, voffA); PG8_STAGE(PG8_SA(0, 1), cA + hstep, voffA);
        if (wr == 1) PG8_BAR;
        PG8_WAIT_V(2); PG8_BAR;
        PG8_STAGE(PG8_SB(1, 0), cB + kstep, voffB); PG8_STAGE(PG8_SA(1, 0), cA + kstep, voffA); PG8_STAGE(PG8_SB(1, 1), cB + hstep + kstep, voffB);
        PG8_WAIT_V(6); PG8_BAR;
    } else {
        PG8_STAGE(PG8_SB(0, 0), cB, voffB); PG8_STAGE(PG8_SA(0, 0), cA, voffA); PG8_STAGE(PG8_SB(0, 1), cB + hstep, voffB); PG8_STAGE(PG8_SA(0, 1), cA + hstep, voffA);
        if (wr == 1) PG8_BAR;
        PG8_WAIT_V(4); PG8_BAR;
        PG8_STAGE(PG8_SB(1, 0), cB + kstep, voffB); PG8_STAGE(PG8_SA(1, 0), cA + kstep, voffA); PG8_STAGE(PG8_SB(1, 1), cB + hstep + kstep, voffB);
        PG8_WAIT_V(6); PG8_BAR;
    }
    for (;;) {
        const bool has_next = S.next(ui + 1, nxt);
        const char* nA = has_next ? (const char*)g.A + (size_t)nxt.pm * tstep : cA; const char* nB = has_next ? (const char*)g.Bt + (size_t)nxt.pn * tstep : cB;
        for (int t = 0; t < nt; t += 2) {
            const bool last = (t == nt - 2);
            const char* a1 = cA + (size_t)(t + 1) * kstep;
            const char* a2 = last ? nA : cA + (size_t)(t + 2) * kstep; const char* b2 = last ? nB : cB + (size_t)(t + 2) * kstep;
            const char* a3 = a2 + kstep; const char* b3 = b2 + kstep;
            if (last && has_next) S.a_ready(nxt);
            if constexpr (SP2) {
            PG8_LDB(B0, 0, 0); PG8_LDB(B1, 0, 1); PG8_SCHED; PG8_LDA(At, 0, 0); PG8_STAGE(PG8_SA(1, 1), a1 + hstep, voffA);
            PG8_WAIT_V(8); PG8_WAIT_L(0); PG8_BAR; PG8_MMA(0, 0, At, B0); PG8_MMA(0, 1, At, B1); PG8_BAR; PG8_SCHED;
            PG8_LDA(At, 0, 1); PG8_STAGE(PG8_SB(0, 0), b2, voffB); PG8_STAGE(PG8_SB(0, 1), b2 + hstep, voffB); PG8_STAGE(PG8_SA(0, 0), a2, voffA);
            PG8_WAIT_V(8); PG8_WAIT_L(0); PG8_BAR; PG8_MMA(1, 0, At, B0); PG8_MMA(1, 1, At, B1); PG8_BAR; PG8_SCHED;
            PG8_LDB(B0, 1, 0); PG8_LDB(B1, 1, 1); PG8_SCHED; PG8_LDA(At, 1, 0); PG8_STAGE(PG8_SA(0, 1), a2 + hstep, voffA);
            PG8_WAIT_V(8); PG8_WAIT_L(0); PG8_BAR; PG8_MMA(0, 0, At, B0); PG8_MMA(0, 1, At, B1); PG8_BAR; PG8_SCHED;
            PG8_LDA(At, 1, 1); PG8_STAGE(PG8_SB(1, 0), b3, voffB); PG8_STAGE(PG8_SB(1, 1), b3 + hstep, voffB); PG8_STAGE(PG8_SA(1, 0), a3, voffA);
            PG8_WAIT_V(8); PG8_WAIT_L(0); PG8_BAR; PG8_MMA(1, 0, At, B0); PG8_MMA(1, 1, At, B1); PG8_BAR; PG8_SCHED;
            } else {
            PG8_LDB(B0, 0, 0); PG8_SCHED; PG8_LDA(At, 0, 0); PG8_STAGE(PG8_SA(1, 1), a1 + hstep, voffA);
            PG8_WAIT_L(8); PG8_BAR; PG8_WAIT_L(0); PG8_MMA(0, 0, At, B0); PG8_BAR; PG8_SCHED;
            PG8_LDB(B1, 0, 1); PG8_STAGE(PG8_SB(0, 0), b2, voffB);
            PG8_BAR; PG8_WAIT_L(0); PG8_MMA(0, 1, At, B1); PG8_BAR;
            PG8_LDA(At, 0, 1); PG8_STAGE(PG8_SA(0, 0), a2, voffA);
            PG8_BAR; PG8_WAIT_L(0); PG8_MMA(1, 0, At, B0); PG8_BAR; PG8_SCHED;
            PG8_STAGE(PG8_SB(0, 1), b2 + hstep, voffB);
            PG8_WAIT_V(6); PG8_BAR; PG8_MMA(1, 1, At, B1); PG8_BAR;
            PG8_LDB(B0, 1, 0); PG8_SCHED; PG8_LDA(At, 1, 0); PG8_STAGE(PG8_SA(0, 1), a2 + hstep, voffA);
            PG8_WAIT_L(8); PG8_BAR; PG8_WAIT_L(0); PG8_MMA(0, 0, At, B0); PG8_BAR; PG8_SCHED;
            PG8_LDB(B1, 1, 1); PG8_STAGE(PG8_SB(1, 0), b3, voffB);
            PG8_BAR; PG8_WAIT_L(0); PG8_MMA(0, 1, At, B1); PG8_BAR;
            PG8_LDA(At, 1, 1); PG8_STAGE(PG8_SA(1, 0), a3, voffA);
            PG8_BAR; PG8_WAIT_L(0); PG8_MMA(1, 0, At, B0); PG8_BAR; PG8_SCHED;
            PG8_STAGE(PG8_SB(1, 1), b3 + hstep, voffB);
            PG8_WAIT_V(6); PG8_BAR; PG8_MMA(1, 1, At, B1); PG8_BAR;
            }
        }
        if constexpr (ALIGN_EPI) { if (wr == 0) PG8_BAR; }
        if constexpr (!Epi::AFTER_DRAIN) { E(acc, cur, wr, wc, fr, fq); S.done(cur); }
        if (!has_next) break;
        if (!pg8_carry<Epi>(nxt)) {
#pragma unroll
        for (int a = 0; a < 2; ++a)
#pragma unroll
            for (int b = 0; b < 2; ++b)
#pragma unroll
                for (int m = 0; m < 4; ++m)
#pragma unroll
                    for (int n = 0; n < 2; ++n) acc[a][b][m][n] = (f32x4){0.f, 0.f, 0.f, 0.f};
        }
        cur = nxt; cA = nA; cB = nB; ++ui;
        if constexpr (ALIGN_EPI) { if (wr == 1) PG8_BAR; }
    }
    PG8_WAIT_V(0);
    if constexpr (!ALIGN_EPI) { if (wr == 0) PG8_BAR; }
    PG8_BAR;
    if constexpr (Epi::AFTER_DRAIN) { E.fused(acc, cur, wr, wc, fr, fq, lds, wid, lane); S.done(cur); }
#undef PG8_SA
#undef PG8_SB
#undef PG8_STAGE
#undef PG8_LDA
#undef PG8_LDB
#undef PG8_MMA
#undef PG8_WAIT_V
#undef PG8_WAIT_L
#undef PG8_BAR
#undef PG8_SCHED
}

typedef int i32x4 __attribute__((ext_vector_type(4)));
typedef int i32x8 __attribute__((ext_vector_type(8)));
template <class Epi, class Sched, bool ALIGN_EPI = false, bool SP2 = false>
__device__ __forceinline__ void gemm_phase8(PG8_LAS unsigned char* lds, const Gemm g, const Sched& S, const Epi& E) {
    int tid_ = threadIdx.x; asm volatile("" : "+v"(tid_));
    const int tid = tid_, wid = __builtin_amdgcn_readfirstlane(tid >> 6), lane = tid & 63, wr = wid >> 2, wc = wid & 3, fr = lane & 15, fq = lane >> 4;
    const int K = g.K, nt = K / BK, LD = g.ld ? g.ld : g.K;
    unsigned voffA[2], voffB[2];
#pragma unroll
    for (int i = 0; i < 2; ++i) { int R, C; stage_rc(tid * 16 + i * 8192, R, C); const int Rb = Epi::PERM ? ((R & ~31) + perm32(R & 31)) : R;
        voffA[i] = (unsigned)(R * LD + C) * 2u; voffB[i] = (unsigned)(Rb * LD + C) * 2u; }
    const size_t kstep = (size_t)(BK * 2);
    const size_t hstep = (size_t)HALF * LD * 2;
    const size_t tstep = 2 * hstep;
    const unsigned ldsw = (unsigned)wid * 1024u;
    const int aoff = lds_byte(wr * 64 + fr, fq * 8), boff = lds_byte(wc * 32 + fr, fq * 8);
#define PG8_SA(b, h) (((b) * 2 + (h)) * HTB)
#define PG8_SB(b, h) ((4 + (b) * 2 + (h)) * HTB)
#define PG8_STAGE(bufoff, gbase, voff) do { _Pragma("unroll") for (int _i = 0; _i < 2; ++_i) \
        __builtin_amdgcn_global_load_lds((const unsigned*)((const char*)(gbase) + (voff)[_i]), (PG8_LAS unsigned*)(lds + (bufoff) + ldsw + _i * 8192), 16, 0, 0); } while (0)
#define PG8_LD8(addr) __builtin_shufflevector(__builtin_bit_cast(i32x4, *(const PG8_LAS bf16x8*)(addr)), __builtin_bit_cast(i32x4, *(const PG8_LAS bf16x8*)((addr) + 1024)), 0, 1, 2, 3, 4, 5, 6, 7)
#define PG8_LDA(dst, b, h) do { _Pragma("unroll") for (int m = 0; m < 4; ++m) dst[m] = PG8_LD8(lds + PG8_SA(b, h) + aoff + m * 2048); } while (0)
#define PG8_LDB(dst, b, h) do { _Pragma("unroll") for (int n = 0; n < 2; ++n) dst[n] = PG8_LD8(lds + PG8_SB(b, h) + boff + n * 2048); } while (0)
#define PG8_MMA(ai, bj, At, Bt) do { __builtin_amdgcn_s_setprio(1); _Pragma("unroll") for (int m = 0; m < 4; ++m) _Pragma("unroll") for (int n = 0; n < 2; ++n) \
        asm volatile("v_mfma_f32_16x16x128_f8f6f4 %0, %1, %2, %0" : "+v"(acc[ai][bj][m][n]) : "v"(Bt[n]), "v"(At[m])); __builtin_amdgcn_s_setprio(0); } while (0)
#define PG8_WAIT_V(n) asm volatile("s_waitcnt vmcnt(" #n ")" ::: "memory")
#define PG8_WAIT_L(n) asm volatile("s_waitcnt lgkmcnt(" #n ")" ::: "memory")
#define PG8_BAR __builtin_amdgcn_s_barrier()
#define PG8_SCHED __builtin_amdgcn_sched_barrier(0)
    Unit cur, nxt; int ui = 0;
    if (!S.next(0, cur)) return;
    f32x4 acc[2][2][4][2];
#pragma unroll
    for (int a = 0; a < 2; ++a)
#pragma unroll
        for (int b = 0; b < 2; ++b)
#pragma unroll
            for (int m = 0; m < 4; ++m)
#pragma unroll
                for (int n = 0; n < 2; ++n) acc[a][b][m][n] = (f32x4){0.f, 0.f, 0.f, 0.f};
    i32x8 At[4], B0[2], B1[2];
    const char* cA = (const char*)g.A + (size_t)cur.pm * tstep; const char* cB = (const char*)g.Bt + (size_t)cur.pn * tstep;
    S.a_ready(cur);
    if constexpr (SP2) {
        PG8_STAGE(PG8_SB(0, 0), cB, voffB); PG8_STAGE(PG8_SB(0, 1), cB + hstep, voffB); PG8_STAGE(PG8_SA(0, 0), cA, voffA); PG8_STAGE(PG8_SA(0, 1), cA + hstep, voffA);
        if (wr == 1) PG8_BAR;
        PG8_WAIT_V(2); PG8_BAR;
        PG8_STAGE(PG8_SB(1, 0), cB + kstep, voffB); PG8_STAGE(PG8_SA(1, 0), cA + kstep, voffA); PG8_STAGE(PG8_SB(1, 1), cB + hstep + kstep, voffB);
        PG8_WAIT_V(6); PG8_BAR;
    } else {
        PG8_STAGE(PG8_SB(0, 0), cB, voffB); PG8_STAGE(PG8_SA(0, 0), cA, voffA); PG8_STAGE(PG8_SB(0, 1), cB + hstep, voffB); PG8_STAGE(PG8_SA(0, 1), cA + hstep, voffA);
        if (wr == 1) PG8_BAR;
        PG8_WAIT_V(4); PG8_BAR;
        PG8_STAGE(PG8_SB(1, 0), cB + kstep, voffB); PG8_STAGE(PG8_SA(1, 0), cA + kstep, voffA); PG8_STAGE(PG8_SB(1, 1), cB + hstep + kstep, voffB);
        PG8_WAIT_V(6); PG8_BAR;
    }
    for (;;) {
        const bool has_next = S.next(ui + 1, nxt);
        const char* nA = has_next ? (const char*)g.A + (size_t)nxt.pm * tstep : cA; const char* nB = has_next ? (const char*)g.Bt + (size_t)nxt.pn * tstep : cB;
        for (int t = 0; t < nt; t += 2) {
            const bool last = (t == nt - 2);
            const char* a1 = cA + (size_t)(t + 1) * kstep;
            const char* a2 = last ? nA : cA + (size_t)(t + 2) * kstep; const char* b2 = last ? nB : cB + (size_t)(t + 2) * kstep;
            const char* a3 = a2 + kstep; const char* b3 = b2 + kstep;
            if (last && has_next) S.a_ready(nxt);
            if constexpr (SP2) {
            PG8_LDB(B0, 0, 0); PG8_LDB(B1, 0, 1); PG8_SCHED; PG8_LDA(At, 0, 0); PG8_STAGE(PG8_SA(1, 1), a1 + hstep, voffA);
            PG8_WAIT_V(8); PG8_WAIT_L(0); PG8_BAR; PG8_MMA(0, 0, At, B0); PG8_MMA(0, 1, At, B1); PG8_BAR; PG8_SCHED;
            PG8_LDA(At, 0, 1); PG8_STAGE(PG8_SB(0, 0), b2, voffB); PG8_STAGE(PG8_SB(0, 1), b2 + hstep, voffB); PG8_STAGE(PG8_SA(0, 0), a2, voffA);
            PG8_WAIT_V(8); PG8_WAIT_L(0); PG8_BAR; PG8_MMA(1, 0, At, B0); PG8_MMA(1, 1, At, B1); PG8_BAR; PG8_SCHED;
            PG8_LDB(B0, 1, 0); PG8_LDB(B1, 1, 1); PG8_SCHED; PG8_LDA(At, 1, 0); PG8_STAGE(PG8_SA(0, 1), a2 + hstep, voffA);
            PG8_WAIT_V(8); PG8_WAIT_L(0); PG8_BAR; PG8_MMA(0, 0, At, B0); PG8_MMA(0, 1, At, B1); PG8_BAR; PG8_SCHED;
            PG8_LDA(At, 1, 1); PG8_STAGE(PG8_SB(1, 0), b3, voffB); PG8_STAGE(PG8_SB(1, 1), b3 + hstep, voffB); PG8_STAGE(PG8_SA(1, 0), a3, voffA);
            PG8_WAIT_V(8); PG8_WAIT_L(0); PG8_BAR; PG8_MMA(1, 0, At, B0); PG8_MMA(1, 1, At, B1); PG8_BAR; PG8_SCHED;
            } else {
            PG8_LDB(B0, 0, 0); PG8_SCHED; PG8_LDA(At, 0, 0); PG8_STAGE(PG8_SA(1, 1), a1 + hstep, voffA);
            PG8_WAIT_L(8); PG8_BAR; PG8_WAIT_L(0); PG8_MMA(0, 0, At, B0); PG8_BAR; PG8_SCHED;
            PG8_LDB(B1, 0, 1); PG8_STAGE(PG8_SB(0, 0), b2, voffB);
            PG8_BAR; PG8_WAIT_L(0); PG8_MMA(0, 1, At, B1); PG8_BAR;
            PG8_LDA(At, 0, 1); PG8_STAGE(PG8_SA(0, 0), a2, voffA);
            PG8_BAR; PG8_WAIT_L(0); PG8_MMA(1, 0, At, B0); PG8_BAR; PG8_SCHED;
            PG8_STAGE(PG8_SB(0, 1), b2 + hstep, voffB);
            PG8_WAIT_V(6); PG8_BAR; PG8_MMA(1, 1, At, B1); PG8_BAR;
            PG8_LDB(B0, 1, 0); PG8_SCHED; PG8_LDA(At, 1, 0); PG8_STAGE(PG8_SA(0, 1), a2 + hstep, voffA);
            PG8_WAIT_L(8); PG8_BAR; PG8_WAIT_L(0); PG8_MMA(0, 0, At, B0); PG8_BAR; PG8_SCHED;
            PG8_LDB(B1, 1, 1); PG8_STAGE(PG8_SB(1, 0), b3, voffB);
            PG8_BAR; PG8_WAIT_L(0); PG8_MMA(0, 1, At, B1); PG8_BAR;
            PG8_LDA(At, 1, 1); PG8_STAGE(PG8_SA(1, 0), a3, voffA);
            PG8_BAR; PG8_WAIT_L(0); PG8_MMA(1, 0, At, B0); PG8_BAR; PG8_SCHED;
            PG8_STAGE(PG8_SB(1, 1), b3 + hstep, voffB);
            PG8_WAIT_V(6); PG8_BAR; PG8_MMA(1, 1, At, B1); PG8_BAR;
            }
        }
        if constexpr (ALIGN_EPI) { if (wr == 0) PG8_BAR; }
        asm volatile("s_nop 15\n\ts_nop 15" ::: "memory");
        if constexpr (!Epi::AFTER_DRAIN) { E(acc, cur, wr, wc, fr, fq); S.done(cur); }
        if (!has_next) break;
#pragma unroll
        for (int a = 0; a < 2; ++a)
#pragma unroll
            for (int b = 0; b < 2; ++b)
#pragma unroll
                for (int m = 0; m < 4; ++m)
#pragma unroll
                    for (int n = 0; n < 2; ++n) acc[a][b][m][n] = (f32x4){0.f, 0.f, 0.f, 0.f};
        cur = nxt; cA = nA; cB = nB; ++ui;
        if constexpr (ALIGN_EPI) { if (wr == 1) PG8_BAR; }
    }
    PG8_WAIT_V(0);
    if constexpr (!ALIGN_EPI) { if (wr == 0) PG8_BAR; }
    PG8_BAR;
    if constexpr (Epi::AFTER_DRAIN) { E.fused(acc, cur, wr, wc, fr, fq, lds, wid, lane); S.done(cur); }
#undef PG8_SA
#undef PG8_SB
#undef PG8_STAGE
#undef PG8_LD8
#undef PG8_LDA
#undef PG8_LDB
#undef PG8_MMA
#undef PG8_WAIT_V
#undef PG8_WAIT_L
#undef PG8_BAR
#undef PG8_SCHED
}
}
#define XB_TMO      128
#define XB_XCNT(j)  (256  + 64 * (j))
#define XB_XSUB(j)  (1280 + 64 * (j))
#define XB_XGEN(j)  (2304 + 64 * (j))
#define XB_TOP      3328
#define XB_TOPGEN   3392
#define XCD_BAR_WORDS 3456
#define XB_SPIN_CAP (1u << 18)
#define LAS __attribute__((address_space(3)))

__device__ __forceinline__ unsigned xb_ld(unsigned* p)              { return __hip_atomic_load(p, __ATOMIC_RELAXED, __HIP_MEMORY_SCOPE_AGENT); }
__device__ __forceinline__ unsigned xb_add(unsigned* p, unsigned v) { return __hip_atomic_fetch_add(p, v, __ATOMIC_RELAXED, __HIP_MEMORY_SCOPE_AGENT); }
__device__ __forceinline__ unsigned xb_xcc_id() { return (unsigned)__builtin_amdgcn_s_getreg((3 << 11) | 20) & 0xFu; }
#define XB_SPIN(cond, bar) do { unsigned _sp = 0; while (cond) { __builtin_amdgcn_s_sleep(1); \
    if ((++_sp & 255u) == 0u) { if (xb_ld(&(bar)[XB_TMO])) break; if (_sp > XB_SPIN_CAP) { atomicAdd(&(bar)[XB_TMO], 1u); break; } } } } while (0)

struct XcdBarrier {
    unsigned* bar; unsigned x;
    volatile LAS unsigned* st;
};

__device__ __forceinline__ XcdBarrier xcd_barrier_post(unsigned* bar, volatile LAS unsigned* st) {
    XcdBarrier b; b.bar = bar; b.x = xb_xcc_id(); b.st = st;
    if (threadIdx.x == 0) (void)xb_add(&bar[XB_XCNT(b.x)], 1u);
    return b;
}
__device__ __forceinline__ void xcd_barrier_complete(unsigned* bar, unsigned x, unsigned& nloc, unsigned& nx) {
    const unsigned G = gridDim.x * gridDim.y * gridDim.z;
    unsigned sum, cnt, mine, sp = 0u;
    for (;;) {
        sum = 0u; cnt = 0u; mine = 0u;
#pragma unroll
        for (unsigned j = 0; j < 16; ++j) { const unsigned c = xb_ld(&bar[XB_XCNT(j)]); sum += c; cnt += (c > 0u) ? 1u : 0u; mine = (j == x) ? c : mine; }
        if (sum == G) break;
        __builtin_amdgcn_s_sleep(1);
        if ((++sp & 255u) == 0u) { if (xb_ld(&bar[XB_TMO])) break; if (sp > XB_SPIN_CAP) { atomicAdd(&bar[XB_TMO], 1u); break; } }
    }
    nloc = mine > 0u ? mine : 1u; nx = cnt > 0u ? cnt : 1u;
}

__device__ __forceinline__ void xcd_barrier(const XcdBarrier& b) {
    asm volatile("s_waitcnt vmcnt(0)" ::: "memory");
    __syncthreads();
    if (threadIdx.x == 0) {
        unsigned* bar = b.bar;
        __builtin_amdgcn_s_waitcnt(0);
        unsigned nloc = b.st[0], nx = b.st[1];
        if (nloc == 0u) { xcd_barrier_complete(bar, b.x, nloc, nx); b.st[0] = nloc; b.st[1] = nx; }
        const unsigned old = xb_add(&bar[XB_XSUB(b.x)], 1u);
        const unsigned gen = old / nloc;
        if (old + 1u == (gen + 1u) * nloc) {
            __builtin_amdgcn_fence(__ATOMIC_RELEASE, "agent");
            asm volatile("s_waitcnt vmcnt(0)" ::: "memory");
            const unsigned og = xb_add(&bar[XB_TOP], 1u);
            const unsigned tg = og / nx;
            if (og + 1u == (tg + 1u) * nx) xb_add(&bar[XB_TOPGEN], 1u);
            else XB_SPIN(xb_ld(&bar[XB_TOPGEN]) == tg, bar);
            __builtin_amdgcn_fence(__ATOMIC_ACQUIRE, "agent");
            xb_add(&bar[XB_XGEN(b.x)], 1u);
            asm volatile("s_waitcnt vmcnt(0)" ::: "memory");
        } else {
            XB_SPIN(xb_ld(&bar[XB_XGEN(b.x)]) == gen, bar);
            __builtin_amdgcn_fence(__ATOMIC_ACQUIRE, "agent");
            asm volatile("s_waitcnt vmcnt(0)" ::: "memory");
        }
    }
    __syncthreads();
}


typedef pg8::bf16_t bf16_t;
typedef pg8::f32x4 f32x4;
typedef pg8::u32x4 u32x4;
typedef unsigned u32x2 __attribute__((ext_vector_type(2)));

constexpr int D = 2048, NB = 2, T = 16384, CL = 256;
constexpr int ML = NB * T;
constexpr int MC = NB * CL;
constexpr int MT = ML + MC;
constexpr int NMIX = 7216, NMIXP = 7424, NGATE = 8192, NPROJ = NMIXP + NGATE;
constexpr int DIN = 15408;
constexpr int FF = 5632, NE = 8;
constexpr int MOE_ROWS = 67584;
constexpr int C_GLA_Q = 0, C_GLA_K = 256, C_GLA_V = 512, C_GLA_G = 1024, C_GLA_A = 1536;
constexpr int C_HG_Q = 1568, C_HG_F = 2080, C_HG_I = 3104, C_HG_G = 3616;
constexpr int C_DN_Q = 4128, C_DN_K = 4640, C_DN_V = 5152, C_DN_A = 5664, C_DN_B = 5672, C_DN_G = 5680;
constexpr int C_RG_X = 6192, C_RG_Y = 6704;
constexpr float EPS = 1e-6f;

enum { I_X = 0, I_C, I_CTX, I_CCTX, I_WMOD, I_BMOD, I_NORMW, I_FNORMW, I_WIN, I_WUP, I_WOUT, I_GLA_WA2, I_GLA_BA2, I_GLA_NW, I_HG_LB, I_HG_NW,
       I_DN_CW, I_DN_ALOG, I_DN_DTB, I_DN_NW, I_RG_CW, I_RG_CB, I_RG_WR, I_RG_BR, I_RG_WI, I_RG_BI, I_RG_LAM, I_F1, I_F3, I_F2, I_ROUTER, I_M1, I_M3, I_M2, N_IN };

constexpr size_t WS_CTL = 0, CTL_BYTES = 65536;
constexpr size_t CTL_BAR = 0, CTL_WGH = 16384, CTL_META = 24576;
constexpr size_t WS_MOD = WS_CTL + CTL_BYTES;
constexpr size_t WS_XC = WS_MOD + 294912;
constexpr size_t WS_TOPI = WS_XC + 4194304;
constexpr size_t WS_TOPW = WS_TOPI + 131072;
constexpr size_t WS_DEST = WS_TOPW + 262144;
constexpr size_t WIN_BYTES = (size_t)NMIXP * D * 2;
constexpr size_t WS_WIN = WS_DEST + 262144;
constexpr size_t WG8_BYTES = (size_t)NGATE * D;
constexpr size_t WS_WG8 = WS_WIN + 2 * WIN_BYTES;
constexpr size_t WS_WUP = WS_WG8 + 2 * WG8_BYTES;
constexpr size_t WS_WOUT = WS_WUP + 2 * 8388608;
constexpr size_t WS_F13 = WS_WOUT + 2 * 8388608;
constexpr size_t WS_F2 = WS_F13 + 46137344;
constexpr size_t WS_RGW = WS_F2 + 23068672;
constexpr size_t WS_H = WS_RGW + 1048576;
constexpr size_t WS_H8 = WS_H + 136314880;
constexpr size_t WS_BIG = WS_H8 + 68157440;
constexpr size_t WS_PMIX = WS_BIG;
constexpr size_t WS_PGATE = WS_BIG;
constexpr size_t WS_ORAW = WS_BIG + 545259520;
constexpr size_t WS_RGLA = WS_ORAW + 272629760;
constexpr size_t WS_RGU = WS_RGLA + 68157440;
constexpr size_t WS_RGTT = WS_RGU, WS_RGCARRY = WS_RGU + 4259840;
constexpr size_t WS_GC = WS_RGU + 8388608;
constexpr size_t WS_SCR = WS_GC + 136314880;
constexpr size_t SC_GLA_VT = 0, SC_GLA_QP = SC_GLA_VT + 34078720, SC_GLA_KT = SC_GLA_QP + 34078720, SC_GLA_A = SC_GLA_KT + 34078720, SC_GLA_LAM = SC_GLA_A + 34078720;
constexpr size_t SC_HG_VT = SC_GLA_LAM + 1064960, SC_HG_QP = SC_HG_VT + 34078720, SC_HG_KT = SC_HG_QP + 68157440, SC_HG_A = SC_HG_KT + 68157440, SC_HG_LAM = SC_HG_A + 34078720;
constexpr size_t SC_DN_QS = SC_HG_LAM + 2129920, SC_DN_KT = SC_DN_QS + 34078720, SC_DN_UT = SC_DN_KT + 34078720, SC_DN_WN = SC_DN_UT + 68157440, SC_DN_AQK = SC_DN_WN + 68157440, SC_DN_SC = SC_DN_AQK + 34078720;
constexpr size_t SC_END = SC_DN_SC + 4259840;
constexpr size_t WS_O = WS_SCR;
constexpr size_t WS_MACC = WS_SCR + 136314880;
constexpr size_t WS_MERGED = WS_MACC + 272629760;
constexpr size_t WS_PF = WS_BIG + 419430400;
constexpr size_t WS_PW = WS_RGLA;
constexpr size_t WS_PU = WS_RGLA + 33554432;
constexpr size_t WS_HID = WS_BIG;
constexpr size_t WS_M13 = WS_BIG;
constexpr size_t WS_M2 = WS_M13 + 369098752;
constexpr size_t WS_GATH = WS_M2 + 184549376;
constexpr size_t WS_HIDM = WS_GATH + 276824064;
constexpr size_t WS_PM2 = WS_HIDM + 402653184;
constexpr size_t WS_END_A = WS_HIDM + 761266176, WS_END_B = WS_SCR + SC_END;
constexpr size_t WS_END = WS_END_A > WS_END_B ? WS_END_A : WS_END_B;
static_assert(WS_MERGED + 136314880 <= WS_SCR + SC_END, "O, MACC, MERGED fit in the record region");
static_assert(WS_END <= 2041000000ull, "workspace budget");

constexpr int LDS_SCR = 0;
constexpr int LDS_AUX = 147456;
constexpr int LDS_MISC = 147456 + 8192;
constexpr int LDS_BYTES = 163840;

constexpr size_t CTL_PT = 32768;
#ifdef PROBE_T
#define PT_START(k) unsigned long long pt_##k = (threadIdx.x == 0) ? wall_clock64() : 0ull
#define PT_STOP(k, ws) do { if (threadIdx.x == 0) atomicAdd((unsigned long long*)((ws) + WS_CTL + CTL_PT) + (k), (unsigned long long)(wall_clock64() - pt_##k)); } while (0)
#else
#define PT_START(k)
#define PT_STOP(k, ws)
#endif
#ifndef PROBE_SUB
#define PROBE_SUB 0
#endif
struct Args { const float* in[N_IN]; float* out; unsigned char* ws; int ph_lo, ph_hi; };

__device__ __forceinline__ float bflo(unsigned w) { return __uint_as_float(w << 16); }
__device__ __forceinline__ float bfhi(unsigned w) { return __uint_as_float(w & 0xffff0000u); }
__device__ __forceinline__ void unpack8(const u32x4 w, float (&f)[8]) { f[0] = bflo(w.x); f[1] = bfhi(w.x); f[2] = bflo(w.y); f[3] = bfhi(w.y); f[4] = bflo(w.z); f[5] = bfhi(w.z); f[6] = bflo(w.w); f[7] = bfhi(w.w); }
typedef __bf16 bfx8_t __attribute__((ext_vector_type(8)));
typedef float f32x8 __attribute__((ext_vector_type(8)));
__device__ __forceinline__ u32x4 pack8(const float (&f)[8]) { f32x8 v;
#pragma unroll
    for (int j = 0; j < 8; ++j) v[j] = f[j];
    return __builtin_bit_cast(u32x4, __builtin_convertvector(v, bfx8_t)); }
__device__ __forceinline__ unsigned pk_fp8x4(float a, float b, float c, float d) {
    a = fminf(fmaxf(a, -448.f), 448.f); b = fminf(fmaxf(b, -448.f), 448.f); c = fminf(fmaxf(c, -448.f), 448.f); d = fminf(fmaxf(d, -448.f), 448.f);
    unsigned p = __builtin_amdgcn_cvt_pk_fp8_f32(a, b, 0, false); return __builtin_amdgcn_cvt_pk_fp8_f32(c, d, p, true); }
__device__ __forceinline__ float bf1(const bf16_t* p) { return __uint_as_float(((unsigned)*p) << 16); }
__device__ __forceinline__ float sigm(float x) { return __builtin_amdgcn_rcpf(1.0f + __expf(-x)); }
__device__ __forceinline__ float siluf(float x) { return x * __builtin_amdgcn_rcpf(1.0f + __expf(-x)); }
__device__ __forceinline__ float softplusf(float x) { return fmaxf(x, 0.f) + __logf(1.0f + __expf(-fabsf(x))); }
__device__ __forceinline__ float wave_sum(float v) { v += __shfl_xor(v, 32); v += __shfl_xor(v, 16); v += __shfl_xor(v, 8); v += __shfl_xor(v, 4); v += __shfl_xor(v, 2); v += __shfl_xor(v, 1); return v; }
__device__ __forceinline__ float gelu_tanh(float y) { const float u = 0.7978845608028654f * (y + 0.044715f * y * y * y); const float e = __expf(2.f * u); const float th = 1.f - 2.f * __builtin_amdgcn_rcpf(e + 1.f); return 0.5f * y * (1.f + th); }

namespace pg8 {
template <bool SIG> struct EpiBf16S {
    static constexpr bool PERM = true, AFTER_DRAIN = false;
    bf16_t* O; int ldc; float sc;
    __device__ __forceinline__ void operator()(const f32x4 (&acc)[2][2][4][2], const Unit& u, int wr, int wc, int fr, int fq) const {
        const int row0 = u.pm * BM + wr * 64 + fr, col0 = u.pn * BM + wc * 32 + 8 * fq;
#pragma unroll
        for (int ai = 0; ai < 2; ++ai)
#pragma unroll
            for (int m = 0; m < 4; ++m) { bf16_t* rowp = O + (size_t)(row0 + ai * HALF + m * 16) * ldc + col0;
#pragma unroll
                for (int bj = 0; bj < 2; ++bj) { f32x4 v0 = acc[ai][bj][m][0], v1 = acc[ai][bj][m][1];
                    if (SIG) {
#pragma unroll
                        for (int j = 0; j < 4; ++j) { v0[j] = sigm(v0[j] * sc); v1[j] = sigm(v1[j] * sc); } }
                    u32x4 w; w.x = cvt_pk_bf16_safe(v0[0], v0[1]); w.y = cvt_pk_bf16_safe(v0[2], v0[3]); w.z = cvt_pk_bf16_safe(v1[0], v1[1]); w.w = cvt_pk_bf16_safe(v1[2], v1[3]);
                    *(u32x4*)(rowp + bj * HALF) = w; } }
    }
};
struct EpiProjMix {
    static constexpr bool PERM = true, AFTER_DRAIN = false;
    bf16_t* pmix; bf16_t* gc;
    __device__ __forceinline__ void operator()(const f32x4 (&acc)[2][2][4][2], const Unit& u, int wr, int wc, int fr, int fq) const {
        const int row0 = u.pm * BM + wr * 64 + fr, col0 = u.pn * BM + wc * 32 + 8 * fq;
#pragma unroll
        for (int bj = 0; bj < 2; ++bj) { const int c = col0 + bj * HALF;
            int g = -1, off = 0;
            if (c >= C_GLA_G && c < C_GLA_G + 512) { g = 0; off = c - C_GLA_G; }
            else if (c >= C_HG_G && c < C_HG_G + 512) { g = 1; off = c - C_HG_G; }
            else if (c >= C_DN_G && c < C_DN_G + 512) { g = 2; off = c - C_DN_G; }
            else if (c >= C_RG_Y && c < C_RG_Y + 512) { g = 3; off = c - C_RG_Y; }
            bf16_t* base = g >= 0 ? gc + g * 512 + off : pmix + c; const size_t ld = g >= 0 ? 2048 : NMIXP;
#pragma unroll
            for (int ai = 0; ai < 2; ++ai)
#pragma unroll
                for (int m = 0; m < 4; ++m) { const f32x4 v0 = acc[ai][bj][m][0], v1 = acc[ai][bj][m][1];
                    u32x4 w; w.x = cvt_pk_bf16_safe(v0[0], v0[1]); w.y = cvt_pk_bf16_safe(v0[2], v0[3]); w.z = cvt_pk_bf16_safe(v1[0], v1[1]); w.w = cvt_pk_bf16_safe(v1[2], v1[3]);
                    *(u32x4*)(base + (size_t)(row0 + ai * HALF + m * 16) * ld) = w; } }
    }
};
struct EpiUpGate {
    static constexpr bool PERM = true, AFTER_DRAIN = false, CARRY = true;
    static __device__ __forceinline__ bool carry(const Unit& nxt) { return (nxt.pn >> 3) != 0; }
    const bf16_t* gate; bf16_t* merged; int nMtot;
    __device__ __forceinline__ void operator()(f32x4 (&acc)[2][2][4][2], const Unit& u, int wr, int wc, int fr, int fq) const {
        const int b = u.pn >> 3, pn = u.pn & 7, pm = u.pm - b * nMtot;
        const int row0 = pm * BM + wr * 64 + fr, col0 = pn * BM + wc * 32 + 8 * fq;
#pragma unroll
        for (int ai = 0; ai < 2; ++ai) {
            u32x4 gw[4][2], gn[4][2];
#pragma unroll
            for (int m = 0; m < 4; ++m) { const size_t r = (size_t)(row0 + ai * HALF + m * 16);
#pragma unroll
                for (int bj = 0; bj < 2; ++bj) { const int c = col0 + bj * HALF; gw[m][bj] = *(const u32x4*)(gate + r * NGATE + b * 2048 + c);
                    if (b < 3) gn[m][bj] = *(const u32x4*)(gate + r * NGATE + (b + 1) * 2048 + c); } }
#pragma unroll
            for (int m = 0; m < 4; ++m) { const size_t r = (size_t)(row0 + ai * HALF + m * 16);
#pragma unroll
                for (int bj = 0; bj < 2; ++bj) { const int c = col0 + bj * HALF; float g[8]; unpack8(gw[m][bj], g);
#pragma unroll
                    for (int j = 0; j < 8; ++j) g[j] = fmaxf(g[j], 1e-6f);
                    if (b < 3) { float h[8]; unpack8(gn[m][bj], h);
#pragma unroll
                        for (int j = 0; j < 8; ++j) g[j] *= __builtin_amdgcn_rcpf(fmaxf(h[j], 1e-6f)); }
                    f32x4 v0 = acc[ai][bj][m][0], v1 = acc[ai][bj][m][1];
#pragma unroll
                    for (int j = 0; j < 4; ++j) { v0[j] *= g[j]; v1[j] *= g[4 + j]; }
                    if (b < 3) { acc[ai][bj][m][0] = v0; acc[ai][bj][m][1] = v1; }
                    else { u32x4 w; w.x = cvt_pk_bf16_safe(v0[0], v0[1]); w.y = cvt_pk_bf16_safe(v0[2], v0[3]); w.z = cvt_pk_bf16_safe(v1[0], v1[1]); w.w = cvt_pk_bf16_safe(v1[2], v1[3]);
                        *(u32x4*)(merged + r * 2048 + c) = w; } } }
        }
    }
};
struct EpiGatePartial {
    static constexpr bool PERM = true, AFTER_DRAIN = false;
    const bf16_t* gate; float* P; int nMtot;
    __device__ __forceinline__ void operator()(const f32x4 (&acc)[2][2][4][2], const Unit& u, int wr, int wc, int fr, int fq) const {
        const int b = u.pn >> 3, pn = u.pn & 7, pm = u.pm - b * nMtot;
        const int row0 = pm * BM + wr * 64 + fr, col0 = pn * BM + wc * 32 + 8 * fq;
#pragma unroll
        for (int ai = 0; ai < 2; ++ai) {
            u32x4 gw[4][2];
#pragma unroll
            for (int m = 0; m < 4; ++m) { const size_t r = (size_t)(row0 + ai * HALF + m * 16);
#pragma unroll
                for (int bj = 0; bj < 2; ++bj) gw[m][bj] = *(const u32x4*)(gate + r * NGATE + b * 2048 + col0 + bj * HALF); }
#pragma unroll
            for (int m = 0; m < 4; ++m) { const int r = row0 + ai * HALF + m * 16;
#pragma unroll
                for (int bj = 0; bj < 2; ++bj) { float g[8]; unpack8(gw[m][bj], g);
                    f32x4 v0 = acc[ai][bj][m][0], v1 = acc[ai][bj][m][1];
#pragma unroll
                    for (int j = 0; j < 4; ++j) { v0[j] *= fmaxf(g[j], 1e-6f); v1[j] *= fmaxf(g[4 + j], 1e-6f); }
                    float* p = P + ((size_t)b * MC + (size_t)(r - ML)) * 2048 + col0 + bj * HALF; *(f32x4*)p = v0; *(f32x4*)(p + 4) = v1; } }
        }
    }
};
template <bool SRCF32> struct EpiResid {
    static constexpr bool PERM = true, AFTER_DRAIN = false;
    const void* src; bf16_t* dst; const float* modv;
    int permute; float sc = 1.0f;
    __device__ __forceinline__ void operator()(const f32x4 (&acc)[2][2][4][2], const Unit& u, int wr, int wc, int fr, int fq) const {
        const int row0 = u.pm * BM + wr * 64 + fr, col0 = u.pn * BM + wc * 32 + 8 * fq;
        const int rfirst = u.pm * BM, bb = rfirst >> 14; const float* mp = modv + bb * 12288;
        f32x4 mv[2][2];
#pragma unroll
        for (int bj = 0; bj < 2; ++bj)
#pragma unroll
            for (int n = 0; n < 2; ++n) mv[bj][n] = *(const f32x4*)(mp + col0 + bj * HALF + n * 4) * sc;
#define EPI_ROWOFF(r) ((size_t)(bb << 14) + (size_t)(permute ? ((((r) & 255) << 6) | (((r) & 16383) >> 8)) : ((r) & 16383)))
#pragma unroll
        for (int ai = 0; ai < 2; ++ai) {
            if constexpr (SRCF32) {
#pragma unroll
                for (int mh = 0; mh < 2; ++mh) {
                f32x4 sv[2][2][2];
#pragma unroll
                for (int m = 0; m < 2; ++m) { const int r = row0 + ai * HALF + (mh * 2 + m) * 16; const float* sp = (const float*)src + EPI_ROWOFF(r) * D + col0;
#pragma unroll
                    for (int bj = 0; bj < 2; ++bj)
#pragma unroll
                        for (int n = 0; n < 2; ++n) sv[m][bj][n] = *(const f32x4*)(sp + bj * HALF + n * 4); }
#pragma unroll
                for (int m = 0; m < 2; ++m) { const int r = row0 + ai * HALF + (mh * 2 + m) * 16; bf16_t* dp = dst + EPI_ROWOFF(r) * (2 * D) + col0;
#pragma unroll
                    for (int bj = 0; bj < 2; ++bj) { const f32x4 v0 = sv[m][bj][0] + mv[bj][0] * acc[ai][bj][mh * 2 + m][0], v1 = sv[m][bj][1] + mv[bj][1] * acc[ai][bj][mh * 2 + m][1];
                        u32x4 w; w.x = cvt_pk_bf16_safe(v0[0], v0[1]); w.y = cvt_pk_bf16_safe(v0[2], v0[3]); w.z = cvt_pk_bf16_safe(v1[0], v1[1]); w.w = cvt_pk_bf16_safe(v1[2], v1[3]);
                        *(u32x4*)(dp + bj * HALF) = w; } }
                }
            } else {
                u32x4 sw[4][2];
#pragma unroll
                for (int m = 0; m < 4; ++m) { const int r = row0 + ai * HALF + m * 16; const bf16_t* sp = (const bf16_t*)src + EPI_ROWOFF(r) * (2 * D) + col0;
#pragma unroll
                    for (int bj = 0; bj < 2; ++bj) sw[m][bj] = *(const u32x4*)(sp + bj * HALF); }
#pragma unroll
                for (int m = 0; m < 4; ++m) { const int r = row0 + ai * HALF + m * 16; bf16_t* dp = dst + EPI_ROWOFF(r) * (2 * D) + col0;
#pragma unroll
                    for (int bj = 0; bj < 2; ++bj) { const u32x4 s = sw[m][bj]; f32x4 v0, v1;
                        v0[0] = __uint_as_float(s.x << 16); v0[1] = __uint_as_float(s.x & 0xffff0000u); v0[2] = __uint_as_float(s.y << 16); v0[3] = __uint_as_float(s.y & 0xffff0000u);
                        v1[0] = __uint_as_float(s.z << 16); v1[1] = __uint_as_float(s.z & 0xffff0000u); v1[2] = __uint_as_float(s.w << 16); v1[3] = __uint_as_float(s.w & 0xffff0000u);
                        v0 += mv[bj][0] * acc[ai][bj][m][0]; v1 += mv[bj][1] * acc[ai][bj][m][1];
                        u32x4 w; w.x = cvt_pk_bf16_safe(v0[0], v0[1]); w.y = cvt_pk_bf16_safe(v0[2], v0[3]); w.z = cvt_pk_bf16_safe(v1[0], v1[1]); w.w = cvt_pk_bf16_safe(v1[2], v1[3]);
                        *(u32x4*)(dp + bj * HALF) = w; } }
            }
        }
#undef EPI_ROWOFF
    }
};
template <bool F8OUT> struct EpiSwiglu {
    static constexpr bool PERM = true, AFTER_DRAIN = false;
    void* hid; int nper; float sc;
    __device__ __forceinline__ void operator()(const f32x4 (&acc)[2][2][4][2], const Unit& u, int wr, int wc, int fr, int fq) const {
        const int pn = u.pn % nper; const int row0 = u.pm * BM + wr * 64 + fr, col0 = pn * HALF + wc * 32 + 8 * fq;
#pragma unroll
        for (int ai = 0; ai < 2; ++ai)
#pragma unroll
            for (int m = 0; m < 4; ++m) { const size_t eo = (size_t)(row0 + ai * HALF + m * 16) * FF + col0;
                float o[8];
#pragma unroll
                for (int n = 0; n < 2; ++n)
#pragma unroll
                    for (int j = 0; j < 4; ++j) { const float g = acc[ai][0][m][n][j] * sc, v = acc[ai][1][m][n][j] * sc; o[n * 4 + j] = siluf(g) * v; }
                if (F8OUT) { u32x2 w; w.x = pk_fp8x4(o[0] * 4.f, o[1] * 4.f, o[2] * 4.f, o[3] * 4.f); w.y = pk_fp8x4(o[4] * 4.f, o[5] * 4.f, o[6] * 4.f, o[7] * 4.f); *(u32x2*)((unsigned char*)hid + eo) = w; }
                else { u32x4 w; w.x = cvt_pk_bf16_safe(o[0], o[1]); w.y = cvt_pk_bf16_safe(o[2], o[3]); w.z = cvt_pk_bf16_safe(o[4], o[5]); w.w = cvt_pk_bf16_safe(o[6], o[7]); *(u32x4*)((bf16_t*)hid + eo) = w; } }
    }
};
struct EpiPlainBf16 {
    static constexpr bool PERM = true, AFTER_DRAIN = false;
    bf16_t* O; int ldc; int nper; float sc;
    __device__ __forceinline__ void operator()(const f32x4 (&acc)[2][2][4][2], const Unit& u, int wr, int wc, int fr, int fq) const {
        const int pn = u.pn % nper; const int row0 = u.pm * BM + wr * 64 + fr, col0 = pn * BM + wc * 32 + 8 * fq;
#pragma unroll
        for (int ai = 0; ai < 2; ++ai)
#pragma unroll
            for (int m = 0; m < 4; ++m) { bf16_t* rowp = O + (size_t)(row0 + ai * HALF + m * 16) * ldc + col0;
#pragma unroll
                for (int bj = 0; bj < 2; ++bj) { const f32x4 v0 = acc[ai][bj][m][0] * sc, v1 = acc[ai][bj][m][1] * sc;
                    u32x4 w; w.x = cvt_pk_bf16_safe(v0[0], v0[1]); w.y = cvt_pk_bf16_safe(v0[2], v0[3]); w.z = cvt_pk_bf16_safe(v1[0], v1[1]); w.w = cvt_pk_bf16_safe(v1[2], v1[3]);
                    *(u32x4*)(rowp + bj * HALF) = w; } }
    }
};
struct EpiPartial {
    static constexpr bool PERM = false, AFTER_DRAIN = false;
    float* P; int row_off; int nper = 1 << 20;
    __device__ __forceinline__ void operator()(const f32x4 (&acc)[2][2][4][2], const Unit& u, int wr, int wc, int fr, int fq) const {
        const int row0 = u.pm * BM + wr * 64 + fr - row_off, col0 = (u.pn % nper) * BM + wc * 32 + 4 * fq;
#pragma unroll
        for (int ai = 0; ai < 2; ++ai)
#pragma unroll
            for (int m = 0; m < 4; ++m) { float* rowp = P + (size_t)(row0 + ai * HALF + m * 16) * 2048 + col0;
#pragma unroll
                for (int bj = 0; bj < 2; ++bj)
#pragma unroll
                    for (int n = 0; n < 2; ++n) *(f32x4*)(rowp + bj * HALF + n * 16) = acc[ai][bj][m][n]; }
    }
};
struct OneUnit {
    Unit u; bool has;
    __device__ bool next(int i, Unit& o) const { if (i != 0 || !has) return false; o = u; return true; }
    __device__ __forceinline__ void a_ready(const Unit&) const {}
    __device__ __forceinline__ void done(const Unit&) const {}
};
struct UpGateOrder {
    StaticOrder so; int nMtot;
    __device__ void init(int M, int G, int c, int nMtot_, int wgm) { so.init(M, 2048, G, c, wgm); nMtot = nMtot_; }
    __device__ bool next(int i, Unit& u) const { Unit t; if (!so.next(i >> 2, t)) return false; const int b = i & 3; u.pm = b * nMtot + t.pm; u.pn = b * 8 + t.pn; return true; }
    __device__ __forceinline__ void a_ready(const Unit&) const {}
    __device__ __forceinline__ void done(const Unit&) const {}
};
struct MoeOrder {
    StaticOrder so; int be[8]; int nper;
    __device__ void init(int nused, int nper_, int G, int c, const int* be_, int wgm) { so.init(nused * BM, nper_ * BM, G, c, wgm); nper = nper_;
#pragma unroll
        for (int e = 0; e < 8; ++e) be[e] = be_[e]; }
    __device__ bool next(int i, Unit& u) const { Unit t; if (!so.next(i, t)) return false; int e = 0;
#pragma unroll
        for (int j = 0; j < 7; ++j) e += (t.pm >= be[j]) ? 1 : 0;
        u.pm = t.pm; u.pn = e * nper + t.pn; return true; }
    __device__ __forceinline__ void a_ready(const Unit&) const {}
    __device__ __forceinline__ void done(const Unit&) const {}
};
}

__device__ __forceinline__ int lds_add(volatile LAS int* p) { return __hip_atomic_fetch_add((LAS int*)p, 1, __ATOMIC_RELAXED, __HIP_MEMORY_SCOPE_WORKGROUP); }
typedef const __attribute__((address_space(4))) Args* ArgsP;
#define ARGS_REF const __attribute__((address_space(4))) Args&
struct Ctx { ArgsP a; LAS unsigned char* lds; int tid, lane, wave, wg, G; };

template <int KIND, bool F8>
__device__ __forceinline__ void conv_job_t(const Ctx& c, const float* src, const float* src2, size_t ldsrc, int K, int Nd, void* dstv, float wscale, int& rot) {
    constexpr int KT = F8 ? 256 : 128, NJ = KT / 32, PITCH = KT + 1;
    LAS float* tile = (LAS float*)(c.lds + LDS_SCR);
    const int nkt = K / KT, nnt = Nd / 64, ntile = nkt * nnt, tid = c.tid;
    const int nn4 = tid & 15, kk = tid >> 4;
    int t = (c.wg - rot) % c.G; if (t < 0) t += c.G;
    f32x4 v[NJ];
#define CONV_LOAD(tt) do { const int nt_ = (tt) % nnt, kt_ = (tt) / nnt, n0_ = nt_ * 64, k0_ = kt_ * KT; const float* s_ = src; int c0_ = n0_, nvalid_ = 64; \
        if (KIND == 1) { if (n0_ >= NMIX) nvalid_ = 0; else { nvalid_ = NMIX - n0_; nvalid_ = nvalid_ > 64 ? 64 : nvalid_; } } \
        if (KIND == 2) { const int which_ = (n0_ & 255) >> 7; c0_ = (n0_ >> 8) * 128 + (n0_ & 127); s_ = which_ ? src2 : src; } \
        const float* p_ = s_ + (size_t)(k0_ + kk) * ldsrc + c0_ + 4 * nn4; const bool ok_ = 4 * nn4 < nvalid_; \
        _Pragma("unroll") for (int j = 0; j < NJ; ++j) v[j] = ok_ ? *(const f32x4*)(p_ + (size_t)(32 * j) * ldsrc) : (f32x4){0.f, 0.f, 0.f, 0.f}; } while (0)
    if (t < ntile) CONV_LOAD(t);
    for (; t < ntile; t += c.G) {
#pragma unroll
        for (int j = 0; j < NJ; ++j)
#pragma unroll
            for (int q = 0; q < 4; ++q) tile[(4 * nn4 + q) * PITCH + kk + 32 * j] = v[j][q] * wscale;
        const int nt = t % nnt, kt = t / nnt, n0 = nt * 64, k0 = kt * KT;
        if (t + c.G < ntile) CONV_LOAD(t + c.G);
        __syncthreads();
        const int lane = tid & 63, w = tid >> 6;
#pragma unroll
        for (int p = 0; p < 8; ++p) { const int n = w + 8 * p;
            if (F8) { const LAS float* tp = tile + n * PITCH + 4 * lane; *(unsigned*)((unsigned char*)dstv + (size_t)(n0 + n) * K + k0 + 4 * lane) = pk_fp8x4(tp[0], tp[1], tp[2], tp[3]); }
            else { const LAS float* tp = tile + n * PITCH + 2 * lane; *(unsigned*)((bf16_t*)dstv + (size_t)(n0 + n) * K + k0 + 2 * lane) = pg8::cvt_pk_bf16_safe(tp[0], tp[1]); } }
        __syncthreads();
    }
#undef CONV_LOAD
    rot = (rot + ntile) % c.G;
}
template <int KIND>
__device__ __forceinline__ void conv_job(const Ctx& c, const float* src, const float* src2, size_t ldsrc, int K, int Nd, bf16_t* dst, int& rot) { conv_job_t<KIND, false>(c, src, src2, ldsrc, K, Nd, dst, 1.0f, rot); }
template <int KIND>
__device__ __forceinline__ void conv_job8(const Ctx& c, const float* src, const float* src2, size_t ldsrc, int K, int Nd, unsigned char* dst, float wscale, int& rot) { conv_job_t<KIND, true>(c, src, src2, ldsrc, K, Nd, dst, wscale, rot); }

__device__ __forceinline__ void mod_phase(const Ctx& c) {
    ARGS_REF a = *c.a; const int tid = c.tid;
    LAS float* s = (LAS float*)(c.lds + LDS_SCR);
    LAS float* red = s + 3 * 2048;
    for (int i = tid; i < 3 * 2048; i += 512) { const int r = i >> 11, k = i & 2047; const float cv = (r < 2) ? a.in[I_C][r * 2048 + k] : a.in[I_CCTX][k]; s[i] = siluf(cv); }
    __syncthreads();
    float* modv = (float*)(a.ws + WS_MOD);
    for (int task = c.wg; task < 192; task += c.G) {
        const int l = task / 96, cb = task % 96, cq = tid & 31, kg = tid >> 5;
        const float* w = a.in[I_WMOD] + (size_t)l * 2048 * 12288 + cb * 128 + cq * 4;
        f32x4 a0 = {0.f, 0.f, 0.f, 0.f}, a1 = a0, a2 = a0;
#pragma unroll 8
        for (int k = kg; k < 2048; k += 16) { const f32x4 wv = *(const f32x4*)(w + (size_t)k * 12288); a0 += s[k] * wv; a1 += s[2048 + k] * wv; a2 += s[4096 + k] * wv; }
#pragma unroll
        for (int j = 0; j < 4; ++j) { red[(kg * 3 + 0) * 128 + cq * 4 + j] = a0[j]; red[(kg * 3 + 1) * 128 + cq * 4 + j] = a1[j]; red[(kg * 3 + 2) * 128 + cq * 4 + j] = a2[j]; }
        __syncthreads();
        if (tid < 384) { const int r = tid >> 7, cc = tid & 127; float sum = 0.f;
#pragma unroll
            for (int g = 0; g < 16; ++g) sum += red[(g * 3 + r) * 128 + cc];
            modv[(size_t)(l * 3 + r) * 12288 + cb * 128 + cc] = sum + a.in[I_BMOD][l * 12288 + cb * 128 + cc]; }
        __syncthreads();
    }
}

__device__ __forceinline__ void modnorm_row(f32x4 (&v)[8], const float* nw, const float* shift, const float* scale, int lane) {
    float ss = 0.f;
#pragma unroll
    for (int j = 0; j < 8; ++j) ss += v[j][0] * v[j][0] + v[j][1] * v[j][1] + v[j][2] * v[j][2] + v[j][3] * v[j][3];
    ss = wave_sum(ss);
    const float rstd = __builtin_amdgcn_rsqf(ss * (1.0f / 2048.0f) + EPS);
#pragma unroll
    for (int j = 0; j < 8; ++j) { const int cc = (j * 64 + lane) * 4; const f32x4 w = *(const f32x4*)(nw + cc), sh = *(const f32x4*)(shift + cc), sc = *(const f32x4*)(scale + cc);
        v[j] = (v[j] * rstd * w) * (1.0f + sc) + sh; }
}
__device__ __forceinline__ void store_row_bf16(const f32x4 (&v)[8], bf16_t* hrow, int lane) {
#pragma unroll
    for (int j = 0; j < 8; ++j) { u32x2 w; w.x = pg8::cvt_pk_bf16_safe(v[j][0], v[j][1]); w.y = pg8::cvt_pk_bf16_safe(v[j][2], v[j][3]); *(u32x2*)(hrow + (j * 64 + lane) * 4) = w; }
}
__device__ __forceinline__ void load_xres(f32x4 (&v)[8], const bf16_t* p, int lane) {
#pragma unroll
    for (int j = 0; j < 8; ++j) { const u32x2 w = *(const u32x2*)(p + (j * 64 + lane) * 4); v[j][0] = bflo(w.x); v[j][1] = bfhi(w.x); v[j][2] = bflo(w.y); v[j][3] = bfhi(w.y); }
}
#ifndef FFN2_FP8
#define FFN2_FP8 1
#endif
#define PF_SCALE (FFN2_FP8 ? (1.0f / 256.0f) : 1.0f)
template <int L, int WHICH>
__device__ __forceinline__ void norm_finish(const Ctx& c, f32x4 (&v)[8], int mr, size_t hrow) {
    ARGS_REF a = *c.a; const int lane = c.lane;
    const float* modv = (const float*)(a.ws + WS_MOD) + (size_t)L * 3 * 12288 + (WHICH ? 3 : 0) * 2048;
    const float* normw = a.in[I_NORMW] + (L * 2 + WHICH) * 2048;
    bf16_t* H = (bf16_t*)(a.ws + WS_H);
    const float* shift = modv + (size_t)mr * 12288;
    modnorm_row(v, normw, shift, shift + 2048, lane);
#ifndef FFN13_FP8
#define FFN13_FP8 1
#endif
    if (!(FFN13_FP8 && L == 0 && WHICH == 1)) store_row_bf16(v, H + hrow * D, lane);
    if (WHICH == 0 || L == 0) { unsigned char* h8 = (unsigned char*)(a.ws + WS_H8) + hrow * D;
#pragma unroll
        for (int j = 0; j < 8; ++j) *(unsigned*)(h8 + (j * 64 + lane) * 4) = pk_fp8x4(v[j][0] * 4.f, v[j][1] * 4.f, v[j][2] * 4.f, v[j][3] * 4.f); }
}
template <int L, int WHICH>
__device__ __forceinline__ void norm_phase(const Ctx& c) {
    ARGS_REF a = *c.a; const int gw = c.wg * 8 + c.wave, nw = c.G * 8, lane = c.lane;
#pragma unroll 1
    for (int r = gw; r < ML; r += nw) {
        const int b = r >> 14, t = r & 16383; const size_t hrow = (L == 1 && WHICH == 0) ? (size_t)(b << 14) + ((t & 63) << 8) + (t >> 6) : (size_t)r;
        f32x4 v[8];
        if (L == 0 && WHICH == 0) { const float* src = a.in[I_X] + (size_t)r * D;
#pragma unroll
            for (int j = 0; j < 8; ++j) v[j] = *(const f32x4*)(src + (j * 64 + lane) * 4); }
        else load_xres(v, (const bf16_t*)(a.out + (size_t)r * D), lane);
        norm_finish<L, WHICH>(c, v, b, hrow);
    }
#pragma unroll 1
    for (int rc = gw; rc < MC; rc += nw) {
        int lane = c.lane; asm volatile("" : "+v"(lane));
        const float* src = ((L == 0 && WHICH == 0) ? a.in[I_CTX] : (const float*)(a.ws + WS_XC)) + (size_t)rc * D;
        f32x4 v[8];
#pragma unroll
        for (int j = 0; j < 8; ++j) v[j] = *(const f32x4*)(src + (j * 64 + lane) * 4);
        if (L == 0 && WHICH == 1) {
            const float* pw = (const float*)(a.ws + WS_PW) + (size_t)rc * D; const float* g2 = (const float*)(a.ws + WS_MOD) + (size_t)(0 * 3 + 2) * 12288 + 2 * 2048;
            const float* cin = a.in[I_CTX] + (size_t)rc * D; float* xcw = (float*)(a.ws + WS_XC) + (size_t)rc * D;
#pragma unroll
            for (int j = 0; j < 8; ++j) { const int cc = (j * 64 + lane) * 4; f32x4 sum = *(const f32x4*)(pw + cc);
#pragma unroll
                for (int ks = 1; ks < 8; ++ks) sum += *(const f32x4*)(pw + (size_t)ks * MC * D + cc);
                v[j] = *(const f32x4*)(cin + cc) + *(const f32x4*)(g2 + cc) * sum; *(f32x4*)(xcw + cc) = v[j];
                if (j & 1) __builtin_amdgcn_sched_barrier(0); } }
        if (L == 1 && WHICH == 0) {
            const float* pf = (const float*)(a.ws + WS_PF) + (size_t)rc * D; const float* g5 = (const float*)(a.ws + WS_MOD) + (size_t)(0 * 3 + 2) * 12288 + 5 * 2048;
#pragma unroll
            for (int j = 0; j < 8; ++j) { const int cc = (j * 64 + lane) * 4; f32x4 sum = *(const f32x4*)(pf + cc);
#pragma unroll
                for (int ks = 1; ks < 11; ++ks) sum += *(const f32x4*)(pf + (size_t)ks * MC * D + cc);
                v[j] += *(const f32x4*)(g5 + cc) * sum * PF_SCALE;
                if (j & 1) __builtin_amdgcn_sched_barrier(0); } }
        norm_finish<L, WHICH>(c, v, 2, (size_t)(ML + rc));
    }
}

template <int L>
__device__ __forceinline__ void rgprep_item(const Ctx& c, int item) {
    ARGS_REF a = *c.a; const int tid = c.tid;
    LAS float* xbT = (LAS float*)(c.lds + LDS_SCR);
    const bf16_t* PM = (const bf16_t*)(a.ws + WS_PMIX);
    bf16_t* RGLA = (bf16_t*)(a.ws + WS_RGLA); bf16_t* RGU = (bf16_t*)(a.ws + WS_RGU);
    const float* cw = a.in[I_RG_CW] + L * 4 * 512; const float* cb = a.in[I_RG_CB] + L * 512;
    {
        const int tt = item >> 2, n = item & 3;
        size_t rowbase; int t0, Ls;
        if (tt < 512) { const int b = tt >> 8; rowbase = (size_t)b * T; t0 = (tt & 255) * 64; Ls = T; }
        else { const int tc = tt - 512, b = tc >> 2; rowbase = (size_t)ML + b * CL; t0 = (tc & 3) * 64; Ls = CL; }
        __syncthreads();
        {
            const int tl = tid >> 3, cg = tid & 7, ch0 = n * 128 + cg * 16;
            float acc[16];
#pragma unroll
            for (int j = 0; j < 16; ++j) acc[j] = cb[ch0 + j];
#pragma unroll
            for (int tap = 0; tap < 4; ++tap) { const int ts = t0 + tl + tap - 2;
                if (ts >= 0 && ts < Ls) { const bf16_t* rp = PM + (rowbase + ts) * NMIXP + C_RG_X + ch0; const u32x4 w0 = *(const u32x4*)rp, w1 = *(const u32x4*)(rp + 8);
                    float f[8], g[8]; unpack8(w0, f); unpack8(w1, g);
#pragma unroll
                    for (int j = 0; j < 8; ++j) { acc[j] += cw[tap * 512 + ch0 + j] * f[j]; acc[8 + j] += cw[tap * 512 + ch0 + 8 + j] * g[j]; } } }
#pragma unroll
            for (int j = 0; j < 16; ++j) xbT[(cg * 16 + j) * 68 + tl] = acc[j];
        }
        __syncthreads();
        const int oc = tid & 127, tg = tid >> 7, ch = n * 128 + oc;
#pragma unroll 1
        for (int d = 0; d < 2; ++d) {
            const float* wr = a.in[I_RG_WR] + ((size_t)((L * 2 + d) * 4 + n) * 128) * 128 + oc;
            const float* wi = a.in[I_RG_WI] + ((size_t)((L * 2 + d) * 4 + n) * 128) * 128 + oc;
            float ar[16], ai[16];
#pragma unroll
            for (int j = 0; j < 16; ++j) { ar[j] = 0.f; ai[j] = 0.f; }
#pragma unroll 4
            for (int k = 0; k < 128; ++k) { const float w1 = wr[k * 128], w2 = wi[k * 128];
                const LAS f32x4* xp = (const LAS f32x4*)(xbT + k * 68 + tg * 16);
#pragma unroll
                for (int q = 0; q < 4; ++q) { const f32x4 xv = xp[q];
#pragma unroll
                    for (int j = 0; j < 4; ++j) { ar[q * 4 + j] += xv[j] * w1; ai[q * 4 + j] += xv[j] * w2; } } }
            const float br = a.in[I_RG_BR][(L * 2 + d) * 512 + ch], bi = a.in[I_RG_BI][(L * 2 + d) * 512 + ch];
            const float sp = softplusf(-a.in[I_RG_LAM][(L * 2 + d) * 512 + ch]);
#pragma unroll
            for (int j = 0; j < 16; ++j) { const int tl = tg * 16 + j; const float r = sigm(ar[j] + br), ig = sigm(ai[j] + bi);
                const float la = -8.0f * r * sp; const float xb = xbT[oc * 68 + tl];
                const float u = sqrtf(fmaxf(-expm1f(2.0f * la), 0.f)) * (ig * xb);
                const size_t o = ((size_t)d * MT + rowbase + t0 + tl) * 512 + ch;
                RGLA[o] = (bf16_t)(pg8::cvt_pk_bf16_safe(la, 0.f) & 0xffffu); RGU[o] = (bf16_t)(pg8::cvt_pk_bf16_safe(u, 0.f) & 0xffffu); }
        }
    }
}

template <int L>
__device__ __forceinline__ void chain_gla(const Ctx& c, int b, int h, int d, int vh) {
    ARGS_REF a = *c.a; const int tid = c.tid;
    LAS float* qs = (LAS float*)(c.lds + LDS_SCR); LAS float* ks = qs + 4096; LAS float* fs = ks + 4096; LAS float* vs = fs + 4096; LAS float* os = vs + 4096;
    LAS float* wa = (LAS float*)(c.lds + LDS_AUX);
    const bf16_t* PM = (const bf16_t*)(a.ws + WS_PMIX);
    bf16_t* ORAW = (bf16_t*)(a.ws + WS_ORAW) + (size_t)d * MT * 2048;
    for (int i = tid; i < 1024; i += 512) wa[i] = a.in[I_GLA_WA2][((L * 2 + d) * 16 + (i >> 6)) * 256 + h * 64 + (i & 63)];
    if (tid < 64) wa[1024 + tid] = a.in[I_GLA_BA2][(L * 2 + d) * 256 + h * 64 + tid];
    float s[8];
#pragma unroll
    for (int j = 0; j < 8; ++j) s[j] = 0.f;
    const int vc = tid >> 3, kq = tid & 7;
#pragma unroll 1
    for (int seg = 0; seg < 2; ++seg) {
        const int Ls = seg ? T : CL; const size_t rowbase = seg ? (size_t)b * T : (size_t)ML + b * CL;
#pragma unroll 1
        for (int jb = 0; jb < Ls / 64; ++jb) {
            const int r0 = d ? Ls - 64 * (jb + 1) : 64 * jb;
            __syncthreads();
            {   const int i = tid >> 3, cg = tid & 7, lr = d ? 63 - i : i; const bf16_t* rp = PM + (rowbase + r0 + lr) * NMIXP;
                float fq[8], fk[8], fv[8], fa[16];
                { const u32x4 w = *(const u32x4*)(rp + C_GLA_Q + h * 64 + cg * 8); unpack8(w, fq); }
                { const u32x4 w = *(const u32x4*)(rp + C_GLA_K + h * 64 + cg * 8); unpack8(w, fk); }
                { const u32x4 w = *(const u32x4*)(rp + C_GLA_V + h * 128 + vh * 64 + cg * 8); unpack8(w, fv); }
                { const u32x4 w0 = *(const u32x4*)(rp + C_GLA_A + d * 16), w1 = *(const u32x4*)(rp + C_GLA_A + d * 16 + 8); float t0[8], t1[8]; unpack8(w0, t0); unpack8(w1, t1);
#pragma unroll
                  for (int j = 0; j < 8; ++j) { fa[j] = t0[j]; fa[8 + j] = t1[j]; } }
#pragma unroll
                for (int j = 0; j < 8; ++j) { const int o = i * 64 + cg * 8 + j; qs[o] = fq[j] * 0.125f; ks[o] = fk[j]; vs[o] = fv[j];
                    float z = wa[1024 + cg * 8 + j];
#pragma unroll
                    for (int r = 0; r < 16; ++r) z += fa[r] * wa[r * 64 + cg * 8 + j];
                    fs[o] = __expf(-softplusf(-z) * (1.0f / 16.0f)); }
            }
            __syncthreads();
#pragma unroll 2
            for (int i = 0; i < 64; ++i) {
                const f32x4 f0 = *(const LAS f32x4*)(fs + i * 64 + kq * 8), f1 = *(const LAS f32x4*)(fs + i * 64 + kq * 8 + 4);
                const f32x4 k0 = *(const LAS f32x4*)(ks + i * 64 + kq * 8), k1 = *(const LAS f32x4*)(ks + i * 64 + kq * 8 + 4);
                const f32x4 q0 = *(const LAS f32x4*)(qs + i * 64 + kq * 8), q1 = *(const LAS f32x4*)(qs + i * 64 + kq * 8 + 4);
                const float vv = vs[i * 64 + vc]; float po = 0.f;
#pragma unroll
                for (int j = 0; j < 4; ++j) { s[j] = f0[j] * s[j] + k0[j] * vv; s[4 + j] = f1[j] * s[4 + j] + k1[j] * vv; po += s[j] * q0[j] + s[4 + j] * q1[j]; }
                po += __shfl_xor(po, 1); po += __shfl_xor(po, 2); po += __shfl_xor(po, 4);
                if (kq == 0) os[i * 64 + vc] = po;
            }
            __syncthreads();
            {   const int i = tid >> 3, cg = tid & 7, lr = d ? 63 - i : i; float o[8];
#pragma unroll
                for (int j = 0; j < 8; ++j) o[j] = os[i * 64 + cg * 8 + j];
                *(u32x4*)(ORAW + (rowbase + r0 + lr) * 2048 + 0 * 512 + h * 128 + vh * 64 + cg * 8) = pack8(o); }
        }
    }
}
template <int L>
__device__ __forceinline__ void chain_hg(const Ctx& c, int b, int h, int d, int vh) {
    ARGS_REF a = *c.a; const int tid = c.tid;
    LAS float* qs = (LAS float*)(c.lds + LDS_SCR); LAS float* ks = qs + 8192; LAS float* fs = ks + 8192; LAS float* vs = fs + 8192; LAS float* os = vs + 4096;
    LAS float* lbs = (LAS float*)(c.lds + LDS_AUX);
    const bf16_t* PM = (const bf16_t*)(a.ws + WS_PMIX);
    bf16_t* ORAW = (bf16_t*)(a.ws + WS_ORAW) + (size_t)d * MT * 2048;
    if (tid < 128) { float lb = 0.f; if (L == 1) { const float l0 = a.in[I_HG_LB][h * 128 + tid], l1 = a.in[I_HG_LB][512 + h * 128 + tid]; lb = __builtin_amdgcn_rcpf(1.0f + __expf(l0 - l1)); } lbs[tid] = lb; }
    float s[16];
#pragma unroll
    for (int j = 0; j < 16; ++j) s[j] = 0.f;
    const int vc = tid >> 3, kq = tid & 7;
#pragma unroll 1
    for (int seg = 0; seg < 2; ++seg) {
        const int Ls = seg ? T : CL; const size_t rowbase = seg ? (size_t)b * T : (size_t)ML + b * CL;
#pragma unroll 1
        for (int jb = 0; jb < Ls / 64; ++jb) {
            const int r0 = d ? Ls - 64 * (jb + 1) : 64 * jb;
            __syncthreads();
            {   const int i = tid >> 3, cg = tid & 7, lr = d ? 63 - i : i; const bf16_t* rp = PM + (rowbase + r0 + lr) * NMIXP;
#pragma unroll
                for (int hf = 0; hf < 2; ++hf) { const int ch = cg * 16 + hf * 8; float fq[8], fz[8];
                    { const u32x4 w = *(const u32x4*)(rp + C_HG_Q + h * 128 + ch); unpack8(w, fq); }
                    { const u32x4 w = *(const u32x4*)(rp + C_HG_F + d * 512 + h * 128 + ch); unpack8(w, fz); }
#pragma unroll
                    for (int j = 0; j < 8; ++j) { const int o = i * 128 + ch + j; const float lb = lbs[ch + j], sg = sigm(fz[j]);
                        qs[o] = siluf(fq[j]) * 0.08838834764831845f; fs[o] = fmaxf(lb + (1.0f - lb) * sg, 1e-30f); ks[o] = (1.0f - lb) * (1.0f - sg); } }
                float fv[8]; { const u32x4 w = *(const u32x4*)(rp + C_HG_I + h * 128 + vh * 64 + cg * 8); unpack8(w, fv); }
#pragma unroll
                for (int j = 0; j < 8; ++j) vs[i * 64 + cg * 8 + j] = fv[j];
            }
            __syncthreads();
#pragma unroll 2
            for (int i = 0; i < 64; ++i) {
                const float vv = vs[i * 64 + vc]; float po = 0.f;
#pragma unroll
                for (int q4 = 0; q4 < 4; ++q4) {
                    const f32x4 f0 = *(const LAS f32x4*)(fs + i * 128 + kq * 16 + q4 * 4), k0 = *(const LAS f32x4*)(ks + i * 128 + kq * 16 + q4 * 4), q0 = *(const LAS f32x4*)(qs + i * 128 + kq * 16 + q4 * 4);
#pragma unroll
                    for (int j = 0; j < 4; ++j) { s[q4 * 4 + j] = f0[j] * s[q4 * 4 + j] + k0[j] * vv; po += s[q4 * 4 + j] * q0[j]; } }
                po += __shfl_xor(po, 1); po += __shfl_xor(po, 2); po += __shfl_xor(po, 4);
                if (kq == 0) os[i * 64 + vc] = po;
            }
            __syncthreads();
            {   const int i = tid >> 3, cg = tid & 7, lr = d ? 63 - i : i; float o[8];
#pragma unroll
                for (int j = 0; j < 8; ++j) o[j] = os[i * 64 + cg * 8 + j];
                *(u32x4*)(ORAW + (rowbase + r0 + lr) * 2048 + 1 * 512 + h * 128 + vh * 64 + cg * 8) = pack8(o); }
        }
    }
}
template <int L>
__device__ __forceinline__ void chain_dn(const Ctx& c, int b, int h, int d, int vh) {
    ARGS_REF a = *c.a; const int tid = c.tid;
    LAS float* qs = (LAS float*)(c.lds + LDS_SCR); LAS float* ks = qs + 8192; LAS float* vs = ks + 8192; LAS float* os = vs + 4096; LAS float* as = os + 4096; LAS float* bs = as + 64;
    LAS float* cwl = (LAS float*)(c.lds + LDS_AUX);
    const bf16_t* PM = (const bf16_t*)(a.ws + WS_PMIX);
    bf16_t* ORAW = (bf16_t*)(a.ws + WS_ORAW) + (size_t)d * MT * 2048;
    for (int i = tid; i < 4 * 320; i += 512) { const int tap = i / 320, cc = i % 320; const int ch = cc < 128 ? h * 128 + cc : (cc < 256 ? 512 + h * 128 + (cc - 128) : 1024 + h * 128 + vh * 64 + (cc - 256));
        cwl[i] = a.in[I_DN_CW][(L * 4 + tap) * 1536 + ch]; }
    const float neg_ea = -expf(a.in[I_DN_ALOG][(L * 2 + d) * 4 + h]), dtb = a.in[I_DN_DTB][(L * 2 + d) * 4 + h];
    float s[16];
#pragma unroll
    for (int j = 0; j < 16; ++j) s[j] = 0.f;
    const int vc = tid >> 3, kq = tid & 7;
#pragma unroll 1
    for (int seg = 0; seg < 2; ++seg) {
        const int Ls = seg ? T : CL; const size_t rowbase = seg ? (size_t)b * T : (size_t)ML + b * CL;
#pragma unroll 1
        for (int jb = 0; jb < Ls / 64; ++jb) {
            const int r0 = d ? Ls - 64 * (jb + 1) : 64 * jb;
            __syncthreads();
            {   const int i = tid >> 3, cg = tid & 7, lr = d ? 63 - i : i, t = r0 + lr;
                float aq[16], ak[16], av[8];
#pragma unroll
                for (int j = 0; j < 16; ++j) { aq[j] = 0.f; ak[j] = 0.f; }
#pragma unroll
                for (int j = 0; j < 8; ++j) av[j] = 0.f;
#pragma unroll
                for (int tap = 0; tap < 4; ++tap) { const int ts = t + tap - 2;
                    if (ts >= 0 && ts < Ls) { const bf16_t* rp = PM + (rowbase + ts) * NMIXP; const LAS float* w = cwl + tap * 320;
                        float f0[8], f1[8];
                        { const u32x4 w0 = *(const u32x4*)(rp + C_DN_Q + h * 128 + cg * 16), w1 = *(const u32x4*)(rp + C_DN_Q + h * 128 + cg * 16 + 8); unpack8(w0, f0); unpack8(w1, f1); }
#pragma unroll
                        for (int j = 0; j < 8; ++j) { aq[j] += w[cg * 16 + j] * f0[j]; aq[8 + j] += w[cg * 16 + 8 + j] * f1[j]; }
                        { const u32x4 w0 = *(const u32x4*)(rp + C_DN_K + h * 128 + cg * 16), w1 = *(const u32x4*)(rp + C_DN_K + h * 128 + cg * 16 + 8); unpack8(w0, f0); unpack8(w1, f1); }
#pragma unroll
                        for (int j = 0; j < 8; ++j) { ak[j] += w[128 + cg * 16 + j] * f0[j]; ak[8 + j] += w[128 + cg * 16 + 8 + j] * f1[j]; }
                        { const u32x4 w0 = *(const u32x4*)(rp + C_DN_V + h * 128 + vh * 64 + cg * 8); unpack8(w0, f0); }
#pragma unroll
                        for (int j = 0; j < 8; ++j) av[j] += w[256 + cg * 8 + j] * f0[j]; } }
#pragma unroll
                for (int j = 0; j < 16; ++j) { qs[i * 128 + cg * 16 + j] = siluf(aq[j]); ks[i * 128 + cg * 16 + j] = siluf(ak[j]); }
#pragma unroll
                for (int j = 0; j < 8; ++j) vs[i * 64 + cg * 8 + j] = siluf(av[j]);
                if (tid < 64) { const int lr2 = d ? 63 - tid : tid; const bf16_t* rp = PM + (rowbase + r0 + lr2) * NMIXP;
                    const float g = neg_ea * softplusf(bf1(rp + C_DN_A + d * 4 + h) + dtb); as[tid] = __expf(g); bs[tid] = sigm(bf1(rp + C_DN_B + d * 4 + h)); }
            }
            __syncthreads();
            {
                const int rowid = tid >> 2, part = tid & 3; LAS float* p = (rowid < 64 ? qs + rowid * 128 : ks + (rowid - 64) * 128) + part * 32; float ss = 0.f;
#pragma unroll
                for (int j = 0; j < 32; ++j) ss += p[j] * p[j];
                ss += __shfl_xor(ss, 1); ss += __shfl_xor(ss, 2);
                const float rs = __builtin_amdgcn_rsqf(ss + EPS) * (rowid < 64 ? 0.08838834764831845f : 1.0f);
#pragma unroll
                for (int j = 0; j < 32; ++j) p[j] *= rs;
            }
            __syncthreads();
#pragma unroll 2
            for (int i = 0; i < 64; ++i) {
                f32x4 kk[4]; float kts = 0.f;
#pragma unroll
                for (int q4 = 0; q4 < 4; ++q4) { kk[q4] = *(const LAS f32x4*)(ks + i * 128 + kq * 16 + q4 * 4);
#pragma unroll
                    for (int j = 0; j < 4; ++j) kts += s[q4 * 4 + j] * kk[q4][j]; }
                kts += __shfl_xor(kts, 1); kts += __shfl_xor(kts, 2); kts += __shfl_xor(kts, 4);
                const float al = as[i], be = bs[i]; const float vn = be * (vs[i * 64 + vc] - al * kts); float po = 0.f;
#pragma unroll
                for (int q4 = 0; q4 < 4; ++q4) { const f32x4 q0 = *(const LAS f32x4*)(qs + i * 128 + kq * 16 + q4 * 4);
#pragma unroll
                    for (int j = 0; j < 4; ++j) { s[q4 * 4 + j] = al * s[q4 * 4 + j] + kk[q4][j] * vn; po += s[q4 * 4 + j] * q0[j]; } }
                po += __shfl_xor(po, 1); po += __shfl_xor(po, 2); po += __shfl_xor(po, 4);
                if (kq == 0) os[i * 64 + vc] = po;
            }
            __syncthreads();
            {   const int i = tid >> 3, cg = tid & 7, lr = d ? 63 - i : i; float o[8];
#pragma unroll
                for (int j = 0; j < 8; ++j) o[j] = os[i * 64 + cg * 8 + j];
                *(u32x4*)(ORAW + (rowbase + r0 + lr) * 2048 + 2 * 512 + h * 128 + vh * 64 + cg * 8) = pack8(o); }
        }
    }
}
__device__ __forceinline__ void chain_rg(const Ctx& c, int gw  ) {
    ARGS_REF a = *c.a; const int b = gw >> 3, d = (gw >> 2) & 1, ch = (gw & 3) * 128 + c.lane * 2;
    const bf16_t* RGLA = (const bf16_t*)(a.ws + WS_RGLA) + (size_t)d * MT * 512 + ch; const bf16_t* RGU = (const bf16_t*)(a.ws + WS_RGU) + (size_t)d * MT * 512 + ch;
    bf16_t* ORAW = (bf16_t*)(a.ws + WS_ORAW) + (size_t)d * MT * 2048 + 1536 + ch;
    float h0 = 0.f, h1 = 0.f;
#pragma unroll 1
    for (int seg = 0; seg < 2; ++seg) {
        const int Ls = seg ? T : CL; const size_t rowbase = seg ? (size_t)b * T : (size_t)ML + b * CL;
#pragma unroll 1
        for (int s0 = 0; s0 < Ls; s0 += 16) {
            unsigned la[16], uu[16];
#pragma unroll
            for (int j = 0; j < 16; ++j) { const size_t row = rowbase + (d ? Ls - 1 - (s0 + j) : s0 + j); la[j] = *(const unsigned*)(RGLA + row * 512); uu[j] = *(const unsigned*)(RGU + row * 512); }
#pragma unroll
            for (int j = 0; j < 16; ++j) { const size_t row = rowbase + (d ? Ls - 1 - (s0 + j) : s0 + j);
                h0 = __expf(bflo(la[j])) * h0 + bflo(uu[j]); h1 = __expf(bfhi(la[j])) * h1 + bfhi(uu[j]);
                *(unsigned*)(ORAW + row * 2048) = pg8::cvt_pk_bf16_safe(h0, h1); }
        }
    }
}

typedef float f32x16 __attribute__((ext_vector_type(16)));
typedef pg8::bf16x8 bf16x8;
#define LBAR() do { asm volatile("s_waitcnt lgkmcnt(0)" ::: "memory"); __builtin_amdgcn_s_barrier(); asm volatile("" ::: "memory"); } while (0)
#define MFMA32(a, b, c) __builtin_amdgcn_mfma_f32_32x32x16_bf16((a), (b), (c), 0, 0, 0)
template <int S_> __device__ __forceinline__ bf16x8 pack_step(const f32x16& x) {
    f32x8 v;
#pragma unroll
    for (int j = 0; j < 8; ++j) v[j] = x[8 * S_ + j];
    return __builtin_bit_cast(bf16x8, __builtin_convertvector(v, bfx8_t));
}
__device__ __forceinline__ float bf1(const LAS bf16_t* p) { return __uint_as_float(((unsigned)*p) << 16); }
__device__ __forceinline__ bf16_t f2bf(float f) { const __bf16 b = (__bf16)f; return __builtin_bit_cast(bf16_t, b); }
__device__ __forceinline__ int permpos(int k) { const int w = k & 15; return (k & ~15) + (((w >> 2) & 1) << 3) + ((w >> 3) << 2) + (w & 3); }
__device__ __forceinline__ int crow16(int idx, int hh) { return (idx & 3) + 8 * (idx >> 2) + 4 * hh; }
__device__ __forceinline__ size_t chunk_rowbase(int b, int n) { return n < 4 ? (size_t)ML + b * CL + n * 64 : (size_t)b * T + (size_t)(n - 4) * 64; }

template <int L, int TY>
__device__ __forceinline__ void intra_g_item(const Ctx& c, int b, int h, int n) {
    constexpr int K = TY ? 128 : 64, NSEG = 512 / K, TS = 64 / NSEG, QPITCH = 2 * K + 16, RP = 2 * K;
    constexpr int O_RQ = 0, O_RZ0 = O_RQ + 64 * RP, O_RZ1 = O_RZ0 + 64 * RP  , O_RV = O_RZ1 + 64 * RP, O_QH = O_RV + 64 * 256,
                  O_KH = O_QH + 64 * QPITCH, O_SEG = O_KH + 64 * QPITCH, O_QO = O_SEG + 2048, O_AO = O_QO + 64 * RP, O_END = O_AO + 8192;
    static_assert(O_END <= 147456, "intra_g LDS");
    ARGS_REF a = *c.a; const int tid = c.tid;
    const bf16_t* PM = (const bf16_t*)(a.ws + WS_PMIX);
    unsigned char* scr = a.ws + WS_SCR;
    const size_t rowbase = chunk_rowbase(b, n);
    const int rec = (b * 4 + h) * 260 + n;
    LAS unsigned char* lds = c.lds + LDS_SCR;
    LAS unsigned char* Qh = lds + O_QH; LAS unsigned char* Kh = lds + O_KH; LAS float* segtot = (LAS float*)(lds + O_SEG);
    LBAR();
    {
        const char* pb = (const char*)(PM + rowbase * NMIXP); asm volatile("" : "+s"(pb));
        constexpr int PPR = K / 8;
#pragma unroll
        for (int i = 0; i < 64 * PPR / 512; ++i) { const int p = i * 512 + tid, t = p / PPR, cc = p % PPR; const unsigned ro = (unsigned)(t * NMIXP) * 2u + cc * 16;
            *(LAS u32x4*)(lds + O_RQ + p * 16) = *(const u32x4*)(pb + ro + ((TY ? C_HG_Q : C_GLA_Q) + h * K) * 2);
            if (TY) { *(LAS u32x4*)(lds + O_RZ0 + p * 16) = *(const u32x4*)(pb + ro + (C_HG_F + h * 128) * 2); *(LAS u32x4*)(lds + O_RZ1 + p * 16) = *(const u32x4*)(pb + ro + (C_HG_F + 512 + h * 128) * 2); }
            else *(LAS u32x4*)(lds + O_RZ0 + p * 16) = *(const u32x4*)(pb + ro + (C_GLA_K + h * 64) * 2); }
        if (TY == 0 && tid < 256) { const int t = tid >> 2, cc = tid & 3; *(LAS u32x4*)(lds + O_RZ1 + tid * 16) = *(const u32x4*)(pb + (unsigned)(t * NMIXP) * 2u + cc * 16 + C_GLA_A * 2); }
#pragma unroll
        for (int i = 0; i < 2; ++i) { const int p = i * 512 + tid, t = p >> 4, cc = p & 15;
            *(LAS u32x4*)(lds + O_RV + p * 16) = *(const u32x4*)(pb + (unsigned)(t * NMIXP) * 2u + cc * 16 + ((TY ? C_HG_I : C_GLA_V) + h * 128) * 2); }
    }
    LBAR();
    {
        const int v = tid & 127, t0 = (tid >> 7) * 16; float v0[8], v1[8];
#pragma unroll
        for (int j = 0; j < 8; ++j) { v0[j] = bf1((const LAS bf16_t*)(lds + O_RV + (t0 + j) * 256 + v * 2)); v1[j] = bf1((const LAS bf16_t*)(lds + O_RV + (t0 + 8 + j) * 256 + v * 2)); }
        u32x4* dst = (u32x4*)(scr + (TY ? SC_HG_VT : SC_GLA_VT) + (size_t)rec * 16384 + v * 128 + t0 * 2);
        dst[0] = pack8(v0); dst[1] = pack8(v1);
    }
    const int k = tid & (K - 1), tq = tid / K;
    float lb = 0.f;
    if (TY == 1 && L == 1) { const float l0 = a.in[I_HG_LB][h * 128 + k], l1 = a.in[I_HG_LB][512 + h * 128 + k]; lb = __builtin_amdgcn_rcpf(1.0f + __expf(l0 - l1)); }
#pragma unroll 1
    for (int d = 0; d < 2; ++d) {
        float qv[TS], kv[TS], bv[TS];
        if (TY == 0) {
            float w[16]; const float bias = a.in[I_GLA_BA2][(L * 2 + d) * 256 + h * 64 + k];
#pragma unroll
            for (int r = 0; r < 16; ++r) w[r] = a.in[I_GLA_WA2][((L * 2 + d) * 16 + r) * 256 + h * 64 + k];
#pragma unroll
            for (int j = 0; j < TS; ++j) { const int t = TS * tq + j;
                qv[j] = bf1((const LAS bf16_t*)(lds + O_RQ + t * RP + k * 2)) * 0.125f; kv[j] = bf1((const LAS bf16_t*)(lds + O_RZ0 + t * RP + k * 2));
                const u32x4 w0 = *(const LAS u32x4*)(lds + O_RZ1 + t * 64 + d * 32), w1 = *(const LAS u32x4*)(lds + O_RZ1 + t * 64 + d * 32 + 16); float f0[8], f1[8]; unpack8(w0, f0); unpack8(w1, f1);
                float z = bias;
#pragma unroll
                for (int r = 0; r < 8; ++r) { z += f0[r] * w[r]; z += f1[r] * w[8 + r]; }
                bv[j] = -softplusf(-z) * (1.0f / 16.0f); }
        } else {
#pragma unroll
            for (int j = 0; j < TS; ++j) { const int t = TS * tq + j;
                qv[j] = siluf(bf1((const LAS bf16_t*)(lds + O_RQ + t * RP + k * 2))) * 0.08838834764831845f;
                const float sg = sigm(bf1((const LAS bf16_t*)(lds + (d ? O_RZ1 : O_RZ0) + t * RP + k * 2)));
                bv[j] = __logf(fmaxf(lb + (1.0f - lb) * sg, 1e-30f)); kv[j] = (1.0f - lb) * (1.0f - sg); }
        }
        float run = 0.f;
        if (d == 0) {
#pragma unroll
            for (int j = 0; j < TS; ++j) { run += bv[j]; bv[j] = run; } }
        else {
#pragma unroll
            for (int j = TS - 1; j >= 0; --j) { run += bv[j]; bv[j] = run; } }
        segtot[tq * K + k] = run;
        LBAR();
        float off = 0.f, tot = 0.f, R = 0.f;
#pragma unroll
        for (int sg = 0; sg < NSEG; ++sg) { const float s = segtot[sg * K + k]; tot += s;
            if (d ? (sg > tq) : (sg < tq)) off += s;
            if (d ? (sg >= NSEG / 2) : (sg < NSEG / 2)) R += s; }
        const size_t drec = (size_t)((d * 8 + b * 4 + h) * 260 + n);
        bf16_t* ktp = (bf16_t*)(scr + (TY ? SC_HG_KT : SC_GLA_KT) + drec * (64 * K * 2));
        const int pk = permpos(k);
        float kt[TS];
#pragma unroll
        for (int j = 0; j < TS; ++j) { const int t = TS * tq + j; const float B = off + bv[j];
            *(LAS bf16_t*)(lds + O_QO + t * RP + pk * 2) = f2bf(qv[j] * __expf(B));
            kt[j] = kv[j] * __expf(tot - B);
            *(LAS bf16_t*)(Qh + t * QPITCH + k * 2) = f2bf(qv[j] * __expf(fminf(B - R, 60.f)));
            *(LAS bf16_t*)(Kh + t * QPITCH + k * 2) = f2bf(kv[j] * __expf(fminf(R - B, 60.f))); }
        {   u32x4* dst = (u32x4*)(ktp + k * 64 + TS * tq);
#pragma unroll
            for (int g = 0; g < TS / 8; ++g) { float t8[8];
#pragma unroll
                for (int j = 0; j < 8; ++j) t8[j] = kt[g * 8 + j];
                dst[g] = pack8(t8); } }
        if (tq == 0) ((float*)(scr + (TY ? SC_HG_LAM : SC_GLA_LAM) + drec * (K * 4)))[k] = __expf(tot);
        LBAR();
        if (c.wave < 4) {
            const int it = c.wave >> 1, jt = c.wave & 1, r = c.lane & 31, hh = c.lane >> 5;
            f32x16 acc;
#pragma unroll
            for (int i = 0; i < 16; ++i) acc[i] = 0.f;
            const bool dead = d ? (it == 1 && jt == 0) : (it == 0 && jt == 1);
            if (!dead) {
#pragma unroll
                for (int ks = 0; ks < K / 16; ++ks) { const bf16x8 af = *(const LAS bf16x8*)(Qh + (32 * it + r) * QPITCH + ks * 32 + hh * 16), bfr = *(const LAS bf16x8*)(Kh + (32 * jt + r) * QPITCH + ks * 32 + hh * 16);
                    acc = MFMA32(af, bfr, acc); } }
            const int jj = 32 * jt + r;
#pragma unroll
            for (int i = 0; i < 16; ++i) { const int ii = 32 * it + crow16(i, hh); const bool ok = d ? (jj >= ii) : (jj <= ii); *(LAS bf16_t*)(lds + O_AO + ii * 128 + jj * 2) = f2bf(ok ? acc[i] : 0.f); }
        }
        LBAR();
        {
            u32x4* qp = (u32x4*)(scr + (TY ? SC_HG_QP : SC_GLA_QP) + drec * (64 * K * 2)); u32x4* ap = (u32x4*)(scr + (TY ? SC_HG_A : SC_GLA_A) + drec * 8192);
#pragma unroll
            for (int i = 0; i < 64 * K * 2 / 16 / 512; ++i) qp[i * 512 + tid] = *(const LAS u32x4*)(lds + O_QO + (i * 512 + tid) * 16);
            ap[tid] = *(const LAS u32x4*)(lds + O_AO + tid * 16);
        }
    }
}

template <int TY> struct GChunk {
    static constexpr int K = TY ? 128 : 64, QPITCH = 2 * K + 16, RQ = 64 * K * 2 / 16 / 256  , NRL = 2 * RQ + 2 + 4;
    static constexpr int OFF_QP = 0, OFF_KT = 64 * QPITCH, OFF_A = OFF_KT + K * 144, OFF_VT = OFF_A + 64 * 144, OFF_LAM = OFF_VT + 128 * 144, BYTES = OFF_LAM + K * 4;
};
template <int TY>
__device__ __forceinline__ void gchunk_issue(const unsigned char* scr, int b, int h, int d, int n, int lt, u32x4 (&pf)[GChunk<TY>::NRL], float& lamv) {
    typedef GChunk<TY> G; constexpr int K = G::K, RQ = G::RQ;
    const size_t drec = (size_t)((d * 8 + b * 4 + h) * 260 + n), rec = (size_t)((b * 4 + h) * 260 + n);
    const u32x4* qp = (const u32x4*)(scr + (TY ? SC_HG_QP : SC_GLA_QP) + drec * (64 * K * 2));
    const u32x4* kt = (const u32x4*)(scr + (TY ? SC_HG_KT : SC_GLA_KT) + drec * (64 * K * 2));
    const u32x4* ap = (const u32x4*)(scr + (TY ? SC_HG_A : SC_GLA_A) + drec * 8192);
    const u32x4* vt = (const u32x4*)(scr + (TY ? SC_HG_VT : SC_GLA_VT) + rec * 16384);
#pragma unroll
    for (int i = 0; i < RQ; ++i) { pf[i] = qp[i * 256 + lt]; pf[RQ + i] = kt[i * 256 + lt]; }
    pf[2 * RQ] = ap[lt]; pf[2 * RQ + 1] = ap[256 + lt];
#pragma unroll
    for (int i = 0; i < 4; ++i) pf[2 * RQ + 2 + i] = vt[i * 256 + lt];
    if (lt < K) lamv = ((const float*)(scr + (TY ? SC_HG_LAM : SC_GLA_LAM) + drec * (K * 4)))[lt];
}
template <int TY>
__device__ __forceinline__ void gchunk_commit(LAS unsigned char* buf, int lt, const u32x4 (&pf)[GChunk<TY>::NRL], float lamv) {
    typedef GChunk<TY> G; constexpr int K = G::K, PPR = K * 2 / 16, RQ = G::RQ;
#pragma unroll
    for (int i = 0; i < RQ; ++i) { const int p = i * 256 + lt;
        *(LAS u32x4*)(buf + G::OFF_QP + (p / PPR) * G::QPITCH + (p % PPR) * 16) = pf[i];
        *(LAS u32x4*)(buf + G::OFF_KT + (p >> 3) * 144 + (p & 7) * 16) = pf[RQ + i]; }
#pragma unroll
    for (int i = 0; i < 2; ++i) { const int p = i * 256 + lt; *(LAS u32x4*)(buf + G::OFF_A + (p >> 3) * 144 + (p & 7) * 16) = pf[2 * RQ + i]; }
#pragma unroll
    for (int i = 0; i < 4; ++i) { const int p = i * 256 + lt; *(LAS u32x4*)(buf + G::OFF_VT + (p >> 3) * 144 + (p & 7) * 16) = pf[2 * RQ + 2 + i]; }
    if (lt < K) *(LAS float*)(buf + G::OFF_LAM + lt * 4) = lamv;
}
template <int TY>
__device__ __forceinline__ void gchunk_compute(LAS unsigned char* buf, f32x16 (&S)[GChunk<TY>::K / 32], bf16_t* orow, int vs, int lane) {
    typedef GChunk<TY> G; constexpr int K = G::K, KT_ = K / 32;
    const int r = lane & 31, hh = lane >> 5;
    const LAS unsigned char* qpp = buf + G::OFF_QP + r * G::QPITCH + hh * 16;
    const LAS unsigned char* app = buf + G::OFF_A + r * 144 + hh * 16;
    const LAS unsigned char* ktp = buf + G::OFF_KT + r * 144 + hh * 16;
#define G_SB() __builtin_amdgcn_sched_barrier(0)
#define G_LDQ(F, kt) do { F[0] = *(const LAS bf16x8*)(qpp + (2 * (kt)) * 32); F[1] = *(const LAS bf16x8*)(qpp + (2 * (kt) + 1) * 32); \
        F[2] = *(const LAS bf16x8*)(qpp + 32 * G::QPITCH + (2 * (kt)) * 32); F[3] = *(const LAS bf16x8*)(qpp + 32 * G::QPITCH + (2 * (kt) + 1) * 32); } while (0)
#define G_MMQ(F, kt) do { const bf16x8 b0 = pack_step<0>(S[kt]), b1 = pack_step<1>(S[kt]); o[0] = MFMA32(F[0], b0, o[0]); o[1] = MFMA32(F[2], b0, o[1]); o[0] = MFMA32(F[1], b1, o[0]); o[1] = MFMA32(F[3], b1, o[1]); } while (0)
#define G_LD4(F, base) do { _Pragma("unroll") for (int ts = 0; ts < 4; ++ts) F[ts] = *(const LAS bf16x8*)((base) + ts * 32); } while (0)
#define G_MMA(F, it) do { _Pragma("unroll") for (int ts = 0; ts < 4; ++ts) o[it] = MFMA32(F[ts], vf[ts], o[it]); } while (0)
#define G_LAM(kt) do { _Pragma("unroll") for (int g = 0; g < 4; ++g) { const f32x4 lm = *(const LAS f32x4*)(buf + G::OFF_LAM + (32 * (kt) + 8 * g + 4 * hh) * 4); \
        _Pragma("unroll") for (int j = 0; j < 4; ++j) S[kt][4 * g + j] *= lm[j]; } } while (0)
#define G_MMK(F, kt) do { _Pragma("unroll") for (int ts = 0; ts < 4; ++ts) S[kt] = MFMA32(F[ts], vf[ts], S[kt]); } while (0)
    bf16x8 vf[4], fa[4], fb[4];
    G_LDQ(fa, 0);
#pragma unroll
    for (int ts = 0; ts < 4; ++ts) vf[ts] = *(const LAS bf16x8*)(buf + G::OFF_VT + (32 * vs + r) * 144 + ts * 32 + hh * 16);
    f32x16 o[2];
#pragma unroll
    for (int it = 0; it < 2; ++it) {
#pragma unroll
        for (int i = 0; i < 16; ++i) o[it][i] = 0.f; }
    if (KT_ == 2) {
        G_LDQ(fb, 1); G_SB(); G_MMQ(fa, 0); G_SB();
        G_LD4(fa, app); G_SB(); G_MMQ(fb, 1); G_SB();
    } else {
        G_LDQ(fb, 1); G_SB(); G_MMQ(fa, 0); G_SB();
        G_LDQ(fa, 2); G_SB(); G_MMQ(fb, 1); G_SB();
        G_LDQ(fb, 3); G_SB(); G_MMQ(fa, 2); G_SB();
        G_LD4(fa, app); G_SB(); G_MMQ(fb, 3); G_SB();
    }
    G_LD4(fb, app + 32 * 144); G_SB(); G_MMA(fa, 0); G_SB();
    G_LD4(fa, ktp); G_LAM(0); G_SB(); G_MMA(fb, 1); G_SB();
    if (KT_ == 2) {
        G_LD4(fb, ktp + 32 * 144); G_LAM(1); G_SB(); G_MMK(fa, 0); G_SB();
        G_MMK(fb, 1); G_SB();
    } else {
        G_LD4(fb, ktp + 32 * 144); G_LAM(1); G_SB(); G_MMK(fa, 0); G_SB();
        G_LD4(fa, ktp + 64 * 144); G_LAM(2); G_SB(); G_MMK(fb, 1); G_SB();
        G_LD4(fb, ktp + 96 * 144); G_LAM(3); G_SB(); G_MMK(fa, 2); G_SB();
        G_MMK(fb, 3); G_SB();
    }
#pragma unroll
    for (int it = 0; it < 2; ++it)
#pragma unroll
        for (int i = 0; i < 16; ++i) orow[(size_t)(32 * it + crow16(i, hh)) * 2048 + 32 * vs + r] = f2bf(o[it][i]);
#undef G_SB
#undef G_LDQ
#undef G_MMQ
#undef G_LD4
#undef G_MMA
#undef G_LAM
#undef G_MMK
}
template <int L, int TY>
__device__ __forceinline__ void chain_g(const Ctx& c, int b, int h, int d) {
    typedef GChunk<TY> G; constexpr int KT_ = G::K / 32;
    ARGS_REF a = *c.a;
    const unsigned char* scr = a.ws + WS_SCR;
    LAS unsigned char* buf = c.lds + LDS_SCR;
    static_assert(G::BYTES <= 65536, "two chunk buffers must fit the scratch region");
#define CHUNK_OF(m) (d ? ((m) < 4 ? 3 - (m) : 263 - (m)) : (m))
    __syncthreads();
    if (c.wave < 4) {
        bf16_t* ORAW = (bf16_t*)(a.ws + WS_ORAW) + (size_t)d * MT * 2048 + TY * 512 + h * 128;
        f32x16 S[KT_];
#pragma unroll
        for (int kt = 0; kt < KT_; ++kt)
#pragma unroll
            for (int i = 0; i < 16; ++i) S[kt][i] = 0.f;
        LBAR();
#pragma unroll 1
        for (int m = 0; m < 260; ++m) {
            gchunk_compute<TY>(buf + (m & 1) * 65536, S, ORAW + chunk_rowbase(b, CHUNK_OF(m)) * 2048, c.wave, c.lane);
            LBAR();
        }
    } else {
        const int lt = c.tid - 256;
        u32x4 p0[G::NRL], p1[G::NRL], p2[G::NRL]; float l0 = 0.f, l1 = 0.f, l2 = 0.f;
        gchunk_issue<TY>(scr, b, h, d, CHUNK_OF(0), lt, p0, l0);
        gchunk_issue<TY>(scr, b, h, d, CHUNK_OF(1), lt, p1, l1);
        gchunk_issue<TY>(scr, b, h, d, CHUNK_OF(2), lt, p2, l2);
        gchunk_commit<TY>(buf, lt, p0, l0);
        gchunk_issue<TY>(scr, b, h, d, CHUNK_OF(3), lt, p0, l0);
        LBAR();
#pragma unroll 1
        for (int m = 0; m < 258; m += 3) {
            gchunk_commit<TY>(buf + ((m + 1) & 1) * 65536, lt, p1, l1); if (m + 4 < 260) gchunk_issue<TY>(scr, b, h, d, CHUNK_OF(m + 4), lt, p1, l1); LBAR();
            gchunk_commit<TY>(buf + ((m + 2) & 1) * 65536, lt, p2, l2); if (m + 5 < 260) gchunk_issue<TY>(scr, b, h, d, CHUNK_OF(m + 5), lt, p2, l2); LBAR();
            gchunk_commit<TY>(buf + ((m + 3) & 1) * 65536, lt, p0, l0); if (m + 6 < 260) gchunk_issue<TY>(scr, b, h, d, CHUNK_OF(m + 6), lt, p0, l0); LBAR();
        }
        gchunk_commit<TY>(buf + (259 & 1) * 65536, lt, p1, l1); LBAR();
        LBAR();
    }
#undef CHUNK_OF
}

__device__ __forceinline__ int posU(int i) { const int w = i & 31; return (i & 32) + (((w >> 2) & 1) << 4) + (w & 3) + ((w >> 3) << 2); }
__device__ __forceinline__ constexpr int pp16(int w) { return (((w >> 2) & 1) << 3) + ((w >> 3) << 2) + (w & 3); }

__device__ __forceinline__ void trisolve64(const LAS float* A, LAS float* TL, int cidx) {
    LAS float* tl = TL + cidx * 68;
#pragma unroll 1
    for (int blk = 0; blk < 4; ++blk) {
        float acc[16];
#pragma unroll
        for (int r = 0; r < 16; ++r) acc[r] = (16 * blk + r == cidx) ? 1.f : 0.f;
        const LAS float* Ab = A + (16 * blk) * 64;
#pragma unroll 1
        for (int pj = 0; pj < 16 * blk; pj += 4) { const f32x4 t4 = *(const LAS f32x4*)(tl + pj);
#pragma unroll
            for (int r = 0; r < 16; ++r) { const f32x4 a4 = *(const LAS f32x4*)(Ab + r * 64 + pj); acc[r] -= a4[0] * t4[0] + a4[1] * t4[1] + a4[2] * t4[2] + a4[3] * t4[3]; } }
#pragma unroll
        for (int r = 1; r < 16; ++r) {
#pragma unroll
            for (int q = 0; q < (r + 3) / 4; ++q) { const f32x4 a4 = *(const LAS f32x4*)(Ab + r * 64 + 16 * blk + 4 * q);
#pragma unroll
                for (int jj = 0; jj < 4; ++jj) if (4 * q + jj < r) acc[r] -= a4[jj] * acc[4 * q + jj]; } }
#pragma unroll
        for (int q = 0; q < 4; ++q) { f32x4 v = {acc[4 * q], acc[4 * q + 1], acc[4 * q + 2], acc[4 * q + 3]}; *(LAS f32x4*)(tl + 16 * blk + 4 * q) = v; }
    }
}

template <int L>
__device__ __forceinline__ void intra_dn_item(const Ctx& c, int b, int h, int n) {
    ARGS_REF a = *c.a; const int tid = c.tid, lane = c.lane, wave = c.wave;
    const bf16_t* PM = (const bf16_t*)(a.ws + WS_PMIX);
    unsigned char* scr = a.ws + WS_SCR;
    const int rec = (b * 4 + h) * 260 + n;
    LAS unsigned char* Qh = c.lds + LDS_SCR;
    LAS unsigned char* Kh = Qh + 17408;
    LAS unsigned char* Tp = c.lds + LDS_SCR + 106496;
    LAS float* TLb = (LAS float*)Qh;
    LAS unsigned char* KTp = c.lds + LDS_SCR + 36864;
    LAS unsigned char* VTp = KTp + 18432;
    LAS float* Ap = (LAS float*)(VTp + 18432);
    LAS float* sm = (LAS float*)(c.lds + LDS_AUX);
    LBAR();
    PT_START(0); PT_START(5);
#pragma unroll 1
    for (int rep1_ = 0; rep1_ < ((PROBE_SUB & 32) ? 2 : 1); ++rep1_)
    {
        const int i = tid >> 3, cg = tid & 7;
        const int Ls = n < 4 ? CL : T; const int tseg = (n < 4 ? n : n - 4) * 64 + i; const size_t segbase = n < 4 ? (size_t)ML + b * CL : (size_t)b * T;
        float aq[16], ak[16], av[16];
#pragma unroll
        for (int j = 0; j < 16; ++j) { aq[j] = 0.f; ak[j] = 0.f; av[j] = 0.f; }
        const float* cw = a.in[I_DN_CW] + (size_t)L * 4 * 1536 + h * 128 + cg * 16;
#pragma unroll
        for (int tap = 0; tap < 4; ++tap) { const int ts = tseg + tap - 2;
            if (ts >= 0 && ts < Ls) { const bf16_t* rp = PM + (segbase + ts) * NMIXP + h * 128 + cg * 16; const float* w = cw + tap * 1536;
                float f0[8], f1[8]; float wq[16], wk[16], wv[16];
#pragma unroll
                for (int q4 = 0; q4 < 4; ++q4) { const f32x4 a4 = *(const f32x4*)(w + 4 * q4), b4 = *(const f32x4*)(w + 512 + 4 * q4), c4 = *(const f32x4*)(w + 1024 + 4 * q4);
#pragma unroll
                    for (int j = 0; j < 4; ++j) { wq[4 * q4 + j] = a4[j]; wk[4 * q4 + j] = b4[j]; wv[4 * q4 + j] = c4[j]; } }
                { const u32x4 w0 = *(const u32x4*)(rp + C_DN_Q), w1 = *(const u32x4*)(rp + C_DN_Q + 8); unpack8(w0, f0); unpack8(w1, f1); }
#pragma unroll
                for (int j = 0; j < 8; ++j) { aq[j] += wq[j] * f0[j]; aq[8 + j] += wq[8 + j] * f1[j]; }
                { const u32x4 w0 = *(const u32x4*)(rp + C_DN_K), w1 = *(const u32x4*)(rp + C_DN_K + 8); unpack8(w0, f0); unpack8(w1, f1); }
#pragma unroll
                for (int j = 0; j < 8; ++j) { ak[j] += wk[j] * f0[j]; ak[8 + j] += wk[8 + j] * f1[j]; }
                { const u32x4 w0 = *(const u32x4*)(rp + C_DN_V), w1 = *(const u32x4*)(rp + C_DN_V + 8); unpack8(w0, f0); unpack8(w1, f1); }
#pragma unroll
                for (int j = 0; j < 8; ++j) { av[j] += wv[j] * f0[j]; av[8 + j] += wv[8 + j] * f1[j]; } } }
        float sq = 0.f, sk = 0.f;
#pragma unroll
        for (int j = 0; j < 16; ++j) { aq[j] = siluf(aq[j]); ak[j] = siluf(ak[j]); av[j] = siluf(av[j]); sq += aq[j] * aq[j]; sk += ak[j] * ak[j]; }
        sq += __shfl_xor(sq, 1); sq += __shfl_xor(sq, 2); sq += __shfl_xor(sq, 4);
        sk += __shfl_xor(sk, 1); sk += __shfl_xor(sk, 2); sk += __shfl_xor(sk, 4);
        const float rq = __builtin_amdgcn_rsqf(sq + EPS) * 0.08838834764831845f, rk = __builtin_amdgcn_rsqf(sk + EPS);
        float qp[16];
#pragma unroll
        for (int j = 0; j < 16; ++j) { aq[j] *= rq; ak[j] *= rk; }
#pragma unroll
        for (int j = 0; j < 16; ++j) qp[pp16(j)] = aq[j];
        {   float x0[8], x1[8];
#pragma unroll
            for (int j = 0; j < 8; ++j) { x0[j] = qp[j]; x1[j] = qp[8 + j]; }
            u32x4* dst = (u32x4*)(scr + SC_DN_QS + (size_t)rec * 16384 + i * 256 + cg * 32); dst[0] = pack8(x0); dst[1] = pack8(x1);
#pragma unroll
            for (int j = 0; j < 8; ++j) { x0[j] = aq[j]; x1[j] = aq[8 + j]; }
            *(LAS u32x4*)(Qh + i * 272 + cg * 32) = pack8(x0); *(LAS u32x4*)(Qh + i * 272 + cg * 32 + 16) = pack8(x1);
#pragma unroll
            for (int j = 0; j < 8; ++j) { x0[j] = ak[j]; x1[j] = ak[8 + j]; }
            *(LAS u32x4*)(Kh + i * 272 + cg * 32) = pack8(x0); *(LAS u32x4*)(Kh + i * 272 + cg * 32 + 16) = pack8(x1); }
        const int pj = permpos(i);
#pragma unroll
        for (int j = 0; j < 16; ++j) { *(LAS bf16_t*)(KTp + (cg * 16 + j) * 144 + pj * 2) = f2bf(ak[j]); *(LAS bf16_t*)(VTp + (cg * 16 + j) * 144 + pj * 2) = f2bf(av[j]); }
        if (tid < 128) { const int d = tid >> 6, t = tid & 63; const bf16_t* rp = PM + (chunk_rowbase(b, n) + t) * NMIXP;
            const float g = -expf(a.in[I_DN_ALOG][(L * 2 + d) * 4 + h]) * softplusf(bf1(rp + C_DN_A + d * 4 + h) + a.in[I_DN_DTB][(L * 2 + d) * 4 + h]);
            sm[d * 256 + t] = g; sm[d * 256 + 128 + t] = sigm(bf1(rp + C_DN_B + d * 4 + h)); }
    }
    LBAR();
    PT_STOP(0, a.ws); PT_START(1);
    const int r = lane & 31, hh = lane >> 5;
    f32x16 gram;
#pragma unroll
    for (int i = 0; i < 16; ++i) gram[i] = 0.f;
    const int t1 = (wave & 3) >> 1, t2 = wave & 1;
#pragma unroll
    for (int ks = 0; ks < 8; ++ks) {
        const bf16x8 af = *(const LAS bf16x8*)(Kh + (32 * (wave < 4 ? t2 : t1) + r) * 272 + ks * 32 + hh * 16);
        const bf16x8 bfr = *(const LAS bf16x8*)((wave < 4 ? Qh : Kh) + (32 * (wave < 4 ? t1 : t2) + r) * 272 + ks * 32 + hh * 16);
        gram = MFMA32(af, bfr, gram); }
    {
        u32x4* dst = (u32x4*)(scr + SC_DN_KT + (size_t)rec * 16384);
#pragma unroll
        for (int q = 0; q < 2; ++q) { const int p = q * 512 + tid; dst[p] = *(const LAS u32x4*)(KTp + (p >> 3) * 144 + (p & 7) * 16); } }
    if (tid < 128) { const int d = tid >> 6, t = tid & 63; float acc = 0.f;
#pragma unroll 16
        for (int tt = 0; tt < 64; ++tt) { const float g = sm[d * 256 + tt]; acc += (d ? (tt >= t) : (tt <= t)) ? g : 0.f; }
        sm[d * 256 + 64 + t] = acc; }
    LBAR();
    PT_STOP(1, a.ws); PT_START(2);
#pragma unroll 1
    for (int d = 0; d < 2; ++d) {
        const LAS float* gc = sm + d * 256 + 64; const LAS float* be = sm + d * 256 + 128;
        const size_t drec = (size_t)((d * 8 + b * 4 + h) * 260 + n);
        if (wave < 4) {
            const int i = 32 * t1 + r; const float gi = gc[i]; float o[16];
#pragma unroll
            for (int g4 = 0; g4 < 4; ++g4) { const f32x4 gj4 = *(const LAS f32x4*)(gc + 32 * t2 + 8 * g4 + 4 * hh);
#pragma unroll
                for (int q = 0; q < 4; ++q) { const int idx = 4 * g4 + q; const int j = 32 * t2 + crow16(idx, hh); const float e = __expf(fminf(gi - gj4[q], 0.f)) * gram[idx]; const bool ok = d ? (j >= i) : (j <= i); o[idx] = ok ? e : 0.f; } }
            float x0[8], x1[8];
#pragma unroll
            for (int j = 0; j < 8; ++j) { x0[j] = o[j]; x1[j] = o[8 + j]; }
            bf16_t* ap = (bf16_t*)(scr + SC_DN_AQK + drec * 8192) + i * 64 + 32 * t2 + 8 * hh;
            *(u32x4*)ap = pack8(x0); *(u32x4*)(ap + 16) = pack8(x1);
        } else {
            const int j = 32 * t2 + r; const float gj = gc[j]; const int pj = d ? 63 - j : j;
#pragma unroll
            for (int g4 = 0; g4 < 4; ++g4) { const f32x4 gi4 = *(const LAS f32x4*)(gc + 32 * t1 + 8 * g4 + 4 * hh), be4 = *(const LAS f32x4*)(be + 32 * t1 + 8 * g4 + 4 * hh);
#pragma unroll
                for (int q = 0; q < 4; ++q) { const int idx = 4 * g4 + q; const int i = 32 * t1 + crow16(idx, hh); const int pi = d ? 63 - i : i;
                    const float v = be4[q] * gram[idx] * __expf(fminf(gi4[q] - gj, 0.f)); Ap[d * 4096 + pi * 64 + pj] = (pj < pi) ? v : 0.f; } }
        }
        if (tid < 64) { const float gtot = d ? gc[0] : gc[63]; float* sc = (float*)(scr + SC_DN_SC + drec * 1024);
            const float eg = __expf(gc[tid]); sc[tid] = eg; sc[64 + tid] = __expf(gtot - gc[tid]); if (tid == 0) sc[128] = __expf(gtot); sm[d * 256 + 192 + tid] = eg; }
    }
    LBAR();
    PT_STOP(2, a.ws); PT_START(3);
#if defined(DN_SOLVE_VALU)
    if (wave < 2) {
        const int d = wave; LAS float* TL = TLb + d * 4352;
        trisolve64(Ap + d * 4096, TL, lane);
        const int j = d ? 63 - lane : lane; const float bj = sm[d * 256 + 128 + j], ej = sm[d * 256 + 192 + j]; const int pj2 = permpos(j) * 2;
        LAS unsigned char* T1 = Tp + d * 18432; LAS unsigned char* T2 = T1 + 9216;
#pragma unroll 4
        for (int pi = 0; pi < 64; ++pi) { const int i = d ? 63 - pi : pi; const float v1 = TL[lane * 68 + pi] * bj;
            *(LAS bf16_t*)(T1 + i * 144 + pj2) = f2bf(v1); *(LAS bf16_t*)(T2 + i * 144 + pj2) = f2bf(v1 * ej); }
    }
#else
    {
        LAS unsigned char* EA = c.lds + LDS_SCR;
        LAS unsigned char* EB = EA + 9216;
        LAS unsigned char* S1 = EB + 9216;
        LAS unsigned char* MA = S1 + 9216;
        LAS unsigned char* S2 = c.lds + LDS_SCR + 73728;
#pragma unroll 1
        for (int d = 0; d < 2; ++d) {
            const LAS float* Ad = Ap + d * 4096;
            {   const u32x4 z = {0u, 0u, 0u, 0u};
                for (int p16 = tid; p16 < 2 * 576; p16 += 512) *(LAS u32x4*)(EA + p16 * 16) = z;
                const int j = tid >> 3, i8 = (tid & 7) * 8; float nv[8];
#pragma unroll
                for (int ii = 0; ii < 8; ++ii) { const int i = i8 + ii; const float v = Ad[i * 64 + j]; nv[ii] = ((i >> 4) > (j >> 4)) ? v : 0.f; }
                *(LAS u32x4*)(S1 + j * 144 + i8 * 2) = pack8(nv); }
            LBAR();
            if (wave == 0) {
                const int bq = lane >> 4, cq = lane & 15; float e[16];
#pragma unroll
                for (int rr = 0; rr < 16; ++rr) e[rr] = (rr == cq) ? 1.f : 0.f;
#pragma unroll
                for (int rr = 1; rr < 16; ++rr) {
#pragma unroll
                    for (int q4 = 0; q4 < (rr + 3) / 4; ++q4) { const f32x4 a4 = *(const LAS f32x4*)(Ad + (16 * bq + rr) * 64 + 16 * bq + 4 * q4);
#pragma unroll
                        for (int jj = 0; jj < 4; ++jj) if (4 * q4 + jj < rr) e[rr] -= a4[jj] * e[4 * q4 + jj]; } }
#pragma unroll
                for (int rr = 0; rr < 16; ++rr) *(LAS bf16_t*)(EA + (16 * bq + rr) * 144 + (16 * bq + cq) * 2) = f2bf(e[rr]);
                float x0[8], x1[8];
#pragma unroll
                for (int jj = 0; jj < 8; ++jj) { x0[jj] = e[jj]; x1[jj] = e[8 + jj]; }
                *(LAS u32x4*)(EB + (16 * bq + cq) * 144 + 32 * bq) = pack8(x0); *(LAS u32x4*)(EB + (16 * bq + cq) * 144 + 32 * bq + 16) = pack8(x1);
            }
            LBAR();
            const int it = (wave >> 1) & 1, jt = wave & 1;
            f32x16 aM, aM2, aT;
#pragma unroll
            for (int i = 0; i < 16; ++i) { aM[i] = 0.f; aM2[i] = 0.f; aT[i] = 0.f; }
            if (wave < 4) {
#pragma unroll
                for (int ks = 0; ks < 4; ++ks) aM = MFMA32(*(const LAS bf16x8*)(EA + (32 * it + r) * 144 + ks * 32 + hh * 16), *(const LAS bf16x8*)(S1 + (32 * jt + r) * 144 + ks * 32 + hh * 16), aM);
#pragma unroll
                for (int i = 0; i < 16; ++i) *(LAS bf16_t*)(MA + (32 * it + crow16(i, hh)) * 144 + (32 * jt + r) * 2) = f2bf(aM[i]);
#pragma unroll
                for (int g4 = 0; g4 < 4; ++g4) { u32x2 w; w.x = pg8::cvt_pk_bf16_safe(aM[4 * g4], aM[4 * g4 + 1]); w.y = pg8::cvt_pk_bf16_safe(aM[4 * g4 + 2], aM[4 * g4 + 3]);
                    *(LAS u32x2*)(S2 + (32 * jt + r) * 144 + (32 * it + 8 * g4 + 4 * hh) * 2) = w; }
            }
            LBAR();
            if (wave < 4) {
#pragma unroll
                for (int ks = 0; ks < 4; ++ks) aM2 = MFMA32(*(const LAS bf16x8*)(MA + (32 * it + r) * 144 + ks * 32 + hh * 16), *(const LAS bf16x8*)(S2 + (32 * jt + r) * 144 + ks * 32 + hh * 16), aM2);
#pragma unroll
                for (int g4 = 0; g4 < 4; ++g4) { u32x2 w; w.x = pg8::cvt_pk_bf16_safe(aM2[4 * g4], aM2[4 * g4 + 1]); w.y = pg8::cvt_pk_bf16_safe(aM2[4 * g4 + 2], aM2[4 * g4 + 3]);
                    *(LAS u32x2*)(S1 + (32 * jt + r) * 144 + (32 * it + 8 * g4 + 4 * hh) * 2) = w; }
            }
            LBAR();
            if (wave < 4) {
                f32x16 aM3;
#pragma unroll
                for (int i = 0; i < 16; ++i) aM3[i] = 0.f;
#pragma unroll
                for (int ks = 0; ks < 4; ++ks) aM3 = MFMA32(*(const LAS bf16x8*)(MA + (32 * it + r) * 144 + ks * 32 + hh * 16), *(const LAS bf16x8*)(S1 + (32 * jt + r) * 144 + ks * 32 + hh * 16), aM3);
#pragma unroll
                for (int i = 0; i < 16; ++i) { const int pp = 32 * it + crow16(i, hh), qq = 32 * jt + r; const float qv = ((pp == qq) ? 1.f : 0.f) - aM[i] + aM2[i] - aM3[i];
                    *(LAS bf16_t*)(S2 + pp * 144 + qq * 2) = f2bf(qv); }
            }
            LBAR();
            if (wave < 4) {
#pragma unroll
                for (int ks = 0; ks < 4; ++ks) aT = MFMA32(*(const LAS bf16x8*)(S2 + (32 * it + r) * 144 + ks * 32 + hh * 16), *(const LAS bf16x8*)(EB + (32 * jt + r) * 144 + ks * 32 + hh * 16), aT);
                const int qq = 32 * jt + r, j = d ? 63 - qq : qq; const float bj = sm[d * 256 + 128 + j], ej = sm[d * 256 + 192 + j]; const int pj2 = permpos(j) * 2;
                LAS unsigned char* T1 = Tp + d * 18432; LAS unsigned char* T2 = T1 + 9216;
#pragma unroll
                for (int i = 0; i < 16; ++i) { const int pp = 32 * it + crow16(i, hh), ii = d ? 63 - pp : pp; const float v1 = aT[i] * bj;
                    *(LAS bf16_t*)(T1 + ii * 144 + pj2) = f2bf(v1); *(LAS bf16_t*)(T2 + ii * 144 + pj2) = f2bf(v1 * ej); }
            }
            LBAR();
        }
    }
#endif
    LBAR();
    PT_STOP(3, a.ws); PT_START(4);
#pragma unroll 1
    for (int rep5_ = 0; rep5_ < ((PROBE_SUB & 64) ? 2 : 1); ++rep5_)
#pragma unroll 2
    for (int q = 0; q < 4; ++q) {
        const int tile = wave * 4 + q, d = tile >> 4, isw = (tile >> 3) & 1, it = (tile >> 2) & 1, xt = tile & 3;
        const size_t drec = (size_t)((d * 8 + b * 4 + h) * 260 + n);
        LAS unsigned char* T1 = Tp + d * 18432; LAS unsigned char* T2 = T1 + 9216;
        f32x16 acc;
#pragma unroll
        for (int i = 0; i < 16; ++i) acc[i] = 0.f;
        if (!isw) {
#pragma unroll
            for (int js = 0; js < 4; ++js) { const bf16x8 af = *(const LAS bf16x8*)(T1 + (32 * it + r) * 144 + js * 32 + hh * 16), bfr = *(const LAS bf16x8*)(VTp + (32 * xt + r) * 144 + js * 32 + hh * 16);
                acc = MFMA32(af, bfr, acc); }
            float x0[8], x1[8];
#pragma unroll
            for (int j = 0; j < 8; ++j) { x0[j] = acc[j]; x1[j] = acc[8 + j]; }
            bf16_t* up = (bf16_t*)(scr + SC_DN_UT + drec * 16384) + (32 * xt + r) * 64 + it * 32 + hh * 16;
            *(u32x4*)up = pack8(x0); *(u32x4*)(up + 8) = pack8(x1);
        } else {
#pragma unroll
            for (int js = 0; js < 4; ++js) { const bf16x8 af = *(const LAS bf16x8*)(KTp + (32 * xt + r) * 144 + js * 32 + hh * 16), bfr = *(const LAS bf16x8*)(T2 + (32 * it + r) * 144 + js * 32 + hh * 16);
                acc = MFMA32(af, bfr, acc); }
            float x0[8], x1[8];
#pragma unroll
            for (int j = 0; j < 8; ++j) { x0[j] = -acc[j]; x1[j] = -acc[8 + j]; }
            bf16_t* wp = (bf16_t*)(scr + SC_DN_WN + drec * 16384) + (32 * it + r) * 128 + 32 * xt + 8 * hh;
            *(u32x4*)wp = pack8(x0); *(u32x4*)(wp + 16) = pack8(x1);
        }
    }
    PT_STOP(4, a.ws); PT_STOP(5, a.ws);
}

struct DChunk { static constexpr int OFF_QS = 0, OFF_KT = 17408, OFF_WN = OFF_KT + 18432, OFF_AQK = OFF_WN + 17408, OFF_SC = OFF_AQK + 9216, BYTES = OFF_SC + 1024, NRL = 14; };
static_assert(DChunk::BYTES <= 65536, "two DeltaNet chunk images must fit the scratch region");
__device__ __forceinline__ void dchunk_issue(const unsigned char* scr, int b, int h, int d, int n, int lt, u32x4 (&pf)[DChunk::NRL], f32x4& scv) {
    const size_t drec = (size_t)((d * 8 + b * 4 + h) * 260 + n), rec = (size_t)((b * 4 + h) * 260 + n);
    const u32x4* qs = (const u32x4*)(scr + SC_DN_QS + rec * 16384); const u32x4* kt = (const u32x4*)(scr + SC_DN_KT + rec * 16384);
    const u32x4* wn = (const u32x4*)(scr + SC_DN_WN + drec * 16384); const u32x4* aq = (const u32x4*)(scr + SC_DN_AQK + drec * 8192);
#pragma unroll
    for (int i = 0; i < 4; ++i) { pf[i] = qs[i * 256 + lt]; pf[4 + i] = kt[i * 256 + lt]; pf[8 + i] = wn[i * 256 + lt]; }
    pf[12] = aq[lt]; pf[13] = aq[256 + lt];
    if (lt < 64) scv = ((const f32x4*)(scr + SC_DN_SC + drec * 1024))[lt];
}
__device__ __forceinline__ void dchunk_commit(LAS unsigned char* buf, int lt, const u32x4 (&pf)[DChunk::NRL], const f32x4 scv) {
    typedef DChunk G;
#pragma unroll
    for (int i = 0; i < 4; ++i) { const int p = i * 256 + lt;
        *(LAS u32x4*)(buf + G::OFF_QS + (p >> 4) * 272 + (p & 15) * 16) = pf[i];
        *(LAS u32x4*)(buf + G::OFF_KT + (p >> 3) * 144 + (p & 7) * 16) = pf[4 + i];
        *(LAS u32x4*)(buf + G::OFF_WN + (p >> 4) * 272 + (p & 15) * 16) = pf[8 + i]; }
#pragma unroll
    for (int i = 0; i < 2; ++i) { const int p = i * 256 + lt; *(LAS u32x4*)(buf + G::OFF_AQK + (p >> 3) * 144 + (p & 7) * 16) = pf[12 + i]; }
    if (lt < 64) *(LAS f32x4*)(buf + G::OFF_SC + lt * 16) = scv;
}
__device__ __forceinline__ void dchunk_loadu(const unsigned char* scr, int b, int h, int d, int n, int vs, int lane, u32x4 (&uu)[4]) {
    const size_t drec = (size_t)((d * 8 + b * 4 + h) * 260 + n); const int r = lane & 31, hh = lane >> 5;
    const u32x4* up = (const u32x4*)(scr + SC_DN_UT + drec * 16384 + (32 * vs + r) * 128 + hh * 32);
    uu[0] = up[0]; uu[1] = up[1]; uu[2] = up[4]; uu[3] = up[5];
}
__device__ __forceinline__ void dchunk_compute(LAS unsigned char* buf, f32x16 (&S)[4], bf16_t* orow, int vs, int lane, u32x4 (&uu)[4], const u32x4* unext) {
    typedef DChunk G; const int r = lane & 31, hh = lane >> 5;
    const LAS unsigned char* wq = buf + r * 272 + hh * 16;
    const LAS unsigned char* aqp = buf + G::OFF_AQK + r * 144 + hh * 16;
    const LAS unsigned char* ktp = buf + G::OFF_KT + r * 144 + hh * 16;
#define DN_LDWQ(F, kt, it) do { F[0] = *(const LAS bf16x8*)(wq + G::OFF_WN + (it) * 8704 + (2 * (kt)) * 32); F[1] = *(const LAS bf16x8*)(wq + G::OFF_WN + (it) * 8704 + (2 * (kt) + 1) * 32); \
        F[2] = *(const LAS bf16x8*)(wq + G::OFF_QS + (it) * 8704 + (2 * (kt)) * 32); F[3] = *(const LAS bf16x8*)(wq + G::OFF_QS + (it) * 8704 + (2 * (kt) + 1) * 32); } while (0)
#define DN_MMWQ(F, it) do { vn[it] = MFMA32(F[0], b0, vn[it]); o[it] = MFMA32(F[2], b0, o[it]); vn[it] = MFMA32(F[1], b1, vn[it]); o[it] = MFMA32(F[3], b1, o[it]); } while (0)
#define DN_SB() __builtin_amdgcn_sched_barrier(0)
    f32x16 vn[2], o[2];
    bf16x8 fa[4], fb[4];
    DN_LDWQ(fa, 0, 0);
#pragma unroll
    for (int it = 0; it < 2; ++it) { const u32x4 u0 = uu[2 * it], u1 = uu[2 * it + 1];
        float f0[8], f1[8]; unpack8(u0, f0); unpack8(u1, f1);
#pragma unroll
        for (int j = 0; j < 8; ++j) { vn[it][j] = f0[j]; vn[it][8 + j] = f1[j]; o[it][j] = 0.f; o[it][8 + j] = 0.f; } }
    if (unext) { uu[0] = unext[0]; uu[1] = unext[1]; uu[2] = unext[4]; uu[3] = unext[5]; }
    {   bf16x8 b0 = pack_step<0>(S[0]), b1 = pack_step<1>(S[0]);
        DN_LDWQ(fb, 0, 1); DN_SB(); DN_MMWQ(fa, 0); DN_SB();
        DN_LDWQ(fa, 1, 0); DN_SB(); DN_MMWQ(fb, 1); DN_SB();
        b0 = pack_step<0>(S[1]); b1 = pack_step<1>(S[1]);
        DN_LDWQ(fb, 1, 1); DN_SB(); DN_MMWQ(fa, 0); DN_SB();
        DN_LDWQ(fa, 2, 0); DN_SB(); DN_MMWQ(fb, 1); DN_SB();
        b0 = pack_step<0>(S[2]); b1 = pack_step<1>(S[2]);
        DN_LDWQ(fb, 2, 1); DN_SB(); DN_MMWQ(fa, 0); DN_SB();
        DN_LDWQ(fa, 3, 0); DN_SB(); DN_MMWQ(fb, 1); DN_SB();
        b0 = pack_step<0>(S[3]); b1 = pack_step<1>(S[3]);
        DN_LDWQ(fb, 3, 1); DN_SB(); DN_MMWQ(fa, 0); DN_SB();
#pragma unroll
        for (int js = 0; js < 4; ++js) fa[js] = *(const LAS bf16x8*)(aqp + js * 32);
        DN_SB(); DN_MMWQ(fb, 1); DN_SB(); }
#pragma unroll
    for (int it = 0; it < 2; ++it) { f32x4 eg[4];
#pragma unroll
        for (int g = 0; g < 4; ++g) eg[g] = *(const LAS f32x4*)(buf + G::OFF_SC + (32 * it + 8 * g + 4 * hh) * 4);
#pragma unroll
        for (int g = 0; g < 4; ++g)
#pragma unroll
            for (int j = 0; j < 4; ++j) o[it][4 * g + j] *= eg[g][j]; }
    {   const bf16x8 p00 = pack_step<0>(vn[0]), p01 = pack_step<1>(vn[0]), p10 = pack_step<0>(vn[1]), p11 = pack_step<1>(vn[1]);
#pragma unroll
        for (int js = 0; js < 4; ++js) fb[js] = *(const LAS bf16x8*)(aqp + 4608 + js * 32);
        DN_SB();
        o[0] = MFMA32(fa[0], p00, o[0]); o[0] = MFMA32(fa[1], p01, o[0]); o[0] = MFMA32(fa[2], p10, o[0]); o[0] = MFMA32(fa[3], p11, o[0]); DN_SB();
#pragma unroll
        for (int js = 0; js < 4; ++js) fa[js] = *(const LAS bf16x8*)(ktp + js * 32);
        DN_SB();
        o[1] = MFMA32(fb[0], p00, o[1]); o[1] = MFMA32(fb[1], p01, o[1]); o[1] = MFMA32(fb[2], p10, o[1]); o[1] = MFMA32(fb[3], p11, o[1]); DN_SB(); }
#pragma unroll
    for (int jt = 0; jt < 2; ++jt) { f32x4 ek[4];
#pragma unroll
        for (int g = 0; g < 4; ++g) ek[g] = *(const LAS f32x4*)(buf + G::OFF_SC + 256 + (32 * jt + 8 * g + 4 * hh) * 4);
#pragma unroll
        for (int g = 0; g < 4; ++g)
#pragma unroll
            for (int j = 0; j < 4; ++j) vn[jt][4 * g + j] *= ek[g][j]; }
    const float glast = *(const LAS float*)(buf + G::OFF_SC + 512);
    const bf16x8 q00 = pack_step<0>(vn[0]), q01 = pack_step<1>(vn[0]), q10 = pack_step<0>(vn[1]), q11 = pack_step<1>(vn[1]);
    DN_SB();
#define DN_SUPD(F, kt) do { _Pragma("unroll") for (int i = 0; i < 16; ++i) S[kt][i] *= glast; \
        S[kt] = MFMA32(F[0], q00, S[kt]); S[kt] = MFMA32(F[1], q01, S[kt]); S[kt] = MFMA32(F[2], q10, S[kt]); S[kt] = MFMA32(F[3], q11, S[kt]); } while (0)
#define DN_LDK(F, kt) do { _Pragma("unroll") for (int js = 0; js < 4; ++js) F[js] = *(const LAS bf16x8*)(ktp + (kt) * 4608 + js * 32); } while (0)
    DN_LDK(fb, 1); DN_SB(); DN_SUPD(fa, 0); DN_SB();
    DN_LDK(fa, 2); DN_SB(); DN_SUPD(fb, 1); DN_SB();
    DN_LDK(fb, 3); DN_SB(); DN_SUPD(fa, 2); DN_SB();
    DN_SUPD(fb, 3); DN_SB();
#pragma unroll
    for (int it = 0; it < 2; ++it)
#pragma unroll
        for (int i = 0; i < 16; ++i) orow[(size_t)(32 * it + crow16(i, hh)) * 2048 + 32 * vs + r] = f2bf(o[it][i]);
#undef DN_LDWQ
#undef DN_MMWQ
#undef DN_SUPD
#undef DN_LDK
#undef DN_SB
}
template <int L>
__device__ __forceinline__ void chain_dnc(const Ctx& c, int b, int h, int d, int vh) {
    ARGS_REF a = *c.a;
    const unsigned char* scr = a.ws + WS_SCR;
    LAS unsigned char* buf = c.lds + LDS_SCR;
#define CHUNK_OF(m) (d ? ((m) < 4 ? 3 - (m) : 263 - (m)) : (m))
    __syncthreads();
    if (c.wave >= 2 && c.wave < 4) { LBAR();
#pragma unroll 1
        for (int m = 0; m < 260; ++m) LBAR(); }
    else if (c.wave < 2) {
        const int vs = vh * 2 + c.wave;
        bf16_t* ORAW = (bf16_t*)(a.ws + WS_ORAW) + (size_t)d * MT * 2048 + 2 * 512 + h * 128;
        f32x16 S[4];
#pragma unroll
        for (int kt = 0; kt < 4; ++kt)
#pragma unroll
            for (int i = 0; i < 16; ++i) S[kt][i] = 0.f;
        u32x4 ua[4];
        dchunk_loadu(scr, b, h, d, CHUNK_OF(0), vs, c.lane, ua);
        LBAR();
#pragma unroll 1
        for (int m = 0; m < 260; ++m) {
            const int nn = CHUNK_OF(m + 1);
            const u32x4* unext = (m + 1 < 260) ? (const u32x4*)(scr + SC_DN_UT + (size_t)((d * 8 + b * 4 + h) * 260 + nn) * 16384 + (32 * vs + (c.lane & 31)) * 128 + (c.lane >> 5) * 32) : nullptr;
            dchunk_compute(buf + (m & 1) * 65536, S, ORAW + chunk_rowbase(b, CHUNK_OF(m)) * 2048, vs, c.lane, ua, unext);
            LBAR();
        }
    } else {
        const int lt = c.tid - 256;
        u32x4 p0[DChunk::NRL], p1[DChunk::NRL], p2[DChunk::NRL]; f32x4 s0 = {0.f, 0.f, 0.f, 0.f}, s1 = s0, s2 = s0;
        dchunk_issue(scr, b, h, d, CHUNK_OF(0), lt, p0, s0);
        dchunk_issue(scr, b, h, d, CHUNK_OF(1), lt, p1, s1);
        dchunk_issue(scr, b, h, d, CHUNK_OF(2), lt, p2, s2);
        dchunk_commit(buf, lt, p0, s0);
        dchunk_issue(scr, b, h, d, CHUNK_OF(3), lt, p0, s0);
        LBAR();
#pragma unroll 1
        for (int m = 0; m < 258; m += 3) {
            dchunk_commit(buf + ((m + 1) & 1) * 65536, lt, p1, s1); if (m + 4 < 260) dchunk_issue(scr, b, h, d, CHUNK_OF(m + 4), lt, p1, s1); LBAR();
            dchunk_commit(buf + ((m + 2) & 1) * 65536, lt, p2, s2); if (m + 5 < 260) dchunk_issue(scr, b, h, d, CHUNK_OF(m + 5), lt, p2, s2); LBAR();
            dchunk_commit(buf + ((m + 3) & 1) * 65536, lt, p0, s0); if (m + 6 < 260) dchunk_issue(scr, b, h, d, CHUNK_OF(m + 6), lt, p0, s0); LBAR();
        }
        dchunk_commit(buf + (259 & 1) * 65536, lt, p1, s1); LBAR();
        LBAR();
    }
#undef CHUNK_OF
}

__device__ __forceinline__ void rgw_convert(const Ctx& c) {
    ARGS_REF a = *c.a; bf16_t* dst = (bf16_t*)(a.ws + WS_RGW);
    for (int e = c.wg * 512 + c.tid; e < 32 * 16384; e += c.G * 512) { const int m = e >> 14, oc = (e >> 7) & 127, cc = e & 127, l = m >> 4, d = (m >> 3) & 1, n = (m >> 1) & 3, g = m & 1;
        const float* src = g ? a.in[I_RG_WI] : a.in[I_RG_WR];
        dst[e] = f2bf(src[((size_t)(((l * 2 + d) * 4 + n) * 128 + cc)) * 128 + oc]); }
}
template <int L>
__device__ __forceinline__ void rgprep_item2(const Ctx& c, int item) {
    ARGS_REF a = *c.a; const int tid = c.tid, lane = c.lane, wave = c.wave;
    LAS unsigned char* XB = c.lds + LDS_SCR;
    LAS float* xbT = (LAS float*)(c.lds + LDS_SCR + 17408);
    LAS float* PRE = (LAS float*)(c.lds + LDS_SCR + 52224);
    LAS float* SEG = (LAS float*)(c.lds + LDS_AUX);
    const bf16_t* PM = (const bf16_t*)(a.ws + WS_PMIX);
    bf16_t* RGLA = (bf16_t*)(a.ws + WS_RGLA); bf16_t* ORAW = (bf16_t*)(a.ws + WS_ORAW);
    float* TT = (float*)(a.ws + WS_RGTT);
    const float* cw = a.in[I_RG_CW] + L * 4 * 512; const float* cb = a.in[I_RG_CB] + L * 512;
    const int tt = item >> 2, n = item & 3;
    size_t rowbase; int t0, Ls, bb, nchunk;
    if (tt < 512) { bb = tt >> 8; rowbase = (size_t)bb * T; t0 = (tt & 255) * 64; Ls = T; nchunk = 4 + (tt & 255); }
    else { const int tc = tt - 512; bb = tc >> 2; rowbase = (size_t)ML + bb * CL; t0 = (tc & 3) * 64; Ls = CL; nchunk = tc & 3; }
    LBAR();
#pragma unroll 1
    for (int repc_ = 0; repc_ < ((PROBE_SUB & 1024) ? 2 : 1); ++repc_)
    {
        const int tl = tid >> 3, cg = tid & 7, ch0 = n * 128 + cg * 16;
        float acc[16];
#pragma unroll
        for (int q4 = 0; q4 < 4; ++q4) { const f32x4 b4 = *(const f32x4*)(cb + ch0 + 4 * q4);
#pragma unroll
            for (int j = 0; j < 4; ++j) acc[4 * q4 + j] = b4[j]; }
#pragma unroll
        for (int tap = 0; tap < 4; ++tap) { const int ts = t0 + tl + tap - 2;
            if (ts >= 0 && ts < Ls) { const bf16_t* rp = PM + (rowbase + ts) * NMIXP + C_RG_X + ch0; const u32x4 w0 = *(const u32x4*)rp, w1 = *(const u32x4*)(rp + 8);
                float f[8], g[8]; unpack8(w0, f); unpack8(w1, g); float wv[16];
#pragma unroll
                for (int q4 = 0; q4 < 4; ++q4) { const f32x4 a4 = *(const f32x4*)(cw + tap * 512 + ch0 + 4 * q4);
#pragma unroll
                    for (int j = 0; j < 4; ++j) wv[4 * q4 + j] = a4[j]; }
#pragma unroll
                for (int j = 0; j < 8; ++j) { acc[j] += wv[j] * f[j]; acc[8 + j] += wv[8 + j] * g[j]; } } }
#pragma unroll
        for (int j = 0; j < 16; ++j) xbT[(cg * 16 + j) * 68 + tl] = acc[j];
        float x0[8], x1[8];
#pragma unroll
        for (int j = 0; j < 8; ++j) { x0[j] = acc[j]; x1[j] = acc[8 + j]; }
        *(LAS u32x4*)(XB + tl * 272 + cg * 32) = pack8(x0); *(LAS u32x4*)(XB + tl * 272 + cg * 32 + 16) = pack8(x1);
    }
    LBAR();
    const int r = lane & 31, hh = lane >> 5, tth = wave & 1, ot = wave >> 1;
    const int oc = tid & 127, tq = tid >> 7, ch = n * 128 + oc;
#pragma unroll 1
    for (int dd_ = 0; dd_ < ((PROBE_SUB & 2048) ? 4 : 2); ++dd_) { const int d = dd_ & 1;
        {
            const bf16_t* wbase = (const bf16_t*)(a.ws + WS_RGW) + (size_t)(((L * 2 + d) * 4 + n) * 2) * 16384 + (32 * ot + r) * 128 + hh * 8;
#pragma unroll
            for (int g = 0; g < 2; ++g) { f32x16 acc;
#pragma unroll
                for (int i = 0; i < 16; ++i) acc[i] = 0.f;
#pragma unroll
                for (int ks = 0; ks < 8; ++ks) { const bf16x8 af = *(const LAS bf16x8*)(XB + (32 * tth + r) * 272 + ks * 32 + hh * 16); const bf16x8 bfr = *(const bf16x8*)(wbase + g * 16384 + ks * 16);
                    acc = MFMA32(af, bfr, acc); }
#pragma unroll
                for (int gq = 0; gq < 4; ++gq) { f32x4 v = {acc[4 * gq], acc[4 * gq + 1], acc[4 * gq + 2], acc[4 * gq + 3]};
                    *(LAS f32x4*)(PRE + (g * 128 + 32 * ot + r) * 68 + 32 * tth + 8 * gq + 4 * hh) = v; } }
        }
        LBAR();
#pragma unroll 1
        for (int repe_ = 0; repe_ < ((PROBE_SUB & 4096) ? 2 : 1); ++repe_)
        {
            const float br = a.in[I_RG_BR][(L * 2 + d) * 512 + ch], bi = a.in[I_RG_BI][(L * 2 + d) * 512 + ch];
            const float sp = softplusf(-a.in[I_RG_LAM][(L * 2 + d) * 512 + ch]);
            float la[16], hl[16];
#pragma unroll
            for (int q = 0; q < 4; ++q) { const f32x4 pr = *(const LAS f32x4*)(PRE + oc * 68 + 16 * tq + 4 * q), pi = *(const LAS f32x4*)(PRE + (128 + oc) * 68 + 16 * tq + 4 * q), xv = *(const LAS f32x4*)(xbT + oc * 68 + 16 * tq + 4 * q);
#pragma unroll
                for (int j = 0; j < 4; ++j) { const float rr = sigm(pr[j] + br), ig = sigm(pi[j] + bi); const float l = -8.0f * rr * sp;
                    la[4 * q + j] = l; hl[4 * q + j] = __builtin_amdgcn_sqrtf(fmaxf(1.0f - __expf(2.0f * l), 0.f)) * (ig * xv[j]); } }
            float hrun = 0.f, lrun = 0.f;
            if (d == 0) {
#pragma unroll
                for (int j = 0; j < 16; ++j) { hrun = __expf(la[j]) * hrun + hl[j]; lrun += la[j]; hl[j] = hrun; la[j] = lrun; } }
            else {
#pragma unroll
                for (int j = 15; j >= 0; --j) { hrun = __expf(la[j]) * hrun + hl[j]; lrun += la[j]; hl[j] = hrun; la[j] = lrun; } }
            SEG[(tq * 128 + oc) * 2] = lrun; SEG[(tq * 128 + oc) * 2 + 1] = hrun;
            LBAR();
            float Hin = 0.f, Lin = 0.f, Htot = 0.f, Ltot = 0.f;
#pragma unroll
            for (int s = 0; s < 4; ++s) { const int sg = d ? 3 - s : s; const float ls = SEG[(sg * 128 + oc) * 2], hs = SEG[(sg * 128 + oc) * 2 + 1];
                const bool before = d ? (sg > tq) : (sg < tq);
                if (before) { Hin = __expf(ls) * Hin + hs; Lin += ls; }
                Htot = __expf(ls) * Htot + hs; Ltot += ls; }
            LAS unsigned char* HT = (LAS unsigned char*)PRE; LAS unsigned char* PT = HT + 34816;
            const float eLin = __expf(Lin);
#pragma unroll
            for (int j = 0; j < 16; ++j) { const float e = __expf(la[j]);
                *(LAS bf16_t*)(HT + (16 * tq + j) * 256 + oc * 2) = f2bf(hl[j] + e * Hin);
                *(LAS bf16_t*)(PT + (16 * tq + j) * 256 + oc * 2) = f2bf(e * eLin); }
            if (tq == 0) { float* tp = TT + ((size_t)((d * 2 + bb) * 260 + nchunk) * 512 + ch) * 2; tp[0] = __expf(Ltot); tp[1] = Htot; }
            LBAR();
            const size_t ob = ((size_t)d * MT + rowbase + t0);
#pragma unroll
            for (int i = 0; i < 2; ++i) { const int p = i * 512 + tid, t = p >> 4, cc = p & 15;
                *(u32x4*)(ORAW + (ob + t) * 2048 + 1536 + n * 128 + cc * 8) = *(const LAS u32x4*)(HT + p * 16);
                *(u32x4*)(RGLA + (ob + t) * 512 + n * 128 + cc * 8) = *(const LAS u32x4*)(PT + p * 16); }
        }
        LBAR();
    }
}
__device__ __forceinline__ void rg_carry(const Ctx& c, int part) {
    ARGS_REF a = *c.a; const int gid = part * 512 + c.tid, d = gid >> 10, b = (gid >> 9) & 1, ch = gid & 511;
    typedef float f32x2v __attribute__((ext_vector_type(2)));
    const f32x2v* TT = (const f32x2v*)(a.ws + WS_RGTT) + (size_t)((d * 2 + b) * 260) * 512 + ch;
    float* CR = (float*)(a.ws + WS_RGCARRY) + (size_t)((d * 2 + b) * 260) * 512 + ch;
    float H = 0.f;
#pragma unroll 1
    for (int m0 = 0; m0 < 260; m0 += 20) { f32x2v p[20];
#pragma unroll
        for (int j = 0; j < 20; ++j) { const int m = m0 + j, nn = d ? (m < 4 ? 3 - m : 263 - m) : m; p[j] = TT[(size_t)nn * 512]; }
#pragma unroll
        for (int j = 0; j < 20; ++j) { const int m = m0 + j, nn = d ? (m < 4 ? 3 - m : 263 - m) : m; CR[(size_t)nn * 512] = H; H = p[j].x * H + p[j].y; } }
}
#ifndef PROBE_SUB
#define PROBE_SUB 0
#endif
template <int L> __device__ __forceinline__ void gemm_gate_part(const Ctx& c, int G2, int c2);
template <int L>
__device__ __forceinline__ void intra_phase(const Ctx& c) {
#pragma unroll 1
    for (int rep = 0; rep < ((PROBE_SUB & 1) ? 2 : 1); ++rep)
#pragma unroll 1
    for (int item = c.wg; item < 2080; item += c.G) rgprep_item2<L>(c, item);
#pragma unroll 1
    for (int rep = 0; rep < ((PROBE_SUB & 2) ? 2 : 1); ++rep)
#pragma unroll 1
    for (int item = (c.wg + 96) % c.G; item < 2080; item += c.G) { const int bh = item / 260, n = item % 260; intra_g_item<L, 0>(c, bh >> 2, bh & 3, n); }
#pragma unroll 1
    for (int rep = 0; rep < ((PROBE_SUB & 4) ? 2 : 1); ++rep)
#pragma unroll 1
    for (int item = (c.wg + 192) % c.G; item < 2080; item += c.G) { const int bh = item / 260, n = item % 260; intra_g_item<L, 1>(c, bh >> 2, bh & 3, n); }
#pragma unroll 1
    for (int rep = 0; rep < ((PROBE_SUB & 8) ? 2 : 1); ++rep)
#pragma unroll 1
    for (int item = (c.wg + 32) % c.G; item < 2080; item += c.G) { const int bh = item / 260, n = item % 260; intra_dn_item<L>(c, bh >> 2, bh & 3, n); }
}
template <int L>
__device__ __forceinline__ void chains_phase(const Ctx& c) {
    const int w = c.wg;
    if (w < 64) {
        if (w < 32) { const int r = w & 15, b = r >> 3, h = (r >> 1) & 3, d = r & 1;
            if (w < 16) { chain_g<L, 0>(c, b, h, d); if (PROBE_SUB & 65536) chain_g<L, 0>(c, b, h, d); }
            else { chain_g<L, 1>(c, b, h, d); if (PROBE_SUB & 32768) chain_g<L, 1>(c, b, h, d); } }
        else { const int r = w - 32, b = r >> 4, h = (r >> 2) & 3, d = (r >> 1) & 1, vh = r & 1; chain_dnc<L>(c, b, h, d, vh); }
    }
    else { if (w < 68) { rg_carry(c, w - 64); __syncthreads(); }
#pragma unroll 1
        for (int rep_ = 0; rep_ < ((PROBE_SUB & 8192) ? 2 : 1); ++rep_)
        gemm_gate_part<L>(c, c.G - 64, w < 68 ? c.G - 68 + (w - 64) : w - 68); }
}
template <int L>
__device__ __forceinline__ void combine_phase(const Ctx& c) {
    ARGS_REF a = *c.a; const int gw = c.wg * 8 + c.wave, nw = c.G * 8, lane = c.lane;
    const bf16_t* PM = (const bf16_t*)(a.ws + WS_PMIX); const bf16_t* O0 = (const bf16_t*)(a.ws + WS_ORAW); const bf16_t* O1 = O0 + (size_t)MT * 2048;
    bf16_t* O = (bf16_t*)(a.ws + WS_O);
    const int cb = lane * 8, hv = cb & 127;
    float nwv[3][8];
#pragma unroll
    for (int j = 0; j < 8; ++j) { nwv[0][j] = a.in[I_GLA_NW][L * 128 + hv + j]; nwv[1][j] = a.in[I_HG_NW][L * 128 + hv + j]; nwv[2][j] = a.in[I_DN_NW][L * 128 + hv + j]; }
    const int nrows = (L == 0) ? MT : ML;
    for (int r = gw; r < nrows; r += nw) {
        const bf16_t* pm = (const bf16_t*)(a.ws + WS_GC) + (size_t)r * 2048;
#pragma unroll
        for (int br = 0; br < 3; ++br) {
            const int gcol = br * 512;
            float x0[8], x1[8], g[8], o[8];
            { const u32x4 w = *(const u32x4*)(O0 + (size_t)r * 2048 + br * 512 + cb); unpack8(w, x0); }
            { const u32x4 w = *(const u32x4*)(O1 + (size_t)r * 2048 + br * 512 + cb); unpack8(w, x1); }
            { const u32x4 w = *(const u32x4*)(pm + gcol + cb); unpack8(w, g); }
            float ss = 0.f;
#pragma unroll
            for (int j = 0; j < 8; ++j) { o[j] = x0[j] + x1[j]; ss += o[j] * o[j]; }
            ss += __shfl_xor(ss, 1); ss += __shfl_xor(ss, 2); ss += __shfl_xor(ss, 4); ss += __shfl_xor(ss, 8);
            const float rs = __builtin_amdgcn_rsqf(ss * (1.0f / 128.0f) + EPS);
#pragma unroll
            for (int j = 0; j < 8; ++j) o[j] = o[j] * rs * nwv[br][j] * siluf(g[j]);
            *(u32x4*)(O + ((size_t)br * MT + r) * 512 + cb) = pack8(o);
        }
        {   float x0[8], x1[8], p0[8], p1[8], y[8], o[8];
            const int bb = r < ML ? (r >> 14) : ((r - ML) >> 8), nchunk = r < ML ? 4 + ((r & 16383) >> 6) : (((r - ML) & 255) >> 6);
            const bf16_t* RGLA = (const bf16_t*)(a.ws + WS_RGLA); const float* CR = (const float*)(a.ws + WS_RGCARRY);
            { const u32x4 w = *(const u32x4*)(O0 + (size_t)r * 2048 + 1536 + cb); unpack8(w, x0); }
            { const u32x4 w = *(const u32x4*)(O1 + (size_t)r * 2048 + 1536 + cb); unpack8(w, x1); }
            { const u32x4 w = *(const u32x4*)(RGLA + (size_t)r * 512 + cb); unpack8(w, p0); }
            { const u32x4 w = *(const u32x4*)(RGLA + ((size_t)MT + r) * 512 + cb); unpack8(w, p1); }
            { const u32x4 w = *(const u32x4*)(pm + 3 * 512 + cb); unpack8(w, y); }
            const float* c0 = CR + (size_t)((0 * 2 + bb) * 260 + nchunk) * 512 + cb; const float* c1 = CR + (size_t)((1 * 2 + bb) * 260 + nchunk) * 512 + cb;
            const f32x4 ca = *(const f32x4*)c0, cb2 = *(const f32x4*)(c0 + 4), cc = *(const f32x4*)c1, cd = *(const f32x4*)(c1 + 4);
#pragma unroll
            for (int j = 0; j < 8; ++j) { const float k0 = j < 4 ? ca[j & 3] : cb2[j & 3], k1 = j < 4 ? cc[j & 3] : cd[j & 3];
                o[j] = gelu_tanh(y[j]) * ((x0[j] + p0[j] * k0) + (x1[j] + p1[j] * k1)); }
            *(u32x4*)(O + ((size_t)3 * MT + r) * 512 + cb) = pack8(o);
        }
    }
}

__device__ __forceinline__ void route1_phase(const Ctx& c) {
    ARGS_REF a = *c.a; const int lane = c.lane;
    const float* modv = (const float*)(a.ws + WS_MOD) + (size_t)1 * 3 * 12288 + 3 * 2048;
    const float* normw = a.in[I_NORMW] + (1 * 2 + 1) * 2048;
    const float* router = a.in[I_ROUTER];
    bf16_t* H = (bf16_t*)(a.ws + WS_H);
    unsigned* topi = (unsigned*)(a.ws + WS_TOPI); float* topw = (float*)(a.ws + WS_TOPW);
    volatile LAS int* hist = (volatile LAS int*)(c.lds + LDS_AUX);
    if (c.tid < 8) hist[c.tid] = 0;
    LAS f32x4* RT = (LAS f32x4*)(c.lds + LDS_SCR);
#pragma unroll
    for (int i = 0; i < 8; ++i) { const int e = c.tid + 512 * i, k = e >> 6, ln = e & 63, cc = ((k >> 3) * 64 + ln) * 4 + ((k >> 1) & 3); RT[e] = *(const f32x4*)(router + cc * 8 + (k & 1) * 4); }
    __syncthreads();
    const int rpw = ML / c.G;
    for (int rr = c.wave; rr < rpw; rr += 8) {
        const int r = c.wg * rpw + rr, b = r >> 14;
        const float* src = (const float*)a.out + (size_t)r * D;
        f32x4 v[8];
        load_xres(v, (const bf16_t*)src, lane);
        const float* shift = modv + (size_t)b * 12288;
        modnorm_row(v, normw, shift, shift + 2048, lane);
        { unsigned char* h8 = (unsigned char*)(a.ws + WS_H8) + (size_t)r * D;
#pragma unroll
            for (int j = 0; j < 8; ++j) *(unsigned*)(h8 + (j * 64 + lane) * 4) = pk_fp8x4(v[j][0] * 4.f, v[j][1] * 4.f, v[j][2] * 4.f, v[j][3] * 4.f); }
        float lg[8];
#pragma unroll
        for (int e = 0; e < 8; ++e) lg[e] = 0.f;
        LAS f32x4* rt = RT; asm volatile("" : "+v"(rt));
#pragma unroll
        for (int j = 0; j < 8; ++j)
#pragma unroll
            for (int q = 0; q < 4; ++q) { const f32x4 r0 = rt[((j * 4 + q) * 2) * 64 + lane], r1 = rt[((j * 4 + q) * 2 + 1) * 64 + lane]; const float x = v[j][q];
                lg[0] += x * r0[0]; lg[1] += x * r0[1]; lg[2] += x * r0[2]; lg[3] += x * r0[3]; lg[4] += x * r1[0]; lg[5] += x * r1[1]; lg[6] += x * r1[2]; lg[7] += x * r1[3]; }
#pragma unroll
        for (int e = 0; e < 8; ++e) lg[e] = wave_sum(lg[e]);
        int e0 = 0; float m0 = lg[0];
#pragma unroll
        for (int e = 1; e < 8; ++e) if (lg[e] > m0) { m0 = lg[e]; e0 = e; }
        int e1 = -1; float m1 = -3.0e38f;
#pragma unroll
        for (int e = 0; e < 8; ++e) if (e != e0 && lg[e] > m1) { m1 = lg[e]; e1 = e; }
        if (e1 < 0) { e1 = (e0 + 1) & 7; m1 = m0; }
        if (lane == 0) { const float ex = __expf(m1 - m0); const float w0 = 1.0f / (1.0f + ex); topi[r] = (unsigned)e0 | ((unsigned)e1 << 8); topw[2 * r] = w0; topw[2 * r + 1] = ex * w0;
            lds_add(&hist[e0]); lds_add(&hist[e1]); }
    }
    __syncthreads();
    if (c.tid < 8) ((int*)(a.ws + WS_CTL + CTL_WGH))[c.wg * 8 + c.tid] = hist[c.tid];
}
__device__ __forceinline__ void route2_phase(const Ctx& c) {
    ARGS_REF a = *c.a; const int lane = c.lane, tid = c.tid;
    const int* wgh = (const int*)(a.ws + WS_CTL + CTL_WGH);
    volatile LAS int* tab = (volatile LAS int*)(c.lds + LDS_AUX);
    if (tid < 40) tab[tid] = 0;
    __syncthreads();
    for (int idx = tid; idx < c.G * 2; idx += 512) { const int w = idx >> 1, eb = (idx & 1) * 4; const u32x4 v = *(const u32x4*)(wgh + idx * 4);
        LAS int* tp = (LAS int*)(c.lds + LDS_AUX) + eb;
        __hip_atomic_fetch_add(tp + 0, (int)v.x, __ATOMIC_RELAXED, __HIP_MEMORY_SCOPE_WORKGROUP); __hip_atomic_fetch_add(tp + 1, (int)v.y, __ATOMIC_RELAXED, __HIP_MEMORY_SCOPE_WORKGROUP);
        __hip_atomic_fetch_add(tp + 2, (int)v.z, __ATOMIC_RELAXED, __HIP_MEMORY_SCOPE_WORKGROUP); __hip_atomic_fetch_add(tp + 3, (int)v.w, __ATOMIC_RELAXED, __HIP_MEMORY_SCOPE_WORKGROUP);
        if (w < c.wg) { __hip_atomic_fetch_add(tp + 8, (int)v.x, __ATOMIC_RELAXED, __HIP_MEMORY_SCOPE_WORKGROUP); __hip_atomic_fetch_add(tp + 9, (int)v.y, __ATOMIC_RELAXED, __HIP_MEMORY_SCOPE_WORKGROUP);
            __hip_atomic_fetch_add(tp + 10, (int)v.z, __ATOMIC_RELAXED, __HIP_MEMORY_SCOPE_WORKGROUP); __hip_atomic_fetch_add(tp + 11, (int)v.w, __ATOMIC_RELAXED, __HIP_MEMORY_SCOPE_WORKGROUP); } }
    __syncthreads();
    if (tid < 8) tab[32 + tid] = (tab[tid] + 255) / 256 * 256;
    __syncthreads();
    if (tid == 0) { int acc = 0; for (int e = 0; e < 8; ++e) { tab[16 + e] = acc; acc += tab[32 + e]; }
        if (c.wg == 0) { int* meta = (int*)(a.ws + WS_CTL + CTL_META); int cum = 0; for (int e = 0; e < 8; ++e) { cum += tab[32 + e] / 256; meta[e] = cum; } meta[8] = cum; } }
    __syncthreads();
    const unsigned char* H8 = (const unsigned char*)(a.ws + WS_H8); unsigned char* GATH8 = (unsigned char*)(a.ws + WS_GATH);
    const unsigned* topi = (const unsigned*)(a.ws + WS_TOPI); int* dest = (int*)(a.ws + WS_DEST);
    const int rpw = ML / c.G;
    unsigned ti_n = topi[c.wg * rpw + c.wave];
    for (int rr = c.wave; rr < rpw; rr += 8) {
        const int r = c.wg * rpw + rr; const unsigned ti = ti_n; const int e0 = ti & 255, e1 = (ti >> 8) & 255;
        const u32x4* spre = (const u32x4*)(H8 + (size_t)r * D); const u32x4 wpre0 = spre[lane], wpre1 = spre[64 + lane];
        if (rr + 8 < rpw) ti_n = topi[r + 8];
        int d0 = 0, d1 = 0;
        if (lane == 0) { d0 = tab[16 + e0] + tab[8 + e0] + lds_add(&tab[24 + e0]); d1 = tab[16 + e1] + tab[8 + e1] + lds_add(&tab[24 + e1]); dest[2 * r] = d0; dest[2 * r + 1] = d1; }
        d0 = __shfl(d0, 0); d1 = __shfl(d1, 0);
        u32x4* p0 = (u32x4*)(GATH8 + (size_t)d0 * D); u32x4* p1 = (u32x4*)(GATH8 + (size_t)d1 * D);
        p0[lane] = wpre0; p1[lane] = wpre0; p0[64 + lane] = wpre1; p1[64 + lane] = wpre1;
    }
    if (c.wg < 8) { const int e = c.wg; const int lo = tab[16 + e] + tab[e], hi = tab[16 + e] + tab[32 + e]; const u32x4 z = {0u, 0u, 0u, 0u};
        for (int r = lo + c.wave; r < hi; r += 8) { u32x4* p = (u32x4*)(GATH8 + (size_t)r * D);
#pragma unroll
            for (int j = 0; j < 2; ++j) p[j * 64 + lane] = z; } }
}
__device__ __forceinline__ void load_yrow8(f32x4 (&y)[8], const bf16_t* Y, const float* PM2, int d, int lane) {
    if (d < 65536) { const bf16_t* p = Y + (size_t)d * D;
#pragma unroll
        for (int j = 0; j < 8; ++j) { const u32x2 w = *(const u32x2*)(p + (j * 64 + lane) * 4); y[j][0] = bflo(w.x); y[j][1] = bfhi(w.x); y[j][2] = bflo(w.y); y[j][3] = bfhi(w.y); } }
    else { const float* p = PM2 + (size_t)(d - 65536) * D;
#pragma unroll
        for (int j = 0; j < 8; ++j) { const float* q = p + (j * 64 + lane) * 4;
            y[j] = ((*(const f32x4*)q + *(const f32x4*)(q + (size_t)2048 * D)) + (*(const f32x4*)(q + (size_t)2 * 2048 * D) + *(const f32x4*)(q + (size_t)3 * 2048 * D))) * (1.0f / 256.0f); } }
}
__device__ __forceinline__ void final_phase(const Ctx& c) {
    ARGS_REF a = *c.a; const int gw = c.wg * 8 + c.wave, nw = c.G * 8, lane = c.lane;
    const float* modv = (const float*)(a.ws + WS_MOD) + (size_t)1 * 3 * 12288 + 5 * 2048;
    const bf16_t* Y = (const bf16_t*)(a.ws + WS_GATH); const int* dest = (const int*)(a.ws + WS_DEST); const float* topw = (const float*)(a.ws + WS_TOPW);
    const float* fw = a.in[I_FNORMW]; const float* PM2 = (const float*)(a.ws + WS_PM2);
    for (int r = gw; r < ML; r += nw) {
        const int b = r >> 14; float* xr = a.out + (size_t)r * D; const float* mg = modv + (size_t)b * 12288;
        const int d0 = dest[2 * r], d1 = dest[2 * r + 1]; const float w0 = topw[2 * r], w1 = topw[2 * r + 1];
        f32x4 v[8], ya[8], yb[8]; float ss = 0.f;
        load_yrow8(ya, Y, PM2, d0, lane); load_yrow8(yb, Y, PM2, d1, lane);
#pragma unroll
        for (int j = 0; j < 8; ++j) { const int cc = (j * 64 + lane) * 4; const u32x2 xw = *(const u32x2*)((const bf16_t*)xr + cc); const f32x4 x = {bflo(xw.x), bfhi(xw.x), bflo(xw.y), bfhi(xw.y)}, g = *(const f32x4*)(mg + cc);
            const f32x4 m = w0 * ya[j] + w1 * yb[j];
            v[j] = x + g * m; ss += v[j][0] * v[j][0] + v[j][1] * v[j][1] + v[j][2] * v[j][2] + v[j][3] * v[j][3]; }
        ss = wave_sum(ss); float rstd = __builtin_amdgcn_rsqf(ss * (1.0f / 2048.0f) + EPS);
#ifdef PROBE_T
        { const unsigned long long tk = ((const unsigned long long*)(a.ws + WS_CTL + CTL_PT))[PROBE_T]; const float xq = floorf((float)tk * (0.01f / 256.0f / 1000.0f) * 25.0f) * 0.04f + 0.02f; rstd *= 1.0f + xq; }
#endif
#pragma unroll
        for (int j = 0; j < 8; ++j) { const int cc = (j * 64 + lane) * 4; const f32x4 w = *(const f32x4*)(fw + cc); *(f32x4*)(xr + cc) = v[j] * rstd * w; }
    }
}

#ifndef N_LAUNCHES
#define N_LAUNCHES 1
#endif
constexpr int N_PHASES = 23;
#ifndef WGM_BIGN
#define WGM_BIGN 4
#endif
#ifndef WGM_MOE
#define WGM_MOE 4
#endif
#ifndef WGM_MOE2
#define WGM_MOE2 4
#endif
#ifndef WGM_SMALLN
#define WGM_SMALLN 4
#endif

template <int L>
__device__ __forceinline__ void gemm_projmix(const Ctx& c) {
    ARGS_REF a = *c.a;
    pg8::Gemm g{(const bf16_t*)(a.ws + WS_H), (const bf16_t*)(a.ws + WS_WIN + (size_t)L * WIN_BYTES), MT, NMIXP, D};
    pg8::StaticOrder S; S.init(MT, NMIXP, c.G, c.wg, WGM_BIGN);
    pg8::EpiProjMix E{(bf16_t*)(a.ws + WS_PMIX), (bf16_t*)(a.ws + WS_GC)};
    pg8::gemm_phase<pg8::EpiProjMix, pg8::StaticOrder, true, true>(c.lds + LDS_SCR, g, S, E);
}
template <int L>
__device__ __forceinline__ void gemm_gate_part(const Ctx& c, int G2, int c2) {
    ARGS_REF a = *c.a; constexpr int M = (L == 0) ? MT : ML;
    pg8::Gemm g{(const bf16_t*)(a.ws + WS_H8), (const bf16_t*)(a.ws + WS_WG8 + (size_t)L * WG8_BYTES), M, NGATE, D / 2};
    pg8::StaticOrder S; S.init(M, NGATE, G2, c2, WGM_BIGN);
    pg8::EpiBf16S<true> E{(bf16_t*)(a.ws + WS_PGATE), NGATE, 1.0f / 256.0f};
    pg8::gemm_phase8<pg8::EpiBf16S<true>, pg8::StaticOrder, true, true>(c.lds + LDS_SCR, g, S, E);
}
template <int L>
__device__ __forceinline__ void gemm_upgate(const Ctx& c) {
    ARGS_REF a = *c.a; constexpr int M = ML;
    pg8::Gemm g{(const bf16_t*)(a.ws + WS_O), (const bf16_t*)(a.ws + WS_WUP + (size_t)L * 8388608), M, 2048, 512};
    {
        pg8::UpGateOrder S; S.init(M, c.G, c.wg, MT / 256, WGM_SMALLN);
        pg8::EpiUpGate E{(const bf16_t*)(a.ws + WS_PGATE), (bf16_t*)(a.ws + WS_MERGED), MT / 256};
        pg8::gemm_phase<pg8::EpiUpGate, pg8::UpGateOrder, true, true>(c.lds + LDS_SCR, g, S, E);
    }
    if (L == 0) {
        const int w = c.wg, t = w >> 2, b = w & 3;
        pg8::OneUnit S; S.u.pm = b * (MT / 256) + ML / 256 + (t >> 3); S.u.pn = b * 8 + (t & 7); S.has = w < 64;
        pg8::EpiGatePartial E{(const bf16_t*)(a.ws + WS_PGATE), (float*)(a.ws + WS_PU), MT / 256};
        pg8::gemm_phase<pg8::EpiGatePartial, pg8::OneUnit, true, true>(c.lds + LDS_SCR, g, S, E);
    }
}
template <int L>
__device__ __forceinline__ void gemm_wout(const Ctx& c) {
    ARGS_REF a = *c.a;
    {
        pg8::Gemm g{(const bf16_t*)(a.ws + WS_MERGED), (const bf16_t*)(a.ws + WS_WOUT + (size_t)L * 8388608), ML, D, D};
        pg8::StaticOrder S; S.init(ML, D, c.G, c.wg, WGM_SMALLN);
        const float* modv = (const float*)(a.ws + WS_MOD) + (size_t)L * 3 * 12288 + 2 * 2048;
        pg8::EpiResid<L == 0> E{L == 0 ? (const void*)a.in[I_X] : (const void*)a.out, (bf16_t*)a.out, modv, L == 1 ? 1 : 0};
        pg8::gemm_phase<pg8::EpiResid<L == 0>, pg8::StaticOrder, true, true>(c.lds + LDS_SCR, g, S, E);
    }
    if (L == 0) {
        const int ks = c.wg >> 4, t = c.wg & 15;
        if (c.wg < 128) {
            const float* PU = (const float*)(a.ws + WS_PU); bf16_t* MG = (bf16_t*)(a.ws + WS_MERGED) + (size_t)ML * 2048;
#pragma unroll 1
            for (int i = c.tid; i < 256 * 32; i += 512) { const int r = (t >> 3) * 256 + (i >> 5), col = ks * 256 + (i & 31) * 8; const float* p = PU + (size_t)r * 2048 + col;
                float f[8];
#pragma unroll
                for (int h = 0; h < 2; ++h) { const f32x4 s = (*(const f32x4*)(p + h * 4) + *(const f32x4*)(p + (size_t)MC * 2048 + h * 4)) + (*(const f32x4*)(p + (size_t)2 * MC * 2048 + h * 4) + *(const f32x4*)(p + (size_t)3 * MC * 2048 + h * 4));
                    f[h * 4] = s[0]; f[h * 4 + 1] = s[1]; f[h * 4 + 2] = s[2]; f[h * 4 + 3] = s[3]; }
                *(u32x4*)(MG + (size_t)r * 2048 + col) = pack8(f); }
            __threadfence();
        }
        __syncthreads();
        __atomic_thread_fence(__ATOMIC_ACQUIRE);
        pg8::Gemm g{(const bf16_t*)(a.ws + WS_MERGED) + (size_t)ks * 256, (const bf16_t*)(a.ws + WS_WOUT) + (size_t)ks * 256, MT, D, 256, D};
        pg8::OneUnit S; S.u.pm = ML / 256 + (t >> 3); S.u.pn = t & 7; S.has = c.wg < 128;
        pg8::EpiPartial E{(float*)(a.ws + WS_PW) + (size_t)ks * MC * D, ML};
        pg8::gemm_phase<pg8::EpiPartial, pg8::OneUnit, true, true>(c.lds + LDS_SCR, g, S, E);
    }
}
#ifndef FFN13_FP8
#define FFN13_FP8 1
#endif
#ifndef FFN2_FP8
#define FFN2_FP8 1
#endif
__device__ __forceinline__ void gemm_ffn13(const Ctx& c) {
    ARGS_REF a = *c.a;
    pg8::StaticOrder S; S.init(MT, 2 * FF, c.G, c.wg, WGM_BIGN);
#if FFN13_FP8
    pg8::Gemm g{(const bf16_t*)(a.ws + WS_H8), (const bf16_t*)(a.ws + WS_F13), MT, 2 * FF, D / 2};
    pg8::EpiSwiglu<FFN2_FP8 != 0> E{(void*)(a.ws + WS_HID), 2 * FF / 256, 1.0f / 256.0f};
    pg8::gemm_phase8<pg8::EpiSwiglu<FFN2_FP8 != 0>, pg8::StaticOrder, true, true>(c.lds + LDS_SCR, g, S, E);
#else
    pg8::Gemm g{(const bf16_t*)(a.ws + WS_H), (const bf16_t*)(a.ws + WS_F13), MT, 2 * FF, D};
    pg8::EpiSwiglu<false> E{(void*)(a.ws + WS_HID), 2 * FF / 256, 1.0f};
    pg8::gemm_phase<pg8::EpiSwiglu<false>, pg8::StaticOrder, true, true>(c.lds + LDS_SCR, g, S, E);
#endif
}
__device__ __forceinline__ void gemm_ffn2(const Ctx& c) {
    ARGS_REF a = *c.a;
    {
        pg8::StaticOrder S; S.init(ML, D, c.G, c.wg, WGM_SMALLN);
        const float* modv = (const float*)(a.ws + WS_MOD) + (size_t)0 * 3 * 12288 + 5 * 2048;
#if FFN2_FP8
        pg8::Gemm g{(const bf16_t*)(a.ws + WS_HID), (const bf16_t*)(a.ws + WS_F2), ML, D, FF / 2};
        pg8::EpiResid<false> E{(const void*)a.out, (bf16_t*)a.out, modv, 0, 1.0f / 256.0f};
        pg8::gemm_phase8<pg8::EpiResid<false>, pg8::StaticOrder, true, true>(c.lds + LDS_SCR, g, S, E);
#else
        pg8::Gemm g{(const bf16_t*)(a.ws + WS_HID), (const bf16_t*)(a.ws + WS_F2), ML, D, FF};
        pg8::EpiResid<false> E{(const void*)a.out, (bf16_t*)a.out, modv, 0};
        pg8::gemm_phase<pg8::EpiResid<false>, pg8::StaticOrder, true, true>(c.lds + LDS_SCR, g, S, E);
#endif
    }
    {
        const int ks = c.wg >> 4, t = c.wg & 15;
        pg8::OneUnit S; S.u.pm = ML / 256 + (t >> 3); S.u.pn = t & 7; S.has = c.wg < 176;
        pg8::EpiPartial E{(float*)(a.ws + WS_PF) + (size_t)ks * MC * D, ML};
#if FFN2_FP8
        pg8::Gemm g{(const bf16_t*)(a.ws + WS_HID) + (size_t)ks * 256, (const bf16_t*)(a.ws + WS_F2) + (size_t)ks * 256, MT, D, 256, FF / 2};
        pg8::gemm_phase8<pg8::EpiPartial, pg8::OneUnit, true, true>(c.lds + LDS_SCR, g, S, E);
#else
        pg8::Gemm g{(const bf16_t*)(a.ws + WS_HID) + (size_t)ks * 512, (const bf16_t*)(a.ws + WS_F2) + (size_t)ks * 512, MT, D, 512, FF};
        pg8::gemm_phase<pg8::EpiPartial, pg8::OneUnit, true, true>(c.lds + LDS_SCR, g, S, E);
#endif
    }
}
__device__ __forceinline__ void gemm_moe13(const Ctx& c) {
    ARGS_REF a = *c.a; const int* meta = (const int*)(a.ws + WS_CTL + CTL_META);
    int be[8];
#pragma unroll
    for (int e = 0; e < 8; ++e) be[e] = __builtin_amdgcn_readfirstlane(meta[e]);
    pg8::Gemm g{(const bf16_t*)(a.ws + WS_GATH), (const bf16_t*)(a.ws + WS_M13), MOE_ROWS, 2 * FF, D / 2};
    pg8::MoeOrder S; S.init(be[7], 2 * FF / 256, c.G, c.wg, be, WGM_MOE);
    pg8::EpiSwiglu<true> E{(void*)(a.ws + WS_HIDM), 2 * FF / 256, 1.0f / 256.0f};
    pg8::gemm_phase8<pg8::EpiSwiglu<true>, pg8::MoeOrder, true, true>(c.lds + LDS_SCR, g, S, E);
}
__device__ __forceinline__ void gemm_moe2(const Ctx& c) {
    ARGS_REF a = *c.a; const int* meta = (const int*)(a.ws + WS_CTL + CTL_META);
    int be[8];
#pragma unroll
    for (int e = 0; e < 8; ++e) be[e] = __builtin_amdgcn_readfirstlane(meta[e]);
    {
        pg8::Gemm g{(const bf16_t*)(a.ws + WS_HIDM), (const bf16_t*)(a.ws + WS_M2), MOE_ROWS, D, FF / 2};
        pg8::MoeOrder S; S.init(256, D / 256, c.G, c.wg, be, WGM_MOE2);
        pg8::EpiPlainBf16 E{(bf16_t*)(a.ws + WS_GATH), D, D / 256, 1.0f / 256.0f};
        pg8::gemm_phase8<pg8::EpiPlainBf16, pg8::MoeOrder, true, true>(c.lds + LDS_SCR, g, S, E);
    }
    {
        const int ntail = be[7] - 256, w = c.wg, rt = w >> 5, ct = (w >> 2) & 7, ks = w & 3;
        const int pm = 256 + rt; int e = 0;
#pragma unroll
        for (int j = 0; j < 7; ++j) e += (pm >= be[j]) ? 1 : 0;
        const int k0 = (ks >> 1) * 22 + (ks & 1) * 12, kn = (ks & 1) ? 10 : 12;
        pg8::Gemm g{(const bf16_t*)(a.ws + WS_HIDM) + (size_t)k0 * 64, (const bf16_t*)(a.ws + WS_M2) + (size_t)k0 * 64, MOE_ROWS, D, kn * 64, FF / 2};
        pg8::OneUnit S; S.u.pm = pm; S.u.pn = e * (D / 256) + ct; S.has = w < ntail * 32;
        pg8::EpiPartial E{(float*)(a.ws + WS_PM2) + (size_t)ks * 2048 * D, 65536, D / 256};
        pg8::gemm_phase8<pg8::EpiPartial, pg8::OneUnit, true, true>(c.lds + LDS_SCR, g, S, E);
    }
}

__device__ __forceinline__ void prologue_phase(const Ctx& c) {
    ARGS_REF a = *c.a; int rot = 0;
    mod_phase(c);
    rgw_convert(c);
    for (int l = 0; l < 2; ++l) {
        conv_job<1>(c, a.in[I_WIN] + (size_t)l * D * DIN, nullptr, DIN, D, NMIXP, (bf16_t*)(a.ws + WS_WIN + (size_t)l * WIN_BYTES), rot);
        conv_job8<0>(c, a.in[I_WIN] + (size_t)l * D * DIN + NMIX, nullptr, DIN, D, NGATE, (unsigned char*)(a.ws + WS_WG8 + (size_t)l * WG8_BYTES), 64.0f, rot);
        for (int b = 0; b < 4; ++b) conv_job<0>(c, a.in[I_WUP] + (size_t)(l * 4 + b) * 512 * D, nullptr, D, 512, D, (bf16_t*)(a.ws + WS_WUP + (size_t)l * 8388608 + (size_t)b * 2048 * 512 * 2), rot);
        conv_job<0>(c, a.in[I_WOUT] + (size_t)l * D * D, nullptr, D, D, D, (bf16_t*)(a.ws + WS_WOUT + (size_t)l * 8388608), rot);
    }
#if FFN13_FP8
    conv_job8<2>(c, a.in[I_F1], a.in[I_F3], FF, D, 2 * FF, (unsigned char*)(a.ws + WS_F13), 64.0f, rot);
#else
    conv_job<2>(c, a.in[I_F1], a.in[I_F3], FF, D, 2 * FF, (bf16_t*)(a.ws + WS_F13), rot);
#endif
#if FFN2_FP8
    conv_job8<0>(c, a.in[I_F2], nullptr, D, FF, D, (unsigned char*)(a.ws + WS_F2), 64.0f, rot);
#else
    conv_job<0>(c, a.in[I_F2], nullptr, D, FF, D, (bf16_t*)(a.ws + WS_F2), rot);
#endif
}
__device__ __forceinline__ void moeconv_phase(const Ctx& c) {
    ARGS_REF a = *c.a; int rot = 0;
    for (int e = 0; e < 8; ++e) {
        conv_job8<2>(c, a.in[I_M1] + (size_t)e * D * FF, a.in[I_M3] + (size_t)e * D * FF, FF, D, 2 * FF, (unsigned char*)(a.ws + WS_M13 + (size_t)e * 23068672), 64.0f, rot);
        conv_job8<0>(c, a.in[I_M2] + (size_t)e * FF * D, nullptr, D, FF, D, (unsigned char*)(a.ws + WS_M2 + (size_t)e * 11534336), 64.0f, rot);
    }
}

__global__ void __launch_bounds__(512, 2) fwd_kernel(Args args) {
    extern __shared__ __attribute__((aligned(16))) unsigned char lds_raw[];
    volatile LAS unsigned* misc = (volatile LAS unsigned*)((LAS unsigned char*)lds_raw + LDS_MISC);
    if (threadIdx.x < 16) misc[threadIdx.x] = 0u;
    __syncthreads();
    const int lo = args.ph_lo, hi = args.ph_hi;
    XcdBarrier bar; bar.bar = (unsigned*)(args.ws + WS_CTL + CTL_BAR); bar.x = 0; bar.st = misc;
    if (hi - lo > 1) bar = xcd_barrier_post((unsigned*)(args.ws + WS_CTL + CTL_BAR), misc);
#define IN(k) (lo <= (k) && (k) < hi)
#define MKCTX Ctx c; { int t_ = threadIdx.x; asm volatile("" : "+v"(t_)); { ArgsP kp_ = (ArgsP)__builtin_amdgcn_kernarg_segment_ptr(); asm volatile("" : "+s"(kp_)); c.a = kp_; } c.lds = (LAS unsigned char*)lds_raw; c.tid = t_; c.lane = t_ & 63; c.wave = __builtin_amdgcn_readfirstlane(t_ >> 6); c.wg = blockIdx.x; c.G = gridDim.x; }
#ifndef PROBE_MASK
#define PROBE_MASK 0u
#endif
#define REP(k, ...) if ((PROBE_MASK >> (k)) & 1u) { __syncthreads(); __VA_ARGS__; }
#define SEAM(k) do { if (IN(k) && IN((k) + 1)) xcd_barrier(bar); } while (0)
    if (IN(0)) { MKCTX prologue_phase(c); REP(0, prologue_phase(c)) }
    if (IN(0)) { MKCTX norm_phase<0, 0>(c); REP(1, norm_phase<0, 0>(c)) } SEAM(0);

    if (IN(2)) { MKCTX gemm_projmix<0>(c); REP(2, gemm_projmix<0>(c)) } SEAM(2);
    if (IN(3)) { MKCTX intra_phase<0>(c); REP(3, intra_phase<0>(c)) } SEAM(3);
    if (IN(4)) { MKCTX chains_phase<0>(c); REP(4, chains_phase<0>(c)) } SEAM(4);
    if (IN(5)) { MKCTX combine_phase<0>(c); REP(5, combine_phase<0>(c)) } SEAM(5);
    if (IN(6)) { MKCTX gemm_upgate<0>(c); REP(6, gemm_upgate<0>(c)) } SEAM(6);
    if (IN(7)) { MKCTX gemm_wout<0>(c); } SEAM(7);
    if (IN(8)) { MKCTX norm_phase<0, 1>(c); REP(8, norm_phase<0, 1>(c)) } SEAM(8);
    if (IN(9)) { MKCTX gemm_ffn13(c); REP(9, gemm_ffn13(c)) } SEAM(9);
    if (IN(10)) { MKCTX gemm_ffn2(c); } SEAM(10);
    if (IN(11)) { MKCTX norm_phase<1, 0>(c); REP(11, norm_phase<1, 0>(c)) } SEAM(11);
    if (IN(12)) { MKCTX gemm_projmix<1>(c); REP(12, gemm_projmix<1>(c)) } SEAM(12);
    if (IN(13)) { MKCTX intra_phase<1>(c); REP(13, intra_phase<1>(c)) } SEAM(13);
    if (IN(14)) { MKCTX chains_phase<1>(c); REP(14, chains_phase<1>(c)) } SEAM(14);
    if (IN(15)) { MKCTX combine_phase<1>(c); REP(15, combine_phase<1>(c)) } SEAM(15);
    if (IN(16)) { MKCTX gemm_upgate<1>(c); REP(16, gemm_upgate<1>(c)) } SEAM(16);
    if (IN(17)) { MKCTX gemm_wout<1>(c); } SEAM(17);
    if (IN(18)) { MKCTX route1_phase(c); __syncthreads(); moeconv_phase(c); REP(18, route1_phase(c); __syncthreads(); moeconv_phase(c)) } SEAM(18);
    if (IN(19)) { MKCTX route2_phase(c); REP(19, route2_phase(c)) } SEAM(19);
    if (IN(20)) { MKCTX gemm_moe13(c); REP(20, gemm_moe13(c)) } SEAM(20);
    if (IN(21)) { MKCTX gemm_moe2(c); REP(21, gemm_moe2(c)) } SEAM(21);
    if (IN(22)) { MKCTX final_phase(c); }
#undef IN
#undef SEAM
}

extern "C" void kernel_launch(void* const* d_in, const int* in_sizes, int n_in, void* d_out, int out_size, void* d_ws, size_t ws_size, hipStream_t stream) {
    static int grid = 0;
    if (grid == 0) {
        if (n_in != N_IN || out_size != ML * D || ws_size < WS_END) { fprintf(stderr, "kernel_launch: unexpected shapes: n_in %d out %d ws %zu (need %zu)\n", n_in, out_size, ws_size, (size_t)WS_END); grid = -1; return; }
        int dev = 0, cus = 0;
        if (hipGetDevice(&dev) != hipSuccess || hipDeviceGetAttribute(&cus, hipDeviceAttributeMultiprocessorCount, dev) != hipSuccess) { grid = -1; return; }
        if (hipFuncSetAttribute((const void*)fwd_kernel, hipFuncAttributeMaxDynamicSharedMemorySize, LDS_BYTES) != hipSuccess) { fprintf(stderr, "kernel_launch: hipFuncSetAttribute failed\n"); grid = -1; return; }
        int per_cu = 0;
        if (hipOccupancyMaxActiveBlocksPerMultiprocessor(&per_cu, (const void*)fwd_kernel, 512, LDS_BYTES) != hipSuccess || per_cu < 1) { fprintf(stderr, "kernel_launch: occupancy query says %d\n", per_cu); }
        (void)hipGetLastError();
        grid = cus > 256 ? 256 : cus;
    }
    if (grid < 0) return;
    (void)hipMemsetAsync((char*)d_ws + WS_CTL, 0, CTL_BYTES, stream);
    Args a{};
    for (int i = 0; i < N_IN; ++i) a.in[i] = (const float*)d_in[i];
    a.out = (float*)d_out; a.ws = (unsigned char*)d_ws;
#if N_LAUNCHES == 1
    a.ph_lo = 0; a.ph_hi = N_PHASES;
    hipLaunchKernelGGL(fwd_kernel, dim3(grid), dim3(512), LDS_BYTES, stream, a);
#else
    for (int p = 0; p < N_PHASES; ++p) { a.ph_lo = p; a.ph_hi = p + 1; hipLaunchKernelGGL(fwd_kernel, dim3(grid), dim3(512), LDS_BYTES, stream, a); }
#endif
}
```
